# Optimizing an MI355X kernel written in HIP

```python
import math
import jax
import jax.numpy as jnp
from jax import lax
import numpy as np

D_MODEL = 1024
BATCH = 4
SEQ = 8192
DEPTH = 2

GRID_W = 64
CTX_LEN = 256

CONV_W = 4
CONV_PAD_L = 2
CONV_PAD_R = 1
CHUNK = 64

RG_WIDTH = D_MODEL
RG_HEADS = 8
RG_BLOCK = RG_WIDTH // RG_HEADS
RG_C = 8.0

SSD_INNER = D_MODEL
SSD_HEADDIM = 64
SSD_HEADS = SSD_INNER // SSD_HEADDIM
SSD_STATE = 128
SSD_GROUPS = 2
SSD_HPG = SSD_HEADS // SSD_GROUPS
SSD_CONV_DIM = SSD_INNER + 2 * SSD_GROUPS * SSD_STATE

GDN_HEADS = 8
GDN_DK = 128
GDN_DV = 128
GDN_QK = GDN_HEADS * GDN_DK
GDN_V = GDN_HEADS * GDN_DV

HG_HEADS = 8
HG_DK = 128
HG_DV = 128
HG_K = HG_HEADS * HG_DK
HG_V = HG_HEADS * HG_DV

MIX_WIDTH = RG_WIDTH + SSD_INNER
AB_SIZES = (RG_WIDTH, RG_WIDTH, SSD_INNER, SSD_CONV_DIM, 2 * SSD_HEADS)
CD_SIZES = (2 * GDN_QK + GDN_V, GDN_V, 2 * GDN_HEADS, 2 * GDN_HEADS, HG_K, 2 * HG_K, HG_V, HG_V)
AB_IN = sum(AB_SIZES)
CD_IN = sum(CD_SIZES)

N_GROUPS = 4
EXPERTS_PER_GROUP = 8
N_EXPERTS = N_GROUPS * EXPERTS_PER_GROUP
TOP_K = 2
D_EXPERT = 512
MOE_BLOCK = 256

N_EVEN = (DEPTH + 1) // 2
N_ODD = DEPTH // 2
ALPHA = (2 * DEPTH) ** 0.25
BETA = (8 * DEPTH) ** -0.25
LN_EPS = 1e-5
RMS_EPS = 1e-6
F32 = jnp.float32

kernel_name = 'hybrid_rglru_ssd_gdn_hgrn2_hmoe_dit'


def split_cols(z, sizes):
    return jnp.split(z, [int(s) for s in np.cumsum(sizes)[:-1]], axis=-1)


def layer_norm(x, g, b):
    xf = x.astype(F32)
    xc = xf - jnp.mean(xf, -1, keepdims=True)
    var = jnp.mean(xc * xc, -1, keepdims=True)
    return (xc * lax.rsqrt(var + LN_EPS) * g + b).astype(x.dtype)


def l2norm(t):
    return t * lax.rsqrt(jnp.sum(t * t, -1, keepdims=True) + RMS_EPS)


def modulate(x, shift, scale):
    return x * (1 + scale) + shift


def short_conv(x, w, b, rows):
    if rows is not None:
        bsz, n, ch = x.shape
        return short_conv(x.reshape(bsz * rows, GRID_W, ch), w, b, None).reshape(bsz, n, ch)
    n = x.shape[1]
    xp = jnp.pad(x, ((0, 0), (CONV_PAD_L, CONV_PAD_R), (0, 0)))
    y = sum(xp[:, j:j + n] * w[j] for j in range(CONV_W))
    return y if b is None else y + b


def block_mask(strict=False):
    return jnp.tril(jnp.ones((CHUNK, CHUNK), bool), -1 if strict else 0)


def chunked_scan(step, state0, xs):
    def to_chunks(t):
        b, n = t.shape[:2]
        return jnp.swapaxes(t.astype(F32).reshape(b, n // CHUNK, CHUNK, *t.shape[2:]), 0, 1)
    state, ys = lax.scan(step, state0, tuple(to_chunks(t) for t in xs))
    ys = jnp.swapaxes(ys, 0, 1)
    return ys.reshape(ys.shape[0], -1, *ys.shape[3:]), state


def bidir(scan_fn, ctx_dirs, lat_dirs):
    flip = lambda ts: tuple(jnp.flip(t, axis=1) for t in ts)
    y_ctx_f, s_f = scan_fn(*ctx_dirs[0], None)
    y_lat_f, _ = scan_fn(*lat_dirs[0], s_f)
    y_ctx_b, s_b = scan_fn(*flip(ctx_dirs[1]), None)
    y_lat_b, _ = scan_fn(*flip(lat_dirs[1]), s_b)
    return y_lat_f + jnp.flip(y_lat_b, 1), y_ctx_f + jnp.flip(y_ctx_b, 1)


def rglru_gates(xc, wa, ba, wx, bx, lam):
    bsz, n, ch = xc.shape
    xh = xc.reshape(bsz, n, RG_HEADS, RG_BLOCK)
    r = jax.nn.sigmoid(jnp.einsum('bthi,hij->bthj', xh, wa).reshape(bsz, n, ch) + ba)
    i = jax.nn.sigmoid(jnp.einsum('bthi,hij->bthj', xh, wx).reshape(bsz, n, ch) + bx)
    log_a = -RG_C * r * jax.nn.softplus(-lam)
    u = jnp.sqrt(-jnp.expm1(2.0 * log_a)) * (i * xc)
    return (u.astype(F32), log_a.astype(F32))


def rglru_scan(u, log_a, h0):
    def combine(left, right):
        a_l, b_l = left
        a_r, b_r = right
        return a_l * a_r, a_r * b_l + b_r
    a_cum, h = lax.associative_scan(combine, (jnp.exp(log_a), u), axis=1)
    if h0 is not None:
        h = h + a_cum * h0[:, None, :]
    return h, h[:, -1]


def ssd_scan(xdt, log_a, b_in, c_in, s0):
    bsz, _, g, r, p = xdt.shape
    nst = b_in.shape[-1]
    if s0 is None:
        s0 = jnp.zeros((bsz, g, r, nst, p), F32)
    mask = block_mask()

    def step(S, inp):
        xq, aq, bq, cq = inp
        cum = jnp.cumsum(aq, axis=1)
        dec = jnp.exp(jnp.where(mask[None, :, :, None, None], cum[:, :, None] - cum[:, None], -jnp.inf))
        scores = jnp.einsum('btgn,bsgn->btsg', cq, bq)
        y = jnp.einsum('btsgr,bsgrp->btgrp', scores[..., None] * dec, xq)
        y = y + jnp.einsum('btgn,bgrnp->btgrp', cq, S) * jnp.exp(cum)[..., None]
        w_end = jnp.exp(cum[:, -1:] - cum)
        S = S * jnp.exp(cum[:, -1])[..., None, None] + jnp.einsum('bsgn,bsgr,bsgrp->bgrnp', bq, w_end, xq)
        return S, y
    return chunked_scan(step, s0, (xdt, log_a, b_in, c_in))


def ab_features(z, rows, rg_conv_w, rg_conv_b, rg_gate_a_w, rg_gate_a_b, rg_gate_x_w, rg_gate_x_b, rg_lambda,
                ssd_conv_w, ssd_conv_b, ssd_a_log, ssd_dt_bias):
    bsz, n, _ = z.shape
    rg_x, rg_y, ssd_z, ssd_xbc, ssd_dt = split_cols(z, AB_SIZES)
    xc = short_conv(rg_x, rg_conv_w, rg_conv_b, rows)
    rg_dirs = tuple(rglru_gates(xc, rg_gate_a_w[d], rg_gate_a_b[d], rg_gate_x_w[d], rg_gate_x_b[d], rg_lambda[d])
                    for d in range(2))
    xbc = jax.nn.silu(short_conv(ssd_xbc, ssd_conv_w, ssd_conv_b, rows))
    xs, b_in, c_in = split_cols(xbc, (SSD_INNER, SSD_GROUPS * SSD_STATE, SSD_GROUPS * SSD_STATE))
    xs = xs.reshape(bsz, n, SSD_GROUPS, SSD_HPG, SSD_HEADDIM)
    b_in = b_in.reshape(bsz, n, SSD_GROUPS, SSD_STATE)
    c_in = c_in.reshape(bsz, n, SSD_GROUPS, SSD_STATE)
    dt_raw = ssd_dt.reshape(bsz, n, 2, SSD_GROUPS, SSD_HPG)
    ssd_dirs = []
    for d in range(2):
        dt = jax.nn.softplus(dt_raw[:, :, d] + ssd_dt_bias[d].reshape(SSD_GROUPS, SSD_HPG))
        log_a = -jnp.exp(ssd_a_log[d]).reshape(SSD_GROUPS, SSD_HPG) * dt
        ssd_dirs.append((xs * dt[..., None], log_a, b_in, c_in))
    return rg_dirs, tuple(ssd_dirs), (rg_y, ssd_z, xs)


def ab_output(h_rg, y_ssd, rg_y, ssd_z, xs, ssd_d, ssd_norm_g, out_w):
    bsz, n = rg_y.shape[:2]
    a_out = h_rg * jax.nn.gelu(rg_y)
    y = (y_ssd + ssd_d.reshape(SSD_GROUPS, SSD_HPG, 1) * xs).reshape(bsz, n, SSD_GROUPS, -1)
    y = y * jax.nn.silu(ssd_z).reshape(bsz, n, SSD_GROUPS, -1)
    y = (y * lax.rsqrt(jnp.mean(y * y, -1, keepdims=True) + RMS_EPS)).reshape(bsz, n, SSD_INNER) * ssd_norm_g
    return jnp.concatenate([a_out, y], -1).astype(out_w.dtype) @ out_w


def mixer_ab(u_lat, u_ctx, rows, in_w, out_w, rg_conv_w, rg_conv_b, rg_gate_a_w, rg_gate_a_b, rg_gate_x_w,
             rg_gate_x_b, rg_lambda, ssd_conv_w, ssd_conv_b, ssd_a_log, ssd_dt_bias, ssd_d, ssd_norm_g, with_ctx_out):
    def feats(u, r):
        return ab_features((u @ in_w).astype(F32), r, rg_conv_w, rg_conv_b, rg_gate_a_w, rg_gate_a_b, rg_gate_x_w,
                           rg_gate_x_b, rg_lambda, ssd_conv_w, ssd_conv_b, ssd_a_log, ssd_dt_bias)
    lat, ctx = feats(u_lat, rows), feats(u_ctx, None)
    h_rg_lat, h_rg_ctx = bidir(rglru_scan, ctx[0], lat[0])
    y_ssd_lat, y_ssd_ctx = bidir(ssd_scan, ctx[1], lat[1])
    y_lat = ab_output(h_rg_lat, y_ssd_lat, *lat[2], ssd_d, ssd_norm_g, out_w)
    y_ctx = ab_output(h_rg_ctx, y_ssd_ctx, *ctx[2], ssd_d, ssd_norm_g, out_w) if with_ctx_out else None
    return y_lat, y_ctx


def gdn_scan(q, k, v, g, beta, s0):
    bsz, _, h, dk = q.shape
    dv = v.shape[-1]
    if s0 is None:
        s0 = jnp.zeros((bsz, h, dk, dv), F32)
    incl, strict = block_mask(), block_mask(strict=True)
    eye = jnp.eye(CHUNK, dtype=F32)

    def step(S, inp):
        qq, kk, vv, gg, bb = inp
        cum = jnp.cumsum(gg, axis=1)
        cum_h = jnp.swapaxes(cum, 1, 2)
        L = jnp.exp(jnp.where(incl, cum_h[..., :, None] - cum_h[..., None, :], -jnp.inf))
        kb = kk * bb[..., None]
        m = jnp.where(strict, jnp.einsum('bthk,bshk->bhts', kb, kk) * L, 0.0)
        t_mat = lax.linalg.triangular_solve(eye + m, jnp.broadcast_to(eye, m.shape), left_side=True, lower=True,
                                            unit_diagonal=True)
        u = jnp.einsum('bhts,bshv->bhtv', t_mat, vv * bb[..., None])
        w = jnp.einsum('bhts,bshk->bhtk', t_mat, kb * jnp.exp(cum)[..., None])
        v_new = u - jnp.einsum('bhtk,bhkv->bhtv', w, S)
        attn = jnp.einsum('bthk,bshk->bhts', qq, kk) * L
        o = jnp.einsum('bthk,bhkv->bhtv', qq * jnp.exp(cum)[..., None], S) + jnp.einsum('bhts,bhsv->bhtv', attn, v_new)
        last = cum[:, -1]
        S = S * jnp.exp(last)[..., None, None] + jnp.einsum(
            'bshk,bhsv->bhkv', kk * jnp.exp(last[:, None] - cum)[..., None], v_new)
        return S, jnp.swapaxes(o, 1, 2)
    return chunked_scan(step, s0, (q, k, v, g, beta))


def hgrn_scan(q, k, v, log_f, s0):
    bsz, _, h, dk = q.shape
    dv = v.shape[-1]
    if s0 is None:
        s0 = jnp.zeros((bsz, h, dk, dv), F32)
    mask = block_mask()

    def step(S, inp):
        qq, kk, vv, lf = inp
        cum = jnp.cumsum(lf, axis=1)
        dec = jnp.exp(jnp.where(mask[None, :, :, None, None], cum[:, :, None] - cum[:, None], -jnp.inf))
        attn = jnp.einsum('bthk,btshk,bshk->bhts', qq, dec, kk)
        o = jnp.einsum('bhts,bshv->bthv', attn, vv) + jnp.einsum('bthk,bhkv->bthv', qq * jnp.exp(cum), S)
        last = cum[:, -1]
        S = S * jnp.exp(last)[..., None] + jnp.einsum('bshk,bshv->bhkv', kk * jnp.exp(last[:, None] - cum), vv)
        return S, o
    return chunked_scan(step, s0, (q, k, v, log_f))


def cd_features(z, rows, gdn_conv_w, gdn_a_log, gdn_dt_bias, lb):
    bsz, n, _ = z.shape
    qkv, g_gdn, beta_raw, a_raw, hq, hf, hi, g_hg = split_cols(z, CD_SIZES)
    qkv = jax.nn.silu(short_conv(qkv, gdn_conv_w, None, rows))
    q, k, v = split_cols(qkv, (GDN_QK, GDN_QK, GDN_V))
    q = l2norm(q.reshape(bsz, n, GDN_HEADS, GDN_DK)) * GDN_DK ** -0.5
    k = l2norm(k.reshape(bsz, n, GDN_HEADS, GDN_DK))
    v = v.reshape(bsz, n, GDN_HEADS, GDN_DV)
    beta = jax.nn.sigmoid(beta_raw.reshape(bsz, n, 2, GDN_HEADS))
    a = a_raw.reshape(bsz, n, 2, GDN_HEADS)
    gdn_dirs = tuple((q, k, v, -jnp.exp(gdn_a_log[d]) * jax.nn.softplus(a[:, :, d] + gdn_dt_bias[d]), beta[:, :, d])
                     for d in range(2))
    hq = hq.reshape(bsz, n, HG_HEADS, HG_DK)
    hi = hi.reshape(bsz, n, HG_HEADS, HG_DV)
    lbh = lb.reshape(HG_HEADS, HG_DK)
    f = lbh + (1 - lbh) * jax.nn.sigmoid(hf.reshape(bsz, n, 2, HG_HEADS, HG_DK))
    hg_dirs = tuple((hq, 1 - f[:, :, d], hi, jnp.log(f[:, :, d])) for d in range(2))
    return gdn_dirs, hg_dirs, (g_gdn, g_hg)


def gated_head_norm(o, gate, g):
    o = o * lax.rsqrt(jnp.mean(o * o, -1, keepdims=True) + RMS_EPS) * g
    return o.reshape(gate.shape) * jax.nn.silu(gate)


def mixer_cd(u_lat, u_ctx, rows, in_w, out_w, gdn_conv_w, gdn_a_log, gdn_dt_bias, gdn_norm_g, hg_norm_g, lb,
             with_ctx_out):
    def feats(u, r):
        return cd_features((u @ in_w).astype(F32), r, gdn_conv_w, gdn_a_log, gdn_dt_bias, lb)

    def out(o_gdn, o_hg, gates):
        y = jnp.concatenate([gated_head_norm(o_gdn, gates[0], gdn_norm_g), gated_head_norm(o_hg, gates[1], hg_norm_g)], -1)
        return y.astype(out_w.dtype) @ out_w
    lat, ctx = feats(u_lat, rows), feats(u_ctx, None)
    o_gdn_lat, o_gdn_ctx = bidir(gdn_scan, ctx[0], lat[0])
    o_hg_lat, o_hg_ctx = bidir(hgrn_scan, ctx[1], lat[1])
    y_lat = out(o_gdn_lat, o_hg_lat, lat[2])
    y_ctx = out(o_gdn_ctx, o_hg_ctx, ctx[2]) if with_ctx_out else None
    return y_lat, y_ctx


def expert_mlps(t, expert, weight, w_gate, w_up, w_down):
    n_tok, d = t.shape
    m = expert.shape[0]
    token = jnp.arange(m, dtype=jnp.int32) // TOP_K
    order = jnp.argsort(expert)
    e_sorted = expert[order]
    counts = jax.ops.segment_sum(jnp.ones_like(expert), expert, num_segments=N_EXPERTS)
    padded = (counts + MOE_BLOCK - 1) // MOE_BLOCK * MOE_BLOCK
    pad_end = jnp.cumsum(padded)
    start = jnp.cumsum(counts) - counts
    slot = (pad_end - padded)[e_sorted] + jnp.arange(m, dtype=jnp.int32) - start[e_sorted]
    n_blocks = m // MOE_BLOCK + N_EXPERTS
    slot_token = jnp.full((n_blocks * MOE_BLOCK,), n_tok, jnp.int32).at[slot].set(token[order])
    slot_w = jnp.zeros((n_blocks * MOE_BLOCK,), weight.dtype).at[slot].set(weight[order])
    block_expert = jnp.clip(jnp.searchsorted(pad_end, jnp.arange(n_blocks) * MOE_BLOCK, side='right'), 0, N_EXPERTS - 1)
    t_pad = jnp.concatenate([t, jnp.zeros((1, d), t.dtype)], 0)

    def run_block(args):
        tok, e = args
        h = t_pad[tok]
        return (jax.nn.silu(h @ w_gate[e]) * (h @ w_up[e])) @ w_down[e]
    y = lax.map(run_block, (slot_token.reshape(n_blocks, MOE_BLOCK), block_expert)).reshape(-1, d)
    out = jnp.zeros((n_tok + 1, d), F32).at[slot_token].add(y.astype(F32) * slot_w[:, None])
    return out[:n_tok].astype(t.dtype)


def hier_moe(t, router_group_w, router_group_b, router_expert_w, router_expert_b, w_gate, w_up, w_down):
    n_tok = t.shape[0]
    tf = t.astype(F32)
    p_group = jax.nn.softmax(tf @ router_group_w + router_group_b, axis=-1)
    p_top_g, top_g = lax.top_k(p_group, 1)
    e_logits = (tf @ router_expert_w + router_expert_b).reshape(n_tok, N_GROUPS, EXPERTS_PER_GROUP)
    e_logits = e_logits[jnp.arange(n_tok), top_g[:, 0]]
    p_top_e, top_e = lax.top_k(jax.nn.softmax(e_logits, axis=-1), TOP_K)
    gate = p_top_g * p_top_e / jnp.sum(p_top_e, -1, keepdims=True)
    expert = (top_g * EXPERTS_PER_GROUP + top_e).reshape(-1)
    return expert_mlps(t, expert, gate.reshape(-1), w_gate, w_up, w_down)


def setup_inputs(seed: int = 0) -> dict:
    key = jax.random.key(seed)
    ks = iter(jax.random.split(key, 64))
    D = D_MODEL

    def nrm(shape, scale):
        return jax.random.normal(next(ks), shape, F32) * scale

    def unif(shape, lo, hi):
        return jax.random.uniform(next(ks), shape, F32, lo, hi)

    def dt_bias(shape):
        dt = jnp.exp(unif(shape, math.log(1e-3), math.log(1e-1)))
        return dt + jnp.log(-jnp.expm1(-dt))

    def logit_unif(shape, lo, hi):
        u = unif(shape, lo, hi)
        return jnp.log(u) - jnp.log1p(-u)

    return {
        'x': nrm((BATCH, SEQ, D), 1.0),
        'c': nrm((BATCH, D), 1.0),
        'ctx': nrm((BATCH, CTX_LEN, D), 1.0),
        'c_ctx': nrm((D,), 1.0),
        'hgrn_lb': nrm((DEPTH, HG_K), 0.5),
        'ada_w': nrm((DEPTH, D, 6 * D), 0.5 * D ** -0.5),
        'ada_b': nrm((DEPTH, 6 * D), 0.02),
        'ln_mix_g': 1.0 + nrm((DEPTH, D), 0.02),
        'ln_mix_b': nrm((DEPTH, D), 0.02),
        'ln_ffn_g': 1.0 + nrm((DEPTH, D), 0.02),
        'ln_ffn_b': nrm((DEPTH, D), 0.02),
        'mix_out_w': nrm((DEPTH, MIX_WIDTH, D), BETA * MIX_WIDTH ** -0.5),
        'router_group_w': nrm((DEPTH, D, N_GROUPS), D ** -0.5),
        'router_group_b': nrm((DEPTH, N_GROUPS), 0.01),
        'router_expert_w': nrm((DEPTH, D, N_EXPERTS), D ** -0.5),
        'router_expert_b': nrm((DEPTH, N_EXPERTS), 0.01),
        'exp_w_gate': nrm((DEPTH, N_EXPERTS, D, D_EXPERT), D ** -0.5),
        'exp_w_up': nrm((DEPTH, N_EXPERTS, D, D_EXPERT), D ** -0.5),
        'exp_w_down': nrm((DEPTH, N_EXPERTS, D_EXPERT, D), BETA * D_EXPERT ** -0.5),
        'ab_in_w': nrm((N_EVEN, D, AB_IN), D ** -0.5),
        'rg_conv_w': nrm((N_EVEN, CONV_W, RG_WIDTH), 0.5),
        'rg_conv_b': nrm((N_EVEN, RG_WIDTH), 0.02),
        'rg_gate_a_w': nrm((N_EVEN, 2, RG_HEADS, RG_BLOCK, RG_BLOCK), RG_BLOCK ** -0.5),
        'rg_gate_a_b': nrm((N_EVEN, 2, RG_WIDTH), 0.02),
        'rg_gate_x_w': nrm((N_EVEN, 2, RG_HEADS, RG_BLOCK, RG_BLOCK), RG_BLOCK ** -0.5),
        'rg_gate_x_b': nrm((N_EVEN, 2, RG_WIDTH), 0.02),
        'rg_lambda': logit_unif((N_EVEN, 2, RG_WIDTH), 0.9, 0.999),
        'ssd_conv_w': nrm((N_EVEN, CONV_W, SSD_CONV_DIM), 0.5),
        'ssd_conv_b': nrm((N_EVEN, SSD_CONV_DIM), 0.02),
        'ssd_a_log': jnp.log(unif((N_EVEN, 2, SSD_HEADS), 1.0, 16.0)),
        'ssd_dt_bias': dt_bias((N_EVEN, 2, SSD_HEADS)),
        'ssd_d': 1.0 + nrm((N_EVEN, SSD_HEADS), 0.02),
        'ssd_norm_g': 1.0 + nrm((N_EVEN, SSD_INNER), 0.02),
        'cd_in_w': nrm((N_ODD, D, CD_IN), D ** -0.5),
        'gdn_conv_w': nrm((N_ODD, CONV_W, 2 * GDN_QK + GDN_V), 0.5),
        'gdn_a_log': jnp.log(unif((N_ODD, 2, GDN_HEADS), 1.0, 16.0)),
        'gdn_dt_bias': dt_bias((N_ODD, 2, GDN_HEADS)),
        'gdn_norm_g': 1.0 + nrm((N_ODD, GDN_DV), 0.02),
        'hg_norm_g': 1.0 + nrm((N_ODD, HG_DV), 0.02),
    }


def reference(x, c, ctx, c_ctx, hgrn_lb, ada_w, ada_b, ln_mix_g, ln_mix_b, ln_ffn_g, ln_ffn_b, mix_out_w,
              router_group_w, router_group_b, router_expert_w, router_expert_b, exp_w_gate, exp_w_up, exp_w_down,
              ab_in_w, rg_conv_w, rg_conv_b, rg_gate_a_w, rg_gate_a_b, rg_gate_x_w, rg_gate_x_b, rg_lambda,
              ssd_conv_w, ssd_conv_b, ssd_a_log, ssd_dt_bias, ssd_d, ssd_norm_g,
              cd_in_w, gdn_conv_w, gdn_a_log, gdn_dt_bias, gdn_norm_g, hg_norm_g):
    rows = x.shape[1] // GRID_W
    d = x.shape[-1]
    lb_all = jnp.cumsum(jax.nn.softmax(hgrn_lb.astype(F32), axis=0), axis=0)
    lb_all = lb_all - lb_all[0]
    s_lat = jax.nn.silu(c)
    s_ctx = jax.nn.silu(c_ctx)
    h_lat, h_ctx = x, ctx
    for l in range(DEPTH):
        last = l == DEPTH - 1
        j = l // 2
        mod_lat = jnp.split((s_lat @ ada_w[l] + ada_b[l])[:, None, :], 6, axis=-1)
        mod_ctx = jnp.split(s_ctx @ ada_w[l] + ada_b[l], 6, axis=-1)
        u_lat = modulate(h_lat, mod_lat[0], mod_lat[1])
        u_ctx = modulate(h_ctx, mod_ctx[0], mod_ctx[1])
        if l % 2 == 0:
            y_lat, y_ctx = mixer_ab(u_lat, u_ctx, rows, ab_in_w[j], mix_out_w[l], rg_conv_w[j], rg_conv_b[j],
                                    rg_gate_a_w[j], rg_gate_a_b[j], rg_gate_x_w[j], rg_gate_x_b[j], rg_lambda[j],
                                    ssd_conv_w[j], ssd_conv_b[j], ssd_a_log[j], ssd_dt_bias[j], ssd_d[j],
                                    ssd_norm_g[j], not last)
        else:
            y_lat, y_ctx = mixer_cd(u_lat, u_ctx, rows, cd_in_w[j], mix_out_w[l], gdn_conv_w[j], gdn_a_log[j],
                                    gdn_dt_bias[j], gdn_norm_g[j], hg_norm_g[j], lb_all[l], not last)
        h_lat = layer_norm(ALPHA * h_lat + mod_lat[2] * y_lat, ln_mix_g[l], ln_mix_b[l])
        v_lat = modulate(h_lat, mod_lat[3], mod_lat[4]).reshape(-1, d)
        moe = lambda t: hier_moe(t, router_group_w[l], router_group_b[l], router_expert_w[l], router_expert_b[l],
                                 exp_w_gate[l], exp_w_up[l], exp_w_down[l])
        if last:
            f_lat = moe(v_lat)
        else:
            h_ctx = layer_norm(ALPHA * h_ctx + mod_ctx[2] * y_ctx, ln_mix_g[l], ln_mix_b[l])
            v_ctx = modulate(h_ctx, mod_ctx[3], mod_ctx[4]).reshape(-1, d)
            f_all = moe(jnp.concatenate([v_lat, v_ctx], 0))
            f_lat = f_all[:v_lat.shape[0]]
            h_ctx = layer_norm(ALPHA * h_ctx + mod_ctx[5] * f_all[v_lat.shape[0]:].reshape(h_ctx.shape),
                               ln_ffn_g[l], ln_ffn_b[l])
        h_lat = layer_norm(ALPHA * h_lat + mod_lat[5] * f_lat.reshape(h_lat.shape), ln_ffn_g[l], ln_ffn_b[l])
    return h_lat
```

```cpp
#include <hip/hip_runtime.h>
#include <hip/hip_cooperative_groups.h>
#include <cstdio>
#include <cstdint>
namespace cg = cooperative_groups;

#define LAS __attribute__((address_space(3)))
typedef unsigned short bf16_t;
typedef short bf16x8 __attribute__((ext_vector_type(8)));
typedef float f32x4 __attribute__((ext_vector_type(4)));
typedef float f32x2 __attribute__((ext_vector_type(2)));
typedef unsigned u32x4 __attribute__((ext_vector_type(4)));
typedef unsigned u32x2 __attribute__((ext_vector_type(2)));

constexpr int D = 1024, NB = 4, SEQ = 8192, CTXL = 256, TB = SEQ + CTXL  , R = NB * TB  , RLAT = NB * SEQ;
constexpr int NT = 512, NWAVES = 8;
constexpr int LDS_BYTES = 163840;
constexpr int AB_IN = 4640, CD_IN = 9248;
constexpr int Z0W = 4608, Z1W = 7168, MIXW = 2048;
constexpr int NEXP = 32, DEXP = 512, MOE_BLK = 256, MAX_BLKS = 304, MAX_SLOTS = 296 * 256;
constexpr float ALPHA = 1.41421356237309515f;
constexpr float LN_EPS = 1e-5f, RMS_EPS = 1e-6f;
constexpr int Z0_RGX = 0, Z0_RGY = 1024, Z0_SSDZ = 2048, Z0_XBC = 3072, Z0_B = 4096, Z0_C = 4352;
constexpr int Z1_Q = 0, Z1_K = 1024, Z1_V = 2048, Z1_HQ = 3072, Z1_HF = 4096, Z1_HI = 6144;

constexpr size_t MiB = 1u << 20;
constexpr size_t OFF_CTL = 0;
constexpr size_t OFF_MOD = 64 * 1024;
constexpr size_t OFF_LB1 = 320 * 1024;
constexpr size_t OFF_ROUTE = 512 * 1024;
constexpr size_t OFF_SLOTW = 2 * MiB;
constexpr size_t OFF_DT = 3 * MiB;
constexpr size_t OFF_HCTX = 8 * MiB;
constexpr size_t OFF_TCTX = 12 * MiB;
constexpr size_t OFF_WOUT0 = 16 * MiB, OFF_WOUT1 = 20 * MiB, OFF_WG1 = 24 * MiB, OFF_WAB = 28 * MiB;
constexpr size_t OFF_A = 40 * MiB;
constexpr size_t OFF_Z0 = OFF_A, OFF_MIX0 = OFF_A + 297 * MiB, OFF_WE0 = OFF_A + 429 * MiB, OFF_U0 = OFF_A + 525 * MiB;
constexpr size_t OFF_AM0 = OFF_A, OFF_HM0 = OFF_A + 148 * MiB, OFF_YM0 = OFF_A + 222 * MiB;
constexpr size_t OFF_Z1 = OFF_A, OFF_U1 = OFF_A + 462 * MiB, OFF_WCD = OFF_A + 528 * MiB, OFF_MIX1 = OFF_A + 462 * MiB;
constexpr size_t OFF_WE1 = OFF_A, OFF_U1B = OFF_A + 96 * MiB, OFF_AM1 = OFF_A + 96 * MiB, OFF_HM1 = OFF_A + 244 * MiB, OFF_YM1 = OFF_A + 318 * MiB, OFF_V1 = OFF_A + 470 * MiB;
constexpr size_t WS_NEED = OFF_A + 594 * MiB;
static_assert((size_t)R * Z0W * 2 <= 297 * MiB && (size_t)R * MIXW * 2 <= 132 * MiB && (size_t)R * Z1W * 2 <= 462 * MiB && (size_t)R * D * 2 <= 66 * MiB, "ws map");
static_assert((size_t)MAX_SLOTS * D * 2 <= 148 * MiB && (size_t)MAX_SLOTS * DEXP * 2 <= 74 * MiB, "ws map moe");
static_assert(OFF_DT + (size_t)R * 32 * 4 <= OFF_HCTX && OFF_ROUTE + (size_t)R * 32 <= OFF_SLOTW && OFF_SLOTW + MAX_SLOTS * 4 <= OFF_DT, "ws map small");

struct Params { const float* in[39]; float* out; unsigned char* ws; };
enum { I_X = 0, I_C, I_CTX, I_CCTX, I_HLB, I_ADAW, I_ADAB, I_LNMG, I_LNMB, I_LNFG, I_LNFB, I_OUTW, I_RGW, I_RGB, I_REW, I_REB, I_EWG, I_EWU, I_EWD,
       I_ABW, I_RGCW, I_RGCB, I_RGAW, I_RGAB, I_RGXW, I_RGXB, I_RGLAM, I_SCW, I_SCB, I_SALOG, I_SDTB, I_SD, I_SNG, I_CDW, I_GCW, I_GALOG, I_GDTB, I_GNG, I_HNG };

__device__ __forceinline__ unsigned f2bf(float f) { unsigned u = __float_as_uint(f); return (u + 0x7fffu + ((u >> 16) & 1u)) >> 16; }
__device__ __forceinline__ float bf2f(unsigned b) { return __uint_as_float(b << 16); }
__device__ __forceinline__ unsigned pk2(float lo, float hi) { return f2bf(lo) | (f2bf(hi) << 16); }
__device__ __forceinline__ float bflo(unsigned w) { return __uint_as_float(w << 16); }
__device__ __forceinline__ float bfhi(unsigned w) { return __uint_as_float(w & 0xffff0000u); }
__device__ __forceinline__ float sigmoidf_(float x) { return 1.f / (1.f + __expf(-x)); }
__device__ __forceinline__ float siluf_(float x) { return x / (1.f + __expf(-x)); }
__device__ __forceinline__ float softplusf_(float x) { return x > 20.f ? x : log1pf(__expf(x)); }
__device__ __forceinline__ float geluf_(float x) { const float u = 0.7978845608028654f * (x + 0.044715f * x * x * x); return 0.5f * x * (1.f + tanhf(u)); }
__device__ __forceinline__ float wave_sum(float v) {
#pragma unroll
  for (int o = 1; o < 64; o <<= 1) v += __shfl_xor(v, o);
  return v;
}
__device__ __forceinline__ float half_sum32(float v) {
#pragma unroll
  for (int o = 1; o < 32; o <<= 1) v += __shfl_xor(v, o);
  return v;
}
__device__ __forceinline__ int row_batch(int r) { return r / TB; }

namespace pg8 {
constexpr int BM = 256, BK = 64, HALF = 128, HTB = HALF * BK * 2, STAGE_BYTES = 8 * HTB, NXCD = 8, WGM = 8;
__host__ __device__ __forceinline__ int lds_byte(int r, int c) { const int st = (r >> 4) * 2 + (c >> 5), rr = r & 15, cc = c & 31, ob = rr * 64 + cc * 2; return st * 1024 + (ob ^ (((ob >> 9) & 1) << 5)); }
__host__ __device__ __forceinline__ void stage_rc(int b, int& Rr, int& C) { const int st = b / 1024, sb = b % 1024, swz = sb ^ (((sb >> 9) & 1) << 5); Rr = (st >> 1) * 16 + swz / 64; C = (st & 1) * 32 + (swz % 64) / 2; }
__host__ __device__ __forceinline__ int perm32(int rho) { const int n = rho >> 4, i = rho & 15; return 8 * (i >> 2) + 4 * n + (i & 3); }
struct Unit { int pm, pn; };
struct Gemm { const bf16_t* A; const bf16_t* Bt; int lda, K; };

struct GridOrder {
  int nM, nN, nwg, G, c, skipctx;
  __device__ void init(int nM_, int nN_, int G_, int c_, int skipctx_) { nM = nM_; nN = nN_; nwg = nM * nN; G = G_; c = c_; skipctx = skipctx_; }
  __device__ bool next(int i, Unit& u) const {
    const long L = (long)i * G + c; if (L >= nwg) return false;
    int wgid = (int)L; { const int q = nwg / NXCD, r = nwg % NXCD, xcd = wgid % NXCD, off = wgid / NXCD; wgid = (xcd < r ? xcd * (q + 1) : r * (q + 1) + (xcd - r) * q) + off; }
    const int nig = WGM * nN, gid = wgid / nig, fm = gid * WGM, gsz = (nM - fm) < WGM ? (nM - fm) : WGM;
    int pm = fm + ((wgid % nig) % gsz); u.pn = (wgid % nig) / gsz;
    if (skipctx) pm = (pm >> 5) * 33 + 1 + (pm & 31);
    u.pm = pm; return true;
  }
};
struct MoeOrder {
  const int* blk_e; int nunits, G, c;
  __device__ bool next(int i, Unit& u) const {
    const long L = (long)i * G + c; if (L >= nunits) return false;
    const int blk = (int)(L >> 2), j = (int)(L & 3);
    u.pm = blk; u.pn = blk_e[blk] * 4 + j; return true;
  }
};

__device__ __forceinline__ unsigned cvt_pk_bf16(float lo, float hi) { unsigned r; asm volatile("v_cvt_pk_bf16_f32 %0, %1, %2" : "=v"(r) : "v"(lo), "v"(hi)); return r; }

template <class Epi, class Sched>
__device__ __forceinline__ void gemm_phase(LAS unsigned char* lds, const Gemm g, const Sched& S, const Epi& E) {
  int tid_ = threadIdx.x; asm volatile("" : "+v"(tid_)); tid_ &= 511; const int tid = tid_, wid = __builtin_amdgcn_readfirstlane(tid >> 6), lane = tid & 63, wr = wid >> 2, wc = wid & 3, fr = lane & 15, fq = lane >> 4;
  const int K = g.K, nt = K / BK, lda = g.lda;
  unsigned voffA[2], voffB[2];
#pragma unroll
  for (int i = 0; i < 2; ++i) { int Rr, C; stage_rc(tid * 16 + i * 8192, Rr, C); const int Rb = Epi::PERM ? ((Rr & ~31) + perm32(Rr & 31)) : Rr;
    voffA[i] = (unsigned)(Rr * lda + C) * 2u; voffB[i] = (unsigned)(Rb * K + C) * 2u; }
  const size_t kstep = (size_t)(BK * 2);
  const size_t hstepA = (size_t)HALF * lda * 2, hstepB = (size_t)HALF * K * 2;
  const size_t tstepA = 2 * hstepA, tstepB = 2 * hstepB;
  const unsigned ldsw = (unsigned)wid * 1024u;
  const int aoff = lds_byte(wr * 64 + fr, fq * 8), boff = lds_byte(wc * 32 + fr, fq * 8);
#define PG8_SA(b, h) (((b) * 2 + (h)) * HTB)
#define PG8_SB(b, h) ((4 + (b) * 2 + (h)) * HTB)
#define PG8_STAGE(bufoff, gbase, voff) do { _Pragma("unroll") for (int _i = 0; _i < 2; ++_i) \
    __builtin_amdgcn_global_load_lds((const unsigned*)((const char*)(gbase) + (voff)[_i]), (LAS unsigned*)(lds + (bufoff) + ldsw + _i * 8192), 16, 0, 0); } while (0)
#define PG8_LDA(dst, b, h) do { _Pragma("unroll") for (int m = 0; m < 4; ++m) _Pragma("unroll") for (int k = 0; k < 2; ++k) dst[m][k] = *(const LAS bf16x8*)(lds + PG8_SA(b, h) + aoff + m * 2048 + k * 1024); } while (0)
#define PG8_LDB(dst, b, h) do { _Pragma("unroll") for (int n = 0; n < 2; ++n) _Pragma("unroll") for (int k = 0; k < 2; ++k) dst[n][k] = *(const LAS bf16x8*)(lds + PG8_SB(b, h) + boff + n * 2048 + k * 1024); } while (0)
#define PG8_MMA(ai, bj, At, Bt) do { __builtin_amdgcn_s_setprio(1); _Pragma("unroll") for (int m = 0; m < 4; ++m) _Pragma("unroll") for (int n = 0; n < 2; ++n) _Pragma("unroll") for (int k = 0; k < 2; ++k) \
    acc[ai][bj][m][n] = __builtin_amdgcn_mfma_f32_16x16x32_bf16(Bt[n][k], At[m][k], acc[ai][bj][m][n], 0, 0, 0); __builtin_amdgcn_s_setprio(0); } while (0)
#define PG8_WAIT_V(n) asm volatile("s_waitcnt vmcnt(" #n ")" ::: "memory")
#define PG8_WAIT_L(n) asm volatile("s_waitcnt lgkmcnt(" #n ")" ::: "memory")
#define PG8_BAR __builtin_amdgcn_s_barrier()
#define PG8_SCHED __builtin_amdgcn_sched_barrier(0)
  Unit cur, nxt; int ui = 0;
  if (!S.next(0, cur)) return;
  f32x4 acc[2][2][4][2];
#pragma unroll
  for (int a = 0; a < 2; ++a)
#pragma unroll
    for (int b = 0; b < 2; ++b)
#pragma unroll
      for (int m = 0; m < 4; ++m)
#pragma unroll
        for (int n = 0; n < 2; ++n) acc[a][b][m][n] = (f32x4){0.f, 0.f, 0.f, 0.f};
  bf16x8 At[4][2], B0[2][2], B1[2][2];
  const char* cA = (const char*)g.A + (size_t)cur.pm * tstepA; const char* cB = (const char*)g.Bt + (size_t)cur.pn * tstepB;
  PG8_STAGE(PG8_SB(0, 0), cB, voffB); PG8_STAGE(PG8_SA(0, 0), cA, voffA); PG8_STAGE(PG8_SB(0, 1), cB + hstepB, voffB); PG8_STAGE(PG8_SA(0, 1), cA + hstepA, voffA);
  if (wr == 1) PG8_BAR;
  PG8_WAIT_V(4); PG8_BAR;
  PG8_STAGE(PG8_SB(1, 0), cB + kstep, voffB); PG8_STAGE(PG8_SA(1, 0), cA + kstep, voffA); PG8_STAGE(PG8_SB(1, 1), cB + hstepB + kstep, voffB);
  PG8_WAIT_V(6); PG8_BAR;
  for (;;) {
    const bool has_next = S.next(ui + 1, nxt);
    const char* nA = has_next ? (const char*)g.A + (size_t)nxt.pm * tstepA : cA; const char* nB = has_next ? (const char*)g.Bt + (size_t)nxt.pn * tstepB : cB;
    for (int t = 0; t < nt; t += 2) {
      const bool last = (t == nt - 2);
      const char* a1 = cA + (size_t)(t + 1) * kstep;
      const char* a2 = last ? nA : cA + (size_t)(t + 2) * kstep; const char* b2 = last ? nB : cB + (size_t)(t + 2) * kstep;
      const char* a3 = a2 + kstep; const char* b3 = b2 + kstep;
      PG8_LDB(B0, 0, 0); PG8_SCHED; PG8_LDA(At, 0, 0); PG8_STAGE(PG8_SA(1, 1), a1 + hstepA, voffA);
      PG8_WAIT_L(8); PG8_BAR; PG8_WAIT_L(0); PG8_MMA(0, 0, At, B0); PG8_BAR; PG8_SCHED;
      PG8_LDB(B1, 0, 1); PG8_STAGE(PG8_SB(0, 0), b2, voffB);
      PG8_BAR; PG8_WAIT_L(0); PG8_MMA(0, 1, At, B1); PG8_BAR;
      PG8_LDA(At, 0, 1); PG8_STAGE(PG8_SA(0, 0), a2, voffA);
      PG8_BAR; PG8_WAIT_L(0); PG8_MMA(1, 0, At, B0); PG8_BAR; PG8_SCHED;
      PG8_STAGE(PG8_SB(0, 1), b2 + hstepB, voffB);
      PG8_WAIT_V(6); PG8_BAR; PG8_MMA(1, 1, At, B1); PG8_BAR;
      PG8_LDB(B0, 1, 0); PG8_SCHED; PG8_LDA(At, 1, 0); PG8_STAGE(PG8_SA(0, 1), a2 + hstepA, voffA);
      PG8_WAIT_L(8); PG8_BAR; PG8_WAIT_L(0); PG8_MMA(0, 0, At, B0); PG8_BAR; PG8_SCHED;
      PG8_LDB(B1, 1, 1); PG8_STAGE(PG8_SB(1, 0), b3, voffB);
      PG8_BAR; PG8_WAIT_L(0); PG8_MMA(0, 1, At, B1); PG8_BAR;
      PG8_LDA(At, 1, 1); PG8_STAGE(PG8_SA(1, 0), a3, voffA);
      PG8_BAR; PG8_WAIT_L(0); PG8_MMA(1, 0, At, B0); PG8_BAR; PG8_SCHED;
      PG8_STAGE(PG8_SB(1, 1), b3 + hstepB, voffB);
      PG8_WAIT_V(6); PG8_BAR; PG8_MMA(1, 1, At, B1); PG8_BAR;
    }
    E(acc, cur, wr, wc, fr, fq);
    if (!has_next) break;
#pragma unroll
    for (int a = 0; a < 2; ++a)
#pragma unroll
      for (int b = 0; b < 2; ++b)
#pragma unroll
        for (int m = 0; m < 4; ++m)
#pragma unroll
          for (int n = 0; n < 2; ++n) acc[a][b][m][n] = (f32x4){0.f, 0.f, 0.f, 0.f};
    cur = nxt; cA = nA; cB = nB; ++ui;
  }
  PG8_WAIT_V(0);
  if (wr == 0) PG8_BAR;
  PG8_BAR;
#undef PG8_SA
#undef PG8_SB
#undef PG8_STAGE
#undef PG8_LDA
#undef PG8_LDB
#undef PG8_MMA
#undef PG8_WAIT_V
#undef PG8_WAIT_L
#undef PG8_BAR
#undef PG8_SCHED
}

struct EpiBf16 {
  static constexpr bool PERM = true;
  bf16_t* O; int ldc;
  __device__ __forceinline__ void operator()(const f32x4 (&acc)[2][2][4][2], const Unit& u, int wr, int wc, int fr, int fq) const {
    const int row0 = u.pm * BM + wr * 64 + fr, col0 = u.pn * BM + wc * 32 + 8 * fq;
#pragma unroll
    for (int ai = 0; ai < 2; ++ai)
#pragma unroll
      for (int m = 0; m < 4; ++m) { bf16_t* rowp = O + (size_t)(row0 + ai * HALF + m * 16) * ldc + col0;
#pragma unroll
        for (int bj = 0; bj < 2; ++bj) { const f32x4 v0 = acc[ai][bj][m][0], v1 = acc[ai][bj][m][1];
          u32x4 w; w.x = cvt_pk_bf16(v0[0], v0[1]); w.y = cvt_pk_bf16(v0[2], v0[3]); w.z = cvt_pk_bf16(v1[0], v1[1]); w.w = cvt_pk_bf16(v1[2], v1[3]);
          *(u32x4*)(rowp + bj * HALF) = w; } }
  }
};
struct EpiResid {
  static constexpr bool PERM = false;
  const float* hlat; const float* hctx; float* tlat; float* tctx; const float* gate;
  __device__ __forceinline__ void operator()(const f32x4 (&acc)[2][2][4][2], const Unit& u, int wr, int wc, int fr, int fq) const {
    const int b = u.pm / 33, tt = u.pm % 33; const bool isctx = (tt == 0);
    const float* hs = isctx ? hctx + (size_t)b * CTXL * D : hlat + ((size_t)b * SEQ + (size_t)(tt - 1) * 256) * D;
    float* td = isctx ? tctx + (size_t)b * CTXL * D : tlat + ((size_t)b * SEQ + (size_t)(tt - 1) * 256) * D;
    const float* gt = gate + (size_t)(isctx ? 4 : b) * 6144;
    const int lrow0 = wr * 64 + fr, col0 = u.pn * BM + wc * 32 + 4 * fq;
#pragma unroll
    for (int bj = 0; bj < 2; ++bj)
#pragma unroll
      for (int n = 0; n < 2; ++n) { const f32x4 gvv = *(const f32x4*)(gt + col0 + bj * HALF + n * 16);
#pragma unroll
        for (int ai = 0; ai < 2; ++ai) {
#pragma unroll
          for (int m = 0; m < 4; ++m) { const size_t off = (size_t)(lrow0 + ai * HALF + m * 16) * D + col0 + bj * HALF + n * 16;
            const f32x4 hv = *(const f32x4*)(hs + off);
            *(f32x4*)(td + off) = hv * ALPHA + gvv * acc[ai][bj][m][n]; }
          asm volatile("" ::: "memory"); } }
  }
};
struct EpiGateMul {
  static constexpr bool PERM = true;
  bf16_t* O; int ldc;
  __device__ __forceinline__ void operator()(const f32x4 (&acc)[2][2][4][2], const Unit& u, int wr, int wc, int fr, int fq) const {
    const int row0 = u.pm * BM + wr * 64 + fr, col0 = u.pn * BM + wc * 32 + 8 * fq;
#pragma unroll
    for (int ai = 0; ai < 2; ++ai)
#pragma unroll
      for (int m = 0; m < 4; ++m) { bf16_t* rowp = O + (size_t)(row0 + ai * HALF + m * 16) * ldc + col0;
#pragma unroll
        for (int bj = 0; bj < 2; ++bj) { const f32x4 v0 = acc[ai][bj][m][0], v1 = acc[ai][bj][m][1];
          const u32x4 o = *(const u32x4*)(rowp + bj * HALF);
          u32x4 w;
          w.x = cvt_pk_bf16(bflo(o.x) * siluf_(v0[0]), bfhi(o.x) * siluf_(v0[1])); w.y = cvt_pk_bf16(bflo(o.y) * siluf_(v0[2]), bfhi(o.y) * siluf_(v0[3]));
          w.z = cvt_pk_bf16(bflo(o.z) * siluf_(v1[0]), bfhi(o.z) * siluf_(v1[1])); w.w = cvt_pk_bf16(bflo(o.w) * siluf_(v1[2]), bfhi(o.w) * siluf_(v1[3]));
          *(u32x4*)(rowp + bj * HALF) = w; } }
  }
};
struct EpiSwiGLU {
  static constexpr bool PERM = true;
  bf16_t* H;
  __device__ __forceinline__ void operator()(const f32x4 (&acc)[2][2][4][2], const Unit& u, int wr, int wc, int fr, int fq) const {
    const int row0 = u.pm * BM + wr * 64 + fr, col0 = (u.pn & 3) * 128 + wc * 32 + 8 * fq;
#pragma unroll
    for (int ai = 0; ai < 2; ++ai)
#pragma unroll
      for (int m = 0; m < 4; ++m) { bf16_t* rowp = H + (size_t)(row0 + ai * HALF + m * 16) * DEXP + col0;
        const f32x4 g0 = acc[ai][0][m][0], g1 = acc[ai][0][m][1], u0 = acc[ai][1][m][0], u1 = acc[ai][1][m][1];
        u32x4 w; w.x = cvt_pk_bf16(siluf_(g0[0]) * u0[0], siluf_(g0[1]) * u0[1]); w.y = cvt_pk_bf16(siluf_(g0[2]) * u0[2], siluf_(g0[3]) * u0[3]);
        w.z = cvt_pk_bf16(siluf_(g1[0]) * u1[0], siluf_(g1[1]) * u1[1]); w.w = cvt_pk_bf16(siluf_(g1[2]) * u1[2], siluf_(g1[3]) * u1[3]);
        *(u32x4*)rowp = w; }
  }
};
struct EpiMoeDown {
  static constexpr bool PERM = true;
  bf16_t* Y; const float* slotw;
  __device__ __forceinline__ void operator()(const f32x4 (&acc)[2][2][4][2], const Unit& u, int wr, int wc, int fr, int fq) const {
    const int row0 = u.pm * BM + wr * 64 + fr, col0 = (u.pn & 3) * BM + wc * 32 + 8 * fq;
#pragma unroll
    for (int ai = 0; ai < 2; ++ai)
#pragma unroll
      for (int m = 0; m < 4; ++m) { const int row = row0 + ai * HALF + m * 16; const float sw = slotw[row]; bf16_t* rowp = Y + (size_t)row * D + col0;
#pragma unroll
        for (int bj = 0; bj < 2; ++bj) { const f32x4 v0 = acc[ai][bj][m][0] * sw, v1 = acc[ai][bj][m][1] * sw;
          u32x4 w; w.x = cvt_pk_bf16(v0[0], v0[1]); w.y = cvt_pk_bf16(v0[2], v0[3]); w.z = cvt_pk_bf16(v1[0], v1[1]); w.w = cvt_pk_bf16(v1[2], v1[3]);
          *(u32x4*)(rowp + bj * HALF) = w; } }
  }
};
}

struct Ctx {
  LAS unsigned char* lds; int tid, lane, wave, gw, ngw, bid, nblk;
};
#define GAS __attribute__((address_space(1)))
#define WS(off, T) ((T*)(GAS T*)(P.ws + (off)))
#define GIN(i) ((const float*)(const GAS float*)P.in[i])
#define GOUT ((float*)(GAS float*)P.out)

__device__ __forceinline__ void transpose_item(const float* W, int ldw, int col0, int k0, bf16_t* dst_row0, int ldd, LAS float* scr, int lane) {
#pragma unroll 8
  for (int i = 0; i < 32; ++i) { const int kk = 2 * i + (lane >> 5); scr[kk * 33 + (lane & 31)] = W[(size_t)(k0 + kk) * ldw + col0 + (lane & 31)]; }
  asm volatile("s_waitcnt lgkmcnt(0)" ::: "memory");
  const int c = lane & 7;
#pragma unroll
  for (int j = 0; j < 4; ++j) { const int n = (lane >> 3) + 8 * j; const LAS float* s = scr + (8 * c) * 33 + n;
    u32x4 o; o.x = pk2(s[0 * 33], s[1 * 33]); o.y = pk2(s[2 * 33], s[3 * 33]); o.z = pk2(s[4 * 33], s[5 * 33]); o.w = pk2(s[6 * 33], s[7 * 33]);
    *(u32x4*)(dst_row0 + (size_t)n * ldd + k0 + 8 * c) = o; }
  asm volatile("s_waitcnt lgkmcnt(0)" ::: "memory");
}
__device__ __forceinline__ void transpose_mat_item(const float* W, int ldw, int col0, int K, int ncols, bf16_t* dst, int ldd, int gu, int it, LAS float* scr, int lane) {
  const int nblk = ncols / 32, kb = it / nblk, nb = it % nblk, n0 = 32 * nb;
  const int drow = gu ? (256 * (n0 >> 7) + (n0 & 127) + (gu == 2 ? 128 : 0)) : n0;
  transpose_item(W, ldw, col0 + n0, 64 * kb, dst + (size_t)drow * ldd, ldd, scr, lane);
}
__device__ __forceinline__ void convert_experts(const Params& P, int layer, bf16_t* wgu, bf16_t* wd, const Ctx& C, LAS float* scr) {
  for (int it = C.gw; it < NEXP * 768; it += C.ngw) {
    const int e = it / 768, r = it % 768;
    const size_t eoff = ((size_t)layer * NEXP + e) * (size_t)D * DEXP;
    if (r < 256) transpose_mat_item(GIN(I_EWG) + eoff, DEXP, 0, D, DEXP, wgu + (size_t)e * 1024 * D, D, 1, r, scr, C.lane);
    else if (r < 512) transpose_mat_item(GIN(I_EWU) + eoff, DEXP, 0, D, DEXP, wgu + (size_t)e * 1024 * D, D, 2, r - 256, scr, C.lane);
    else transpose_mat_item(GIN(I_EWD) + eoff, D, 0, DEXP, D, wd + (size_t)e * D * DEXP, DEXP, 0, r - 512, scr, C.lane);
  }
}

__device__ __forceinline__ void row_load(const float* row, int lane, f32x4 (&v)[4]) {
#pragma unroll
  for (int j = 0; j < 4; ++j) v[j] = *(const f32x4*)(row + 4 * lane + 256 * j);
}
__device__ __forceinline__ void row_store(float* row, int lane, const f32x4 (&v)[4]) {
#pragma unroll
  for (int j = 0; j < 4; ++j) *(f32x4*)(row + 4 * lane + 256 * j) = v[j];
}
__device__ __forceinline__ void row_store_bf16(bf16_t* row, int lane, const f32x4 (&v)[4]) {
#pragma unroll
  for (int j = 0; j < 4; ++j) { u32x2 w; w.x = pk2(v[j][0], v[j][1]); w.y = pk2(v[j][2], v[j][3]); *(u32x2*)(row + 4 * lane + 256 * j) = w; }
}
__device__ __forceinline__ void row_layernorm(f32x4 (&v)[4], const float* g, const float* b, int lane) {
  float s = 0.f;
#pragma unroll
  for (int j = 0; j < 4; ++j) s += (v[j][0] + v[j][1]) + (v[j][2] + v[j][3]);
  const float mean = wave_sum(s) * (1.f / D); float s2 = 0.f;
#pragma unroll
  for (int j = 0; j < 4; ++j) { v[j] = v[j] - mean; s2 += (v[j][0] * v[j][0] + v[j][1] * v[j][1]) + (v[j][2] * v[j][2] + v[j][3] * v[j][3]); }
  const float rstd = rsqrtf(wave_sum(s2) * (1.f / D) + LN_EPS);
#pragma unroll
  for (int j = 0; j < 4; ++j) { const f32x4 gg = *(const f32x4*)(g + 4 * lane + 256 * j), bb = *(const f32x4*)(b + 4 * lane + 256 * j); v[j] = v[j] * rstd * gg + bb; }
}
__device__ __forceinline__ void row_modulate(const f32x4 (&h)[4], const float* shift, const float* scale, int lane, f32x4 (&u)[4]) {
#pragma unroll
  for (int j = 0; j < 4; ++j) { const f32x4 sh = *(const f32x4*)(shift + 4 * lane + 256 * j), sc = *(const f32x4*)(scale + 4 * lane + 256 * j); u[j] = h[j] * (sc + 1.f) + sh; }
}
__device__ __forceinline__ void row_dot32(const f32x4 (&u)[4], const LAS float* Wt, int lane, float* out32) {
  float myv = 0.f;
#pragma unroll 4
  for (int c = 0; c < 32; ++c) {
    float s = 0.f;
#pragma unroll
    for (int j = 0; j < 4; ++j) { const f32x4 w = *(const LAS f32x4*)(Wt + c * 1024 + 4 * lane + 256 * j); s += (u[j][0] * w[0] + u[j][1] * w[1]) + (u[j][2] * w[2] + u[j][3] * w[3]); }
    s = wave_sum(s);
    if (lane == c) myv = s;
  }
  if (lane < 32) out32[lane] = myv;
}
__device__ __forceinline__ void stage_cols32(const float* W, int ldw, int col0, LAS float* Wt, int tid) {
  for (int i = tid; i < 1024 * 32; i += NT) { const int k = i >> 5, c = i & 31; Wt[c * 1024 + k] = W[(size_t)k * ldw + col0 + c]; }
}
__device__ __forceinline__ const float* lat_or_ctx(const float* lat, const float* ctxp, int r) {
  const int b = r / TB, pos = r % TB;
  return pos < CTXL ? ctxp + ((size_t)b * CTXL + pos) * D : lat + ((size_t)b * SEQ + (pos - CTXL)) * D;
}
__device__ __forceinline__ float* lat_or_ctx_w(float* lat, float* ctxp, int r) {
  const int b = r / TB, pos = r % TB;
  return pos < CTXL ? ctxp + ((size_t)b * CTXL + pos) * D : lat + ((size_t)b * SEQ + (pos - CTXL)) * D;
}
__device__ __forceinline__ int row_b5(int r) { const int b = r / TB, pos = r % TB; return pos < CTXL ? 4 : b; }

__device__ __forceinline__ void phase0(const Params& P, const Ctx& C) {
  LAS float* sv = (LAS float*)C.lds;
  LAS float* part = (LAS float*)(C.lds + 20480);
  LAS float* scr = (LAS float*)(C.lds + 32768) + C.wave * (64 * 33);
  if (C.bid == 0) { int* ctl = WS(OFF_CTL, int); for (int i = C.tid; i < 1024; i += NT) ctl[i] = 0; }
  for (int i = C.tid; i < 5 * 1024; i += NT) { const float x = i < 4096 ? GIN(I_C)[i] : GIN(I_CCTX)[i - 4096]; sv[i] = siluf_(x); }
  __syncthreads();
  float* MOD = WS(OFF_MOD, float);
  for (int task = C.bid; task < 2 * 96; task += C.nblk) {
    const int l = task / 96, n0 = (task % 96) * 64;
    const float* W = GIN(I_ADAW) + (size_t)l * D * 6144 + n0 + C.lane;
    float acc[5] = {0.f, 0.f, 0.f, 0.f, 0.f};
    const int kbeg = C.wave * 128;
#pragma unroll 8
    for (int k = kbeg; k < kbeg + 128; ++k) { const float w = W[(size_t)k * 6144];
#pragma unroll
      for (int r = 0; r < 5; ++r) acc[r] += sv[r * 1024 + k] * w; }
#pragma unroll
    for (int r = 0; r < 5; ++r) part[(C.wave * 5 + r) * 64 + C.lane] = acc[r];
    __syncthreads();
    if (C.tid < 320) { const int r = C.tid / 64, c = C.tid % 64; float s = GIN(I_ADAB)[l * 6144 + n0 + c];
#pragma unroll
      for (int w = 0; w < 8; ++w) s += part[(w * 5 + r) * 64 + c];
      MOD[((size_t)l * 5 + r) * 6144 + n0 + c] = s; }
    __syncthreads();
  }
  if (C.bid == C.nblk - 1) { float* LB = WS(OFF_LB1, float); for (int i = C.tid; i < 1024; i += NT) { const float a = GIN(I_HLB)[i], b = GIN(I_HLB)[1024 + i]; LB[i] = 1.f / (1.f + __expf(a - b)); } }
  constexpr int N_AB = 16 * 144, N_OUT = 32 * 32, N_G1 = 16 * 32;
  constexpr int TOT = N_AB + 2 * N_OUT + 2 * N_G1;
  for (int it = C.gw; it < TOT; it += C.ngw) {
    int r = it;
    if (r < N_AB) { transpose_mat_item(GIN(I_ABW), AB_IN, 0, D, Z0W, WS(OFF_WAB, bf16_t), D, 0, r, scr, C.lane); continue; } r -= N_AB;
    if (r < N_OUT) { transpose_mat_item(GIN(I_OUTW), D, 0, 2048, D, WS(OFF_WOUT0, bf16_t), 2048, 0, r, scr, C.lane); continue; } r -= N_OUT;
    if (r < N_OUT) { transpose_mat_item(GIN(I_OUTW) + (size_t)2048 * D, D, 0, 2048, D, WS(OFF_WOUT1, bf16_t), 2048, 0, r, scr, C.lane); continue; } r -= N_OUT;
    if (r < N_G1) { transpose_mat_item(GIN(I_CDW), CD_IN, 3072, D, 1024, WS(OFF_WG1, bf16_t), D, 0, r, scr, C.lane); continue; } r -= N_G1;
    transpose_mat_item(GIN(I_CDW), CD_IN, 8224, D, 1024, WS(OFF_WG1, bf16_t) + (size_t)1024 * D, D, 0, r, scr, C.lane);
  }
  convert_experts(P, 0, WS(OFF_WE0, bf16_t), WS(OFF_WE0 + 64 * MiB, bf16_t), C, scr);
}

__device__ __forceinline__ void phase_u0(const Params& P, const Ctx& C) {
  LAS float* Wt = (LAS float*)C.lds;
  stage_cols32(GIN(I_ABW), AB_IN, 4608, Wt, C.tid);
  __syncthreads();
  const float* MOD = WS(OFF_MOD, float); bf16_t* U = WS(OFF_U0, bf16_t); float* DT = WS(OFF_DT, float);
  for (int r = C.gw; r < R; r += C.ngw) {
    f32x4 h[4], u[4]; row_load(lat_or_ctx(GIN(I_X), GIN(I_CTX), r), C.lane, h);
    const float* m = MOD + (size_t)row_b5(r) * 6144;
    row_modulate(h, m, m + D, C.lane, u);
    row_store_bf16(U + (size_t)r * D, C.lane, u);
    row_dot32(u, Wt, C.lane, DT + (size_t)r * 32);
  }
}

__device__ __forceinline__ void phase_inproj(const Params& P, const Ctx& C, const bf16_t* U, const bf16_t* W, bf16_t* Z, int zw) {
  pg8::Gemm g{U, W, D, D}; pg8::GridOrder S; S.init(R / 256, zw / 256, C.nblk, C.bid, 0);
  pg8::EpiBf16 E{Z, zw};
  pg8::gemm_phase(C.lds, g, S, E);
}

__device__ __forceinline__ void conv_task(bf16_t* Z, int zw, int row0, int L, int col, const float* cw, int cwld, int cch, const float* cb, int mode, float qscale, int lane) {
  float w[4][2];
#pragma unroll
  for (int j = 0; j < 4; ++j) { w[j][0] = cw[j * cwld + cch + 2 * lane]; w[j][1] = cw[j * cwld + cch + 2 * lane + 1]; }
  const float b0 = cb ? cb[cch + 2 * lane] : 0.f, b1 = cb ? cb[cch + 2 * lane + 1] : 0.f;
  unsigned* base = (unsigned*)(Z + (size_t)row0 * zw + col) + lane;
  const size_t rs = (size_t)zw / 2;
  float pm2[2] = {0.f, 0.f}, pm1[2] = {0.f, 0.f};
  for (int t0 = 0; t0 < L; t0 += 16) {
    unsigned v[17];
#pragma unroll
    for (int i = 0; i < 16; ++i) v[i] = base[(size_t)(t0 + i) * rs];
    v[16] = (t0 + 16 < L) ? base[(size_t)(t0 + 16) * rs] : 0u;
    unsigned o[16];
#pragma unroll
    for (int i = 0; i < 16; ++i) {
      const float x0 = bflo(v[i]), x1 = bfhi(v[i]), n0 = bflo(v[i + 1]), n1 = bfhi(v[i + 1]);
      float y0 = w[0][0] * pm2[0] + w[1][0] * pm1[0] + w[2][0] * x0 + w[3][0] * n0 + b0;
      float y1 = w[0][1] * pm2[1] + w[1][1] * pm1[1] + w[2][1] * x1 + w[3][1] * n1 + b1;
      pm2[0] = pm1[0]; pm2[1] = pm1[1]; pm1[0] = x0; pm1[1] = x1;
      if (mode >= 1) { y0 = siluf_(y0); y1 = siluf_(y1); }
      if (mode == 2) { const float ss = wave_sum(y0 * y0 + y1 * y1); const float sc = rsqrtf(ss + RMS_EPS) * qscale; y0 *= sc; y1 *= sc; }
      o[i] = pk2(y0, y1);
    }
#pragma unroll
    for (int i = 0; i < 16; ++i) base[(size_t)(t0 + i) * rs] = o[i];
  }
}
__device__ __forceinline__ void seg_rows(int seg, int& row0, int& L) {
  const int b = seg / 129, s = seg % 129;
  if (s == 0) { row0 = b * TB; L = CTXL; } else { row0 = b * TB + CTXL + (s - 1) * 64; L = 64; }
}
__device__ __forceinline__ void phase_feat0(const Params& P, const Ctx& C) {
  bf16_t* Z = WS(OFF_Z0, bf16_t);
  for (int task = C.gw; task < NB * 129 * 20; task += C.ngw) {
    const int seg = task / 20, cg = task % 20; int row0, L; seg_rows(seg, row0, L);
    if (cg < 8) conv_task(Z, Z0W, row0, L, Z0_RGX + cg * 128, GIN(I_RGCW), 1024, cg * 128, GIN(I_RGCB), 0, 1.f, C.lane);
    else conv_task(Z, Z0W, row0, L, Z0_XBC + (cg - 8) * 128, GIN(I_SCW), 1536, (cg - 8) * 128, GIN(I_SCB), 1, 1.f, C.lane);
  }
}
__device__ __forceinline__ void phase_feat1(const Params& P, const Ctx& C) {
  bf16_t* Z = WS(OFF_Z1, bf16_t);
  for (int task = C.gw; task < NB * 129 * 24; task += C.ngw) {
    const int seg = task / 24, cg = task % 24; int row0, L; seg_rows(seg, row0, L);
    if (cg < 16) conv_task(Z, Z1W, row0, L, cg * 128, GIN(I_GCW), 3072, cg * 128, nullptr, 2, cg < 8 ? 0.08838834764831845f : 1.f, C.lane);
    else conv_task(Z, Z1W, row0, L, cg * 128, GIN(I_GCW), 3072, cg * 128, nullptr, 1, 1.f, C.lane);
  }
}

__device__ __forceinline__ int seq_pos(int dir, int j) { return dir == 0 ? j : (j < CTXL ? CTXL - 1 - j : TB - 1 - (j - CTXL)); }
__device__ __forceinline__ int seq_chunk(int dir, int j) { return dir == 0 ? j : (j < 4 ? 3 - j : 135 - j); }

__device__ __forceinline__ void rg_task(const Params& P, const Ctx& C, int task) {
  const int b = task >> 6, h = (task >> 3) & 7, q = task & 7;
  LAS float* Wl = (LAS float*)C.lds;
  LAS float* xc = Wl + 2 * 2 * 128 * 16;
  LAS float* SA = xc + 64 * 129;
  LAS float* SU = SA + 16 * 64;
  const bf16_t* Z = WS(OFF_Z0, bf16_t); bf16_t* MIX = WS(OFF_MIX0, bf16_t);
  __syncthreads();
  for (int i = C.tid; i < 2 * 2 * 128 * 16; i += NT) { const int j = i & 15, ii = (i >> 4) & 127, gate = (i >> 11) & 1, d = i >> 12;
    const float* W = (gate ? GIN(I_RGXW) : GIN(I_RGAW)) + ((size_t)(d * 8 + h) * 128 + ii) * 128 + q * 16 + j; Wl[i] = *W; }
  const int j = C.tid & 15, tg = C.tid >> 4;
  const int ch = h * 128 + q * 16 + j;
  const int sch = C.wave * 2;
  for (int d = 0; d < 2; ++d) {
    const float ba = GIN(I_RGAB)[d * 1024 + ch], bx = GIN(I_RGXB)[d * 1024 + ch], spl = softplusf_(-GIN(I_RGLAM)[d * 1024 + ch]);
    float hin0 = 0.f, hin1 = 0.f;
    for (int cs = 0; cs < 132; ++cs) {
      const int chunk = seq_chunk(d, cs), row0 = b * TB + chunk * 64;
      __syncthreads();
      { const int t = C.tid >> 3, sg = C.tid & 7; const u32x4* src = (const u32x4*)(Z + (size_t)(row0 + t) * Z0W + Z0_RGX + h * 128 + sg * 16);
        const u32x4 a = src[0], bb = src[1]; LAS float* dst = xc + t * 129 + sg * 16;
        dst[0] = bflo(a.x); dst[1] = bfhi(a.x); dst[2] = bflo(a.y); dst[3] = bfhi(a.y); dst[4] = bflo(a.z); dst[5] = bfhi(a.z); dst[6] = bflo(a.w); dst[7] = bfhi(a.w);
        dst[8] = bflo(bb.x); dst[9] = bfhi(bb.x); dst[10] = bflo(bb.y); dst[11] = bfhi(bb.y); dst[12] = bflo(bb.z); dst[13] = bfhi(bb.z); dst[14] = bflo(bb.w); dst[15] = bfhi(bb.w); }
      __syncthreads();
      { const LAS float* Wa = Wl + (d * 2 + 0) * 2048 + j; const LAS float* Wx = Wl + (d * 2 + 1) * 2048 + j;
        const LAS float* x0 = xc + (2 * tg) * 129; const LAS float* x1 = x0 + 129;
        float aa0 = 0.f, aa1 = 0.f, ax0 = 0.f, ax1 = 0.f;
#pragma unroll 8
        for (int i = 0; i < 128; ++i) { const float wa = Wa[i * 16], wx = Wx[i * 16], v0 = x0[i], v1 = x1[i]; aa0 += v0 * wa; aa1 += v1 * wa; ax0 += v0 * wx; ax1 += v1 * wx; }
#pragma unroll
        for (int tt = 0; tt < 2; ++tt) { const int t = 2 * tg + tt; const float pa = tt ? aa1 : aa0, px = tt ? ax1 : ax0;
          const float r = sigmoidf_(pa + ba), ig = sigmoidf_(px + bx); const float la = -8.f * r * spl; const float xv = xc[t * 129 + q * 16 + j];
          SA[j * 64 + t] = __expf(la); SU[j * 64 + t] = sqrtf(-expm1f(2.f * la)) * (ig * xv); } }
      __syncthreads();
#pragma unroll
      for (int cc = 0; cc < 2; ++cc) {
        const int lc = sch + cc; const int t = d == 0 ? C.lane : 63 - C.lane;
        float A = SA[lc * 64 + t], Bv = SU[lc * 64 + t];
#pragma unroll
        for (int off = 1; off < 64; off <<= 1) { const float Ap = __shfl_up(A, off), Bp = __shfl_up(Bv, off); if (C.lane >= off) { Bv = A * Bp + Bv; A = A * Ap; } }
        const float hin = cc ? hin1 : hin0; const float hv = Bv + A * hin;
        const float hlast = __shfl(hv, 63); if (cc) hin1 = hlast; else hin0 = hlast;
        const int gch = h * 128 + q * 16 + lc; bf16_t* o = MIX + (size_t)(row0 + t) * MIXW + gch;
        if (d == 0) *o = (bf16_t)f2bf(hv);
        else { const float hf = bf2f(*o); const float gy = bf2f(Z[(size_t)(row0 + t) * Z0W + Z0_RGY + gch]); *o = (bf16_t)f2bf((hf + hv) * geluf_(gy)); }
      }
    }
    __threadfence_block();
  }
}
__device__ __forceinline__ void ssd_task(const Params& P, const Ctx& C, int task) {
  const int b = task >> 9, hd = (task >> 5) & 15, ps = task & 31, g = hd >> 3;
  const int c = C.lane >> 5, ng = C.lane & 31;
  const bf16_t* Z = WS(OFF_Z0, bf16_t); bf16_t* MIX = WS(OFF_MIX0, bf16_t); const float* DT = WS(OFF_DT, float);
  const int colx = Z0_XBC + hd * 64 + 2 * ps + c, colB = Z0_B + g * 128 + 4 * ng, colC = Z0_C + g * 128 + 4 * ng, outc = 1024 + hd * 64 + 2 * ps + c;
  for (int d = 0; d < 2; ++d) {
    const float Aneg = -__expf(GIN(I_SALOG)[d * 16 + hd]), dtb = GIN(I_SDTB)[d * 16 + hd];
    float S0 = 0.f, S1 = 0.f, S2 = 0.f, S3 = 0.f;
    for (int j0 = 0; j0 < TB; j0 += 8) {
      u32x2 Bv[8], Cv[8]; unsigned short xv[8], yp[8]; float dtr[8];
#pragma unroll
      for (int u = 0; u < 8; ++u) { const size_t row = (size_t)b * TB + seq_pos(d, j0 + u);
        Bv[u] = *(const u32x2*)(Z + row * Z0W + colB); Cv[u] = *(const u32x2*)(Z + row * Z0W + colC); xv[u] = Z[row * Z0W + colx]; dtr[u] = DT[row * 32 + d * 16 + hd];
        yp[u] = d ? MIX[row * MIXW + outc] : (unsigned short)0; }
#pragma unroll
      for (int u = 0; u < 8; ++u) { const size_t row = (size_t)b * TB + seq_pos(d, j0 + u);
        const float dt = softplusf_(dtr[u] + dtb), a = __expf(Aneg * dt), xdt = bf2f(xv[u]) * dt;
        S0 = a * S0 + bflo(Bv[u].x) * xdt; S1 = a * S1 + bfhi(Bv[u].x) * xdt; S2 = a * S2 + bflo(Bv[u].y) * xdt; S3 = a * S3 + bfhi(Bv[u].y) * xdt;
        float y = (bflo(Cv[u].x) * S0 + bfhi(Cv[u].x) * S1) + (bflo(Cv[u].y) * S2 + bfhi(Cv[u].y) * S3);
        y = half_sum32(y);
        if (ng == 0) MIX[row * MIXW + outc] = (bf16_t)f2bf(y + bf2f(yp[u])); }
    }
    __threadfence_block();
  }
}
__device__ __forceinline__ void phase_chain0(const Params& P, const Ctx& C) {
  for (int task = C.bid; task < 256; task += C.nblk) rg_task(P, C, task);
  for (int task = C.gw; task < NB * 16 * 32; task += C.ngw) ssd_task(P, C, task);
}
__device__ __forceinline__ void phase_ssdfin(const Params& P, const Ctx& C) {
  const bf16_t* Z = WS(OFF_Z0, bf16_t); bf16_t* MIX = WS(OFF_MIX0, bf16_t);
  for (int r = C.gw; r < R; r += C.ngw) {
    f32x4 y[4];
#pragma unroll
    for (int j = 0; j < 4; ++j) { const int e = 4 * C.lane + 256 * j; const float dsk = GIN(I_SD)[e >> 6];
      const u32x2 ys = *(const u32x2*)(MIX + (size_t)r * MIXW + 1024 + e), xs = *(const u32x2*)(Z + (size_t)r * Z0W + Z0_XBC + e), zz = *(const u32x2*)(Z + (size_t)r * Z0W + Z0_SSDZ + e);
      y[j][0] = (bflo(ys.x) + dsk * bflo(xs.x)) * siluf_(bflo(zz.x)); y[j][1] = (bfhi(ys.x) + dsk * bfhi(xs.x)) * siluf_(bfhi(zz.x));
      y[j][2] = (bflo(ys.y) + dsk * bflo(xs.y)) * siluf_(bflo(zz.y)); y[j][3] = (bfhi(ys.y) + dsk * bfhi(xs.y)) * siluf_(bfhi(zz.y)); }
    float s0 = 0.f, s1 = 0.f;
#pragma unroll
    for (int i = 0; i < 4; ++i) { s0 += y[0][i] * y[0][i] + y[1][i] * y[1][i]; s1 += y[2][i] * y[2][i] + y[3][i] * y[3][i]; }
    const float r0 = rsqrtf(wave_sum(s0) * (1.f / 512.f) + RMS_EPS), r1 = rsqrtf(wave_sum(s1) * (1.f / 512.f) + RMS_EPS);
#pragma unroll
    for (int j = 0; j < 4; ++j) { const int e = 4 * C.lane + 256 * j; const f32x4 gn = *(const f32x4*)(GIN(I_SNG) + e); const float rr = j < 2 ? r0 : r1;
      u32x2 w; w.x = pk2(y[j][0] * rr * gn[0], y[j][1] * rr * gn[1]); w.y = pk2(y[j][2] * rr * gn[2], y[j][3] * rr * gn[3]);
      *(u32x2*)(MIX + (size_t)r * MIXW + 1024 + e) = w; }
  }
}

__device__ __forceinline__ void phase_outproj(const Params& P, const Ctx& C, int layer) {
  const float* MOD = WS(OFF_MOD, float) + (size_t)layer * 5 * 6144;
  pg8::Gemm g{layer ? WS(OFF_MIX1, bf16_t) : WS(OFF_MIX0, bf16_t), layer ? WS(OFF_WOUT1, bf16_t) : WS(OFF_WOUT0, bf16_t), MIXW, MIXW};
  pg8::GridOrder S; if (layer) S.init(128, 4, C.nblk, C.bid, 1); else S.init(132, 4, C.nblk, C.bid, 0);
  pg8::EpiResid E{layer ? GOUT : GIN(I_X), layer ? WS(OFF_HCTX, float) : GIN(I_CTX), GOUT, WS(OFF_TCTX, float), MOD + 2 * D};
  pg8::gemm_phase(C.lds, g, S, E);
}

__device__ __forceinline__ void phase_lnmix(const Params& P, const Ctx& C, int layer) {
  LAS float* Wt = (LAS float*)C.lds;
  { const float* gw = GIN(I_RGW) + (size_t)layer * D * 4; const float* ew = GIN(I_REW) + (size_t)layer * D * 32;
    for (int i = C.tid; i < 1024 * 4; i += NT) { const int k = i >> 2, c = i & 3; Wt[c * 1024 + k] = gw[i]; }
    for (int i = C.tid; i < 1024 * 32; i += NT) { const int k = i >> 5, c = i & 31; Wt[(4 + c) * 1024 + k] = ew[i]; } }
  __syncthreads();
  const float* MOD = WS(OFF_MOD, float) + (size_t)layer * 5 * 6144;
  const float* lng = GIN(I_LNMG) + layer * D; const float* lnb = GIN(I_LNMB) + layer * D;
  const float* rgb = GIN(I_RGB) + layer * 4; const float* reb = GIN(I_REB) + layer * 32;
  bf16_t* V = layer ? WS(OFF_V1, bf16_t) : WS(OFF_U0, bf16_t);
  int* cnt = WS(OFF_CTL, int) + layer * 32; int* route = WS(OFF_ROUTE, int);
  for (int r = C.gw; r < R; r += C.ngw) {
    const int pos = r % TB; if (layer && pos < CTXL) continue;
    float* trow = lat_or_ctx_w(GOUT, WS(OFF_TCTX, float), r);
    float* hrow = lat_or_ctx_w(GOUT, WS(OFF_HCTX, float), r);
    f32x4 h[4], v[4]; row_load(trow, C.lane, h);
    row_layernorm(h, lng, lnb, C.lane);
    row_store(hrow, C.lane, h);
    const float* m = MOD + (size_t)row_b5(r) * 6144;
    row_modulate(h, m + 3 * D, m + 4 * D, C.lane, v);
    row_store_bf16(V + (size_t)r * D, C.lane, v);
    float myv = 0.f;
#pragma unroll 4
    for (int c = 0; c < 36; ++c) { float s = 0.f;
#pragma unroll
      for (int j = 0; j < 4; ++j) { const f32x4 w = *(const LAS f32x4*)(Wt + c * 1024 + 4 * C.lane + 256 * j); s += (v[j][0] * w[0] + v[j][1] * w[1]) + (v[j][2] * w[2] + v[j][3] * w[3]); }
      s = wave_sum(s); if (C.lane == c) myv = s; }
    float lg[4]; int gsel = 0; float gmax;
#pragma unroll
    for (int i = 0; i < 4; ++i) lg[i] = __shfl(myv, i) + rgb[i];
    gmax = lg[0];
#pragma unroll
    for (int i = 1; i < 4; ++i) if (lg[i] > gmax) { gmax = lg[i]; gsel = i; }
    float gden = 0.f;
#pragma unroll
    for (int i = 0; i < 4; ++i) gden += __expf(lg[i] - gmax);
    const float ptg = 1.f / gden;
    float le[8];
#pragma unroll
    for (int i = 0; i < 8; ++i) le[i] = __shfl(myv, 4 + gsel * 8 + i) + reb[gsel * 8 + i];
    int e1 = 0; float m1 = le[0];
#pragma unroll
    for (int i = 1; i < 8; ++i) if (le[i] > m1) { m1 = le[i]; e1 = i; }
    int e2 = -1; float m2 = -3.0e38f;
#pragma unroll
    for (int i = 0; i < 8; ++i) if (i != e1 && le[i] > m2) { m2 = le[i]; e2 = i; }
    const float q2 = __expf(m2 - m1); const float w1 = ptg / (1.f + q2), w2 = ptg * q2 / (1.f + q2);
    if (C.lane == 0) {
      const int E1 = gsel * 8 + e1, E2 = gsel * 8 + e2;
      const int p1 = atomicAdd(cnt + E1, 1), p2 = atomicAdd(cnt + E2, 1);
      int* rr = route + (size_t)r * 8; rr[0] = E1; rr[1] = E2; ((float*)rr)[2] = w1; ((float*)rr)[3] = w2; rr[4] = p1; rr[5] = p2;
    }
  }
}

__device__ __forceinline__ void phase_dispatch(const Params& P, const Ctx& C, int layer) {
  LAS int* base = (LAS int*)C.lds;
  int* ctl = WS(OFF_CTL, int); const int* cnt = ctl + layer * 32;
  if (C.tid == 0) { int acc = 0; for (int e = 0; e < NEXP; ++e) { base[e] = acc; acc += (cnt[e] + 255) >> 8; } base[32] = acc; }
  __syncthreads();
  if (C.bid == 0) { if (C.tid == 0) ctl[64 + layer] = base[32];
    if (C.tid < NEXP) { for (int bk = base[C.tid]; bk < base[C.tid + 1]; ++bk) ctl[128 + layer * MAX_BLKS + bk] = C.tid; } }
  const bf16_t* V = layer ? WS(OFF_V1, bf16_t) : WS(OFF_U0, bf16_t);
  bf16_t* AM = layer ? WS(OFF_AM1, bf16_t) : WS(OFF_AM0, bf16_t);
  float* slotw = WS(OFF_SLOTW, float); int* route = WS(OFF_ROUTE, int);
  for (int r = C.gw; r < R; r += C.ngw) {
    const int pos = r % TB; if (layer && pos < CTXL) continue;
    int* rr = route + (size_t)r * 8;
    const int E1 = rr[0], E2 = rr[1]; const int s1 = base[E1] * 256 + rr[4], s2 = base[E2] * 256 + rr[5];
    const u32x4* src = (const u32x4*)(V + (size_t)r * D);
    const u32x4 a = src[C.lane], b = src[64 + C.lane];
    u32x4* d1 = (u32x4*)(AM + (size_t)s1 * D); u32x4* d2 = (u32x4*)(AM + (size_t)s2 * D);
    d1[C.lane] = a; d1[64 + C.lane] = b; d2[C.lane] = a; d2[64 + C.lane] = b;
    if (C.lane == 0) { rr[6] = s1; rr[7] = s2; slotw[s1] = ((const float*)rr)[2]; slotw[s2] = ((const float*)rr)[3]; }
  }
}
__device__ __forceinline__ void phase_moe1(const Params& P, const Ctx& C, int layer) {
  const int* ctl = WS(OFF_CTL, int);
  pg8::Gemm g{layer ? WS(OFF_AM1, bf16_t) : WS(OFF_AM0, bf16_t), layer ? WS(OFF_WE1, bf16_t) : WS(OFF_WE0, bf16_t), D, D};
  pg8::MoeOrder S{ctl + 128 + layer * MAX_BLKS, ctl[64 + layer] * 4, C.nblk, C.bid};
  pg8::EpiSwiGLU E{layer ? WS(OFF_HM1, bf16_t) : WS(OFF_HM0, bf16_t)};
  pg8::gemm_phase(C.lds, g, S, E);
}
__device__ __forceinline__ void phase_moe2(const Params& P, const Ctx& C, int layer) {
  const int* ctl = WS(OFF_CTL, int);
  pg8::Gemm g{layer ? WS(OFF_HM1, bf16_t) : WS(OFF_HM0, bf16_t), layer ? WS(OFF_WE1 + 64 * MiB, bf16_t) : WS(OFF_WE0 + 64 * MiB, bf16_t), DEXP, DEXP};
  pg8::MoeOrder S{ctl + 128 + layer * MAX_BLKS, ctl[64 + layer] * 4, C.nblk, C.bid};
  pg8::EpiMoeDown E{layer ? WS(OFF_YM1, bf16_t) : WS(OFF_YM0, bf16_t), WS(OFF_SLOTW, float)};
  pg8::gemm_phase(C.lds, g, S, E);
}

__device__ __forceinline__ void phase_lnffn(const Params& P, const Ctx& C, int layer) {
  LAS float* Wt = (LAS float*)C.lds;
  if (layer == 0) { stage_cols32(GIN(I_CDW), CD_IN, 4096, Wt, C.tid); __syncthreads(); }
  const float* MOD = WS(OFF_MOD, float) + (size_t)layer * 5 * 6144;
  const float* lng = GIN(I_LNFG) + layer * D; const float* lnb = GIN(I_LNFB) + layer * D;
  const bf16_t* YM = layer ? WS(OFF_YM1, bf16_t) : WS(OFF_YM0, bf16_t); const int* route = WS(OFF_ROUTE, int);
  for (int r = C.gw; r < R; r += C.ngw) {
    const int pos = r % TB; if (layer && pos < CTXL) continue;
    float* hrow = lat_or_ctx_w(GOUT, WS(OFF_HCTX, float), r);
    const float* m = MOD + (size_t)row_b5(r) * 6144;
    const int* rr = route + (size_t)r * 8; const int s1 = rr[6], s2 = rr[7];
    f32x4 h[4]; row_load(hrow, C.lane, h);
#pragma unroll
    for (int j = 0; j < 4; ++j) { const u32x2 a = *(const u32x2*)(YM + (size_t)s1 * D + 4 * C.lane + 256 * j), b = *(const u32x2*)(YM + (size_t)s2 * D + 4 * C.lane + 256 * j);
      const f32x4 g5 = *(const f32x4*)(m + 5 * D + 4 * C.lane + 256 * j);
      f32x4 f; f[0] = bflo(a.x) + bflo(b.x); f[1] = bfhi(a.x) + bfhi(b.x); f[2] = bflo(a.y) + bflo(b.y); f[3] = bfhi(a.y) + bfhi(b.y);
      h[j] = h[j] * ALPHA + g5 * f; }
    row_layernorm(h, lng, lnb, C.lane);
    row_store(hrow, C.lane, h);
    if (layer == 0) {
      const float* m1 = WS(OFF_MOD, float) + (size_t)(5 + row_b5(r)) * 6144;
      f32x4 u[4]; row_modulate(h, m1, m1 + D, C.lane, u);
      row_store_bf16(WS(OFF_U1, bf16_t) + (size_t)r * D, C.lane, u);
      row_dot32(u, Wt, C.lane, WS(OFF_DT, float) + (size_t)r * 32);
    }
  }
  if (layer == 0) {
    __syncthreads();
    LAS float* scr = (LAS float*)C.lds + C.wave * (64 * 33);
    constexpr int N_A = 16 * 96, N_B = 16 * 128;
    for (int it = C.gw; it < N_A + N_B; it += C.ngw) {
      if (it < N_A) transpose_mat_item(GIN(I_CDW), CD_IN, 0, D, 3072, WS(OFF_WCD, bf16_t), D, 0, it, scr, C.lane);
      else transpose_mat_item(GIN(I_CDW), CD_IN, 4128, D, 4096, WS(OFF_WCD, bf16_t) + (size_t)3072 * D, D, 0, it - N_A, scr, C.lane);
    }
  }
}

__device__ __forceinline__ void gdn_task(const Params& P, const Ctx& C, int task) {
  const int b = task >> 9, h = (task >> 6) & 7, vs = task & 63; const int c = C.lane >> 5, kg = C.lane & 31;
  const bf16_t* Z = WS(OFF_Z1, bf16_t); bf16_t* MIX = WS(OFF_MIX1, bf16_t); const float* DT = WS(OFF_DT, float);
  const int colq = Z1_Q + h * 128 + 4 * kg, colk = Z1_K + h * 128 + 4 * kg, colv = Z1_V + h * 128 + 2 * vs + c, outc = h * 128 + 2 * vs + c;
  for (int d = 0; d < 2; ++d) {
    const float Aneg = -__expf(GIN(I_GALOG)[d * 8 + h]), dtb = GIN(I_GDTB)[d * 8 + h];
    float S0 = 0.f, S1 = 0.f, S2 = 0.f, S3 = 0.f;
    for (int j0 = 0; j0 < TB; j0 += 8) {
      u32x2 qv[8], kv[8]; unsigned short vv[8], yp[8]; float br[8], ar[8];
#pragma unroll
      for (int u = 0; u < 8; ++u) { const size_t row = (size_t)b * TB + seq_pos(d, j0 + u);
        qv[u] = *(const u32x2*)(Z + row * Z1W + colq); kv[u] = *(const u32x2*)(Z + row * Z1W + colk); vv[u] = Z[row * Z1W + colv];
        br[u] = DT[row * 32 + d * 8 + h]; ar[u] = DT[row * 32 + 16 + d * 8 + h]; yp[u] = d ? MIX[row * MIXW + outc] : (unsigned short)0; }
#pragma unroll
      for (int u = 0; u < 8; ++u) { const size_t row = (size_t)b * TB + seq_pos(d, j0 + u);
        const float al = __expf(Aneg * softplusf_(ar[u] + dtb)), be = sigmoidf_(br[u]);
        const float k0 = bflo(kv[u].x), k1 = bfhi(kv[u].x), k2 = bflo(kv[u].y), k3 = bfhi(kv[u].y);
        S0 *= al; S1 *= al; S2 *= al; S3 *= al;
        const float p = half_sum32((k0 * S0 + k1 * S1) + (k2 * S2 + k3 * S3));
        const float dl = be * (bf2f(vv[u]) - p);
        S0 += k0 * dl; S1 += k1 * dl; S2 += k2 * dl; S3 += k3 * dl;
        const float o = half_sum32((bflo(qv[u].x) * S0 + bfhi(qv[u].x) * S1) + (bflo(qv[u].y) * S2 + bfhi(qv[u].y) * S3));
        if (kg == 0) MIX[row * MIXW + outc] = (bf16_t)f2bf(o + bf2f(yp[u])); }
    }
    __threadfence_block();
  }
}
__device__ __forceinline__ void hgrn_task(const Params& P, const Ctx& C, int task) {
  const int b = task >> 9, h = (task >> 6) & 7, vs = task & 63; const int c = C.lane >> 5, kg = C.lane & 31;
  const bf16_t* Z = WS(OFF_Z1, bf16_t); bf16_t* MIX = WS(OFF_MIX1, bf16_t);
  const f32x4 lb = *(const f32x4*)(WS(OFF_LB1, float) + h * 128 + 4 * kg);
  const int colq = Z1_HQ + h * 128 + 4 * kg, colv = Z1_HI + h * 128 + 2 * vs + c, outc = 1024 + h * 128 + 2 * vs + c;
  for (int d = 0; d < 2; ++d) {
    const int colf = Z1_HF + d * 1024 + h * 128 + 4 * kg;
    float S0 = 0.f, S1 = 0.f, S2 = 0.f, S3 = 0.f;
    for (int j0 = 0; j0 < TB; j0 += 8) {
      u32x2 qv[8], fv[8]; unsigned short vv[8], yp[8];
#pragma unroll
      for (int u = 0; u < 8; ++u) { const size_t row = (size_t)b * TB + seq_pos(d, j0 + u);
        qv[u] = *(const u32x2*)(Z + row * Z1W + colq); fv[u] = *(const u32x2*)(Z + row * Z1W + colf); vv[u] = Z[row * Z1W + colv];
        yp[u] = d ? MIX[row * MIXW + outc] : (unsigned short)0; }
#pragma unroll
      for (int u = 0; u < 8; ++u) { const size_t row = (size_t)b * TB + seq_pos(d, j0 + u);
        const float f0 = lb[0] + (1.f - lb[0]) * sigmoidf_(bflo(fv[u].x)), f1 = lb[1] + (1.f - lb[1]) * sigmoidf_(bfhi(fv[u].x));
        const float f2 = lb[2] + (1.f - lb[2]) * sigmoidf_(bflo(fv[u].y)), f3 = lb[3] + (1.f - lb[3]) * sigmoidf_(bfhi(fv[u].y));
        const float v = bf2f(vv[u]);
        S0 = f0 * S0 + (1.f - f0) * v; S1 = f1 * S1 + (1.f - f1) * v; S2 = f2 * S2 + (1.f - f2) * v; S3 = f3 * S3 + (1.f - f3) * v;
        const float o = half_sum32((bflo(qv[u].x) * S0 + bfhi(qv[u].x) * S1) + (bflo(qv[u].y) * S2 + bfhi(qv[u].y) * S3));
        if (kg == 0) MIX[row * MIXW + outc] = (bf16_t)f2bf(o + bf2f(yp[u])); }
    }
    __threadfence_block();
  }
}
__device__ __forceinline__ void phase_chain1(const Params& P, const Ctx& C) {
  for (int task = C.gw; task < NB * 8 * 64; task += C.ngw) gdn_task(P, C, task);
  for (int task = C.gw; task < NB * 8 * 64; task += C.ngw) hgrn_task(P, C, task);
}
__device__ __forceinline__ void phase_onorm(const Params& P, const Ctx& C) {
  bf16_t* MIX = WS(OFF_MIX1, bf16_t); bf16_t* U = WS(OFF_U1B, bf16_t);
  const float* m1 = WS(OFF_MOD, float) + (size_t)5 * 6144;
  for (int r = C.gw; r < R; r += C.ngw) {
    const int b = r / TB, pos = r % TB; if (pos < CTXL) continue;
#pragma unroll
    for (int half = 0; half < 2; ++half) {
      const float* gn = half ? GIN(I_HNG) : GIN(I_GNG);
#pragma unroll
      for (int j = 0; j < 4; ++j) { const int e = 4 * C.lane + 256 * j; bf16_t* p = MIX + (size_t)r * MIXW + half * 1024 + e;
        const u32x2 a = *(const u32x2*)p; const float o0 = bflo(a.x), o1 = bfhi(a.x), o2 = bflo(a.y), o3 = bfhi(a.y);
        const float ss = half_sum32((o0 * o0 + o1 * o1) + (o2 * o2 + o3 * o3)); const float rs = rsqrtf(ss * (1.f / 128.f) + RMS_EPS);
        const f32x4 g = *(const f32x4*)(gn + (e & 127));
        u32x2 w; w.x = pk2(o0 * rs * g[0], o1 * rs * g[1]); w.y = pk2(o2 * rs * g[2], o3 * rs * g[3]); *(u32x2*)p = w; }
    }
    f32x4 h[4], u[4]; row_load(GOUT + ((size_t)b * SEQ + (pos - CTXL)) * D, C.lane, h);
    row_modulate(h, m1 + (size_t)b * 6144, m1 + (size_t)b * 6144 + D, C.lane, u);
    row_store_bf16(U + (size_t)r * D, C.lane, u);
  }
  LAS float* scr = (LAS float*)C.lds + C.wave * (64 * 33);
  convert_experts(P, 1, WS(OFF_WE1, bf16_t), WS(OFF_WE1 + 64 * MiB, bf16_t), C, scr);
}
__device__ __forceinline__ void phase_gates(const Params& P, const Ctx& C) {
  pg8::Gemm g{WS(OFF_U1B, bf16_t), WS(OFF_WG1, bf16_t), D, D}; pg8::GridOrder S; S.init(128, 8, C.nblk, C.bid, 1);
  pg8::EpiGateMul E{WS(OFF_MIX1, bf16_t), MIXW};
  pg8::gemm_phase(C.lds, g, S, E);
}

__global__ void __launch_bounds__(NT, 2) fwd_megakernel(Params Pk) {
  extern __shared__ __attribute__((aligned(16))) unsigned char lds_raw[];
  cg::grid_group grid = cg::this_grid();
#ifndef PHASE_MASK
#define PHASE_MASK 0xFFFFFFFFu
#endif
#define SYNC() do { __syncthreads(); grid.sync(); } while (0)
#define LAUNDER() const Params* pp; { unsigned long long a_ = (unsigned long long)__builtin_amdgcn_kernarg_segment_ptr(); asm volatile("" : "+s"(a_)); \
    const unsigned lo_ = __builtin_amdgcn_readfirstlane((unsigned)a_), hi_ = __builtin_amdgcn_readfirstlane((unsigned)(a_ >> 32)); \
    pp = (const Params*)(const __attribute__((address_space(4))) Params*)(((unsigned long long)hi_ << 32) | lo_); } \
  Ctx C; { int t_ = threadIdx.x; asm volatile("" : "+v"(t_)); t_ &= 511; int b_ = blockIdx.x; asm volatile("" : "+s"(b_)); b_ = __builtin_amdgcn_readfirstlane(b_); int g_ = gridDim.x; asm volatile("" : "+s"(g_)); g_ = __builtin_amdgcn_readfirstlane(g_); \
    C.lds = (LAS unsigned char*)lds_raw; C.tid = t_; C.lane = t_ & 63; C.wave = __builtin_amdgcn_readfirstlane(t_ >> 6); \
    C.bid = b_; C.nblk = g_; C.gw = b_ * NWAVES + C.wave; C.ngw = g_ * NWAVES; }
#define WSP(off, T) ((T*)(GAS T*)(pp->ws + (off)))
  if (PHASE_MASK & (1u << 0)) { LAUNDER(); phase0(*pp, C); } SYNC();
  if (PHASE_MASK & (1u << 1)) { LAUNDER(); phase_u0(*pp, C); } SYNC();
  if (PHASE_MASK & (1u << 2)) { LAUNDER(); phase_inproj(*pp, C, WSP(OFF_U0, bf16_t), WSP(OFF_WAB, bf16_t), WSP(OFF_Z0, bf16_t), Z0W); } SYNC();
  if (PHASE_MASK & (1u << 3)) { LAUNDER(); phase_feat0(*pp, C); } SYNC();
  if (PHASE_MASK & (1u << 4)) { LAUNDER(); phase_chain0(*pp, C); } SYNC();
  if (PHASE_MASK & (1u << 5)) { LAUNDER(); phase_ssdfin(*pp, C); } SYNC();
  if (PHASE_MASK & (1u << 6)) { LAUNDER(); phase_outproj(*pp, C, 0); } SYNC();
  if (PHASE_MASK & (1u << 7)) { LAUNDER(); phase_lnmix(*pp, C, 0); } SYNC();
  if (PHASE_MASK & (1u << 8)) { LAUNDER(); phase_dispatch(*pp, C, 0); } SYNC();
  if (PHASE_MASK & (1u << 9)) { LAUNDER(); phase_moe1(*pp, C, 0); } SYNC();
  if (PHASE_MASK & (1u << 10)) { LAUNDER(); phase_moe2(*pp, C, 0); } SYNC();
  if (PHASE_MASK & (1u << 11)) { LAUNDER(); phase_lnffn(*pp, C, 0); } SYNC();
  if (PHASE_MASK & (1u << 12)) { LAUNDER(); phase_inproj(*pp, C, WSP(OFF_U1, bf16_t), WSP(OFF_WCD, bf16_t), WSP(OFF_Z1, bf16_t), Z1W); } SYNC();
  if (PHASE_MASK & (1u << 13)) { LAUNDER(); phase_feat1(*pp, C); } SYNC();
  if (PHASE_MASK & (1u << 14)) { LAUNDER(); phase_chain1(*pp, C); } SYNC();
  if (PHASE_MASK & (1u << 15)) { LAUNDER(); phase_onorm(*pp, C); } SYNC();
  if (PHASE_MASK & (1u << 16)) { LAUNDER(); phase_gates(*pp, C); } SYNC();
  if (PHASE_MASK & (1u << 17)) { LAUNDER(); phase_outproj(*pp, C, 1); } SYNC();
  if (PHASE_MASK & (1u << 18)) { LAUNDER(); phase_lnmix(*pp, C, 1); } SYNC();
  if (PHASE_MASK & (1u << 19)) { LAUNDER(); phase_dispatch(*pp, C, 1); } SYNC();
  if (PHASE_MASK & (1u << 20)) { LAUNDER(); phase_moe1(*pp, C, 1); } SYNC();
  if (PHASE_MASK & (1u << 21)) { LAUNDER(); phase_moe2(*pp, C, 1); } SYNC();
  if (PHASE_MASK & (1u << 22)) { LAUNDER(); phase_lnffn(*pp, C, 1); }
}

extern "C" void kernel_launch(void* const* d_in, const int* in_sizes, int n_in, void* d_out, int out_size,
                              void* d_ws, size_t ws_size, hipStream_t stream) {
  static int grid_blocks = 0;
  if (!grid_blocks) {
    int dev = 0, cus = 0, per_cu = 0;
    (void)hipGetDevice(&dev);
    (void)hipDeviceGetAttribute(&cus, hipDeviceAttributeMultiprocessorCount, dev);
    (void)hipFuncSetAttribute((const void*)fwd_megakernel, hipFuncAttributeMaxDynamicSharedMemorySize, LDS_BYTES);
    (void)hipOccupancyMaxActiveBlocksPerMultiprocessor(&per_cu, (const void*)fwd_megakernel, NT, LDS_BYTES);
    if (per_cu < 1) per_cu = 1;
    grid_blocks = cus * 1;
    fprintf(stderr, "grid %d (cus %d per_cu %d) ws_size %zu need %zu n_in %d\n", grid_blocks, cus, per_cu, ws_size, (size_t)WS_NEED, n_in);
    if (ws_size < WS_NEED || n_in != 39) { fprintf(stderr, "kernel_launch: workspace too small or unexpected inputs\n"); grid_blocks = -1; }
  }
  if (grid_blocks < 0) return;
  Params p{};
  for (int i = 0; i < 39; ++i) p.in[i] = (const float*)d_in[i];
  p.out = (float*)d_out; p.ws = (unsigned char*)d_ws;
  void* args[] = {&p};
  hipError_t e = hipLaunchCooperativeKernel((const void*)fwd_megakernel, dim3(grid_blocks), dim3(NT), args, LDS_BYTES, stream);
  if (e != hipSuccess) fprintf(stderr, "cooperative launch failed: %s (grid %d)\n", hipGetErrorString(e), grid_blocks);
}
```

```cpp
#include <hip/hip_runtime.h>
#include <hip/hip_cooperative_groups.h>
#include <cstdio>
#include <cstdint>
namespace cg = cooperative_groups;

#define LAS __attribute__((address_space(3)))
typedef unsigned short bf16_t;
typedef short bf16x8 __attribute__((ext_vector_type(8)));
typedef float f32x4 __attribute__((ext_vector_type(4)));
typedef float f32x2 __attribute__((ext_vector_type(2)));
typedef unsigned u32x4 __attribute__((ext_vector_type(4)));
typedef unsigned u32x2 __attribute__((ext_vector_type(2)));

constexpr int D = 1024, NB = 4, SEQ = 8192, CTXL = 256, TB = SEQ + CTXL  , R = NB * TB  , RLAT = NB * SEQ;
constexpr int NT = 512, NWAVES = 8;
constexpr int LDS_BYTES = 163840;
constexpr int AB_IN = 4640, CD_IN = 9248;
constexpr int Z0W = 4608, Z1W = 7168, MIXW = 2048;
constexpr int NEXP = 32, DEXP = 512, MOE_BLK = 256, MAX_BLKS = 304, MAX_SLOTS = 296 * 256;
constexpr float ALPHA = 1.41421356237309515f;
constexpr float LN_EPS = 1e-5f, RMS_EPS = 1e-6f;
constexpr int Z0_RGX = 0, Z0_RGY = 1024, Z0_SSDZ = 2048, Z0_XBC = 3072, Z0_B = 4096, Z0_C = 4352;
constexpr int Z1_Q = 0, Z1_K = 1024, Z1_V = 2048, Z1_HQ = 3072, Z1_HF = 4096, Z1_HI = 6144;

constexpr size_t MiB = 1u << 20;
constexpr size_t OFF_CTL = 0;
constexpr size_t OFF_MOD = 64 * 1024;
constexpr size_t OFF_LB1 = 320 * 1024;
constexpr size_t OFF_ROUTE = 512 * 1024;
constexpr size_t OFF_SLOTW = 2 * MiB;
constexpr size_t OFF_DT = 3 * MiB;
constexpr size_t OFF_HCTX = 8 * MiB;
constexpr size_t OFF_TCTX = 12 * MiB;
constexpr size_t OFF_WOUT0 = 16 * MiB, OFF_WOUT1 = 20 * MiB, OFF_WG1 = 24 * MiB, OFF_WAB = 28 * MiB;
constexpr size_t OFF_A = 40 * MiB;
constexpr size_t OFF_Z0 = OFF_A, OFF_MIX0 = OFF_A + 297 * MiB, OFF_WE0 = OFF_A + 429 * MiB, OFF_U0 = OFF_A + 525 * MiB;
constexpr size_t OFF_AM0 = OFF_A, OFF_HM0 = OFF_A + 148 * MiB, OFF_YM0 = OFF_A + 222 * MiB;
constexpr size_t OFF_Z1 = OFF_A, OFF_U1 = OFF_A + 462 * MiB, OFF_WCD = OFF_A + 528 * MiB, OFF_MIX1 = OFF_A + 462 * MiB;
constexpr size_t OFF_WE1 = OFF_A, OFF_U1B = OFF_A + 96 * MiB, OFF_AM1 = OFF_A + 96 * MiB, OFF_HM1 = OFF_A + 244 * MiB, OFF_YM1 = OFF_A + 318 * MiB, OFF_V1 = OFF_A + 470 * MiB;
constexpr size_t WS_NEED = OFF_A + 594 * MiB;
static_assert((size_t)R * Z0W * 2 <= 297 * MiB && (size_t)R * MIXW * 2 <= 132 * MiB && (size_t)R * Z1W * 2 <= 462 * MiB && (size_t)R * D * 2 <= 66 * MiB, "ws map");
static_assert((size_t)MAX_SLOTS * D * 2 <= 148 * MiB && (size_t)MAX_SLOTS * DEXP * 2 <= 74 * MiB, "ws map moe");
static_assert(OFF_DT + (size_t)R * 32 * 4 <= OFF_HCTX && OFF_ROUTE + (size_t)R * 32 <= OFF_SLOTW && OFF_SLOTW + MAX_SLOTS * 4 <= OFF_DT, "ws map small");

struct Params { const float* in[39]; float* out; unsigned char* ws; };
enum { I_X = 0, I_C, I_CTX, I_CCTX, I_HLB, I_ADAW, I_ADAB, I_LNMG, I_LNMB, I_LNFG, I_LNFB, I_OUTW, I_RGW, I_RGB, I_REW, I_REB, I_EWG, I_EWU, I_EWD,
       I_ABW, I_RGCW, I_RGCB, I_RGAW, I_RGAB, I_RGXW, I_RGXB, I_RGLAM, I_SCW, I_SCB, I_SALOG, I_SDTB, I_SD, I_SNG, I_CDW, I_GCW, I_GALOG, I_GDTB, I_GNG, I_HNG };

__device__ __forceinline__ unsigned f2bf(float f) { unsigned u = __float_as_uint(f); return (u + 0x7fffu + ((u >> 16) & 1u)) >> 16; }
__device__ __forceinline__ float bf2f(unsigned b) { return __uint_as_float(b << 16); }
__device__ __forceinline__ unsigned pk2(float lo, float hi) { return f2bf(lo) | (f2bf(hi) << 16); }
__device__ __forceinline__ float bflo(unsigned w) { return __uint_as_float(w << 16); }
__device__ __forceinline__ float bfhi(unsigned w) { return __uint_as_float(w & 0xffff0000u); }
__device__ __forceinline__ float sigmoidf_(float x) { return 1.f / (1.f + __expf(-x)); }
__device__ __forceinline__ float siluf_(float x) { return x / (1.f + __expf(-x)); }
__device__ __forceinline__ float softplusf_(float x) { return x > 20.f ? x : log1pf(__expf(x)); }
__device__ __forceinline__ float geluf_(float x) { const float u = 0.7978845608028654f * (x + 0.044715f * x * x * x); return 0.5f * x * (1.f + tanhf(u)); }
__device__ __forceinline__ float wave_sum(float v) {
#pragma unroll
  for (int o = 1; o < 64; o <<= 1) v += __shfl_xor(v, o);
  return v;
}
__device__ __forceinline__ float half_sum32(float v) {
#pragma unroll
  for (int o = 1; o < 32; o <<= 1) v += __shfl_xor(v, o);
  return v;
}
__device__ __forceinline__ int row_batch(int r) { return r / TB; }

namespace pg8 {
constexpr int BM = 256, BK = 64, HALF = 128, HTB = HALF * BK * 2, STAGE_BYTES = 8 * HTB, NXCD = 8, WGM = 8;
__host__ __device__ __forceinline__ int lds_byte(int r, int c) { const int st = (r >> 4) * 2 + (c >> 5), rr = r & 15, cc = c & 31, ob = rr * 64 + cc * 2; return st * 1024 + (ob ^ (((ob >> 9) & 1) << 5)); }
__host__ __device__ __forceinline__ void stage_rc(int b, int& Rr, int& C) { const int st = b / 1024, sb = b % 1024, swz = sb ^ (((sb >> 9) & 1) << 5); Rr = (st >> 1) * 16 + swz / 64; C = (st & 1) * 32 + (swz % 64) / 2; }
__host__ __device__ __forceinline__ int perm32(int rho) { const int n = rho >> 4, i = rho & 15; return 8 * (i >> 2) + 4 * n + (i & 3); }
struct Unit { int pm, pn; };
struct Gemm { const bf16_t* A; const bf16_t* Bt; int lda, K; };

struct GridOrder {
  int nM, nN, nwg, G, c, skipctx;
  __device__ void init(int nM_, int nN_, int G_, int c_, int skipctx_) { nM = nM_; nN = nN_; nwg = nM * nN; G = G_; c = c_; skipctx = skipctx_; }
  __device__ bool next(int i, Unit& u) const {
    const long L = (long)i * G + c; if (L >= nwg) return false;
    int wgid = (int)L; { const int q = nwg / NXCD, r = nwg % NXCD, xcd = wgid % NXCD, off = wgid / NXCD; wgid = (xcd < r ? xcd * (q + 1) : r * (q + 1) + (xcd - r) * q) + off; }
    const int nig = WGM * nN, gid = wgid / nig, fm = gid * WGM, gsz = (nM - fm) < WGM ? (nM - fm) : WGM;
    int pm = fm + ((wgid % nig) % gsz); u.pn = (wgid % nig) / gsz;
    if (skipctx) pm = (pm >> 5) * 33 + 1 + (pm & 31);
    u.pm = pm; return true;
  }
};
struct MoeOrder {
  const int* blk_e; int nunits, G, c;
  __device__ bool next(int i, Unit& u) const {
    const long L = (long)i * G + c; if (L >= nunits) return false;
    const int blk = (int)(L >> 2), j = (int)(L & 3);
    u.pm = blk; u.pn = blk_e[blk] * 4 + j; return true;
  }
};

__device__ __forceinline__ unsigned cvt_pk_bf16(float lo, float hi) { unsigned r; asm volatile("v_cvt_pk_bf16_f32 %0, %1, %2" : "=v"(r) : "v"(lo), "v"(hi)); return r; }

template <class Epi, class Sched>
__device__ __forceinline__ void gemm_phase(LAS unsigned char* lds, const Gemm g, const Sched& S, const Epi& E) {
  int tid_ = threadIdx.x; asm volatile("" : "+v"(tid_)); tid_ &= 511; const int tid = tid_, wid = __builtin_amdgcn_readfirstlane(tid >> 6), lane = tid & 63, wr = wid >> 2, wc = wid & 3, fr = lane & 15, fq = lane >> 4;
  const int K = g.K, nt = K / BK, lda = g.lda;
  unsigned voffA[2], voffB[2];
#pragma unroll
  for (int i = 0; i < 2; ++i) { int Rr, C; stage_rc(tid * 16 + i * 8192, Rr, C); const int Rb = Epi::PERM ? ((Rr & ~31) + perm32(Rr & 31)) : Rr;
    voffA[i] = (unsigned)(Rr * lda + C) * 2u; voffB[i] = (unsigned)(Rb * K + C) * 2u; }
  const size_t kstep = (size_t)(BK * 2);
  const size_t hstepA = (size_t)HALF * lda * 2, hstepB = (size_t)HALF * K * 2;
  const size_t tstepA = 2 * hstepA, tstepB = 2 * hstepB;
  const unsigned ldsw = (unsigned)wid * 1024u;
  const int aoff = lds_byte(wr * 64 + fr, fq * 8), boff = lds_byte(wc * 32 + fr, fq * 8);
#define PG8_SA(b, h) (((b) * 2 + (h)) * HTB)
#define PG8_SB(b, h) ((4 + (b) * 2 + (h)) * HTB)
#define PG8_STAGE(bufoff, gbase, voff) do { _Pragma("unroll") for (int _i = 0; _i < 2; ++_i) \
    __builtin_amdgcn_global_load_lds((const unsigned*)((const char*)(gbase) + (voff)[_i]), (LAS unsigned*)(lds + (bufoff) + ldsw + _i * 8192), 16, 0, 0); } while (0)
#define PG8_LDA(dst, b, h) do { _Pragma("unroll") for (int m = 0; m < 4; ++m) _Pragma("unroll") for (int k = 0; k < 2; ++k) dst[m][k] = *(const LAS bf16x8*)(lds + PG8_SA(b, h) + aoff + m * 2048 + k * 1024); } while (0)
#define PG8_LDB(dst, b, h) do { _Pragma("unroll") for (int n = 0; n < 2; ++n) _Pragma("unroll") for (int k = 0; k < 2; ++k) dst[n][k] = *(const LAS bf16x8*)(lds + PG8_SB(b, h) + boff + n * 2048 + k * 1024); } while (0)
#define PG8_MMA(ai, bj, At, Bt) do { __builtin_amdgcn_s_setprio(1); _Pragma("unroll") for (int m = 0; m < 4; ++m) _Pragma("unroll") for (int n = 0; n < 2; ++n) _Pragma("unroll") for (int k = 0; k < 2; ++k) \
    acc[ai][bj][m][n] = __builtin_amdgcn_mfma_f32_16x16x32_bf16(Bt[n][k], At[m][k], acc[ai][bj][m][n], 0, 0, 0); __builtin_amdgcn_s_setprio(0); } while (0)
#define PG8_WAIT_V(n) asm volatile("s_waitcnt vmcnt(" #n ")" ::: "memory")
#define PG8_WAIT_L(n) asm volatile("s_waitcnt lgkmcnt(" #n ")" ::: "memory")
#define PG8_BAR __builtin_amdgcn_s_barrier()
#define PG8_SCHED __builtin_amdgcn_sched_barrier(0)
  Unit cur, nxt; int ui = 0;
  if (!S.next(0, cur)) return;
  f32x4 acc[2][2][4][2];
#pragma unroll
  for (int a = 0; a < 2; ++a)
#pragma unroll
    for (int b = 0; b < 2; ++b)
#pragma unroll
      for (int m = 0; m < 4; ++m)
#pragma unroll
        for (int n = 0; n < 2; ++n) acc[a][b][m][n] = (f32x4){0.f, 0.f, 0.f, 0.f};
  bf16x8 At[4][2], B0[2][2], B1[2][2];
  const char* cA = (const char*)g.A + (size_t)cur.pm * tstepA; const char* cB = (const char*)g.Bt + (size_t)cur.pn * tstepB;
  PG8_STAGE(PG8_SB(0, 0), cB, voffB); PG8_STAGE(PG8_SA(0, 0), cA, voffA); PG8_STAGE(PG8_SB(0, 1), cB + hstepB, voffB); PG8_STAGE(PG8_SA(0, 1), cA + hstepA, voffA);
  if (wr == 1) PG8_BAR;
  PG8_WAIT_V(4); PG8_BAR;
  PG8_STAGE(PG8_SB(1, 0), cB + kstep, voffB); PG8_STAGE(PG8_SA(1, 0), cA + kstep, voffA); PG8_STAGE(PG8_SB(1, 1), cB + hstepB + kstep, voffB);
  PG8_WAIT_V(6); PG8_BAR;
  for (;;) {
    const bool has_next = S.next(ui + 1, nxt);
    const char* nA = has_next ? (const char*)g.A + (size_t)nxt.pm * tstepA : cA; const char* nB = has_next ? (const char*)g.Bt + (size_t)nxt.pn * tstepB : cB;
    for (int t = 0; t < nt; t += 2) {
      const bool last = (t == nt - 2);
      const char* a1 = cA + (size_t)(t + 1) * kstep;
      const char* a2 = last ? nA : cA + (size_t)(t + 2) * kstep; const char* b2 = last ? nB : cB + (size_t)(t + 2) * kstep;
      const char* a3 = a2 + kstep; const char* b3 = b2 + kstep;
      PG8_LDB(B0, 0, 0); PG8_SCHED; PG8_LDA(At, 0, 0); PG8_STAGE(PG8_SA(1, 1), a1 + hstepA, voffA);
      PG8_WAIT_L(8); PG8_BAR; PG8_WAIT_L(0); PG8_MMA(0, 0, At, B0); PG8_BAR; PG8_SCHED;
      PG8_LDB(B1, 0, 1); PG8_STAGE(PG8_SB(0, 0), b2, voffB);
      PG8_BAR; PG8_WAIT_L(0); PG8_MMA(0, 1, At, B1); PG8_BAR;
      PG8_LDA(At, 0, 1); PG8_STAGE(PG8_SA(0, 0), a2, voffA);
      PG8_BAR; PG8_WAIT_L(0); PG8_MMA(1, 0, At, B0); PG8_BAR; PG8_SCHED;
      PG8_STAGE(PG8_SB(0, 1), b2 + hstepB, voffB);
      PG8_WAIT_V(6); PG8_BAR; PG8_MMA(1, 1, At, B1); PG8_BAR;
      PG8_LDB(B0, 1, 0); PG8_SCHED; PG8_LDA(At, 1, 0); PG8_STAGE(PG8_SA(0, 1), a2 + hstepA, voffA);
      PG8_WAIT_L(8); PG8_BAR; PG8_WAIT_L(0); PG8_MMA(0, 0, At, B0); PG8_BAR; PG8_SCHED;
      PG8_LDB(B1, 1, 1); PG8_STAGE(PG8_SB(1, 0), b3, voffB);
      PG8_BAR; PG8_WAIT_L(0); PG8_MMA(0, 1, At, B1); PG8_BAR;
      PG8_LDA(At, 1, 1); PG8_STAGE(PG8_SA(1, 0), a3, voffA);
      PG8_BAR; PG8_WAIT_L(0); PG8_MMA(1, 0, At, B0); PG8_BAR; PG8_SCHED;
      PG8_STAGE(PG8_SB(1, 1), b3 + hstepB, voffB);
      PG8_WAIT_V(6); PG8_BAR; PG8_MMA(1, 1, At, B1); PG8_BAR;
    }
    E(acc, cur, wr, wc, fr, fq);
    if (!has_next) break;
#pragma unroll
    for (int a = 0; a < 2; ++a)
#pragma unroll
      for (int b = 0; b < 2; ++b)
#pragma unroll
        for (int m = 0; m < 4; ++m)
#pragma unroll
          for (int n = 0; n < 2; ++n) acc[a][b][m][n] = (f32x4){0.f, 0.f, 0.f, 0.f};
    cur = nxt; cA = nA; cB = nB; ++ui;
  }
  PG8_WAIT_V(0);
  if (wr == 0) PG8_BAR;
  PG8_BAR;
#undef PG8_SA
#undef PG8_SB
#undef PG8_STAGE
#undef PG8_LDA
#undef PG8_LDB
#undef PG8_MMA
#undef PG8_WAIT_V
#undef PG8_WAIT_L
#undef PG8_BAR
#undef PG8_SCHED
}

struct EpiBf16 {
  static constexpr bool PERM = true;
  bf16_t* O; int ldc;
  __device__ __forceinline__ void operator()(const f32x4 (&acc)[2][2][4][2], const Unit& u, int wr, int wc, int fr, int fq) const {
    const int row0 = u.pm * BM + wr * 64 + fr, col0 = u.pn * BM + wc * 32 + 8 * fq;
#pragma unroll
    for (int ai = 0; ai < 2; ++ai)
#pragma unroll
      for (int m = 0; m < 4; ++m) { bf16_t* rowp = O + (size_t)(row0 + ai * HALF + m * 16) * ldc + col0;
#pragma unroll
        for (int bj = 0; bj < 2; ++bj) { const f32x4 v0 = acc[ai][bj][m][0], v1 = acc[ai][bj][m][1];
          u32x4 w; w.x = cvt_pk_bf16(v0[0], v0[1]); w.y = cvt_pk_bf16(v0[2], v0[3]); w.z = cvt_pk_bf16(v1[0], v1[1]); w.w = cvt_pk_bf16(v1[2], v1[3]);
          *(u32x4*)(rowp + bj * HALF) = w; } }
  }
};
struct EpiResid {
  static constexpr bool PERM = false;
  const float* hlat; const float* hctx; float* tlat; float* tctx; const float* gate;
  __device__ __forceinline__ void operator()(const f32x4 (&acc)[2][2][4][2], const Unit& u, int wr, int wc, int fr, int fq) const {
    const int b = u.pm / 33, tt = u.pm % 33; const bool isctx = (tt == 0);
    const float* hs = isctx ? hctx + (size_t)b * CTXL * D : hlat + ((size_t)b * SEQ + (size_t)(tt - 1) * 256) * D;
    float* td = isctx ? tctx + (size_t)b * CTXL * D : tlat + ((size_t)b * SEQ + (size_t)(tt - 1) * 256) * D;
    const float* gt = gate + (size_t)(isctx ? 4 : b) * 6144;
    const int lrow0 = wr * 64 + fr, col0 = u.pn * BM + wc * 32 + 4 * fq;
#pragma unroll
    for (int bj = 0; bj < 2; ++bj)
#pragma unroll
      for (int n = 0; n < 2; ++n) { const f32x4 gvv = *(const f32x4*)(gt + col0 + bj * HALF + n * 16);
#pragma unroll
        for (int ai = 0; ai < 2; ++ai) {
#pragma unroll
          for (int m = 0; m < 4; ++m) { const size_t off = (size_t)(lrow0 + ai * HALF + m * 16) * D + col0 + bj * HALF + n * 16;
            const f32x4 hv = *(const f32x4*)(hs + off);
            *(f32x4*)(td + off) = hv * ALPHA + gvv * acc[ai][bj][m][n]; }
          asm volatile("" ::: "memory"); } }
  }
};
struct EpiGateMul {
  static constexpr bool PERM = true;
  bf16_t* O; int ldc;
  __device__ __forceinline__ void operator()(const f32x4 (&acc)[2][2][4][2], const Unit& u, int wr, int wc, int fr, int fq) const {
    const int row0 = u.pm * BM + wr * 64 + fr, col0 = u.pn * BM + wc * 32 + 8 * fq;
#pragma unroll
    for (int ai = 0; ai < 2; ++ai)
#pragma unroll
      for (int m = 0; m < 4; ++m) { bf16_t* rowp = O + (size_t)(row0 + ai * HALF + m * 16) * ldc + col0;
#pragma unroll
        for (int bj = 0; bj < 2; ++bj) { const f32x4 v0 = acc[ai][bj][m][0], v1 = acc[ai][bj][m][1];
          const u32x4 o = *(const u32x4*)(rowp + bj * HALF);
          u32x4 w;
          w.x = cvt_pk_bf16(bflo(o.x) * siluf_(v0[0]), bfhi(o.x) * siluf_(v0[1])); w.y = cvt_pk_bf16(bflo(o.y) * siluf_(v0[2]), bfhi(o.y) * siluf_(v0[3]));
          w.z = cvt_pk_bf16(bflo(o.z) * siluf_(v1[0]), bfhi(o.z) * siluf_(v1[1])); w.w = cvt_pk_bf16(bflo(o.w) * siluf_(v1[2]), bfhi(o.w) * siluf_(v1[3]));
          *(u32x4*)(rowp + bj * HALF) = w; } }
  }
};
struct EpiSwiGLU {
  static constexpr bool PERM = true;
  bf16_t* H;
  __device__ __forceinline__ void operator()(const f32x4 (&acc)[2][2][4][2], const Unit& u, int wr, int wc, int fr, int fq) const {
    const int row0 = u.pm * BM + wr * 64 + fr, col0 = (u.pn & 3) * 128 + wc * 32 + 8 * fq;
#pragma unroll
    for (int ai = 0; ai < 2; ++ai)
#pragma unroll
      for (int m = 0; m < 4; ++m) { bf16_t* rowp = H + (size_t)(row0 + ai * HALF + m * 16) * DEXP + col0;
        const f32x4 g0 = acc[ai][0][m][0], g1 = acc[ai][0][m][1], u0 = acc[ai][1][m][0], u1 = acc[ai][1][m][1];
        u32x4 w; w.x = cvt_pk_bf16(siluf_(g0[0]) * u0[0], siluf_(g0[1]) * u0[1]); w.y = cvt_pk_bf16(siluf_(g0[2]) * u0[2], siluf_(g0[3]) * u0[3]);
        w.z = cvt_pk_bf16(siluf_(g1[0]) * u1[0], siluf_(g1[1]) * u1[1]); w.w = cvt_pk_bf16(siluf_(g1[2]) * u1[2], siluf_(g1[3]) * u1[3]);
        *(u32x4*)rowp = w; }
  }
};
struct EpiMoeDown {
  static constexpr bool PERM = true;
  bf16_t* Y; const float* slotw;
  __device__ __forceinline__ void operator()(const f32x4 (&acc)[2][2][4][2], const Unit& u, int wr, int wc, int fr, int fq) const {
    const int row0 = u.pm * BM + wr * 64 + fr, col0 = (u.pn & 3) * BM + wc * 32 + 8 * fq;
#pragma unroll
    for (int ai = 0; ai < 2; ++ai)
#pragma unroll
      for (int m = 0; m < 4; ++m) { const int row = row0 + ai * HALF + m * 16; const float sw = slotw[row]; bf16_t* rowp = Y + (size_t)row * D + col0;
#pragma unroll
        for (int bj = 0; bj < 2; ++bj) { const f32x4 v0 = acc[ai][bj][m][0] * sw, v1 = acc[ai][bj][m][1] * sw;
          u32x4 w; w.x = cvt_pk_bf16(v0[0], v0[1]); w.y = cvt_pk_bf16(v0[2], v0[3]); w.z = cvt_pk_bf16(v1[0], v1[1]); w.w = cvt_pk_bf16(v1[2], v1[3]);
          *(u32x4*)(rowp + bj * HALF) = w; } }
  }
};
}

struct Ctx {
  LAS unsigned char* lds; int tid, lane, wave, gw, ngw, bid, nblk;
};
#define GAS __attribute__((address_space(1)))
#define WS(off, T) ((T*)(GAS T*)(P.ws + (off)))
#define GIN(i) ((const float*)(const GAS float*)P.in[i])
#define GOUT ((float*)(GAS float*)P.out)

__device__ __forceinline__ void transpose_item(const float* W, int ldw, int col0, int k0, bf16_t* dst_row0, int ldd, LAS float* scr, int lane) {
#pragma unroll 8
  for (int i = 0; i < 32; ++i) { const int kk = 2 * i + (lane >> 5); scr[kk * 33 + (lane & 31)] = W[(size_t)(k0 + kk) * ldw + col0 + (lane & 31)]; }
  asm volatile("s_waitcnt lgkmcnt(0)" ::: "memory");
  const int c = lane & 7;
#pragma unroll
  for (int j = 0; j < 4; ++j) { const int n = (lane >> 3) + 8 * j; const LAS float* s = scr + (8 * c) * 33 + n;
    u32x4 o; o.x = pk2(s[0 * 33], s[1 * 33]); o.y = pk2(s[2 * 33], s[3 * 33]); o.z = pk2(s[4 * 33], s[5 * 33]); o.w = pk2(s[6 * 33], s[7 * 33]);
    *(u32x4*)(dst_row0 + (size_t)n * ldd + k0 + 8 * c) = o; }
  asm volatile("s_waitcnt lgkmcnt(0)" ::: "memory");
}
__device__ __forceinline__ void transpose_mat_item(const float* W, int ldw, int col0, int K, int ncols, bf16_t* dst, int ldd, int gu, int it, LAS float* scr, int lane) {
  const int nblk = ncols / 32, kb = it / nblk, nb = it % nblk, n0 = 32 * nb;
  const int drow = gu ? (256 * (n0 >> 7) + (n0 & 127) + (gu == 2 ? 128 : 0)) : n0;
  transpose_item(W, ldw, col0 + n0, 64 * kb, dst + (size_t)drow * ldd, ldd, scr, lane);
}
__device__ __forceinline__ void convert_experts(const Params& P, int layer, bf16_t* wgu, bf16_t* wd, const Ctx& C, LAS float* scr) {
  for (int it = C.gw; it < NEXP * 768; it += C.ngw) {
    const int e = it / 768, r = it % 768;
    const size_t eoff = ((size_t)layer * NEXP + e) * (size_t)D * DEXP;
    if (r < 256) transpose_mat_item(GIN(I_EWG) + eoff, DEXP, 0, D, DEXP, wgu + (size_t)e * 1024 * D, D, 1, r, scr, C.lane);
    else if (r < 512) transpose_mat_item(GIN(I_EWU) + eoff, DEXP, 0, D, DEXP, wgu + (size_t)e * 1024 * D, D, 2, r - 256, scr, C.lane);
    else transpose_mat_item(GIN(I_EWD) + eoff, D, 0, DEXP, D, wd + (size_t)e * D * DEXP, DEXP, 0, r - 512, scr, C.lane);
  }
}

__device__ __forceinline__ void row_load(const float* row, int lane, f32x4 (&v)[4]) {
#pragma unroll
  for (int j = 0; j < 4; ++j) v[j] = *(const f32x4*)(row + 4 * lane + 256 * j);
}
__device__ __forceinline__ void row_store(float* row, int lane, const f32x4 (&v)[4]) {
#pragma unroll
  for (int j = 0; j < 4; ++j) *(f32x4*)(row + 4 * lane + 256 * j) = v[j];
}
__device__ __forceinline__ void row_store_bf16(bf16_t* row, int lane, const f32x4 (&v)[4]) {
#pragma unroll
  for (int j = 0; j < 4; ++j) { u32x2 w; w.x = pk2(v[j][0], v[j][1]); w.y = pk2(v[j][2], v[j][3]); *(u32x2*)(row + 4 * lane + 256 * j) = w; }
}
__device__ __forceinline__ void row_layernorm(f32x4 (&v)[4], const float* g, const float* b, int lane) {
  float s = 0.f;
#pragma unroll
  for (int j = 0; j < 4; ++j) s += (v[j][0] + v[j][1]) + (v[j][2] + v[j][3]);
  const float mean = wave_sum(s) * (1.f / D); float s2 = 0.f;
#pragma unroll
  for (int j = 0; j < 4; ++j) { v[j] = v[j] - mean; s2 += (v[j][0] * v[j][0] + v[j][1] * v[j][1]) + (v[j][2] * v[j][2] + v[j][3] * v[j][3]); }
  const float rstd = rsqrtf(wave_sum(s2) * (1.f / D) + LN_EPS);
#pragma unroll
  for (int j = 0; j < 4; ++j) { const f32x4 gg = *(const f32x4*)(g + 4 * lane + 256 * j), bb = *(const f32x4*)(b + 4 * lane + 256 * j); v[j] = v[j] * rstd * gg + bb; }
}
__device__ __forceinline__ void row_modulate(const f32x4 (&h)[4], const float* shift, const float* scale, int lane, f32x4 (&u)[4]) {
#pragma unroll
  for (int j = 0; j < 4; ++j) { const f32x4 sh = *(const f32x4*)(shift + 4 * lane + 256 * j), sc = *(const f32x4*)(scale + 4 * lane + 256 * j); u[j] = h[j] * (sc + 1.f) + sh; }
}
__device__ __forceinline__ void row_dot32(const f32x4 (&u)[4], const LAS float* Wt, int lane, float* out32) {
  float myv = 0.f;
#pragma unroll 4
  for (int c = 0; c < 32; ++c) {
    float s = 0.f;
#pragma unroll
    for (int j = 0; j < 4; ++j) { const f32x4 w = *(const LAS f32x4*)(Wt + c * 1024 + 4 * lane + 256 * j); s += (u[j][0] * w[0] + u[j][1] * w[1]) + (u[j][2] * w[2] + u[j][3] * w[3]); }
    s = wave_sum(s);
    if (lane == c) myv = s;
  }
  if (lane < 32) out32[lane] = myv;
}
__device__ __forceinline__ void stage_cols32(const float* W, int ldw, int col0, LAS float* Wt, int tid) {
  for (int i = tid; i < 1024 * 32; i += NT) { const int k = i >> 5, c = i & 31; Wt[c * 1024 + k] = W[(size_t)k * ldw + col0 + c]; }
}
__device__ __forceinline__ const float* lat_or_ctx(const float* lat, const float* ctxp, int r) {
  const int b = r / TB, pos = r % TB;
  return pos < CTXL ? ctxp + ((size_t)b * CTXL + pos) * D : lat + ((size_t)b * SEQ + (pos - CTXL)) * D;
}
__device__ __forceinline__ float* lat_or_ctx_w(float* lat, float* ctxp, int r) {
  const int b = r / TB, pos = r % TB;
  return pos < CTXL ? ctxp + ((size_t)b * CTXL + pos) * D : lat + ((size_t)b * SEQ + (pos - CTXL)) * D;
}
__device__ __forceinline__ int row_b5(int r) { const int b = r / TB, pos = r % TB; return pos < CTXL ? 4 : b; }

__device__ __forceinline__ void phase0(const Params& P, const Ctx& C) {
  LAS float* sv = (LAS float*)C.lds;
  LAS float* part = (LAS float*)(C.lds + 20480);
  LAS float* scr = (LAS float*)(C.lds + 32768) + C.wave * (64 * 33);
  if (C.bid == 0) { int* ctl = WS(OFF_CTL, int); for (int i = C.tid; i < 1024; i += NT) ctl[i] = 0; }
  for (int i = C.tid; i < 5 * 1024; i += NT) { const float x = i < 4096 ? GIN(I_C)[i] : GIN(I_CCTX)[i - 4096]; sv[i] = siluf_(x); }
  __syncthreads();
  float* MOD = WS(OFF_MOD, float);
  for (int task = C.bid; task < 2 * 96; task += C.nblk) {
    const int l = task / 96, n0 = (task % 96) * 64;
    const float* W = GIN(I_ADAW) + (size_t)l * D * 6144 + n0 + C.lane;
    float acc[5] = {0.f, 0.f, 0.f, 0.f, 0.f};
    const int kbeg = C.wave * 128;
#pragma unroll 8
    for (int k = kbeg; k < kbeg + 128; ++k) { const float w = W[(size_t)k * 6144];
#pragma unroll
      for (int r = 0; r < 5; ++r) acc[r] += sv[r * 1024 + k] * w; }
#pragma unroll
    for (int r = 0; r < 5; ++r) part[(C.wave * 5 + r) * 64 + C.lane] = acc[r];
    __syncthreads();
    if (C.tid < 320) { const int r = C.tid / 64, c = C.tid % 64; float s = GIN(I_ADAB)[l * 6144 + n0 + c];
#pragma unroll
      for (int w = 0; w < 8; ++w) s += part[(w * 5 + r) * 64 + c];
      MOD[((size_t)l * 5 + r) * 6144 + n0 + c] = s; }
    __syncthreads();
  }
  if (C.bid == C.nblk - 1) { float* LB = WS(OFF_LB1, float); for (int i = C.tid; i < 1024; i += NT) { const float a = GIN(I_HLB)[i], b = GIN(I_HLB)[1024 + i]; LB[i] = 1.f / (1.f + __expf(a - b)); } }
  constexpr int N_AB = 16 * 144, N_OUT = 32 * 32, N_G1 = 16 * 32;
  constexpr int TOT = N_AB + 2 * N_OUT + 2 * N_G1;
  for (int it = C.gw; it < TOT; it += C.ngw) {
    int r = it;
    if (r < N_AB) { transpose_mat_item(GIN(I_ABW), AB_IN, 0, D, Z0W, WS(OFF_WAB, bf16_t), D, 0, r, scr, C.lane); continue; } r -= N_AB;
    if (r < N_OUT) { transpose_mat_item(GIN(I_OUTW), D, 0, 2048, D, WS(OFF_WOUT0, bf16_t), 2048, 0, r, scr, C.lane); continue; } r -= N_OUT;
    if (r < N_OUT) { transpose_mat_item(GIN(I_OUTW) + (size_t)2048 * D, D, 0, 2048, D, WS(OFF_WOUT1, bf16_t), 2048, 0, r, scr, C.lane); continue; } r -= N_OUT;
    if (r < N_G1) { transpose_mat_item(GIN(I_CDW), CD_IN, 3072, D, 1024, WS(OFF_WG1, bf16_t), D, 0, r, scr, C.lane); continue; } r -= N_G1;
    transpose_mat_item(GIN(I_CDW), CD_IN, 8224, D, 1024, WS(OFF_WG1, bf16_t) + (size_t)1024 * D, D, 0, r, scr, C.lane);
  }
  convert_experts(P, 0, WS(OFF_WE0, bf16_t), WS(OFF_WE0 + 64 * MiB, bf16_t), C, scr);
}

__device__ __forceinline__ void phase_u0(const Params& P, const Ctx& C) {
  LAS float* Wt = (LAS float*)C.lds;
  stage_cols32(GIN(I_ABW), AB_IN, 4608, Wt, C.tid);
  __syncthreads();
  const float* MOD = WS(OFF_MOD, float); bf16_t* U = WS(OFF_U0, bf16_t); float* DT = WS(OFF_DT, float);
  for (int r = C.gw; r < R; r += C.ngw) {
    f32x4 h[4], u[4]; row_load(lat_or_ctx(GIN(I_X), GIN(I_CTX), r), C.lane, h);
    const float* m = MOD + (size_t)row_b5(r) * 6144;
    row_modulate(h, m, m + D, C.lane, u);
    row_store_bf16(U + (size_t)r * D, C.lane, u);
    row_dot32(u, Wt, C.lane, DT + (size_t)r * 32);
  }
}

__device__ __forceinline__ void phase_inproj(const Params& P, const Ctx& C, const bf16_t* U, const bf16_t* W, bf16_t* Z, int zw) {
  pg8::Gemm g{U, W, D, D}; pg8::GridOrder S; S.init(R / 256, zw / 256, C.nblk, C.bid, 0);
  pg8::EpiBf16 E{Z, zw};
  pg8::gemm_phase(C.lds, g, S, E);
}

__device__ __forceinline__ void conv_task(bf16_t* Z, int zw, int row0, int L, int col, const float* cw, int cwld, int cch, const float* cb, int mode, float qscale, int lane) {
  float w[4][2];
#pragma unroll
  for (int j = 0; j < 4; ++j) { w[j][0] = cw[j * cwld + cch + 2 * lane]; w[j][1] = cw[j * cwld + cch + 2 * lane + 1]; }
  const float b0 = cb ? cb[cch + 2 * lane] : 0.f, b1 = cb ? cb[cch + 2 * lane + 1] : 0.f;
  unsigned* base = (unsigned*)(Z + (size_t)row0 * zw + col) + lane;
  const size_t rs = (size_t)zw / 2;
  float pm2[2] = {0.f, 0.f}, pm1[2] = {0.f, 0.f};
  for (int t0 = 0; t0 < L; t0 += 16) {
    unsigned v[17];
#pragma unroll
    for (int i = 0; i < 16; ++i) v[i] = base[(size_t)(t0 + i) * rs];
    v[16] = (t0 + 16 < L) ? base[(size_t)(t0 + 16) * rs] : 0u;
    unsigned o[16];
#pragma unroll
    for (int i = 0; i < 16; ++i) {
      const float x0 = bflo(v[i]), x1 = bfhi(v[i]), n0 = bflo(v[i + 1]), n1 = bfhi(v[i + 1]);
      float y0 = w[0][0] * pm2[0] + w[1][0] * pm1[0] + w[2][0] * x0 + w[3][0] * n0 + b0;
      float y1 = w[0][1] * pm2[1] + w[1][1] * pm1[1] + w[2][1] * x1 + w[3][1] * n1 + b1;
      pm2[0] = pm1[0]; pm2[1] = pm1[1]; pm1[0] = x0; pm1[1] = x1;
      if (mode >= 1) { y0 = siluf_(y0); y1 = siluf_(y1); }
      if (mode == 2) { const float ss = wave_sum(y0 * y0 + y1 * y1); const float sc = rsqrtf(ss + RMS_EPS) * qscale; y0 *= sc; y1 *= sc; }
      o[i] = pk2(y0, y1);
    }
#pragma unroll
    for (int i = 0; i < 16; ++i) base[(size_t)(t0 + i) * rs] = o[i];
  }
}
__device__ __forceinline__ void seg_rows(int seg, int& row0, int& L) {
  const int b = seg / 129, s = seg % 129;
  if (s == 0) { row0 = b * TB; L = CTXL; } else { row0 = b * TB + CTXL + (s - 1) * 64; L = 64; }
}
__device__ __forceinline__ void phase_feat0(const Params& P, const Ctx& C) {
  bf16_t* Z = WS(OFF_Z0, bf16_t);
  for (int task = C.gw; task < NB * 129 * 20; task += C.ngw) {
    const int seg = task / 20, cg = task % 20; int row0, L; seg_rows(seg, row0, L);
    if (cg < 8) conv_task(Z, Z0W, row0, L, Z0_RGX + cg * 128, GIN(I_RGCW), 1024, cg * 128, GIN(I_RGCB), 0, 1.f, C.lane);
    else conv_task(Z, Z0W, row0, L, Z0_XBC + (cg - 8) * 128, GIN(I_SCW), 1536, (cg - 8) * 128, GIN(I_SCB), 1, 1.f, C.lane);
  }
}
__device__ __forceinline__ void phase_feat1(const Params& P, const Ctx& C) {
  bf16_t* Z = WS(OFF_Z1, bf16_t);
  for (int task = C.gw; task < NB * 129 * 24; task += C.ngw) {
    const int seg = task / 24, cg = task % 24; int row0, L; seg_rows(seg, row0, L);
    if (cg < 16) conv_task(Z, Z1W, row0, L, cg * 128, GIN(I_GCW), 3072, cg * 128, nullptr, 2, cg < 8 ? 0.08838834764831845f : 1.f, C.lane);
    else conv_task(Z, Z1W, row0, L, cg * 128, GIN(I_GCW), 3072, cg * 128, nullptr, 1, 1.f, C.lane);
  }
}

__device__ __forceinline__ int seq_pos(int dir, int j) { return dir == 0 ? j : (j < CTXL ? CTXL - 1 - j : TB - 1 - (j - CTXL)); }
__device__ __forceinline__ int seq_chunk(int dir, int j) { return dir == 0 ? j : (j < 4 ? 3 - j : 135 - j); }

__device__ __forceinline__ void rg_task(const Params& P, const Ctx& C, int task) {
  const int b = task >> 6, h = (task >> 3) & 7, q = task & 7;
  LAS float* Wl = (LAS float*)C.lds;
  LAS float* xc = Wl + 2 * 2 * 128 * 16;
  LAS float* SA = xc + 64 * 129;
  LAS float* SU = SA + 16 * 64;
  const bf16_t* Z = WS(OFF_Z0, bf16_t); bf16_t* MIX = WS(OFF_MIX0, bf16_t);
  __syncthreads();
  for (int i = C.tid; i < 2 * 2 * 128 * 16; i += NT) { const int j = i & 15, ii = (i >> 4) & 127, gate = (i >> 11) & 1, d = i >> 12;
    const float* W = (gate ? GIN(I_RGXW) : GIN(I_RGAW)) + ((size_t)(d * 8 + h) * 128 + ii) * 128 + q * 16 + j; Wl[i] = *W; }
  const int j = C.tid & 15, tg = C.tid >> 4;
  const int ch = h * 128 + q * 16 + j;
  const int sch = C.wave * 2;
  for (int d = 0; d < 2; ++d) {
    const float ba = GIN(I_RGAB)[d * 1024 + ch], bx = GIN(I_RGXB)[d * 1024 + ch], spl = softplusf_(-GIN(I_RGLAM)[d * 1024 + ch]);
    float hin0 = 0.f, hin1 = 0.f;
    for (int cs = 0; cs < 132; ++cs) {
      const int chunk = seq_chunk(d, cs), row0 = b * TB + chunk * 64;
      __syncthreads();
      { const int t = C.tid >> 3, sg = C.tid & 7; const u32x4* src = (const u32x4*)(Z + (size_t)(row0 + t) * Z0W + Z0_RGX + h * 128 + sg * 16);
        const u32x4 a = src[0], bb = src[1]; LAS float* dst = xc + t * 129 + sg * 16;
        dst[0] = bflo(a.x); dst[1] = bfhi(a.x); dst[2] = bflo(a.y); dst[3] = bfhi(a.y); dst[4] = bflo(a.z); dst[5] = bfhi(a.z); dst[6] = bflo(a.w); dst[7] = bfhi(a.w);
        dst[8] = bflo(bb.x); dst[9] = bfhi(bb.x); dst[10] = bflo(bb.y); dst[11] = bfhi(bb.y); dst[12] = bflo(bb.z); dst[13] = bfhi(bb.z); dst[14] = bflo(bb.w); dst[15] = bfhi(bb.w); }
      __syncthreads();
      { const LAS float* Wa = Wl + (d * 2 + 0) * 2048 + j; const LAS float* Wx = Wl + (d * 2 + 1) * 2048 + j;
        const LAS float* x0 = xc + (2 * tg) * 129; const LAS float* x1 = x0 + 129;
        float aa0 = 0.f, aa1 = 0.f, ax0 = 0.f, ax1 = 0.f;
#pragma unroll 8
        for (int i = 0; i < 128; ++i) { const float wa = Wa[i * 16], wx = Wx[i * 16], v0 = x0[i], v1 = x1[i]; aa0 += v0 * wa; aa1 += v1 * wa; ax0 += v0 * wx; ax1 += v1 * wx; }
#pragma unroll
        for (int tt = 0; tt < 2; ++tt) { const int t = 2 * tg + tt; const float pa = tt ? aa1 : aa0, px = tt ? ax1 : ax0;
          const float r = sigmoidf_(pa + ba), ig = sigmoidf_(px + bx); const float la = -8.f * r * spl; const float xv = xc[t * 129 + q * 16 + j];
          SA[j * 64 + t] = __expf(la); SU[j * 64 + t] = sqrtf(-expm1f(2.f * la)) * (ig * xv); } }
      __syncthreads();
#pragma unroll
      for (int cc = 0; cc < 2; ++cc) {
        const int lc = sch + cc; const int t = d == 0 ? C.lane : 63 - C.lane;
        float A = SA[lc * 64 + t], Bv = SU[lc * 64 + t];
#pragma unroll
        for (int off = 1; off < 64; off <<= 1) { const float Ap = __shfl_up(A, off), Bp = __shfl_up(Bv, off); if (C.lane >= off) { Bv = A * Bp + Bv; A = A * Ap; } }
        const float hin = cc ? hin1 : hin0; const float hv = Bv + A * hin;
        const float hlast = __shfl(hv, 63); if (cc) hin1 = hlast; else hin0 = hlast;
        const int gch = h * 128 + q * 16 + lc; bf16_t* o = MIX + (size_t)(row0 + t) * MIXW + gch;
        if (d == 0) *o = (bf16_t)f2bf(hv);
        else { const float hf = bf2f(*o); const float gy = bf2f(Z[(size_t)(row0 + t) * Z0W + Z0_RGY + gch]); *o = (bf16_t)f2bf((hf + hv) * geluf_(gy)); }
      }
    }
    __threadfence_block();
  }
}
__device__ __forceinline__ void ssd_task(const Params& P, const Ctx& C, int task) {
  const int b = task >> 9, hd = (task >> 5) & 15, ps = task & 31, g = hd >> 3;
  const int c = C.lane >> 5, ng = C.lane & 31;
  const bf16_t* Z = WS(OFF_Z0, bf16_t); bf16_t* MIX = WS(OFF_MIX0, bf16_t); const float* DT = WS(OFF_DT, float);
  const int colx = Z0_XBC + hd * 64 + 2 * ps + c, colB = Z0_B + g * 128 + 4 * ng, colC = Z0_C + g * 128 + 4 * ng, outc = 1024 + hd * 64 + 2 * ps + c;
  for (int d = 0; d < 2; ++d) {
    const float Aneg = -__expf(GIN(I_SALOG)[d * 16 + hd]), dtb = GIN(I_SDTB)[d * 16 + hd];
    float S0 = 0.f, S1 = 0.f, S2 = 0.f, S3 = 0.f;
    for (int j0 = 0; j0 < TB; j0 += 8) {
      u32x2 Bv[8], Cv[8]; unsigned short xv[8], yp[8]; float dtr[8];
#pragma unroll
      for (int u = 0; u < 8; ++u) { const size_t row = (size_t)b * TB + seq_pos(d, j0 + u);
        Bv[u] = *(const u32x2*)(Z + row * Z0W + colB); Cv[u] = *(const u32x2*)(Z + row * Z0W + colC); xv[u] = Z[row * Z0W + colx]; dtr[u] = DT[row * 32 + d * 16 + hd];
        yp[u] = d ? MIX[row * MIXW + outc] : (unsigned short)0; }
#pragma unroll
      for (int u = 0; u < 8; ++u) { const size_t row = (size_t)b * TB + seq_pos(d, j0 + u);
        const float dt = softplusf_(dtr[u] + dtb), a = __expf(Aneg * dt), xdt = bf2f(xv[u]) * dt;
        S0 = a * S0 + bflo(Bv[u].x) * xdt; S1 = a * S1 + bfhi(Bv[u].x) * xdt; S2 = a * S2 + bflo(Bv[u].y) * xdt; S3 = a * S3 + bfhi(Bv[u].y) * xdt;
        float y = (bflo(Cv[u].x) * S0 + bfhi(Cv[u].x) * S1) + (bflo(Cv[u].y) * S2 + bfhi(Cv[u].y) * S3);
        y = half_sum32(y);
        if (ng == 0) MIX[row * MIXW + outc] = (bf16_t)f2bf(y + bf2f(yp[u])); }
    }
    __threadfence_block();
  }
}

typedef short s16x4 __attribute__((ext_vector_type(4)));
__device__ __forceinline__ bf16x8 frag_row(const LAS bf16_t* base, int ld, int r0, int k0, int lane) {
  return *(const LAS bf16x8*)(base + (r0 + (lane & 15)) * ld + k0 + 8 * (lane >> 4));
}
__device__ __forceinline__ bf16x8 frag_tr(const LAS bf16_t* base, int ld, int k0, int n0, int lane) {
  const int g = lane >> 4, q = (lane & 15) >> 2, p = lane & 3;
  const LAS bf16_t* a0 = base + (k0 + 8 * g + q) * ld + n0 + 4 * p;
  const s16x4 v0 = __builtin_amdgcn_ds_read_tr16_b64_v4i16((LAS s16x4*)a0);
  const s16x4 v1 = __builtin_amdgcn_ds_read_tr16_b64_v4i16((LAS s16x4*)(a0 + 4 * ld));
  bf16x8 r; r[0] = v0[0]; r[1] = v0[1]; r[2] = v0[2]; r[3] = v0[3]; r[4] = v1[0]; r[5] = v1[1]; r[6] = v1[2]; r[7] = v1[3];
  return r;
}
__device__ __forceinline__ f32x4 mma16(bf16x8 fa, bf16x8 fb, f32x4 acc) { return __builtin_amdgcn_mfma_f32_16x16x32_bf16(fa, fb, acc, 0, 0, 0); }
__device__ __forceinline__ float wave_incl_scan(float v, int lane) {
#pragma unroll
  for (int off = 1; off < 64; off <<= 1) { const float p = __shfl_up(v, off); if (lane >= off) v += p; }
  return v;
}
__device__ __forceinline__ void tri_tile(int tt, int& I, int& J) { I = tt >= 6 ? 3 : (tt >= 3 ? 2 : (tt >= 1 ? 1 : 0)); J = tt - (I * (I + 1)) / 2; }
__device__ __forceinline__ unsigned long long ld_agent_u64(const void* p) { return __hip_atomic_load((const unsigned long long*)p, __ATOMIC_RELAXED, __HIP_MEMORY_SCOPE_AGENT); }
__device__ __forceinline__ bool fwd_first(int c) { return c < 4 ? (c <= 1) : (c <= 67); }

__device__ __forceinline__ void ssd_chain_wg(const Params& P, const Ctx& C, int task) {
  const int b = task >> 5, hd = (task >> 1) & 15, ps = task & 1, g = hd >> 3;
  const int d = C.wave >> 2, w = C.wave & 3, td = C.tid & 255, lane = C.lane, fr = lane & 15, fq = lane >> 4;
  constexpr int LDN = 136, LDP = 40, LDT = 72;
  constexpr int DIRSZ = 78 * 1024;
  LAS unsigned char* L = C.lds + d * DIRSZ;
  LAS bf16_t* Cs = (LAS bf16_t*)L;
  LAS bf16_t* Bs = Cs + 64 * LDN;
  LAS bf16_t* Xd = Bs + 64 * LDN;
  LAS bf16_t* Xw = Xd + 64 * LDP;
  LAS bf16_t* Pt = Xw + 64 * LDP;
  LAS bf16_t* St = Pt + 64 * LDT;
  LAS float* dtL = (LAS float*)(St + 2 * 32 * LDN);
  const bf16_t* Z = WS(OFF_Z0, bf16_t); bf16_t* MIX = WS(OFF_MIX0, bf16_t); const float* DT = WS(OFF_DT, float);
  const float Aneg = -__expf(GIN(I_SALOG)[d * 16 + hd]), dtb = GIN(I_SDTB)[d * 16 + hd];
  const int colC = Z0_C + g * 128, colB = Z0_B + g * 128, colX = Z0_XBC + hd * 64 + ps * 32, outc = 1024 + hd * 64 + ps * 32;
  __syncthreads();
  for (int i = td; i < 64 * LDT / 2; i += 256) ((LAS unsigned*)Pt)[i] = 0u;
  for (int i = td; i < 2 * 32 * LDN / 2; i += 256) ((LAS unsigned*)St)[i] = 0u;
  f32x4 Sacc[2][2];
#pragma unroll
  for (int a = 0; a < 2; ++a)
#pragma unroll
    for (int c = 0; c < 2; ++c) Sacc[a][c] = (f32x4){0.f, 0.f, 0.f, 0.f};
  const int st_t = td >> 2, st_q = td & 3;
  u32x4 rc[4], rb[4], rx; float rdt = 0.f;
  auto issue_loads = [&](int step) {
    const int chunk = seq_chunk(d, step); const size_t row = (size_t)b * TB + chunk * 64 + st_t;
    const u32x4* pc = (const u32x4*)(Z + row * Z0W + colC + st_q * 32); const u32x4* pb = (const u32x4*)(Z + row * Z0W + colB + st_q * 32);
#pragma unroll
    for (int i = 0; i < 4; ++i) { rc[i] = pc[i]; rb[i] = pb[i]; }
    rx = *(const u32x4*)(Z + row * Z0W + colX + st_q * 8);
    rdt = DT[row * 32 + d * 16 + hd];
  };
  issue_loads(0);
  for (int step = 0; step < 132; ++step) {
    const int chunk = seq_chunk(d, step); const int row0 = b * TB + chunk * 64;
    { const int i = d ? 63 - st_t : st_t; const float dt = softplusf_(rdt + dtb);
      LAS u32x4* dc = (LAS u32x4*)(Cs + i * LDN + st_q * 32); LAS u32x4* db = (LAS u32x4*)(Bs + i * LDN + st_q * 32);
#pragma unroll
      for (int k = 0; k < 4; ++k) { dc[k] = rc[k]; db[k] = rb[k]; }
      u32x4 xo; xo.x = pk2(bflo(rx.x) * dt, bfhi(rx.x) * dt); xo.y = pk2(bflo(rx.y) * dt, bfhi(rx.y) * dt); xo.z = pk2(bflo(rx.z) * dt, bfhi(rx.z) * dt); xo.w = pk2(bflo(rx.w) * dt, bfhi(rx.w) * dt);
      *(LAS u32x4*)(Xd + i * LDP + st_q * 8) = xo;
      if (st_q == 0) dtL[i] = dt; }
    __syncthreads();
    if (step + 1 < 132) issue_loads(step + 1);
    const float cum = wave_incl_scan(Aneg * dtL[lane], lane);
    const float cum_last = __shfl(cum, 63);
    { const int i = td >> 2; const float sc = __expf(cum_last - __shfl(cum, i & 63));
      const u32x4 v = *(const LAS u32x4*)(Xd + i * LDP + (td & 3) * 8);
      u32x4 o; o.x = pk2(bflo(v.x) * sc, bfhi(v.x) * sc); o.y = pk2(bflo(v.y) * sc, bfhi(v.y) * sc); o.z = pk2(bflo(v.z) * sc, bfhi(v.z) * sc); o.w = pk2(bflo(v.w) * sc, bfhi(v.w) * sc);
      *(LAS u32x4*)(Xw + i * LDP + (td & 3) * 8) = o; }
    for (int tt = w; tt < 10; tt += 4) {
      int I, J; tri_tile(tt, I, J);
      f32x4 acc = (f32x4){0.f, 0.f, 0.f, 0.f};
#pragma unroll
      for (int k = 0; k < 4; ++k) acc = mma16(frag_row(Cs, LDN, 16 * I, 32 * k, lane), frag_row(Bs, LDN, 16 * J, 32 * k, lane), acc);
      const int jj = 16 * J + fr; const float cj = __shfl(cum, jj);
      u32x2 o; float pv[4];
#pragma unroll
      for (int r = 0; r < 4; ++r) { const int ii = 16 * I + 4 * fq + r; const float ci = __shfl(cum, ii); pv[r] = (jj <= ii) ? acc[r] * __expf(ci - cj) : 0.f; }
      o.x = pk2(pv[0], pv[1]); o.y = pk2(pv[2], pv[3]);
      *(LAS u32x2*)(Pt + jj * LDT + 16 * I + 4 * fq) = o;
    }
    __syncthreads();
    const LAS bf16_t* Sr = St + (step & 1) * 32 * LDN; LAS bf16_t* Sw = St + ((step + 1) & 1) * 32 * LDN;
    { const int I = w; const int nks = I < 2 ? 1 : 2;
      const int ii = 16 * I + fr; const float eci = __expf(__shfl(cum, ii));
      const int t = d ? 63 - ii : ii; const bool first = (d == 0) == fwd_first(chunk);
#pragma unroll
      for (int pt = 0; pt < 2; ++pt) {
        f32x4 y1 = (f32x4){0.f, 0.f, 0.f, 0.f}, y2 = (f32x4){0.f, 0.f, 0.f, 0.f};
        for (int k = 0; k < nks; ++k) y1 = mma16(frag_tr(Xd, LDP, 32 * k, 16 * pt, lane), frag_tr(Pt, LDT, 32 * k, 16 * I, lane), y1);
#pragma unroll
        for (int k = 0; k < 4; ++k) y2 = mma16(frag_row(Sr, LDN, 16 * pt, 32 * k, lane), frag_row(Cs, LDN, 16 * I, 32 * k, lane), y2);
        bf16_t* op = MIX + (size_t)(row0 + t) * MIXW + outc + 16 * pt + 4 * fq;
        float o0 = y1[0] + eci * y2[0], o1 = y1[1] + eci * y2[1], o2 = y1[2] + eci * y2[2], o3 = y1[3] + eci * y2[3];
        if (!first) { const unsigned long long pv = ld_agent_u64(op); const unsigned lo = (unsigned)pv, hi = (unsigned)(pv >> 32); o0 += bflo(lo); o1 += bfhi(lo); o2 += bflo(hi); o3 += bfhi(hi); }
        u32x2 o; o.x = pk2(o0, o1); o.y = pk2(o2, o3); *(u32x2*)op = o;
      } }
    { const float el = __expf(cum_last);
#pragma unroll
      for (int a = 0; a < 2; ++a)
#pragma unroll
        for (int c = 0; c < 2; ++c) { f32x4 acc = Sacc[a][c] * el;
#pragma unroll
          for (int k = 0; k < 2; ++k) acc = mma16(frag_tr(Bs, LDN, 32 * k, 16 * (2 * w + a), lane), frag_tr(Xw, LDP, 32 * k, 16 * c, lane), acc);
          Sacc[a][c] = acc;
          u32x2 o; o.x = pk2(acc[0], acc[1]); o.y = pk2(acc[2], acc[3]);
          *(LAS u32x2*)(Sw + (16 * c + fr) * LDN + 16 * (2 * w + a) + 4 * fq) = o; } }
    __syncthreads();
  }
}
__device__ __forceinline__ void phase_chain0(const Params& P, const Ctx& C) {
  for (int task = C.bid; task < 128; task += C.nblk) ssd_chain_wg(P, C, task);
  for (int task = C.bid; task < 256; task += C.nblk) rg_task(P, C, task);
}
__device__ __forceinline__ void phase_ssdfin(const Params& P, const Ctx& C) {
  const bf16_t* Z = WS(OFF_Z0, bf16_t); bf16_t* MIX = WS(OFF_MIX0, bf16_t);
  for (int r = C.gw; r < R; r += C.ngw) {
    f32x4 y[4];
#pragma unroll
    for (int j = 0; j < 4; ++j) { const int e = 4 * C.lane + 256 * j; const float dsk = GIN(I_SD)[e >> 6];
      const u32x2 ys = *(const u32x2*)(MIX + (size_t)r * MIXW + 1024 + e), xs = *(const u32x2*)(Z + (size_t)r * Z0W + Z0_XBC + e), zz = *(const u32x2*)(Z + (size_t)r * Z0W + Z0_SSDZ + e);
      y[j][0] = (bflo(ys.x) + dsk * bflo(xs.x)) * siluf_(bflo(zz.x)); y[j][1] = (bfhi(ys.x) + dsk * bfhi(xs.x)) * siluf_(bfhi(zz.x));
      y[j][2] = (bflo(ys.y) + dsk * bflo(xs.y)) * siluf_(bflo(zz.y)); y[j][3] = (bfhi(ys.y) + dsk * bfhi(xs.y)) * siluf_(bfhi(zz.y)); }
    float s0 = 0.f, s1 = 0.f;
#pragma unroll
    for (int i = 0; i < 4; ++i) { s0 += y[0][i] * y[0][i] + y[1][i] * y[1][i]; s1 += y[2][i] * y[2][i] + y[3][i] * y[3][i]; }
    const float r0 = rsqrtf(wave_sum(s0) * (1.f / 512.f) + RMS_EPS), r1 = rsqrtf(wave_sum(s1) * (1.f / 512.f) + RMS_EPS);
#pragma unroll
    for (int j = 0; j < 4; ++j) { const int e = 4 * C.lane + 256 * j; const f32x4 gn = *(const f32x4*)(GIN(I_SNG) + e); const float rr = j < 2 ? r0 : r1;
      u32x2 w; w.x = pk2(y[j][0] * rr * gn[0], y[j][1] * rr * gn[1]); w.y = pk2(y[j][2] * rr * gn[2], y[j][3] * rr * gn[3]);
      *(u32x2*)(MIX + (size_t)r * MIXW + 1024 + e) = w; }
  }
}

__device__ __forceinline__ void phase_outproj(const Params& P, const Ctx& C, int layer) {
  const float* MOD = WS(OFF_MOD, float) + (size_t)layer * 5 * 6144;
  pg8::Gemm g{layer ? WS(OFF_MIX1, bf16_t) : WS(OFF_MIX0, bf16_t), layer ? WS(OFF_WOUT1, bf16_t) : WS(OFF_WOUT0, bf16_t), MIXW, MIXW};
  pg8::GridOrder S; if (layer) S.init(128, 4, C.nblk, C.bid, 1); else S.init(132, 4, C.nblk, C.bid, 0);
  pg8::EpiResid E{layer ? GOUT : GIN(I_X), layer ? WS(OFF_HCTX, float) : GIN(I_CTX), GOUT, WS(OFF_TCTX, float), MOD + 2 * D};
  pg8::gemm_phase(C.lds, g, S, E);
}

__device__ __forceinline__ void phase_lnmix(const Params& P, const Ctx& C, int layer) {
  LAS float* Wt = (LAS float*)C.lds;
  { const float* gw = GIN(I_RGW) + (size_t)layer * D * 4; const float* ew = GIN(I_REW) + (size_t)layer * D * 32;
    for (int i = C.tid; i < 1024 * 4; i += NT) { const int k = i >> 2, c = i & 3; Wt[c * 1024 + k] = gw[i]; }
    for (int i = C.tid; i < 1024 * 32; i += NT) { const int k = i >> 5, c = i & 31; Wt[(4 + c) * 1024 + k] = ew[i]; } }
  __syncthreads();
  const float* MOD = WS(OFF_MOD, float) + (size_t)layer * 5 * 6144;
  const float* lng = GIN(I_LNMG) + layer * D; const float* lnb = GIN(I_LNMB) + layer * D;
  const float* rgb = GIN(I_RGB) + layer * 4; const float* reb = GIN(I_REB) + layer * 32;
  bf16_t* V = layer ? WS(OFF_V1, bf16_t) : WS(OFF_U0, bf16_t);
  int* cnt = WS(OFF_CTL, int) + layer * 32; int* route = WS(OFF_ROUTE, int);
  for (int r = C.gw; r < R; r += C.ngw) {
    const int pos = r % TB; if (layer && pos < CTXL) continue;
    float* trow = lat_or_ctx_w(GOUT, WS(OFF_TCTX, float), r);
    float* hrow = lat_or_ctx_w(GOUT, WS(OFF_HCTX, float), r);
    f32x4 h[4], v[4]; row_load(trow, C.lane, h);
    row_layernorm(h, lng, lnb, C.lane);
    row_store(hrow, C.lane, h);
    const float* m = MOD + (size_t)row_b5(r) * 6144;
    row_modulate(h, m + 3 * D, m + 4 * D, C.lane, v);
    row_store_bf16(V + (size_t)r * D, C.lane, v);
    float myv = 0.f;
#pragma unroll 4
    for (int c = 0; c < 36; ++c) { float s = 0.f;
#pragma unroll
      for (int j = 0; j < 4; ++j) { const f32x4 w = *(const LAS f32x4*)(Wt + c * 1024 + 4 * C.lane + 256 * j); s += (v[j][0] * w[0] + v[j][1] * w[1]) + (v[j][2] * w[2] + v[j][3] * w[3]); }
      s = wave_sum(s); if (C.lane == c) myv = s; }
    float lg[4]; int gsel = 0; float gmax;
#pragma unroll
    for (int i = 0; i < 4; ++i) lg[i] = __shfl(myv, i) + rgb[i];
    gmax = lg[0];
#pragma unroll
    for (int i = 1; i < 4; ++i) if (lg[i] > gmax) { gmax = lg[i]; gsel = i; }
    float gden = 0.f;
#pragma unroll
    for (int i = 0; i < 4; ++i) gden += __expf(lg[i] - gmax);
    const float ptg = 1.f / gden;
    float le[8];
#pragma unroll
    for (int i = 0; i < 8; ++i) le[i] = __shfl(myv, 4 + gsel * 8 + i) + reb[gsel * 8 + i];
    int e1 = 0; float m1 = le[0];
#pragma unroll
    for (int i = 1; i < 8; ++i) if (le[i] > m1) { m1 = le[i]; e1 = i; }
    int e2 = -1; float m2 = -3.0e38f;
#pragma unroll
    for (int i = 0; i < 8; ++i) if (i != e1 && le[i] > m2) { m2 = le[i]; e2 = i; }
    const float q2 = __expf(m2 - m1); const float w1 = ptg / (1.f + q2), w2 = ptg * q2 / (1.f + q2);
    if (C.lane == 0) {
      const int E1 = gsel * 8 + e1, E2 = gsel * 8 + e2;
      const int p1 = atomicAdd(cnt + E1, 1), p2 = atomicAdd(cnt + E2, 1);
      int* rr = route + (size_t)r * 8; rr[0] = E1; rr[1] = E2; ((float*)rr)[2] = w1; ((float*)rr)[3] = w2; rr[4] = p1; rr[5] = p2;
    }
  }
}

__device__ __forceinline__ void phase_dispatch(const Params& P, const Ctx& C, int layer) {
  LAS int* base = (LAS int*)C.lds;
  int* ctl = WS(OFF_CTL, int); const int* cnt = ctl + layer * 32;
  if (C.tid == 0) { int acc = 0; for (int e = 0; e < NEXP; ++e) { base[e] = acc; acc += (cnt[e] + 255) >> 8; } base[32] = acc; }
  __syncthreads();
  if (C.bid == 0) { if (C.tid == 0) ctl[64 + layer] = base[32];
    if (C.tid < NEXP) { for (int bk = base[C.tid]; bk < base[C.tid + 1]; ++bk) ctl[128 + layer * MAX_BLKS + bk] = C.tid; } }
  const bf16_t* V = layer ? WS(OFF_V1, bf16_t) : WS(OFF_U0, bf16_t);
  bf16_t* AM = layer ? WS(OFF_AM1, bf16_t) : WS(OFF_AM0, bf16_t);
  float* slotw = WS(OFF_SLOTW, float); int* route = WS(OFF_ROUTE, int);
  for (int r = C.gw; r < R; r += C.ngw) {
    const int pos = r % TB; if (layer && pos < CTXL) continue;
    int* rr = route + (size_t)r * 8;
    const int E1 = rr[0], E2 = rr[1]; const int s1 = base[E1] * 256 + rr[4], s2 = base[E2] * 256 + rr[5];
    const u32x4* src = (const u32x4*)(V + (size_t)r * D);
    const u32x4 a = src[C.lane], b = src[64 + C.lane];
    u32x4* d1 = (u32x4*)(AM + (size_t)s1 * D); u32x4* d2 = (u32x4*)(AM + (size_t)s2 * D);
    d1[C.lane] = a; d1[64 + C.lane] = b; d2[C.lane] = a; d2[64 + C.lane] = b;
    if (C.lane == 0) { rr[6] = s1; rr[7] = s2; slotw[s1] = ((const float*)rr)[2]; slotw[s2] = ((const float*)rr)[3]; }
  }
}
__device__ __forceinline__ void phase_moe1(const Params& P, const Ctx& C, int layer) {
  const int* ctl = WS(OFF_CTL, int);
  pg8::Gemm g{layer ? WS(OFF_AM1, bf16_t) : WS(OFF_AM0, bf16_t), layer ? WS(OFF_WE1, bf16_t) : WS(OFF_WE0, bf16_t), D, D};
  pg8::MoeOrder S{ctl + 128 + layer * MAX_BLKS, ctl[64 + layer] * 4, C.nblk, C.bid};
  pg8::EpiSwiGLU E{layer ? WS(OFF_HM1, bf16_t) : WS(OFF_HM0, bf16_t)};
  pg8::gemm_phase(C.lds, g, S, E);
}
__device__ __forceinline__ void phase_moe2(const Params& P, const Ctx& C, int layer) {
  const int* ctl = WS(OFF_CTL, int);
  pg8::Gemm g{layer ? WS(OFF_HM1, bf16_t) : WS(OFF_HM0, bf16_t), layer ? WS(OFF_WE1 + 64 * MiB, bf16_t) : WS(OFF_WE0 + 64 * MiB, bf16_t), DEXP, DEXP};
  pg8::MoeOrder S{ctl + 128 + layer * MAX_BLKS, ctl[64 + layer] * 4, C.nblk, C.bid};
  pg8::EpiMoeDown E{layer ? WS(OFF_YM1, bf16_t) : WS(OFF_YM0, bf16_t), WS(OFF_SLOTW, float)};
  pg8::gemm_phase(C.lds, g, S, E);
}

__device__ __forceinline__ void phase_lnffn(const Params& P, const Ctx& C, int layer) {
  LAS float* Wt = (LAS float*)C.lds;
  if (layer == 0) { stage_cols32(GIN(I_CDW), CD_IN, 4096, Wt, C.tid); __syncthreads(); }
  const float* MOD = WS(OFF_MOD, float) + (size_t)layer * 5 * 6144;
  const float* lng = GIN(I_LNFG) + layer * D; const float* lnb = GIN(I_LNFB) + layer * D;
  const bf16_t* YM = layer ? WS(OFF_YM1, bf16_t) : WS(OFF_YM0, bf16_t); const int* route = WS(OFF_ROUTE, int);
  for (int r = C.gw; r < R; r += C.ngw) {
    const int pos = r % TB; if (layer && pos < CTXL) continue;
    float* hrow = lat_or_ctx_w(GOUT, WS(OFF_HCTX, float), r);
    const float* m = MOD + (size_t)row_b5(r) * 6144;
    const int* rr = route + (size_t)r * 8; const int s1 = rr[6], s2 = rr[7];
    f32x4 h[4]; row_load(hrow, C.lane, h);
#pragma unroll
    for (int j = 0; j < 4; ++j) { const u32x2 a = *(const u32x2*)(YM + (size_t)s1 * D + 4 * C.lane + 256 * j), b = *(const u32x2*)(YM + (size_t)s2 * D + 4 * C.lane + 256 * j);
      const f32x4 g5 = *(const f32x4*)(m + 5 * D + 4 * C.lane + 256 * j);
      f32x4 f; f[0] = bflo(a.x) + bflo(b.x); f[1] = bfhi(a.x) + bfhi(b.x); f[2] = bflo(a.y) + bflo(b.y); f[3] = bfhi(a.y) + bfhi(b.y);
      h[j] = h[j] * ALPHA + g5 * f; }
    row_layernorm(h, lng, lnb, C.lane);
    row_store(hrow, C.lane, h);
    if (layer == 0) {
      const float* m1 = WS(OFF_MOD, float) + (size_t)(5 + row_b5(r)) * 6144;
      f32x4 u[4]; row_modulate(h, m1, m1 + D, C.lane, u);
      row_store_bf16(WS(OFF_U1, bf16_t) + (size_t)r * D, C.lane, u);
      row_dot32(u, Wt, C.lane, WS(OFF_DT, float) + (size_t)r * 32);
    }
  }
  if (layer == 0) {
    __syncthreads();
    LAS float* scr = (LAS float*)C.lds + C.wave * (64 * 33);
    constexpr int N_A = 16 * 96, N_B = 16 * 128;
    for (int it = C.gw; it < N_A + N_B; it += C.ngw) {
      if (it < N_A) transpose_mat_item(GIN(I_CDW), CD_IN, 0, D, 3072, WS(OFF_WCD, bf16_t), D, 0, it, scr, C.lane);
      else transpose_mat_item(GIN(I_CDW), CD_IN, 4128, D, 4096, WS(OFF_WCD, bf16_t) + (size_t)3072 * D, D, 0, it - N_A, scr, C.lane);
    }
  }
}

__device__ __forceinline__ void gdn_task(const Params& P, const Ctx& C, int task) {
  const int b = task >> 9, h = (task >> 6) & 7, vs = task & 63; const int c = C.lane >> 5, kg = C.lane & 31;
  const bf16_t* Z = WS(OFF_Z1, bf16_t); bf16_t* MIX = WS(OFF_MIX1, bf16_t); const float* DT = WS(OFF_DT, float);
  const int colq = Z1_Q + h * 128 + 4 * kg, colk = Z1_K + h * 128 + 4 * kg, colv = Z1_V + h * 128 + 2 * vs + c, outc = h * 128 + 2 * vs + c;
  for (int d = 0; d < 2; ++d) {
    const float Aneg = -__expf(GIN(I_GALOG)[d * 8 + h]), dtb = GIN(I_GDTB)[d * 8 + h];
    float S0 = 0.f, S1 = 0.f, S2 = 0.f, S3 = 0.f;
    for (int j0 = 0; j0 < TB; j0 += 8) {
      u32x2 qv[8], kv[8]; unsigned short vv[8], yp[8]; float br[8], ar[8];
#pragma unroll
      for (int u = 0; u < 8; ++u) { const size_t row = (size_t)b * TB + seq_pos(d, j0 + u);
        qv[u] = *(const u32x2*)(Z + row * Z1W + colq); kv[u] = *(const u32x2*)(Z + row * Z1W + colk); vv[u] = Z[row * Z1W + colv];
        br[u] = DT[row * 32 + d * 8 + h]; ar[u] = DT[row * 32 + 16 + d * 8 + h]; yp[u] = d ? MIX[row * MIXW + outc] : (unsigned short)0; }
#pragma unroll
      for (int u = 0; u < 8; ++u) { const size_t row = (size_t)b * TB + seq_pos(d, j0 + u);
        const float al = __expf(Aneg * softplusf_(ar[u] + dtb)), be = sigmoidf_(br[u]);
        const float k0 = bflo(kv[u].x), k1 = bfhi(kv[u].x), k2 = bflo(kv[u].y), k3 = bfhi(kv[u].y);
        S0 *= al; S1 *= al; S2 *= al; S3 *= al;
        const float p = half_sum32((k0 * S0 + k1 * S1) + (k2 * S2 + k3 * S3));
        const float dl = be * (bf2f(vv[u]) - p);
        S0 += k0 * dl; S1 += k1 * dl; S2 += k2 * dl; S3 += k3 * dl;
        const float o = half_sum32((bflo(qv[u].x) * S0 + bfhi(qv[u].x) * S1) + (bflo(qv[u].y) * S2 + bfhi(qv[u].y) * S3));
        if (kg == 0) MIX[row * MIXW + outc] = (bf16_t)f2bf(o + bf2f(yp[u])); }
    }
    __threadfence_block();
  }
}
__device__ __forceinline__ void hgrn_task(const Params& P, const Ctx& C, int task) {
  const int b = task >> 9, h = (task >> 6) & 7, vs = task & 63; const int c = C.lane >> 5, kg = C.lane & 31;
  const bf16_t* Z = WS(OFF_Z1, bf16_t); bf16_t* MIX = WS(OFF_MIX1, bf16_t);
  const f32x4 lb = *(const f32x4*)(WS(OFF_LB1, float) + h * 128 + 4 * kg);
  const int colq = Z1_HQ + h * 128 + 4 * kg, colv = Z1_HI + h * 128 + 2 * vs + c, outc = 1024 + h * 128 + 2 * vs + c;
  for (int d = 0; d < 2; ++d) {
    const int colf = Z1_HF + d * 1024 + h * 128 + 4 * kg;
    float S0 = 0.f, S1 = 0.f, S2 = 0.f, S3 = 0.f;
    for (int j0 = 0; j0 < TB; j0 += 8) {
      u32x2 qv[8], fv[8]; unsigned short vv[8], yp[8];
#pragma unroll
      for (int u = 0; u < 8; ++u) { const size_t row = (size_t)b * TB + seq_pos(d, j0 + u);
        qv[u] = *(const u32x2*)(Z + row * Z1W + colq); fv[u] = *(const u32x2*)(Z + row * Z1W + colf); vv[u] = Z[row * Z1W + colv];
        yp[u] = d ? MIX[row * MIXW + outc] : (unsigned short)0; }
#pragma unroll
      for (int u = 0; u < 8; ++u) { const size_t row = (size_t)b * TB + seq_pos(d, j0 + u);
        const float f0 = lb[0] + (1.f - lb[0]) * sigmoidf_(bflo(fv[u].x)), f1 = lb[1] + (1.f - lb[1]) * sigmoidf_(bfhi(fv[u].x));
        const float f2 = lb[2] + (1.f - lb[2]) * sigmoidf_(bflo(fv[u].y)), f3 = lb[3] + (1.f - lb[3]) * sigmoidf_(bfhi(fv[u].y));
        const float v = bf2f(vv[u]);
        S0 = f0 * S0 + (1.f - f0) * v; S1 = f1 * S1 + (1.f - f1) * v; S2 = f2 * S2 + (1.f - f2) * v; S3 = f3 * S3 + (1.f - f3) * v;
        const float o = half_sum32((bflo(qv[u].x) * S0 + bfhi(qv[u].x) * S1) + (bflo(qv[u].y) * S2 + bfhi(qv[u].y) * S3));
        if (kg == 0) MIX[row * MIXW + outc] = (bf16_t)f2bf(o + bf2f(yp[u])); }
    }
    __threadfence_block();
  }
}

__device__ __forceinline__ int seq_chunk32(int dir, int j) { return dir == 0 ? j : (j < 8 ? 7 - j : 271 - j); }
__device__ __forceinline__ bool fwd_first32(int c) { return c < 8 ? (c <= 3) : (c <= 135); }

__device__ __forceinline__ void hgrn_chain_wg(const Params& P, const Ctx& C, int task) {
  const int b = task >> 5, h = (task >> 2) & 7, vs = task & 3;
  const int d = C.wave >> 2, w = C.wave & 3, td = C.tid & 255, lane = C.lane, fr = lane & 15, fq = lane >> 4;
  constexpr int LDN = 136, LDP = 40;
  constexpr int DIRSZ = 72 * 1024;
  LAS unsigned char* L = C.lds + d * DIRSZ;
  LAS bf16_t* Qt = (LAS bf16_t*)L;
  LAS bf16_t* Kh = Qt + 32 * LDN;
  LAS bf16_t* Kw = Kh + 32 * LDN;
  LAS bf16_t* Vs = Kw + 32 * LDN;
  LAS bf16_t* Pt = Vs + 32 * LDP;
  LAS bf16_t* St = Pt + 32 * LDP;
  LAS float* CUM = (LAS float*)(St + 2 * 32 * LDN);
  const bf16_t* Z = WS(OFF_Z1, bf16_t); bf16_t* MIX = WS(OFF_MIX1, bf16_t);
  const int colq = Z1_HQ + h * 128, colf = Z1_HF + d * 1024 + h * 128, colv = Z1_HI + h * 128 + vs * 32, outc = 1024 + h * 128 + vs * 32;
  __syncthreads();
  for (int i = td; i < 32 * LDP / 2; i += 256) ((LAS unsigned*)Pt)[i] = 0u;
  for (int i = td; i < 2 * 32 * LDN / 2; i += 256) ((LAS unsigned*)St)[i] = 0u;
  f32x4 Sacc[2][2];
#pragma unroll
  for (int a = 0; a < 2; ++a)
#pragma unroll
    for (int c = 0; c < 2; ++c) Sacc[a][c] = (f32x4){0.f, 0.f, 0.f, 0.f};
  const int st_t = td >> 3, st_s = td & 7;
  float lbv[16];
#pragma unroll
  for (int e = 0; e < 16; ++e) lbv[e] = WS(OFF_LB1, float)[h * 128 + st_s * 16 + e];
  u32x4 rq[2], rf[2]; u32x2 rv;
  auto issue_loads = [&](int step) {
    const int chunk = seq_chunk32(d, step); const size_t row = (size_t)b * TB + chunk * 32 + st_t;
    const u32x4* pq = (const u32x4*)(Z + row * Z1W + colq + st_s * 16); const u32x4* pf = (const u32x4*)(Z + row * Z1W + colf + st_s * 16);
    rq[0] = pq[0]; rq[1] = pq[1]; rf[0] = pf[0]; rf[1] = pf[1];
    rv = *(const u32x2*)(Z + row * Z1W + colv + st_s * 4);
  };
  issue_loads(0);
  for (int step = 0; step < 264; ++step) {
    const int chunk = seq_chunk32(d, step); const int row0 = b * TB + chunk * 32;
    const int si = d ? 31 - st_t : st_t;
    float qv[16], kk[16];
    { const unsigned qw[8] = {rq[0].x, rq[0].y, rq[0].z, rq[0].w, rq[1].x, rq[1].y, rq[1].z, rq[1].w};
      const unsigned fw[8] = {rf[0].x, rf[0].y, rf[0].z, rf[0].w, rf[1].x, rf[1].y, rf[1].z, rf[1].w};
      f32x4 lf4[4];
#pragma unroll
      for (int e = 0; e < 8; ++e) { qv[2 * e] = bflo(qw[e]); qv[2 * e + 1] = bfhi(qw[e]);
        const float f0 = lbv[2 * e] + (1.f - lbv[2 * e]) * sigmoidf_(bflo(fw[e])), f1 = lbv[2 * e + 1] + (1.f - lbv[2 * e + 1]) * sigmoidf_(bfhi(fw[e]));
        kk[2 * e] = 1.f - f0; kk[2 * e + 1] = 1.f - f1; lf4[e >> 1][(2 * e) & 3] = __logf(f0); lf4[e >> 1][(2 * e + 1) & 3] = __logf(f1); }
#pragma unroll
      for (int e = 0; e < 4; ++e) *(LAS f32x4*)(CUM + si * 128 + st_s * 16 + 4 * e) = lf4[e];
      *(LAS u32x2*)(Vs + si * LDP + st_s * 4) = rv; }
    __syncthreads();
    if (step + 1 < 264) issue_loads(step + 1);
    if (td < 128) { float c = 0.f;
#pragma unroll 8
      for (int i = 0; i < 32; ++i) { c += CUM[i * 128 + td]; CUM[i * 128 + td] = c; } }
    __syncthreads();
    { unsigned oq[8], oh[8], ow[8];
#pragma unroll
      for (int e = 0; e < 8; ++e) { const int k0 = st_s * 16 + 2 * e;
        const float c0 = CUM[si * 128 + k0], c1 = CUM[si * 128 + k0 + 1], l0 = CUM[31 * 128 + k0], l1 = CUM[31 * 128 + k0 + 1];
        oq[e] = pk2(qv[2 * e] * __expf(c0), qv[2 * e + 1] * __expf(c1));
        oh[e] = pk2(kk[2 * e] * __expf(fminf(-c0, 80.f)), kk[2 * e + 1] * __expf(fminf(-c1, 80.f)));
        ow[e] = pk2(kk[2 * e] * __expf(l0 - c0), kk[2 * e + 1] * __expf(l1 - c1)); }
      LAS u32x4* dq = (LAS u32x4*)(Qt + si * LDN + st_s * 16); LAS u32x4* dh = (LAS u32x4*)(Kh + si * LDN + st_s * 16); LAS u32x4* dw = (LAS u32x4*)(Kw + si * LDN + st_s * 16);
      dq[0] = (u32x4){oq[0], oq[1], oq[2], oq[3]}; dq[1] = (u32x4){oq[4], oq[5], oq[6], oq[7]};
      dh[0] = (u32x4){oh[0], oh[1], oh[2], oh[3]}; dh[1] = (u32x4){oh[4], oh[5], oh[6], oh[7]};
      dw[0] = (u32x4){ow[0], ow[1], ow[2], ow[3]}; dw[1] = (u32x4){ow[4], ow[5], ow[6], ow[7]}; }
    __syncthreads();
    if (w < 3) { const int I = w >= 1 ? 1 : 0, J = w == 2 ? 1 : 0;
      f32x4 acc = (f32x4){0.f, 0.f, 0.f, 0.f};
#pragma unroll
      for (int k = 0; k < 4; ++k) acc = mma16(frag_row(Qt, LDN, 16 * I, 32 * k, lane), frag_row(Kh, LDN, 16 * J, 32 * k, lane), acc);
      const int jj = 16 * J + fr; float pv[4];
#pragma unroll
      for (int r = 0; r < 4; ++r) { const int ii = 16 * I + 4 * fq + r; pv[r] = (jj <= ii) ? acc[r] : 0.f; }
      u32x2 o; o.x = pk2(pv[0], pv[1]); o.y = pk2(pv[2], pv[3]);
      *(LAS u32x2*)(Pt + jj * LDP + 16 * I + 4 * fq) = o; }
    const LAS bf16_t* Sr = St + (step & 1) * 32 * LDN; LAS bf16_t* Sw = St + ((step + 1) & 1) * 32 * LDN;
    const int vt = w & 1, it = w >> 1;
    f32x4 o2 = (f32x4){0.f, 0.f, 0.f, 0.f};
#pragma unroll
    for (int k = 0; k < 4; ++k) o2 = mma16(frag_row(Sr, LDN, 16 * vt, 32 * k, lane), frag_row(Qt, LDN, 16 * it, 32 * k, lane), o2);
#pragma unroll
    for (int a = 0; a < 2; ++a) { const int kt = 2 * w + a; const f32x4 cl = *(const LAS f32x4*)(CUM + 31 * 128 + 16 * kt + 4 * fq);
      f32x4 dec; dec[0] = __expf(cl[0]); dec[1] = __expf(cl[1]); dec[2] = __expf(cl[2]); dec[3] = __expf(cl[3]);
#pragma unroll
      for (int c = 0; c < 2; ++c) { f32x4 acc = Sacc[a][c] * dec;
        acc = mma16(frag_tr(Kw, LDN, 0, 16 * kt, lane), frag_tr(Vs, LDP, 0, 16 * c, lane), acc);
        Sacc[a][c] = acc;
        u32x2 o; o.x = pk2(acc[0], acc[1]); o.y = pk2(acc[2], acc[3]);
        *(LAS u32x2*)(Sw + (16 * c + fr) * LDN + 16 * kt + 4 * fq) = o; } }
    __syncthreads();
    { f32x4 o1 = mma16(frag_tr(Vs, LDP, 0, 16 * vt, lane), frag_tr(Pt, LDP, 0, 16 * it, lane), (f32x4){0.f, 0.f, 0.f, 0.f});
      const int ii = 16 * it + fr; const int t = d ? 31 - ii : ii; const bool first = (d == 0) == fwd_first32(chunk);
      bf16_t* op = MIX + (size_t)(row0 + t) * MIXW + outc + 16 * vt + 4 * fq;
      float o0 = o1[0] + o2[0], o1v = o1[1] + o2[1], o2v = o1[2] + o2[2], o3 = o1[3] + o2[3];
      if (!first) { const unsigned long long pv = ld_agent_u64(op); const unsigned lo = (unsigned)pv, hi = (unsigned)(pv >> 32); o0 += bflo(lo); o1v += bfhi(lo); o2v += bflo(hi); o3 += bfhi(hi); }
      u32x2 o; o.x = pk2(o0, o1v); o.y = pk2(o2v, o3); *(u32x2*)op = o; }
    __syncthreads();
  }
}

__device__ __forceinline__ void gdn_chain_wg(const Params& P, const Ctx& C, int task) {
  const int b = task >> 5, h = (task >> 2) & 7, vs = task & 3;
  const int d = C.wave >> 2, w = C.wave & 3, td = C.tid & 255, lane = C.lane, fr = lane & 15, fq = lane >> 4;
  constexpr int LDN = 136, LDP = 40, LDT = 24;
  constexpr int DIRSZ = 72 * 1024;
  LAS unsigned char* L = C.lds + d * DIRSZ;
  LAS bf16_t* Qs = (LAS bf16_t*)L;
  LAS bf16_t* Ks = Qs + 32 * LDN;
  LAS bf16_t* Vs = Ks + 32 * LDN;
  LAS bf16_t* Mt = Vs + 32 * LDP;
  LAS bf16_t* At = Mt + 32 * LDP;
  LAS bf16_t* Tt = At + 32 * LDP;
  LAS bf16_t* Xt = Tt + 2 * 32 * LDT;
  LAS bf16_t* Rt = Xt + 160 * LDP;
  LAS bf16_t* Vn = Rt + 4 * 16 * LDP;
  LAS bf16_t* Vw = Vn + 32 * LDP;
  LAS bf16_t* St = Vw + 32 * LDP;
  LAS float* Md = (LAS float*)(St + 2 * 32 * LDN);
  LAS float* gL = Md + 2 * 256;
  LAS float* bL = gL + 32;
  const bf16_t* Z = WS(OFF_Z1, bf16_t); bf16_t* MIX = WS(OFF_MIX1, bf16_t); const float* DT = WS(OFF_DT, float);
  const float Aneg = -__expf(GIN(I_GALOG)[d * 8 + h]), dtb = GIN(I_GDTB)[d * 8 + h];
  const int colq = Z1_Q + h * 128, colk = Z1_K + h * 128, colv = Z1_V + h * 128 + vs * 32, outc = h * 128 + vs * 32;
  __syncthreads();
  for (int i = td; i < 71 * 1024 / 4; i += 256) ((LAS unsigned*)L)[i] = 0u;
  f32x4 Sacc[2][2];
#pragma unroll
  for (int a = 0; a < 2; ++a)
#pragma unroll
    for (int c = 0; c < 2; ++c) Sacc[a][c] = (f32x4){0.f, 0.f, 0.f, 0.f};
  const int st_t = td >> 3, st_s = td & 7;
  u32x4 rq[2], rk[2]; u32x2 rv; float ra = 0.f, rb = 0.f;
  auto issue_loads = [&](int step) {
    const int chunk = seq_chunk32(d, step); const size_t row = (size_t)b * TB + chunk * 32 + st_t;
    const u32x4* pq = (const u32x4*)(Z + row * Z1W + colq + st_s * 16); const u32x4* pk = (const u32x4*)(Z + row * Z1W + colk + st_s * 16);
    rq[0] = pq[0]; rq[1] = pq[1]; rk[0] = pk[0]; rk[1] = pk[1];
    rv = *(const u32x2*)(Z + row * Z1W + colv + st_s * 4);
    if (st_s == 0) { rb = DT[row * 32 + d * 8 + h]; ra = DT[row * 32 + 16 + d * 8 + h]; }
  };
  issue_loads(0);
  __syncthreads();
  LAS bf16_t* Rw = Rt + w * 16 * LDP;
  for (int step = 0; step < 264; ++step) {
    const int chunk = seq_chunk32(d, step); const int row0 = b * TB + chunk * 32;
    { const int si = d ? 31 - st_t : st_t;
      LAS u32x4* dq = (LAS u32x4*)(Qs + si * LDN + st_s * 16); LAS u32x4* dk = (LAS u32x4*)(Ks + si * LDN + st_s * 16);
      dq[0] = rq[0]; dq[1] = rq[1]; dk[0] = rk[0]; dk[1] = rk[1];
      *(LAS u32x2*)(Vs + si * LDP + st_s * 4) = rv;
      if (st_s == 0) { gL[si] = Aneg * softplusf_(ra + dtb); bL[si] = sigmoidf_(rb); } }
    __syncthreads();
    if (step + 1 < 264) issue_loads(step + 1);
    const float cum = wave_incl_scan(lane < 32 ? gL[lane] : 0.f, lane);
    const float cum_last = __shfl(cum, 31);
    const LAS bf16_t* Sr = St + (step & 1) * 32 * LDN; LAS bf16_t* Sw = St + ((step + 1) & 1) * 32 * LDN;
    const int vt = w & 1, it = w >> 1;
    for (int job = w; job < 6; job += 4) {
      const int isq = job >= 3, tj = job - 3 * isq; const int I = tj >= 1 ? 1 : 0, J = tj == 2 ? 1 : 0;
      const LAS bf16_t* A = isq ? Qs : Ks;
      f32x4 acc = (f32x4){0.f, 0.f, 0.f, 0.f};
#pragma unroll
      for (int k = 0; k < 4; ++k) acc = mma16(frag_row(A, LDN, 16 * I, 32 * k, lane), frag_row(Ks, LDN, 16 * J, 32 * k, lane), acc);
      const int jj = 16 * J + fr; const float cj = __shfl(cum, jj); float pv[4];
#pragma unroll
      for (int r = 0; r < 4; ++r) { const int ii = 16 * I + 4 * fq + r; const float ci = __shfl(cum, ii); const float dec = __expf(ci - cj);
        if (isq) pv[r] = (jj <= ii) ? acc[r] * dec : 0.f;
        else { pv[r] = (jj < ii) ? acc[r] * dec * bL[ii] : 0.f; if (I == J) Md[I * 256 + (4 * fq + r) * 16 + fr] = pv[r]; } }
      u32x2 o; o.x = pk2(pv[0], pv[1]); o.y = pk2(pv[2], pv[3]);
      *(LAS u32x2*)((isq ? At : Mt) + jj * LDP + 16 * I + 4 * fq) = o;
    }
    f32x4 o2 = (f32x4){0.f, 0.f, 0.f, 0.f};
#pragma unroll
    for (int k = 0; k < 4; ++k) o2 = mma16(frag_row(Sr, LDN, 16 * vt, 32 * k, lane), frag_row(Qs, LDN, 16 * it, 32 * k, lane), o2);
    __syncthreads();
    if (w < 2) { const LAS float* M = Md + w * 256; const int c = lane & 15;
      float m[16];
#pragma unroll
      for (int q4 = 0; q4 < 4; ++q4) { const f32x4 t4 = *(const LAS f32x4*)(M + c * 16 + 4 * q4); m[4 * q4] = t4[0]; m[4 * q4 + 1] = t4[1]; m[4 * q4 + 2] = t4[2]; m[4 * q4 + 3] = t4[3]; }
      float T[16];
#pragma unroll
      for (int r = 0; r < 16; ++r) { float v = (r == c) ? 1.f : 0.f;
#pragma unroll
        for (int s2 = 0; s2 < r; ++s2) v -= __builtin_bit_cast(float, __builtin_amdgcn_readlane(__builtin_bit_cast(int, m[s2]), r)) * T[s2];
        T[r] = v; }
      if (lane < 16) { LAS u32x4* dst = (LAS u32x4*)(Tt + w * 32 * LDT + c * LDT);
        dst[0] = (u32x4){pk2(T[0], T[1]), pk2(T[2], T[3]), pk2(T[4], T[5]), pk2(T[6], T[7])};
        dst[1] = (u32x4){pk2(T[8], T[9]), pk2(T[10], T[11]), pk2(T[12], T[13]), pk2(T[14], T[15])}; } }
    __syncthreads();
    for (int ct = w; ct < 10; ct += 4) {
      const int cc = 16 * ct + fr;
      f32x4 rhs;
#pragma unroll
      for (int r = 0; r < 4; ++r) { const int ii = 4 * fq + r; const float bi = bL[ii];
        rhs[r] = ct < 2 ? bi * bf2f(Vs[ii * LDP + cc]) : bi * __expf(__shfl(cum, ii)) * bf2f(Ks[ii * LDN + cc - 32]); }
      { u32x2 o; o.x = pk2(rhs[0], rhs[1]); o.y = pk2(rhs[2], rhs[3]); *(LAS u32x2*)(Rw + fr * LDP + 4 * fq) = o; }
      asm volatile("s_waitcnt lgkmcnt(0)" ::: "memory");
      f32x4 x0 = mma16(frag_tr(Tt, LDT, 0, 0, lane), frag_row(Rw, LDP, 0, 0, lane), (f32x4){0.f, 0.f, 0.f, 0.f});
      { u32x2 o; o.x = pk2(x0[0], x0[1]); o.y = pk2(x0[2], x0[3]); *(LAS u32x2*)(Xt + cc * LDP + 4 * fq) = o; }
#pragma unroll
      for (int r = 0; r < 4; ++r) { const int ii = 16 + 4 * fq + r; const float bi = bL[ii];
        rhs[r] = ct < 2 ? bi * bf2f(Vs[ii * LDP + cc]) : bi * __expf(__shfl(cum, ii)) * bf2f(Ks[ii * LDN + cc - 32]); }
      asm volatile("s_waitcnt lgkmcnt(0)" ::: "memory");
      { bf16x8 fa = frag_tr(Mt, LDP, 0, 16, lane); if (fq >= 2) fa = (bf16x8){0, 0, 0, 0, 0, 0, 0, 0};
        bf16x8 fb = frag_row(Xt, LDP, 16 * ct, 0, lane); if (fq >= 2) fb = (bf16x8){0, 0, 0, 0, 0, 0, 0, 0};
        const f32x4 corr = mma16(fa, fb, (f32x4){0.f, 0.f, 0.f, 0.f});
        rhs = rhs - corr; }
      { u32x2 o; o.x = pk2(rhs[0], rhs[1]); o.y = pk2(rhs[2], rhs[3]); *(LAS u32x2*)(Rw + fr * LDP + 4 * fq) = o; }
      asm volatile("s_waitcnt lgkmcnt(0)" ::: "memory");
      f32x4 x1 = mma16(frag_tr(Tt + 32 * LDT, LDT, 0, 0, lane), frag_row(Rw, LDP, 0, 0, lane), (f32x4){0.f, 0.f, 0.f, 0.f});
      { u32x2 o; o.x = pk2(x1[0], x1[1]); o.y = pk2(x1[2], x1[3]); *(LAS u32x2*)(Xt + cc * LDP + 16 + 4 * fq) = o; }
    }
    __syncthreads();
    { f32x4 ws = (f32x4){0.f, 0.f, 0.f, 0.f};
#pragma unroll
      for (int k = 0; k < 4; ++k) ws = mma16(frag_tr(Xt + 32 * LDP, LDP, 32 * k, 16 * it, lane), frag_row(Sr, LDN, 16 * vt, 32 * k, lane), ws);
      const u32x2 uu = *(const LAS u32x2*)(Xt + (16 * vt + fr) * LDP + 16 * it + 4 * fq);
      float vn[4] = {bflo(uu.x) - ws[0], bfhi(uu.x) - ws[1], bflo(uu.y) - ws[2], bfhi(uu.y) - ws[3]};
      float vw[4];
#pragma unroll
      for (int r = 0; r < 4; ++r) vw[r] = vn[r] * __expf(cum_last - __shfl(cum, 16 * it + 4 * fq + r));
      u32x2 o; o.x = pk2(vn[0], vn[1]); o.y = pk2(vn[2], vn[3]); *(LAS u32x2*)(Vn + (16 * vt + fr) * LDP + 16 * it + 4 * fq) = o;
      o.x = pk2(vw[0], vw[1]); o.y = pk2(vw[2], vw[3]); *(LAS u32x2*)(Vw + (16 * vt + fr) * LDP + 16 * it + 4 * fq) = o; }
    __syncthreads();
    { const f32x4 o1 = mma16(frag_row(Vn, LDP, 16 * vt, 0, lane), frag_tr(At, LDP, 0, 16 * it, lane), (f32x4){0.f, 0.f, 0.f, 0.f});
      const int ii = 16 * it + fr; const float eci = __expf(__shfl(cum, ii)); const int t = d ? 31 - ii : ii; const bool first = (d == 0) == fwd_first32(chunk);
      bf16_t* op = MIX + (size_t)(row0 + t) * MIXW + outc + 16 * vt + 4 * fq;
      float o0 = o1[0] + eci * o2[0], o1v = o1[1] + eci * o2[1], o2v = o1[2] + eci * o2[2], o3 = o1[3] + eci * o2[3];
      if (!first) { const unsigned long long pv = ld_agent_u64(op); const unsigned lo = (unsigned)pv, hi = (unsigned)(pv >> 32); o0 += bflo(lo); o1v += bfhi(lo); o2v += bflo(hi); o3 += bfhi(hi); }
      u32x2 o; o.x = pk2(o0, o1v); o.y = pk2(o2v, o3); *(u32x2*)op = o; }
    { const float el = __expf(cum_last);
#pragma unroll
      for (int a = 0; a < 2; ++a) { const int kt = 2 * w + a; const bf16x8 fa = frag_tr(Ks, LDN, 0, 16 * kt, lane);
#pragma unroll
        for (int c = 0; c < 2; ++c) { f32x4 acc = mma16(fa, frag_row(Vw, LDP, 16 * c, 0, lane), Sacc[a][c] * el);
          Sacc[a][c] = acc;
          u32x2 o; o.x = pk2(acc[0], acc[1]); o.y = pk2(acc[2], acc[3]);
          *(LAS u32x2*)(Sw + (16 * c + fr) * LDN + 16 * kt + 4 * fq) = o; } } }
    __syncthreads();
  }
}
__device__ __forceinline__ void phase_chain1(const Params& P, const Ctx& C) {
  for (int task = C.bid; task < 128; task += C.nblk) gdn_chain_wg(P, C, task);
  __builtin_amdgcn_sched_barrier(0);
  for (int task = C.bid < 128 ? C.bid + C.nblk : C.bid; task < 256; task += C.nblk) hgrn_chain_wg(P, C, task - 128);
}
__device__ __forceinline__ void phase_onorm(const Params& P, const Ctx& C) {
  bf16_t* MIX = WS(OFF_MIX1, bf16_t); bf16_t* U = WS(OFF_U1B, bf16_t);
  const float* m1 = WS(OFF_MOD, float) + (size_t)5 * 6144;
  for (int r = C.gw; r < R; r += C.ngw) {
    const int b = r / TB, pos = r % TB; if (pos < CTXL) continue;
#pragma unroll
    for (int half = 0; half < 2; ++half) {
      const float* gn = half ? GIN(I_HNG) : GIN(I_GNG);
#pragma unroll
      for (int j = 0; j < 4; ++j) { const int e = 4 * C.lane + 256 * j; bf16_t* p = MIX + (size_t)r * MIXW + half * 1024 + e;
        const u32x2 a = *(const u32x2*)p; const float o0 = bflo(a.x), o1 = bfhi(a.x), o2 = bflo(a.y), o3 = bfhi(a.y);
        const float ss = half_sum32((o0 * o0 + o1 * o1) + (o2 * o2 + o3 * o3)); const float rs = rsqrtf(ss * (1.f / 128.f) + RMS_EPS);
        const f32x4 g = *(const f32x4*)(gn + (e & 127));
        u32x2 w; w.x = pk2(o0 * rs * g[0], o1 * rs * g[1]); w.y = pk2(o2 * rs * g[2], o3 * rs * g[3]); *(u32x2*)p = w; }
    }
    f32x4 h[4], u[4]; row_load(GOUT + ((size_t)b * SEQ + (pos - CTXL)) * D, C.lane, h);
    row_modulate(h, m1 + (size_t)b * 6144, m1 + (size_t)b * 6144 + D, C.lane, u);
    row_store_bf16(U + (size_t)r * D, C.lane, u);
  }
  LAS float* scr = (LAS float*)C.lds + C.wave * (64 * 33);
  convert_experts(P, 1, WS(OFF_WE1, bf16_t), WS(OFF_WE1 + 64 * MiB, bf16_t), C, scr);
}
__device__ __forceinline__ void phase_gates(const Params& P, const Ctx& C) {
  pg8::Gemm g{WS(OFF_U1B, bf16_t), WS(OFF_WG1, bf16_t), D, D}; pg8::GridOrder S; S.init(128, 8, C.nblk, C.bid, 1);
  pg8::EpiGateMul E{WS(OFF_MIX1, bf16_t), MIXW};
  pg8::gemm_phase(C.lds, g, S, E);
}

__global__ void __launch_bounds__(NT, 2) fwd_megakernel(Params Pk) {
  extern __shared__ __attribute__((aligned(16))) unsigned char lds_raw[];
  cg::grid_group grid = cg::this_grid();
#ifndef PHASE_MASK
#define PHASE_MASK 0xFFFFFFFFu
#endif
#define SYNC() do { __syncthreads(); grid.sync(); } while (0)
#define LAUNDER() const Params* pp; { unsigned long long a_ = (unsigned long long)__builtin_amdgcn_kernarg_segment_ptr(); asm volatile("" : "+s"(a_)); \
    const unsigned lo_ = __builtin_amdgcn_readfirstlane((unsigned)a_), hi_ = __builtin_amdgcn_readfirstlane((unsigned)(a_ >> 32)); \
    pp = (const Params*)(const __attribute__((address_space(4))) Params*)(((unsigned long long)hi_ << 32) | lo_); } \
  Ctx C; { int t_ = threadIdx.x; asm volatile("" : "+v"(t_)); t_ &= 511; int b_ = blockIdx.x; asm volatile("" : "+s"(b_)); b_ = __builtin_amdgcn_readfirstlane(b_); int g_ = gridDim.x; asm volatile("" : "+s"(g_)); g_ = __builtin_amdgcn_readfirstlane(g_); \
    C.lds = (LAS unsigned char*)lds_raw; C.tid = t_; C.lane = t_ & 63; C.wave = __builtin_amdgcn_readfirstlane(t_ >> 6); \
    C.bid = b_; C.nblk = g_; C.gw = b_ * NWAVES + C.wave; C.ngw = g_ * NWAVES; }
#define WSP(off, T) ((T*)(GAS T*)(pp->ws + (off)))
  if (PHASE_MASK & (1u << 0)) { LAUNDER(); phase0(*pp, C); } SYNC();
  if (PHASE_MASK & (1u << 1)) { LAUNDER(); phase_u0(*pp, C); } SYNC();
  if (PHASE_MASK & (1u << 2)) { LAUNDER(); phase_inproj(*pp, C, WSP(OFF_U0, bf16_t), WSP(OFF_WAB, bf16_t), WSP(OFF_Z0, bf16_t), Z0W); } SYNC();
  if (PHASE_MASK & (1u << 3)) { LAUNDER(); phase_feat0(*pp, C); } SYNC();
  if (PHASE_MASK & (1u << 4)) { LAUNDER(); phase_chain0(*pp, C); } SYNC();
  if (PHASE_MASK & (1u << 5)) { LAUNDER(); phase_ssdfin(*pp, C); } SYNC();
  if (PHASE_MASK & (1u << 6)) { LAUNDER(); phase_outproj(*pp, C, 0); } SYNC();
  if (PHASE_MASK & (1u << 7)) { LAUNDER(); phase_lnmix(*pp, C, 0); } SYNC();
  if (PHASE_MASK & (1u << 8)) { LAUNDER(); phase_dispatch(*pp, C, 0); } SYNC();
  if (PHASE_MASK & (1u << 9)) { LAUNDER(); phase_moe1(*pp, C, 0); } SYNC();
  if (PHASE_MASK & (1u << 10)) { LAUNDER(); phase_moe2(*pp, C, 0); } SYNC();
  if (PHASE_MASK & (1u << 11)) { LAUNDER(); phase_lnffn(*pp, C, 0); } SYNC();
  if (PHASE_MASK & (1u << 12)) { LAUNDER(); phase_inproj(*pp, C, WSP(OFF_U1, bf16_t), WSP(OFF_WCD, bf16_t), WSP(OFF_Z1, bf16_t), Z1W); } SYNC();
  if (PHASE_MASK & (1u << 13)) { LAUNDER(); phase_feat1(*pp, C); } SYNC();
  if (PHASE_MASK & (1u << 14)) { LAUNDER(); phase_chain1(*pp, C); } SYNC();
  if (PHASE_MASK & (1u << 15)) { LAUNDER(); phase_onorm(*pp, C); } SYNC();
  if (PHASE_MASK & (1u << 16)) { LAUNDER(); phase_gates(*pp, C); } SYNC();
  if (PHASE_MASK & (1u << 17)) { LAUNDER(); phase_outproj(*pp, C, 1); } SYNC();
  if (PHASE_MASK & (1u << 18)) { LAUNDER(); phase_lnmix(*pp, C, 1); } SYNC();
  if (PHASE_MASK & (1u << 19)) { LAUNDER(); phase_dispatch(*pp, C, 1); } SYNC();
  if (PHASE_MASK & (1u << 20)) { LAUNDER(); phase_moe1(*pp, C, 1); } SYNC();
  if (PHASE_MASK & (1u << 21)) { LAUNDER(); phase_moe2(*pp, C, 1); } SYNC();
  if (PHASE_MASK & (1u << 22)) { LAUNDER(); phase_lnffn(*pp, C, 1); }
}

extern "C" void kernel_launch(void* const* d_in, const int* in_sizes, int n_in, void* d_out, int out_size,
                              void* d_ws, size_t ws_size, hipStream_t stream) {
  static int grid_blocks = 0;
  if (!grid_blocks) {
    int dev = 0, cus = 0, per_cu = 0;
    (void)hipGetDevice(&dev);
    (void)hipDeviceGetAttribute(&cus, hipDeviceAttributeMultiprocessorCount, dev);
    (void)hipFuncSetAttribute((const void*)fwd_megakernel, hipFuncAttributeMaxDynamicSharedMemorySize, LDS_BYTES);
    (void)hipOccupancyMaxActiveBlocksPerMultiprocessor(&per_cu, (const void*)fwd_megakernel, NT, LDS_BYTES);
    if (per_cu < 1) per_cu = 1;
    grid_blocks = cus * 1;
    fprintf(stderr, "grid %d (cus %d per_cu %d) ws_size %zu need %zu n_in %d\n", grid_blocks, cus, per_cu, ws_size, (size_t)WS_NEED, n_in);
    if (ws_size < WS_NEED || n_in != 39) { fprintf(stderr, "kernel_launch: workspace too small or unexpected inputs\n"); grid_blocks = -1; }
  }
  if (grid_blocks < 0) return;
  Params p{};
  for (int i = 0; i < 39; ++i) p.in[i] = (const float*)d_in[i];
  p.out = (float*)d_out; p.ws = (unsigned char*)d_ws;
  void* args[] = {&p};
  hipError_t e = hipLaunchCooperativeKernel((const void*)fwd_megakernel, dim3(grid_blocks), dim3(NT), args, LDS_BYTES, stream);
  if (e != hipSuccess) fprintf(stderr, "cooperative launch failed: %s (grid %d)\n", hipGetErrorString(e), grid_blocks);
}
```

```cpp
#include <hip/hip_runtime.h>
#include <hip/hip_cooperative_groups.h>
#include <cstdio>
#include <cstdint>
namespace cg = cooperative_groups;

#define LAS __attribute__((address_space(3)))
typedef unsigned short bf16_t;
typedef short bf16x8 __attribute__((ext_vector_type(8)));
typedef float f32x4 __attribute__((ext_vector_type(4)));
typedef float f32x2 __attribute__((ext_vector_type(2)));
typedef unsigned u32x4 __attribute__((ext_vector_type(4)));
typedef unsigned u32x2 __attribute__((ext_vector_type(2)));

constexpr int D = 1024, NB = 4, SEQ = 8192, CTXL = 256, TB = SEQ + CTXL  , R = NB * TB  , RLAT = NB * SEQ;
constexpr int NT = 512, NWAVES = 8;
constexpr int LDS_BYTES = 163840;
constexpr int AB_IN = 4640, CD_IN = 9248;
constexpr int Z0W = 4608, Z1W = 7168, MIXW = 2048;
constexpr int NEXP = 32, DEXP = 512, MOE_BLK = 256, MAX_BLKS = 304, MAX_SLOTS = 296 * 256;
constexpr float ALPHA = 1.41421356237309515f;
constexpr float LN_EPS = 1e-5f, RMS_EPS = 1e-6f;
constexpr int Z0_RGX = 0, Z0_RGY = 1024, Z0_SSDZ = 2048, Z0_XBC = 3072, Z0_B = 4096, Z0_C = 4352;
constexpr int Z1_Q = 0, Z1_K = 1024, Z1_V = 2048, Z1_HQ = 3072, Z1_HF = 4096, Z1_HI = 6144;

constexpr size_t MiB = 1u << 20;
constexpr size_t OFF_CTL = 0;
constexpr size_t OFF_MOD = 64 * 1024;
constexpr size_t OFF_LB1 = 320 * 1024;
constexpr size_t OFF_ROUTE = 512 * 1024;
constexpr size_t OFF_SLOTW = 2 * MiB;
constexpr size_t OFF_DT = 3 * MiB;
constexpr size_t OFF_HCTX = 8 * MiB;
constexpr size_t OFF_TCTX = 12 * MiB;
constexpr size_t OFF_WOUT0 = 16 * MiB, OFF_WOUT1 = 20 * MiB, OFF_WG1 = 24 * MiB, OFF_WAB = 28 * MiB;
constexpr size_t OFF_A = 40 * MiB;
constexpr size_t OFF_Z0 = OFF_A, OFF_MIX0 = OFF_A + 297 * MiB, OFF_WE0 = OFF_A + 429 * MiB, OFF_U0 = OFF_A + 525 * MiB;
constexpr size_t OFF_AM0 = OFF_A, OFF_HM0 = OFF_A + 148 * MiB, OFF_YM0 = OFF_A + 222 * MiB;
constexpr size_t OFF_Z1 = OFF_A, OFF_U1 = OFF_A + 462 * MiB, OFF_WCD = OFF_A + 528 * MiB, OFF_MIX1 = OFF_A + 462 * MiB;
constexpr size_t OFF_WE1 = OFF_A, OFF_U1B = OFF_A + 96 * MiB, OFF_AM1 = OFF_A + 96 * MiB, OFF_HM1 = OFF_A + 244 * MiB, OFF_YM1 = OFF_A + 318 * MiB, OFF_V1 = OFF_A + 470 * MiB;
constexpr size_t WS_NEED = OFF_A + 594 * MiB;
static_assert((size_t)R * Z0W * 2 <= 297 * MiB && (size_t)R * MIXW * 2 <= 132 * MiB && (size_t)R * Z1W * 2 <= 462 * MiB && (size_t)R * D * 2 <= 66 * MiB, "ws map");
static_assert((size_t)MAX_SLOTS * D * 2 <= 148 * MiB && (size_t)MAX_SLOTS * DEXP * 2 <= 74 * MiB, "ws map moe");
static_assert(OFF_DT + (size_t)R * 32 * 4 <= OFF_HCTX && OFF_ROUTE + (size_t)R * 32 <= OFF_SLOTW && OFF_SLOTW + MAX_SLOTS * 4 <= OFF_DT, "ws map small");

struct Params { const float* in[39]; float* out; unsigned char* ws; };
enum { I_X = 0, I_C, I_CTX, I_CCTX, I_HLB, I_ADAW, I_ADAB, I_LNMG, I_LNMB, I_LNFG, I_LNFB, I_OUTW, I_RGW, I_RGB, I_REW, I_REB, I_EWG, I_EWU, I_EWD,
       I_ABW, I_RGCW, I_RGCB, I_RGAW, I_RGAB, I_RGXW, I_RGXB, I_RGLAM, I_SCW, I_SCB, I_SALOG, I_SDTB, I_SD, I_SNG, I_CDW, I_GCW, I_GALOG, I_GDTB, I_GNG, I_HNG };

__device__ __forceinline__ unsigned f2bf(float f) { unsigned u = __float_as_uint(f); return (u + 0x7fffu + ((u >> 16) & 1u)) >> 16; }
__device__ __forceinline__ float bf2f(unsigned b) { return __uint_as_float(b << 16); }
typedef __bf16 bf16x2v_t __attribute__((ext_vector_type(2)));
__device__ __forceinline__ unsigned pk2(float lo, float hi) { const f32x2 v = {lo, hi}; const bf16x2v_t r = __builtin_convertvector(v, bf16x2v_t); return __builtin_bit_cast(unsigned, r); }
__device__ __forceinline__ float bflo(unsigned w) { return __uint_as_float(w << 16); }
__device__ __forceinline__ float bfhi(unsigned w) { return __uint_as_float(w & 0xffff0000u); }
__device__ __forceinline__ float sigmoidf_(float x) { return 1.f / (1.f + __expf(-x)); }
__device__ __forceinline__ float siluf_(float x) { return x / (1.f + __expf(-x)); }
__device__ __forceinline__ float softplusf_(float x) { return x > 20.f ? x : log1pf(__expf(x)); }
__device__ __forceinline__ float geluf_(float x) { const float u = 0.7978845608028654f * (x + 0.044715f * x * x * x); return 0.5f * x * (1.f + tanhf(u)); }
__device__ __forceinline__ float wave_sum(float v) {
#pragma unroll
  for (int o = 1; o < 64; o <<= 1) v += __shfl_xor(v, o);
  return v;
}
__device__ __forceinline__ float half_sum32(float v) {
#pragma unroll
  for (int o = 1; o < 32; o <<= 1) v += __shfl_xor(v, o);
  return v;
}
__device__ __forceinline__ int row_batch(int r) { return r / TB; }

namespace pg8 {
constexpr int BM = 256, BK = 64, HALF = 128, HTB = HALF * BK * 2, STAGE_BYTES = 8 * HTB, NXCD = 8, WGM = 8;
__host__ __device__ __forceinline__ int lds_byte(int r, int c) { const int st = (r >> 4) * 2 + (c >> 5), rr = r & 15, cc = c & 31, ob = rr * 64 + cc * 2; return st * 1024 + (ob ^ (((ob >> 9) & 1) << 5)); }
__host__ __device__ __forceinline__ void stage_rc(int b, int& Rr, int& C) { const int st = b / 1024, sb = b % 1024, swz = sb ^ (((sb >> 9) & 1) << 5); Rr = (st >> 1) * 16 + swz / 64; C = (st & 1) * 32 + (swz % 64) / 2; }
__host__ __device__ __forceinline__ int perm32(int rho) { const int n = rho >> 4, i = rho & 15; return 8 * (i >> 2) + 4 * n + (i & 3); }
struct Unit { int pm, pn; };
struct Gemm { const bf16_t* A; const bf16_t* Bt; int lda, K; };

struct GridOrder {
  int nM, nN, nwg, G, c, skipctx;
  __device__ void init(int nM_, int nN_, int G_, int c_, int skipctx_) { nM = nM_; nN = nN_; nwg = nM * nN; G = G_; c = c_; skipctx = skipctx_; }
  __device__ bool next(int i, Unit& u) const {
    const long L = (long)i * G + c; if (L >= nwg) return false;
    int wgid = (int)L; { const int q = nwg / NXCD, r = nwg % NXCD, xcd = wgid % NXCD, off = wgid / NXCD; wgid = (xcd < r ? xcd * (q + 1) : r * (q + 1) + (xcd - r) * q) + off; }
    const int nig = WGM * nN, gid = wgid / nig, fm = gid * WGM, gsz = (nM - fm) < WGM ? (nM - fm) : WGM;
    int pm = fm + ((wgid % nig) % gsz); u.pn = (wgid % nig) / gsz;
    if (skipctx) pm = (pm >> 5) * 33 + 1 + (pm & 31);
    u.pm = pm; return true;
  }
};
struct MoeOrder {
  const int* blk_e; int nunits, G, c;
  __device__ bool next(int i, Unit& u) const {
    const long L = (long)i * G + c; if (L >= nunits) return false;
    const int blk = (int)(L >> 2), j = (int)(L & 3);
    u.pm = blk; u.pn = blk_e[blk] * 4 + j; return true;
  }
};

__device__ __forceinline__ unsigned cvt_pk_bf16(float lo, float hi) { return pk2(lo, hi); }

template <class Epi, class Sched>
__device__ __forceinline__ void gemm_phase(LAS unsigned char* lds, const Gemm g, const Sched& S, const Epi& E) {
  int tid_ = threadIdx.x; asm volatile("" : "+v"(tid_)); tid_ &= 511; const int tid = tid_, wid = __builtin_amdgcn_readfirstlane(tid >> 6), lane = tid & 63, wr = wid >> 2, wc = wid & 3, fr = lane & 15, fq = lane >> 4;
  const int K = g.K, nt = K / BK, lda = g.lda;
  unsigned voffA[2], voffB[2];
#pragma unroll
  for (int i = 0; i < 2; ++i) { int Rr, C; stage_rc(tid * 16 + i * 8192, Rr, C); const int Rb = Epi::PERM ? ((Rr & ~31) + perm32(Rr & 31)) : Rr;
    voffA[i] = (unsigned)(Rr * lda + C) * 2u; voffB[i] = (unsigned)(Rb * K + C) * 2u; }
  const size_t kstep = (size_t)(BK * 2);
  const size_t hstepA = (size_t)HALF * lda * 2, hstepB = (size_t)HALF * K * 2;
  const size_t tstepA = 2 * hstepA, tstepB = 2 * hstepB;
  const unsigned ldsw = (unsigned)wid * 1024u;
  const int aoff = lds_byte(wr * 64 + fr, fq * 8), boff = lds_byte(wc * 32 + fr, fq * 8);
#define PG8_SA(b, h) (((b) * 2 + (h)) * HTB)
#define PG8_SB(b, h) ((4 + (b) * 2 + (h)) * HTB)
#define PG8_STAGE(bufoff, gbase, voff) do { _Pragma("unroll") for (int _i = 0; _i < 2; ++_i) \
    __builtin_amdgcn_global_load_lds((const unsigned*)((const char*)(gbase) + (voff)[_i]), (LAS unsigned*)(lds + (bufoff) + ldsw + _i * 8192), 16, 0, 0); } while (0)
#define PG8_LDA(dst, b, h) do { _Pragma("unroll") for (int m = 0; m < 4; ++m) _Pragma("unroll") for (int k = 0; k < 2; ++k) dst[m][k] = *(const LAS bf16x8*)(lds + PG8_SA(b, h) + aoff + m * 2048 + k * 1024); } while (0)
#define PG8_LDB(dst, b, h) do { _Pragma("unroll") for (int n = 0; n < 2; ++n) _Pragma("unroll") for (int k = 0; k < 2; ++k) dst[n][k] = *(const LAS bf16x8*)(lds + PG8_SB(b, h) + boff + n * 2048 + k * 1024); } while (0)
#define PG8_MMA(ai, bj, At, Bt) do { __builtin_amdgcn_s_setprio(1); _Pragma("unroll") for (int m = 0; m < 4; ++m) _Pragma("unroll") for (int n = 0; n < 2; ++n) _Pragma("unroll") for (int k = 0; k < 2; ++k) \
    acc[ai][bj][m][n] = __builtin_amdgcn_mfma_f32_16x16x32_bf16(Bt[n][k], At[m][k], acc[ai][bj][m][n], 0, 0, 0); __builtin_amdgcn_s_setprio(0); } while (0)
#define PG8_WAIT_V(n) asm volatile("s_waitcnt vmcnt(" #n ")" ::: "memory")
#define PG8_WAIT_L(n) asm volatile("s_waitcnt lgkmcnt(" #n ")" ::: "memory")
#define PG8_BAR __builtin_amdgcn_s_barrier()
#define PG8_SCHED __builtin_amdgcn_sched_barrier(0)
  Unit cur, nxt; int ui = 0;
  if (!S.next(0, cur)) return;
  f32x4 acc[2][2][4][2];
#pragma unroll
  for (int a = 0; a < 2; ++a)
#pragma unroll
    for (int b = 0; b < 2; ++b)
#pragma unroll
      for (int m = 0; m < 4; ++m)
#pragma unroll
        for (int n = 0; n < 2; ++n) acc[a][b][m][n] = (f32x4){0.f, 0.f, 0.f, 0.f};
  bf16x8 At[4][2], B0[2][2], B1[2][2];
  const char* cA = (const char*)g.A + (size_t)cur.pm * tstepA; const char* cB = (const char*)g.Bt + (size_t)cur.pn * tstepB;
  PG8_STAGE(PG8_SB(0, 0), cB, voffB); PG8_STAGE(PG8_SA(0, 0), cA, voffA); PG8_STAGE(PG8_SB(0, 1), cB + hstepB, voffB); PG8_STAGE(PG8_SA(0, 1), cA + hstepA, voffA);
  if (wr == 1) PG8_BAR;
  PG8_WAIT_V(4); PG8_BAR;
  PG8_STAGE(PG8_SB(1, 0), cB + kstep, voffB); PG8_STAGE(PG8_SA(1, 0), cA + kstep, voffA); PG8_STAGE(PG8_SB(1, 1), cB + hstepB + kstep, voffB);
  PG8_WAIT_V(6); PG8_BAR;
  for (;;) {
    const bool has_next = S.next(ui + 1, nxt);
    const char* nA = has_next ? (const char*)g.A + (size_t)nxt.pm * tstepA : cA; const char* nB = has_next ? (const char*)g.Bt + (size_t)nxt.pn * tstepB : cB;
    for (int t = 0; t < nt; t += 2) {
      const bool last = (t == nt - 2);
      const char* a1 = cA + (size_t)(t + 1) * kstep;
      const char* a2 = last ? nA : cA + (size_t)(t + 2) * kstep; const char* b2 = last ? nB : cB + (size_t)(t + 2) * kstep;
      const char* a3 = a2 + kstep; const char* b3 = b2 + kstep;
      PG8_LDB(B0, 0, 0); PG8_SCHED; PG8_LDA(At, 0, 0); PG8_STAGE(PG8_SA(1, 1), a1 + hstepA, voffA);
      PG8_WAIT_L(8); PG8_BAR; PG8_WAIT_L(0); PG8_MMA(0, 0, At, B0); PG8_BAR; PG8_SCHED;
      PG8_LDB(B1, 0, 1); PG8_STAGE(PG8_SB(0, 0), b2, voffB);
      PG8_BAR; PG8_WAIT_L(0); PG8_MMA(0, 1, At, B1); PG8_BAR;
      PG8_LDA(At, 0, 1); PG8_STAGE(PG8_SA(0, 0), a2, voffA);
      PG8_BAR; PG8_WAIT_L(0); PG8_MMA(1, 0, At, B0); PG8_BAR; PG8_SCHED;
      PG8_STAGE(PG8_SB(0, 1), b2 + hstepB, voffB);
      PG8_WAIT_V(6); PG8_BAR; PG8_MMA(1, 1, At, B1); PG8_BAR;
      PG8_LDB(B0, 1, 0); PG8_SCHED; PG8_LDA(At, 1, 0); PG8_STAGE(PG8_SA(0, 1), a2 + hstepA, voffA);
      PG8_WAIT_L(8); PG8_BAR; PG8_WAIT_L(0); PG8_MMA(0, 0, At, B0); PG8_BAR; PG8_SCHED;
      PG8_LDB(B1, 1, 1); PG8_STAGE(PG8_SB(1, 0), b3, voffB);
      PG8_BAR; PG8_WAIT_L(0); PG8_MMA(0, 1, At, B1); PG8_BAR;
      PG8_LDA(At, 1, 1); PG8_STAGE(PG8_SA(1, 0), a3, voffA);
      PG8_BAR; PG8_WAIT_L(0); PG8_MMA(1, 0, At, B0); PG8_BAR; PG8_SCHED;
      PG8_STAGE(PG8_SB(1, 1), b3 + hstepB, voffB);
      PG8_WAIT_V(6); PG8_BAR; PG8_MMA(1, 1, At, B1); PG8_BAR;
    }
    E(acc, cur, wr, wc, fr, fq);
    if (!has_next) break;
#pragma unroll
    for (int a = 0; a < 2; ++a)
#pragma unroll
      for (int b = 0; b < 2; ++b)
#pragma unroll
        for (int m = 0; m < 4; ++m)
#pragma unroll
          for (int n = 0; n < 2; ++n) acc[a][b][m][n] = (f32x4){0.f, 0.f, 0.f, 0.f};
    cur = nxt; cA = nA; cB = nB; ++ui;
  }
  PG8_WAIT_V(0);
  if (wr == 0) PG8_BAR;
  PG8_BAR;
#undef PG8_SA
#undef PG8_SB
#undef PG8_STAGE
#undef PG8_LDA
#undef PG8_LDB
#undef PG8_MMA
#undef PG8_WAIT_V
#undef PG8_WAIT_L
#undef PG8_BAR
#undef PG8_SCHED
}

struct EpiBf16 {
  static constexpr bool PERM = true;
  bf16_t* O; int ldc;
  __device__ __forceinline__ void operator()(const f32x4 (&acc)[2][2][4][2], const Unit& u, int wr, int wc, int fr, int fq) const {
    const int row0 = u.pm * BM + wr * 64 + fr, col0 = u.pn * BM + wc * 32 + 8 * fq;
#pragma unroll
    for (int ai = 0; ai < 2; ++ai)
#pragma unroll
      for (int m = 0; m < 4; ++m) { bf16_t* rowp = O + (size_t)(row0 + ai * HALF + m * 16) * ldc + col0;
#pragma unroll
        for (int bj = 0; bj < 2; ++bj) { const f32x4 v0 = acc[ai][bj][m][0], v1 = acc[ai][bj][m][1];
          u32x4 w; w.x = cvt_pk_bf16(v0[0], v0[1]); w.y = cvt_pk_bf16(v0[2], v0[3]); w.z = cvt_pk_bf16(v1[0], v1[1]); w.w = cvt_pk_bf16(v1[2], v1[3]);
          *(u32x4*)(rowp + bj * HALF) = w; } }
  }
};
struct EpiResid {
  static constexpr bool PERM = false;
  const float* hlat; const float* hctx; float* tlat; float* tctx; const float* gate;
  __device__ __forceinline__ void operator()(const f32x4 (&acc)[2][2][4][2], const Unit& u, int wr, int wc, int fr, int fq) const {
    const int b = u.pm / 33, tt = u.pm % 33; const bool isctx = (tt == 0);
    const float* hs = isctx ? hctx + (size_t)b * CTXL * D : hlat + ((size_t)b * SEQ + (size_t)(tt - 1) * 256) * D;
    float* td = isctx ? tctx + (size_t)b * CTXL * D : tlat + ((size_t)b * SEQ + (size_t)(tt - 1) * 256) * D;
    const float* gt = gate + (size_t)(isctx ? 4 : b) * 6144;
    const int lrow0 = wr * 64 + fr, col0 = u.pn * BM + wc * 32 + 4 * fq;
#pragma unroll
    for (int bj = 0; bj < 2; ++bj)
#pragma unroll
      for (int n = 0; n < 2; ++n) { const f32x4 gvv = *(const f32x4*)(gt + col0 + bj * HALF + n * 16);
#pragma unroll
        for (int ai = 0; ai < 2; ++ai) {
#pragma unroll
          for (int m = 0; m < 4; ++m) { const size_t off = (size_t)(lrow0 + ai * HALF + m * 16) * D + col0 + bj * HALF + n * 16;
            const f32x4 hv = *(const f32x4*)(hs + off);
            *(f32x4*)(td + off) = hv * ALPHA + gvv * acc[ai][bj][m][n]; }
          asm volatile("" ::: "memory"); } }
  }
};
struct EpiGateMul {
  static constexpr bool PERM = true;
  bf16_t* O; int ldc;
  __device__ __forceinline__ void operator()(const f32x4 (&acc)[2][2][4][2], const Unit& u, int wr, int wc, int fr, int fq) const {
    const int row0 = u.pm * BM + wr * 64 + fr, col0 = u.pn * BM + wc * 32 + 8 * fq;
#pragma unroll
    for (int ai = 0; ai < 2; ++ai)
#pragma unroll
      for (int m = 0; m < 4; ++m) { bf16_t* rowp = O + (size_t)(row0 + ai * HALF + m * 16) * ldc + col0;
#pragma unroll
        for (int bj = 0; bj < 2; ++bj) { const f32x4 v0 = acc[ai][bj][m][0], v1 = acc[ai][bj][m][1];
          const u32x4 o = *(const u32x4*)(rowp + bj * HALF);
          u32x4 w;
          w.x = cvt_pk_bf16(bflo(o.x) * siluf_(v0[0]), bfhi(o.x) * siluf_(v0[1])); w.y = cvt_pk_bf16(bflo(o.y) * siluf_(v0[2]), bfhi(o.y) * siluf_(v0[3]));
          w.z = cvt_pk_bf16(bflo(o.z) * siluf_(v1[0]), bfhi(o.z) * siluf_(v1[1])); w.w = cvt_pk_bf16(bflo(o.w) * siluf_(v1[2]), bfhi(o.w) * siluf_(v1[3]));
          *(u32x4*)(rowp + bj * HALF) = w; } }
  }
};
struct EpiSwiGLU {
  static constexpr bool PERM = true;
  bf16_t* H;
  __device__ __forceinline__ void operator()(const f32x4 (&acc)[2][2][4][2], const Unit& u, int wr, int wc, int fr, int fq) const {
    const int row0 = u.pm * BM + wr * 64 + fr, col0 = (u.pn & 3) * 128 + wc * 32 + 8 * fq;
#pragma unroll
    for (int ai = 0; ai < 2; ++ai)
#pragma unroll
      for (int m = 0; m < 4; ++m) { bf16_t* rowp = H + (size_t)(row0 + ai * HALF + m * 16) * DEXP + col0;
        const f32x4 g0 = acc[ai][0][m][0], g1 = acc[ai][0][m][1], u0 = acc[ai][1][m][0], u1 = acc[ai][1][m][1];
        u32x4 w; w.x = cvt_pk_bf16(siluf_(g0[0]) * u0[0], siluf_(g0[1]) * u0[1]); w.y = cvt_pk_bf16(siluf_(g0[2]) * u0[2], siluf_(g0[3]) * u0[3]);
        w.z = cvt_pk_bf16(siluf_(g1[0]) * u1[0], siluf_(g1[1]) * u1[1]); w.w = cvt_pk_bf16(siluf_(g1[2]) * u1[2], siluf_(g1[3]) * u1[3]);
        *(u32x4*)rowp = w; }
  }
};
struct EpiMoeDown {
  static constexpr bool PERM = true;
  bf16_t* Y; const float* slotw;
  __device__ __forceinline__ void operator()(const f32x4 (&acc)[2][2][4][2], const Unit& u, int wr, int wc, int fr, int fq) const {
    const int row0 = u.pm * BM + wr * 64 + fr, col0 = (u.pn & 3) * BM + wc * 32 + 8 * fq;
#pragma unroll
    for (int ai = 0; ai < 2; ++ai)
#pragma unroll
      for (int m = 0; m < 4; ++m) { const int row = row0 + ai * HALF + m * 16; const float sw = slotw[row]; bf16_t* rowp = Y + (size_t)row * D + col0;
#pragma unroll
        for (int bj = 0; bj < 2; ++bj) { const f32x4 v0 = acc[ai][bj][m][0] * sw, v1 = acc[ai][bj][m][1] * sw;
          u32x4 w; w.x = cvt_pk_bf16(v0[0], v0[1]); w.y = cvt_pk_bf16(v0[2], v0[3]); w.z = cvt_pk_bf16(v1[0], v1[1]); w.w = cvt_pk_bf16(v1[2], v1[3]);
          *(u32x4*)(rowp + bj * HALF) = w; } }
  }
};
}

struct Ctx {
  LAS unsigned char* lds; int tid, lane, wave, gw, ngw, bid, nblk;
};
#define GAS __attribute__((address_space(1)))
#define WS(off, T) ((T*)(GAS T*)(P.ws + (off)))
#define GIN(i) ((const float*)(const GAS float*)P.in[i])
#define GOUT ((float*)(GAS float*)P.out)

__device__ __forceinline__ void transpose_item(const float* W, int ldw, int col0, int k0, bf16_t* dst_row0, int ldd, LAS float* scr, int lane) {
#pragma unroll 8
  for (int i = 0; i < 32; ++i) { const int kk = 2 * i + (lane >> 5); scr[kk * 33 + (lane & 31)] = W[(size_t)(k0 + kk) * ldw + col0 + (lane & 31)]; }
  asm volatile("s_waitcnt lgkmcnt(0)" ::: "memory");
  const int c = lane & 7;
#pragma unroll
  for (int j = 0; j < 4; ++j) { const int n = (lane >> 3) + 8 * j; const LAS float* s = scr + (8 * c) * 33 + n;
    u32x4 o; o.x = pk2(s[0 * 33], s[1 * 33]); o.y = pk2(s[2 * 33], s[3 * 33]); o.z = pk2(s[4 * 33], s[5 * 33]); o.w = pk2(s[6 * 33], s[7 * 33]);
    *(u32x4*)(dst_row0 + (size_t)n * ldd + k0 + 8 * c) = o; }
  asm volatile("s_waitcnt lgkmcnt(0)" ::: "memory");
}
__device__ __forceinline__ void transpose_mat_item(const float* W, int ldw, int col0, int K, int ncols, bf16_t* dst, int ldd, int gu, int it, LAS float* scr, int lane) {
  const int nblk = ncols / 32, kb = it / nblk, nb = it % nblk, n0 = 32 * nb;
  const int drow = gu ? (256 * (n0 >> 7) + (n0 & 127) + (gu == 2 ? 128 : 0)) : n0;
  transpose_item(W, ldw, col0 + n0, 64 * kb, dst + (size_t)drow * ldd, ldd, scr, lane);
}
__device__ __forceinline__ void convert_experts(const Params& P, int layer, bf16_t* wgu, bf16_t* wd, const Ctx& C, LAS float* scr) {
  for (int it = C.gw; it < NEXP * 768; it += C.ngw) {
    const int e = it / 768, r = it % 768;
    const size_t eoff = ((size_t)layer * NEXP + e) * (size_t)D * DEXP;
    if (r < 256) transpose_mat_item(GIN(I_EWG) + eoff, DEXP, 0, D, DEXP, wgu + (size_t)e * 1024 * D, D, 1, r, scr, C.lane);
    else if (r < 512) transpose_mat_item(GIN(I_EWU) + eoff, DEXP, 0, D, DEXP, wgu + (size_t)e * 1024 * D, D, 2, r - 256, scr, C.lane);
    else transpose_mat_item(GIN(I_EWD) + eoff, D, 0, DEXP, D, wd + (size_t)e * D * DEXP, DEXP, 0, r - 512, scr, C.lane);
  }
}

__device__ __forceinline__ void row_load(const float* row, int lane, f32x4 (&v)[4]) {
#pragma unroll
  for (int j = 0; j < 4; ++j) v[j] = *(const f32x4*)(row + 4 * lane + 256 * j);
}
__device__ __forceinline__ void row_store(float* row, int lane, const f32x4 (&v)[4]) {
#pragma unroll
  for (int j = 0; j < 4; ++j) *(f32x4*)(row + 4 * lane + 256 * j) = v[j];
}
__device__ __forceinline__ void row_store_bf16(bf16_t* row, int lane, const f32x4 (&v)[4]) {
#pragma unroll
  for (int j = 0; j < 4; ++j) { u32x2 w; w.x = pk2(v[j][0], v[j][1]); w.y = pk2(v[j][2], v[j][3]); *(u32x2*)(row + 4 * lane + 256 * j) = w; }
}
__device__ __forceinline__ void row_layernorm(f32x4 (&v)[4], const float* g, const float* b, int lane) {
  float s = 0.f;
#pragma unroll
  for (int j = 0; j < 4; ++j) s += (v[j][0] + v[j][1]) + (v[j][2] + v[j][3]);
  const float mean = wave_sum(s) * (1.f / D); float s2 = 0.f;
#pragma unroll
  for (int j = 0; j < 4; ++j) { v[j] = v[j] - mean; s2 += (v[j][0] * v[j][0] + v[j][1] * v[j][1]) + (v[j][2] * v[j][2] + v[j][3] * v[j][3]); }
  const float rstd = rsqrtf(wave_sum(s2) * (1.f / D) + LN_EPS);
#pragma unroll
  for (int j = 0; j < 4; ++j) { const f32x4 gg = *(const f32x4*)(g + 4 * lane + 256 * j), bb = *(const f32x4*)(b + 4 * lane + 256 * j); v[j] = v[j] * rstd * gg + bb; }
}
__device__ __forceinline__ void row_modulate(const f32x4 (&h)[4], const float* shift, const float* scale, int lane, f32x4 (&u)[4]) {
#pragma unroll
  for (int j = 0; j < 4; ++j) { const f32x4 sh = *(const f32x4*)(shift + 4 * lane + 256 * j), sc = *(const f32x4*)(scale + 4 * lane + 256 * j); u[j] = h[j] * (sc + 1.f) + sh; }
}
__device__ __forceinline__ void row_dot32(const f32x4 (&u)[4], const LAS float* Wt, int lane, float* out32) {
  float myv = 0.f;
#pragma unroll 4
  for (int c = 0; c < 32; ++c) {
    float s = 0.f;
#pragma unroll
    for (int j = 0; j < 4; ++j) { const f32x4 w = *(const LAS f32x4*)(Wt + c * 1024 + 4 * lane + 256 * j); s += (u[j][0] * w[0] + u[j][1] * w[1]) + (u[j][2] * w[2] + u[j][3] * w[3]); }
    s = wave_sum(s);
    if (lane == c) myv = s;
  }
  if (lane < 32) out32[lane] = myv;
}
__device__ __forceinline__ void stage_cols32(const float* W, int ldw, int col0, LAS float* Wt, int tid) {
  for (int i = tid; i < 1024 * 32; i += NT) { const int k = i >> 5, c = i & 31; Wt[c * 1024 + k] = W[(size_t)k * ldw + col0 + c]; }
}
__device__ __forceinline__ const float* lat_or_ctx(const float* lat, const float* ctxp, int r) {
  const int b = r / TB, pos = r % TB;
  return pos < CTXL ? ctxp + ((size_t)b * CTXL + pos) * D : lat + ((size_t)b * SEQ + (pos - CTXL)) * D;
}
__device__ __forceinline__ float* lat_or_ctx_w(float* lat, float* ctxp, int r) {
  const int b = r / TB, pos = r % TB;
  return pos < CTXL ? ctxp + ((size_t)b * CTXL + pos) * D : lat + ((size_t)b * SEQ + (pos - CTXL)) * D;
}
__device__ __forceinline__ int row_b5(int r) { const int b = r / TB, pos = r % TB; return pos < CTXL ? 4 : b; }

__device__ __forceinline__ void phase0(const Params& P, const Ctx& C) {
  LAS float* sv = (LAS float*)C.lds;
  LAS float* part = (LAS float*)(C.lds + 20480);
  LAS float* scr = (LAS float*)(C.lds + 32768) + C.wave * (64 * 33);
  for (int i = C.tid; i < 5 * 1024; i += NT) { const float x = i < 4096 ? GIN(I_C)[i] : GIN(I_CCTX)[i - 4096]; sv[i] = siluf_(x); }
  __syncthreads();
  float* MOD = WS(OFF_MOD, float);
  for (int task = C.bid; task < 2 * 96; task += C.nblk) {
    const int l = task / 96, n0 = (task % 96) * 64;
    const float* W = GIN(I_ADAW) + (size_t)l * D * 6144 + n0 + C.lane;
    float acc[5] = {0.f, 0.f, 0.f, 0.f, 0.f};
    const int kbeg = C.wave * 128;
#pragma unroll 8
    for (int k = kbeg; k < kbeg + 128; ++k) { const float w = W[(size_t)k * 6144];
#pragma unroll
      for (int r = 0; r < 5; ++r) acc[r] += sv[r * 1024 + k] * w; }
#pragma unroll
    for (int r = 0; r < 5; ++r) part[(C.wave * 5 + r) * 64 + C.lane] = acc[r];
    __syncthreads();
    if (C.tid < 320) { const int r = C.tid / 64, c = C.tid % 64; float s = GIN(I_ADAB)[l * 6144 + n0 + c];
#pragma unroll
      for (int w = 0; w < 8; ++w) s += part[(w * 5 + r) * 64 + c];
      MOD[((size_t)l * 5 + r) * 6144 + n0 + c] = s; }
    __syncthreads();
  }
  if (C.bid == C.nblk - 1) { float* LB = WS(OFF_LB1, float); for (int i = C.tid; i < 1024; i += NT) { const float a = GIN(I_HLB)[i], b = GIN(I_HLB)[1024 + i]; LB[i] = 1.f / (1.f + __expf(a - b)); } }
  constexpr int N_AB = 16 * 144, N_OUT = 32 * 32, N_G1 = 16 * 32;
  constexpr int TOT = N_AB + 2 * N_OUT + 2 * N_G1;
  for (int it = C.gw; it < TOT; it += C.ngw) {
    int r = it;
    if (r < N_AB) { transpose_mat_item(GIN(I_ABW), AB_IN, 0, D, Z0W, WS(OFF_WAB, bf16_t), D, 0, r, scr, C.lane); continue; } r -= N_AB;
    if (r < N_OUT) { transpose_mat_item(GIN(I_OUTW), D, 0, 2048, D, WS(OFF_WOUT0, bf16_t), 2048, 0, r, scr, C.lane); continue; } r -= N_OUT;
    if (r < N_OUT) { transpose_mat_item(GIN(I_OUTW) + (size_t)2048 * D, D, 0, 2048, D, WS(OFF_WOUT1, bf16_t), 2048, 0, r, scr, C.lane); continue; } r -= N_OUT;
    if (r < N_G1) { transpose_mat_item(GIN(I_CDW), CD_IN, 3072, D, 1024, WS(OFF_WG1, bf16_t), D, 0, r, scr, C.lane); continue; } r -= N_G1;
    transpose_mat_item(GIN(I_CDW), CD_IN, 8224, D, 1024, WS(OFF_WG1, bf16_t) + (size_t)1024 * D, D, 0, r, scr, C.lane);
  }
  convert_experts(P, 0, WS(OFF_WE0, bf16_t), WS(OFF_WE0 + 64 * MiB, bf16_t), C, scr);
}

__device__ __forceinline__ void phase_u0(const Params& P, const Ctx& C) {
  LAS float* Wt = (LAS float*)C.lds;
  stage_cols32(GIN(I_ABW), AB_IN, 4608, Wt, C.tid);
  __syncthreads();
  const float* MOD = WS(OFF_MOD, float); bf16_t* U = WS(OFF_U0, bf16_t); float* DT = WS(OFF_DT, float);
  for (int r = C.gw; r < R; r += C.ngw) {
    f32x4 h[4], u[4]; row_load(lat_or_ctx(GIN(I_X), GIN(I_CTX), r), C.lane, h);
    const float* m = MOD + (size_t)row_b5(r) * 6144;
    row_modulate(h, m, m + D, C.lane, u);
    row_store_bf16(U + (size_t)r * D, C.lane, u);
    row_dot32(u, Wt, C.lane, DT + (size_t)r * 32);
  }
}

__device__ __forceinline__ void phase_inproj(const Params& P, const Ctx& C, const bf16_t* U, const bf16_t* W, bf16_t* Z, int zw) {
  pg8::Gemm g{U, W, D, D}; pg8::GridOrder S; S.init(R / 256, zw / 256, C.nblk, C.bid, 0);
  pg8::EpiBf16 E{Z, zw};
  pg8::gemm_phase(C.lds, g, S, E);
}

__device__ __forceinline__ void conv_task(bf16_t* Z, int zw, int row0, int L, int col, const float* cw, int cwld, int cch, const float* cb, int mode, float qscale, int lane) {
  float w[4][2];
#pragma unroll
  for (int j = 0; j < 4; ++j) { w[j][0] = cw[j * cwld + cch + 2 * lane]; w[j][1] = cw[j * cwld + cch + 2 * lane + 1]; }
  const float b0 = cb ? cb[cch + 2 * lane] : 0.f, b1 = cb ? cb[cch + 2 * lane + 1] : 0.f;
  unsigned* base = (unsigned*)(Z + (size_t)row0 * zw + col) + lane;
  const size_t rs = (size_t)zw / 2;
  float pm2[2] = {0.f, 0.f}, pm1[2] = {0.f, 0.f};
  for (int t0 = 0; t0 < L; t0 += 16) {
    unsigned v[17];
#pragma unroll
    for (int i = 0; i < 16; ++i) v[i] = base[(size_t)(t0 + i) * rs];
    v[16] = (t0 + 16 < L) ? base[(size_t)(t0 + 16) * rs] : 0u;
    unsigned o[16];
#pragma unroll
    for (int i = 0; i < 16; ++i) {
      const float x0 = bflo(v[i]), x1 = bfhi(v[i]), n0 = bflo(v[i + 1]), n1 = bfhi(v[i + 1]);
      float y0 = w[0][0] * pm2[0] + w[1][0] * pm1[0] + w[2][0] * x0 + w[3][0] * n0 + b0;
      float y1 = w[0][1] * pm2[1] + w[1][1] * pm1[1] + w[2][1] * x1 + w[3][1] * n1 + b1;
      pm2[0] = pm1[0]; pm2[1] = pm1[1]; pm1[0] = x0; pm1[1] = x1;
      if (mode >= 1) { y0 = siluf_(y0); y1 = siluf_(y1); }
      if (mode == 2) { const float ss = wave_sum(y0 * y0 + y1 * y1); const float sc = rsqrtf(ss + RMS_EPS) * qscale; y0 *= sc; y1 *= sc; }
      o[i] = pk2(y0, y1);
    }
#pragma unroll
    for (int i = 0; i < 16; ++i) base[(size_t)(t0 + i) * rs] = o[i];
  }
}
__device__ __forceinline__ void seg_rows(int seg, int& row0, int& L) {
  const int b = seg / 129, s = seg % 129;
  if (s == 0) { row0 = b * TB; L = CTXL; } else { row0 = b * TB + CTXL + (s - 1) * 64; L = 64; }
}
__device__ __forceinline__ void phase_feat0(const Params& P, const Ctx& C) {
  bf16_t* Z = WS(OFF_Z0, bf16_t);
  for (int task = C.gw; task < NB * 129 * 20; task += C.ngw) {
    const int seg = task / 20, cg = task % 20; int row0, L; seg_rows(seg, row0, L);
    if (cg < 8) conv_task(Z, Z0W, row0, L, Z0_RGX + cg * 128, GIN(I_RGCW), 1024, cg * 128, GIN(I_RGCB), 0, 1.f, C.lane);
    else conv_task(Z, Z0W, row0, L, Z0_XBC + (cg - 8) * 128, GIN(I_SCW), 1536, (cg - 8) * 128, GIN(I_SCB), 1, 1.f, C.lane);
  }
}
__device__ __forceinline__ void phase_feat1(const Params& P, const Ctx& C) {
  bf16_t* Z = WS(OFF_Z1, bf16_t);
  for (int task = C.gw; task < NB * 129 * 24; task += C.ngw) {
    const int seg = task / 24, cg = task % 24; int row0, L; seg_rows(seg, row0, L);
    if (cg < 16) conv_task(Z, Z1W, row0, L, cg * 128, GIN(I_GCW), 3072, cg * 128, nullptr, 2, cg < 8 ? 0.08838834764831845f : 1.f, C.lane);
    else conv_task(Z, Z1W, row0, L, cg * 128, GIN(I_GCW), 3072, cg * 128, nullptr, 1, 1.f, C.lane);
  }
}

__device__ __forceinline__ int seq_pos(int dir, int j) { return dir == 0 ? j : (j < CTXL ? CTXL - 1 - j : TB - 1 - (j - CTXL)); }
__device__ __forceinline__ int seq_chunk(int dir, int j) { return dir == 0 ? j : (j < 4 ? 3 - j : 135 - j); }

__device__ __forceinline__ void rg_task(const Params& P, const Ctx& C, int task) {
  const int b = task >> 6, h = (task >> 3) & 7, q = task & 7;
  LAS float* Wl = (LAS float*)C.lds;
  LAS float* xc = Wl + 2 * 2 * 128 * 16;
  LAS float* SA = xc + 64 * 129;
  LAS float* SU = SA + 16 * 64;
  const bf16_t* Z = WS(OFF_Z0, bf16_t); bf16_t* MIX = WS(OFF_MIX0, bf16_t);
  __syncthreads();
  for (int i = C.tid; i < 2 * 2 * 128 * 16; i += NT) { const int j = i & 15, ii = (i >> 4) & 127, gate = (i >> 11) & 1, d = i >> 12;
    const float* W = (gate ? GIN(I_RGXW) : GIN(I_RGAW)) + ((size_t)(d * 8 + h) * 128 + ii) * 128 + q * 16 + j; Wl[i] = *W; }
  const int j = C.tid & 15, tg = C.tid >> 4;
  const int ch = h * 128 + q * 16 + j;
  const int sch = C.wave * 2;
  for (int d = 0; d < 2; ++d) {
    const float ba = GIN(I_RGAB)[d * 1024 + ch], bx = GIN(I_RGXB)[d * 1024 + ch], spl = softplusf_(-GIN(I_RGLAM)[d * 1024 + ch]);
    float hin0 = 0.f, hin1 = 0.f;
    for (int cs = 0; cs < 132; ++cs) {
      const int chunk = seq_chunk(d, cs), row0 = b * TB + chunk * 64;
      __syncthreads();
      { const int t = C.tid >> 3, sg = C.tid & 7; const u32x4* src = (const u32x4*)(Z + (size_t)(row0 + t) * Z0W + Z0_RGX + h * 128 + sg * 16);
        const u32x4 a = src[0], bb = src[1]; LAS float* dst = xc + t * 129 + sg * 16;
        dst[0] = bflo(a.x); dst[1] = bfhi(a.x); dst[2] = bflo(a.y); dst[3] = bfhi(a.y); dst[4] = bflo(a.z); dst[5] = bfhi(a.z); dst[6] = bflo(a.w); dst[7] = bfhi(a.w);
        dst[8] = bflo(bb.x); dst[9] = bfhi(bb.x); dst[10] = bflo(bb.y); dst[11] = bfhi(bb.y); dst[12] = bflo(bb.z); dst[13] = bfhi(bb.z); dst[14] = bflo(bb.w); dst[15] = bfhi(bb.w); }
      __syncthreads();
      { const LAS float* Wa = Wl + (d * 2 + 0) * 2048 + j; const LAS float* Wx = Wl + (d * 2 + 1) * 2048 + j;
        const LAS float* x0 = xc + (2 * tg) * 129; const LAS float* x1 = x0 + 129;
        float aa0 = 0.f, aa1 = 0.f, ax0 = 0.f, ax1 = 0.f;
#pragma unroll 8
        for (int i = 0; i < 128; ++i) { const float wa = Wa[i * 16], wx = Wx[i * 16], v0 = x0[i], v1 = x1[i]; aa0 += v0 * wa; aa1 += v1 * wa; ax0 += v0 * wx; ax1 += v1 * wx; }
#pragma unroll
        for (int tt = 0; tt < 2; ++tt) { const int t = 2 * tg + tt; const float pa = tt ? aa1 : aa0, px = tt ? ax1 : ax0;
          const float r = sigmoidf_(pa + ba), ig = sigmoidf_(px + bx); const float la = -8.f * r * spl; const float xv = xc[t * 129 + q * 16 + j];
          SA[j * 64 + t] = __expf(la); SU[j * 64 + t] = sqrtf(-expm1f(2.f * la)) * (ig * xv); } }
      __syncthreads();
#pragma unroll
      for (int cc = 0; cc < 2; ++cc) {
        const int lc = sch + cc; const int t = d == 0 ? C.lane : 63 - C.lane;
        float A = SA[lc * 64 + t], Bv = SU[lc * 64 + t];
#pragma unroll
        for (int off = 1; off < 64; off <<= 1) { const float Ap = __shfl_up(A, off), Bp = __shfl_up(Bv, off); if (C.lane >= off) { Bv = A * Bp + Bv; A = A * Ap; } }
        const float hin = cc ? hin1 : hin0; const float hv = Bv + A * hin;
        const float hlast = __shfl(hv, 63); if (cc) hin1 = hlast; else hin0 = hlast;
        const int gch = h * 128 + q * 16 + lc; bf16_t* o = MIX + (size_t)(row0 + t) * MIXW + gch;
        if (d == 0) *o = (bf16_t)f2bf(hv);
        else { const float hf = bf2f(*o); const float gy = bf2f(Z[(size_t)(row0 + t) * Z0W + Z0_RGY + gch]); *o = (bf16_t)f2bf((hf + hv) * geluf_(gy)); }
      }
    }
    __threadfence_block();
  }
}
__device__ __forceinline__ void ssd_task(const Params& P, const Ctx& C, int task) {
  const int b = task >> 9, hd = (task >> 5) & 15, ps = task & 31, g = hd >> 3;
  const int c = C.lane >> 5, ng = C.lane & 31;
  const bf16_t* Z = WS(OFF_Z0, bf16_t); bf16_t* MIX = WS(OFF_MIX0, bf16_t); const float* DT = WS(OFF_DT, float);
  const int colx = Z0_XBC + hd * 64 + 2 * ps + c, colB = Z0_B + g * 128 + 4 * ng, colC = Z0_C + g * 128 + 4 * ng, outc = 1024 + hd * 64 + 2 * ps + c;
  for (int d = 0; d < 2; ++d) {
    const float Aneg = -__expf(GIN(I_SALOG)[d * 16 + hd]), dtb = GIN(I_SDTB)[d * 16 + hd];
    float S0 = 0.f, S1 = 0.f, S2 = 0.f, S3 = 0.f;
    for (int j0 = 0; j0 < TB; j0 += 8) {
      u32x2 Bv[8], Cv[8]; unsigned short xv[8], yp[8]; float dtr[8];
#pragma unroll
      for (int u = 0; u < 8; ++u) { const size_t row = (size_t)b * TB + seq_pos(d, j0 + u);
        Bv[u] = *(const u32x2*)(Z + row * Z0W + colB); Cv[u] = *(const u32x2*)(Z + row * Z0W + colC); xv[u] = Z[row * Z0W + colx]; dtr[u] = DT[row * 32 + d * 16 + hd];
        yp[u] = d ? MIX[row * MIXW + outc] : (unsigned short)0; }
#pragma unroll
      for (int u = 0; u < 8; ++u) { const size_t row = (size_t)b * TB + seq_pos(d, j0 + u);
        const float dt = softplusf_(dtr[u] + dtb), a = __expf(Aneg * dt), xdt = bf2f(xv[u]) * dt;
        S0 = a * S0 + bflo(Bv[u].x) * xdt; S1 = a * S1 + bfhi(Bv[u].x) * xdt; S2 = a * S2 + bflo(Bv[u].y) * xdt; S3 = a * S3 + bfhi(Bv[u].y) * xdt;
        float y = (bflo(Cv[u].x) * S0 + bfhi(Cv[u].x) * S1) + (bflo(Cv[u].y) * S2 + bfhi(Cv[u].y) * S3);
        y = half_sum32(y);
        if (ng == 0) MIX[row * MIXW + outc] = (bf16_t)f2bf(y + bf2f(yp[u])); }
    }
    __threadfence_block();
  }
}

#define LBAR() do { asm volatile("s_waitcnt lgkmcnt(0)" ::: "memory"); __builtin_amdgcn_s_barrier(); asm volatile("" ::: "memory"); } while (0)
#define VMWAIT() asm volatile("s_waitcnt vmcnt(0)" ::: "memory")
typedef short s16x4 __attribute__((ext_vector_type(4)));
__device__ __forceinline__ bf16x8 frag_row(const LAS bf16_t* base, int ld, int r0, int k0, int lane) {
  return *(const LAS bf16x8*)(base + (r0 + (lane & 15)) * ld + k0 + 8 * (lane >> 4));
}
__device__ __forceinline__ bf16x8 frag_tr(const LAS bf16_t* base, int ld, int k0, int n0, int lane) {
  const int g = lane >> 4, q = (lane & 15) >> 2, p = lane & 3;
  const LAS bf16_t* a0 = base + (k0 + 8 * g + q) * ld + n0 + 4 * p;
  const s16x4 v0 = __builtin_amdgcn_ds_read_tr16_b64_v4i16((LAS s16x4*)a0);
  const s16x4 v1 = __builtin_amdgcn_ds_read_tr16_b64_v4i16((LAS s16x4*)(a0 + 4 * ld));
  bf16x8 r; r[0] = v0[0]; r[1] = v0[1]; r[2] = v0[2]; r[3] = v0[3]; r[4] = v1[0]; r[5] = v1[1]; r[6] = v1[2]; r[7] = v1[3];
  return r;
}
__device__ __forceinline__ f32x4 mma16(bf16x8 fa, bf16x8 fb, f32x4 acc) { return __builtin_amdgcn_mfma_f32_16x16x32_bf16(fa, fb, acc, 0, 0, 0); }
__device__ __forceinline__ float wave_incl_scan(float v, int lane) {
#pragma unroll
  for (int off = 1; off < 64; off <<= 1) { const float p = __shfl_up(v, off); if (lane >= off) v += p; }
  return v;
}
__device__ __forceinline__ void tri_tile(int tt, int& I, int& J) { I = tt >= 6 ? 3 : (tt >= 3 ? 2 : (tt >= 1 ? 1 : 0)); J = tt - (I * (I + 1)) / 2; }
__device__ __forceinline__ unsigned long long ld_agent_u64(const void* p) { return __hip_atomic_load((const unsigned long long*)p, __ATOMIC_RELAXED, __HIP_MEMORY_SCOPE_AGENT); }
__device__ __forceinline__ bool fwd_first(int c) { return c < 4 ? (c <= 1) : (c <= 67); }

__device__ __forceinline__ void ssd_chain_wg(const Params& P, const Ctx& C, int task) {
  const int b = task >> 5, hd = (task >> 1) & 15, ps = task & 1, g = hd >> 3;
  const int d = C.wave >> 2, w = C.wave & 3, td = C.tid & 255, lane = C.lane, fr = lane & 15, fq = lane >> 4;
  constexpr int LDN = 136, LDP = 40, LDT = 72;
  constexpr int DIRSZ = 78 * 1024;
  LAS unsigned char* L = C.lds + d * DIRSZ;
  LAS bf16_t* Cs = (LAS bf16_t*)L;
  LAS bf16_t* Bs = Cs + 64 * LDN;
  LAS bf16_t* Xd = Bs + 64 * LDN;
  LAS bf16_t* Xw = Xd + 64 * LDP;
  LAS bf16_t* Pt = Xw + 64 * LDP;
  LAS bf16_t* St = Pt + 64 * LDT;
  LAS float* dtL = (LAS float*)(St + 2 * 32 * LDN);
  const bf16_t* Z = WS(OFF_Z0, bf16_t); bf16_t* MIX = WS(OFF_MIX0, bf16_t); const float* DT = WS(OFF_DT, float);
  const float Aneg = -__expf(GIN(I_SALOG)[d * 16 + hd]), dtb = GIN(I_SDTB)[d * 16 + hd];
  const int colC = Z0_C + g * 128, colB = Z0_B + g * 128, colX = Z0_XBC + hd * 64 + ps * 32, outc = 1024 + hd * 64 + ps * 32;
  __syncthreads();
  for (int i = td; i < 64 * LDT / 2; i += 256) ((LAS unsigned*)Pt)[i] = 0u;
  for (int i = td; i < 2 * 32 * LDN / 2; i += 256) ((LAS unsigned*)St)[i] = 0u;
  f32x4 Sacc[2][2];
#pragma unroll
  for (int a = 0; a < 2; ++a)
#pragma unroll
    for (int c = 0; c < 2; ++c) Sacc[a][c] = (f32x4){0.f, 0.f, 0.f, 0.f};
  const int st_t = td >> 2, st_q = td & 3;
  u32x4 rc[4], rb[4], rx; float rdt = 0.f;
  auto issue_loads = [&](int step) {
    const int chunk = seq_chunk(d, step); const size_t row = (size_t)b * TB + chunk * 64 + st_t;
    const u32x4* pc = (const u32x4*)(Z + row * Z0W + colC + st_q * 32); const u32x4* pb = (const u32x4*)(Z + row * Z0W + colB + st_q * 32);
#pragma unroll
    for (int i = 0; i < 4; ++i) { rc[i] = pc[i]; rb[i] = pb[i]; }
    rx = *(const u32x4*)(Z + row * Z0W + colX + st_q * 8);
    rdt = DT[row * 32 + d * 16 + hd];
  };
  issue_loads(0);
  for (int step = 0; step < 132; ++step) {
    const int chunk = seq_chunk(d, step); const int row0 = b * TB + chunk * 64;
    VMWAIT();
    { const int i = d ? 63 - st_t : st_t; const float dt = softplusf_(rdt + dtb);
      LAS u32x4* dc = (LAS u32x4*)(Cs + i * LDN + st_q * 32); LAS u32x4* db = (LAS u32x4*)(Bs + i * LDN + st_q * 32);
#pragma unroll
      for (int k = 0; k < 4; ++k) { dc[k] = rc[k]; db[k] = rb[k]; }
      u32x4 xo; xo.x = pk2(bflo(rx.x) * dt, bfhi(rx.x) * dt); xo.y = pk2(bflo(rx.y) * dt, bfhi(rx.y) * dt); xo.z = pk2(bflo(rx.z) * dt, bfhi(rx.z) * dt); xo.w = pk2(bflo(rx.w) * dt, bfhi(rx.w) * dt);
      *(LAS u32x4*)(Xd + i * LDP + st_q * 8) = xo;
      if (st_q == 0) dtL[i] = dt; }
    LBAR();
    if (step + 1 < 132) issue_loads(step + 1);
    const bool first = (d == 0) == fwd_first(chunk);
    bf16_t* op0; unsigned long long ppv[2] = {0ull, 0ull};
    { const int ii = 16 * w + fr; const int t = d ? 63 - ii : ii; op0 = MIX + (size_t)(row0 + t) * MIXW + outc + 4 * fq;
      if (!first) { ppv[0] = ld_agent_u64(op0); ppv[1] = ld_agent_u64(op0 + 16); } }
    const float cum = wave_incl_scan(Aneg * dtL[lane], lane);
    const float cum_last = __shfl(cum, 63);
    { const int i = td >> 2; const float sc = __expf(cum_last - __shfl(cum, i & 63));
      const u32x4 v = *(const LAS u32x4*)(Xd + i * LDP + (td & 3) * 8);
      u32x4 o; o.x = pk2(bflo(v.x) * sc, bfhi(v.x) * sc); o.y = pk2(bflo(v.y) * sc, bfhi(v.y) * sc); o.z = pk2(bflo(v.z) * sc, bfhi(v.z) * sc); o.w = pk2(bflo(v.w) * sc, bfhi(v.w) * sc);
      *(LAS u32x4*)(Xw + i * LDP + (td & 3) * 8) = o; }
    for (int tt = w; tt < 10; tt += 4) {
      int I, J; tri_tile(tt, I, J);
      f32x4 acc = (f32x4){0.f, 0.f, 0.f, 0.f};
#pragma unroll
      for (int k = 0; k < 4; ++k) acc = mma16(frag_row(Cs, LDN, 16 * I, 32 * k, lane), frag_row(Bs, LDN, 16 * J, 32 * k, lane), acc);
      const int jj = 16 * J + fr; const float cj = __shfl(cum, jj);
      u32x2 o; float pv[4];
#pragma unroll
      for (int r = 0; r < 4; ++r) { const int ii = 16 * I + 4 * fq + r; const float ci = __shfl(cum, ii); pv[r] = (jj <= ii) ? acc[r] * __expf(ci - cj) : 0.f; }
      o.x = pk2(pv[0], pv[1]); o.y = pk2(pv[2], pv[3]);
      *(LAS u32x2*)(Pt + jj * LDT + 16 * I + 4 * fq) = o;
    }
    LBAR();
    const LAS bf16_t* Sr = St + (step & 1) * 32 * LDN; LAS bf16_t* Sw = St + ((step + 1) & 1) * 32 * LDN;
    { const int I = w; const int nks = I < 2 ? 1 : 2;
      const int ii = 16 * I + fr; const float eci = __expf(__shfl(cum, ii));
#pragma unroll
      for (int pt = 0; pt < 2; ++pt) {
        f32x4 y1 = (f32x4){0.f, 0.f, 0.f, 0.f}, y2 = (f32x4){0.f, 0.f, 0.f, 0.f};
        for (int k = 0; k < nks; ++k) y1 = mma16(frag_tr(Xd, LDP, 32 * k, 16 * pt, lane), frag_tr(Pt, LDT, 32 * k, 16 * I, lane), y1);
#pragma unroll
        for (int k = 0; k < 4; ++k) y2 = mma16(frag_row(Sr, LDN, 16 * pt, 32 * k, lane), frag_row(Cs, LDN, 16 * I, 32 * k, lane), y2);
        bf16_t* op = op0 + 16 * pt;
        float o0 = y1[0] + eci * y2[0], o1 = y1[1] + eci * y2[1], o2 = y1[2] + eci * y2[2], o3 = y1[3] + eci * y2[3];
        if (!first) { const unsigned long long pv = ppv[pt]; const unsigned lo = (unsigned)pv, hi = (unsigned)(pv >> 32); o0 += bflo(lo); o1 += bfhi(lo); o2 += bflo(hi); o3 += bfhi(hi); }
        u32x2 o; o.x = pk2(o0, o1); o.y = pk2(o2, o3); *(u32x2*)op = o;
      } }
    { const float el = __expf(cum_last);
#pragma unroll
      for (int a = 0; a < 2; ++a)
#pragma unroll
        for (int c = 0; c < 2; ++c) { f32x4 acc = Sacc[a][c] * el;
#pragma unroll
          for (int k = 0; k < 2; ++k) acc = mma16(frag_tr(Bs, LDN, 32 * k, 16 * (2 * w + a), lane), frag_tr(Xw, LDP, 32 * k, 16 * c, lane), acc);
          Sacc[a][c] = acc;
          u32x2 o; o.x = pk2(acc[0], acc[1]); o.y = pk2(acc[2], acc[3]);
          *(LAS u32x2*)(Sw + (16 * c + fr) * LDN + 16 * (2 * w + a) + 4 * fq) = o; } }
    LBAR();
  }
}

template <int N> __device__ __forceinline__ float dpp_shr(float oldv, float v) {
  return __builtin_bit_cast(float, __builtin_amdgcn_update_dpp(__builtin_bit_cast(int, oldv), __builtin_bit_cast(int, v), 0x110 + N, 0xf, 0xf, false));
}
__device__ __forceinline__ float fast_sigmoid(float x) { return __builtin_amdgcn_rcpf(1.f + __expf(-x)); }
__device__ __forceinline__ void rg_chain_wg(const Params& P, const Ctx& C, int task) {
  const int b = task >> 5, h = (task >> 2) & 7, q = task & 3;
  const int d = C.wave >> 2, w = C.wave & 3, td = C.tid & 255, lane = C.lane, fr = lane & 15, fq = lane >> 4;
  constexpr int LDN = 136, LDW = 72;
  constexpr int DIRSZ = 40 * 1024;
  LAS unsigned char* L = C.lds + d * DIRSZ;
  LAS bf16_t* Xc = (LAS bf16_t*)L;
  LAS bf16_t* Wl = Xc + 64 * LDN;
  LAS float* Sum = (LAS float*)(Wl + 128 * LDW);
  const bf16_t* Z = WS(OFF_Z0, bf16_t); bf16_t* MIX = WS(OFF_MIX0, bf16_t);
  const int ch0 = h * 128 + q * 32;
  __syncthreads();
#pragma unroll 2
  for (int i = td; i < 128 * 64; i += 256) { const int ii = i >> 6, j = i & 63, gate = j >> 5, jj = j & 31;
    const float* W = (gate ? GIN(I_RGXW) : GIN(I_RGAW)) + ((size_t)(d * 8 + h) * 128 + ii) * 128 + q * 32 + jj; Wl[ii * LDW + j] = (bf16_t)f2bf(*W); }
  float ba[8], bx[8], spl[8], hc[8];
#pragma unroll
  for (int e = 0; e < 8; ++e) { const int c = ch0 + 16 * (e >> 2) + 4 * fq + (e & 3);
    ba[e] = GIN(I_RGAB)[d * 1024 + c]; bx[e] = GIN(I_RGXB)[d * 1024 + c]; spl[e] = -8.f * softplusf_(-GIN(I_RGLAM)[d * 1024 + c]); hc[e] = 0.f; }
  const int st_t = td >> 2, st_p = td & 3;
  u32x4 rx[4];
  auto issue_loads = [&](int step) {
    const int chunk = seq_chunk(d, step); const size_t row = (size_t)b * TB + chunk * 64 + st_t;
    const u32x4* px = (const u32x4*)(Z + row * Z0W + Z0_RGX + h * 128 + st_p * 32);
#pragma unroll
    for (int i = 0; i < 4; ++i) rx[i] = px[i];
  };
  issue_loads(0);
  __syncthreads();
  const int ii = 16 * w + fr;
  const LAS bf16_t* xrow = Xc + ii * LDN + q * 32 + 4 * fq;
  for (int step = 0; step < 132; ++step) {
    const int chunk = seq_chunk(d, step); const int row0 = b * TB + chunk * 64;
    VMWAIT();
    { const int i = d ? 63 - st_t : st_t; LAS u32x4* dx = (LAS u32x4*)(Xc + i * LDN + st_p * 32);
#pragma unroll
      for (int k = 0; k < 4; ++k) dx[k] = rx[k]; }
    LBAR();
    if (step + 1 < 132) issue_loads(step + 1);
    const bool first = (d == 0) == fwd_first(chunk);
    const int t = d ? 63 - ii : ii;
    bf16_t* op = MIX + (size_t)(row0 + t) * MIXW + ch0 + 4 * fq;
    unsigned long long ppv[2] = {0ull, 0ull}; u32x2 gy[2] = {(u32x2){0u, 0u}, (u32x2){0u, 0u}};
    if (!first) { ppv[0] = ld_agent_u64(op); ppv[1] = ld_agent_u64(op + 16);
      const bf16_t* gp = Z + (size_t)(row0 + t) * Z0W + Z0_RGY + ch0 + 4 * fq; gy[0] = *(const u32x2*)gp; gy[1] = *(const u32x2*)(gp + 16); }
    f32x4 ga[2], gx[2];
#pragma unroll
    for (int jt = 0; jt < 2; ++jt) { ga[jt] = (f32x4){0.f, 0.f, 0.f, 0.f}; gx[jt] = (f32x4){0.f, 0.f, 0.f, 0.f}; }
#pragma unroll
    for (int k = 0; k < 4; ++k) { const bf16x8 fb = frag_row(Xc, LDN, 16 * w, 32 * k, lane);
#pragma unroll
      for (int jt = 0; jt < 2; ++jt) { ga[jt] = mma16(frag_tr(Wl, LDW, 32 * k, 16 * jt, lane), fb, ga[jt]); gx[jt] = mma16(frag_tr(Wl, LDW, 32 * k, 32 + 16 * jt, lane), fb, gx[jt]); } }
    float A[8], Bv[8];
#pragma unroll
    for (int jt = 0; jt < 2; ++jt) { const u32x2 xw = *(const LAS u32x2*)(xrow + 16 * jt); const float xv[4] = {bflo(xw.x), bfhi(xw.x), bflo(xw.y), bfhi(xw.y)};
#pragma unroll
      for (int r = 0; r < 4; ++r) { const int e = 4 * jt + r;
        const float rg = fast_sigmoid(ga[jt][r] + ba[e]), ig = fast_sigmoid(gx[jt][r] + bx[e]); const float la = rg * spl[e];
        const float a = __expf(la); A[e] = a; Bv[e] = sqrtf(fmaxf(1.f - a * a, 0.f)) * (ig * xv[r]); } }
#pragma unroll
    for (int e = 0; e < 8; ++e) {
      { const float Ap = dpp_shr<1>(1.f, A[e]), Bp = dpp_shr<1>(0.f, Bv[e]); Bv[e] = A[e] * Bp + Bv[e]; A[e] = A[e] * Ap; }
      { const float Ap = dpp_shr<2>(1.f, A[e]), Bp = dpp_shr<2>(0.f, Bv[e]); Bv[e] = A[e] * Bp + Bv[e]; A[e] = A[e] * Ap; }
      { const float Ap = dpp_shr<4>(1.f, A[e]), Bp = dpp_shr<4>(0.f, Bv[e]); Bv[e] = A[e] * Bp + Bv[e]; A[e] = A[e] * Ap; }
      { const float Ap = dpp_shr<8>(1.f, A[e]), Bp = dpp_shr<8>(0.f, Bv[e]); Bv[e] = A[e] * Bp + Bv[e]; A[e] = A[e] * Ap; } }
    if (fr == 15) {
#pragma unroll
      for (int e = 0; e < 8; ++e) { f32x2 sv; sv[0] = A[e]; sv[1] = Bv[e]; *(LAS f32x2*)(Sum + ((w * 32) + 16 * (e >> 2) + 4 * fq + (e & 3)) * 2) = sv; } }
    LBAR();
    float hin[8];
#pragma unroll
    for (int e = 0; e < 8; ++e) { float hh = hc[e]; const int c = 16 * (e >> 2) + 4 * fq + (e & 3);
#pragma unroll
      for (int tt = 0; tt < 4; ++tt) { const f32x2 sv = *(const LAS f32x2*)(Sum + (tt * 32 + c) * 2); if (tt == w) hin[e] = hh; hh = sv[0] * hh + sv[1]; }
      hc[e] = hh; }
#pragma unroll
    for (int jt = 0; jt < 2; ++jt) { float hv[4];
#pragma unroll
      for (int r = 0; r < 4; ++r) hv[r] = Bv[4 * jt + r] + A[4 * jt + r] * hin[4 * jt + r];
      if (!first) { const unsigned lo = (unsigned)ppv[jt], hi = (unsigned)(ppv[jt] >> 32);
        const float gyv[4] = {bflo(gy[jt].x), bfhi(gy[jt].x), bflo(gy[jt].y), bfhi(gy[jt].y)}; const float pf[4] = {bflo(lo), bfhi(lo), bflo(hi), bfhi(hi)};
#pragma unroll
        for (int r = 0; r < 4; ++r) { const float x = gyv[r]; const float u2 = 1.5957691216057308f * (x + 0.044715f * x * x * x); hv[r] = (hv[r] + pf[r]) * x * fast_sigmoid(u2); } }
      u32x2 o; o.x = pg8::cvt_pk_bf16(hv[0], hv[1]); o.y = pg8::cvt_pk_bf16(hv[2], hv[3]); *(u32x2*)(op + 16 * jt) = o; }
  }
}
__device__ __forceinline__ void phase_chain0(const Params& P, const Ctx& C, int mode) {
  if (mode != 2) for (int task = C.bid; task < 128; task += C.nblk) ssd_chain_wg(P, C, task);
  __builtin_amdgcn_sched_barrier(0);
  if (mode != 1) for (int task = C.bid < 128 ? C.bid + C.nblk : C.bid; task < 256; task += C.nblk) rg_chain_wg(P, C, task - 128);
}
__device__ __forceinline__ void phase_ssdfin(const Params& P, const Ctx& C) {
  const bf16_t* Z = WS(OFF_Z0, bf16_t); bf16_t* MIX = WS(OFF_MIX0, bf16_t);
  for (int r = C.gw; r < R; r += C.ngw) {
    f32x4 y[4];
#pragma unroll
    for (int j = 0; j < 4; ++j) { const int e = 4 * C.lane + 256 * j; const float dsk = GIN(I_SD)[e >> 6];
      const u32x2 ys = *(const u32x2*)(MIX + (size_t)r * MIXW + 1024 + e), xs = *(const u32x2*)(Z + (size_t)r * Z0W + Z0_XBC + e), zz = *(const u32x2*)(Z + (size_t)r * Z0W + Z0_SSDZ + e);
      y[j][0] = (bflo(ys.x) + dsk * bflo(xs.x)) * siluf_(bflo(zz.x)); y[j][1] = (bfhi(ys.x) + dsk * bfhi(xs.x)) * siluf_(bfhi(zz.x));
      y[j][2] = (bflo(ys.y) + dsk * bflo(xs.y)) * siluf_(bflo(zz.y)); y[j][3] = (bfhi(ys.y) + dsk * bfhi(xs.y)) * siluf_(bfhi(zz.y)); }
    float s0 = 0.f, s1 = 0.f;
#pragma unroll
    for (int i = 0; i < 4; ++i) { s0 += y[0][i] * y[0][i] + y[1][i] * y[1][i]; s1 += y[2][i] * y[2][i] + y[3][i] * y[3][i]; }
    const float r0 = rsqrtf(wave_sum(s0) * (1.f / 512.f) + RMS_EPS), r1 = rsqrtf(wave_sum(s1) * (1.f / 512.f) + RMS_EPS);
#pragma unroll
    for (int j = 0; j < 4; ++j) { const int e = 4 * C.lane + 256 * j; const f32x4 gn = *(const f32x4*)(GIN(I_SNG) + e); const float rr = j < 2 ? r0 : r1;
      u32x2 w; w.x = pk2(y[j][0] * rr * gn[0], y[j][1] * rr * gn[1]); w.y = pk2(y[j][2] * rr * gn[2], y[j][3] * rr * gn[3]);
      *(u32x2*)(MIX + (size_t)r * MIXW + 1024 + e) = w; }
  }
}

__device__ __forceinline__ void phase_outproj(const Params& P, const Ctx& C, int layer) {
  const float* MOD = WS(OFF_MOD, float) + (size_t)layer * 5 * 6144;
  pg8::Gemm g{layer ? WS(OFF_MIX1, bf16_t) : WS(OFF_MIX0, bf16_t), layer ? WS(OFF_WOUT1, bf16_t) : WS(OFF_WOUT0, bf16_t), MIXW, MIXW};
  pg8::GridOrder S; if (layer) S.init(128, 4, C.nblk, C.bid, 1); else S.init(132, 4, C.nblk, C.bid, 0);
  pg8::EpiResid E{layer ? GOUT : GIN(I_X), layer ? WS(OFF_HCTX, float) : GIN(I_CTX), GOUT, WS(OFF_TCTX, float), MOD + 2 * D};
  pg8::gemm_phase(C.lds, g, S, E);
}

__device__ __forceinline__ void phase_lnmix(const Params& P, const Ctx& C, int layer) {
  LAS float* Wt = (LAS float*)C.lds;
  { const float* gw = GIN(I_RGW) + (size_t)layer * D * 4; const float* ew = GIN(I_REW) + (size_t)layer * D * 32;
    for (int i = C.tid; i < 1024 * 4; i += NT) { const int k = i >> 2, c = i & 3; Wt[c * 1024 + k] = gw[i]; }
    for (int i = C.tid; i < 1024 * 32; i += NT) { const int k = i >> 5, c = i & 31; Wt[(4 + c) * 1024 + k] = ew[i]; } }
  __syncthreads();
  const float* MOD = WS(OFF_MOD, float) + (size_t)layer * 5 * 6144;
  const float* lng = GIN(I_LNMG) + layer * D; const float* lnb = GIN(I_LNMB) + layer * D;
  const float* rgb = GIN(I_RGB) + layer * 4; const float* reb = GIN(I_REB) + layer * 32;
  bf16_t* V = layer ? WS(OFF_V1, bf16_t) : WS(OFF_U0, bf16_t);
  int* cnt = WS(OFF_CTL, int) + layer * 32; int* route = WS(OFF_ROUTE, int);
  for (int r = C.gw; r < R; r += C.ngw) {
    const int pos = r % TB; if (layer && pos < CTXL) continue;
    float* trow = lat_or_ctx_w(GOUT, WS(OFF_TCTX, float), r);
    float* hrow = lat_or_ctx_w(GOUT, WS(OFF_HCTX, float), r);
    f32x4 h[4], v[4]; row_load(trow, C.lane, h);
    row_layernorm(h, lng, lnb, C.lane);
    row_store(hrow, C.lane, h);
    const float* m = MOD + (size_t)row_b5(r) * 6144;
    row_modulate(h, m + 3 * D, m + 4 * D, C.lane, v);
    row_store_bf16(V + (size_t)r * D, C.lane, v);
    float myv = 0.f;
#pragma unroll 4
    for (int c = 0; c < 36; ++c) { float s = 0.f;
#pragma unroll
      for (int j = 0; j < 4; ++j) { const f32x4 w = *(const LAS f32x4*)(Wt + c * 1024 + 4 * C.lane + 256 * j); s += (v[j][0] * w[0] + v[j][1] * w[1]) + (v[j][2] * w[2] + v[j][3] * w[3]); }
      s = wave_sum(s); if (C.lane == c) myv = s; }
    float lg[4]; int gsel = 0; float gmax;
#pragma unroll
    for (int i = 0; i < 4; ++i) lg[i] = __shfl(myv, i) + rgb[i];
    gmax = lg[0];
#pragma unroll
    for (int i = 1; i < 4; ++i) if (lg[i] > gmax) { gmax = lg[i]; gsel = i; }
    float gden = 0.f;
#pragma unroll
    for (int i = 0; i < 4; ++i) gden += __expf(lg[i] - gmax);
    const float ptg = 1.f / gden;
    float le[8];
#pragma unroll
    for (int i = 0; i < 8; ++i) le[i] = __shfl(myv, 4 + gsel * 8 + i) + reb[gsel * 8 + i];
    int e1 = 0; float m1 = le[0];
#pragma unroll
    for (int i = 1; i < 8; ++i) if (le[i] > m1) { m1 = le[i]; e1 = i; }
    int e2 = -1; float m2 = -3.0e38f;
#pragma unroll
    for (int i = 0; i < 8; ++i) if (i != e1 && le[i] > m2) { m2 = le[i]; e2 = i; }
    const float q2 = __expf(m2 - m1); const float w1 = ptg / (1.f + q2), w2 = ptg * q2 / (1.f + q2);
    if (C.lane == 0) {
      const int E1 = gsel * 8 + e1, E2 = gsel * 8 + e2;
      const int p1 = atomicAdd(cnt + E1, 1), p2 = atomicAdd(cnt + E2, 1);
      int* rr = route + (size_t)r * 8; rr[0] = E1; rr[1] = E2; ((float*)rr)[2] = w1; ((float*)rr)[3] = w2; rr[4] = p1; rr[5] = p2;
    }
  }
}

__device__ __forceinline__ void phase_dispatch(const Params& P, const Ctx& C, int layer) {
  LAS int* base = (LAS int*)C.lds;
  int* ctl = WS(OFF_CTL, int); const int* cnt = ctl + layer * 32;
  if (C.tid == 0) { int acc = 0; for (int e = 0; e < NEXP; ++e) { base[e] = acc; acc += (cnt[e] + 255) >> 8; } base[32] = acc; }
  __syncthreads();
  if (C.bid == 0) { if (C.tid == 0) ctl[64 + layer] = base[32];
    if (C.tid < NEXP) { for (int bk = base[C.tid]; bk < base[C.tid + 1]; ++bk) ctl[128 + layer * MAX_BLKS + bk] = C.tid; } }
  const bf16_t* V = layer ? WS(OFF_V1, bf16_t) : WS(OFF_U0, bf16_t);
  bf16_t* AM = layer ? WS(OFF_AM1, bf16_t) : WS(OFF_AM0, bf16_t);
  float* slotw = WS(OFF_SLOTW, float); int* route = WS(OFF_ROUTE, int);
  for (int r = C.gw; r < R; r += C.ngw) {
    const int pos = r % TB; if (layer && pos < CTXL) continue;
    int* rr = route + (size_t)r * 8;
    const int E1 = rr[0], E2 = rr[1]; const int s1 = base[E1] * 256 + rr[4], s2 = base[E2] * 256 + rr[5];
    const u32x4* src = (const u32x4*)(V + (size_t)r * D);
    const u32x4 a = src[C.lane], b = src[64 + C.lane];
    u32x4* d1 = (u32x4*)(AM + (size_t)s1 * D); u32x4* d2 = (u32x4*)(AM + (size_t)s2 * D);
    d1[C.lane] = a; d1[64 + C.lane] = b; d2[C.lane] = a; d2[64 + C.lane] = b;
    if (C.lane == 0) { rr[6] = s1; rr[7] = s2; slotw[s1] = ((const float*)rr)[2]; slotw[s2] = ((const float*)rr)[3]; }
  }
}
__device__ __forceinline__ void phase_moe1(const Params& P, const Ctx& C, int layer) {
  const int* ctl = WS(OFF_CTL, int);
  pg8::Gemm g{layer ? WS(OFF_AM1, bf16_t) : WS(OFF_AM0, bf16_t), layer ? WS(OFF_WE1, bf16_t) : WS(OFF_WE0, bf16_t), D, D};
  pg8::MoeOrder S{ctl + 128 + layer * MAX_BLKS, ctl[64 + layer] * 4, C.nblk, C.bid};
  pg8::EpiSwiGLU E{layer ? WS(OFF_HM1, bf16_t) : WS(OFF_HM0, bf16_t)};
  pg8::gemm_phase(C.lds, g, S, E);
}
__device__ __forceinline__ void phase_moe2(const Params& P, const Ctx& C, int layer) {
  const int* ctl = WS(OFF_CTL, int);
  pg8::Gemm g{layer ? WS(OFF_HM1, bf16_t) : WS(OFF_HM0, bf16_t), layer ? WS(OFF_WE1 + 64 * MiB, bf16_t) : WS(OFF_WE0 + 64 * MiB, bf16_t), DEXP, DEXP};
  pg8::MoeOrder S{ctl + 128 + layer * MAX_BLKS, ctl[64 + layer] * 4, C.nblk, C.bid};
  pg8::EpiMoeDown E{layer ? WS(OFF_YM1, bf16_t) : WS(OFF_YM0, bf16_t), WS(OFF_SLOTW, float)};
  pg8::gemm_phase(C.lds, g, S, E);
}

__device__ __forceinline__ void phase_lnffn(const Params& P, const Ctx& C, int layer) {
  LAS float* Wt = (LAS float*)C.lds;
  if (layer == 0) { stage_cols32(GIN(I_CDW), CD_IN, 4096, Wt, C.tid); __syncthreads(); }
  const float* MOD = WS(OFF_MOD, float) + (size_t)layer * 5 * 6144;
  const float* lng = GIN(I_LNFG) + layer * D; const float* lnb = GIN(I_LNFB) + layer * D;
  const bf16_t* YM = layer ? WS(OFF_YM1, bf16_t) : WS(OFF_YM0, bf16_t); const int* route = WS(OFF_ROUTE, int);
  for (int r = C.gw; r < R; r += C.ngw) {
    const int pos = r % TB; if (layer && pos < CTXL) continue;
    float* hrow = lat_or_ctx_w(GOUT, WS(OFF_HCTX, float), r);
    const float* m = MOD + (size_t)row_b5(r) * 6144;
    const int* rr = route + (size_t)r * 8; const int s1 = rr[6], s2 = rr[7];
    f32x4 h[4]; row_load(hrow, C.lane, h);
#pragma unroll
    for (int j = 0; j < 4; ++j) { const u32x2 a = *(const u32x2*)(YM + (size_t)s1 * D + 4 * C.lane + 256 * j), b = *(const u32x2*)(YM + (size_t)s2 * D + 4 * C.lane + 256 * j);
      const f32x4 g5 = *(const f32x4*)(m + 5 * D + 4 * C.lane + 256 * j);
      f32x4 f; f[0] = bflo(a.x) + bflo(b.x); f[1] = bfhi(a.x) + bfhi(b.x); f[2] = bflo(a.y) + bflo(b.y); f[3] = bfhi(a.y) + bfhi(b.y);
      h[j] = h[j] * ALPHA + g5 * f; }
    row_layernorm(h, lng, lnb, C.lane);
    row_store(hrow, C.lane, h);
    if (layer == 0) {
      const float* m1 = WS(OFF_MOD, float) + (size_t)(5 + row_b5(r)) * 6144;
      f32x4 u[4]; row_modulate(h, m1, m1 + D, C.lane, u);
      row_store_bf16(WS(OFF_U1, bf16_t) + (size_t)r * D, C.lane, u);
      row_dot32(u, Wt, C.lane, WS(OFF_DT, float) + (size_t)r * 32);
    }
  }
  if (layer == 0) {
    __syncthreads();
    LAS float* scr = (LAS float*)C.lds + C.wave * (64 * 33);
    constexpr int N_A = 16 * 96, N_B = 16 * 128;
    for (int it = C.gw; it < N_A + N_B; it += C.ngw) {
      if (it < N_A) transpose_mat_item(GIN(I_CDW), CD_IN, 0, D, 3072, WS(OFF_WCD, bf16_t), D, 0, it, scr, C.lane);
      else transpose_mat_item(GIN(I_CDW), CD_IN, 4128, D, 4096, WS(OFF_WCD, bf16_t) + (size_t)3072 * D, D, 0, it - N_A, scr, C.lane);
    }
  }
}

__device__ __forceinline__ void gdn_task(const Params& P, const Ctx& C, int task) {
  const int b = task >> 9, h = (task >> 6) & 7, vs = task & 63; const int c = C.lane >> 5, kg = C.lane & 31;
  const bf16_t* Z = WS(OFF_Z1, bf16_t); bf16_t* MIX = WS(OFF_MIX1, bf16_t); const float* DT = WS(OFF_DT, float);
  const int colq = Z1_Q + h * 128 + 4 * kg, colk = Z1_K + h * 128 + 4 * kg, colv = Z1_V + h * 128 + 2 * vs + c, outc = h * 128 + 2 * vs + c;
  for (int d = 0; d < 2; ++d) {
    const float Aneg = -__expf(GIN(I_GALOG)[d * 8 + h]), dtb = GIN(I_GDTB)[d * 8 + h];
    float S0 = 0.f, S1 = 0.f, S2 = 0.f, S3 = 0.f;
    for (int j0 = 0; j0 < TB; j0 += 8) {
      u32x2 qv[8], kv[8]; unsigned short vv[8], yp[8]; float br[8], ar[8];
#pragma unroll
      for (int u = 0; u < 8; ++u) { const size_t row = (size_t)b * TB + seq_pos(d, j0 + u);
        qv[u] = *(const u32x2*)(Z + row * Z1W + colq); kv[u] = *(const u32x2*)(Z + row * Z1W + colk); vv[u] = Z[row * Z1W + colv];
        br[u] = DT[row * 32 + d * 8 + h]; ar[u] = DT[row * 32 + 16 + d * 8 + h]; yp[u] = d ? MIX[row * MIXW + outc] : (unsigned short)0; }
#pragma unroll
      for (int u = 0; u < 8; ++u) { const size_t row = (size_t)b * TB + seq_pos(d, j0 + u);
        const float al = __expf(Aneg * softplusf_(ar[u] + dtb)), be = sigmoidf_(br[u]);
        const float k0 = bflo(kv[u].x), k1 = bfhi(kv[u].x), k2 = bflo(kv[u].y), k3 = bfhi(kv[u].y);
        S0 *= al; S1 *= al; S2 *= al; S3 *= al;
        const float p = half_sum32((k0 * S0 + k1 * S1) + (k2 * S2 + k3 * S3));
        const float dl = be * (bf2f(vv[u]) - p);
        S0 += k0 * dl; S1 += k1 * dl; S2 += k2 * dl; S3 += k3 * dl;
        const float o = half_sum32((bflo(qv[u].x) * S0 + bfhi(qv[u].x) * S1) + (bflo(qv[u].y) * S2 + bfhi(qv[u].y) * S3));
        if (kg == 0) MIX[row * MIXW + outc] = (bf16_t)f2bf(o + bf2f(yp[u])); }
    }
    __threadfence_block();
  }
}
__device__ __forceinline__ void hgrn_task(const Params& P, const Ctx& C, int task) {
  const int b = task >> 9, h = (task >> 6) & 7, vs = task & 63; const int c = C.lane >> 5, kg = C.lane & 31;
  const bf16_t* Z = WS(OFF_Z1, bf16_t); bf16_t* MIX = WS(OFF_MIX1, bf16_t);
  const f32x4 lb = *(const f32x4*)(WS(OFF_LB1, float) + h * 128 + 4 * kg);
  const int colq = Z1_HQ + h * 128 + 4 * kg, colv = Z1_HI + h * 128 + 2 * vs + c, outc = 1024 + h * 128 + 2 * vs + c;
  for (int d = 0; d < 2; ++d) {
    const int colf = Z1_HF + d * 1024 + h * 128 + 4 * kg;
    float S0 = 0.f, S1 = 0.f, S2 = 0.f, S3 = 0.f;
    for (int j0 = 0; j0 < TB; j0 += 8) {
      u32x2 qv[8], fv[8]; unsigned short vv[8], yp[8];
#pragma unroll
      for (int u = 0; u < 8; ++u) { const size_t row = (size_t)b * TB + seq_pos(d, j0 + u);
        qv[u] = *(const u32x2*)(Z + row * Z1W + colq); fv[u] = *(const u32x2*)(Z + row * Z1W + colf); vv[u] = Z[row * Z1W + colv];
        yp[u] = d ? MIX[row * MIXW + outc] : (unsigned short)0; }
#pragma unroll
      for (int u = 0; u < 8; ++u) { const size_t row = (size_t)b * TB + seq_pos(d, j0 + u);
        const float f0 = lb[0] + (1.f - lb[0]) * sigmoidf_(bflo(fv[u].x)), f1 = lb[1] + (1.f - lb[1]) * sigmoidf_(bfhi(fv[u].x));
        const float f2 = lb[2] + (1.f - lb[2]) * sigmoidf_(bflo(fv[u].y)), f3 = lb[3] + (1.f - lb[3]) * sigmoidf_(bfhi(fv[u].y));
        const float v = bf2f(vv[u]);
        S0 = f0 * S0 + (1.f - f0) * v; S1 = f1 * S1 + (1.f - f1) * v; S2 = f2 * S2 + (1.f - f2) * v; S3 = f3 * S3 + (1.f - f3) * v;
        const float o = half_sum32((bflo(qv[u].x) * S0 + bfhi(qv[u].x) * S1) + (bflo(qv[u].y) * S2 + bfhi(qv[u].y) * S3));
        if (kg == 0) MIX[row * MIXW + outc] = (bf16_t)f2bf(o + bf2f(yp[u])); }
    }
    __threadfence_block();
  }
}

__device__ __forceinline__ int seq_chunk32(int dir, int j) { return dir == 0 ? j : (j < 8 ? 7 - j : 271 - j); }
__device__ __forceinline__ bool fwd_first32(int c) { return c < 8 ? (c <= 3) : (c <= 135); }

__device__ __forceinline__ void hgrn_chain_wg(const Params& P, const Ctx& C, int task) {
  const int b = task >> 5, h = (task >> 2) & 7, vs = task & 3;
  const int d = C.wave >> 2, w = C.wave & 3, td = C.tid & 255, lane = C.lane, fr = lane & 15, fq = lane >> 4;
  constexpr int LDN = 136, LDP = 40;
  constexpr int DIRSZ = 72 * 1024;
  LAS unsigned char* L = C.lds + d * DIRSZ;
  LAS bf16_t* Qt = (LAS bf16_t*)L;
  LAS bf16_t* Kh = Qt + 32 * LDN;
  LAS bf16_t* Kw = Kh + 32 * LDN;
  LAS bf16_t* Vs = Kw + 32 * LDN;
  LAS bf16_t* Pt = Vs + 32 * LDP;
  LAS bf16_t* St = Pt + 32 * LDP;
  LAS float* CUM = (LAS float*)(St + 2 * 32 * LDN);
  const bf16_t* Z = WS(OFF_Z1, bf16_t); bf16_t* MIX = WS(OFF_MIX1, bf16_t);
  const int colq = Z1_HQ + h * 128, colf = Z1_HF + d * 1024 + h * 128, colv = Z1_HI + h * 128 + vs * 32, outc = 1024 + h * 128 + vs * 32;
  __syncthreads();
  for (int i = td; i < 32 * LDP / 2; i += 256) ((LAS unsigned*)Pt)[i] = 0u;
  for (int i = td; i < 2 * 32 * LDN / 2; i += 256) ((LAS unsigned*)St)[i] = 0u;
  f32x4 Sacc[2][2];
#pragma unroll
  for (int a = 0; a < 2; ++a)
#pragma unroll
    for (int c = 0; c < 2; ++c) Sacc[a][c] = (f32x4){0.f, 0.f, 0.f, 0.f};
  const int st_t = td >> 3, st_s = td & 7;
  float lbv[16];
#pragma unroll
  for (int e = 0; e < 16; ++e) lbv[e] = WS(OFF_LB1, float)[h * 128 + st_s * 16 + e];
  u32x4 rq[2], rf[2]; u32x2 rv;
  auto issue_loads = [&](int step) {
    const int chunk = seq_chunk32(d, step); const size_t row = (size_t)b * TB + chunk * 32 + st_t;
    const u32x4* pq = (const u32x4*)(Z + row * Z1W + colq + st_s * 16); const u32x4* pf = (const u32x4*)(Z + row * Z1W + colf + st_s * 16);
    rq[0] = pq[0]; rq[1] = pq[1]; rf[0] = pf[0]; rf[1] = pf[1];
    rv = *(const u32x2*)(Z + row * Z1W + colv + st_s * 4);
  };
  issue_loads(0);
  for (int step = 0; step < 264; ++step) {
    const int chunk = seq_chunk32(d, step); const int row0 = b * TB + chunk * 32;
    const int si = d ? 31 - st_t : st_t;
    VMWAIT();
    float qv[16], kk[16];
    { const unsigned qw[8] = {rq[0].x, rq[0].y, rq[0].z, rq[0].w, rq[1].x, rq[1].y, rq[1].z, rq[1].w};
      const unsigned fw[8] = {rf[0].x, rf[0].y, rf[0].z, rf[0].w, rf[1].x, rf[1].y, rf[1].z, rf[1].w};
      f32x4 lf4[4];
#pragma unroll
      for (int e = 0; e < 8; ++e) { qv[2 * e] = bflo(qw[e]); qv[2 * e + 1] = bfhi(qw[e]);
        const float f0 = lbv[2 * e] + (1.f - lbv[2 * e]) * sigmoidf_(bflo(fw[e])), f1 = lbv[2 * e + 1] + (1.f - lbv[2 * e + 1]) * sigmoidf_(bfhi(fw[e]));
        kk[2 * e] = 1.f - f0; kk[2 * e + 1] = 1.f - f1; lf4[e >> 1][(2 * e) & 3] = __logf(f0); lf4[e >> 1][(2 * e + 1) & 3] = __logf(f1); }
#pragma unroll
      for (int e = 0; e < 4; ++e) *(LAS f32x4*)(CUM + si * 128 + st_s * 16 + 4 * e) = lf4[e];
      *(LAS u32x2*)(Vs + si * LDP + st_s * 4) = rv; }
    LBAR();
    if (step + 1 < 264) issue_loads(step + 1);
    const int vt = w & 1, it = w >> 1;
    const bool first = (d == 0) == fwd_first32(chunk);
    bf16_t* op; unsigned long long ppv = 0ull;
    { const int ii = 16 * it + fr; const int t = d ? 31 - ii : ii; op = MIX + (size_t)(row0 + t) * MIXW + outc + 16 * vt + 4 * fq; if (!first) ppv = ld_agent_u64(op); }
    if (td < 128) { float c = 0.f;
#pragma unroll 8
      for (int i = 0; i < 32; ++i) { c += CUM[i * 128 + td]; CUM[i * 128 + td] = c; } }
    LBAR();
    { unsigned oq[8], oh[8], ow[8];
#pragma unroll
      for (int e = 0; e < 8; ++e) { const int k0 = st_s * 16 + 2 * e;
        const float c0 = CUM[si * 128 + k0], c1 = CUM[si * 128 + k0 + 1], l0 = CUM[31 * 128 + k0], l1 = CUM[31 * 128 + k0 + 1];
        oq[e] = pk2(qv[2 * e] * __expf(c0), qv[2 * e + 1] * __expf(c1));
        oh[e] = pk2(kk[2 * e] * __expf(fminf(-c0, 80.f)), kk[2 * e + 1] * __expf(fminf(-c1, 80.f)));
        ow[e] = pk2(kk[2 * e] * __expf(l0 - c0), kk[2 * e + 1] * __expf(l1 - c1)); }
      LAS u32x4* dq = (LAS u32x4*)(Qt + si * LDN + st_s * 16); LAS u32x4* dh = (LAS u32x4*)(Kh + si * LDN + st_s * 16); LAS u32x4* dw = (LAS u32x4*)(Kw + si * LDN + st_s * 16);
      dq[0] = (u32x4){oq[0], oq[1], oq[2], oq[3]}; dq[1] = (u32x4){oq[4], oq[5], oq[6], oq[7]};
      dh[0] = (u32x4){oh[0], oh[1], oh[2], oh[3]}; dh[1] = (u32x4){oh[4], oh[5], oh[6], oh[7]};
      dw[0] = (u32x4){ow[0], ow[1], ow[2], ow[3]}; dw[1] = (u32x4){ow[4], ow[5], ow[6], ow[7]}; }
    LBAR();
    if (w < 3) { const int I = w >= 1 ? 1 : 0, J = w == 2 ? 1 : 0;
      f32x4 acc = (f32x4){0.f, 0.f, 0.f, 0.f};
#pragma unroll
      for (int k = 0; k < 4; ++k) acc = mma16(frag_row(Qt, LDN, 16 * I, 32 * k, lane), frag_row(Kh, LDN, 16 * J, 32 * k, lane), acc);
      const int jj = 16 * J + fr; float pv[4];
#pragma unroll
      for (int r = 0; r < 4; ++r) { const int ii = 16 * I + 4 * fq + r; pv[r] = (jj <= ii) ? acc[r] : 0.f; }
      u32x2 o; o.x = pk2(pv[0], pv[1]); o.y = pk2(pv[2], pv[3]);
      *(LAS u32x2*)(Pt + jj * LDP + 16 * I + 4 * fq) = o; }
    const LAS bf16_t* Sr = St + (step & 1) * 32 * LDN; LAS bf16_t* Sw = St + ((step + 1) & 1) * 32 * LDN;
    f32x4 o2 = (f32x4){0.f, 0.f, 0.f, 0.f};
#pragma unroll
    for (int k = 0; k < 4; ++k) o2 = mma16(frag_row(Sr, LDN, 16 * vt, 32 * k, lane), frag_row(Qt, LDN, 16 * it, 32 * k, lane), o2);
#pragma unroll
    for (int a = 0; a < 2; ++a) { const int kt = 2 * w + a; const f32x4 cl = *(const LAS f32x4*)(CUM + 31 * 128 + 16 * kt + 4 * fq);
      f32x4 dec; dec[0] = __expf(cl[0]); dec[1] = __expf(cl[1]); dec[2] = __expf(cl[2]); dec[3] = __expf(cl[3]);
#pragma unroll
      for (int c = 0; c < 2; ++c) { f32x4 acc = Sacc[a][c] * dec;
        acc = mma16(frag_tr(Kw, LDN, 0, 16 * kt, lane), frag_tr(Vs, LDP, 0, 16 * c, lane), acc);
        Sacc[a][c] = acc;
        u32x2 o; o.x = pk2(acc[0], acc[1]); o.y = pk2(acc[2], acc[3]);
        *(LAS u32x2*)(Sw + (16 * c + fr) * LDN + 16 * kt + 4 * fq) = o; } }
    LBAR();
    { f32x4 o1 = mma16(frag_tr(Vs, LDP, 0, 16 * vt, lane), frag_tr(Pt, LDP, 0, 16 * it, lane), (f32x4){0.f, 0.f, 0.f, 0.f});
      float o0 = o1[0] + o2[0], o1v = o1[1] + o2[1], o2v = o1[2] + o2[2], o3 = o1[3] + o2[3];
      if (!first) { const unsigned long long pv = ppv; const unsigned lo = (unsigned)pv, hi = (unsigned)(pv >> 32); o0 += bflo(lo); o1v += bfhi(lo); o2v += bflo(hi); o3 += bfhi(hi); }
      u32x2 o; o.x = pk2(o0, o1v); o.y = pk2(o2v, o3); *(u32x2*)op = o; }
    LBAR();
  }
}

__device__ __forceinline__ void gdn_chain_wg(const Params& P, const Ctx& C, int task) {
  const int b = task >> 5, h = (task >> 2) & 7, vs = task & 3;
  const int d = C.wave >> 2, w = C.wave & 3, td = C.tid & 255, lane = C.lane, fr = lane & 15, fq = lane >> 4;
  constexpr int LDN = 136, LDP = 40, LDT = 24;
  constexpr int DIRSZ = 72 * 1024;
  LAS unsigned char* L = C.lds + d * DIRSZ;
  LAS bf16_t* Qs = (LAS bf16_t*)L;
  LAS bf16_t* Ks = Qs + 32 * LDN;
  LAS bf16_t* Vs = Ks + 32 * LDN;
  LAS bf16_t* Mt = Vs + 32 * LDP;
  LAS bf16_t* At = Mt + 32 * LDP;
  LAS bf16_t* Tt = At + 32 * LDP;
  LAS bf16_t* Xt = Tt + 2 * 32 * LDT;
  LAS bf16_t* Rt = Xt + 160 * LDP;
  LAS bf16_t* Vn = Rt + 4 * 16 * LDP;
  LAS bf16_t* Vw = Vn + 32 * LDP;
  LAS bf16_t* St = Vw + 32 * LDP;
  LAS float* Md = (LAS float*)(St + 2 * 32 * LDN);
  LAS float* gL = Md + 2 * 256;
  LAS float* bL = gL + 32;
  const bf16_t* Z = WS(OFF_Z1, bf16_t); bf16_t* MIX = WS(OFF_MIX1, bf16_t); const float* DT = WS(OFF_DT, float);
  const float Aneg = -__expf(GIN(I_GALOG)[d * 8 + h]), dtb = GIN(I_GDTB)[d * 8 + h];
  const int colq = Z1_Q + h * 128, colk = Z1_K + h * 128, colv = Z1_V + h * 128 + vs * 32, outc = h * 128 + vs * 32;
  __syncthreads();
  for (int i = td; i < 71 * 1024 / 4; i += 256) ((LAS unsigned*)L)[i] = 0u;
  f32x4 Sacc[2][2];
#pragma unroll
  for (int a = 0; a < 2; ++a)
#pragma unroll
    for (int c = 0; c < 2; ++c) Sacc[a][c] = (f32x4){0.f, 0.f, 0.f, 0.f};
  const int st_t = td >> 3, st_s = td & 7;
  u32x4 rq[2], rk[2]; u32x2 rv; float ra = 0.f, rb = 0.f;
  auto issue_loads = [&](int step) {
    const int chunk = seq_chunk32(d, step); const size_t row = (size_t)b * TB + chunk * 32 + st_t;
    const u32x4* pq = (const u32x4*)(Z + row * Z1W + colq + st_s * 16); const u32x4* pk = (const u32x4*)(Z + row * Z1W + colk + st_s * 16);
    rq[0] = pq[0]; rq[1] = pq[1]; rk[0] = pk[0]; rk[1] = pk[1];
    rv = *(const u32x2*)(Z + row * Z1W + colv + st_s * 4);
    if (st_s == 0) { rb = DT[row * 32 + d * 8 + h]; ra = DT[row * 32 + 16 + d * 8 + h]; }
  };
  issue_loads(0);
  __syncthreads();
  LAS bf16_t* Rw = Rt + w * 16 * LDP;
  for (int step = 0; step < 264; ++step) {
    const int chunk = seq_chunk32(d, step); const int row0 = b * TB + chunk * 32;
    VMWAIT();
    { const int si = d ? 31 - st_t : st_t;
      LAS u32x4* dq = (LAS u32x4*)(Qs + si * LDN + st_s * 16); LAS u32x4* dk = (LAS u32x4*)(Ks + si * LDN + st_s * 16);
      dq[0] = rq[0]; dq[1] = rq[1]; dk[0] = rk[0]; dk[1] = rk[1];
      *(LAS u32x2*)(Vs + si * LDP + st_s * 4) = rv;
      if (st_s == 0) { gL[si] = Aneg * softplusf_(ra + dtb); bL[si] = sigmoidf_(rb); } }
    LBAR();
    if (step + 1 < 264) issue_loads(step + 1);
    const bool first = (d == 0) == fwd_first32(chunk);
    bf16_t* op; unsigned long long ppv = 0ull;
    { const int ii = 16 * (w >> 1) + fr; const int t = d ? 31 - ii : ii; op = MIX + (size_t)(row0 + t) * MIXW + outc + 16 * (w & 1) + 4 * fq; if (!first) ppv = ld_agent_u64(op); }
    const float cum = wave_incl_scan(lane < 32 ? gL[lane] : 0.f, lane);
    const float cum_last = __shfl(cum, 31);
    const LAS bf16_t* Sr = St + (step & 1) * 32 * LDN; LAS bf16_t* Sw = St + ((step + 1) & 1) * 32 * LDN;
    const int vt = w & 1, it = w >> 1;
    for (int job = w; job < 6; job += 4) {
      const int isq = job >= 3, tj = job - 3 * isq; const int I = tj >= 1 ? 1 : 0, J = tj == 2 ? 1 : 0;
      const LAS bf16_t* A = isq ? Qs : Ks;
      f32x4 acc = (f32x4){0.f, 0.f, 0.f, 0.f};
#pragma unroll
      for (int k = 0; k < 4; ++k) acc = mma16(frag_row(A, LDN, 16 * I, 32 * k, lane), frag_row(Ks, LDN, 16 * J, 32 * k, lane), acc);
      const int jj = 16 * J + fr; const float cj = __shfl(cum, jj); float pv[4];
#pragma unroll
      for (int r = 0; r < 4; ++r) { const int ii = 16 * I + 4 * fq + r; const float ci = __shfl(cum, ii); const float dec = __expf(ci - cj);
        if (isq) pv[r] = (jj <= ii) ? acc[r] * dec : 0.f;
        else { pv[r] = (jj < ii) ? acc[r] * dec * bL[ii] : 0.f; if (I == J) Md[I * 256 + (4 * fq + r) * 16 + fr] = pv[r]; } }
      u32x2 o; o.x = pk2(pv[0], pv[1]); o.y = pk2(pv[2], pv[3]);
      *(LAS u32x2*)((isq ? At : Mt) + jj * LDP + 16 * I + 4 * fq) = o;
    }
    f32x4 o2 = (f32x4){0.f, 0.f, 0.f, 0.f};
#pragma unroll
    for (int k = 0; k < 4; ++k) o2 = mma16(frag_row(Sr, LDN, 16 * vt, 32 * k, lane), frag_row(Qs, LDN, 16 * it, 32 * k, lane), o2);
    LBAR();
    if (w < 2) { const LAS float* M = Md + w * 256; const int c = lane & 15;
      float m[16];
#pragma unroll
      for (int q4 = 0; q4 < 4; ++q4) { const f32x4 t4 = *(const LAS f32x4*)(M + c * 16 + 4 * q4); m[4 * q4] = t4[0]; m[4 * q4 + 1] = t4[1]; m[4 * q4 + 2] = t4[2]; m[4 * q4 + 3] = t4[3]; }
      float T[16];
#pragma unroll
      for (int r = 0; r < 16; ++r) { float v = (r == c) ? 1.f : 0.f;
#pragma unroll
        for (int s2 = 0; s2 < r; ++s2) v -= __builtin_bit_cast(float, __builtin_amdgcn_readlane(__builtin_bit_cast(int, m[s2]), r)) * T[s2];
        T[r] = v; }
      if (lane < 16) { LAS u32x4* dst = (LAS u32x4*)(Tt + w * 32 * LDT + c * LDT);
        dst[0] = (u32x4){pk2(T[0], T[1]), pk2(T[2], T[3]), pk2(T[4], T[5]), pk2(T[6], T[7])};
        dst[1] = (u32x4){pk2(T[8], T[9]), pk2(T[10], T[11]), pk2(T[12], T[13]), pk2(T[14], T[15])}; } }
    LBAR();
    for (int ct = w; ct < 10; ct += 4) {
      const int cc = 16 * ct + fr;
      f32x4 rhs;
#pragma unroll
      for (int r = 0; r < 4; ++r) { const int ii = 4 * fq + r; const float bi = bL[ii];
        rhs[r] = ct < 2 ? bi * bf2f(Vs[ii * LDP + cc]) : bi * __expf(__shfl(cum, ii)) * bf2f(Ks[ii * LDN + cc - 32]); }
      { u32x2 o; o.x = pk2(rhs[0], rhs[1]); o.y = pk2(rhs[2], rhs[3]); *(LAS u32x2*)(Rw + fr * LDP + 4 * fq) = o; }
      asm volatile("s_waitcnt lgkmcnt(0)" ::: "memory");
      f32x4 x0 = mma16(frag_tr(Tt, LDT, 0, 0, lane), frag_row(Rw, LDP, 0, 0, lane), (f32x4){0.f, 0.f, 0.f, 0.f});
      { u32x2 o; o.x = pk2(x0[0], x0[1]); o.y = pk2(x0[2], x0[3]); *(LAS u32x2*)(Xt + cc * LDP + 4 * fq) = o; }
#pragma unroll
      for (int r = 0; r < 4; ++r) { const int ii = 16 + 4 * fq + r; const float bi = bL[ii];
        rhs[r] = ct < 2 ? bi * bf2f(Vs[ii * LDP + cc]) : bi * __expf(__shfl(cum, ii)) * bf2f(Ks[ii * LDN + cc - 32]); }
      asm volatile("s_waitcnt lgkmcnt(0)" ::: "memory");
      { bf16x8 fa = frag_tr(Mt, LDP, 0, 16, lane); if (fq >= 2) fa = (bf16x8){0, 0, 0, 0, 0, 0, 0, 0};
        bf16x8 fb = frag_row(Xt, LDP, 16 * ct, 0, lane); if (fq >= 2) fb = (bf16x8){0, 0, 0, 0, 0, 0, 0, 0};
        const f32x4 corr = mma16(fa, fb, (f32x4){0.f, 0.f, 0.f, 0.f});
        rhs = rhs - corr; }
      { u32x2 o; o.x = pk2(rhs[0], rhs[1]); o.y = pk2(rhs[2], rhs[3]); *(LAS u32x2*)(Rw + fr * LDP + 4 * fq) = o; }
      asm volatile("s_waitcnt lgkmcnt(0)" ::: "memory");
      f32x4 x1 = mma16(frag_tr(Tt + 32 * LDT, LDT, 0, 0, lane), frag_row(Rw, LDP, 0, 0, lane), (f32x4){0.f, 0.f, 0.f, 0.f});
      { u32x2 o; o.x = pk2(x1[0], x1[1]); o.y = pk2(x1[2], x1[3]); *(LAS u32x2*)(Xt + cc * LDP + 16 + 4 * fq) = o; }
    }
    LBAR();
    { f32x4 ws = (f32x4){0.f, 0.f, 0.f, 0.f};
#pragma unroll
      for (int k = 0; k < 4; ++k) ws = mma16(frag_tr(Xt + 32 * LDP, LDP, 32 * k, 16 * it, lane), frag_row(Sr, LDN, 16 * vt, 32 * k, lane), ws);
      const u32x2 uu = *(const LAS u32x2*)(Xt + (16 * vt + fr) * LDP + 16 * it + 4 * fq);
      float vn[4] = {bflo(uu.x) - ws[0], bfhi(uu.x) - ws[1], bflo(uu.y) - ws[2], bfhi(uu.y) - ws[3]};
      float vw[4];
#pragma unroll
      for (int r = 0; r < 4; ++r) vw[r] = vn[r] * __expf(cum_last - __shfl(cum, 16 * it + 4 * fq + r));
      u32x2 o; o.x = pk2(vn[0], vn[1]); o.y = pk2(vn[2], vn[3]); *(LAS u32x2*)(Vn + (16 * vt + fr) * LDP + 16 * it + 4 * fq) = o;
      o.x = pk2(vw[0], vw[1]); o.y = pk2(vw[2], vw[3]); *(LAS u32x2*)(Vw + (16 * vt + fr) * LDP + 16 * it + 4 * fq) = o; }
    LBAR();
    { const f32x4 o1 = mma16(frag_row(Vn, LDP, 16 * vt, 0, lane), frag_tr(At, LDP, 0, 16 * it, lane), (f32x4){0.f, 0.f, 0.f, 0.f});
      const int ii = 16 * it + fr; const float eci = __expf(__shfl(cum, ii));
      float o0 = o1[0] + eci * o2[0], o1v = o1[1] + eci * o2[1], o2v = o1[2] + eci * o2[2], o3 = o1[3] + eci * o2[3];
      if (!first) { const unsigned long long pv = ppv; const unsigned lo = (unsigned)pv, hi = (unsigned)(pv >> 32); o0 += bflo(lo); o1v += bfhi(lo); o2v += bflo(hi); o3 += bfhi(hi); }
      u32x2 o; o.x = pk2(o0, o1v); o.y = pk2(o2v, o3); *(u32x2*)op = o; }
    { const float el = __expf(cum_last);
#pragma unroll
      for (int a = 0; a < 2; ++a) { const int kt = 2 * w + a; const bf16x8 fa = frag_tr(Ks, LDN, 0, 16 * kt, lane);
#pragma unroll
        for (int c = 0; c < 2; ++c) { f32x4 acc = mma16(fa, frag_row(Vw, LDP, 16 * c, 0, lane), Sacc[a][c] * el);
          Sacc[a][c] = acc;
          u32x2 o; o.x = pk2(acc[0], acc[1]); o.y = pk2(acc[2], acc[3]);
          *(LAS u32x2*)(Sw + (16 * c + fr) * LDN + 16 * kt + 4 * fq) = o; } } }
    LBAR();
  }
}

__device__ __forceinline__ bf16x8 ldfr(const LAS bf16_t* p) { return *(const LAS bf16x8*)p; }
__device__ __forceinline__ bf16x8 ldft(const LAS bf16_t* p, int ld) {
  const s16x4 v0 = __builtin_amdgcn_ds_read_tr16_b64_v4i16((LAS s16x4*)p);
  const s16x4 v1 = __builtin_amdgcn_ds_read_tr16_b64_v4i16((LAS s16x4*)(p + 4 * ld));
  bf16x8 r; r[0] = v0[0]; r[1] = v0[1]; r[2] = v0[2]; r[3] = v0[3]; r[4] = v1[0]; r[5] = v1[1]; r[6] = v1[2]; r[7] = v1[3];
  return r;
}
__device__ __forceinline__ u32x2 pk4(float a, float b, float c, float dd) { u32x2 o; o.x = pg8::cvt_pk_bf16(a, b); o.y = pg8::cvt_pk_bf16(c, dd); return o; }
__device__ __forceinline__ float bcast_lane(float v, int l) { return __builtin_bit_cast(float, __builtin_amdgcn_readlane(__builtin_bit_cast(int, v), l)); }

__device__ __forceinline__ void gdn2_chain_wg(const Params& P, const Ctx& C, int task) {
  const int b = task >> 5, h = (task >> 2) & 7, vs = task & 3;
  const int d = C.wave >> 2, w = ((C.wave & 3) + 2 * d) & 3, td = C.tid & 255, lane = C.lane, fr = lane & 15, fq = lane >> 4;
  constexpr int LDN = 136, LDP = 40, LDT = 24;
  constexpr int DIRSZ = 64 * 1024;
  LAS unsigned char* L = C.lds + d * DIRSZ;
  LAS bf16_t* Qs = (LAS bf16_t*)L;
  LAS bf16_t* Ks = Qs + 32 * LDN;
  LAS bf16_t* Vt = Ks + 32 * LDN;
  LAS bf16_t* Mt = Vt + 32 * LDP;
  LAS bf16_t* At = Mt + 32 * LDP;
  LAS bf16_t* Rt = At + 32 * LDP;
  LAS bf16_t* Vn = Rt + 32 * LDP;
  LAS bf16_t* Vw = Vn + 32 * LDP;
  LAS bf16_t* Tt = Vw + 32 * LDP;
  LAS bf16_t* St = Tt + 2 * 32 * LDT;
  LAS float* Md = (LAS float*)(St + 2 * 32 * LDN);
  LAS float* gL = Md + 512;
  LAS float* bL = gL + 32; LAS float* becL = bL;
  LAS float* ecL = bL + 32 + (C.wave & 3) * 96; LAS float* encL = ecL + 32; LAS float* ewL = encL + 32;
  const bf16_t* Z = WS(OFF_Z1, bf16_t); bf16_t* MIX = WS(OFF_MIX1, bf16_t); const float* DT = WS(OFF_DT, float);
  const float Aneg = -__expf(GIN(I_GALOG)[d * 8 + h]), dtb = GIN(I_GDTB)[d * 8 + h];
  const int colq = Z1_Q + h * 128, colk = Z1_K + h * 128, colv = Z1_V + h * 128 + vs * 32, outc = h * 128 + vs * 32;
  __syncthreads();
  for (int i = td; i < 58 * 1024 / 4; i += 256) ((LAS unsigned*)L)[i] = 0u;
  f32x4 Sacc[2][2];
#pragma unroll
  for (int a = 0; a < 2; ++a)
#pragma unroll
    for (int c = 0; c < 2; ++c) Sacc[a][c] = (f32x4){0.f, 0.f, 0.f, 0.f};
  const int st_t = td >> 3, st_s = td & 7;
  u32x4 rq[2], rk[2]; u32x2 rv; float ra = 0.f, rb = 0.f;
  auto issue_loads = [&](int step) {
    const int chunk = seq_chunk32(d, step); const size_t row = (size_t)b * TB + chunk * 32 + st_t;
    const u32x4* pq = (const u32x4*)(Z + row * Z1W + colq + st_s * 16); const u32x4* pk = (const u32x4*)(Z + row * Z1W + colk + st_s * 16);
    rq[0] = pq[0]; rq[1] = pq[1]; rk[0] = pk[0]; rk[1] = pk[1];
    rv = *(const u32x2*)(Z + row * Z1W + colv + st_s * 4);
    if (st_s == 0) { rb = DT[row * 32 + d * 8 + h]; ra = DT[row * 32 + 16 + d * 8 + h]; }
  };
  issue_loads(0);
  __syncthreads();
  const int rL136 = fr * LDN + 8 * fq, rL40 = fr * LDP + 8 * fq;
  const int tq = fr >> 2, tp = fr & 3;
  const int tL136 = (8 * fq + tq) * LDN + 4 * tp, tL40 = (8 * fq + tq) * LDP + 4 * tp, tL24 = (8 * fq + tq) * LDT + 4 * tp;
  const int it = w >> 1, vt = w & 1;
  const int si = d ? 31 - st_t : st_t;
  LAS u32x4* stq = (LAS u32x4*)(Qs + si * LDN + st_s * 16); LAS u32x4* stk = (LAS u32x4*)(Ks + si * LDN + st_s * 16);
  LAS bf16_t* stv = Vt + (st_s * 4) * LDP + si;
  const LAS bf16_t* pK_it = Ks + 16 * it * LDN + rL136; const LAS bf16_t* pQ_it = Qs + 16 * it * LDN + rL136;
  for (int step = 0; step < 264; ++step) {
    const int chunk = seq_chunk32(d, step); const int row0 = b * TB + chunk * 32;
    VMWAIT();
    stq[0] = rq[0]; stq[1] = rq[1]; stk[0] = rk[0]; stk[1] = rk[1];
    stv[0] = (bf16_t)(rv.x & 0xffffu); stv[LDP] = (bf16_t)(rv.x >> 16); stv[2 * LDP] = (bf16_t)(rv.y & 0xffffu); stv[3 * LDP] = (bf16_t)(rv.y >> 16);
    if (st_s == 0) { gL[si] = Aneg * softplusf_(ra + dtb); bL[si] = fast_sigmoid(rb); }
    LBAR();
    if (step + 1 < 264) issue_loads(step + 1);
    const bool first = (d == 0) == fwd_first32(chunk);
    bf16_t* op; unsigned long long ppv = 0ull;
    { const int ii = 16 * it + fr; const int t = d ? 31 - ii : ii; op = MIX + (size_t)(row0 + t) * MIXW + outc + 16 * vt + 4 * fq; if (!first) ppv = ld_agent_u64(op); }
    float elast;
    { const float c = wave_incl_scan(lane < 32 ? gL[lane & 31] : 0.f, lane); const float cl = bcast_lane(c, 31); elast = __expf(cl);
      if (lane < 32) { const float ec = __expf(c); ecL[lane] = ec; encL[lane] = c; ewL[lane] = __expf(cl - c); } }
    asm volatile("s_waitcnt lgkmcnt(0)" ::: "memory");
    const LAS bf16_t* Sr = St + (step & 1) * 32 * LDN; LAS bf16_t* Sw = St + ((step + 1) & 1) * 32 * LDN;
    f32x4 o2 = (f32x4){0.f, 0.f, 0.f, 0.f};
    { f32x4 ks = (f32x4){0.f, 0.f, 0.f, 0.f};
      const LAS bf16_t* pS = Sr + 16 * vt * LDN + rL136;
#pragma unroll
      for (int k = 0; k < 4; ++k) { const bf16x8 fs = ldfr(pS + 32 * k); ks = mma16(ldfr(pK_it + 32 * k), fs, ks); o2 = mma16(fs, ldfr(pQ_it + 32 * k), o2); }
      const u32x2 vv = *(const LAS u32x2*)(Vt + (16 * vt + fr) * LDP + 16 * it + 4 * fq);
      const f32x4 ec4 = *(const LAS f32x4*)(ecL + 16 * it + 4 * fq), b4 = *(const LAS f32x4*)(bL + 16 * it + 4 * fq);
      *(LAS u32x2*)(Rt + (16 * vt + fr) * LDP + 16 * it + 4 * fq) =
        pk4(b4[0] * (bflo(vv.x) - ec4[0] * ks[0]), b4[1] * (bfhi(vv.x) - ec4[1] * ks[1]), b4[2] * (bflo(vv.y) - ec4[2] * ks[2]), b4[3] * (bfhi(vv.y) - ec4[3] * ks[3])); }
    { const int isq = w & 1; const LAS bf16_t* A = isq ? Qs : Ks;
      const int njobs = w < 2 ? 1 : 2;
      for (int jb = 0; jb < njobs; ++jb) {
        const int I = (w < 2) ? 1 : jb, J = (w < 2) ? 1 : 0;
        f32x4 acc = (f32x4){0.f, 0.f, 0.f, 0.f};
        const LAS bf16_t* pa = A + 16 * I * LDN + rL136; const LAS bf16_t* pb = Ks + 16 * J * LDN + rL136;
#pragma unroll
        for (int k = 0; k < 4; ++k) acc = mma16(ldfr(pa + 32 * k), ldfr(pb + 32 * k), acc);
        const int jj = 16 * J + fr, i0 = 16 * I + 4 * fq; const float cj = encL[jj];
        const f32x4 c4 = *(const LAS f32x4*)(encL + i0); const f32x4 b4 = *(const LAS f32x4*)(becL + i0);
        float pv[4];
#pragma unroll
        for (int r = 0; r < 4; ++r) { const bool keep = isq ? (jj <= i0 + r) : (jj < i0 + r); const float sc = isq ? 1.f : b4[r];
          pv[r] = keep ? acc[r] * sc * __expf(c4[r] - cj) : 0.f; }
        if (!isq && I == J) { LAS float* md = Md + I * 256 + (4 * fq) * 16 + fr; md[0] = pv[0]; md[16] = pv[1]; md[32] = pv[2]; md[48] = pv[3]; }
        *(LAS u32x2*)((isq ? At : Mt) + jj * LDP + i0) = pk4(pv[0], pv[1], pv[2], pv[3]);
      } }
    LBAR();
    if (w < 2) { const LAS float* M = Md + w * 256; const int c = fr;
      float m[16];
#pragma unroll
      for (int q4 = 0; q4 < 4; ++q4) { const f32x4 t4 = *(const LAS f32x4*)(M + c * 16 + 4 * q4); m[4 * q4] = t4[0]; m[4 * q4 + 1] = t4[1]; m[4 * q4 + 2] = t4[2]; m[4 * q4 + 3] = t4[3]; }
      float T[16];
#pragma unroll
      for (int r = 0; r < 16; ++r) { float v = (r == c) ? 1.f : 0.f;
#pragma unroll
        for (int s2 = 0; s2 < r; ++s2) v -= bcast_lane(m[s2], r) * T[s2];
        T[r] = v; }
      if (lane < 16) { LAS u32x4* dst = (LAS u32x4*)(Tt + w * 32 * LDT + c * LDT);
        dst[0] = (u32x4){pg8::cvt_pk_bf16(T[0], T[1]), pg8::cvt_pk_bf16(T[2], T[3]), pg8::cvt_pk_bf16(T[4], T[5]), pg8::cvt_pk_bf16(T[6], T[7])};
        dst[1] = (u32x4){pg8::cvt_pk_bf16(T[8], T[9]), pg8::cvt_pk_bf16(T[10], T[11]), pg8::cvt_pk_bf16(T[12], T[13]), pg8::cvt_pk_bf16(T[14], T[15])}; } }
    LBAR();
    if (w < 2) { const int ct = w; const int cc = 16 * ct + fr;
      const f32x4 x0 = mma16(ldft(Tt + tL24, LDT), ldfr(Rt + 16 * ct * LDP + rL40), (f32x4){0.f, 0.f, 0.f, 0.f});
      const f32x4 ew0 = *(const LAS f32x4*)(ewL + 4 * fq);
      *(LAS u32x2*)(Vn + cc * LDP + 4 * fq) = pk4(x0[0], x0[1], x0[2], x0[3]);
      *(LAS u32x2*)(Vw + cc * LDP + 4 * fq) = pk4(x0[0] * ew0[0], x0[1] * ew0[1], x0[2] * ew0[2], x0[3] * ew0[3]);
      const u32x2 r1 = *(const LAS u32x2*)(Rt + cc * LDP + 16 + 4 * fq);
      asm volatile("s_waitcnt lgkmcnt(0)" ::: "memory");
      bf16x8 fa = ldft(Mt + tL40 + 16, LDP); bf16x8 fb = ldfr(Vn + 16 * ct * LDP + rL40);
      if (fq >= 2) { fa = (bf16x8){0, 0, 0, 0, 0, 0, 0, 0}; fb = (bf16x8){0, 0, 0, 0, 0, 0, 0, 0}; }
      const f32x4 corr = mma16(fa, fb, (f32x4){0.f, 0.f, 0.f, 0.f});
      *(LAS u32x2*)(Rt + cc * LDP + 16 + 4 * fq) = pk4(bflo(r1.x) - corr[0], bfhi(r1.x) - corr[1], bflo(r1.y) - corr[2], bfhi(r1.y) - corr[3]);
      asm volatile("s_waitcnt lgkmcnt(0)" ::: "memory");
      const f32x4 x1 = mma16(ldft(Tt + 32 * LDT + tL24, LDT), ldfr(Rt + 16 * ct * LDP + 16 + rL40), (f32x4){0.f, 0.f, 0.f, 0.f});
      const f32x4 ew1 = *(const LAS f32x4*)(ewL + 16 + 4 * fq);
      *(LAS u32x2*)(Vn + cc * LDP + 16 + 4 * fq) = pk4(x1[0], x1[1], x1[2], x1[3]);
      *(LAS u32x2*)(Vw + cc * LDP + 16 + 4 * fq) = pk4(x1[0] * ew1[0], x1[1] * ew1[1], x1[2] * ew1[2], x1[3] * ew1[3]); }
    LBAR();
    { const f32x4 o1 = mma16(ldfr(Vn + 16 * vt * LDP + rL40), ldft(At + tL40 + 16 * it, LDP), (f32x4){0.f, 0.f, 0.f, 0.f});
      const float eci = ecL[16 * it + fr];
      float o0 = o1[0] + eci * o2[0], o1v = o1[1] + eci * o2[1], o2v = o1[2] + eci * o2[2], o3 = o1[3] + eci * o2[3];
      if (!first) { const unsigned lo = (unsigned)ppv, hi = (unsigned)(ppv >> 32); o0 += bflo(lo); o1v += bfhi(lo); o2v += bflo(hi); o3 += bfhi(hi); }
      *(u32x2*)op = pk4(o0, o1v, o2v, o3); }
    { const bf16x8 fv0 = ldfr(Vw + rL40), fv1 = ldfr(Vw + 16 * LDP + rL40);
#pragma unroll
      for (int a = 0; a < 2; ++a) { const int kt = 2 * w + a; const bf16x8 fa = ldft(Ks + tL136 + 16 * kt, LDN);
        f32x4 a0 = mma16(fa, fv0, Sacc[a][0] * elast), a1 = mma16(fa, fv1, Sacc[a][1] * elast);
        Sacc[a][0] = a0; Sacc[a][1] = a1;
        *(LAS u32x2*)(Sw + fr * LDN + 16 * kt + 4 * fq) = pk4(a0[0], a0[1], a0[2], a0[3]);
        *(LAS u32x2*)(Sw + (16 + fr) * LDN + 16 * kt + 4 * fq) = pk4(a1[0], a1[1], a1[2], a1[3]); } }
    LBAR();
  }
}

__device__ __forceinline__ void hgrn2_chain_wg(const Params& P, const Ctx& C, int task) {
  const int b = task >> 5, h = (task >> 2) & 7, vs = task & 3;
  const int d = C.wave >> 2, w = C.wave & 3, td = C.tid & 255, lane = C.lane, fr = lane & 15, fq = lane >> 4;
  constexpr int LDN = 136, LDP = 40;
  constexpr int DIRSZ = 72 * 1024;
  LAS unsigned char* L = C.lds + d * DIRSZ;
  LAS bf16_t* Qt = (LAS bf16_t*)L;
  LAS bf16_t* Kh = Qt + 32 * LDN;
  LAS bf16_t* Kw = Kh + 32 * LDN;
  LAS bf16_t* Vs = Kw + 32 * LDN;
  LAS bf16_t* Pt = Vs + 32 * LDP;
  LAS bf16_t* St = Pt + 32 * LDP;
  LAS float* PR = (LAS float*)(St + 2 * 32 * LDN);
  LAS float* PL = PR + 32 * 128;
  const bf16_t* Z = WS(OFF_Z1, bf16_t); bf16_t* MIX = WS(OFF_MIX1, bf16_t);
  const int colq = Z1_HQ + h * 128, colf = Z1_HF + d * 1024 + h * 128, colv = Z1_HI + h * 128 + vs * 32, outc = 1024 + h * 128 + vs * 32;
  __syncthreads();
  for (int i = td; i < 32 * LDP / 2; i += 256) ((LAS unsigned*)Pt)[i] = 0u;
  for (int i = td; i < 2 * 32 * LDN / 2; i += 256) ((LAS unsigned*)St)[i] = 0u;
  f32x4 Sacc[2][2];
#pragma unroll
  for (int a = 0; a < 2; ++a)
#pragma unroll
    for (int c = 0; c < 2; ++c) Sacc[a][c] = (f32x4){0.f, 0.f, 0.f, 0.f};
  const int st_t = td >> 3, st_s = td & 7;
  float lbv[16];
#pragma unroll
  for (int e = 0; e < 16; ++e) lbv[e] = WS(OFF_LB1, float)[h * 128 + st_s * 16 + e];
  u32x4 rq[2], rf[2]; u32x2 rv;
  auto issue_loads = [&](int step) {
    const int chunk = seq_chunk32(d, step); const size_t row = (size_t)b * TB + chunk * 32 + st_t;
    const u32x4* pq = (const u32x4*)(Z + row * Z1W + colq + st_s * 16); const u32x4* pf = (const u32x4*)(Z + row * Z1W + colf + st_s * 16);
    rq[0] = pq[0]; rq[1] = pq[1]; rf[0] = pf[0]; rf[1] = pf[1];
    rv = *(const u32x2*)(Z + row * Z1W + colv + st_s * 4);
  };
  issue_loads(0);
  __syncthreads();
  const int rL136 = fr * LDN + 8 * fq;
  const int tq = fr >> 2, tp = fr & 3;
  const int tL136 = (8 * fq + tq) * LDN + 4 * tp, tL40 = (8 * fq + tq) * LDP + 4 * tp;
  const int vt = w & 1, it = w >> 1;
  const int si = d ? 31 - st_t : st_t;
  LAS float* prow = PR + si * 128 + st_s * 16;
  LAS float* pscan = PR + (td >> 7) * 16 * 128 + (td & 127);
  for (int step = 0; step < 264; ++step) {
    const int chunk = seq_chunk32(d, step); const int row0 = b * TB + chunk * 32;
    VMWAIT();
    float qv[16], kk[16];
    { const unsigned qw[8] = {rq[0].x, rq[0].y, rq[0].z, rq[0].w, rq[1].x, rq[1].y, rq[1].z, rq[1].w};
      const unsigned fw[8] = {rf[0].x, rf[0].y, rf[0].z, rf[0].w, rf[1].x, rf[1].y, rf[1].z, rf[1].w};
      f32x4 f4[4];
#pragma unroll
      for (int e = 0; e < 8; ++e) { qv[2 * e] = bflo(qw[e]); qv[2 * e + 1] = bfhi(qw[e]);
        const float k0 = (1.f - lbv[2 * e]) * (1.f - fast_sigmoid(bflo(fw[e]))), k1 = (1.f - lbv[2 * e + 1]) * (1.f - fast_sigmoid(bfhi(fw[e])));
        kk[2 * e] = k0; kk[2 * e + 1] = k1; f4[e >> 1][(2 * e) & 3] = 1.f - k0; f4[e >> 1][(2 * e + 1) & 3] = 1.f - k1; }
#pragma unroll
      for (int e = 0; e < 4; ++e) *(LAS f32x4*)(prow + 4 * e) = f4[e];
      *(LAS u32x2*)(Vs + si * LDP + st_s * 4) = rv; }
    LBAR();
    if (step + 1 < 264) issue_loads(step + 1);
    const bool first = (d == 0) == fwd_first32(chunk);
    bf16_t* op; unsigned long long ppv = 0ull;
    { const int ii = 16 * it + fr; const int t = d ? 31 - ii : ii; op = MIX + (size_t)(row0 + t) * MIXW + outc + 16 * vt + 4 * fq; if (!first) ppv = ld_agent_u64(op); }
    { float p = 1.f;
#pragma unroll
      for (int i = 0; i < 16; ++i) { p *= pscan[i * 128]; pscan[i * 128] = p; } }
    LBAR();
    { const bool hi = si >= 16;
      unsigned oq[8], oh[8], ow[8];
#pragma unroll
      for (int e4 = 0; e4 < 4; ++e4) {
        f32x4 p = *(const LAS f32x4*)(prow + 4 * e4); const f32x4 p15 = *(const LAS f32x4*)(PR + 15 * 128 + st_s * 16 + 4 * e4), p31 = *(const LAS f32x4*)(PR + 31 * 128 + st_s * 16 + 4 * e4);
        const f32x4 pl = p15 * p31; if (hi) p = p * p15;
        if (si == 0) *(LAS f32x4*)(PL + st_s * 16 + 4 * e4) = pl;
        float q_[4], h_[4], w_[4];
#pragma unroll
        for (int r = 0; r < 4; ++r) { const int e = 4 * e4 + r; const float rp = __builtin_amdgcn_rcpf(fmaxf(p[r], 1e-30f)); q_[r] = qv[e] * p[r]; h_[r] = kk[e] * rp; w_[r] = h_[r] * pl[r]; }
        oq[2 * e4] = pk2(q_[0], q_[1]); oq[2 * e4 + 1] = pk2(q_[2], q_[3]); oh[2 * e4] = pk2(h_[0], h_[1]); oh[2 * e4 + 1] = pk2(h_[2], h_[3]); ow[2 * e4] = pk2(w_[0], w_[1]); ow[2 * e4 + 1] = pk2(w_[2], w_[3]); }
      LAS u32x4* dq = (LAS u32x4*)(Qt + si * LDN + st_s * 16); LAS u32x4* dh = (LAS u32x4*)(Kh + si * LDN + st_s * 16); LAS u32x4* dw = (LAS u32x4*)(Kw + si * LDN + st_s * 16);
      dq[0] = (u32x4){oq[0], oq[1], oq[2], oq[3]}; dq[1] = (u32x4){oq[4], oq[5], oq[6], oq[7]};
      dh[0] = (u32x4){oh[0], oh[1], oh[2], oh[3]}; dh[1] = (u32x4){oh[4], oh[5], oh[6], oh[7]};
      dw[0] = (u32x4){ow[0], ow[1], ow[2], ow[3]}; dw[1] = (u32x4){ow[4], ow[5], ow[6], ow[7]}; }
    LBAR();
    if (w < 3) { const int I = w >= 1 ? 1 : 0, J = w == 2 ? 1 : 0;
      f32x4 acc = (f32x4){0.f, 0.f, 0.f, 0.f};
      const LAS bf16_t* pa = Qt + 16 * I * LDN + rL136; const LAS bf16_t* pb = Kh + 16 * J * LDN + rL136;
#pragma unroll
      for (int k = 0; k < 4; ++k) acc = mma16(ldfr(pa + 32 * k), ldfr(pb + 32 * k), acc);
      const int jj = 16 * J + fr, i0 = 16 * I + 4 * fq;
      *(LAS u32x2*)(Pt + jj * LDP + i0) = pk4(jj <= i0 ? acc[0] : 0.f, jj <= i0 + 1 ? acc[1] : 0.f, jj <= i0 + 2 ? acc[2] : 0.f, jj <= i0 + 3 ? acc[3] : 0.f); }
    const LAS bf16_t* Sr = St + (step & 1) * 32 * LDN; LAS bf16_t* Sw = St + ((step + 1) & 1) * 32 * LDN;
    f32x4 o2 = (f32x4){0.f, 0.f, 0.f, 0.f};
    { const LAS bf16_t* ps = Sr + 16 * vt * LDN + rL136; const LAS bf16_t* pq = Qt + 16 * it * LDN + rL136;
#pragma unroll
      for (int k = 0; k < 4; ++k) o2 = mma16(ldfr(ps + 32 * k), ldfr(pq + 32 * k), o2); }
    { const bf16x8 fv0 = ldft(Vs + tL40, LDP), fv1 = ldft(Vs + tL40 + 16, LDP);
#pragma unroll
      for (int a = 0; a < 2; ++a) { const int kt = 2 * w + a; const f32x4 dec = *(const LAS f32x4*)(PL + 16 * kt + 4 * fq);
        const bf16x8 fa = ldft(Kw + tL136 + 16 * kt, LDN);
        const f32x4 a0 = mma16(fa, fv0, Sacc[a][0] * dec), a1 = mma16(fa, fv1, Sacc[a][1] * dec);
        Sacc[a][0] = a0; Sacc[a][1] = a1;
        *(LAS u32x2*)(Sw + fr * LDN + 16 * kt + 4 * fq) = pk4(a0[0], a0[1], a0[2], a0[3]);
        *(LAS u32x2*)(Sw + (16 + fr) * LDN + 16 * kt + 4 * fq) = pk4(a1[0], a1[1], a1[2], a1[3]); } }
    LBAR();
    { const f32x4 o1 = mma16(ldft(Vs + tL40 + 16 * vt, LDP), ldft(Pt + tL40 + 16 * it, LDP), (f32x4){0.f, 0.f, 0.f, 0.f});
      float o0 = o1[0] + o2[0], o1v = o1[1] + o2[1], o2v = o1[2] + o2[2], o3 = o1[3] + o2[3];
      if (!first) { const unsigned lo = (unsigned)ppv, hi2 = (unsigned)(ppv >> 32); o0 += bflo(lo); o1v += bfhi(lo); o2v += bflo(hi2); o3 += bfhi(hi2); }
      *(u32x2*)op = pk4(o0, o1v, o2v, o3); }
    LBAR();
  }
}
__device__ __forceinline__ void phase_chain1(const Params& P, const Ctx& C, int mode) {
  if (mode != 2) for (int task = C.bid; task < 128; task += C.nblk) gdn2_chain_wg(P, C, task);
  __builtin_amdgcn_sched_barrier(0);
  if (mode != 1) for (int task = C.bid < 128 ? C.bid + C.nblk : C.bid; task < 256; task += C.nblk) hgrn2_chain_wg(P, C, task - 128);
}
__device__ __forceinline__ void phase_onorm(const Params& P, const Ctx& C) {
  bf16_t* MIX = WS(OFF_MIX1, bf16_t); bf16_t* U = WS(OFF_U1B, bf16_t);
  const float* m1 = WS(OFF_MOD, float) + (size_t)5 * 6144;
  for (int r = C.gw; r < R; r += C.ngw) {
    const int b = r / TB, pos = r % TB; if (pos < CTXL) continue;
#pragma unroll
    for (int half = 0; half < 2; ++half) {
      const float* gn = half ? GIN(I_HNG) : GIN(I_GNG);
#pragma unroll
      for (int j = 0; j < 4; ++j) { const int e = 4 * C.lane + 256 * j; bf16_t* p = MIX + (size_t)r * MIXW + half * 1024 + e;
        const u32x2 a = *(const u32x2*)p; const float o0 = bflo(a.x), o1 = bfhi(a.x), o2 = bflo(a.y), o3 = bfhi(a.y);
        const float ss = half_sum32((o0 * o0 + o1 * o1) + (o2 * o2 + o3 * o3)); const float rs = rsqrtf(ss * (1.f / 128.f) + RMS_EPS);
        const f32x4 g = *(const f32x4*)(gn + (e & 127));
        u32x2 w; w.x = pk2(o0 * rs * g[0], o1 * rs * g[1]); w.y = pk2(o2 * rs * g[2], o3 * rs * g[3]); *(u32x2*)p = w; }
    }
    f32x4 h[4], u[4]; row_load(GOUT + ((size_t)b * SEQ + (pos - CTXL)) * D, C.lane, h);
    row_modulate(h, m1 + (size_t)b * 6144, m1 + (size_t)b * 6144 + D, C.lane, u);
    row_store_bf16(U + (size_t)r * D, C.lane, u);
  }
  LAS float* scr = (LAS float*)C.lds + C.wave * (64 * 33);
  convert_experts(P, 1, WS(OFF_WE1, bf16_t), WS(OFF_WE1 + 64 * MiB, bf16_t), C, scr);
}
__device__ __forceinline__ void phase_gates(const Params& P, const Ctx& C) {
  pg8::Gemm g{WS(OFF_U1B, bf16_t), WS(OFF_WG1, bf16_t), D, D}; pg8::GridOrder S; S.init(128, 8, C.nblk, C.bid, 1);
  pg8::EpiGateMul E{WS(OFF_MIX1, bf16_t), MIXW};
  pg8::gemm_phase(C.lds, g, S, E);
}


#define XB_TMO      128
#define XB_XCNT(j)  (256  + 64 * (j))
#define XB_XSUB(j)  (1280 + 64 * (j))
#define XB_XGEN(j)  (2304 + 64 * (j))
#define XB_TOP      3328
#define XB_TOPGEN   3392
#define XCD_BAR_WORDS 3456
#define XB_SPIN_CAP (1u << 22)
constexpr size_t OFF_BAR = 16 * 1024;
constexpr int LDS_BAR_OFF = LDS_BYTES - 64;
__device__ __forceinline__ unsigned xb_ld(unsigned* p)              { return __hip_atomic_load(p, __ATOMIC_RELAXED, __HIP_MEMORY_SCOPE_AGENT); }
__device__ __forceinline__ unsigned xb_add(unsigned* p, unsigned v) { return __hip_atomic_fetch_add(p, v, __ATOMIC_RELAXED, __HIP_MEMORY_SCOPE_AGENT); }
__device__ __forceinline__ unsigned xb_xcc_id() { return (unsigned)__builtin_amdgcn_s_getreg((3 << 11) | 20) & 0xFu; }
#define XB_SPIN(cond, bar) do { unsigned _sp = 0; while (cond) { __builtin_amdgcn_s_sleep(1); \
    if ((++_sp & 255u) == 0u) { if (xb_ld(&(bar)[XB_TMO])) break; if (_sp > XB_SPIN_CAP) { atomicAdd(&(bar)[XB_TMO], 1u); break; } } } } while (0)
__device__ __forceinline__ void xcd_barrier_post(unsigned* bar) { if (threadIdx.x == 0) (void)xb_add(&bar[XB_XCNT(xb_xcc_id())], 1u); }
__device__ __forceinline__ void xcd_barrier_complete(unsigned* bar, unsigned x, unsigned& nloc, unsigned& nx) {
  const unsigned G = gridDim.x * gridDim.y * gridDim.z;
  unsigned sum, cnt, mine, sp = 0u;
  for (;;) {
    sum = 0u; cnt = 0u; mine = 0u;
#pragma unroll
    for (unsigned j = 0; j < 16; ++j) { const unsigned c = xb_ld(&bar[XB_XCNT(j)]); sum += c; cnt += (c > 0u) ? 1u : 0u; mine = (j == x) ? c : mine; }
    if (sum == G) break;
    __builtin_amdgcn_s_sleep(1);
    if ((++sp & 255u) == 0u) { if (xb_ld(&bar[XB_TMO])) break; if (sp > XB_SPIN_CAP) { atomicAdd(&bar[XB_TMO], 1u); break; } }
  }
  nloc = mine > 0u ? mine : 1u; nx = cnt > 0u ? cnt : 1u;
}
__device__ __forceinline__ void xcd_barrier(unsigned* bar, volatile LAS unsigned* st) {
  asm volatile("s_waitcnt vmcnt(0)" ::: "memory");
  __syncthreads();
  if (threadIdx.x == 0) {
    const unsigned x = xb_xcc_id();
    __builtin_amdgcn_s_waitcnt(0);
    unsigned nloc = st[0], nx = st[1];
    if (nloc == 0u) { xcd_barrier_complete(bar, x, nloc, nx); st[0] = nloc; st[1] = nx; }
    const unsigned old = xb_add(&bar[XB_XSUB(x)], 1u);
    const unsigned gen = old / nloc;
    if (old + 1u == (gen + 1u) * nloc) {
      __builtin_amdgcn_fence(__ATOMIC_RELEASE, "agent");
      asm volatile("s_waitcnt vmcnt(0)" ::: "memory");
      const unsigned og = xb_add(&bar[XB_TOP], 1u);
      const unsigned tg = og / nx;
      if (og + 1u == (tg + 1u) * nx) xb_add(&bar[XB_TOPGEN], 1u);
      else XB_SPIN(xb_ld(&bar[XB_TOPGEN]) == tg, bar);
      __builtin_amdgcn_fence(__ATOMIC_ACQUIRE, "agent");
      xb_add(&bar[XB_XGEN(x)], 1u);
      asm volatile("s_waitcnt vmcnt(0)" ::: "memory");
    } else {
      XB_SPIN(xb_ld(&bar[XB_XGEN(x)]) == gen, bar);
      __builtin_amdgcn_fence(__ATOMIC_ACQUIRE, "agent");
      asm volatile("s_waitcnt vmcnt(0)" ::: "memory");
    }
  }
  __syncthreads();
}
__global__ void __launch_bounds__(NT, 2) fwd_megakernel(Params Pk) {
  extern __shared__ __attribute__((aligned(16))) unsigned char lds_raw[];
  cg::grid_group grid = cg::this_grid();
#ifndef PROBE_DOUBLE
#define PROBE_DOUBLE -1
#endif
#ifndef PROBE_MODE
#define PROBE_MODE 0
#endif
#ifndef PHASE_MASK
#define PHASE_MASK 0xFFFFFFFFu
#endif
#define SYNC() do { const unsigned char* wsb_ = ((const Params*)(const __attribute__((address_space(4))) Params*)__builtin_amdgcn_kernarg_segment_ptr())->ws; \
    xcd_barrier((unsigned*)(GAS unsigned*)(wsb_ + OFF_BAR), (volatile LAS unsigned*)((LAS unsigned char*)lds_raw + LDS_BAR_OFF)); } while (0)
#define SYNC_CG() do { __syncthreads(); grid.sync(); } while (0)
  if (threadIdx.x < 16) ((LAS unsigned*)((LAS unsigned char*)lds_raw + LDS_BAR_OFF))[threadIdx.x] = 0u;
  __syncthreads();
  xcd_barrier_post((unsigned*)(GAS unsigned*)(Pk.ws + OFF_BAR));
#define LAUNDER() const Params* pp; { unsigned long long a_ = (unsigned long long)__builtin_amdgcn_kernarg_segment_ptr(); asm volatile("" : "+s"(a_)); \
    const unsigned lo_ = __builtin_amdgcn_readfirstlane((unsigned)a_), hi_ = __builtin_amdgcn_readfirstlane((unsigned)(a_ >> 32)); \
    pp = (const Params*)(const __attribute__((address_space(4))) Params*)(((unsigned long long)hi_ << 32) | lo_); } \
  Ctx C; { int t_ = threadIdx.x; asm volatile("" : "+v"(t_)); t_ &= 511; int b_ = blockIdx.x; asm volatile("" : "+s"(b_)); b_ = __builtin_amdgcn_readfirstlane(b_); int g_ = gridDim.x; asm volatile("" : "+s"(g_)); g_ = __builtin_amdgcn_readfirstlane(g_); \
    C.lds = (LAS unsigned char*)lds_raw; C.tid = t_; C.lane = t_ & 63; C.wave = __builtin_amdgcn_readfirstlane(t_ >> 6); \
    C.bid = b_; C.nblk = g_; C.gw = b_ * NWAVES + C.wave; C.ngw = g_ * NWAVES; }
#define WSP(off, T) ((T*)(GAS T*)(pp->ws + (off)))
  for (int rep_ = 0; rep_ < ((PROBE_DOUBLE == 0) ? 2 : 1); ++rep_) { if (PHASE_MASK & (1u << 0)) { LAUNDER(); phase0(*pp, C); }  SYNC_CG(); }
  for (int rep_ = 0; rep_ < ((PROBE_DOUBLE == 1) ? 2 : 1); ++rep_) { if (PHASE_MASK & (1u << 1)) { LAUNDER(); phase_u0(*pp, C); }  SYNC(); }
  for (int rep_ = 0; rep_ < ((PROBE_DOUBLE == 2) ? 2 : 1); ++rep_) { if (PHASE_MASK & (1u << 2)) { LAUNDER(); phase_inproj(*pp, C, WSP(OFF_U0, bf16_t), WSP(OFF_WAB, bf16_t), WSP(OFF_Z0, bf16_t), Z0W); }  SYNC(); }
  for (int rep_ = 0; rep_ < ((PROBE_DOUBLE == 3) ? 2 : 1); ++rep_) { if (PHASE_MASK & (1u << 3)) { LAUNDER(); phase_feat0(*pp, C); }  SYNC(); }
  for (int rep_ = 0; rep_ < ((PROBE_DOUBLE == 4) ? 2 : 1); ++rep_) { if (PHASE_MASK & (1u << 4)) { LAUNDER(); phase_chain0(*pp, C, rep_ ? PROBE_MODE : 0); }  SYNC(); }
  for (int rep_ = 0; rep_ < ((PROBE_DOUBLE == 5) ? 2 : 1); ++rep_) { if (PHASE_MASK & (1u << 5)) { LAUNDER(); phase_ssdfin(*pp, C); }  SYNC(); }
  for (int rep_ = 0; rep_ < ((PROBE_DOUBLE == 6) ? 2 : 1); ++rep_) { if (PHASE_MASK & (1u << 6)) { LAUNDER(); phase_outproj(*pp, C, 0); }  SYNC(); }
  for (int rep_ = 0; rep_ < ((PROBE_DOUBLE == 7) ? 2 : 1); ++rep_) { if (PHASE_MASK & (1u << 7)) { LAUNDER(); phase_lnmix(*pp, C, 0); }  SYNC(); }
  for (int rep_ = 0; rep_ < ((PROBE_DOUBLE == 8) ? 2 : 1); ++rep_) { if (PHASE_MASK & (1u << 8)) { LAUNDER(); phase_dispatch(*pp, C, 0); }  SYNC(); }
  for (int rep_ = 0; rep_ < ((PROBE_DOUBLE == 9) ? 2 : 1); ++rep_) { if (PHASE_MASK & (1u << 9)) { LAUNDER(); phase_moe1(*pp, C, 0); }  SYNC(); }
  for (int rep_ = 0; rep_ < ((PROBE_DOUBLE == 10) ? 2 : 1); ++rep_) { if (PHASE_MASK & (1u << 10)) { LAUNDER(); phase_moe2(*pp, C, 0); }  SYNC(); }
  for (int rep_ = 0; rep_ < ((PROBE_DOUBLE == 11) ? 2 : 1); ++rep_) { if (PHASE_MASK & (1u << 11)) { LAUNDER(); phase_lnffn(*pp, C, 0); }  SYNC(); }
  for (int rep_ = 0; rep_ < ((PROBE_DOUBLE == 12) ? 2 : 1); ++rep_) { if (PHASE_MASK & (1u << 12)) { LAUNDER(); phase_inproj(*pp, C, WSP(OFF_U1, bf16_t), WSP(OFF_WCD, bf16_t), WSP(OFF_Z1, bf16_t), Z1W); }  SYNC(); }
  for (int rep_ = 0; rep_ < ((PROBE_DOUBLE == 13) ? 2 : 1); ++rep_) { if (PHASE_MASK & (1u << 13)) { LAUNDER(); phase_feat1(*pp, C); }  SYNC(); }
  for (int rep_ = 0; rep_ < ((PROBE_DOUBLE == 14) ? 2 : 1); ++rep_) { if (PHASE_MASK & (1u << 14)) { LAUNDER(); phase_chain1(*pp, C, rep_ ? PROBE_MODE : 0); }  SYNC(); }
  for (int rep_ = 0; rep_ < ((PROBE_DOUBLE == 15) ? 2 : 1); ++rep_) { if (PHASE_MASK & (1u << 15)) { LAUNDER(); phase_onorm(*pp, C); }  SYNC(); }
  for (int rep_ = 0; rep_ < ((PROBE_DOUBLE == 16) ? 2 : 1); ++rep_) { if (PHASE_MASK & (1u << 16)) { LAUNDER(); phase_gates(*pp, C); }  SYNC(); }
  for (int rep_ = 0; rep_ < ((PROBE_DOUBLE == 17) ? 2 : 1); ++rep_) { if (PHASE_MASK & (1u << 17)) { LAUNDER(); phase_outproj(*pp, C, 1); }  SYNC(); }
  for (int rep_ = 0; rep_ < ((PROBE_DOUBLE == 18) ? 2 : 1); ++rep_) { if (PHASE_MASK & (1u << 18)) { LAUNDER(); phase_lnmix(*pp, C, 1); }  SYNC(); }
  for (int rep_ = 0; rep_ < ((PROBE_DOUBLE == 19) ? 2 : 1); ++rep_) { if (PHASE_MASK & (1u << 19)) { LAUNDER(); phase_dispatch(*pp, C, 1); }  SYNC(); }
  for (int rep_ = 0; rep_ < ((PROBE_DOUBLE == 20) ? 2 : 1); ++rep_) { if (PHASE_MASK & (1u << 20)) { LAUNDER(); phase_moe1(*pp, C, 1); }  SYNC(); }
  for (int rep_ = 0; rep_ < ((PROBE_DOUBLE == 21) ? 2 : 1); ++rep_) { if (PHASE_MASK & (1u << 21)) { LAUNDER(); phase_moe2(*pp, C, 1); }  SYNC(); }
  if (PHASE_MASK & (1u << 22)) { LAUNDER(); phase_lnffn(*pp, C, 1); }
}

extern "C" void kernel_launch(void* const* d_in, const int* in_sizes, int n_in, void* d_out, int out_size,
                              void* d_ws, size_t ws_size, hipStream_t stream) {
  static int grid_blocks = 0;
  if (!grid_blocks) {
    int dev = 0, cus = 0, per_cu = 0;
    (void)hipGetDevice(&dev);
    (void)hipDeviceGetAttribute(&cus, hipDeviceAttributeMultiprocessorCount, dev);
    (void)hipFuncSetAttribute((const void*)fwd_megakernel, hipFuncAttributeMaxDynamicSharedMemorySize, LDS_BYTES);
    (void)hipOccupancyMaxActiveBlocksPerMultiprocessor(&per_cu, (const void*)fwd_megakernel, NT, LDS_BYTES);
    if (per_cu < 1) per_cu = 1;
    grid_blocks = cus * 1;
    fprintf(stderr, "grid %d (cus %d per_cu %d) ws_size %zu need %zu n_in %d\n", grid_blocks, cus, per_cu, ws_size, (size_t)WS_NEED, n_in);
    if (ws_size < WS_NEED || n_in != 39) { fprintf(stderr, "kernel_launch: workspace too small or unexpected inputs\n"); grid_blocks = -1; }
  }
  if (grid_blocks < 0) return;
  (void)hipMemsetAsync(d_ws, 0, 64 * 1024, stream);
  Params p{};
  for (int i = 0; i < 39; ++i) p.in[i] = (const float*)d_in[i];
  p.out = (float*)d_out; p.ws = (unsigned char*)d_ws;
  void* args[] = {&p};
  hipError_t e = hipLaunchCooperativeKernel((const void*)fwd_megakernel, dim3(grid_blocks), dim3(NT), args, LDS_BYTES, stream);
  if (e != hipSuccess) fprintf(stderr, "cooperative launch failed: %s (grid %d)\n", hipGetErrorString(e), grid_blocks);
}
```

```cpp
#include <hip/hip_runtime.h>
#include <hip/hip_cooperative_groups.h>
#include <cstdio>
#include <cstdint>
namespace cg = cooperative_groups;

#define LAS __attribute__((address_space(3)))
typedef unsigned short bf16_t;
typedef short bf16x8 __attribute__((ext_vector_type(8)));
typedef float f32x4 __attribute__((ext_vector_type(4)));
typedef float f32x2 __attribute__((ext_vector_type(2)));
typedef unsigned u32x4 __attribute__((ext_vector_type(4)));
typedef unsigned u32x2 __attribute__((ext_vector_type(2)));

constexpr int D = 1024, NB = 4, SEQ = 8192, CTXL = 256, TB = SEQ + CTXL  , R = NB * TB  , RLAT = NB * SEQ;
constexpr int NT = 512, NWAVES = 8;
constexpr int LDS_BYTES = 163840;
constexpr int AB_IN = 4640, CD_IN = 9248;
constexpr int Z0W = 4608, Z1W = 7168, MIXW = 2048;
constexpr int NEXP = 32, DEXP = 512, MOE_BLK = 256, MAX_BLKS = 304, MAX_SLOTS = 296 * 256;
constexpr float ALPHA = 1.41421356237309515f;
constexpr float LN_EPS = 1e-5f, RMS_EPS = 1e-6f;
constexpr int Z0_RGX = 0, Z0_RGY = 1024, Z0_SSDZ = 2048, Z0_XBC = 3072, Z0_B = 4096, Z0_C = 4352;
constexpr int Z1_Q = 0, Z1_K = 1024, Z1_V = 2048, Z1_HQ = 3072, Z1_HF = 4096, Z1_HI = 6144;

constexpr size_t MiB = 1u << 20;
constexpr size_t OFF_CTL = 0;
constexpr size_t OFF_MOD = 64 * 1024;
constexpr size_t OFF_LB1 = 320 * 1024;
constexpr size_t OFF_ROUTE = 512 * 1024;
constexpr size_t OFF_SLOTW = 2 * MiB;
constexpr size_t OFF_DT = 3 * MiB;
constexpr size_t OFF_HCTX = 8 * MiB;
constexpr size_t OFF_TCTX = 12 * MiB;
constexpr size_t OFF_WOUT0 = 16 * MiB, OFF_WOUT1 = 20 * MiB, OFF_WG1 = 24 * MiB, OFF_WAB = 28 * MiB;
constexpr size_t OFF_A = 40 * MiB;
constexpr size_t OFF_Z0 = OFF_A, OFF_MIX0 = OFF_A + 297 * MiB, OFF_WE0 = OFF_A + 429 * MiB, OFF_U0 = OFF_A + 525 * MiB;
constexpr size_t OFF_AM0 = OFF_A, OFF_HM0 = OFF_A + 148 * MiB, OFF_YM0 = OFF_A + 222 * MiB;
constexpr size_t OFF_Z1 = OFF_A, OFF_U1 = OFF_A + 462 * MiB, OFF_WCD = OFF_A + 528 * MiB, OFF_MIX1 = OFF_A + 462 * MiB;
constexpr size_t OFF_WE1 = OFF_A, OFF_U1B = OFF_A + 96 * MiB, OFF_AM1 = OFF_A + 96 * MiB, OFF_HM1 = OFF_A + 244 * MiB, OFF_YM1 = OFF_A + 318 * MiB, OFF_V1 = OFF_A + 470 * MiB;
constexpr size_t WS_NEED = OFF_A + 594 * MiB;
static_assert((size_t)R * Z0W * 2 <= 297 * MiB && (size_t)R * MIXW * 2 <= 132 * MiB && (size_t)R * Z1W * 2 <= 462 * MiB && (size_t)R * D * 2 <= 66 * MiB, "ws map");
static_assert((size_t)MAX_SLOTS * D * 2 <= 148 * MiB && (size_t)MAX_SLOTS * DEXP * 2 <= 74 * MiB, "ws map moe");
static_assert(OFF_DT + (size_t)R * 32 * 4 <= OFF_HCTX && OFF_ROUTE + (size_t)R * 32 <= OFF_SLOTW && OFF_SLOTW + MAX_SLOTS * 4 <= OFF_DT, "ws map small");

struct Params { const float* in[39]; float* out; unsigned char* ws; };
enum { I_X = 0, I_C, I_CTX, I_CCTX, I_HLB, I_ADAW, I_ADAB, I_LNMG, I_LNMB, I_LNFG, I_LNFB, I_OUTW, I_RGW, I_RGB, I_REW, I_REB, I_EWG, I_EWU, I_EWD,
       I_ABW, I_RGCW, I_RGCB, I_RGAW, I_RGAB, I_RGXW, I_RGXB, I_RGLAM, I_SCW, I_SCB, I_SALOG, I_SDTB, I_SD, I_SNG, I_CDW, I_GCW, I_GALOG, I_GDTB, I_GNG, I_HNG };

__device__ __forceinline__ unsigned f2bf(float f) { unsigned u = __float_as_uint(f); return (u + 0x7fffu + ((u >> 16) & 1u)) >> 16; }
__device__ __forceinline__ float bf2f(unsigned b) { return __uint_as_float(b << 16); }
typedef __bf16 bf16x2v_t __attribute__((ext_vector_type(2)));
__device__ __forceinline__ unsigned pk2(float lo, float hi) { const f32x2 v = {lo, hi}; const bf16x2v_t r = __builtin_convertvector(v, bf16x2v_t); return __builtin_bit_cast(unsigned, r); }
__device__ __forceinline__ float bflo(unsigned w) { return __uint_as_float(w << 16); }
__device__ __forceinline__ float bfhi(unsigned w) { return __uint_as_float(w & 0xffff0000u); }
__device__ __forceinline__ float sigmoidf_(float x) { return 1.f / (1.f + __expf(-x)); }
__device__ __forceinline__ float siluf_(float x) { return x / (1.f + __expf(-x)); }
__device__ __forceinline__ float softplusf_(float x) { return x > 20.f ? x : log1pf(__expf(x)); }
__device__ __forceinline__ float geluf_(float x) { const float u = 0.7978845608028654f * (x + 0.044715f * x * x * x); return 0.5f * x * (1.f + tanhf(u)); }
template <int CTRL> __device__ __forceinline__ float dpp_mov(float v) {
  return __builtin_bit_cast(float, __builtin_amdgcn_update_dpp(0, __builtin_bit_cast(int, v), CTRL, 0xf, 0xf, true));
}
__device__ __forceinline__ float row_sum16(float v) {
  v += dpp_mov<0xB1>(v); v += dpp_mov<0x4E>(v); v += dpp_mov<0x141>(v); v += dpp_mov<0x140>(v);
  return v;
}
__device__ __forceinline__ float wave_sum(float v) { v = row_sum16(v); v += __shfl_xor(v, 16); v += __shfl_xor(v, 32); return v; }
__device__ __forceinline__ float half_sum32(float v) { v = row_sum16(v); v += __shfl_xor(v, 16); return v; }
__device__ __forceinline__ int rmap(int latonly, int q) { return latonly ? (q >> 13) * TB + CTXL + (q & 8191) : q; }
__device__ __forceinline__ int row_batch(int r) { return r / TB; }

namespace pg8 {
constexpr int BM = 256, BK = 64, HALF = 128, HTB = HALF * BK * 2, STAGE_BYTES = 8 * HTB, NXCD = 8, WGM = 8;
__host__ __device__ __forceinline__ int lds_byte(int r, int c) { const int st = (r >> 4) * 2 + (c >> 5), rr = r & 15, cc = c & 31, ob = rr * 64 + cc * 2; return st * 1024 + (ob ^ (((ob >> 9) & 1) << 5)); }
__host__ __device__ __forceinline__ void stage_rc(int b, int& Rr, int& C) { const int st = b / 1024, sb = b % 1024, swz = sb ^ (((sb >> 9) & 1) << 5); Rr = (st >> 1) * 16 + swz / 64; C = (st & 1) * 32 + (swz % 64) / 2; }
__host__ __device__ __forceinline__ int perm32(int rho) { const int n = rho >> 4, i = rho & 15; return 8 * (i >> 2) + 4 * n + (i & 3); }
struct Unit { int pm, pn; };
struct Gemm { const bf16_t* A; const bf16_t* Bt; int lda, K; };

struct GridOrder {
  int nM, nN, nwg, G, c, skipctx;
  __device__ void init(int nM_, int nN_, int G_, int c_, int skipctx_) { nM = nM_; nN = nN_; nwg = nM * nN; G = G_; c = c_; skipctx = skipctx_; }
  __device__ bool next(int i, Unit& u) const {
    const long L = (long)i * G + c; if (L >= nwg) return false;
    int wgid = (int)L; { const int q = nwg / NXCD, r = nwg % NXCD, xcd = wgid % NXCD, off = wgid / NXCD; wgid = (xcd < r ? xcd * (q + 1) : r * (q + 1) + (xcd - r) * q) + off; }
    const int nig = WGM * nN, gid = wgid / nig, fm = gid * WGM, gsz = (nM - fm) < WGM ? (nM - fm) : WGM;
    int pm = fm + ((wgid % nig) % gsz); u.pn = (wgid % nig) / gsz;
    if (skipctx) pm = (pm >> 5) * 33 + 1 + (pm & 31);
    u.pm = pm; return true;
  }
};
struct MoeOrder {
  const int* blk_e; int nunits, G, c;
  __device__ bool next(int i, Unit& u) const {
    const long L = (long)i * G + c; if (L >= nunits) return false;
    const int blk = (int)(L >> 2), j = (int)(L & 3);
    u.pm = blk; u.pn = blk_e[blk] * 4 + j; return true;
  }
};

__device__ __forceinline__ unsigned cvt_pk_bf16(float lo, float hi) { return pk2(lo, hi); }

template <class Epi, class Sched>
__device__ __forceinline__ void gemm_phase(LAS unsigned char* lds, const Gemm g, const Sched& S, const Epi& E) {
  int tid_ = threadIdx.x; asm volatile("" : "+v"(tid_)); tid_ &= 511; const int tid = tid_, wid = __builtin_amdgcn_readfirstlane(tid >> 6), lane = tid & 63, wr = wid >> 2, wc = wid & 3, fr = lane & 15, fq = lane >> 4;
  const int K = g.K, nt = K / BK, lda = g.lda;
  unsigned voffA[2], voffB[2];
#pragma unroll
  for (int i = 0; i < 2; ++i) { int Rr, C; stage_rc(tid * 16 + i * 8192, Rr, C); const int Rb = Epi::PERM ? ((Rr & ~31) + perm32(Rr & 31)) : Rr;
    voffA[i] = (unsigned)(Rr * lda + C) * 2u; voffB[i] = (unsigned)(Rb * K + C) * 2u; }
  const size_t kstep = (size_t)(BK * 2);
  const size_t hstepA = (size_t)HALF * lda * 2, hstepB = (size_t)HALF * K * 2;
  const size_t tstepA = 2 * hstepA, tstepB = 2 * hstepB;
  const unsigned ldsw = (unsigned)wid * 1024u;
  const int aoff = lds_byte(wr * 64 + fr, fq * 8), boff = lds_byte(wc * 32 + fr, fq * 8);
#define PG8_SA(b, h) (((b) * 2 + (h)) * HTB)
#define PG8_SB(b, h) ((4 + (b) * 2 + (h)) * HTB)
#define PG8_STAGE(bufoff, gbase, voff) do { _Pragma("unroll") for (int _i = 0; _i < 2; ++_i) \
    __builtin_amdgcn_global_load_lds((const unsigned*)((const char*)(gbase) + (voff)[_i]), (LAS unsigned*)(lds + (bufoff) + ldsw + _i * 8192), 16, 0, 0); } while (0)
#define PG8_LDA(dst, b, h) do { _Pragma("unroll") for (int m = 0; m < 4; ++m) _Pragma("unroll") for (int k = 0; k < 2; ++k) dst[m][k] = *(const LAS bf16x8*)(lds + PG8_SA(b, h) + aoff + m * 2048 + k * 1024); } while (0)
#define PG8_LDB(dst, b, h) do { _Pragma("unroll") for (int n = 0; n < 2; ++n) _Pragma("unroll") for (int k = 0; k < 2; ++k) dst[n][k] = *(const LAS bf16x8*)(lds + PG8_SB(b, h) + boff + n * 2048 + k * 1024); } while (0)
#define PG8_MMA(ai, bj, At, Bt) do { __builtin_amdgcn_s_setprio(1); _Pragma("unroll") for (int m = 0; m < 4; ++m) _Pragma("unroll") for (int n = 0; n < 2; ++n) _Pragma("unroll") for (int k = 0; k < 2; ++k) \
    acc[ai][bj][m][n] = __builtin_amdgcn_mfma_f32_16x16x32_bf16(Bt[n][k], At[m][k], acc[ai][bj][m][n], 0, 0, 0); __builtin_amdgcn_s_setprio(0); } while (0)
#define PG8_WAIT_V(n) asm volatile("s_waitcnt vmcnt(" #n ")" ::: "memory")
#define PG8_WAIT_L(n) asm volatile("s_waitcnt lgkmcnt(" #n ")" ::: "memory")
#define PG8_BAR __builtin_amdgcn_s_barrier()
#define PG8_SCHED __builtin_amdgcn_sched_barrier(0)
  Unit cur, nxt; int ui = 0;
  if (!S.next(0, cur)) return;
  f32x4 acc[2][2][4][2];
#pragma unroll
  for (int a = 0; a < 2; ++a)
#pragma unroll
    for (int b = 0; b < 2; ++b)
#pragma unroll
      for (int m = 0; m < 4; ++m)
#pragma unroll
        for (int n = 0; n < 2; ++n) acc[a][b][m][n] = (f32x4){0.f, 0.f, 0.f, 0.f};
  bf16x8 At[4][2], B0[2][2], B1[2][2];
  const char* cA = (const char*)g.A + (size_t)cur.pm * tstepA; const char* cB = (const char*)g.Bt + (size_t)cur.pn * tstepB;
  PG8_STAGE(PG8_SB(0, 0), cB, voffB); PG8_STAGE(PG8_SA(0, 0), cA, voffA); PG8_STAGE(PG8_SB(0, 1), cB + hstepB, voffB); PG8_STAGE(PG8_SA(0, 1), cA + hstepA, voffA);
  if (wr == 1) PG8_BAR;
  PG8_WAIT_V(4); PG8_BAR;
  PG8_STAGE(PG8_SB(1, 0), cB + kstep, voffB); PG8_STAGE(PG8_SA(1, 0), cA + kstep, voffA); PG8_STAGE(PG8_SB(1, 1), cB + hstepB + kstep, voffB);
  PG8_WAIT_V(6); PG8_BAR;
  for (;;) {
    const bool has_next = S.next(ui + 1, nxt);
    const char* nA = has_next ? (const char*)g.A + (size_t)nxt.pm * tstepA : cA; const char* nB = has_next ? (const char*)g.Bt + (size_t)nxt.pn * tstepB : cB;
    for (int t = 0; t < nt; t += 2) {
      const bool last = (t == nt - 2);
      const char* a1 = cA + (size_t)(t + 1) * kstep;
      const char* a2 = last ? nA : cA + (size_t)(t + 2) * kstep; const char* b2 = last ? nB : cB + (size_t)(t + 2) * kstep;
      const char* a3 = a2 + kstep; const char* b3 = b2 + kstep;
      PG8_LDB(B0, 0, 0); PG8_SCHED; PG8_LDA(At, 0, 0); PG8_STAGE(PG8_SA(1, 1), a1 + hstepA, voffA);
      PG8_WAIT_L(8); PG8_BAR; PG8_WAIT_L(0); PG8_MMA(0, 0, At, B0); PG8_BAR; PG8_SCHED;
      PG8_LDB(B1, 0, 1); PG8_STAGE(PG8_SB(0, 0), b2, voffB);
      PG8_BAR; PG8_WAIT_L(0); PG8_MMA(0, 1, At, B1); PG8_BAR;
      PG8_LDA(At, 0, 1); PG8_STAGE(PG8_SA(0, 0), a2, voffA);
      PG8_BAR; PG8_WAIT_L(0); PG8_MMA(1, 0, At, B0); PG8_BAR; PG8_SCHED;
      PG8_STAGE(PG8_SB(0, 1), b2 + hstepB, voffB);
      PG8_WAIT_V(6); PG8_BAR; PG8_MMA(1, 1, At, B1); PG8_BAR;
      PG8_LDB(B0, 1, 0); PG8_SCHED; PG8_LDA(At, 1, 0); PG8_STAGE(PG8_SA(0, 1), a2 + hstepA, voffA);
      PG8_WAIT_L(8); PG8_BAR; PG8_WAIT_L(0); PG8_MMA(0, 0, At, B0); PG8_BAR; PG8_SCHED;
      PG8_LDB(B1, 1, 1); PG8_STAGE(PG8_SB(1, 0), b3, voffB);
      PG8_BAR; PG8_WAIT_L(0); PG8_MMA(0, 1, At, B1); PG8_BAR;
      PG8_LDA(At, 1, 1); PG8_STAGE(PG8_SA(1, 0), a3, voffA);
      PG8_BAR; PG8_WAIT_L(0); PG8_MMA(1, 0, At, B0); PG8_BAR; PG8_SCHED;
      PG8_STAGE(PG8_SB(1, 1), b3 + hstepB, voffB);
      PG8_WAIT_V(6); PG8_BAR; PG8_MMA(1, 1, At, B1); PG8_BAR;
    }
    E(acc, cur, wr, wc, fr, fq);
    if (!has_next) break;
#pragma unroll
    for (int a = 0; a < 2; ++a)
#pragma unroll
      for (int b = 0; b < 2; ++b)
#pragma unroll
        for (int m = 0; m < 4; ++m)
#pragma unroll
          for (int n = 0; n < 2; ++n) acc[a][b][m][n] = (f32x4){0.f, 0.f, 0.f, 0.f};
    cur = nxt; cA = nA; cB = nB; ++ui;
  }
  PG8_WAIT_V(0);
  if (wr == 0) PG8_BAR;
  PG8_BAR;
#undef PG8_SA
#undef PG8_SB
#undef PG8_STAGE
#undef PG8_LDA
#undef PG8_LDB
#undef PG8_MMA
#undef PG8_WAIT_V
#undef PG8_WAIT_L
#undef PG8_BAR
#undef PG8_SCHED
}

struct EpiBf16 {
  static constexpr bool PERM = true;
  bf16_t* O; int ldc;
  __device__ __forceinline__ void operator()(const f32x4 (&acc)[2][2][4][2], const Unit& u, int wr, int wc, int fr, int fq) const {
    const int row0 = u.pm * BM + wr * 64 + fr, col0 = u.pn * BM + wc * 32 + 8 * fq;
#pragma unroll
    for (int ai = 0; ai < 2; ++ai)
#pragma unroll
      for (int m = 0; m < 4; ++m) { bf16_t* rowp = O + (size_t)(row0 + ai * HALF + m * 16) * ldc + col0;
#pragma unroll
        for (int bj = 0; bj < 2; ++bj) { const f32x4 v0 = acc[ai][bj][m][0], v1 = acc[ai][bj][m][1];
          u32x4 w; w.x = cvt_pk_bf16(v0[0], v0[1]); w.y = cvt_pk_bf16(v0[2], v0[3]); w.z = cvt_pk_bf16(v1[0], v1[1]); w.w = cvt_pk_bf16(v1[2], v1[3]);
          *(u32x4*)(rowp + bj * HALF) = w; } }
  }
};
struct EpiInProj {
  static constexpr bool PERM = true;
  bf16_t* O; int ldc; int nz; float* DT;
  __device__ __forceinline__ void operator()(const f32x4 (&acc)[2][2][4][2], const Unit& u, int wr, int wc, int fr, int fq) const {
    const int row0 = u.pm * BM + wr * 64 + fr;
    if (u.pn < nz) {
      const int col0 = u.pn * BM + wc * 32 + 8 * fq;
#pragma unroll
      for (int ai = 0; ai < 2; ++ai)
#pragma unroll
        for (int m = 0; m < 4; ++m) { bf16_t* rowp = O + (size_t)(row0 + ai * HALF + m * 16) * ldc + col0;
#pragma unroll
          for (int bj = 0; bj < 2; ++bj) { const f32x4 v0 = acc[ai][bj][m][0], v1 = acc[ai][bj][m][1];
            u32x4 w; w.x = cvt_pk_bf16(v0[0], v0[1]); w.y = cvt_pk_bf16(v0[2], v0[3]); w.z = cvt_pk_bf16(v1[0], v1[1]); w.w = cvt_pk_bf16(v1[2], v1[3]);
            *(u32x4*)(rowp + bj * HALF) = w; } }
    } else if (wc == 0) {
#pragma unroll
      for (int ai = 0; ai < 2; ++ai)
#pragma unroll
        for (int m = 0; m < 4; ++m) { float* rowp = DT + (size_t)(row0 + ai * HALF + m * 16) * 32 + 8 * fq;
          *(f32x4*)rowp = acc[ai][0][m][0]; *(f32x4*)(rowp + 4) = acc[ai][0][m][1]; }
    }
  }
};
struct EpiResid {
  static constexpr bool PERM = false;
  const float* hlat; const float* hctx; float* tlat; float* tctx; const float* gate;
  __device__ __forceinline__ void operator()(const f32x4 (&acc)[2][2][4][2], const Unit& u, int wr, int wc, int fr, int fq) const {
    const int b = u.pm / 33, tt = u.pm % 33; const bool isctx = (tt == 0);
    const float* hs = isctx ? hctx + (size_t)b * CTXL * D : hlat + ((size_t)b * SEQ + (size_t)(tt - 1) * 256) * D;
    float* td = isctx ? tctx + (size_t)b * CTXL * D : tlat + ((size_t)b * SEQ + (size_t)(tt - 1) * 256) * D;
    const float* gt = gate + (size_t)(isctx ? 4 : b) * 6144;
    const int lrow0 = wr * 64 + fr, col0 = u.pn * BM + wc * 32 + 4 * fq;
#pragma unroll
    for (int bj = 0; bj < 2; ++bj)
#pragma unroll
      for (int n = 0; n < 2; ++n) { const f32x4 gvv = *(const f32x4*)(gt + col0 + bj * HALF + n * 16);
#pragma unroll
        for (int ai = 0; ai < 2; ++ai) {
#pragma unroll
          for (int m = 0; m < 4; ++m) { const size_t off = (size_t)(lrow0 + ai * HALF + m * 16) * D + col0 + bj * HALF + n * 16;
            const f32x4 hv = *(const f32x4*)(hs + off);
            *(f32x4*)(td + off) = hv * ALPHA + gvv * acc[ai][bj][m][n]; }
          asm volatile("" ::: "memory"); } }
  }
};
struct EpiGateMul {
  static constexpr bool PERM = true;
  bf16_t* O; int ldc;
  __device__ __forceinline__ void operator()(const f32x4 (&acc)[2][2][4][2], const Unit& u, int wr, int wc, int fr, int fq) const {
    const int row0 = u.pm * BM + wr * 64 + fr, col0 = u.pn * BM + wc * 32 + 8 * fq;
#pragma unroll
    for (int ai = 0; ai < 2; ++ai)
#pragma unroll
      for (int m = 0; m < 4; ++m) { bf16_t* rowp = O + (size_t)(row0 + ai * HALF + m * 16) * ldc + col0;
#pragma unroll
        for (int bj = 0; bj < 2; ++bj) { const f32x4 v0 = acc[ai][bj][m][0], v1 = acc[ai][bj][m][1];
          const u32x4 o = *(const u32x4*)(rowp + bj * HALF);
          u32x4 w;
          w.x = cvt_pk_bf16(bflo(o.x) * siluf_(v0[0]), bfhi(o.x) * siluf_(v0[1])); w.y = cvt_pk_bf16(bflo(o.y) * siluf_(v0[2]), bfhi(o.y) * siluf_(v0[3]));
          w.z = cvt_pk_bf16(bflo(o.z) * siluf_(v1[0]), bfhi(o.z) * siluf_(v1[1])); w.w = cvt_pk_bf16(bflo(o.w) * siluf_(v1[2]), bfhi(o.w) * siluf_(v1[3]));
          *(u32x4*)(rowp + bj * HALF) = w; } }
  }
};
struct EpiSwiGLU {
  static constexpr bool PERM = true;
  bf16_t* H;
  __device__ __forceinline__ void operator()(const f32x4 (&acc)[2][2][4][2], const Unit& u, int wr, int wc, int fr, int fq) const {
    const int row0 = u.pm * BM + wr * 64 + fr, col0 = (u.pn & 3) * 128 + wc * 32 + 8 * fq;
#pragma unroll
    for (int ai = 0; ai < 2; ++ai)
#pragma unroll
      for (int m = 0; m < 4; ++m) { bf16_t* rowp = H + (size_t)(row0 + ai * HALF + m * 16) * DEXP + col0;
        const f32x4 g0 = acc[ai][0][m][0], g1 = acc[ai][0][m][1], u0 = acc[ai][1][m][0], u1 = acc[ai][1][m][1];
        u32x4 w; w.x = cvt_pk_bf16(siluf_(g0[0]) * u0[0], siluf_(g0[1]) * u0[1]); w.y = cvt_pk_bf16(siluf_(g0[2]) * u0[2], siluf_(g0[3]) * u0[3]);
        w.z = cvt_pk_bf16(siluf_(g1[0]) * u1[0], siluf_(g1[1]) * u1[1]); w.w = cvt_pk_bf16(siluf_(g1[2]) * u1[2], siluf_(g1[3]) * u1[3]);
        *(u32x4*)rowp = w; }
  }
};
struct EpiMoeDown {
  static constexpr bool PERM = true;
  bf16_t* Y; const float* slotw;
  __device__ __forceinline__ void operator()(const f32x4 (&acc)[2][2][4][2], const Unit& u, int wr, int wc, int fr, int fq) const {
    const int row0 = u.pm * BM + wr * 64 + fr, col0 = (u.pn & 3) * BM + wc * 32 + 8 * fq;
#pragma unroll
    for (int ai = 0; ai < 2; ++ai)
#pragma unroll
      for (int m = 0; m < 4; ++m) { const int row = row0 + ai * HALF + m * 16; const float sw = slotw[row]; bf16_t* rowp = Y + (size_t)row * D + col0;
#pragma unroll
        for (int bj = 0; bj < 2; ++bj) { const f32x4 v0 = acc[ai][bj][m][0] * sw, v1 = acc[ai][bj][m][1] * sw;
          u32x4 w; w.x = cvt_pk_bf16(v0[0], v0[1]); w.y = cvt_pk_bf16(v0[2], v0[3]); w.z = cvt_pk_bf16(v1[0], v1[1]); w.w = cvt_pk_bf16(v1[2], v1[3]);
          *(u32x4*)(rowp + bj * HALF) = w; } }
  }
};
}

struct Ctx {
  LAS unsigned char* lds; int tid, lane, wave, gw, ngw, bid, nblk;
};
#define GAS __attribute__((address_space(1)))
#define WS(off, T) ((T*)(GAS T*)(P.ws + (off)))
#define GIN(i) ((const float*)(const GAS float*)P.in[i])
#define GOUT ((float*)(GAS float*)P.out)

__device__ __forceinline__ void transpose_item(const float* W, int ldw, int col0, int k0, bf16_t* dst_row0, int ldd, LAS float* scr, int lane) {
#pragma unroll 8
  for (int i = 0; i < 32; ++i) { const int kk = 2 * i + (lane >> 5); scr[kk * 33 + (lane & 31)] = W[(size_t)(k0 + kk) * ldw + col0 + (lane & 31)]; }
  asm volatile("s_waitcnt lgkmcnt(0)" ::: "memory");
  const int c = lane & 7;
#pragma unroll
  for (int j = 0; j < 4; ++j) { const int n = (lane >> 3) + 8 * j; const LAS float* s = scr + (8 * c) * 33 + n;
    u32x4 o; o.x = pk2(s[0 * 33], s[1 * 33]); o.y = pk2(s[2 * 33], s[3 * 33]); o.z = pk2(s[4 * 33], s[5 * 33]); o.w = pk2(s[6 * 33], s[7 * 33]);
    *(u32x4*)(dst_row0 + (size_t)n * ldd + k0 + 8 * c) = o; }
  asm volatile("s_waitcnt lgkmcnt(0)" ::: "memory");
}
__device__ __forceinline__ void transpose_mat_item(const float* W, int ldw, int col0, int K, int ncols, bf16_t* dst, int ldd, int gu, int it, LAS float* scr, int lane) {
  const int nblk = ncols / 32, kb = it / nblk, nb = it % nblk, n0 = 32 * nb;
  const int drow = gu ? (256 * (n0 >> 7) + (n0 & 127) + (gu == 2 ? 128 : 0)) : n0;
  transpose_item(W, ldw, col0 + n0, 64 * kb, dst + (size_t)drow * ldd, ldd, scr, lane);
}
__device__ __forceinline__ void convert_experts(const Params& P, int layer, bf16_t* wgu, bf16_t* wd, const Ctx& C, LAS float* scr) {
  for (int it = C.gw; it < NEXP * 768; it += C.ngw) {
    const int e = it / 768, r = it % 768;
    const size_t eoff = ((size_t)layer * NEXP + e) * (size_t)D * DEXP;
    if (r < 256) transpose_mat_item(GIN(I_EWG) + eoff, DEXP, 0, D, DEXP, wgu + (size_t)e * 1024 * D, D, 1, r, scr, C.lane);
    else if (r < 512) transpose_mat_item(GIN(I_EWU) + eoff, DEXP, 0, D, DEXP, wgu + (size_t)e * 1024 * D, D, 2, r - 256, scr, C.lane);
    else transpose_mat_item(GIN(I_EWD) + eoff, D, 0, DEXP, D, wd + (size_t)e * D * DEXP, DEXP, 0, r - 512, scr, C.lane);
  }
}

__device__ __forceinline__ void row_load(const float* row, int lane, f32x4 (&v)[4]) {
#pragma unroll
  for (int j = 0; j < 4; ++j) v[j] = *(const f32x4*)(row + 4 * lane + 256 * j);
}
__device__ __forceinline__ void row_store(float* row, int lane, const f32x4 (&v)[4]) {
#pragma unroll
  for (int j = 0; j < 4; ++j) *(f32x4*)(row + 4 * lane + 256 * j) = v[j];
}
__device__ __forceinline__ void row_store_bf16(bf16_t* row, int lane, const f32x4 (&v)[4]) {
#pragma unroll
  for (int j = 0; j < 4; ++j) { u32x2 w; w.x = pk2(v[j][0], v[j][1]); w.y = pk2(v[j][2], v[j][3]); *(u32x2*)(row + 4 * lane + 256 * j) = w; }
}
__device__ __forceinline__ void row_layernorm(f32x4 (&v)[4], const float* g, const float* b, int lane) {
  float s = 0.f;
#pragma unroll
  for (int j = 0; j < 4; ++j) s += (v[j][0] + v[j][1]) + (v[j][2] + v[j][3]);
  const float mean = wave_sum(s) * (1.f / D); float s2 = 0.f;
#pragma unroll
  for (int j = 0; j < 4; ++j) { v[j] = v[j] - mean; s2 += (v[j][0] * v[j][0] + v[j][1] * v[j][1]) + (v[j][2] * v[j][2] + v[j][3] * v[j][3]); }
  const float rstd = rsqrtf(wave_sum(s2) * (1.f / D) + LN_EPS);
#pragma unroll
  for (int j = 0; j < 4; ++j) { const f32x4 gg = *(const f32x4*)(g + 4 * lane + 256 * j), bb = *(const f32x4*)(b + 4 * lane + 256 * j); v[j] = v[j] * rstd * gg + bb; }
}
__device__ __forceinline__ void row_modulate(const f32x4 (&h)[4], const float* shift, const float* scale, int lane, f32x4 (&u)[4]) {
#pragma unroll
  for (int j = 0; j < 4; ++j) { const f32x4 sh = *(const f32x4*)(shift + 4 * lane + 256 * j), sc = *(const f32x4*)(scale + 4 * lane + 256 * j); u[j] = h[j] * (sc + 1.f) + sh; }
}
__device__ __forceinline__ void row_dot32(const f32x4 (&u)[4], const LAS float* Wt, int lane, float* out32) {
  float myv = 0.f;
#pragma unroll 4
  for (int c = 0; c < 32; ++c) {
    float s = 0.f;
#pragma unroll
    for (int j = 0; j < 4; ++j) { const f32x4 w = *(const LAS f32x4*)(Wt + c * 1024 + 4 * lane + 256 * j); s += (u[j][0] * w[0] + u[j][1] * w[1]) + (u[j][2] * w[2] + u[j][3] * w[3]); }
    s = wave_sum(s);
    if (lane == c) myv = s;
  }
  if (lane < 32) out32[lane] = myv;
}
__device__ __forceinline__ void stage_cols32(const float* W, int ldw, int col0, LAS float* Wt, int tid) {
  for (int i = tid; i < 1024 * 32; i += NT) { const int k = i >> 5, c = i & 31; Wt[c * 1024 + k] = W[(size_t)k * ldw + col0 + c]; }
}
__device__ __forceinline__ const float* lat_or_ctx(const float* lat, const float* ctxp, int r) {
  const int b = r / TB, pos = r % TB;
  return pos < CTXL ? ctxp + ((size_t)b * CTXL + pos) * D : lat + ((size_t)b * SEQ + (pos - CTXL)) * D;
}
__device__ __forceinline__ float* lat_or_ctx_w(float* lat, float* ctxp, int r) {
  const int b = r / TB, pos = r % TB;
  return pos < CTXL ? ctxp + ((size_t)b * CTXL + pos) * D : lat + ((size_t)b * SEQ + (pos - CTXL)) * D;
}
__device__ __forceinline__ int row_b5(int r) { const int b = r / TB, pos = r % TB; return pos < CTXL ? 4 : b; }

__device__ __forceinline__ void phase0(const Params& P, const Ctx& C) {
  LAS float* sv = (LAS float*)C.lds;
  LAS float* part = (LAS float*)(C.lds + 20480);
  LAS float* scr = (LAS float*)(C.lds + 32768) + C.wave * (64 * 33);
  for (int i = C.tid; i < 5 * 1024; i += NT) { const float x = i < 4096 ? GIN(I_C)[i] : GIN(I_CCTX)[i - 4096]; sv[i] = siluf_(x); }
  __syncthreads();
  float* MOD = WS(OFF_MOD, float);
  for (int task = C.bid; task < 2 * 96; task += C.nblk) {
    const int l = task / 96, n0 = (task % 96) * 64;
    const float* W = GIN(I_ADAW) + (size_t)l * D * 6144 + n0 + C.lane;
    float acc[5] = {0.f, 0.f, 0.f, 0.f, 0.f};
    const int kbeg = C.wave * 128;
#pragma unroll 8
    for (int k = kbeg; k < kbeg + 128; ++k) { const float w = W[(size_t)k * 6144];
#pragma unroll
      for (int r = 0; r < 5; ++r) acc[r] += sv[r * 1024 + k] * w; }
#pragma unroll
    for (int r = 0; r < 5; ++r) part[(C.wave * 5 + r) * 64 + C.lane] = acc[r];
    __syncthreads();
    if (C.tid < 320) { const int r = C.tid / 64, c = C.tid % 64; float s = GIN(I_ADAB)[l * 6144 + n0 + c];
#pragma unroll
      for (int w = 0; w < 8; ++w) s += part[(w * 5 + r) * 64 + c];
      MOD[((size_t)l * 5 + r) * 6144 + n0 + c] = s; }
    __syncthreads();
  }
  if (C.bid == C.nblk - 1) { float* LB = WS(OFF_LB1, float); for (int i = C.tid; i < 1024; i += NT) { const float a = GIN(I_HLB)[i], b = GIN(I_HLB)[1024 + i]; LB[i] = 1.f / (1.f + __expf(a - b)); } }
  constexpr int N_AB = 16 * 144, N_OUT = 32 * 32, N_G1 = 16 * 32;
  constexpr int TOT = N_AB + 2 * N_OUT + 2 * N_G1;
  for (int it = C.gw; it < TOT; it += C.ngw) {
    int r = it;
    if (r < N_AB) { transpose_mat_item(GIN(I_ABW), AB_IN, 0, D, Z0W, WS(OFF_WAB, bf16_t), D, 0, r, scr, C.lane); continue; } r -= N_AB;
    if (r < N_OUT) { transpose_mat_item(GIN(I_OUTW), D, 0, 2048, D, WS(OFF_WOUT0, bf16_t), 2048, 0, r, scr, C.lane); continue; } r -= N_OUT;
    if (r < N_OUT) { transpose_mat_item(GIN(I_OUTW) + (size_t)2048 * D, D, 0, 2048, D, WS(OFF_WOUT1, bf16_t), 2048, 0, r, scr, C.lane); continue; } r -= N_OUT;
    if (r < N_G1) { transpose_mat_item(GIN(I_CDW), CD_IN, 3072, D, 1024, WS(OFF_WG1, bf16_t), D, 0, r, scr, C.lane); continue; } r -= N_G1;
    transpose_mat_item(GIN(I_CDW), CD_IN, 8224, D, 1024, WS(OFF_WG1, bf16_t) + (size_t)1024 * D, D, 0, r, scr, C.lane);
  }
  for (int it = C.gw; it < 16; it += C.ngw) transpose_mat_item(GIN(I_ABW), AB_IN, 4608, D, 32, WS(OFF_WAB, bf16_t) + (size_t)4608 * D, D, 0, it, scr, C.lane);
  { u32x4* z = (u32x4*)(WS(OFF_WAB, bf16_t) + (size_t)4640 * D); const u32x4 zz = {0u, 0u, 0u, 0u};
    for (int i = C.bid * NT + C.tid; i < 224 * D * 2 / 16; i += C.nblk * NT) z[i] = zz; }
  convert_experts(P, 0, WS(OFF_WE0, bf16_t), WS(OFF_WE0 + 64 * MiB, bf16_t), C, scr);
}

__device__ __forceinline__ void phase_u0(const Params& P, const Ctx& C) {
  const float* MOD = WS(OFF_MOD, float); bf16_t* U = WS(OFF_U0, bf16_t);
  f32x4 h[4], hn[4];
  if (C.gw < R) row_load(lat_or_ctx(GIN(I_X), GIN(I_CTX), C.gw), C.lane, h);
  for (int r = C.gw; r < R; r += C.ngw) {
    if (r + C.ngw < R) row_load(lat_or_ctx(GIN(I_X), GIN(I_CTX), r + C.ngw), C.lane, hn);
    f32x4 u[4];
    const float* m = MOD + (size_t)row_b5(r) * 6144;
    row_modulate(h, m, m + D, C.lane, u);
    row_store_bf16(U + (size_t)r * D, C.lane, u);
#pragma unroll
    for (int j = 0; j < 4; ++j) h[j] = hn[j];
  }
}

__device__ __forceinline__ void phase_inproj(const Params& P, const Ctx& C, const bf16_t* U, const bf16_t* W, bf16_t* Z, int zw) {
  pg8::Gemm g{U, W, D, D}; pg8::GridOrder S; S.init(R / 256, zw / 256 + 1, C.nblk, C.bid, 0);
  pg8::EpiInProj E{Z, zw, zw / 256, WS(OFF_DT, float)};
  pg8::gemm_phase(C.lds, g, S, E);
}

__device__ __forceinline__ void conv_task(bf16_t* Z, int zw, int row0, int L, int col, const float* cw, int cwld, int cch, const float* cb, int mode, float qscale, int lane) {
  float w[4][2];
#pragma unroll
  for (int j = 0; j < 4; ++j) { w[j][0] = cw[j * cwld + cch + 2 * lane]; w[j][1] = cw[j * cwld + cch + 2 * lane + 1]; }
  const float b0 = cb ? cb[cch + 2 * lane] : 0.f, b1 = cb ? cb[cch + 2 * lane + 1] : 0.f;
  unsigned* base = (unsigned*)(Z + (size_t)row0 * zw + col) + lane;
  const size_t rs = (size_t)zw / 2;
  float pm2[2] = {0.f, 0.f}, pm1[2] = {0.f, 0.f};
  for (int t0 = 0; t0 < L; t0 += 16) {
    unsigned v[17];
#pragma unroll
    for (int i = 0; i < 16; ++i) v[i] = base[(size_t)(t0 + i) * rs];
    v[16] = (t0 + 16 < L) ? base[(size_t)(t0 + 16) * rs] : 0u;
    unsigned o[16];
#pragma unroll
    for (int i = 0; i < 16; ++i) {
      const float x0 = bflo(v[i]), x1 = bfhi(v[i]), n0 = bflo(v[i + 1]), n1 = bfhi(v[i + 1]);
      float y0 = w[0][0] * pm2[0] + w[1][0] * pm1[0] + w[2][0] * x0 + w[3][0] * n0 + b0;
      float y1 = w[0][1] * pm2[1] + w[1][1] * pm1[1] + w[2][1] * x1 + w[3][1] * n1 + b1;
      pm2[0] = pm1[0]; pm2[1] = pm1[1]; pm1[0] = x0; pm1[1] = x1;
      if (mode >= 1) { y0 = siluf_(y0); y1 = siluf_(y1); }
      if (mode == 2) { const float ss = wave_sum(y0 * y0 + y1 * y1); const float sc = rsqrtf(ss + RMS_EPS) * qscale; y0 *= sc; y1 *= sc; }
      o[i] = pk2(y0, y1);
    }
#pragma unroll
    for (int i = 0; i < 16; ++i) base[(size_t)(t0 + i) * rs] = o[i];
  }
}
__device__ __forceinline__ void seg_rows(int seg, int& row0, int& L) {
  const int b = seg / 129, s = seg % 129;
  if (s == 0) { row0 = b * TB; L = CTXL; } else { row0 = b * TB + CTXL + (s - 1) * 64; L = 64; }
}
__device__ __forceinline__ void phase_feat0(const Params& P, const Ctx& C) {
  bf16_t* Z = WS(OFF_Z0, bf16_t);
  for (int task = C.gw; task < NB * 129 * 20; task += C.ngw) {
    const int seg = task / 20, cg = task % 20; int row0, L; seg_rows(seg, row0, L);
    if (cg < 8) conv_task(Z, Z0W, row0, L, Z0_RGX + cg * 128, GIN(I_RGCW), 1024, cg * 128, GIN(I_RGCB), 0, 1.f, C.lane);
    else conv_task(Z, Z0W, row0, L, Z0_XBC + (cg - 8) * 128, GIN(I_SCW), 1536, (cg - 8) * 128, GIN(I_SCB), 1, 1.f, C.lane);
  }
}
__device__ __forceinline__ void phase_feat1(const Params& P, const Ctx& C) {
  bf16_t* Z = WS(OFF_Z1, bf16_t);
  for (int task = C.gw; task < NB * 129 * 24; task += C.ngw) {
    const int seg = task / 24, cg = task % 24; int row0, L; seg_rows(seg, row0, L);
    if (cg < 16) conv_task(Z, Z1W, row0, L, cg * 128, GIN(I_GCW), 3072, cg * 128, nullptr, 2, cg < 8 ? 0.08838834764831845f : 1.f, C.lane);
    else conv_task(Z, Z1W, row0, L, cg * 128, GIN(I_GCW), 3072, cg * 128, nullptr, 1, 1.f, C.lane);
  }
}

__device__ __forceinline__ int seq_pos(int dir, int j) { return dir == 0 ? j : (j < CTXL ? CTXL - 1 - j : TB - 1 - (j - CTXL)); }
__device__ __forceinline__ int seq_chunk(int dir, int j) { return dir == 0 ? j : (j < 4 ? 3 - j : 135 - j); }

__device__ __forceinline__ void rg_task(const Params& P, const Ctx& C, int task) {
  const int b = task >> 6, h = (task >> 3) & 7, q = task & 7;
  LAS float* Wl = (LAS float*)C.lds;
  LAS float* xc = Wl + 2 * 2 * 128 * 16;
  LAS float* SA = xc + 64 * 129;
  LAS float* SU = SA + 16 * 64;
  const bf16_t* Z = WS(OFF_Z0, bf16_t); bf16_t* MIX = WS(OFF_MIX0, bf16_t);
  __syncthreads();
  for (int i = C.tid; i < 2 * 2 * 128 * 16; i += NT) { const int j = i & 15, ii = (i >> 4) & 127, gate = (i >> 11) & 1, d = i >> 12;
    const float* W = (gate ? GIN(I_RGXW) : GIN(I_RGAW)) + ((size_t)(d * 8 + h) * 128 + ii) * 128 + q * 16 + j; Wl[i] = *W; }
  const int j = C.tid & 15, tg = C.tid >> 4;
  const int ch = h * 128 + q * 16 + j;
  const int sch = C.wave * 2;
  for (int d = 0; d < 2; ++d) {
    const float ba = GIN(I_RGAB)[d * 1024 + ch], bx = GIN(I_RGXB)[d * 1024 + ch], spl = softplusf_(-GIN(I_RGLAM)[d * 1024 + ch]);
    float hin0 = 0.f, hin1 = 0.f;
    for (int cs = 0; cs < 132; ++cs) {
      const int chunk = seq_chunk(d, cs), row0 = b * TB + chunk * 64;
      __syncthreads();
      { const int t = C.tid >> 3, sg = C.tid & 7; const u32x4* src = (const u32x4*)(Z + (size_t)(row0 + t) * Z0W + Z0_RGX + h * 128 + sg * 16);
        const u32x4 a = src[0], bb = src[1]; LAS float* dst = xc + t * 129 + sg * 16;
        dst[0] = bflo(a.x); dst[1] = bfhi(a.x); dst[2] = bflo(a.y); dst[3] = bfhi(a.y); dst[4] = bflo(a.z); dst[5] = bfhi(a.z); dst[6] = bflo(a.w); dst[7] = bfhi(a.w);
        dst[8] = bflo(bb.x); dst[9] = bfhi(bb.x); dst[10] = bflo(bb.y); dst[11] = bfhi(bb.y); dst[12] = bflo(bb.z); dst[13] = bfhi(bb.z); dst[14] = bflo(bb.w); dst[15] = bfhi(bb.w); }
      __syncthreads();
      { const LAS float* Wa = Wl + (d * 2 + 0) * 2048 + j; const LAS float* Wx = Wl + (d * 2 + 1) * 2048 + j;
        const LAS float* x0 = xc + (2 * tg) * 129; const LAS float* x1 = x0 + 129;
        float aa0 = 0.f, aa1 = 0.f, ax0 = 0.f, ax1 = 0.f;
#pragma unroll 8
        for (int i = 0; i < 128; ++i) { const float wa = Wa[i * 16], wx = Wx[i * 16], v0 = x0[i], v1 = x1[i]; aa0 += v0 * wa; aa1 += v1 * wa; ax0 += v0 * wx; ax1 += v1 * wx; }
#pragma unroll
        for (int tt = 0; tt < 2; ++tt) { const int t = 2 * tg + tt; const float pa = tt ? aa1 : aa0, px = tt ? ax1 : ax0;
          const float r = sigmoidf_(pa + ba), ig = sigmoidf_(px + bx); const float la = -8.f * r * spl; const float xv = xc[t * 129 + q * 16 + j];
          SA[j * 64 + t] = __expf(la); SU[j * 64 + t] = sqrtf(-expm1f(2.f * la)) * (ig * xv); } }
      __syncthreads();
#pragma unroll
      for (int cc = 0; cc < 2; ++cc) {
        const int lc = sch + cc; const int t = d == 0 ? C.lane : 63 - C.lane;
        float A = SA[lc * 64 + t], Bv = SU[lc * 64 + t];
#pragma unroll
        for (int off = 1; off < 64; off <<= 1) { const float Ap = __shfl_up(A, off), Bp = __shfl_up(Bv, off); if (C.lane >= off) { Bv = A * Bp + Bv; A = A * Ap; } }
        const float hin = cc ? hin1 : hin0; const float hv = Bv + A * hin;
        const float hlast = __shfl(hv, 63); if (cc) hin1 = hlast; else hin0 = hlast;
        const int gch = h * 128 + q * 16 + lc; bf16_t* o = MIX + (size_t)(row0 + t) * MIXW + gch;
        if (d == 0) *o = (bf16_t)f2bf(hv);
        else { const float hf = bf2f(*o); const float gy = bf2f(Z[(size_t)(row0 + t) * Z0W + Z0_RGY + gch]); *o = (bf16_t)f2bf((hf + hv) * geluf_(gy)); }
      }
    }
    __threadfence_block();
  }
}
__device__ __forceinline__ void ssd_task(const Params& P, const Ctx& C, int task) {
  const int b = task >> 9, hd = (task >> 5) & 15, ps = task & 31, g = hd >> 3;
  const int c = C.lane >> 5, ng = C.lane & 31;
  const bf16_t* Z = WS(OFF_Z0, bf16_t); bf16_t* MIX = WS(OFF_MIX0, bf16_t); const float* DT = WS(OFF_DT, float);
  const int colx = Z0_XBC + hd * 64 + 2 * ps + c, colB = Z0_B + g * 128 + 4 * ng, colC = Z0_C + g * 128 + 4 * ng, outc = 1024 + hd * 64 + 2 * ps + c;
  for (int d = 0; d < 2; ++d) {
    const float Aneg = -__expf(GIN(I_SALOG)[d * 16 + hd]), dtb = GIN(I_SDTB)[d * 16 + hd];
    float S0 = 0.f, S1 = 0.f, S2 = 0.f, S3 = 0.f;
    for (int j0 = 0; j0 < TB; j0 += 8) {
      u32x2 Bv[8], Cv[8]; unsigned short xv[8], yp[8]; float dtr[8];
#pragma unroll
      for (int u = 0; u < 8; ++u) { const size_t row = (size_t)b * TB + seq_pos(d, j0 + u);
        Bv[u] = *(const u32x2*)(Z + row * Z0W + colB); Cv[u] = *(const u32x2*)(Z + row * Z0W + colC); xv[u] = Z[row * Z0W + colx]; dtr[u] = DT[row * 32 + d * 16 + hd];
        yp[u] = d ? MIX[row * MIXW + outc] : (unsigned short)0; }
#pragma unroll
      for (int u = 0; u < 8; ++u) { const size_t row = (size_t)b * TB + seq_pos(d, j0 + u);
        const float dt = softplusf_(dtr[u] + dtb), a = __expf(Aneg * dt), xdt = bf2f(xv[u]) * dt;
        S0 = a * S0 + bflo(Bv[u].x) * xdt; S1 = a * S1 + bfhi(Bv[u].x) * xdt; S2 = a * S2 + bflo(Bv[u].y) * xdt; S3 = a * S3 + bfhi(Bv[u].y) * xdt;
        float y = (bflo(Cv[u].x) * S0 + bfhi(Cv[u].x) * S1) + (bflo(Cv[u].y) * S2 + bfhi(Cv[u].y) * S3);
        y = half_sum32(y);
        if (ng == 0) MIX[row * MIXW + outc] = (bf16_t)f2bf(y + bf2f(yp[u])); }
    }
    __threadfence_block();
  }
}

#define LBAR() do { asm volatile("s_waitcnt lgkmcnt(0)" ::: "memory"); __builtin_amdgcn_s_barrier(); asm volatile("" ::: "memory"); } while (0)
#define VMWAIT() asm volatile("s_waitcnt vmcnt(0)" ::: "memory")
typedef short s16x4 __attribute__((ext_vector_type(4)));
__device__ __forceinline__ bf16x8 frag_row(const LAS bf16_t* base, int ld, int r0, int k0, int lane) {
  return *(const LAS bf16x8*)(base + (r0 + (lane & 15)) * ld + k0 + 8 * (lane >> 4));
}
__device__ __forceinline__ bf16x8 frag_tr(const LAS bf16_t* base, int ld, int k0, int n0, int lane) {
  const int g = lane >> 4, q = (lane & 15) >> 2, p = lane & 3;
  const LAS bf16_t* a0 = base + (k0 + 8 * g + q) * ld + n0 + 4 * p;
  const s16x4 v0 = __builtin_amdgcn_ds_read_tr16_b64_v4i16((LAS s16x4*)a0);
  const s16x4 v1 = __builtin_amdgcn_ds_read_tr16_b64_v4i16((LAS s16x4*)(a0 + 4 * ld));
  bf16x8 r; r[0] = v0[0]; r[1] = v0[1]; r[2] = v0[2]; r[3] = v0[3]; r[4] = v1[0]; r[5] = v1[1]; r[6] = v1[2]; r[7] = v1[3];
  return r;
}
__device__ __forceinline__ f32x4 mma16(bf16x8 fa, bf16x8 fb, f32x4 acc) { return __builtin_amdgcn_mfma_f32_16x16x32_bf16(fa, fb, acc, 0, 0, 0); }
__device__ __forceinline__ float wave_incl_scan(float v, int lane) {
#pragma unroll
  for (int off = 1; off < 64; off <<= 1) { const float p = __shfl_up(v, off); if (lane >= off) v += p; }
  return v;
}
__device__ __forceinline__ void tri_tile(int tt, int& I, int& J) { I = tt >= 6 ? 3 : (tt >= 3 ? 2 : (tt >= 1 ? 1 : 0)); J = tt - (I * (I + 1)) / 2; }
__device__ __forceinline__ unsigned long long ld_agent_u64(const void* p) { return __hip_atomic_load((const unsigned long long*)p, __ATOMIC_RELAXED, __HIP_MEMORY_SCOPE_AGENT); }
__device__ __forceinline__ bool fwd_first(int c) { return c < 4 ? (c <= 1) : (c <= 67); }

__device__ __forceinline__ void ssd_chain_wg(const Params& P, const Ctx& C, int task) {
  const int b = task >> 5, hd = (task >> 1) & 15, ps = task & 1, g = hd >> 3;
  const int d = C.wave >> 2, w = C.wave & 3, td = C.tid & 255, lane = C.lane, fr = lane & 15, fq = lane >> 4;
  constexpr int LDN = 136, LDP = 40, LDT = 72;
  constexpr int DIRSZ = 78 * 1024;
  LAS unsigned char* L = C.lds + d * DIRSZ;
  LAS bf16_t* Cs = (LAS bf16_t*)L;
  LAS bf16_t* Bs = Cs + 64 * LDN;
  LAS bf16_t* Xd = Bs + 64 * LDN;
  LAS bf16_t* Xw = Xd + 64 * LDP;
  LAS bf16_t* Pt = Xw + 64 * LDP;
  LAS bf16_t* St = Pt + 64 * LDT;
  LAS float* dtL = (LAS float*)(St + 2 * 32 * LDN);
  const bf16_t* Z = WS(OFF_Z0, bf16_t); bf16_t* MIX = WS(OFF_MIX0, bf16_t); const float* DT = WS(OFF_DT, float);
  const float Aneg = -__expf(GIN(I_SALOG)[d * 16 + hd]), dtb = GIN(I_SDTB)[d * 16 + hd];
  const int colC = Z0_C + g * 128, colB = Z0_B + g * 128, colX = Z0_XBC + hd * 64 + ps * 32, outc = 1024 + hd * 64 + ps * 32;
  __syncthreads();
  for (int i = td; i < 64 * LDT / 2; i += 256) ((LAS unsigned*)Pt)[i] = 0u;
  for (int i = td; i < 2 * 32 * LDN / 2; i += 256) ((LAS unsigned*)St)[i] = 0u;
  f32x4 Sacc[2][2];
#pragma unroll
  for (int a = 0; a < 2; ++a)
#pragma unroll
    for (int c = 0; c < 2; ++c) Sacc[a][c] = (f32x4){0.f, 0.f, 0.f, 0.f};
  const int st_t = td >> 2, st_q = td & 3;
  u32x4 rc[4], rb[4], rx; float rdt = 0.f;
  auto issue_loads = [&](int step) {
    const int chunk = seq_chunk(d, step); const size_t row = (size_t)b * TB + chunk * 64 + st_t;
    const u32x4* pc = (const u32x4*)(Z + row * Z0W + colC + st_q * 32); const u32x4* pb = (const u32x4*)(Z + row * Z0W + colB + st_q * 32);
#pragma unroll
    for (int i = 0; i < 4; ++i) { rc[i] = pc[i]; rb[i] = pb[i]; }
    rx = *(const u32x4*)(Z + row * Z0W + colX + st_q * 8);
    rdt = DT[row * 32 + d * 16 + hd];
  };
  issue_loads(0);
  for (int step = 0; step < 132; ++step) {
    const int chunk = seq_chunk(d, step); const int row0 = b * TB + chunk * 64;
    VMWAIT();
    { const int i = d ? 63 - st_t : st_t; const float dt = softplusf_(rdt + dtb);
      LAS u32x4* dc = (LAS u32x4*)(Cs + i * LDN + st_q * 32); LAS u32x4* db = (LAS u32x4*)(Bs + i * LDN + st_q * 32);
#pragma unroll
      for (int k = 0; k < 4; ++k) { dc[k] = rc[k]; db[k] = rb[k]; }
      u32x4 xo; xo.x = pk2(bflo(rx.x) * dt, bfhi(rx.x) * dt); xo.y = pk2(bflo(rx.y) * dt, bfhi(rx.y) * dt); xo.z = pk2(bflo(rx.z) * dt, bfhi(rx.z) * dt); xo.w = pk2(bflo(rx.w) * dt, bfhi(rx.w) * dt);
      *(LAS u32x4*)(Xd + i * LDP + st_q * 8) = xo;
      if (st_q == 0) dtL[i] = dt; }
    LBAR();
    if (step + 1 < 132) issue_loads(step + 1);
    const bool first = (d == 0) == fwd_first(chunk);
    bf16_t* op0; unsigned long long ppv[2] = {0ull, 0ull};
    { const int ii = 16 * w + fr; const int t = d ? 63 - ii : ii; op0 = MIX + (size_t)(row0 + t) * MIXW + outc + 4 * fq;
      if (!first) { ppv[0] = ld_agent_u64(op0); ppv[1] = ld_agent_u64(op0 + 16); } }
    const float cum = wave_incl_scan(Aneg * dtL[lane], lane);
    const float cum_last = __shfl(cum, 63);
    { const int i = td >> 2; const float sc = __expf(cum_last - __shfl(cum, i & 63));
      const u32x4 v = *(const LAS u32x4*)(Xd + i * LDP + (td & 3) * 8);
      u32x4 o; o.x = pk2(bflo(v.x) * sc, bfhi(v.x) * sc); o.y = pk2(bflo(v.y) * sc, bfhi(v.y) * sc); o.z = pk2(bflo(v.z) * sc, bfhi(v.z) * sc); o.w = pk2(bflo(v.w) * sc, bfhi(v.w) * sc);
      *(LAS u32x4*)(Xw + i * LDP + (td & 3) * 8) = o; }
    for (int tt = w; tt < 10; tt += 4) {
      int I, J; tri_tile(tt, I, J);
      f32x4 acc = (f32x4){0.f, 0.f, 0.f, 0.f};
#pragma unroll
      for (int k = 0; k < 4; ++k) acc = mma16(frag_row(Cs, LDN, 16 * I, 32 * k, lane), frag_row(Bs, LDN, 16 * J, 32 * k, lane), acc);
      const int jj = 16 * J + fr; const float cj = __shfl(cum, jj);
      u32x2 o; float pv[4];
#pragma unroll
      for (int r = 0; r < 4; ++r) { const int ii = 16 * I + 4 * fq + r; const float ci = __shfl(cum, ii); pv[r] = (jj <= ii) ? acc[r] * __expf(ci - cj) : 0.f; }
      o.x = pk2(pv[0], pv[1]); o.y = pk2(pv[2], pv[3]);
      *(LAS u32x2*)(Pt + jj * LDT + 16 * I + 4 * fq) = o;
    }
    LBAR();
    const LAS bf16_t* Sr = St + (step & 1) * 32 * LDN; LAS bf16_t* Sw = St + ((step + 1) & 1) * 32 * LDN;
    { const int I = w; const int nks = I < 2 ? 1 : 2;
      const int ii = 16 * I + fr; const float eci = __expf(__shfl(cum, ii));
#pragma unroll
      for (int pt = 0; pt < 2; ++pt) {
        f32x4 y1 = (f32x4){0.f, 0.f, 0.f, 0.f}, y2 = (f32x4){0.f, 0.f, 0.f, 0.f};
        for (int k = 0; k < nks; ++k) y1 = mma16(frag_tr(Xd, LDP, 32 * k, 16 * pt, lane), frag_tr(Pt, LDT, 32 * k, 16 * I, lane), y1);
#pragma unroll
        for (int k = 0; k < 4; ++k) y2 = mma16(frag_row(Sr, LDN, 16 * pt, 32 * k, lane), frag_row(Cs, LDN, 16 * I, 32 * k, lane), y2);
        bf16_t* op = op0 + 16 * pt;
        float o0 = y1[0] + eci * y2[0], o1 = y1[1] + eci * y2[1], o2 = y1[2] + eci * y2[2], o3 = y1[3] + eci * y2[3];
        if (!first) { const unsigned long long pv = ppv[pt]; const unsigned lo = (unsigned)pv, hi = (unsigned)(pv >> 32); o0 += bflo(lo); o1 += bfhi(lo); o2 += bflo(hi); o3 += bfhi(hi); }
        u32x2 o; o.x = pk2(o0, o1); o.y = pk2(o2, o3); *(u32x2*)op = o;
      } }
    { const float el = __expf(cum_last);
#pragma unroll
      for (int a = 0; a < 2; ++a)
#pragma unroll
        for (int c = 0; c < 2; ++c) { f32x4 acc = Sacc[a][c] * el;
#pragma unroll
          for (int k = 0; k < 2; ++k) acc = mma16(frag_tr(Bs, LDN, 32 * k, 16 * (2 * w + a), lane), frag_tr(Xw, LDP, 32 * k, 16 * c, lane), acc);
          Sacc[a][c] = acc;
          u32x2 o; o.x = pk2(acc[0], acc[1]); o.y = pk2(acc[2], acc[3]);
          *(LAS u32x2*)(Sw + (16 * c + fr) * LDN + 16 * (2 * w + a) + 4 * fq) = o; } }
    LBAR();
  }
}

template <int N> __device__ __forceinline__ float dpp_shr(float oldv, float v) {
  return __builtin_bit_cast(float, __builtin_amdgcn_update_dpp(__builtin_bit_cast(int, oldv), __builtin_bit_cast(int, v), 0x110 + N, 0xf, 0xf, false));
}
__device__ __forceinline__ float fast_sigmoid(float x) { return __builtin_amdgcn_rcpf(1.f + __expf(-x)); }
__device__ __forceinline__ void rg_chain_wg(const Params& P, const Ctx& C, int task) {
  const int b = task >> 5, h = (task >> 2) & 7, q = task & 3;
  const int d = C.wave >> 2, w = C.wave & 3, td = C.tid & 255, lane = C.lane, fr = lane & 15, fq = lane >> 4;
  constexpr int LDN = 136, LDW = 72;
  constexpr int DIRSZ = 40 * 1024;
  LAS unsigned char* L = C.lds + d * DIRSZ;
  LAS bf16_t* Xc = (LAS bf16_t*)L;
  LAS bf16_t* Wl = Xc + 64 * LDN;
  LAS float* Sum = (LAS float*)(Wl + 128 * LDW);
  const bf16_t* Z = WS(OFF_Z0, bf16_t); bf16_t* MIX = WS(OFF_MIX0, bf16_t);
  const int ch0 = h * 128 + q * 32;
  __syncthreads();
#pragma unroll 2
  for (int i = td; i < 128 * 64; i += 256) { const int ii = i >> 6, j = i & 63, gate = j >> 5, jj = j & 31;
    const float* W = (gate ? GIN(I_RGXW) : GIN(I_RGAW)) + ((size_t)(d * 8 + h) * 128 + ii) * 128 + q * 32 + jj; Wl[ii * LDW + j] = (bf16_t)f2bf(*W); }
  float ba[8], bx[8], spl[8], hc[8];
#pragma unroll
  for (int e = 0; e < 8; ++e) { const int c = ch0 + 16 * (e >> 2) + 4 * fq + (e & 3);
    ba[e] = GIN(I_RGAB)[d * 1024 + c]; bx[e] = GIN(I_RGXB)[d * 1024 + c]; spl[e] = -8.f * softplusf_(-GIN(I_RGLAM)[d * 1024 + c]); hc[e] = 0.f; }
  const int st_t = td >> 2, st_p = td & 3;
  u32x4 rx[4];
  auto issue_loads = [&](int step) {
    const int chunk = seq_chunk(d, step); const size_t row = (size_t)b * TB + chunk * 64 + st_t;
    const u32x4* px = (const u32x4*)(Z + row * Z0W + Z0_RGX + h * 128 + st_p * 32);
#pragma unroll
    for (int i = 0; i < 4; ++i) rx[i] = px[i];
  };
  issue_loads(0);
  __syncthreads();
  const int ii = 16 * w + fr;
  const LAS bf16_t* xrow = Xc + ii * LDN + q * 32 + 4 * fq;
  for (int step = 0; step < 132; ++step) {
    const int chunk = seq_chunk(d, step); const int row0 = b * TB + chunk * 64;
    VMWAIT();
    { const int i = d ? 63 - st_t : st_t; LAS u32x4* dx = (LAS u32x4*)(Xc + i * LDN + st_p * 32);
#pragma unroll
      for (int k = 0; k < 4; ++k) dx[k] = rx[k]; }
    LBAR();
    if (step + 1 < 132) issue_loads(step + 1);
    const bool first = (d == 0) == fwd_first(chunk);
    const int t = d ? 63 - ii : ii;
    bf16_t* op = MIX + (size_t)(row0 + t) * MIXW + ch0 + 4 * fq;
    unsigned long long ppv[2] = {0ull, 0ull}; u32x2 gy[2] = {(u32x2){0u, 0u}, (u32x2){0u, 0u}};
    if (!first) { ppv[0] = ld_agent_u64(op); ppv[1] = ld_agent_u64(op + 16);
      const bf16_t* gp = Z + (size_t)(row0 + t) * Z0W + Z0_RGY + ch0 + 4 * fq; gy[0] = *(const u32x2*)gp; gy[1] = *(const u32x2*)(gp + 16); }
    f32x4 ga[2], gx[2];
#pragma unroll
    for (int jt = 0; jt < 2; ++jt) { ga[jt] = (f32x4){0.f, 0.f, 0.f, 0.f}; gx[jt] = (f32x4){0.f, 0.f, 0.f, 0.f}; }
#pragma unroll
    for (int k = 0; k < 4; ++k) { const bf16x8 fb = frag_row(Xc, LDN, 16 * w, 32 * k, lane);
#pragma unroll
      for (int jt = 0; jt < 2; ++jt) { ga[jt] = mma16(frag_tr(Wl, LDW, 32 * k, 16 * jt, lane), fb, ga[jt]); gx[jt] = mma16(frag_tr(Wl, LDW, 32 * k, 32 + 16 * jt, lane), fb, gx[jt]); } }
    float A[8], Bv[8];
#pragma unroll
    for (int jt = 0; jt < 2; ++jt) { const u32x2 xw = *(const LAS u32x2*)(xrow + 16 * jt); const float xv[4] = {bflo(xw.x), bfhi(xw.x), bflo(xw.y), bfhi(xw.y)};
#pragma unroll
      for (int r = 0; r < 4; ++r) { const int e = 4 * jt + r;
        const float rg = fast_sigmoid(ga[jt][r] + ba[e]), ig = fast_sigmoid(gx[jt][r] + bx[e]); const float la = rg * spl[e];
        const float a = __expf(la); A[e] = a; Bv[e] = sqrtf(fmaxf(1.f - a * a, 0.f)) * (ig * xv[r]); } }
#pragma unroll
    for (int e = 0; e < 8; ++e) {
      { const float Ap = dpp_shr<1>(1.f, A[e]), Bp = dpp_shr<1>(0.f, Bv[e]); Bv[e] = A[e] * Bp + Bv[e]; A[e] = A[e] * Ap; }
      { const float Ap = dpp_shr<2>(1.f, A[e]), Bp = dpp_shr<2>(0.f, Bv[e]); Bv[e] = A[e] * Bp + Bv[e]; A[e] = A[e] * Ap; }
      { const float Ap = dpp_shr<4>(1.f, A[e]), Bp = dpp_shr<4>(0.f, Bv[e]); Bv[e] = A[e] * Bp + Bv[e]; A[e] = A[e] * Ap; }
      { const float Ap = dpp_shr<8>(1.f, A[e]), Bp = dpp_shr<8>(0.f, Bv[e]); Bv[e] = A[e] * Bp + Bv[e]; A[e] = A[e] * Ap; } }
    if (fr == 15) {
#pragma unroll
      for (int e = 0; e < 8; ++e) { f32x2 sv; sv[0] = A[e]; sv[1] = Bv[e]; *(LAS f32x2*)(Sum + ((w * 32) + 16 * (e >> 2) + 4 * fq + (e & 3)) * 2) = sv; } }
    LBAR();
    float hin[8];
#pragma unroll
    for (int e = 0; e < 8; ++e) { float hh = hc[e]; const int c = 16 * (e >> 2) + 4 * fq + (e & 3);
#pragma unroll
      for (int tt = 0; tt < 4; ++tt) { const f32x2 sv = *(const LAS f32x2*)(Sum + (tt * 32 + c) * 2); if (tt == w) hin[e] = hh; hh = sv[0] * hh + sv[1]; }
      hc[e] = hh; }
#pragma unroll
    for (int jt = 0; jt < 2; ++jt) { float hv[4];
#pragma unroll
      for (int r = 0; r < 4; ++r) hv[r] = Bv[4 * jt + r] + A[4 * jt + r] * hin[4 * jt + r];
      if (!first) { const unsigned lo = (unsigned)ppv[jt], hi = (unsigned)(ppv[jt] >> 32);
        const float gyv[4] = {bflo(gy[jt].x), bfhi(gy[jt].x), bflo(gy[jt].y), bfhi(gy[jt].y)}; const float pf[4] = {bflo(lo), bfhi(lo), bflo(hi), bfhi(hi)};
#pragma unroll
        for (int r = 0; r < 4; ++r) { const float x = gyv[r]; const float u2 = 1.5957691216057308f * (x + 0.044715f * x * x * x); hv[r] = (hv[r] + pf[r]) * x * fast_sigmoid(u2); } }
      u32x2 o; o.x = pg8::cvt_pk_bf16(hv[0], hv[1]); o.y = pg8::cvt_pk_bf16(hv[2], hv[3]); *(u32x2*)(op + 16 * jt) = o; }
  }
}
__device__ __forceinline__ void phase_chain0(const Params& P, const Ctx& C, int mode) {
  if (mode != 2) for (int task = C.bid; task < 128; task += C.nblk) ssd_chain_wg(P, C, task);
  __builtin_amdgcn_sched_barrier(0);
  if (mode != 1) for (int task = C.bid < 128 ? C.bid + C.nblk : C.bid; task < 256; task += C.nblk) rg_chain_wg(P, C, task - 128);
}
__device__ __forceinline__ void phase_ssdfin(const Params& P, const Ctx& C) {
  const bf16_t* Z = WS(OFF_Z0, bf16_t); bf16_t* MIX = WS(OFF_MIX0, bf16_t);
  for (int r = C.gw; r < R; r += C.ngw) {
    f32x4 y[4];
#pragma unroll
    for (int j = 0; j < 4; ++j) { const int e = 4 * C.lane + 256 * j; const float dsk = GIN(I_SD)[e >> 6];
      const u32x2 ys = *(const u32x2*)(MIX + (size_t)r * MIXW + 1024 + e), xs = *(const u32x2*)(Z + (size_t)r * Z0W + Z0_XBC + e), zz = *(const u32x2*)(Z + (size_t)r * Z0W + Z0_SSDZ + e);
      y[j][0] = (bflo(ys.x) + dsk * bflo(xs.x)) * siluf_(bflo(zz.x)); y[j][1] = (bfhi(ys.x) + dsk * bfhi(xs.x)) * siluf_(bfhi(zz.x));
      y[j][2] = (bflo(ys.y) + dsk * bflo(xs.y)) * siluf_(bflo(zz.y)); y[j][3] = (bfhi(ys.y) + dsk * bfhi(xs.y)) * siluf_(bfhi(zz.y)); }
    float s0 = 0.f, s1 = 0.f;
#pragma unroll
    for (int i = 0; i < 4; ++i) { s0 += y[0][i] * y[0][i] + y[1][i] * y[1][i]; s1 += y[2][i] * y[2][i] + y[3][i] * y[3][i]; }
    const float r0 = rsqrtf(wave_sum(s0) * (1.f / 512.f) + RMS_EPS), r1 = rsqrtf(wave_sum(s1) * (1.f / 512.f) + RMS_EPS);
#pragma unroll
    for (int j = 0; j < 4; ++j) { const int e = 4 * C.lane + 256 * j; const f32x4 gn = *(const f32x4*)(GIN(I_SNG) + e); const float rr = j < 2 ? r0 : r1;
      u32x2 w; w.x = pk2(y[j][0] * rr * gn[0], y[j][1] * rr * gn[1]); w.y = pk2(y[j][2] * rr * gn[2], y[j][3] * rr * gn[3]);
      *(u32x2*)(MIX + (size_t)r * MIXW + 1024 + e) = w; }
  }
}

__device__ __forceinline__ void phase_outproj(const Params& P, const Ctx& C, int layer) {
  const float* MOD = WS(OFF_MOD, float) + (size_t)layer * 5 * 6144;
  pg8::Gemm g{layer ? WS(OFF_MIX1, bf16_t) : WS(OFF_MIX0, bf16_t), layer ? WS(OFF_WOUT1, bf16_t) : WS(OFF_WOUT0, bf16_t), MIXW, MIXW};
  pg8::GridOrder S; if (layer) S.init(128, 4, C.nblk, C.bid, 1); else S.init(132, 4, C.nblk, C.bid, 0);
  pg8::EpiResid E{layer ? GOUT : GIN(I_X), layer ? WS(OFF_HCTX, float) : GIN(I_CTX), GOUT, WS(OFF_TCTX, float), MOD + 2 * D};
  pg8::gemm_phase(C.lds, g, S, E);
}

__device__ __forceinline__ void phase_lnmix(const Params& P, const Ctx& C, int layer) {
  LAS float* Wt = (LAS float*)C.lds;
  { const float* gw = GIN(I_RGW) + (size_t)layer * D * 4; const float* ew = GIN(I_REW) + (size_t)layer * D * 32;
    for (int i = C.tid; i < 1024 * 4; i += NT) { const int k = i >> 2, c = i & 3; Wt[c * 1024 + k] = gw[i]; }
    for (int i = C.tid; i < 1024 * 32; i += NT) { const int k = i >> 5, c = i & 31; Wt[(4 + c) * 1024 + k] = ew[i]; } }
  __syncthreads();
  const float* MOD = WS(OFF_MOD, float) + (size_t)layer * 5 * 6144;
  const float* lng = GIN(I_LNMG) + layer * D; const float* lnb = GIN(I_LNMB) + layer * D;
  const float* rgb = GIN(I_RGB) + layer * 4; const float* reb = GIN(I_REB) + layer * 32;
  bf16_t* V = layer ? WS(OFF_V1, bf16_t) : WS(OFF_U0, bf16_t);
  int* cnt = WS(OFF_CTL, int) + layer * 32; int* route = WS(OFF_ROUTE, int);
  const int nrows = layer ? RLAT : R;
  f32x4 h[4], hn[4];
  if (C.gw < nrows) row_load(lat_or_ctx_w(GOUT, WS(OFF_TCTX, float), rmap(layer, C.gw)), C.lane, h);
  for (int q = C.gw; q < nrows; q += C.ngw) {
    const int r = rmap(layer, q);
    if (q + C.ngw < nrows) row_load(lat_or_ctx_w(GOUT, WS(OFF_TCTX, float), rmap(layer, q + C.ngw)), C.lane, hn);
    float* hrow = lat_or_ctx_w(GOUT, WS(OFF_HCTX, float), r);
    f32x4 v[4];
    row_layernorm(h, lng, lnb, C.lane);
    row_store(hrow, C.lane, h);
    const float* m = MOD + (size_t)row_b5(r) * 6144;
    row_modulate(h, m + 3 * D, m + 4 * D, C.lane, v);
    row_store_bf16(V + (size_t)r * D, C.lane, v);
    float lg[4];
#pragma unroll
    for (int c = 0; c < 4; ++c) { float s = 0.f;
#pragma unroll
      for (int j = 0; j < 4; ++j) { const f32x4 w = *(const LAS f32x4*)(Wt + c * 1024 + 4 * C.lane + 256 * j); s += (v[j][0] * w[0] + v[j][1] * w[1]) + (v[j][2] * w[2] + v[j][3] * w[3]); }
      lg[c] = wave_sum(s) + rgb[c]; }
    int gsel = 0; float gmax = lg[0];
#pragma unroll
    for (int i = 1; i < 4; ++i) if (lg[i] > gmax) { gmax = lg[i]; gsel = i; }
    gsel = __builtin_amdgcn_readfirstlane(gsel);
    float gden = 0.f;
#pragma unroll
    for (int i = 0; i < 4; ++i) gden += __expf(lg[i] - gmax);
    const float ptg = 1.f / gden;
    float le[8];
    { const LAS float* We = Wt + (4 + gsel * 8) * 1024 + 4 * C.lane;
#pragma unroll
      for (int c = 0; c < 8; ++c) { float s = 0.f;
#pragma unroll
        for (int j = 0; j < 4; ++j) { const f32x4 w = *(const LAS f32x4*)(We + c * 1024 + 256 * j); s += (v[j][0] * w[0] + v[j][1] * w[1]) + (v[j][2] * w[2] + v[j][3] * w[3]); }
        le[c] = wave_sum(s) + reb[gsel * 8 + c]; } }
    int e1 = 0; float m1 = le[0];
#pragma unroll
    for (int i = 1; i < 8; ++i) if (le[i] > m1) { m1 = le[i]; e1 = i; }
    int e2 = -1; float m2 = -3.0e38f;
#pragma unroll
    for (int i = 0; i < 8; ++i) if (i != e1 && le[i] > m2) { m2 = le[i]; e2 = i; }
    const float q2 = __expf(m2 - m1); const float w1 = ptg / (1.f + q2), w2 = ptg * q2 / (1.f + q2);
    if (C.lane == 0) {
      const int E1 = gsel * 8 + e1, E2 = gsel * 8 + e2;
      const int p1 = atomicAdd(cnt + E1, 1), p2 = atomicAdd(cnt + E2, 1);
      int* rr = route + (size_t)r * 8; rr[0] = E1; rr[1] = E2; ((float*)rr)[2] = w1; ((float*)rr)[3] = w2; rr[4] = p1; rr[5] = p2;
    }
#pragma unroll
    for (int j = 0; j < 4; ++j) h[j] = hn[j];
  }
}

__device__ __forceinline__ void phase_dispatch(const Params& P, const Ctx& C, int layer) {
  LAS int* base = (LAS int*)C.lds;
  int* ctl = WS(OFF_CTL, int); const int* cnt = ctl + layer * 32;
  if (C.tid == 0) { int acc = 0; for (int e = 0; e < NEXP; ++e) { base[e] = acc; acc += (cnt[e] + 255) >> 8; } base[32] = acc; }
  __syncthreads();
  if (C.bid == 0) { if (C.tid == 0) ctl[64 + layer] = base[32];
    if (C.tid < NEXP) { for (int bk = base[C.tid]; bk < base[C.tid + 1]; ++bk) ctl[128 + layer * MAX_BLKS + bk] = C.tid; } }
  const bf16_t* V = layer ? WS(OFF_V1, bf16_t) : WS(OFF_U0, bf16_t);
  bf16_t* AM = layer ? WS(OFF_AM1, bf16_t) : WS(OFF_AM0, bf16_t);
  float* slotw = WS(OFF_SLOTW, float); int* route = WS(OFF_ROUTE, int);
  for (int r = C.gw; r < R; r += C.ngw) {
    const int pos = r % TB; if (layer && pos < CTXL) continue;
    int* rr = route + (size_t)r * 8;
    const int E1 = rr[0], E2 = rr[1]; const int s1 = base[E1] * 256 + rr[4], s2 = base[E2] * 256 + rr[5];
    const u32x4* src = (const u32x4*)(V + (size_t)r * D);
    const u32x4 a = src[C.lane], b = src[64 + C.lane];
    u32x4* d1 = (u32x4*)(AM + (size_t)s1 * D); u32x4* d2 = (u32x4*)(AM + (size_t)s2 * D);
    d1[C.lane] = a; d1[64 + C.lane] = b; d2[C.lane] = a; d2[64 + C.lane] = b;
    if (C.lane == 0) { rr[6] = s1; rr[7] = s2; slotw[s1] = ((const float*)rr)[2]; slotw[s2] = ((const float*)rr)[3]; }
  }
}
__device__ __forceinline__ void phase_moe1(const Params& P, const Ctx& C, int layer) {
  const int* ctl = WS(OFF_CTL, int);
  pg8::Gemm g{layer ? WS(OFF_AM1, bf16_t) : WS(OFF_AM0, bf16_t), layer ? WS(OFF_WE1, bf16_t) : WS(OFF_WE0, bf16_t), D, D};
  pg8::MoeOrder S{ctl + 128 + layer * MAX_BLKS, ctl[64 + layer] * 4, C.nblk, C.bid};
  pg8::EpiSwiGLU E{layer ? WS(OFF_HM1, bf16_t) : WS(OFF_HM0, bf16_t)};
  pg8::gemm_phase(C.lds, g, S, E);
}
__device__ __forceinline__ void phase_moe2(const Params& P, const Ctx& C, int layer) {
  const int* ctl = WS(OFF_CTL, int);
  pg8::Gemm g{layer ? WS(OFF_HM1, bf16_t) : WS(OFF_HM0, bf16_t), layer ? WS(OFF_WE1 + 64 * MiB, bf16_t) : WS(OFF_WE0 + 64 * MiB, bf16_t), DEXP, DEXP};
  pg8::MoeOrder S{ctl + 128 + layer * MAX_BLKS, ctl[64 + layer] * 4, C.nblk, C.bid};
  pg8::EpiMoeDown E{layer ? WS(OFF_YM1, bf16_t) : WS(OFF_YM0, bf16_t), WS(OFF_SLOTW, float)};
  pg8::gemm_phase(C.lds, g, S, E);
}

__device__ __forceinline__ void phase_lnffn(const Params& P, const Ctx& C, int layer) {
  const float* MOD = WS(OFF_MOD, float) + (size_t)layer * 5 * 6144;
  const float* lng = GIN(I_LNFG) + layer * D; const float* lnb = GIN(I_LNFB) + layer * D;
  const bf16_t* YM = layer ? WS(OFF_YM1, bf16_t) : WS(OFF_YM0, bf16_t); const int* route = WS(OFF_ROUTE, int);
  const int nrows = layer ? RLAT : R;
  f32x4 h[4], hn[4]; u32x2 ya[4], yb[4], yan[4], ybn[4]; int s1n = 0, s2n = 0;
  auto ldrow = [&](int q, f32x4 (&hh)[4], u32x2 (&a)[4], u32x2 (&bq)[4], int sa, int sb) {
    const int r = rmap(layer, q); row_load(lat_or_ctx_w(GOUT, WS(OFF_HCTX, float), r), C.lane, hh);
#pragma unroll
    for (int j = 0; j < 4; ++j) { a[j] = *(const u32x2*)(YM + (size_t)sa * D + 4 * C.lane + 256 * j); bq[j] = *(const u32x2*)(YM + (size_t)sb * D + 4 * C.lane + 256 * j); } };
  if (C.gw < nrows) { const int* rr = route + (size_t)rmap(layer, C.gw) * 8; ldrow(C.gw, h, ya, yb, rr[6], rr[7]); }
  if (C.gw + C.ngw < nrows) { const int* rr = route + (size_t)rmap(layer, C.gw + C.ngw) * 8; s1n = rr[6]; s2n = rr[7]; }
  for (int q = C.gw; q < nrows; q += C.ngw) {
    const int r = rmap(layer, q);
    if (q + C.ngw < nrows) ldrow(q + C.ngw, hn, yan, ybn, s1n, s2n);
    if (q + 2 * C.ngw < nrows) { const int* rr = route + (size_t)rmap(layer, q + 2 * C.ngw) * 8; s1n = rr[6]; s2n = rr[7]; }
    float* hrow = lat_or_ctx_w(GOUT, WS(OFF_HCTX, float), r);
    const float* m = MOD + (size_t)row_b5(r) * 6144;
#pragma unroll
    for (int j = 0; j < 4; ++j) { const u32x2 a = ya[j], b = yb[j];
      const f32x4 g5 = *(const f32x4*)(m + 5 * D + 4 * C.lane + 256 * j);
      f32x4 f; f[0] = bflo(a.x) + bflo(b.x); f[1] = bfhi(a.x) + bfhi(b.x); f[2] = bflo(a.y) + bflo(b.y); f[3] = bfhi(a.y) + bfhi(b.y);
      h[j] = h[j] * ALPHA + g5 * f; }
    row_layernorm(h, lng, lnb, C.lane);
    row_store(hrow, C.lane, h);
    if (layer == 0) {
      const float* m1 = WS(OFF_MOD, float) + (size_t)(5 + row_b5(r)) * 6144;
      f32x4 u[4]; row_modulate(h, m1, m1 + D, C.lane, u);
      row_store_bf16(WS(OFF_U1, bf16_t) + (size_t)r * D, C.lane, u);
    }
#pragma unroll
    for (int j = 0; j < 4; ++j) { h[j] = hn[j]; ya[j] = yan[j]; yb[j] = ybn[j]; }
  }
  if (layer == 0) {
    __syncthreads();
    LAS float* scr = (LAS float*)C.lds + C.wave * (64 * 33);
    constexpr int N_A = 16 * 96, N_B = 16 * 128;
    for (int it = C.gw; it < N_A + N_B + 16; it += C.ngw) {
      if (it < N_A) transpose_mat_item(GIN(I_CDW), CD_IN, 0, D, 3072, WS(OFF_WCD, bf16_t), D, 0, it, scr, C.lane);
      else if (it < N_A + N_B) transpose_mat_item(GIN(I_CDW), CD_IN, 4128, D, 4096, WS(OFF_WCD, bf16_t) + (size_t)3072 * D, D, 0, it - N_A, scr, C.lane);
      else transpose_mat_item(GIN(I_CDW), CD_IN, 4096, D, 32, WS(OFF_WCD, bf16_t) + (size_t)7168 * D, D, 0, it - N_A - N_B, scr, C.lane);
    }
    { u32x4* z = (u32x4*)(WS(OFF_WCD, bf16_t) + (size_t)7200 * D); const u32x4 zz = {0u, 0u, 0u, 0u};
      for (int i = C.bid * NT + C.tid; i < 224 * D * 2 / 16; i += C.nblk * NT) z[i] = zz; }
  }
}

__device__ __forceinline__ void gdn_task(const Params& P, const Ctx& C, int task) {
  const int b = task >> 9, h = (task >> 6) & 7, vs = task & 63; const int c = C.lane >> 5, kg = C.lane & 31;
  const bf16_t* Z = WS(OFF_Z1, bf16_t); bf16_t* MIX = WS(OFF_MIX1, bf16_t); const float* DT = WS(OFF_DT, float);
  const int colq = Z1_Q + h * 128 + 4 * kg, colk = Z1_K + h * 128 + 4 * kg, colv = Z1_V + h * 128 + 2 * vs + c, outc = h * 128 + 2 * vs + c;
  for (int d = 0; d < 2; ++d) {
    const float Aneg = -__expf(GIN(I_GALOG)[d * 8 + h]), dtb = GIN(I_GDTB)[d * 8 + h];
    float S0 = 0.f, S1 = 0.f, S2 = 0.f, S3 = 0.f;
    for (int j0 = 0; j0 < TB; j0 += 8) {
      u32x2 qv[8], kv[8]; unsigned short vv[8], yp[8]; float br[8], ar[8];
#pragma unroll
      for (int u = 0; u < 8; ++u) { const size_t row = (size_t)b * TB + seq_pos(d, j0 + u);
        qv[u] = *(const u32x2*)(Z + row * Z1W + colq); kv[u] = *(const u32x2*)(Z + row * Z1W + colk); vv[u] = Z[row * Z1W + colv];
        br[u] = DT[row * 32 + d * 8 + h]; ar[u] = DT[row * 32 + 16 + d * 8 + h]; yp[u] = d ? MIX[row * MIXW + outc] : (unsigned short)0; }
#pragma unroll
      for (int u = 0; u < 8; ++u) { const size_t row = (size_t)b * TB + seq_pos(d, j0 + u);
        const float al = __expf(Aneg * softplusf_(ar[u] + dtb)), be = sigmoidf_(br[u]);
        const float k0 = bflo(kv[u].x), k1 = bfhi(kv[u].x), k2 = bflo(kv[u].y), k3 = bfhi(kv[u].y);
        S0 *= al; S1 *= al; S2 *= al; S3 *= al;
        const float p = half_sum32((k0 * S0 + k1 * S1) + (k2 * S2 + k3 * S3));
        const float dl = be * (bf2f(vv[u]) - p);
        S0 += k0 * dl; S1 += k1 * dl; S2 += k2 * dl; S3 += k3 * dl;
        const float o = half_sum32((bflo(qv[u].x) * S0 + bfhi(qv[u].x) * S1) + (bflo(qv[u].y) * S2 + bfhi(qv[u].y) * S3));
        if (kg == 0) MIX[row * MIXW + outc] = (bf16_t)f2bf(o + bf2f(yp[u])); }
    }
    __threadfence_block();
  }
}
__device__ __forceinline__ void hgrn_task(const Params& P, const Ctx& C, int task) {
  const int b = task >> 9, h = (task >> 6) & 7, vs = task & 63; const int c = C.lane >> 5, kg = C.lane & 31;
  const bf16_t* Z = WS(OFF_Z1, bf16_t); bf16_t* MIX = WS(OFF_MIX1, bf16_t);
  const f32x4 lb = *(const f32x4*)(WS(OFF_LB1, float) + h * 128 + 4 * kg);
  const int colq = Z1_HQ + h * 128 + 4 * kg, colv = Z1_HI + h * 128 + 2 * vs + c, outc = 1024 + h * 128 + 2 * vs + c;
  for (int d = 0; d < 2; ++d) {
    const int colf = Z1_HF + d * 1024 + h * 128 + 4 * kg;
    float S0 = 0.f, S1 = 0.f, S2 = 0.f, S3 = 0.f;
    for (int j0 = 0; j0 < TB; j0 += 8) {
      u32x2 qv[8], fv[8]; unsigned short vv[8], yp[8];
#pragma unroll
      for (int u = 0; u < 8; ++u) { const size_t row = (size_t)b * TB + seq_pos(d, j0 + u);
        qv[u] = *(const u32x2*)(Z + row * Z1W + colq); fv[u] = *(const u32x2*)(Z + row * Z1W + colf); vv[u] = Z[row * Z1W + colv];
        yp[u] = d ? MIX[row * MIXW + outc] : (unsigned short)0; }
#pragma unroll
      for (int u = 0; u < 8; ++u) { const size_t row = (size_t)b * TB + seq_pos(d, j0 + u);
        const float f0 = lb[0] + (1.f - lb[0]) * sigmoidf_(bflo(fv[u].x)), f1 = lb[1] + (1.f - lb[1]) * sigmoidf_(bfhi(fv[u].x));
        const float f2 = lb[2] + (1.f - lb[2]) * sigmoidf_(bflo(fv[u].y)), f3 = lb[3] + (1.f - lb[3]) * sigmoidf_(bfhi(fv[u].y));
        const float v = bf2f(vv[u]);
        S0 = f0 * S0 + (1.f - f0) * v; S1 = f1 * S1 + (1.f - f1) * v; S2 = f2 * S2 + (1.f - f2) * v; S3 = f3 * S3 + (1.f - f3) * v;
        const float o = half_sum32((bflo(qv[u].x) * S0 + bfhi(qv[u].x) * S1) + (bflo(qv[u].y) * S2 + bfhi(qv[u].y) * S3));
        if (kg == 0) MIX[row * MIXW + outc] = (bf16_t)f2bf(o + bf2f(yp[u])); }
    }
    __threadfence_block();
  }
}

__device__ __forceinline__ int seq_chunk32(int dir, int j) { return dir == 0 ? j : (j < 8 ? 7 - j : 271 - j); }
__device__ __forceinline__ bool fwd_first32(int c) { return c < 8 ? (c <= 3) : (c <= 135); }

__device__ __forceinline__ void hgrn_chain_wg(const Params& P, const Ctx& C, int task) {
  const int b = task >> 5, h = (task >> 2) & 7, vs = task & 3;
  const int d = C.wave >> 2, w = C.wave & 3, td = C.tid & 255, lane = C.lane, fr = lane & 15, fq = lane >> 4;
  constexpr int LDN = 136, LDP = 40;
  constexpr int DIRSZ = 72 * 1024;
  LAS unsigned char* L = C.lds + d * DIRSZ;
  LAS bf16_t* Qt = (LAS bf16_t*)L;
  LAS bf16_t* Kh = Qt + 32 * LDN;
  LAS bf16_t* Kw = Kh + 32 * LDN;
  LAS bf16_t* Vs = Kw + 32 * LDN;
  LAS bf16_t* Pt = Vs + 32 * LDP;
  LAS bf16_t* St = Pt + 32 * LDP;
  LAS float* CUM = (LAS float*)(St + 2 * 32 * LDN);
  const bf16_t* Z = WS(OFF_Z1, bf16_t); bf16_t* MIX = WS(OFF_MIX1, bf16_t);
  const int colq = Z1_HQ + h * 128, colf = Z1_HF + d * 1024 + h * 128, colv = Z1_HI + h * 128 + vs * 32, outc = 1024 + h * 128 + vs * 32;
  __syncthreads();
  for (int i = td; i < 32 * LDP / 2; i += 256) ((LAS unsigned*)Pt)[i] = 0u;
  for (int i = td; i < 2 * 32 * LDN / 2; i += 256) ((LAS unsigned*)St)[i] = 0u;
  f32x4 Sacc[2][2];
#pragma unroll
  for (int a = 0; a < 2; ++a)
#pragma unroll
    for (int c = 0; c < 2; ++c) Sacc[a][c] = (f32x4){0.f, 0.f, 0.f, 0.f};
  const int st_t = td >> 3, st_s = td & 7;
  float lbv[16];
#pragma unroll
  for (int e = 0; e < 16; ++e) lbv[e] = WS(OFF_LB1, float)[h * 128 + st_s * 16 + e];
  u32x4 rq[2], rf[2]; u32x2 rv;
  auto issue_loads = [&](int step) {
    const int chunk = seq_chunk32(d, step); const size_t row = (size_t)b * TB + chunk * 32 + st_t;
    const u32x4* pq = (const u32x4*)(Z + row * Z1W + colq + st_s * 16); const u32x4* pf = (const u32x4*)(Z + row * Z1W + colf + st_s * 16);
    rq[0] = pq[0]; rq[1] = pq[1]; rf[0] = pf[0]; rf[1] = pf[1];
    rv = *(const u32x2*)(Z + row * Z1W + colv + st_s * 4);
  };
  issue_loads(0);
  for (int step = 0; step < 264; ++step) {
    const int chunk = seq_chunk32(d, step); const int row0 = b * TB + chunk * 32;
    const int si = d ? 31 - st_t : st_t;
    VMWAIT();
    float qv[16], kk[16];
    { const unsigned qw[8] = {rq[0].x, rq[0].y, rq[0].z, rq[0].w, rq[1].x, rq[1].y, rq[1].z, rq[1].w};
      const unsigned fw[8] = {rf[0].x, rf[0].y, rf[0].z, rf[0].w, rf[1].x, rf[1].y, rf[1].z, rf[1].w};
      f32x4 lf4[4];
#pragma unroll
      for (int e = 0; e < 8; ++e) { qv[2 * e] = bflo(qw[e]); qv[2 * e + 1] = bfhi(qw[e]);
        const float f0 = lbv[2 * e] + (1.f - lbv[2 * e]) * sigmoidf_(bflo(fw[e])), f1 = lbv[2 * e + 1] + (1.f - lbv[2 * e + 1]) * sigmoidf_(bfhi(fw[e]));
        kk[2 * e] = 1.f - f0; kk[2 * e + 1] = 1.f - f1; lf4[e >> 1][(2 * e) & 3] = __logf(f0); lf4[e >> 1][(2 * e + 1) & 3] = __logf(f1); }
#pragma unroll
      for (int e = 0; e < 4; ++e) *(LAS f32x4*)(CUM + si * 128 + st_s * 16 + 4 * e) = lf4[e];
      *(LAS u32x2*)(Vs + si * LDP + st_s * 4) = rv; }
    LBAR();
    if (step + 1 < 264) issue_loads(step + 1);
    const int vt = w & 1, it = w >> 1;
    const bool first = (d == 0) == fwd_first32(chunk);
    bf16_t* op; unsigned long long ppv = 0ull;
    { const int ii = 16 * it + fr; const int t = d ? 31 - ii : ii; op = MIX + (size_t)(row0 + t) * MIXW + outc + 16 * vt + 4 * fq; if (!first) ppv = ld_agent_u64(op); }
    if (td < 128) { float c = 0.f;
#pragma unroll 8
      for (int i = 0; i < 32; ++i) { c += CUM[i * 128 + td]; CUM[i * 128 + td] = c; } }
    LBAR();
    { unsigned oq[8], oh[8], ow[8];
#pragma unroll
      for (int e = 0; e < 8; ++e) { const int k0 = st_s * 16 + 2 * e;
        const float c0 = CUM[si * 128 + k0], c1 = CUM[si * 128 + k0 + 1], l0 = CUM[31 * 128 + k0], l1 = CUM[31 * 128 + k0 + 1];
        oq[e] = pk2(qv[2 * e] * __expf(c0), qv[2 * e + 1] * __expf(c1));
        oh[e] = pk2(kk[2 * e] * __expf(fminf(-c0, 80.f)), kk[2 * e + 1] * __expf(fminf(-c1, 80.f)));
        ow[e] = pk2(kk[2 * e] * __expf(l0 - c0), kk[2 * e + 1] * __expf(l1 - c1)); }
      LAS u32x4* dq = (LAS u32x4*)(Qt + si * LDN + st_s * 16); LAS u32x4* dh = (LAS u32x4*)(Kh + si * LDN + st_s * 16); LAS u32x4* dw = (LAS u32x4*)(Kw + si * LDN + st_s * 16);
      dq[0] = (u32x4){oq[0], oq[1], oq[2], oq[3]}; dq[1] = (u32x4){oq[4], oq[5], oq[6], oq[7]};
      dh[0] = (u32x4){oh[0], oh[1], oh[2], oh[3]}; dh[1] = (u32x4){oh[4], oh[5], oh[6], oh[7]};
      dw[0] = (u32x4){ow[0], ow[1], ow[2], ow[3]}; dw[1] = (u32x4){ow[4], ow[5], ow[6], ow[7]}; }
    LBAR();
    if (w < 3) { const int I = w >= 1 ? 1 : 0, J = w == 2 ? 1 : 0;
      f32x4 acc = (f32x4){0.f, 0.f, 0.f, 0.f};
#pragma unroll
      for (int k = 0; k < 4; ++k) acc = mma16(frag_row(Qt, LDN, 16 * I, 32 * k, lane), frag_row(Kh, LDN, 16 * J, 32 * k, lane), acc);
      const int jj = 16 * J + fr; float pv[4];
#pragma unroll
      for (int r = 0; r < 4; ++r) { const int ii = 16 * I + 4 * fq + r; pv[r] = (jj <= ii) ? acc[r] : 0.f; }
      u32x2 o; o.x = pk2(pv[0], pv[1]); o.y = pk2(pv[2], pv[3]);
      *(LAS u32x2*)(Pt + jj * LDP + 16 * I + 4 * fq) = o; }
    const LAS bf16_t* Sr = St + (step & 1) * 32 * LDN; LAS bf16_t* Sw = St + ((step + 1) & 1) * 32 * LDN;
    f32x4 o2 = (f32x4){0.f, 0.f, 0.f, 0.f};
#pragma unroll
    for (int k = 0; k < 4; ++k) o2 = mma16(frag_row(Sr, LDN, 16 * vt, 32 * k, lane), frag_row(Qt, LDN, 16 * it, 32 * k, lane), o2);
#pragma unroll
    for (int a = 0; a < 2; ++a) { const int kt = 2 * w + a; const f32x4 cl = *(const LAS f32x4*)(CUM + 31 * 128 + 16 * kt + 4 * fq);
      f32x4 dec; dec[0] = __expf(cl[0]); dec[1] = __expf(cl[1]); dec[2] = __expf(cl[2]); dec[3] = __expf(cl[3]);
#pragma unroll
      for (int c = 0; c < 2; ++c) { f32x4 acc = Sacc[a][c] * dec;
        acc = mma16(frag_tr(Kw, LDN, 0, 16 * kt, lane), frag_tr(Vs, LDP, 0, 16 * c, lane), acc);
        Sacc[a][c] = acc;
        u32x2 o; o.x = pk2(acc[0], acc[1]); o.y = pk2(acc[2], acc[3]);
        *(LAS u32x2*)(Sw + (16 * c + fr) * LDN + 16 * kt + 4 * fq) = o; } }
    LBAR();
    { f32x4 o1 = mma16(frag_tr(Vs, LDP, 0, 16 * vt, lane), frag_tr(Pt, LDP, 0, 16 * it, lane), (f32x4){0.f, 0.f, 0.f, 0.f});
      float o0 = o1[0] + o2[0], o1v = o1[1] + o2[1], o2v = o1[2] + o2[2], o3 = o1[3] + o2[3];
      if (!first) { const unsigned long long pv = ppv; const unsigned lo = (unsigned)pv, hi = (unsigned)(pv >> 32); o0 += bflo(lo); o1v += bfhi(lo); o2v += bflo(hi); o3 += bfhi(hi); }
      u32x2 o; o.x = pk2(o0, o1v); o.y = pk2(o2v, o3); *(u32x2*)op = o; }
    LBAR();
  }
}

__device__ __forceinline__ void gdn_chain_wg(const Params& P, const Ctx& C, int task) {
  const int b = task >> 5, h = (task >> 2) & 7, vs = task & 3;
  const int d = C.wave >> 2, w = C.wave & 3, td = C.tid & 255, lane = C.lane, fr = lane & 15, fq = lane >> 4;
  constexpr int LDN = 136, LDP = 40, LDT = 24;
  constexpr int DIRSZ = 72 * 1024;
  LAS unsigned char* L = C.lds + d * DIRSZ;
  LAS bf16_t* Qs = (LAS bf16_t*)L;
  LAS bf16_t* Ks = Qs + 32 * LDN;
  LAS bf16_t* Vs = Ks + 32 * LDN;
  LAS bf16_t* Mt = Vs + 32 * LDP;
  LAS bf16_t* At = Mt + 32 * LDP;
  LAS bf16_t* Tt = At + 32 * LDP;
  LAS bf16_t* Xt = Tt + 2 * 32 * LDT;
  LAS bf16_t* Rt = Xt + 160 * LDP;
  LAS bf16_t* Vn = Rt + 4 * 16 * LDP;
  LAS bf16_t* Vw = Vn + 32 * LDP;
  LAS bf16_t* St = Vw + 32 * LDP;
  LAS float* Md = (LAS float*)(St + 2 * 32 * LDN);
  LAS float* gL = Md + 2 * 256;
  LAS float* bL = gL + 32;
  const bf16_t* Z = WS(OFF_Z1, bf16_t); bf16_t* MIX = WS(OFF_MIX1, bf16_t); const float* DT = WS(OFF_DT, float);
  const float Aneg = -__expf(GIN(I_GALOG)[d * 8 + h]), dtb = GIN(I_GDTB)[d * 8 + h];
  const int colq = Z1_Q + h * 128, colk = Z1_K + h * 128, colv = Z1_V + h * 128 + vs * 32, outc = h * 128 + vs * 32;
  __syncthreads();
  for (int i = td; i < 71 * 1024 / 4; i += 256) ((LAS unsigned*)L)[i] = 0u;
  f32x4 Sacc[2][2];
#pragma unroll
  for (int a = 0; a < 2; ++a)
#pragma unroll
    for (int c = 0; c < 2; ++c) Sacc[a][c] = (f32x4){0.f, 0.f, 0.f, 0.f};
  const int st_t = td >> 3, st_s = td & 7;
  u32x4 rq[2], rk[2]; u32x2 rv; float ra = 0.f, rb = 0.f;
  auto issue_loads = [&](int step) {
    const int chunk = seq_chunk32(d, step); const size_t row = (size_t)b * TB + chunk * 32 + st_t;
    const u32x4* pq = (const u32x4*)(Z + row * Z1W + colq + st_s * 16); const u32x4* pk = (const u32x4*)(Z + row * Z1W + colk + st_s * 16);
    rq[0] = pq[0]; rq[1] = pq[1]; rk[0] = pk[0]; rk[1] = pk[1];
    rv = *(const u32x2*)(Z + row * Z1W + colv + st_s * 4);
    if (st_s == 0) { rb = DT[row * 32 + d * 8 + h]; ra = DT[row * 32 + 16 + d * 8 + h]; }
  };
  issue_loads(0);
  __syncthreads();
  LAS bf16_t* Rw = Rt + w * 16 * LDP;
  for (int step = 0; step < 264; ++step) {
    const int chunk = seq_chunk32(d, step); const int row0 = b * TB + chunk * 32;
    VMWAIT();
    { const int si = d ? 31 - st_t : st_t;
      LAS u32x4* dq = (LAS u32x4*)(Qs + si * LDN + st_s * 16); LAS u32x4* dk = (LAS u32x4*)(Ks + si * LDN + st_s * 16);
      dq[0] = rq[0]; dq[1] = rq[1]; dk[0] = rk[0]; dk[1] = rk[1];
      *(LAS u32x2*)(Vs + si * LDP + st_s * 4) = rv;
      if (st_s == 0) { gL[si] = Aneg * softplusf_(ra + dtb); bL[si] = sigmoidf_(rb); } }
    LBAR();
    if (step + 1 < 264) issue_loads(step + 1);
    const bool first = (d == 0) == fwd_first32(chunk);
    bf16_t* op; unsigned long long ppv = 0ull;
    { const int ii = 16 * (w >> 1) + fr; const int t = d ? 31 - ii : ii; op = MIX + (size_t)(row0 + t) * MIXW + outc + 16 * (w & 1) + 4 * fq; if (!first) ppv = ld_agent_u64(op); }
    const float cum = wave_incl_scan(lane < 32 ? gL[lane] : 0.f, lane);
    const float cum_last = __shfl(cum, 31);
    const LAS bf16_t* Sr = St + (step & 1) * 32 * LDN; LAS bf16_t* Sw = St + ((step + 1) & 1) * 32 * LDN;
    const int vt = w & 1, it = w >> 1;
    for (int job = w; job < 6; job += 4) {
      const int isq = job >= 3, tj = job - 3 * isq; const int I = tj >= 1 ? 1 : 0, J = tj == 2 ? 1 : 0;
      const LAS bf16_t* A = isq ? Qs : Ks;
      f32x4 acc = (f32x4){0.f, 0.f, 0.f, 0.f};
#pragma unroll
      for (int k = 0; k < 4; ++k) acc = mma16(frag_row(A, LDN, 16 * I, 32 * k, lane), frag_row(Ks, LDN, 16 * J, 32 * k, lane), acc);
      const int jj = 16 * J + fr; const float cj = __shfl(cum, jj); float pv[4];
#pragma unroll
      for (int r = 0; r < 4; ++r) { const int ii = 16 * I + 4 * fq + r; const float ci = __shfl(cum, ii); const float dec = __expf(ci - cj);
        if (isq) pv[r] = (jj <= ii) ? acc[r] * dec : 0.f;
        else { pv[r] = (jj < ii) ? acc[r] * dec * bL[ii] : 0.f; if (I == J) Md[I * 256 + (4 * fq + r) * 16 + fr] = pv[r]; } }
      u32x2 o; o.x = pk2(pv[0], pv[1]); o.y = pk2(pv[2], pv[3]);
      *(LAS u32x2*)((isq ? At : Mt) + jj * LDP + 16 * I + 4 * fq) = o;
    }
    f32x4 o2 = (f32x4){0.f, 0.f, 0.f, 0.f};
#pragma unroll
    for (int k = 0; k < 4; ++k) o2 = mma16(frag_row(Sr, LDN, 16 * vt, 32 * k, lane), frag_row(Qs, LDN, 16 * it, 32 * k, lane), o2);
    LBAR();
    if (w < 2) { const LAS float* M = Md + w * 256; const int c = lane & 15;
      float m[16];
#pragma unroll
      for (int q4 = 0; q4 < 4; ++q4) { const f32x4 t4 = *(const LAS f32x4*)(M + c * 16 + 4 * q4); m[4 * q4] = t4[0]; m[4 * q4 + 1] = t4[1]; m[4 * q4 + 2] = t4[2]; m[4 * q4 + 3] = t4[3]; }
      float T[16];
#pragma unroll
      for (int r = 0; r < 16; ++r) { float v = (r == c) ? 1.f : 0.f;
#pragma unroll
        for (int s2 = 0; s2 < r; ++s2) v -= __builtin_bit_cast(float, __builtin_amdgcn_readlane(__builtin_bit_cast(int, m[s2]), r)) * T[s2];
        T[r] = v; }
      if (lane < 16) { LAS u32x4* dst = (LAS u32x4*)(Tt + w * 32 * LDT + c * LDT);
        dst[0] = (u32x4){pk2(T[0], T[1]), pk2(T[2], T[3]), pk2(T[4], T[5]), pk2(T[6], T[7])};
        dst[1] = (u32x4){pk2(T[8], T[9]), pk2(T[10], T[11]), pk2(T[12], T[13]), pk2(T[14], T[15])}; } }
    LBAR();
    for (int ct = w; ct < 10; ct += 4) {
      const int cc = 16 * ct + fr;
      f32x4 rhs;
#pragma unroll
      for (int r = 0; r < 4; ++r) { const int ii = 4 * fq + r; const float bi = bL[ii];
        rhs[r] = ct < 2 ? bi * bf2f(Vs[ii * LDP + cc]) : bi * __expf(__shfl(cum, ii)) * bf2f(Ks[ii * LDN + cc - 32]); }
      { u32x2 o; o.x = pk2(rhs[0], rhs[1]); o.y = pk2(rhs[2], rhs[3]); *(LAS u32x2*)(Rw + fr * LDP + 4 * fq) = o; }
      asm volatile("s_waitcnt lgkmcnt(0)" ::: "memory");
      f32x4 x0 = mma16(frag_tr(Tt, LDT, 0, 0, lane), frag_row(Rw, LDP, 0, 0, lane), (f32x4){0.f, 0.f, 0.f, 0.f});
      { u32x2 o; o.x = pk2(x0[0], x0[1]); o.y = pk2(x0[2], x0[3]); *(LAS u32x2*)(Xt + cc * LDP + 4 * fq) = o; }
#pragma unroll
      for (int r = 0; r < 4; ++r) { const int ii = 16 + 4 * fq + r; const float bi = bL[ii];
        rhs[r] = ct < 2 ? bi * bf2f(Vs[ii * LDP + cc]) : bi * __expf(__shfl(cum, ii)) * bf2f(Ks[ii * LDN + cc - 32]); }
      asm volatile("s_waitcnt lgkmcnt(0)" ::: "memory");
      { bf16x8 fa = frag_tr(Mt, LDP, 0, 16, lane); if (fq >= 2) fa = (bf16x8){0, 0, 0, 0, 0, 0, 0, 0};
        bf16x8 fb = frag_row(Xt, LDP, 16 * ct, 0, lane); if (fq >= 2) fb = (bf16x8){0, 0, 0, 0, 0, 0, 0, 0};
        const f32x4 corr = mma16(fa, fb, (f32x4){0.f, 0.f, 0.f, 0.f});
        rhs = rhs - corr; }
      { u32x2 o; o.x = pk2(rhs[0], rhs[1]); o.y = pk2(rhs[2], rhs[3]); *(LAS u32x2*)(Rw + fr * LDP + 4 * fq) = o; }
      asm volatile("s_waitcnt lgkmcnt(0)" ::: "memory");
      f32x4 x1 = mma16(frag_tr(Tt + 32 * LDT, LDT, 0, 0, lane), frag_row(Rw, LDP, 0, 0, lane), (f32x4){0.f, 0.f, 0.f, 0.f});
      { u32x2 o; o.x = pk2(x1[0], x1[1]); o.y = pk2(x1[2], x1[3]); *(LAS u32x2*)(Xt + cc * LDP + 16 + 4 * fq) = o; }
    }
    LBAR();
    { f32x4 ws = (f32x4){0.f, 0.f, 0.f, 0.f};
#pragma unroll
      for (int k = 0; k < 4; ++k) ws = mma16(frag_tr(Xt + 32 * LDP, LDP, 32 * k, 16 * it, lane), frag_row(Sr, LDN, 16 * vt, 32 * k, lane), ws);
      const u32x2 uu = *(const LAS u32x2*)(Xt + (16 * vt + fr) * LDP + 16 * it + 4 * fq);
      float vn[4] = {bflo(uu.x) - ws[0], bfhi(uu.x) - ws[1], bflo(uu.y) - ws[2], bfhi(uu.y) - ws[3]};
      float vw[4];
#pragma unroll
      for (int r = 0; r < 4; ++r) vw[r] = vn[r] * __expf(cum_last - __shfl(cum, 16 * it + 4 * fq + r));
      u32x2 o; o.x = pk2(vn[0], vn[1]); o.y = pk2(vn[2], vn[3]); *(LAS u32x2*)(Vn + (16 * vt + fr) * LDP + 16 * it + 4 * fq) = o;
      o.x = pk2(vw[0], vw[1]); o.y = pk2(vw[2], vw[3]); *(LAS u32x2*)(Vw + (16 * vt + fr) * LDP + 16 * it + 4 * fq) = o; }
    LBAR();
    { const f32x4 o1 = mma16(frag_row(Vn, LDP, 16 * vt, 0, lane), frag_tr(At, LDP, 0, 16 * it, lane), (f32x4){0.f, 0.f, 0.f, 0.f});
      const int ii = 16 * it + fr; const float eci = __expf(__shfl(cum, ii));
      float o0 = o1[0] + eci * o2[0], o1v = o1[1] + eci * o2[1], o2v = o1[2] + eci * o2[2], o3 = o1[3] + eci * o2[3];
      if (!first) { const unsigned long long pv = ppv; const unsigned lo = (unsigned)pv, hi = (unsigned)(pv >> 32); o0 += bflo(lo); o1v += bfhi(lo); o2v += bflo(hi); o3 += bfhi(hi); }
      u32x2 o; o.x = pk2(o0, o1v); o.y = pk2(o2v, o3); *(u32x2*)op = o; }
    { const float el = __expf(cum_last);
#pragma unroll
      for (int a = 0; a < 2; ++a) { const int kt = 2 * w + a; const bf16x8 fa = frag_tr(Ks, LDN, 0, 16 * kt, lane);
#pragma unroll
        for (int c = 0; c < 2; ++c) { f32x4 acc = mma16(fa, frag_row(Vw, LDP, 16 * c, 0, lane), Sacc[a][c] * el);
          Sacc[a][c] = acc;
          u32x2 o; o.x = pk2(acc[0], acc[1]); o.y = pk2(acc[2], acc[3]);
          *(LAS u32x2*)(Sw + (16 * c + fr) * LDN + 16 * kt + 4 * fq) = o; } } }
    LBAR();
  }
}

__device__ __forceinline__ bf16x8 ldfr(const LAS bf16_t* p) { return *(const LAS bf16x8*)p; }
__device__ __forceinline__ bf16x8 ldft(const LAS bf16_t* p, int ld) {
  const s16x4 v0 = __builtin_amdgcn_ds_read_tr16_b64_v4i16((LAS s16x4*)p);
  const s16x4 v1 = __builtin_amdgcn_ds_read_tr16_b64_v4i16((LAS s16x4*)(p + 4 * ld));
  bf16x8 r; r[0] = v0[0]; r[1] = v0[1]; r[2] = v0[2]; r[3] = v0[3]; r[4] = v1[0]; r[5] = v1[1]; r[6] = v1[2]; r[7] = v1[3];
  return r;
}
__device__ __forceinline__ u32x2 pk4(float a, float b, float c, float dd) { u32x2 o; o.x = pg8::cvt_pk_bf16(a, b); o.y = pg8::cvt_pk_bf16(c, dd); return o; }
__device__ __forceinline__ float bcast_lane(float v, int l) { return __builtin_bit_cast(float, __builtin_amdgcn_readlane(__builtin_bit_cast(int, v), l)); }

__device__ __forceinline__ void gdn2_chain_wg(const Params& P, const Ctx& C, int task) {
  const int b = task >> 5, h = (task >> 2) & 7, vs = task & 3;
  const int d = C.wave >> 2, w = ((C.wave & 3) + 2 * d) & 3, td = C.tid & 255, lane = C.lane, fr = lane & 15, fq = lane >> 4;
  constexpr int LDN = 136, LDP = 40, LDT = 24;
  constexpr int DIRSZ = 64 * 1024;
  LAS unsigned char* L = C.lds + d * DIRSZ;
  LAS bf16_t* Qs = (LAS bf16_t*)L;
  LAS bf16_t* Ks = Qs + 32 * LDN;
  LAS bf16_t* Vt = Ks + 32 * LDN;
  LAS bf16_t* Mt = Vt + 32 * LDP;
  LAS bf16_t* At = Mt + 32 * LDP;
  LAS bf16_t* Rt = At + 32 * LDP;
  LAS bf16_t* Vn = Rt + 32 * LDP;
  LAS bf16_t* Vw = Vn + 32 * LDP;
  LAS bf16_t* Tt = Vw + 32 * LDP;
  LAS bf16_t* St = Tt + 2 * 32 * LDT;
  LAS float* Md = (LAS float*)(St + 2 * 32 * LDN);
  LAS float* gL = Md + 512;
  LAS float* bL = gL + 32; LAS float* becL = bL;
  LAS float* ecL = bL + 32 + (C.wave & 3) * 96; LAS float* encL = ecL + 32; LAS float* ewL = encL + 32;
  const bf16_t* Z = WS(OFF_Z1, bf16_t); bf16_t* MIX = WS(OFF_MIX1, bf16_t); const float* DT = WS(OFF_DT, float);
  const float Aneg = -__expf(GIN(I_GALOG)[d * 8 + h]), dtb = GIN(I_GDTB)[d * 8 + h];
  const int colq = Z1_Q + h * 128, colk = Z1_K + h * 128, colv = Z1_V + h * 128 + vs * 32, outc = h * 128 + vs * 32;
  __syncthreads();
  for (int i = td; i < 58 * 1024 / 4; i += 256) ((LAS unsigned*)L)[i] = 0u;
  f32x4 Sacc[2][2];
#pragma unroll
  for (int a = 0; a < 2; ++a)
#pragma unroll
    for (int c = 0; c < 2; ++c) Sacc[a][c] = (f32x4){0.f, 0.f, 0.f, 0.f};
  const int st_t = td >> 3, st_s = td & 7;
  u32x4 rq[2], rk[2]; u32x2 rv; float ra = 0.f, rb = 0.f;
  auto issue_loads = [&](int step) {
    const int chunk = seq_chunk32(d, step); const size_t row = (size_t)b * TB + chunk * 32 + st_t;
    const u32x4* pq = (const u32x4*)(Z + row * Z1W + colq + st_s * 16); const u32x4* pk = (const u32x4*)(Z + row * Z1W + colk + st_s * 16);
    rq[0] = pq[0]; rq[1] = pq[1]; rk[0] = pk[0]; rk[1] = pk[1];
    rv = *(const u32x2*)(Z + row * Z1W + colv + st_s * 4);
    if (st_s == 0) { rb = DT[row * 32 + d * 8 + h]; ra = DT[row * 32 + 16 + d * 8 + h]; }
  };
  issue_loads(0);
  __syncthreads();
  const int rL136 = fr * LDN + 8 * fq, rL40 = fr * LDP + 8 * fq;
  const int tq = fr >> 2, tp = fr & 3;
  const int tL136 = (8 * fq + tq) * LDN + 4 * tp, tL40 = (8 * fq + tq) * LDP + 4 * tp, tL24 = (8 * fq + tq) * LDT + 4 * tp;
  const int it = w >> 1, vt = w & 1;
  const int si = d ? 31 - st_t : st_t;
  LAS u32x4* stq = (LAS u32x4*)(Qs + si * LDN + st_s * 16); LAS u32x4* stk = (LAS u32x4*)(Ks + si * LDN + st_s * 16);
  LAS bf16_t* stv = Vt + (st_s * 4) * LDP + si;
  const LAS bf16_t* pK_it = Ks + 16 * it * LDN + rL136; const LAS bf16_t* pQ_it = Qs + 16 * it * LDN + rL136;
  for (int step = 0; step < 264; ++step) {
    const int chunk = seq_chunk32(d, step); const int row0 = b * TB + chunk * 32;
    VMWAIT();
    stq[0] = rq[0]; stq[1] = rq[1]; stk[0] = rk[0]; stk[1] = rk[1];
    stv[0] = (bf16_t)(rv.x & 0xffffu); stv[LDP] = (bf16_t)(rv.x >> 16); stv[2 * LDP] = (bf16_t)(rv.y & 0xffffu); stv[3 * LDP] = (bf16_t)(rv.y >> 16);
    if (st_s == 0) { gL[si] = Aneg * softplusf_(ra + dtb); bL[si] = fast_sigmoid(rb); }
    LBAR();
    if (step + 1 < 264) issue_loads(step + 1);
    const bool first = (d == 0) == fwd_first32(chunk);
    bf16_t* op; unsigned long long ppv = 0ull;
    { const int ii = 16 * it + fr; const int t = d ? 31 - ii : ii; op = MIX + (size_t)(row0 + t) * MIXW + outc + 16 * vt + 4 * fq; if (!first) ppv = ld_agent_u64(op); }
    float elast;
    { const float c = wave_incl_scan(lane < 32 ? gL[lane & 31] : 0.f, lane); const float cl = bcast_lane(c, 31); elast = __expf(cl);
      if (lane < 32) { const float ec = __expf(c); ecL[lane] = ec; encL[lane] = c; ewL[lane] = __expf(cl - c); } }
    asm volatile("s_waitcnt lgkmcnt(0)" ::: "memory");
    const LAS bf16_t* Sr = St + (step & 1) * 32 * LDN; LAS bf16_t* Sw = St + ((step + 1) & 1) * 32 * LDN;
    f32x4 o2 = (f32x4){0.f, 0.f, 0.f, 0.f};
    { f32x4 ks = (f32x4){0.f, 0.f, 0.f, 0.f};
      const LAS bf16_t* pS = Sr + 16 * vt * LDN + rL136;
#pragma unroll
      for (int k = 0; k < 4; ++k) { const bf16x8 fs = ldfr(pS + 32 * k); ks = mma16(ldfr(pK_it + 32 * k), fs, ks); o2 = mma16(fs, ldfr(pQ_it + 32 * k), o2); }
      const u32x2 vv = *(const LAS u32x2*)(Vt + (16 * vt + fr) * LDP + 16 * it + 4 * fq);
      const f32x4 ec4 = *(const LAS f32x4*)(ecL + 16 * it + 4 * fq), b4 = *(const LAS f32x4*)(bL + 16 * it + 4 * fq);
      *(LAS u32x2*)(Rt + (16 * vt + fr) * LDP + 16 * it + 4 * fq) =
        pk4(b4[0] * (bflo(vv.x) - ec4[0] * ks[0]), b4[1] * (bfhi(vv.x) - ec4[1] * ks[1]), b4[2] * (bflo(vv.y) - ec4[2] * ks[2]), b4[3] * (bfhi(vv.y) - ec4[3] * ks[3])); }
    { const int isq = w & 1; const LAS bf16_t* A = isq ? Qs : Ks;
      const int njobs = w < 2 ? 1 : 2;
      for (int jb = 0; jb < njobs; ++jb) {
        const int I = (w < 2) ? 1 : jb, J = (w < 2) ? 1 : 0;
        f32x4 acc = (f32x4){0.f, 0.f, 0.f, 0.f};
        const LAS bf16_t* pa = A + 16 * I * LDN + rL136; const LAS bf16_t* pb = Ks + 16 * J * LDN + rL136;
#pragma unroll
        for (int k = 0; k < 4; ++k) acc = mma16(ldfr(pa + 32 * k), ldfr(pb + 32 * k), acc);
        const int jj = 16 * J + fr, i0 = 16 * I + 4 * fq; const float cj = encL[jj];
        const f32x4 c4 = *(const LAS f32x4*)(encL + i0); const f32x4 b4 = *(const LAS f32x4*)(becL + i0);
        float pv[4];
#pragma unroll
        for (int r = 0; r < 4; ++r) { const bool keep = isq ? (jj <= i0 + r) : (jj < i0 + r); const float sc = isq ? 1.f : b4[r];
          pv[r] = keep ? acc[r] * sc * __expf(c4[r] - cj) : 0.f; }
        if (!isq && I == J) { LAS float* md = Md + I * 256 + (4 * fq) * 16 + fr; md[0] = pv[0]; md[16] = pv[1]; md[32] = pv[2]; md[48] = pv[3]; }
        *(LAS u32x2*)((isq ? At : Mt) + jj * LDP + i0) = pk4(pv[0], pv[1], pv[2], pv[3]);
      } }
    LBAR();
    if (w < 2) { const LAS float* M = Md + w * 256; const int c = fr;
      float m[16];
#pragma unroll
      for (int q4 = 0; q4 < 4; ++q4) { const f32x4 t4 = *(const LAS f32x4*)(M + c * 16 + 4 * q4); m[4 * q4] = t4[0]; m[4 * q4 + 1] = t4[1]; m[4 * q4 + 2] = t4[2]; m[4 * q4 + 3] = t4[3]; }
      float T[16];
#pragma unroll
      for (int r = 0; r < 16; ++r) { float v = (r == c) ? 1.f : 0.f;
#pragma unroll
        for (int s2 = 0; s2 < r; ++s2) v -= bcast_lane(m[s2], r) * T[s2];
        T[r] = v; }
      if (lane < 16) { LAS u32x4* dst = (LAS u32x4*)(Tt + w * 32 * LDT + c * LDT);
        dst[0] = (u32x4){pg8::cvt_pk_bf16(T[0], T[1]), pg8::cvt_pk_bf16(T[2], T[3]), pg8::cvt_pk_bf16(T[4], T[5]), pg8::cvt_pk_bf16(T[6], T[7])};
        dst[1] = (u32x4){pg8::cvt_pk_bf16(T[8], T[9]), pg8::cvt_pk_bf16(T[10], T[11]), pg8::cvt_pk_bf16(T[12], T[13]), pg8::cvt_pk_bf16(T[14], T[15])}; } }
    LBAR();
    if (w < 2) { const int ct = w; const int cc = 16 * ct + fr;
      const f32x4 x0 = mma16(ldft(Tt + tL24, LDT), ldfr(Rt + 16 * ct * LDP + rL40), (f32x4){0.f, 0.f, 0.f, 0.f});
      const f32x4 ew0 = *(const LAS f32x4*)(ewL + 4 * fq);
      *(LAS u32x2*)(Vn + cc * LDP + 4 * fq) = pk4(x0[0], x0[1], x0[2], x0[3]);
      *(LAS u32x2*)(Vw + cc * LDP + 4 * fq) = pk4(x0[0] * ew0[0], x0[1] * ew0[1], x0[2] * ew0[2], x0[3] * ew0[3]);
      const u32x2 r1 = *(const LAS u32x2*)(Rt + cc * LDP + 16 + 4 * fq);
      asm volatile("s_waitcnt lgkmcnt(0)" ::: "memory");
      bf16x8 fa = ldft(Mt + tL40 + 16, LDP); bf16x8 fb = ldfr(Vn + 16 * ct * LDP + rL40);
      if (fq >= 2) { fa = (bf16x8){0, 0, 0, 0, 0, 0, 0, 0}; fb = (bf16x8){0, 0, 0, 0, 0, 0, 0, 0}; }
      const f32x4 corr = mma16(fa, fb, (f32x4){0.f, 0.f, 0.f, 0.f});
      *(LAS u32x2*)(Rt + cc * LDP + 16 + 4 * fq) = pk4(bflo(r1.x) - corr[0], bfhi(r1.x) - corr[1], bflo(r1.y) - corr[2], bfhi(r1.y) - corr[3]);
      asm volatile("s_waitcnt lgkmcnt(0)" ::: "memory");
      const f32x4 x1 = mma16(ldft(Tt + 32 * LDT + tL24, LDT), ldfr(Rt + 16 * ct * LDP + 16 + rL40), (f32x4){0.f, 0.f, 0.f, 0.f});
      const f32x4 ew1 = *(const LAS f32x4*)(ewL + 16 + 4 * fq);
      *(LAS u32x2*)(Vn + cc * LDP + 16 + 4 * fq) = pk4(x1[0], x1[1], x1[2], x1[3]);
      *(LAS u32x2*)(Vw + cc * LDP + 16 + 4 * fq) = pk4(x1[0] * ew1[0], x1[1] * ew1[1], x1[2] * ew1[2], x1[3] * ew1[3]); }
    LBAR();
    { const f32x4 o1 = mma16(ldfr(Vn + 16 * vt * LDP + rL40), ldft(At + tL40 + 16 * it, LDP), (f32x4){0.f, 0.f, 0.f, 0.f});
      const float eci = ecL[16 * it + fr];
      float o0 = o1[0] + eci * o2[0], o1v = o1[1] + eci * o2[1], o2v = o1[2] + eci * o2[2], o3 = o1[3] + eci * o2[3];
      if (!first) { const unsigned lo = (unsigned)ppv, hi = (unsigned)(ppv >> 32); o0 += bflo(lo); o1v += bfhi(lo); o2v += bflo(hi); o3 += bfhi(hi); }
      *(u32x2*)op = pk4(o0, o1v, o2v, o3); }
    { const bf16x8 fv0 = ldfr(Vw + rL40), fv1 = ldfr(Vw + 16 * LDP + rL40);
#pragma unroll
      for (int a = 0; a < 2; ++a) { const int kt = 2 * w + a; const bf16x8 fa = ldft(Ks + tL136 + 16 * kt, LDN);
        f32x4 a0 = mma16(fa, fv0, Sacc[a][0] * elast), a1 = mma16(fa, fv1, Sacc[a][1] * elast);
        Sacc[a][0] = a0; Sacc[a][1] = a1;
        *(LAS u32x2*)(Sw + fr * LDN + 16 * kt + 4 * fq) = pk4(a0[0], a0[1], a0[2], a0[3]);
        *(LAS u32x2*)(Sw + (16 + fr) * LDN + 16 * kt + 4 * fq) = pk4(a1[0], a1[1], a1[2], a1[3]); } }
    LBAR();
  }
}

__device__ __forceinline__ void gdn3_chain_wg(const Params& P, const Ctx& C, int task) {
  const int b = task >> 5, h = (task >> 2) & 7, vs = task & 3;
  const int d = C.wave >> 2, w = ((C.wave & 3) + 2 * d) & 3, td = C.tid & 255, lane = C.lane, fr = lane & 15, fq = lane >> 4;
  constexpr int LDN = 136, LDP = 40, LDT = 24;
  constexpr int DIRSZ = 64 * 1024;
  LAS unsigned char* L = C.lds + d * DIRSZ;
  LAS bf16_t* Qs = (LAS bf16_t*)L;
  LAS bf16_t* Ks = Qs + 32 * LDN;
  LAS bf16_t* Vt = Ks + 32 * LDN;
  LAS bf16_t* Mt = Vt + 32 * LDP;
  LAS bf16_t* At = Mt + 32 * LDP;
  LAS bf16_t* Rt = At + 32 * LDP;
  LAS bf16_t* Vn = Rt + 32 * LDP;
  LAS bf16_t* Vw = Vn + 32 * LDP;
  LAS bf16_t* Tt = Vw + 32 * LDP;
  LAS bf16_t* St = Tt + 2 * 32 * LDT;
  LAS float* Md = (LAS float*)(St + 2 * 32 * LDN);
  LAS float* gL = Md + 512;
  LAS float* bL = gL + 32; LAS float* becL = bL;
  LAS float* ecL = bL + 32 + (C.wave & 3) * 96; LAS float* encL = ecL + 32; LAS float* ewL = encL + 32;
  LAS f32x4* O2x = (LAS f32x4*)(bL + 32 + 4 * 96);
  const bf16_t* Z = WS(OFF_Z1, bf16_t); bf16_t* MIX = WS(OFF_MIX1, bf16_t); const float* DT = WS(OFF_DT, float);
  const float Aneg = -__expf(GIN(I_GALOG)[d * 8 + h]), dtb = GIN(I_GDTB)[d * 8 + h];
  const int colq = Z1_Q + h * 128, colk = Z1_K + h * 128, colv = Z1_V + h * 128 + vs * 32, outc = h * 128 + vs * 32;
  __syncthreads();
  for (int i = td; i < 60 * 1024 / 4; i += 256) ((LAS unsigned*)L)[i] = 0u;
  f32x4 Sacc[2][2];
#pragma unroll
  for (int a = 0; a < 2; ++a)
#pragma unroll
    for (int c = 0; c < 2; ++c) Sacc[a][c] = (f32x4){0.f, 0.f, 0.f, 0.f};
  const int st_t = td >> 3, st_s = td & 7;
  u32x4 rq[2], rk[2]; u32x2 rv; float ra = 0.f, rb = 0.f;
  auto issue_loads = [&](int step) {
    const int chunk = seq_chunk32(d, step); const size_t row = (size_t)b * TB + chunk * 32 + st_t;
    const u32x4* pq = (const u32x4*)(Z + row * Z1W + colq + st_s * 16); const u32x4* pk = (const u32x4*)(Z + row * Z1W + colk + st_s * 16);
    rq[0] = pq[0]; rq[1] = pq[1]; rk[0] = pk[0]; rk[1] = pk[1];
    rv = *(const u32x2*)(Z + row * Z1W + colv + st_s * 4);
    if (st_s == 0) { rb = DT[row * 32 + d * 8 + h]; ra = DT[row * 32 + 16 + d * 8 + h]; }
  };
  issue_loads(0);
  __syncthreads();
  const int rL136 = fr * LDN + 8 * fq, rL40 = fr * LDP + 8 * fq;
  const int tq = fr >> 2, tp = fr & 3;
  const int tL136 = (8 * fq + tq) * LDN + 4 * tp, tL40 = (8 * fq + tq) * LDP + 4 * tp, tL24 = (8 * fq + tq) * LDT + 4 * tp;
  const int it = w >> 1, vt = w & 1;
  const int si = d ? 31 - st_t : st_t;
  LAS u32x4* stq = (LAS u32x4*)(Qs + si * LDN + st_s * 16); LAS u32x4* stk = (LAS u32x4*)(Ks + si * LDN + st_s * 16);
  LAS bf16_t* stv = Vt + (st_s * 4) * LDP + si;
  const LAS bf16_t* pK_it = Ks + 16 * it * LDN + rL136; const LAS bf16_t* pQ_it = Qs + 16 * it * LDN + rL136;
  for (int step = 0; step < 264; ++step) {
    const int chunk = seq_chunk32(d, step); const int row0 = b * TB + chunk * 32;
    VMWAIT();
    stq[0] = rq[0]; stq[1] = rq[1]; stk[0] = rk[0]; stk[1] = rk[1];
    stv[0] = (bf16_t)(rv.x & 0xffffu); stv[LDP] = (bf16_t)(rv.x >> 16); stv[2 * LDP] = (bf16_t)(rv.y & 0xffffu); stv[3 * LDP] = (bf16_t)(rv.y >> 16);
    if (st_s == 0) { gL[si] = Aneg * softplusf_(ra + dtb); bL[si] = fast_sigmoid(rb); }
    LBAR();
    if (step + 1 < 264) issue_loads(step + 1);
    const bool first = (d == 0) == fwd_first32(chunk);
    bf16_t* op; unsigned long long ppv = 0ull;
    { const int ii = 16 * it + fr; const int t = d ? 31 - ii : ii; op = MIX + (size_t)(row0 + t) * MIXW + outc + 16 * vt + 4 * fq; if (!first) ppv = ld_agent_u64(op); }
    float elast;
    { const float c = wave_incl_scan(lane < 32 ? gL[lane & 31] : 0.f, lane); const float cl = bcast_lane(c, 31); elast = __expf(cl);
      if (lane < 32) { const float ec = __expf(c); ecL[lane] = ec; encL[lane] = c; ewL[lane] = __expf(cl - c); } }
    asm volatile("s_waitcnt lgkmcnt(0)" ::: "memory");
    const LAS bf16_t* Sr = St + (step & 1) * 32 * LDN; LAS bf16_t* Sw = St + ((step + 1) & 1) * 32 * LDN;
    f32x4 o2 = (f32x4){0.f, 0.f, 0.f, 0.f};
    if (w < 2) {
      f32x4 acc = (f32x4){0.f, 0.f, 0.f, 0.f};
      { const LAS bf16_t* pk = Ks + 16 * w * LDN + rL136;
#pragma unroll
        for (int k = 0; k < 4; ++k) { const bf16x8 f = ldfr(pk + 32 * k); acc = mma16(f, f, acc); } }
      { const int jj = 16 * w + fr, i0 = 16 * w + 4 * fq; const float cj = encL[jj];
        const f32x4 c4 = *(const LAS f32x4*)(encL + i0); const f32x4 b4 = *(const LAS f32x4*)(becL + i0);
        LAS float* md = Md + w * 256 + (4 * fq) * 16 + fr;
#pragma unroll
        for (int r = 0; r < 4; ++r) md[16 * r] = (jj < i0 + r) ? acc[r] * b4[r] * __expf(c4[r] - cj) : 0.f; }
      asm volatile("s_waitcnt lgkmcnt(0)" ::: "memory");
      const LAS float* M = Md + w * 256; const int c = fr;
      float m[16];
#pragma unroll
      for (int q4 = 0; q4 < 4; ++q4) { const f32x4 t4 = *(const LAS f32x4*)(M + c * 16 + 4 * q4); m[4 * q4] = t4[0]; m[4 * q4 + 1] = t4[1]; m[4 * q4 + 2] = t4[2]; m[4 * q4 + 3] = t4[3]; }
      float T[16];
#pragma unroll
      for (int r = 0; r < 16; ++r) { float v = (r == c) ? 1.f : 0.f;
#pragma unroll
        for (int s2 = 0; s2 < r; ++s2) v -= bcast_lane(m[s2], r) * T[s2];
        T[r] = v; }
      if (lane < 16) { LAS u32x4* dst = (LAS u32x4*)(Tt + w * 32 * LDT + c * LDT);
        dst[0] = (u32x4){pk2(T[0], T[1]), pk2(T[2], T[3]), pk2(T[4], T[5]), pk2(T[6], T[7])};
        dst[1] = (u32x4){pk2(T[8], T[9]), pk2(T[10], T[11]), pk2(T[12], T[13]), pk2(T[14], T[15])}; }
    } else {
      const int pvt = w & 1;
#pragma unroll
      for (int pit = 1; pit >= 0; --pit) {
        f32x4 ks = (f32x4){0.f, 0.f, 0.f, 0.f}, qs = (f32x4){0.f, 0.f, 0.f, 0.f};
        const LAS bf16_t* pS = Sr + 16 * pvt * LDN + rL136; const LAS bf16_t* pK = Ks + 16 * pit * LDN + rL136; const LAS bf16_t* pQ = Qs + 16 * pit * LDN + rL136;
#pragma unroll
        for (int k = 0; k < 4; ++k) { const bf16x8 fs = ldfr(pS + 32 * k); ks = mma16(ldfr(pK + 32 * k), fs, ks); qs = mma16(fs, ldfr(pQ + 32 * k), qs); }
        const u32x2 vv = *(const LAS u32x2*)(Vt + (16 * pvt + fr) * LDP + 16 * pit + 4 * fq);
        const f32x4 ec4 = *(const LAS f32x4*)(ecL + 16 * pit + 4 * fq), b4 = *(const LAS f32x4*)(bL + 16 * pit + 4 * fq);
        *(LAS u32x2*)(Rt + (16 * pvt + fr) * LDP + 16 * pit + 4 * fq) =
          pk4(b4[0] * (bflo(vv.x) - ec4[0] * ks[0]), b4[1] * (bfhi(vv.x) - ec4[1] * ks[1]), b4[2] * (bflo(vv.y) - ec4[2] * ks[2]), b4[3] * (bfhi(vv.y) - ec4[3] * ks[3]));
        if (pit == 1) o2 = qs; else O2x[pvt * 64 + lane] = qs;
      }
#pragma unroll
      for (int jb = 0; jb < 2; ++jb) {
        const bool isq = (w == 3) || (jb == 1);
        const int I = (w == 2) ? 1 : jb, J = (w == 2) ? 0 : jb;
        f32x4 acc = (f32x4){0.f, 0.f, 0.f, 0.f};
        const LAS bf16_t* pa = (isq ? Qs : Ks) + 16 * I * LDN + rL136; const LAS bf16_t* pb = Ks + 16 * J * LDN + rL136;
#pragma unroll
        for (int k = 0; k < 4; ++k) acc = mma16(ldfr(pa + 32 * k), ldfr(pb + 32 * k), acc);
        const int jj = 16 * J + fr, i0 = 16 * I + 4 * fq; const float cj = encL[jj];
        const f32x4 c4 = *(const LAS f32x4*)(encL + i0); const f32x4 b4 = *(const LAS f32x4*)(becL + i0);
        float pv[4];
#pragma unroll
        for (int r = 0; r < 4; ++r) { const bool keep = isq ? (jj <= i0 + r) : (jj < i0 + r); const float sc = isq ? 1.f : b4[r];
          pv[r] = keep ? acc[r] * sc * __expf(c4[r] - cj) : 0.f; }
        *(LAS u32x2*)((isq ? At : Mt) + jj * LDP + i0) = pk4(pv[0], pv[1], pv[2], pv[3]);
      }
    }
    LBAR();
    if (w < 2) { const int ct = w; const int cc = 16 * ct + fr;
      const f32x4 x0 = mma16(ldft(Tt + tL24, LDT), ldfr(Rt + 16 * ct * LDP + rL40), (f32x4){0.f, 0.f, 0.f, 0.f});
      const f32x4 ew0 = *(const LAS f32x4*)(ewL + 4 * fq);
      *(LAS u32x2*)(Vn + cc * LDP + 4 * fq) = pk4(x0[0], x0[1], x0[2], x0[3]);
      *(LAS u32x2*)(Vw + cc * LDP + 4 * fq) = pk4(x0[0] * ew0[0], x0[1] * ew0[1], x0[2] * ew0[2], x0[3] * ew0[3]);
      const u32x2 r1 = *(const LAS u32x2*)(Rt + cc * LDP + 16 + 4 * fq);
      asm volatile("s_waitcnt lgkmcnt(0)" ::: "memory");
      bf16x8 fa = ldft(Mt + tL40 + 16, LDP); bf16x8 fb = ldfr(Vn + 16 * ct * LDP + rL40);
      if (fq >= 2) { fa = (bf16x8){0, 0, 0, 0, 0, 0, 0, 0}; fb = (bf16x8){0, 0, 0, 0, 0, 0, 0, 0}; }
      const f32x4 corr = mma16(fa, fb, (f32x4){0.f, 0.f, 0.f, 0.f});
      *(LAS u32x2*)(Rt + cc * LDP + 16 + 4 * fq) = pk4(bflo(r1.x) - corr[0], bfhi(r1.x) - corr[1], bflo(r1.y) - corr[2], bfhi(r1.y) - corr[3]);
      asm volatile("s_waitcnt lgkmcnt(0)" ::: "memory");
      const f32x4 x1 = mma16(ldft(Tt + 32 * LDT + tL24, LDT), ldfr(Rt + 16 * ct * LDP + 16 + rL40), (f32x4){0.f, 0.f, 0.f, 0.f});
      const f32x4 ew1 = *(const LAS f32x4*)(ewL + 16 + 4 * fq);
      *(LAS u32x2*)(Vn + cc * LDP + 16 + 4 * fq) = pk4(x1[0], x1[1], x1[2], x1[3]);
      *(LAS u32x2*)(Vw + cc * LDP + 16 + 4 * fq) = pk4(x1[0] * ew1[0], x1[1] * ew1[1], x1[2] * ew1[2], x1[3] * ew1[3]); }
    LBAR();
    if (w < 2) o2 = O2x[w * 64 + lane];
    { const f32x4 o1 = mma16(ldfr(Vn + 16 * vt * LDP + rL40), ldft(At + tL40 + 16 * it, LDP), (f32x4){0.f, 0.f, 0.f, 0.f});
      const float eci = ecL[16 * it + fr];
      float o0 = o1[0] + eci * o2[0], o1v = o1[1] + eci * o2[1], o2v = o1[2] + eci * o2[2], o3 = o1[3] + eci * o2[3];
      if (!first) { const unsigned lo = (unsigned)ppv, hi = (unsigned)(ppv >> 32); o0 += bflo(lo); o1v += bfhi(lo); o2v += bflo(hi); o3 += bfhi(hi); }
      *(u32x2*)op = pk4(o0, o1v, o2v, o3); }
    { const bf16x8 fv0 = ldfr(Vw + rL40), fv1 = ldfr(Vw + 16 * LDP + rL40);
#pragma unroll
      for (int a = 0; a < 2; ++a) { const int kt = 2 * w + a; const bf16x8 fa = ldft(Ks + tL136 + 16 * kt, LDN);
        f32x4 a0 = mma16(fa, fv0, Sacc[a][0] * elast), a1 = mma16(fa, fv1, Sacc[a][1] * elast);
        Sacc[a][0] = a0; Sacc[a][1] = a1;
        *(LAS u32x2*)(Sw + fr * LDN + 16 * kt + 4 * fq) = pk4(a0[0], a0[1], a0[2], a0[3]);
        *(LAS u32x2*)(Sw + (16 + fr) * LDN + 16 * kt + 4 * fq) = pk4(a1[0], a1[1], a1[2], a1[3]); } }
    LBAR();
  }
}

__device__ __forceinline__ void hgrn2_chain_wg(const Params& P, const Ctx& C, int task) {
  const int b = task >> 5, h = (task >> 2) & 7, vs = task & 3;
  const int d = C.wave >> 2, w = C.wave & 3, td = C.tid & 255, lane = C.lane, fr = lane & 15, fq = lane >> 4;
  constexpr int LDN = 136, LDP = 40;
  constexpr int DIRSZ = 72 * 1024;
  LAS unsigned char* L = C.lds + d * DIRSZ;
  LAS bf16_t* Qt = (LAS bf16_t*)L;
  LAS bf16_t* Kh = Qt + 32 * LDN;
  LAS bf16_t* Kw = Kh + 32 * LDN;
  LAS bf16_t* Vs = Kw + 32 * LDN;
  LAS bf16_t* Pt = Vs + 32 * LDP;
  LAS bf16_t* St = Pt + 32 * LDP;
  LAS float* PR = (LAS float*)(St + 2 * 32 * LDN);
  LAS float* PL = PR + 32 * 128;
  const bf16_t* Z = WS(OFF_Z1, bf16_t); bf16_t* MIX = WS(OFF_MIX1, bf16_t);
  const int colq = Z1_HQ + h * 128, colf = Z1_HF + d * 1024 + h * 128, colv = Z1_HI + h * 128 + vs * 32, outc = 1024 + h * 128 + vs * 32;
  __syncthreads();
  for (int i = td; i < 32 * LDP / 2; i += 256) ((LAS unsigned*)Pt)[i] = 0u;
  for (int i = td; i < 2 * 32 * LDN / 2; i += 256) ((LAS unsigned*)St)[i] = 0u;
  f32x4 Sacc[2][2];
#pragma unroll
  for (int a = 0; a < 2; ++a)
#pragma unroll
    for (int c = 0; c < 2; ++c) Sacc[a][c] = (f32x4){0.f, 0.f, 0.f, 0.f};
  const int st_t = td >> 3, st_s = td & 7;
  float lbv[16];
#pragma unroll
  for (int e = 0; e < 16; ++e) lbv[e] = WS(OFF_LB1, float)[h * 128 + st_s * 16 + e];
  u32x4 rq[2], rf[2]; u32x2 rv;
  auto issue_loads = [&](int step) {
    const int chunk = seq_chunk32(d, step); const size_t row = (size_t)b * TB + chunk * 32 + st_t;
    const u32x4* pq = (const u32x4*)(Z + row * Z1W + colq + st_s * 16); const u32x4* pf = (const u32x4*)(Z + row * Z1W + colf + st_s * 16);
    rq[0] = pq[0]; rq[1] = pq[1]; rf[0] = pf[0]; rf[1] = pf[1];
    rv = *(const u32x2*)(Z + row * Z1W + colv + st_s * 4);
  };
  issue_loads(0);
  __syncthreads();
  const int rL136 = fr * LDN + 8 * fq;
  const int tq = fr >> 2, tp = fr & 3;
  const int tL136 = (8 * fq + tq) * LDN + 4 * tp, tL40 = (8 * fq + tq) * LDP + 4 * tp;
  const int vt = w & 1, it = w >> 1;
  const int si = d ? 31 - st_t : st_t;
  LAS float* prow = PR + si * 128 + st_s * 16;
  LAS float* pscan = PR + (td >> 7) * 16 * 128 + (td & 127);
  for (int step = 0; step < 264; ++step) {
    const int chunk = seq_chunk32(d, step); const int row0 = b * TB + chunk * 32;
    VMWAIT();
    float qv[16], kk[16];
    { const unsigned qw[8] = {rq[0].x, rq[0].y, rq[0].z, rq[0].w, rq[1].x, rq[1].y, rq[1].z, rq[1].w};
      const unsigned fw[8] = {rf[0].x, rf[0].y, rf[0].z, rf[0].w, rf[1].x, rf[1].y, rf[1].z, rf[1].w};
      f32x4 f4[4];
#pragma unroll
      for (int e = 0; e < 8; ++e) { qv[2 * e] = bflo(qw[e]); qv[2 * e + 1] = bfhi(qw[e]);
        const float k0 = (1.f - lbv[2 * e]) * (1.f - fast_sigmoid(bflo(fw[e]))), k1 = (1.f - lbv[2 * e + 1]) * (1.f - fast_sigmoid(bfhi(fw[e])));
        kk[2 * e] = k0; kk[2 * e + 1] = k1; f4[e >> 1][(2 * e) & 3] = 1.f - k0; f4[e >> 1][(2 * e + 1) & 3] = 1.f - k1; }
#pragma unroll
      for (int e = 0; e < 4; ++e) *(LAS f32x4*)(prow + 4 * e) = f4[e];
      *(LAS u32x2*)(Vs + si * LDP + st_s * 4) = rv; }
    LBAR();
    if (step + 1 < 264) issue_loads(step + 1);
    const bool first = (d == 0) == fwd_first32(chunk);
    bf16_t* op; unsigned long long ppv = 0ull;
    { const int ii = 16 * it + fr; const int t = d ? 31 - ii : ii; op = MIX + (size_t)(row0 + t) * MIXW + outc + 16 * vt + 4 * fq; if (!first) ppv = ld_agent_u64(op); }
    { float pv[16];
#pragma unroll
      for (int i = 0; i < 16; ++i) pv[i] = pscan[i * 128];
#pragma unroll
      for (int i = 1; i < 16; ++i) pv[i] *= pv[i - 1];
#pragma unroll
      for (int i = 0; i < 16; ++i) pscan[i * 128] = pv[i]; }
    LBAR();
    { const bool hi = si >= 16;
      unsigned oq[8], oh[8], ow[8];
#pragma unroll
      for (int e4 = 0; e4 < 4; ++e4) {
        f32x4 p = *(const LAS f32x4*)(prow + 4 * e4); const f32x4 p15 = *(const LAS f32x4*)(PR + 15 * 128 + st_s * 16 + 4 * e4), p31 = *(const LAS f32x4*)(PR + 31 * 128 + st_s * 16 + 4 * e4);
        const f32x4 pl = p15 * p31; if (hi) p = p * p15;
        if (si == 0) *(LAS f32x4*)(PL + st_s * 16 + 4 * e4) = pl;
        float q_[4], h_[4], w_[4];
#pragma unroll
        for (int r = 0; r < 4; ++r) { const int e = 4 * e4 + r; const float rp = __builtin_amdgcn_rcpf(fmaxf(p[r], 1e-30f)); q_[r] = qv[e] * p[r]; h_[r] = kk[e] * rp; w_[r] = h_[r] * pl[r]; }
        oq[2 * e4] = pk2(q_[0], q_[1]); oq[2 * e4 + 1] = pk2(q_[2], q_[3]); oh[2 * e4] = pk2(h_[0], h_[1]); oh[2 * e4 + 1] = pk2(h_[2], h_[3]); ow[2 * e4] = pk2(w_[0], w_[1]); ow[2 * e4 + 1] = pk2(w_[2], w_[3]); }
      LAS u32x4* dq = (LAS u32x4*)(Qt + si * LDN + st_s * 16); LAS u32x4* dh = (LAS u32x4*)(Kh + si * LDN + st_s * 16); LAS u32x4* dw = (LAS u32x4*)(Kw + si * LDN + st_s * 16);
      dq[0] = (u32x4){oq[0], oq[1], oq[2], oq[3]}; dq[1] = (u32x4){oq[4], oq[5], oq[6], oq[7]};
      dh[0] = (u32x4){oh[0], oh[1], oh[2], oh[3]}; dh[1] = (u32x4){oh[4], oh[5], oh[6], oh[7]};
      dw[0] = (u32x4){ow[0], ow[1], ow[2], ow[3]}; dw[1] = (u32x4){ow[4], ow[5], ow[6], ow[7]}; }
    LBAR();
    if (w < 3) { const int I = w >= 1 ? 1 : 0, J = w == 2 ? 1 : 0;
      f32x4 acc = (f32x4){0.f, 0.f, 0.f, 0.f};
      const LAS bf16_t* pa = Qt + 16 * I * LDN + rL136; const LAS bf16_t* pb = Kh + 16 * J * LDN + rL136;
#pragma unroll
      for (int k = 0; k < 4; ++k) acc = mma16(ldfr(pa + 32 * k), ldfr(pb + 32 * k), acc);
      const int jj = 16 * J + fr, i0 = 16 * I + 4 * fq;
      *(LAS u32x2*)(Pt + jj * LDP + i0) = pk4(jj <= i0 ? acc[0] : 0.f, jj <= i0 + 1 ? acc[1] : 0.f, jj <= i0 + 2 ? acc[2] : 0.f, jj <= i0 + 3 ? acc[3] : 0.f); }
    const LAS bf16_t* Sr = St + (step & 1) * 32 * LDN; LAS bf16_t* Sw = St + ((step + 1) & 1) * 32 * LDN;
    f32x4 o2 = (f32x4){0.f, 0.f, 0.f, 0.f};
    { const LAS bf16_t* ps = Sr + 16 * vt * LDN + rL136; const LAS bf16_t* pq = Qt + 16 * it * LDN + rL136;
#pragma unroll
      for (int k = 0; k < 4; ++k) o2 = mma16(ldfr(ps + 32 * k), ldfr(pq + 32 * k), o2); }
    { const bf16x8 fv0 = ldft(Vs + tL40, LDP), fv1 = ldft(Vs + tL40 + 16, LDP);
#pragma unroll
      for (int a = 0; a < 2; ++a) { const int kt = 2 * w + a; const f32x4 dec = *(const LAS f32x4*)(PL + 16 * kt + 4 * fq);
        const bf16x8 fa = ldft(Kw + tL136 + 16 * kt, LDN);
        const f32x4 a0 = mma16(fa, fv0, Sacc[a][0] * dec), a1 = mma16(fa, fv1, Sacc[a][1] * dec);
        Sacc[a][0] = a0; Sacc[a][1] = a1;
        *(LAS u32x2*)(Sw + fr * LDN + 16 * kt + 4 * fq) = pk4(a0[0], a0[1], a0[2], a0[3]);
        *(LAS u32x2*)(Sw + (16 + fr) * LDN + 16 * kt + 4 * fq) = pk4(a1[0], a1[1], a1[2], a1[3]); } }
    LBAR();
    { const f32x4 o1 = mma16(ldft(Vs + tL40 + 16 * vt, LDP), ldft(Pt + tL40 + 16 * it, LDP), (f32x4){0.f, 0.f, 0.f, 0.f});
      float o0 = o1[0] + o2[0], o1v = o1[1] + o2[1], o2v = o1[2] + o2[2], o3 = o1[3] + o2[3];
      if (!first) { const unsigned lo = (unsigned)ppv, hi2 = (unsigned)(ppv >> 32); o0 += bflo(lo); o1v += bfhi(lo); o2v += bflo(hi2); o3 += bfhi(hi2); }
      *(u32x2*)op = pk4(o0, o1v, o2v, o3); }
    LBAR();
  }
}
__device__ __forceinline__ void phase_chain1(const Params& P, const Ctx& C, int mode) {
  if (mode != 2) for (int task = C.bid; task < 128; task += C.nblk) gdn3_chain_wg(P, C, task);
  __builtin_amdgcn_sched_barrier(0);
  if (mode != 1) for (int task = C.bid < 128 ? C.bid + C.nblk : C.bid; task < 256; task += C.nblk) hgrn2_chain_wg(P, C, task - 128);
}
__device__ __forceinline__ void phase_onorm(const Params& P, const Ctx& C) {
  bf16_t* MIX = WS(OFF_MIX1, bf16_t); bf16_t* U = WS(OFF_U1B, bf16_t);
  const float* m1 = WS(OFF_MOD, float) + (size_t)5 * 6144;
  for (int r = C.gw; r < R; r += C.ngw) {
    const int b = r / TB, pos = r % TB; if (pos < CTXL) continue;
#pragma unroll
    for (int half = 0; half < 2; ++half) {
      const float* gn = half ? GIN(I_HNG) : GIN(I_GNG);
#pragma unroll
      for (int j = 0; j < 4; ++j) { const int e = 4 * C.lane + 256 * j; bf16_t* p = MIX + (size_t)r * MIXW + half * 1024 + e;
        const u32x2 a = *(const u32x2*)p; const float o0 = bflo(a.x), o1 = bfhi(a.x), o2 = bflo(a.y), o3 = bfhi(a.y);
        const float ss = half_sum32((o0 * o0 + o1 * o1) + (o2 * o2 + o3 * o3)); const float rs = rsqrtf(ss * (1.f / 128.f) + RMS_EPS);
        const f32x4 g = *(const f32x4*)(gn + (e & 127));
        u32x2 w; w.x = pk2(o0 * rs * g[0], o1 * rs * g[1]); w.y = pk2(o2 * rs * g[2], o3 * rs * g[3]); *(u32x2*)p = w; }
    }
    f32x4 h[4], u[4]; row_load(GOUT + ((size_t)b * SEQ + (pos - CTXL)) * D, C.lane, h);
    row_modulate(h, m1 + (size_t)b * 6144, m1 + (size_t)b * 6144 + D, C.lane, u);
    row_store_bf16(U + (size_t)r * D, C.lane, u);
  }
  LAS float* scr = (LAS float*)C.lds + C.wave * (64 * 33);
  convert_experts(P, 1, WS(OFF_WE1, bf16_t), WS(OFF_WE1 + 64 * MiB, bf16_t), C, scr);
}
__device__ __forceinline__ void phase_gates(const Params& P, const Ctx& C) {
  pg8::Gemm g{WS(OFF_U1B, bf16_t), WS(OFF_WG1, bf16_t), D, D}; pg8::GridOrder S; S.init(128, 8, C.nblk, C.bid, 1);
  pg8::EpiGateMul E{WS(OFF_MIX1, bf16_t), MIXW};
  pg8::gemm_phase(C.lds, g, S, E);
}


#define XB_TMO      128
#define XB_XCNT(j)  (256  + 64 * (j))
#define XB_XSUB(j)  (1280 + 64 * (j))
#define XB_XGEN(j)  (2304 + 64 * (j))
#define XB_TOP      3328
#define XB_TOPGEN   3392
#define XCD_BAR_WORDS 3456
#define XB_SPIN_CAP (1u << 22)
constexpr size_t OFF_BAR = 16 * 1024;
constexpr int LDS_BAR_OFF = LDS_BYTES - 64;
__device__ __forceinline__ unsigned xb_ld(unsigned* p)              { return __hip_atomic_load(p, __ATOMIC_RELAXED, __HIP_MEMORY_SCOPE_AGENT); }
__device__ __forceinline__ unsigned xb_add(unsigned* p, unsigned v) { return __hip_atomic_fetch_add(p, v, __ATOMIC_RELAXED, __HIP_MEMORY_SCOPE_AGENT); }
__device__ __forceinline__ unsigned xb_xcc_id() { return (unsigned)__builtin_amdgcn_s_getreg((3 << 11) | 20) & 0xFu; }
#define XB_SPIN(cond, bar) do { unsigned _sp = 0; while (cond) { __builtin_amdgcn_s_sleep(1); \
    if ((++_sp & 255u) == 0u) { if (xb_ld(&(bar)[XB_TMO])) break; if (_sp > XB_SPIN_CAP) { atomicAdd(&(bar)[XB_TMO], 1u); break; } } } } while (0)
__device__ __forceinline__ void xcd_barrier_post(unsigned* bar) { if (threadIdx.x == 0) (void)xb_add(&bar[XB_XCNT(xb_xcc_id())], 1u); }
__device__ __forceinline__ void xcd_barrier_complete(unsigned* bar, unsigned x, unsigned& nloc, unsigned& nx) {
  const unsigned G = gridDim.x * gridDim.y * gridDim.z;
  unsigned sum, cnt, mine, sp = 0u;
  for (;;) {
    sum = 0u; cnt = 0u; mine = 0u;
#pragma unroll
    for (unsigned j = 0; j < 16; ++j) { const unsigned c = xb_ld(&bar[XB_XCNT(j)]); sum += c; cnt += (c > 0u) ? 1u : 0u; mine = (j == x) ? c : mine; }
    if (sum == G) break;
    __builtin_amdgcn_s_sleep(1);
    if ((++sp & 255u) == 0u) { if (xb_ld(&bar[XB_TMO])) break; if (sp > XB_SPIN_CAP) { atomicAdd(&bar[XB_TMO], 1u); break; } }
  }
  nloc = mine > 0u ? mine : 1u; nx = cnt > 0u ? cnt : 1u;
}
__device__ __forceinline__ void xcd_barrier(unsigned* bar, volatile LAS unsigned* st) {
  asm volatile("s_waitcnt vmcnt(0)" ::: "memory");
  __syncthreads();
  if (threadIdx.x == 0) {
    const unsigned x = xb_xcc_id();
    __builtin_amdgcn_s_waitcnt(0);
    unsigned nloc = st[0], nx = st[1];
    if (nloc == 0u) { xcd_barrier_complete(bar, x, nloc, nx); st[0] = nloc; st[1] = nx; }
    const unsigned old = xb_add(&bar[XB_XSUB(x)], 1u);
    const unsigned gen = old / nloc;
    if (old + 1u == (gen + 1u) * nloc) {
      __builtin_amdgcn_fence(__ATOMIC_RELEASE, "agent");
      asm volatile("s_waitcnt vmcnt(0)" ::: "memory");
      const unsigned og = xb_add(&bar[XB_TOP], 1u);
      const unsigned tg = og / nx;
      if (og + 1u == (tg + 1u) * nx) xb_add(&bar[XB_TOPGEN], 1u);
      else XB_SPIN(xb_ld(&bar[XB_TOPGEN]) == tg, bar);
      __builtin_amdgcn_fence(__ATOMIC_ACQUIRE, "agent");
      xb_add(&bar[XB_XGEN(x)], 1u);
      asm volatile("s_waitcnt vmcnt(0)" ::: "memory");
    } else {
      XB_SPIN(xb_ld(&bar[XB_XGEN(x)]) == gen, bar);
      __builtin_amdgcn_fence(__ATOMIC_ACQUIRE, "agent");
      asm volatile("s_waitcnt vmcnt(0)" ::: "memory");
    }
  }
  __syncthreads();
}
__global__ void __launch_bounds__(NT, 2) fwd_megakernel(Params Pk) {
  extern __shared__ __attribute__((aligned(16))) unsigned char lds_raw[];
  cg::grid_group grid = cg::this_grid();
#ifndef PROBE_DOUBLE
#define PROBE_DOUBLE -1
#endif
#ifndef PROBE_MODE
#define PROBE_MODE 0
#endif
#ifndef PHASE_MASK
#define PHASE_MASK 0xFFFFFFFFu
#endif
#define SYNC() do { const unsigned char* wsb_ = ((const Params*)(const __attribute__((address_space(4))) Params*)__builtin_amdgcn_kernarg_segment_ptr())->ws; \
    xcd_barrier((unsigned*)(GAS unsigned*)(wsb_ + OFF_BAR), (volatile LAS unsigned*)((LAS unsigned char*)lds_raw + LDS_BAR_OFF)); } while (0)
#define SYNC_CG() do { __syncthreads(); grid.sync(); } while (0)
  if (threadIdx.x < 16) ((LAS unsigned*)((LAS unsigned char*)lds_raw + LDS_BAR_OFF))[threadIdx.x] = 0u;
  __syncthreads();
  xcd_barrier_post((unsigned*)(GAS unsigned*)(Pk.ws + OFF_BAR));
#define LAUNDER() const Params* pp; { unsigned long long a_ = (unsigned long long)__builtin_amdgcn_kernarg_segment_ptr(); asm volatile("" : "+s"(a_)); \
    const unsigned lo_ = __builtin_amdgcn_readfirstlane((unsigned)a_), hi_ = __builtin_amdgcn_readfirstlane((unsigned)(a_ >> 32)); \
    pp = (const Params*)(const __attribute__((address_space(4))) Params*)(((unsigned long long)hi_ << 32) | lo_); } \
  Ctx C; { int t_ = threadIdx.x; asm volatile("" : "+v"(t_)); t_ &= 511; int b_ = blockIdx.x; asm volatile("" : "+s"(b_)); b_ = __builtin_amdgcn_readfirstlane(b_); int g_ = gridDim.x; asm volatile("" : "+s"(g_)); g_ = __builtin_amdgcn_readfirstlane(g_); \
    C.lds = (LAS unsigned char*)lds_raw; C.tid = t_; C.lane = t_ & 63; C.wave = __builtin_amdgcn_readfirstlane(t_ >> 6); \
    C.bid = b_; C.nblk = g_; C.gw = b_ * NWAVES + C.wave; C.ngw = g_ * NWAVES; }
#define WSP(off, T) ((T*)(GAS T*)(pp->ws + (off)))
  for (int rep_ = 0; rep_ < ((PROBE_DOUBLE == 0) ? 2 : 1); ++rep_) { if (PHASE_MASK & (1u << 0)) { LAUNDER(); phase0(*pp, C); }  SYNC_CG(); }
  for (int rep_ = 0; rep_ < ((PROBE_DOUBLE == 1) ? 2 : 1); ++rep_) { if (PHASE_MASK & (1u << 1)) { LAUNDER(); phase_u0(*pp, C); }  SYNC(); }
  for (int rep_ = 0; rep_ < ((PROBE_DOUBLE == 2) ? 2 : 1); ++rep_) { if (PHASE_MASK & (1u << 2)) { LAUNDER(); phase_inproj(*pp, C, WSP(OFF_U0, bf16_t), WSP(OFF_WAB, bf16_t), WSP(OFF_Z0, bf16_t), Z0W); }  SYNC(); }
  for (int rep_ = 0; rep_ < ((PROBE_DOUBLE == 3) ? 2 : 1); ++rep_) { if (PHASE_MASK & (1u << 3)) { LAUNDER(); phase_feat0(*pp, C); }  SYNC(); }
  for (int rep_ = 0; rep_ < ((PROBE_DOUBLE == 4) ? 2 : 1); ++rep_) { if (PHASE_MASK & (1u << 4)) { LAUNDER(); phase_chain0(*pp, C, rep_ ? PROBE_MODE : 0); }  SYNC(); }
  for (int rep_ = 0; rep_ < ((PROBE_DOUBLE == 5) ? 2 : 1); ++rep_) { if (PHASE_MASK & (1u << 5)) { LAUNDER(); phase_ssdfin(*pp, C); }  SYNC(); }
  for (int rep_ = 0; rep_ < ((PROBE_DOUBLE == 6) ? 2 : 1); ++rep_) { if (PHASE_MASK & (1u << 6)) { LAUNDER(); phase_outproj(*pp, C, 0); }  SYNC(); }
  for (int rep_ = 0; rep_ < ((PROBE_DOUBLE == 7) ? 2 : 1); ++rep_) { if (PHASE_MASK & (1u << 7)) { LAUNDER(); phase_lnmix(*pp, C, 0); }  SYNC(); }
  for (int rep_ = 0; rep_ < ((PROBE_DOUBLE == 8) ? 2 : 1); ++rep_) { if (PHASE_MASK & (1u << 8)) { LAUNDER(); phase_dispatch(*pp, C, 0); }  SYNC(); }
  for (int rep_ = 0; rep_ < ((PROBE_DOUBLE == 9) ? 2 : 1); ++rep_) { if (PHASE_MASK & (1u << 9)) { LAUNDER(); phase_moe1(*pp, C, 0); }  SYNC(); }
  for (int rep_ = 0; rep_ < ((PROBE_DOUBLE == 10) ? 2 : 1); ++rep_) { if (PHASE_MASK & (1u << 10)) { LAUNDER(); phase_moe2(*pp, C, 0); }  SYNC(); }
  for (int rep_ = 0; rep_ < ((PROBE_DOUBLE == 11) ? 2 : 1); ++rep_) { if (PHASE_MASK & (1u << 11)) { LAUNDER(); phase_lnffn(*pp, C, 0); }  SYNC(); }
  for (int rep_ = 0; rep_ < ((PROBE_DOUBLE == 12) ? 2 : 1); ++rep_) { if (PHASE_MASK & (1u << 12)) { LAUNDER(); phase_inproj(*pp, C, WSP(OFF_U1, bf16_t), WSP(OFF_WCD, bf16_t), WSP(OFF_Z1, bf16_t), Z1W); }  SYNC(); }
  for (int rep_ = 0; rep_ < ((PROBE_DOUBLE == 13) ? 2 : 1); ++rep_) { if (PHASE_MASK & (1u << 13)) { LAUNDER(); phase_feat1(*pp, C); }  SYNC(); }
  for (int rep_ = 0; rep_ < ((PROBE_DOUBLE == 14) ? 2 : 1); ++rep_) { if (PHASE_MASK & (1u << 14)) { LAUNDER(); phase_chain1(*pp, C, rep_ ? PROBE_MODE : 0); }  SYNC(); }
  for (int rep_ = 0; rep_ < ((PROBE_DOUBLE == 15) ? 2 : 1); ++rep_) { if (PHASE_MASK & (1u << 15)) { LAUNDER(); phase_onorm(*pp, C); }  SYNC(); }
  for (int rep_ = 0; rep_ < ((PROBE_DOUBLE == 16) ? 2 : 1); ++rep_) { if (PHASE_MASK & (1u << 16)) { LAUNDER(); phase_gates(*pp, C); }  SYNC(); }
  for (int rep_ = 0; rep_ < ((PROBE_DOUBLE == 17) ? 2 : 1); ++rep_) { if (PHASE_MASK & (1u << 17)) { LAUNDER(); phase_outproj(*pp, C, 1); }  SYNC(); }
  for (int rep_ = 0; rep_ < ((PROBE_DOUBLE == 18) ? 2 : 1); ++rep_) { if (PHASE_MASK & (1u << 18)) { LAUNDER(); phase_lnmix(*pp, C, 1); }  SYNC(); }
  for (int rep_ = 0; rep_ < ((PROBE_DOUBLE == 19) ? 2 : 1); ++rep_) { if (PHASE_MASK & (1u << 19)) { LAUNDER(); phase_dispatch(*pp, C, 1); }  SYNC(); }
  for (int rep_ = 0; rep_ < ((PROBE_DOUBLE == 20) ? 2 : 1); ++rep_) { if (PHASE_MASK & (1u << 20)) { LAUNDER(); phase_moe1(*pp, C, 1); }  SYNC(); }
  for (int rep_ = 0; rep_ < ((PROBE_DOUBLE == 21) ? 2 : 1); ++rep_) { if (PHASE_MASK & (1u << 21)) { LAUNDER(); phase_moe2(*pp, C, 1); }  SYNC(); }
  if (PHASE_MASK & (1u << 22)) { LAUNDER(); phase_lnffn(*pp, C, 1); }
}

extern "C" void kernel_launch(void* const* d_in, const int* in_sizes, int n_in, void* d_out, int out_size,
                              void* d_ws, size_t ws_size, hipStream_t stream) {
  static int grid_blocks = 0;
  if (!grid_blocks) {
    int dev = 0, cus = 0, per_cu = 0;
    (void)hipGetDevice(&dev);
    (void)hipDeviceGetAttribute(&cus, hipDeviceAttributeMultiprocessorCount, dev);
    (void)hipFuncSetAttribute((const void*)fwd_megakernel, hipFuncAttributeMaxDynamicSharedMemorySize, LDS_BYTES);
    (void)hipOccupancyMaxActiveBlocksPerMultiprocessor(&per_cu, (const void*)fwd_megakernel, NT, LDS_BYTES);
    if (per_cu < 1) per_cu = 1;
    grid_blocks = cus * 1;
    fprintf(stderr, "grid %d (cus %d per_cu %d) ws_size %zu need %zu n_in %d\n", grid_blocks, cus, per_cu, ws_size, (size_t)WS_NEED, n_in);
    if (ws_size < WS_NEED || n_in != 39) { fprintf(stderr, "kernel_launch: workspace too small or unexpected inputs\n"); grid_blocks = -1; }
  }
  if (grid_blocks < 0) return;
  (void)hipMemsetAsync(d_ws, 0, 64 * 1024, stream);
  Params p{};
  for (int i = 0; i < 39; ++i) p.in[i] = (const float*)d_in[i];
  p.out = (float*)d_out; p.ws = (unsigned char*)d_ws;
  void* args[] = {&p};
  hipError_t e = hipLaunchCooperativeKernel((const void*)fwd_megakernel, dim3(grid_blocks), dim3(NT), args, LDS_BYTES, stream);
  if (e != hipSuccess) fprintf(stderr, "cooperative launch failed: %s (grid %d)\n", hipGetErrorString(e), grid_blocks);
}
```

```cpp
#include <hip/hip_runtime.h>
#include <hip/hip_cooperative_groups.h>
#include <cstdio>
#include <cstdint>
namespace cg = cooperative_groups;

#define LAS __attribute__((address_space(3)))
typedef unsigned short bf16_t;
typedef short bf16x8 __attribute__((ext_vector_type(8)));
typedef float f32x4 __attribute__((ext_vector_type(4)));
typedef float f32x2 __attribute__((ext_vector_type(2)));
typedef unsigned u32x4 __attribute__((ext_vector_type(4)));
typedef unsigned u32x2 __attribute__((ext_vector_type(2)));

constexpr int D = 1024, NB = 4, SEQ = 8192, CTXL = 256, TB = SEQ + CTXL  , R = NB * TB  , RLAT = NB * SEQ;
constexpr int NT = 512, NWAVES = 8;
constexpr int LDS_BYTES = 163840;
constexpr int AB_IN = 4640, CD_IN = 9248;
constexpr int Z0W = 4608, Z1W = 7168, MIXW = 2048;
constexpr int NEXP = 32, DEXP = 512, MOE_BLK = 256, MAX_BLKS = 304, MAX_SLOTS = 296 * 256;
constexpr float ALPHA = 1.41421356237309515f;
constexpr float LN_EPS = 1e-5f, RMS_EPS = 1e-6f;
constexpr int Z0_RGX = 0, Z0_RGY = 1024, Z0_SSDZ = 2048, Z0_XBC = 3072, Z0_B = 4096, Z0_C = 4352;
constexpr int Z1_Q = 0, Z1_K = 1024, Z1_V = 2048, Z1_HQ = 3072, Z1_HF = 4096, Z1_HI = 6144;

constexpr size_t MiB = 1u << 20;
constexpr size_t OFF_CTL = 0;
constexpr size_t OFF_MOD = 64 * 1024;
constexpr size_t OFF_LB1 = 320 * 1024;
constexpr size_t OFF_ROUTE = 512 * 1024;
constexpr size_t OFF_SLOTW = 2 * MiB;
constexpr size_t OFF_DT = 3 * MiB;
constexpr size_t OFF_HCTX = 8 * MiB;
constexpr size_t OFF_TCTX = 12 * MiB;
constexpr size_t OFF_WOUT0 = 16 * MiB, OFF_WOUT1 = 20 * MiB, OFF_WG1 = 24 * MiB, OFF_WAB = 28 * MiB;
constexpr size_t OFF_A = 40 * MiB;
constexpr size_t OFF_Z0 = OFF_A, OFF_MIX0 = OFF_A + 297 * MiB, OFF_WE0 = OFF_A + 429 * MiB, OFF_U0 = OFF_A + 525 * MiB;
constexpr size_t OFF_AM0 = OFF_A, OFF_HM0 = OFF_A + 148 * MiB, OFF_YM0 = OFF_A + 222 * MiB;
constexpr size_t OFF_Z1 = OFF_A, OFF_U1 = OFF_A + 462 * MiB, OFF_WCD = OFF_A + 528 * MiB, OFF_MIX1 = OFF_A + 462 * MiB;
constexpr size_t OFF_WE1 = OFF_A, OFF_U1B = OFF_A + 96 * MiB, OFF_AM1 = OFF_A + 96 * MiB, OFF_HM1 = OFF_A + 244 * MiB, OFF_YM1 = OFF_A + 318 * MiB, OFF_V1 = OFF_A + 470 * MiB;
constexpr size_t WS_NEED = OFF_A + 594 * MiB;
static_assert((size_t)R * Z0W * 2 <= 297 * MiB && (size_t)R * MIXW * 2 <= 132 * MiB && (size_t)R * Z1W * 2 <= 462 * MiB && (size_t)R * D * 2 <= 66 * MiB, "ws map");
static_assert((size_t)MAX_SLOTS * D * 2 <= 148 * MiB && (size_t)MAX_SLOTS * DEXP * 2 <= 74 * MiB, "ws map moe");
static_assert(OFF_DT + (size_t)R * 32 * 4 <= OFF_HCTX && OFF_ROUTE + (size_t)R * 32 <= OFF_SLOTW && OFF_SLOTW + MAX_SLOTS * 4 <= OFF_DT, "ws map small");

struct Params { const float* in[39]; float* out; unsigned char* ws; };
enum { I_X = 0, I_C, I_CTX, I_CCTX, I_HLB, I_ADAW, I_ADAB, I_LNMG, I_LNMB, I_LNFG, I_LNFB, I_OUTW, I_RGW, I_RGB, I_REW, I_REB, I_EWG, I_EWU, I_EWD,
       I_ABW, I_RGCW, I_RGCB, I_RGAW, I_RGAB, I_RGXW, I_RGXB, I_RGLAM, I_SCW, I_SCB, I_SALOG, I_SDTB, I_SD, I_SNG, I_CDW, I_GCW, I_GALOG, I_GDTB, I_GNG, I_HNG };

__device__ __forceinline__ unsigned f2bf(float f) { unsigned u = __float_as_uint(f); return (u + 0x7fffu + ((u >> 16) & 1u)) >> 16; }
__device__ __forceinline__ float bf2f(unsigned b) { return __uint_as_float(b << 16); }
typedef __bf16 bf16x2v_t __attribute__((ext_vector_type(2)));
__device__ __forceinline__ unsigned pk2(float lo, float hi) { const f32x2 v = {lo, hi}; const bf16x2v_t r = __builtin_convertvector(v, bf16x2v_t); return __builtin_bit_cast(unsigned, r); }
__device__ __forceinline__ float bflo(unsigned w) { return __uint_as_float(w << 16); }
__device__ __forceinline__ float bfhi(unsigned w) { return __uint_as_float(w & 0xffff0000u); }
__device__ __forceinline__ float sigmoidf_(float x) { return 1.f / (1.f + __expf(-x)); }
__device__ __forceinline__ float siluf_(float x) { return x / (1.f + __expf(-x)); }
__device__ __forceinline__ float softplusf_(float x) { return x > 20.f ? x : log1pf(__expf(x)); }
__device__ __forceinline__ float geluf_(float x) { const float u = 0.7978845608028654f * (x + 0.044715f * x * x * x); return 0.5f * x * (1.f + tanhf(u)); }
template <int CTRL> __device__ __forceinline__ float dpp_mov(float v) {
  return __builtin_bit_cast(float, __builtin_amdgcn_update_dpp(0, __builtin_bit_cast(int, v), CTRL, 0xf, 0xf, true));
}
__device__ __forceinline__ float row_sum16(float v) {
  v += dpp_mov<0xB1>(v); v += dpp_mov<0x4E>(v); v += dpp_mov<0x141>(v); v += dpp_mov<0x140>(v);
  return v;
}
__device__ __forceinline__ float wave_sum(float v) { v = row_sum16(v); v += __shfl_xor(v, 16); v += __shfl_xor(v, 32); return v; }
__device__ __forceinline__ float half_sum32(float v) { v = row_sum16(v); v += __shfl_xor(v, 16); return v; }
__device__ __forceinline__ int rmap(int latonly, int q) { return latonly ? (q >> 13) * TB + CTXL + (q & 8191) : q; }
__device__ __forceinline__ int row_batch(int r) { return r / TB; }

namespace pg8 {
constexpr int BM = 256, BK = 64, HALF = 128, HTB = HALF * BK * 2, STAGE_BYTES = 8 * HTB, NXCD = 8, WGM = 8;
__host__ __device__ __forceinline__ int lds_byte(int r, int c) { const int st = (r >> 4) * 2 + (c >> 5), rr = r & 15, cc = c & 31, ob = rr * 64 + cc * 2; return st * 1024 + (ob ^ (((ob >> 9) & 1) << 5)); }
__host__ __device__ __forceinline__ void stage_rc(int b, int& Rr, int& C) { const int st = b / 1024, sb = b % 1024, swz = sb ^ (((sb >> 9) & 1) << 5); Rr = (st >> 1) * 16 + swz / 64; C = (st & 1) * 32 + (swz % 64) / 2; }
__host__ __device__ __forceinline__ int perm32(int rho) { const int n = rho >> 4, i = rho & 15; return 8 * (i >> 2) + 4 * n + (i & 3); }
struct Unit { int pm, pn; };
struct Gemm { const bf16_t* A; const bf16_t* Bt; int lda, K; };

struct GridOrder {
  int nM, nN, nwg, G, c, skipctx;
  __device__ void init(int nM_, int nN_, int G_, int c_, int skipctx_) { nM = nM_; nN = nN_; nwg = nM * nN; G = G_; c = c_; skipctx = skipctx_; }
  __device__ bool next(int i, Unit& u) const {
    const long L = (long)i * G + c; if (L >= nwg) return false;
    int wgid = (int)L; { const int q = nwg / NXCD, r = nwg % NXCD, xcd = wgid % NXCD, off = wgid / NXCD; wgid = (xcd < r ? xcd * (q + 1) : r * (q + 1) + (xcd - r) * q) + off; }
    const int nig = WGM * nN, gid = wgid / nig, fm = gid * WGM, gsz = (nM - fm) < WGM ? (nM - fm) : WGM;
    int pm = fm + ((wgid % nig) % gsz); u.pn = (wgid % nig) / gsz;
    if (skipctx) pm = (pm >> 5) * 33 + 1 + (pm & 31);
    u.pm = pm; return true;
  }
};
struct MoeOrder {
  const int* blk_e; int nunits, G, c;
  __device__ bool next(int i, Unit& u) const {
    const long L = (long)i * G + c; if (L >= nunits) return false;
    const int blk = (int)(L >> 2), j = (int)(L & 3);
    u.pm = blk; u.pn = blk_e[blk] * 4 + j; return true;
  }
};

__device__ __forceinline__ unsigned cvt_pk_bf16(float lo, float hi) { return pk2(lo, hi); }

template <class Epi, class Sched>
__device__ __forceinline__ void gemm_phase(LAS unsigned char* lds, const Gemm g, const Sched& S, const Epi& E) {
  int tid_ = threadIdx.x; asm volatile("" : "+v"(tid_)); tid_ &= 511; const int tid = tid_, wid = __builtin_amdgcn_readfirstlane(tid >> 6), lane = tid & 63, wr = wid >> 2, wc = wid & 3, fr = lane & 15, fq = lane >> 4;
  const int K = g.K, nt = K / BK, lda = g.lda;
  unsigned voffA[2], voffB[2];
#pragma unroll
  for (int i = 0; i < 2; ++i) { int Rr, C; stage_rc(tid * 16 + i * 8192, Rr, C); const int Rb = Epi::PERM ? ((Rr & ~31) + perm32(Rr & 31)) : Rr;
    voffA[i] = (unsigned)(Rr * lda + C) * 2u; voffB[i] = (unsigned)(Rb * K + C) * 2u; }
  const size_t kstep = (size_t)(BK * 2);
  const size_t hstepA = (size_t)HALF * lda * 2, hstepB = (size_t)HALF * K * 2;
  const size_t tstepA = 2 * hstepA, tstepB = 2 * hstepB;
  const unsigned ldsw = (unsigned)wid * 1024u;
  const int aoff = lds_byte(wr * 64 + fr, fq * 8), boff = lds_byte(wc * 32 + fr, fq * 8);
#define PG8_SA(b, h) (((b) * 2 + (h)) * HTB)
#define PG8_SB(b, h) ((4 + (b) * 2 + (h)) * HTB)
#define PG8_STAGE(bufoff, gbase, voff) do { _Pragma("unroll") for (int _i = 0; _i < 2; ++_i) \
    __builtin_amdgcn_global_load_lds((const unsigned*)((const char*)(gbase) + (voff)[_i]), (LAS unsigned*)(lds + (bufoff) + ldsw + _i * 8192), 16, 0, 0); } while (0)
#define PG8_LDA(dst, b, h) do { _Pragma("unroll") for (int m = 0; m < 4; ++m) _Pragma("unroll") for (int k = 0; k < 2; ++k) dst[m][k] = *(const LAS bf16x8*)(lds + PG8_SA(b, h) + aoff + m * 2048 + k * 1024); } while (0)
#define PG8_LDB(dst, b, h) do { _Pragma("unroll") for (int n = 0; n < 2; ++n) _Pragma("unroll") for (int k = 0; k < 2; ++k) dst[n][k] = *(const LAS bf16x8*)(lds + PG8_SB(b, h) + boff + n * 2048 + k * 1024); } while (0)
#define PG8_MMA(ai, bj, At, Bt) do { __builtin_amdgcn_s_setprio(1); _Pragma("unroll") for (int m = 0; m < 4; ++m) _Pragma("unroll") for (int n = 0; n < 2; ++n) _Pragma("unroll") for (int k = 0; k < 2; ++k) \
    acc[ai][bj][m][n] = __builtin_amdgcn_mfma_f32_16x16x32_bf16(Bt[n][k], At[m][k], acc[ai][bj][m][n], 0, 0, 0); __builtin_amdgcn_s_setprio(0); } while (0)
#define PG8_WAIT_V(n) asm volatile("s_waitcnt vmcnt(" #n ")" ::: "memory")
#define PG8_WAIT_L(n) asm volatile("s_waitcnt lgkmcnt(" #n ")" ::: "memory")
#define PG8_BAR __builtin_amdgcn_s_barrier()
#define PG8_SCHED __builtin_amdgcn_sched_barrier(0)
  Unit cur, nxt; int ui = 0;
  if (!S.next(0, cur)) return;
  f32x4 acc[2][2][4][2];
#pragma unroll
  for (int a = 0; a < 2; ++a)
#pragma unroll
    for (int b = 0; b < 2; ++b)
#pragma unroll
      for (int m = 0; m < 4; ++m)
#pragma unroll
        for (int n = 0; n < 2; ++n) acc[a][b][m][n] = (f32x4){0.f, 0.f, 0.f, 0.f};
  bf16x8 At[4][2], B0[2][2], B1[2][2];
  const char* cA = (const char*)g.A + (size_t)cur.pm * tstepA; const char* cB = (const char*)g.Bt + (size_t)cur.pn * tstepB;
  PG8_STAGE(PG8_SB(0, 0), cB, voffB); PG8_STAGE(PG8_SA(0, 0), cA, voffA); PG8_STAGE(PG8_SB(0, 1), cB + hstepB, voffB); PG8_STAGE(PG8_SA(0, 1), cA + hstepA, voffA);
  if (wr == 1) PG8_BAR;
  PG8_WAIT_V(4); PG8_BAR;
  PG8_STAGE(PG8_SB(1, 0), cB + kstep, voffB); PG8_STAGE(PG8_SA(1, 0), cA + kstep, voffA); PG8_STAGE(PG8_SB(1, 1), cB + hstepB + kstep, voffB);
  PG8_WAIT_V(6); PG8_BAR;
  for (;;) {
    const bool has_next = S.next(ui + 1, nxt);
    const char* nA = has_next ? (const char*)g.A + (size_t)nxt.pm * tstepA : cA; const char* nB = has_next ? (const char*)g.Bt + (size_t)nxt.pn * tstepB : cB;
    for (int t = 0; t < nt; t += 2) {
      const bool last = (t == nt - 2);
      const char* a1 = cA + (size_t)(t + 1) * kstep;
      const char* a2 = last ? nA : cA + (size_t)(t + 2) * kstep; const char* b2 = last ? nB : cB + (size_t)(t + 2) * kstep;
      const char* a3 = a2 + kstep; const char* b3 = b2 + kstep;
      PG8_LDB(B0, 0, 0); PG8_SCHED; PG8_LDA(At, 0, 0); PG8_STAGE(PG8_SA(1, 1), a1 + hstepA, voffA);
      PG8_WAIT_L(8); PG8_BAR; PG8_WAIT_L(0); PG8_MMA(0, 0, At, B0); PG8_BAR; PG8_SCHED;
      PG8_LDB(B1, 0, 1); PG8_STAGE(PG8_SB(0, 0), b2, voffB);
      PG8_BAR; PG8_WAIT_L(0); PG8_MMA(0, 1, At, B1); PG8_BAR;
      PG8_LDA(At, 0, 1); PG8_STAGE(PG8_SA(0, 0), a2, voffA);
      PG8_BAR; PG8_WAIT_L(0); PG8_MMA(1, 0, At, B0); PG8_BAR; PG8_SCHED;
      PG8_STAGE(PG8_SB(0, 1), b2 + hstepB, voffB);
      PG8_WAIT_V(6); PG8_BAR; PG8_MMA(1, 1, At, B1); PG8_BAR;
      PG8_LDB(B0, 1, 0); PG8_SCHED; PG8_LDA(At, 1, 0); PG8_STAGE(PG8_SA(0, 1), a2 + hstepA, voffA);
      PG8_WAIT_L(8); PG8_BAR; PG8_WAIT_L(0); PG8_MMA(0, 0, At, B0); PG8_BAR; PG8_SCHED;
      PG8_LDB(B1, 1, 1); PG8_STAGE(PG8_SB(1, 0), b3, voffB);
      PG8_BAR; PG8_WAIT_L(0); PG8_MMA(0, 1, At, B1); PG8_BAR;
      PG8_LDA(At, 1, 1); PG8_STAGE(PG8_SA(1, 0), a3, voffA);
      PG8_BAR; PG8_WAIT_L(0); PG8_MMA(1, 0, At, B0); PG8_BAR; PG8_SCHED;
      PG8_STAGE(PG8_SB(1, 1), b3 + hstepB, voffB);
      PG8_WAIT_V(6); PG8_BAR; PG8_MMA(1, 1, At, B1); PG8_BAR;
    }
    E(acc, cur, wr, wc, fr, fq);
    if (!has_next) break;
#pragma unroll
    for (int a = 0; a < 2; ++a)
#pragma unroll
      for (int b = 0; b < 2; ++b)
#pragma unroll
        for (int m = 0; m < 4; ++m)
#pragma unroll
          for (int n = 0; n < 2; ++n) acc[a][b][m][n] = (f32x4){0.f, 0.f, 0.f, 0.f};
    cur = nxt; cA = nA; cB = nB; ++ui;
  }
  PG8_WAIT_V(0);
  if (wr == 0) PG8_BAR;
  PG8_BAR;
#undef PG8_SA
#undef PG8_SB
#undef PG8_STAGE
#undef PG8_LDA
#undef PG8_LDB
#undef PG8_MMA
#undef PG8_WAIT_V
#undef PG8_WAIT_L
#undef PG8_BAR
#undef PG8_SCHED
}

struct EpiBf16 {
  static constexpr bool PERM = true;
  bf16_t* O; int ldc;
  __device__ __forceinline__ void operator()(const f32x4 (&acc)[2][2][4][2], const Unit& u, int wr, int wc, int fr, int fq) const {
    const int row0 = u.pm * BM + wr * 64 + fr, col0 = u.pn * BM + wc * 32 + 8 * fq;
#pragma unroll
    for (int ai = 0; ai < 2; ++ai)
#pragma unroll
      for (int m = 0; m < 4; ++m) { bf16_t* rowp = O + (size_t)(row0 + ai * HALF + m * 16) * ldc + col0;
#pragma unroll
        for (int bj = 0; bj < 2; ++bj) { const f32x4 v0 = acc[ai][bj][m][0], v1 = acc[ai][bj][m][1];
          u32x4 w; w.x = cvt_pk_bf16(v0[0], v0[1]); w.y = cvt_pk_bf16(v0[2], v0[3]); w.z = cvt_pk_bf16(v1[0], v1[1]); w.w = cvt_pk_bf16(v1[2], v1[3]);
          *(u32x4*)(rowp + bj * HALF) = w; } }
  }
};
struct EpiInProj {
  static constexpr bool PERM = true;
  bf16_t* O; int ldc; int nz; float* DT;
  __device__ __forceinline__ void operator()(const f32x4 (&acc)[2][2][4][2], const Unit& u, int wr, int wc, int fr, int fq) const {
    const int row0 = u.pm * BM + wr * 64 + fr;
    if (u.pn < nz) {
      const int col0 = u.pn * BM + wc * 32 + 8 * fq;
#pragma unroll
      for (int ai = 0; ai < 2; ++ai)
#pragma unroll
        for (int m = 0; m < 4; ++m) { bf16_t* rowp = O + (size_t)(row0 + ai * HALF + m * 16) * ldc + col0;
#pragma unroll
          for (int bj = 0; bj < 2; ++bj) { const f32x4 v0 = acc[ai][bj][m][0], v1 = acc[ai][bj][m][1];
            u32x4 w; w.x = cvt_pk_bf16(v0[0], v0[1]); w.y = cvt_pk_bf16(v0[2], v0[3]); w.z = cvt_pk_bf16(v1[0], v1[1]); w.w = cvt_pk_bf16(v1[2], v1[3]);
            *(u32x4*)(rowp + bj * HALF) = w; } }
    } else if (wc == 0) {
#pragma unroll
      for (int ai = 0; ai < 2; ++ai)
#pragma unroll
        for (int m = 0; m < 4; ++m) { float* rowp = DT + (size_t)(row0 + ai * HALF + m * 16) * 32 + 8 * fq;
          *(f32x4*)rowp = acc[ai][0][m][0]; *(f32x4*)(rowp + 4) = acc[ai][0][m][1]; }
    }
  }
};
struct EpiResid {
  static constexpr bool PERM = false;
  const float* hlat; const float* hctx; float* tlat; float* tctx; const float* gate;
  __device__ __forceinline__ void operator()(const f32x4 (&acc)[2][2][4][2], const Unit& u, int wr, int wc, int fr, int fq) const {
    const int b = u.pm / 33, tt = u.pm % 33; const bool isctx = (tt == 0);
    const float* hs = isctx ? hctx + (size_t)b * CTXL * D : hlat + ((size_t)b * SEQ + (size_t)(tt - 1) * 256) * D;
    float* td = isctx ? tctx + (size_t)b * CTXL * D : tlat + ((size_t)b * SEQ + (size_t)(tt - 1) * 256) * D;
    const float* gt = gate + (size_t)(isctx ? 4 : b) * 6144;
    const int lrow0 = wr * 64 + fr, col0 = u.pn * BM + wc * 32 + 4 * fq;
#pragma unroll
    for (int bj = 0; bj < 2; ++bj)
#pragma unroll
      for (int n = 0; n < 2; ++n) { const f32x4 gvv = *(const f32x4*)(gt + col0 + bj * HALF + n * 16);
        f32x4 hv[2][4];
#pragma unroll
        for (int ai = 0; ai < 2; ++ai)
#pragma unroll
          for (int m = 0; m < 4; ++m) hv[ai][m] = *(const f32x4*)(hs + (size_t)(lrow0 + ai * HALF + m * 16) * D + col0 + bj * HALF + n * 16);
        asm volatile("" ::: "memory");
#pragma unroll
        for (int ai = 0; ai < 2; ++ai)
#pragma unroll
          for (int m = 0; m < 4; ++m) *(f32x4*)(td + (size_t)(lrow0 + ai * HALF + m * 16) * D + col0 + bj * HALF + n * 16) = hv[ai][m] * ALPHA + gvv * acc[ai][bj][m][n];
        asm volatile("" ::: "memory"); }
  }
};
struct EpiGateMul {
  static constexpr bool PERM = true;
  bf16_t* O; int ldc;
  __device__ __forceinline__ void operator()(const f32x4 (&acc)[2][2][4][2], const Unit& u, int wr, int wc, int fr, int fq) const {
    const int row0 = u.pm * BM + wr * 64 + fr, col0 = u.pn * BM + wc * 32 + 8 * fq;
#pragma unroll
    for (int ai = 0; ai < 2; ++ai) {
      u32x4 ov[4][2];
#pragma unroll
      for (int m = 0; m < 4; ++m)
#pragma unroll
        for (int bj = 0; bj < 2; ++bj) ov[m][bj] = *(const u32x4*)(O + (size_t)(row0 + ai * HALF + m * 16) * ldc + col0 + bj * HALF);
      asm volatile("" ::: "memory");
#pragma unroll
      for (int m = 0; m < 4; ++m) { bf16_t* rowp = O + (size_t)(row0 + ai * HALF + m * 16) * ldc + col0;
#pragma unroll
        for (int bj = 0; bj < 2; ++bj) { const f32x4 v0 = acc[ai][bj][m][0], v1 = acc[ai][bj][m][1]; const u32x4 o = ov[m][bj];
          u32x4 w;
          w.x = cvt_pk_bf16(bflo(o.x) * siluf_(v0[0]), bfhi(o.x) * siluf_(v0[1])); w.y = cvt_pk_bf16(bflo(o.y) * siluf_(v0[2]), bfhi(o.y) * siluf_(v0[3]));
          w.z = cvt_pk_bf16(bflo(o.z) * siluf_(v1[0]), bfhi(o.z) * siluf_(v1[1])); w.w = cvt_pk_bf16(bflo(o.w) * siluf_(v1[2]), bfhi(o.w) * siluf_(v1[3]));
          *(u32x4*)(rowp + bj * HALF) = w; } }
      asm volatile("" ::: "memory");
    }
  }
};
struct EpiSwiGLU {
  static constexpr bool PERM = true;
  bf16_t* H;
  __device__ __forceinline__ void operator()(const f32x4 (&acc)[2][2][4][2], const Unit& u, int wr, int wc, int fr, int fq) const {
    const int row0 = u.pm * BM + wr * 64 + fr, col0 = (u.pn & 3) * 128 + wc * 32 + 8 * fq;
#pragma unroll
    for (int ai = 0; ai < 2; ++ai)
#pragma unroll
      for (int m = 0; m < 4; ++m) { bf16_t* rowp = H + (size_t)(row0 + ai * HALF + m * 16) * DEXP + col0;
        const f32x4 g0 = acc[ai][0][m][0], g1 = acc[ai][0][m][1], u0 = acc[ai][1][m][0], u1 = acc[ai][1][m][1];
        u32x4 w; w.x = cvt_pk_bf16(siluf_(g0[0]) * u0[0], siluf_(g0[1]) * u0[1]); w.y = cvt_pk_bf16(siluf_(g0[2]) * u0[2], siluf_(g0[3]) * u0[3]);
        w.z = cvt_pk_bf16(siluf_(g1[0]) * u1[0], siluf_(g1[1]) * u1[1]); w.w = cvt_pk_bf16(siluf_(g1[2]) * u1[2], siluf_(g1[3]) * u1[3]);
        *(u32x4*)rowp = w; }
  }
};
struct EpiMoeDown {
  static constexpr bool PERM = true;
  bf16_t* Y; const float* slotw;
  __device__ __forceinline__ void operator()(const f32x4 (&acc)[2][2][4][2], const Unit& u, int wr, int wc, int fr, int fq) const {
    const int row0 = u.pm * BM + wr * 64 + fr, col0 = (u.pn & 3) * BM + wc * 32 + 8 * fq;
    float sw[2][4];
#pragma unroll
    for (int ai = 0; ai < 2; ++ai)
#pragma unroll
      for (int m = 0; m < 4; ++m) sw[ai][m] = slotw[row0 + ai * HALF + m * 16];
    asm volatile("" ::: "memory");
#pragma unroll
    for (int ai = 0; ai < 2; ++ai)
#pragma unroll
      for (int m = 0; m < 4; ++m) { const int row = row0 + ai * HALF + m * 16; const float s1 = sw[ai][m]; bf16_t* rowp = Y + (size_t)row * D + col0;
#pragma unroll
        for (int bj = 0; bj < 2; ++bj) { const f32x4 v0 = acc[ai][bj][m][0] * s1, v1 = acc[ai][bj][m][1] * s1;
          u32x4 w; w.x = cvt_pk_bf16(v0[0], v0[1]); w.y = cvt_pk_bf16(v0[2], v0[3]); w.z = cvt_pk_bf16(v1[0], v1[1]); w.w = cvt_pk_bf16(v1[2], v1[3]);
          *(u32x4*)(rowp + bj * HALF) = w; } }
  }
};
}

struct Ctx {
  LAS unsigned char* lds; int tid, lane, wave, gw, ngw, bid, nblk;
};
#define GAS __attribute__((address_space(1)))
#define WS(off, T) ((T*)(GAS T*)(P.ws + (off)))
#define GIN(i) ((const float*)(const GAS float*)P.in[i])
#define GOUT ((float*)(GAS float*)P.out)

__device__ __forceinline__ void transpose_item(const float* W, int ldw, int col0, int k0, bf16_t* dst_row0, int ldd, LAS float* scr, int lane) {
#pragma unroll 8
  for (int i = 0; i < 32; ++i) { const int kk = 2 * i + (lane >> 5); scr[kk * 33 + (lane & 31)] = W[(size_t)(k0 + kk) * ldw + col0 + (lane & 31)]; }
  asm volatile("s_waitcnt lgkmcnt(0)" ::: "memory");
  const int c = lane & 7;
#pragma unroll
  for (int j = 0; j < 4; ++j) { const int n = (lane >> 3) + 8 * j; const LAS float* s = scr + (8 * c) * 33 + n;
    u32x4 o; o.x = pk2(s[0 * 33], s[1 * 33]); o.y = pk2(s[2 * 33], s[3 * 33]); o.z = pk2(s[4 * 33], s[5 * 33]); o.w = pk2(s[6 * 33], s[7 * 33]);
    *(u32x4*)(dst_row0 + (size_t)n * ldd + k0 + 8 * c) = o; }
  asm volatile("s_waitcnt lgkmcnt(0)" ::: "memory");
}
__device__ __forceinline__ void transpose_mat_item(const float* W, int ldw, int col0, int K, int ncols, bf16_t* dst, int ldd, int gu, int it, LAS float* scr, int lane) {
  const int nblk = ncols / 32, kb = it / nblk, nb = it % nblk, n0 = 32 * nb;
  const int drow = gu ? (256 * (n0 >> 7) + (n0 & 127) + (gu == 2 ? 128 : 0)) : n0;
  transpose_item(W, ldw, col0 + n0, 64 * kb, dst + (size_t)drow * ldd, ldd, scr, lane);
}
__device__ __forceinline__ void convert_experts(const Params& P, int layer, bf16_t* wgu, bf16_t* wd, const Ctx& C, LAS float* scr) {
  for (int it = C.gw; it < NEXP * 768; it += C.ngw) {
    const int e = it / 768, r = it % 768;
    const size_t eoff = ((size_t)layer * NEXP + e) * (size_t)D * DEXP;
    if (r < 256) transpose_mat_item(GIN(I_EWG) + eoff, DEXP, 0, D, DEXP, wgu + (size_t)e * 1024 * D, D, 1, r, scr, C.lane);
    else if (r < 512) transpose_mat_item(GIN(I_EWU) + eoff, DEXP, 0, D, DEXP, wgu + (size_t)e * 1024 * D, D, 2, r - 256, scr, C.lane);
    else transpose_mat_item(GIN(I_EWD) + eoff, D, 0, DEXP, D, wd + (size_t)e * D * DEXP, DEXP, 0, r - 512, scr, C.lane);
  }
}

__device__ __forceinline__ void row_load(const float* row, int lane, f32x4 (&v)[4]) {
#pragma unroll
  for (int j = 0; j < 4; ++j) v[j] = *(const f32x4*)(row + 4 * lane + 256 * j);
}
__device__ __forceinline__ void row_store(float* row, int lane, const f32x4 (&v)[4]) {
#pragma unroll
  for (int j = 0; j < 4; ++j) *(f32x4*)(row + 4 * lane + 256 * j) = v[j];
}
__device__ __forceinline__ void row_store_bf16(bf16_t* row, int lane, const f32x4 (&v)[4]) {
#pragma unroll
  for (int j = 0; j < 4; ++j) { u32x2 w; w.x = pk2(v[j][0], v[j][1]); w.y = pk2(v[j][2], v[j][3]); *(u32x2*)(row + 4 * lane + 256 * j) = w; }
}
__device__ __forceinline__ void row_layernorm(f32x4 (&v)[4], const float* g, const float* b, int lane) {
  float s = 0.f;
#pragma unroll
  for (int j = 0; j < 4; ++j) s += (v[j][0] + v[j][1]) + (v[j][2] + v[j][3]);
  const float mean = wave_sum(s) * (1.f / D); float s2 = 0.f;
#pragma unroll
  for (int j = 0; j < 4; ++j) { v[j] = v[j] - mean; s2 += (v[j][0] * v[j][0] + v[j][1] * v[j][1]) + (v[j][2] * v[j][2] + v[j][3] * v[j][3]); }
  const float rstd = rsqrtf(wave_sum(s2) * (1.f / D) + LN_EPS);
#pragma unroll
  for (int j = 0; j < 4; ++j) { const f32x4 gg = *(const f32x4*)(g + 4 * lane + 256 * j), bb = *(const f32x4*)(b + 4 * lane + 256 * j); v[j] = v[j] * rstd * gg + bb; }
}
__device__ __forceinline__ void row_modulate(const f32x4 (&h)[4], const float* shift, const float* scale, int lane, f32x4 (&u)[4]) {
#pragma unroll
  for (int j = 0; j < 4; ++j) { const f32x4 sh = *(const f32x4*)(shift + 4 * lane + 256 * j), sc = *(const f32x4*)(scale + 4 * lane + 256 * j); u[j] = h[j] * (sc + 1.f) + sh; }
}
__device__ __forceinline__ void row_dot32(const f32x4 (&u)[4], const LAS float* Wt, int lane, float* out32) {
  float myv = 0.f;
#pragma unroll 4
  for (int c = 0; c < 32; ++c) {
    float s = 0.f;
#pragma unroll
    for (int j = 0; j < 4; ++j) { const f32x4 w = *(const LAS f32x4*)(Wt + c * 1024 + 4 * lane + 256 * j); s += (u[j][0] * w[0] + u[j][1] * w[1]) + (u[j][2] * w[2] + u[j][3] * w[3]); }
    s = wave_sum(s);
    if (lane == c) myv = s;
  }
  if (lane < 32) out32[lane] = myv;
}
__device__ __forceinline__ void stage_cols32(const float* W, int ldw, int col0, LAS float* Wt, int tid) {
  for (int i = tid; i < 1024 * 32; i += NT) { const int k = i >> 5, c = i & 31; Wt[c * 1024 + k] = W[(size_t)k * ldw + col0 + c]; }
}
__device__ __forceinline__ const float* lat_or_ctx(const float* lat, const float* ctxp, int r) {
  const int b = r / TB, pos = r % TB;
  return pos < CTXL ? ctxp + ((size_t)b * CTXL + pos) * D : lat + ((size_t)b * SEQ + (pos - CTXL)) * D;
}
__device__ __forceinline__ float* lat_or_ctx_w(float* lat, float* ctxp, int r) {
  const int b = r / TB, pos = r % TB;
  return pos < CTXL ? ctxp + ((size_t)b * CTXL + pos) * D : lat + ((size_t)b * SEQ + (pos - CTXL)) * D;
}
__device__ __forceinline__ int row_b5(int r) { const int b = r / TB, pos = r % TB; return pos < CTXL ? 4 : b; }

__device__ __forceinline__ void phase0(const Params& P, const Ctx& C) {
  LAS float* sv = (LAS float*)C.lds;
  LAS float* part = (LAS float*)(C.lds + 20480);
  LAS float* scr = (LAS float*)(C.lds + 32768) + C.wave * (64 * 33);
  for (int i = C.tid; i < 5 * 1024; i += NT) { const float x = i < 4096 ? GIN(I_C)[i] : GIN(I_CCTX)[i - 4096]; sv[i] = siluf_(x); }
  __syncthreads();
  float* MOD = WS(OFF_MOD, float);
  for (int task = C.bid; task < 2 * 96; task += C.nblk) {
    const int l = task / 96, n0 = (task % 96) * 64;
    const float* W = GIN(I_ADAW) + (size_t)l * D * 6144 + n0 + C.lane;
    float acc[5] = {0.f, 0.f, 0.f, 0.f, 0.f};
    const int kbeg = C.wave * 128;
#pragma unroll 8
    for (int k = kbeg; k < kbeg + 128; ++k) { const float w = W[(size_t)k * 6144];
#pragma unroll
      for (int r = 0; r < 5; ++r) acc[r] += sv[r * 1024 + k] * w; }
#pragma unroll
    for (int r = 0; r < 5; ++r) part[(C.wave * 5 + r) * 64 + C.lane] = acc[r];
    __syncthreads();
    if (C.tid < 320) { const int r = C.tid / 64, c = C.tid % 64; float s = GIN(I_ADAB)[l * 6144 + n0 + c];
#pragma unroll
      for (int w = 0; w < 8; ++w) s += part[(w * 5 + r) * 64 + c];
      MOD[((size_t)l * 5 + r) * 6144 + n0 + c] = s; }
    __syncthreads();
  }
  if (C.bid == C.nblk - 1) { float* LB = WS(OFF_LB1, float); for (int i = C.tid; i < 1024; i += NT) { const float a = GIN(I_HLB)[i], b = GIN(I_HLB)[1024 + i]; LB[i] = 1.f / (1.f + __expf(a - b)); } }
  constexpr int N_AB = 16 * 144, N_OUT = 32 * 32, N_G1 = 16 * 32;
  constexpr int TOT = N_AB + 2 * N_OUT + 2 * N_G1;
  for (int it = C.gw; it < TOT; it += C.ngw) {
    int r = it;
    if (r < N_AB) { transpose_mat_item(GIN(I_ABW), AB_IN, 0, D, Z0W, WS(OFF_WAB, bf16_t), D, 0, r, scr, C.lane); continue; } r -= N_AB;
    if (r < N_OUT) { transpose_mat_item(GIN(I_OUTW), D, 0, 2048, D, WS(OFF_WOUT0, bf16_t), 2048, 0, r, scr, C.lane); continue; } r -= N_OUT;
    if (r < N_OUT) { transpose_mat_item(GIN(I_OUTW) + (size_t)2048 * D, D, 0, 2048, D, WS(OFF_WOUT1, bf16_t), 2048, 0, r, scr, C.lane); continue; } r -= N_OUT;
    if (r < N_G1) { transpose_mat_item(GIN(I_CDW), CD_IN, 3072, D, 1024, WS(OFF_WG1, bf16_t), D, 0, r, scr, C.lane); continue; } r -= N_G1;
    transpose_mat_item(GIN(I_CDW), CD_IN, 8224, D, 1024, WS(OFF_WG1, bf16_t) + (size_t)1024 * D, D, 0, r, scr, C.lane);
  }
  for (int it = C.gw; it < 16; it += C.ngw) transpose_mat_item(GIN(I_ABW), AB_IN, 4608, D, 32, WS(OFF_WAB, bf16_t) + (size_t)4608 * D, D, 0, it, scr, C.lane);
  { u32x4* z = (u32x4*)(WS(OFF_WAB, bf16_t) + (size_t)4640 * D); const u32x4 zz = {0u, 0u, 0u, 0u};
    for (int i = C.bid * NT + C.tid; i < 224 * D * 2 / 16; i += C.nblk * NT) z[i] = zz; }
  convert_experts(P, 0, WS(OFF_WE0, bf16_t), WS(OFF_WE0 + 64 * MiB, bf16_t), C, scr);
}

__device__ __forceinline__ void phase_u0(const Params& P, const Ctx& C) {
  const float* MOD = WS(OFF_MOD, float); bf16_t* U = WS(OFF_U0, bf16_t);
  f32x4 h[4], hn[4];
  if (C.gw < R) row_load(lat_or_ctx(GIN(I_X), GIN(I_CTX), C.gw), C.lane, h);
  for (int r = C.gw; r < R; r += C.ngw) {
    if (r + C.ngw < R) row_load(lat_or_ctx(GIN(I_X), GIN(I_CTX), r + C.ngw), C.lane, hn);
    f32x4 u[4];
    const float* m = MOD + (size_t)row_b5(r) * 6144;
    row_modulate(h, m, m + D, C.lane, u);
    row_store_bf16(U + (size_t)r * D, C.lane, u);
#pragma unroll
    for (int j = 0; j < 4; ++j) h[j] = hn[j];
  }
}

__device__ __forceinline__ void phase_inproj(const Params& P, const Ctx& C, const bf16_t* U, const bf16_t* W, bf16_t* Z, int zw) {
  pg8::Gemm g{U, W, D, D}; pg8::GridOrder S; S.init(R / 256, zw / 256 + 1, C.nblk, C.bid, 0);
  pg8::EpiInProj E{Z, zw, zw / 256, WS(OFF_DT, float)};
  pg8::gemm_phase(C.lds, g, S, E);
}

__device__ __forceinline__ void conv_task(bf16_t* Z, int zw, int row0, int L, int col, const float* cw, int cwld, int cch, const float* cb, int mode, float qscale, int lane, int ident = 0) {
  float w[4][2];
#pragma unroll
  for (int j = 0; j < 4; ++j) { w[j][0] = cw[j * cwld + cch + 2 * lane]; w[j][1] = cw[j * cwld + cch + 2 * lane + 1]; }
  const float b0 = cb ? cb[cch + 2 * lane] : 0.f, b1 = cb ? cb[cch + 2 * lane + 1] : 0.f;
  unsigned* base = (unsigned*)(Z + (size_t)row0 * zw + col) + lane;
  const size_t rs = (size_t)zw / 2;
  float pm2[2] = {0.f, 0.f}, pm1[2] = {0.f, 0.f};
  for (int t0 = 0; t0 < L; t0 += 16) {
    unsigned v[17];
#pragma unroll
    for (int i = 0; i < 16; ++i) v[i] = base[(size_t)(t0 + i) * rs];
    v[16] = (t0 + 16 < L) ? base[(size_t)(t0 + 16) * rs] : 0u;
    unsigned o[16];
#pragma unroll
    for (int i = 0; i < 16; ++i) {
      const float x0 = bflo(v[i]), x1 = bfhi(v[i]), n0 = bflo(v[i + 1]), n1 = bfhi(v[i + 1]);
      float y0 = w[0][0] * pm2[0] + w[1][0] * pm1[0] + w[2][0] * x0 + w[3][0] * n0 + b0;
      float y1 = w[0][1] * pm2[1] + w[1][1] * pm1[1] + w[2][1] * x1 + w[3][1] * n1 + b1;
      pm2[0] = pm1[0]; pm2[1] = pm1[1]; pm1[0] = x0; pm1[1] = x1;
      if (mode >= 1) { y0 = siluf_(y0); y1 = siluf_(y1); }
      if (mode == 2) { const float ss = wave_sum(y0 * y0 + y1 * y1); const float sc = rsqrtf(ss + RMS_EPS) * qscale; y0 *= sc; y1 *= sc; }
      o[i] = ident ? v[i] : pk2(y0, y1);
    }
#pragma unroll
    for (int i = 0; i < 16; ++i) base[(size_t)(t0 + i) * rs] = o[i];
  }
}
__device__ __forceinline__ void seg_rows(int seg, int& row0, int& L) {
  const int b = seg / 129, s = seg % 129;
  if (s == 0) { row0 = b * TB; L = CTXL; } else { row0 = b * TB + CTXL + (s - 1) * 64; L = 64; }
}
__device__ __forceinline__ void phase_feat0(const Params& P, const Ctx& C, int ident) {
  bf16_t* Z = WS(OFF_Z0, bf16_t);
  for (int task = C.gw; task < NB * 129 * 20; task += C.ngw) {
    const int seg = task / 20, cg = task % 20; int row0, L; seg_rows(seg, row0, L);
    if (cg < 8) conv_task(Z, Z0W, row0, L, Z0_RGX + cg * 128, GIN(I_RGCW), 1024, cg * 128, GIN(I_RGCB), 0, 1.f, C.lane, ident);
    else conv_task(Z, Z0W, row0, L, Z0_XBC + (cg - 8) * 128, GIN(I_SCW), 1536, (cg - 8) * 128, GIN(I_SCB), 1, 1.f, C.lane, ident);
  }
}
__device__ __forceinline__ void phase_feat1(const Params& P, const Ctx& C, int ident) {
  bf16_t* Z = WS(OFF_Z1, bf16_t);
  for (int task = C.gw; task < NB * 129 * 24; task += C.ngw) {
    const int seg = task / 24, cg = task % 24; int row0, L; seg_rows(seg, row0, L);
    if (cg < 16) conv_task(Z, Z1W, row0, L, cg * 128, GIN(I_GCW), 3072, cg * 128, nullptr, 2, cg < 8 ? 0.08838834764831845f : 1.f, C.lane, ident);
    else conv_task(Z, Z1W, row0, L, cg * 128, GIN(I_GCW), 3072, cg * 128, nullptr, 1, 1.f, C.lane, ident);
  }
}

__device__ __forceinline__ int seq_pos(int dir, int j) { return dir == 0 ? j : (j < CTXL ? CTXL - 1 - j : TB - 1 - (j - CTXL)); }
__device__ __forceinline__ int seq_chunk(int dir, int j) { return dir == 0 ? j : (j < 4 ? 3 - j : 135 - j); }

__device__ __forceinline__ void rg_task(const Params& P, const Ctx& C, int task) {
  const int b = task >> 6, h = (task >> 3) & 7, q = task & 7;
  LAS float* Wl = (LAS float*)C.lds;
  LAS float* xc = Wl + 2 * 2 * 128 * 16;
  LAS float* SA = xc + 64 * 129;
  LAS float* SU = SA + 16 * 64;
  const bf16_t* Z = WS(OFF_Z0, bf16_t); bf16_t* MIX = WS(OFF_MIX0, bf16_t);
  __syncthreads();
  for (int i = C.tid; i < 2 * 2 * 128 * 16; i += NT) { const int j = i & 15, ii = (i >> 4) & 127, gate = (i >> 11) & 1, d = i >> 12;
    const float* W = (gate ? GIN(I_RGXW) : GIN(I_RGAW)) + ((size_t)(d * 8 + h) * 128 + ii) * 128 + q * 16 + j; Wl[i] = *W; }
  const int j = C.tid & 15, tg = C.tid >> 4;
  const int ch = h * 128 + q * 16 + j;
  const int sch = C.wave * 2;
  for (int d = 0; d < 2; ++d) {
    const float ba = GIN(I_RGAB)[d * 1024 + ch], bx = GIN(I_RGXB)[d * 1024 + ch], spl = softplusf_(-GIN(I_RGLAM)[d * 1024 + ch]);
    float hin0 = 0.f, hin1 = 0.f;
    for (int cs = 0; cs < 132; ++cs) {
      const int chunk = seq_chunk(d, cs), row0 = b * TB + chunk * 64;
      __syncthreads();
      { const int t = C.tid >> 3, sg = C.tid & 7; const u32x4* src = (const u32x4*)(Z + (size_t)(row0 + t) * Z0W + Z0_RGX + h * 128 + sg * 16);
        const u32x4 a = src[0], bb = src[1]; LAS float* dst = xc + t * 129 + sg * 16;
        dst[0] = bflo(a.x); dst[1] = bfhi(a.x); dst[2] = bflo(a.y); dst[3] = bfhi(a.y); dst[4] = bflo(a.z); dst[5] = bfhi(a.z); dst[6] = bflo(a.w); dst[7] = bfhi(a.w);
        dst[8] = bflo(bb.x); dst[9] = bfhi(bb.x); dst[10] = bflo(bb.y); dst[11] = bfhi(bb.y); dst[12] = bflo(bb.z); dst[13] = bfhi(bb.z); dst[14] = bflo(bb.w); dst[15] = bfhi(bb.w); }
      __syncthreads();
      { const LAS float* Wa = Wl + (d * 2 + 0) * 2048 + j; const LAS float* Wx = Wl + (d * 2 + 1) * 2048 + j;
        const LAS float* x0 = xc + (2 * tg) * 129; const LAS float* x1 = x0 + 129;
        float aa0 = 0.f, aa1 = 0.f, ax0 = 0.f, ax1 = 0.f;
#pragma unroll 8
        for (int i = 0; i < 128; ++i) { const float wa = Wa[i * 16], wx = Wx[i * 16], v0 = x0[i], v1 = x1[i]; aa0 += v0 * wa; aa1 += v1 * wa; ax0 += v0 * wx; ax1 += v1 * wx; }
#pragma unroll
        for (int tt = 0; tt < 2; ++tt) { const int t = 2 * tg + tt; const float pa = tt ? aa1 : aa0, px = tt ? ax1 : ax0;
          const float r = sigmoidf_(pa + ba), ig = sigmoidf_(px + bx); const float la = -8.f * r * spl; const float xv = xc[t * 129 + q * 16 + j];
          SA[j * 64 + t] = __expf(la); SU[j * 64 + t] = sqrtf(-expm1f(2.f * la)) * (ig * xv); } }
      __syncthreads();
#pragma unroll
      for (int cc = 0; cc < 2; ++cc) {
        const int lc = sch + cc; const int t = d == 0 ? C.lane : 63 - C.lane;
        float A = SA[lc * 64 + t], Bv = SU[lc * 64 + t];
#pragma unroll
        for (int off = 1; off < 64; off <<= 1) { const float Ap = __shfl_up(A, off), Bp = __shfl_up(Bv, off); if (C.lane >= off) { Bv = A * Bp + Bv; A = A * Ap; } }
        const float hin = cc ? hin1 : hin0; const float hv = Bv + A * hin;
        const float hlast = __shfl(hv, 63); if (cc) hin1 = hlast; else hin0 = hlast;
        const int gch = h * 128 + q * 16 + lc; bf16_t* o = MIX + (size_t)(row0 + t) * MIXW + gch;
        if (d == 0) *o = (bf16_t)f2bf(hv);
        else { const float hf = bf2f(*o); const float gy = bf2f(Z[(size_t)(row0 + t) * Z0W + Z0_RGY + gch]); *o = (bf16_t)f2bf((hf + hv) * geluf_(gy)); }
      }
    }
    __threadfence_block();
  }
}
__device__ __forceinline__ void ssd_task(const Params& P, const Ctx& C, int task) {
  const int b = task >> 9, hd = (task >> 5) & 15, ps = task & 31, g = hd >> 3;
  const int c = C.lane >> 5, ng = C.lane & 31;
  const bf16_t* Z = WS(OFF_Z0, bf16_t); bf16_t* MIX = WS(OFF_MIX0, bf16_t); const float* DT = WS(OFF_DT, float);
  const int colx = Z0_XBC + hd * 64 + 2 * ps + c, colB = Z0_B + g * 128 + 4 * ng, colC = Z0_C + g * 128 + 4 * ng, outc = 1024 + hd * 64 + 2 * ps + c;
  for (int d = 0; d < 2; ++d) {
    const float Aneg = -__expf(GIN(I_SALOG)[d * 16 + hd]), dtb = GIN(I_SDTB)[d * 16 + hd];
    float S0 = 0.f, S1 = 0.f, S2 = 0.f, S3 = 0.f;
    for (int j0 = 0; j0 < TB; j0 += 8) {
      u32x2 Bv[8], Cv[8]; unsigned short xv[8], yp[8]; float dtr[8];
#pragma unroll
      for (int u = 0; u < 8; ++u) { const size_t row = (size_t)b * TB + seq_pos(d, j0 + u);
        Bv[u] = *(const u32x2*)(Z + row * Z0W + colB); Cv[u] = *(const u32x2*)(Z + row * Z0W + colC); xv[u] = Z[row * Z0W + colx]; dtr[u] = DT[row * 32 + d * 16 + hd];
        yp[u] = d ? MIX[row * MIXW + outc] : (unsigned short)0; }
#pragma unroll
      for (int u = 0; u < 8; ++u) { const size_t row = (size_t)b * TB + seq_pos(d, j0 + u);
        const float dt = softplusf_(dtr[u] + dtb), a = __expf(Aneg * dt), xdt = bf2f(xv[u]) * dt;
        S0 = a * S0 + bflo(Bv[u].x) * xdt; S1 = a * S1 + bfhi(Bv[u].x) * xdt; S2 = a * S2 + bflo(Bv[u].y) * xdt; S3 = a * S3 + bfhi(Bv[u].y) * xdt;
        float y = (bflo(Cv[u].x) * S0 + bfhi(Cv[u].x) * S1) + (bflo(Cv[u].y) * S2 + bfhi(Cv[u].y) * S3);
        y = half_sum32(y);
        if (ng == 0) MIX[row * MIXW + outc] = (bf16_t)f2bf(y + bf2f(yp[u])); }
    }
    __threadfence_block();
  }
}

#define LBAR() do { asm volatile("s_waitcnt lgkmcnt(0)" ::: "memory"); __builtin_amdgcn_s_barrier(); asm volatile("" ::: "memory"); } while (0)
#define VMWAIT() asm volatile("s_waitcnt vmcnt(0)" ::: "memory")
typedef short s16x4 __attribute__((ext_vector_type(4)));
__device__ __forceinline__ bf16x8 frag_row(const LAS bf16_t* base, int ld, int r0, int k0, int lane) {
  return *(const LAS bf16x8*)(base + (r0 + (lane & 15)) * ld + k0 + 8 * (lane >> 4));
}
__device__ __forceinline__ bf16x8 frag_tr(const LAS bf16_t* base, int ld, int k0, int n0, int lane) {
  const int g = lane >> 4, q = (lane & 15) >> 2, p = lane & 3;
  const LAS bf16_t* a0 = base + (k0 + 8 * g + q) * ld + n0 + 4 * p;
  const s16x4 v0 = __builtin_amdgcn_ds_read_tr16_b64_v4i16((LAS s16x4*)a0);
  const s16x4 v1 = __builtin_amdgcn_ds_read_tr16_b64_v4i16((LAS s16x4*)(a0 + 4 * ld));
  bf16x8 r; r[0] = v0[0]; r[1] = v0[1]; r[2] = v0[2]; r[3] = v0[3]; r[4] = v1[0]; r[5] = v1[1]; r[6] = v1[2]; r[7] = v1[3];
  return r;
}
__device__ __forceinline__ f32x4 mma16(bf16x8 fa, bf16x8 fb, f32x4 acc) { return __builtin_amdgcn_mfma_f32_16x16x32_bf16(fa, fb, acc, 0, 0, 0); }
__device__ __forceinline__ float wave_incl_scan(float v, int lane) {
#pragma unroll
  for (int off = 1; off < 64; off <<= 1) { const float p = __shfl_up(v, off); if (lane >= off) v += p; }
  return v;
}
__device__ __forceinline__ void tri_tile(int tt, int& I, int& J) { I = tt >= 6 ? 3 : (tt >= 3 ? 2 : (tt >= 1 ? 1 : 0)); J = tt - (I * (I + 1)) / 2; }
__device__ __forceinline__ unsigned long long ld_agent_u64(const void* p) { return __hip_atomic_load((const unsigned long long*)p, __ATOMIC_RELAXED, __HIP_MEMORY_SCOPE_AGENT); }
__device__ __forceinline__ bool fwd_first(int c) { return c < 4 ? (c <= 1) : (c <= 67); }

__device__ __forceinline__ void ssd_chain_wg(const Params& P, const Ctx& C, int task) {
  const int b = task >> 5, hd = (task >> 1) & 15, ps = task & 1, g = hd >> 3;
  const int d = C.wave >> 2, w = C.wave & 3, td = C.tid & 255, lane = C.lane, fr = lane & 15, fq = lane >> 4;
  constexpr int LDN = 136, LDP = 40, LDT = 72;
  constexpr int DIRSZ = 78 * 1024;
  LAS unsigned char* L = C.lds + d * DIRSZ;
  LAS bf16_t* Cs = (LAS bf16_t*)L;
  LAS bf16_t* Bs = Cs + 64 * LDN;
  LAS bf16_t* Xd = Bs + 64 * LDN;
  LAS bf16_t* Xw = Xd + 64 * LDP;
  LAS bf16_t* Pt = Xw + 64 * LDP;
  LAS bf16_t* St = Pt + 64 * LDT;
  LAS float* dtL = (LAS float*)(St + 2 * 32 * LDN);
  const bf16_t* Z = WS(OFF_Z0, bf16_t); bf16_t* MIX = WS(OFF_MIX0, bf16_t); const float* DT = WS(OFF_DT, float);
  const float Aneg = -__expf(GIN(I_SALOG)[d * 16 + hd]), dtb = GIN(I_SDTB)[d * 16 + hd];
  const int colC = Z0_C + g * 128, colB = Z0_B + g * 128, colX = Z0_XBC + hd * 64 + ps * 32, outc = 1024 + hd * 64 + ps * 32;
  __syncthreads();
  for (int i = td; i < 64 * LDT / 2; i += 256) ((LAS unsigned*)Pt)[i] = 0u;
  for (int i = td; i < 2 * 32 * LDN / 2; i += 256) ((LAS unsigned*)St)[i] = 0u;
  f32x4 Sacc[2][2];
#pragma unroll
  for (int a = 0; a < 2; ++a)
#pragma unroll
    for (int c = 0; c < 2; ++c) Sacc[a][c] = (f32x4){0.f, 0.f, 0.f, 0.f};
  const int st_t = td >> 2, st_q = td & 3;
  u32x4 rc[4], rb[4], rx; float rdt = 0.f;
  auto issue_loads = [&](int step) {
    const int chunk = seq_chunk(d, step); const size_t row = (size_t)b * TB + chunk * 64 + st_t;
    const u32x4* pc = (const u32x4*)(Z + row * Z0W + colC + st_q * 32); const u32x4* pb = (const u32x4*)(Z + row * Z0W + colB + st_q * 32);
#pragma unroll
    for (int i = 0; i < 4; ++i) { rc[i] = pc[i]; rb[i] = pb[i]; }
    rx = *(const u32x4*)(Z + row * Z0W + colX + st_q * 8);
    rdt = DT[row * 32 + d * 16 + hd];
  };
  issue_loads(0);
  for (int step = 0; step < 132; ++step) {
    const int chunk = seq_chunk(d, step); const int row0 = b * TB + chunk * 64;
    VMWAIT();
    { const int i = d ? 63 - st_t : st_t; const float dt = softplusf_(rdt + dtb);
      LAS u32x4* dc = (LAS u32x4*)(Cs + i * LDN + st_q * 32); LAS u32x4* db = (LAS u32x4*)(Bs + i * LDN + st_q * 32);
#pragma unroll
      for (int k = 0; k < 4; ++k) { dc[k] = rc[k]; db[k] = rb[k]; }
      u32x4 xo; xo.x = pk2(bflo(rx.x) * dt, bfhi(rx.x) * dt); xo.y = pk2(bflo(rx.y) * dt, bfhi(rx.y) * dt); xo.z = pk2(bflo(rx.z) * dt, bfhi(rx.z) * dt); xo.w = pk2(bflo(rx.w) * dt, bfhi(rx.w) * dt);
      *(LAS u32x4*)(Xd + i * LDP + st_q * 8) = xo;
      if (st_q == 0) dtL[i] = dt; }
    LBAR();
    if (step + 1 < 132) issue_loads(step + 1);
    const bool first = (d == 0) == fwd_first(chunk);
    bf16_t* op0; unsigned long long ppv[2] = {0ull, 0ull};
    { const int ii = 16 * w + fr; const int t = d ? 63 - ii : ii; op0 = MIX + (size_t)(row0 + t) * MIXW + outc + 4 * fq;
      if (!first) { ppv[0] = ld_agent_u64(op0); ppv[1] = ld_agent_u64(op0 + 16); } }
    const float cum = wave_incl_scan(Aneg * dtL[lane], lane);
    const float cum_last = __shfl(cum, 63);
    { const int i = td >> 2; const float sc = __expf(cum_last - __shfl(cum, i & 63));
      const u32x4 v = *(const LAS u32x4*)(Xd + i * LDP + (td & 3) * 8);
      u32x4 o; o.x = pk2(bflo(v.x) * sc, bfhi(v.x) * sc); o.y = pk2(bflo(v.y) * sc, bfhi(v.y) * sc); o.z = pk2(bflo(v.z) * sc, bfhi(v.z) * sc); o.w = pk2(bflo(v.w) * sc, bfhi(v.w) * sc);
      *(LAS u32x4*)(Xw + i * LDP + (td & 3) * 8) = o; }
    for (int tt = w; tt < 10; tt += 4) {
      int I, J; tri_tile(tt, I, J);
      f32x4 acc = (f32x4){0.f, 0.f, 0.f, 0.f};
#pragma unroll
      for (int k = 0; k < 4; ++k) acc = mma16(frag_row(Cs, LDN, 16 * I, 32 * k, lane), frag_row(Bs, LDN, 16 * J, 32 * k, lane), acc);
      const int jj = 16 * J + fr; const float cj = __shfl(cum, jj);
      u32x2 o; float pv[4];
#pragma unroll
      for (int r = 0; r < 4; ++r) { const int ii = 16 * I + 4 * fq + r; const float ci = __shfl(cum, ii); pv[r] = (jj <= ii) ? acc[r] * __expf(ci - cj) : 0.f; }
      o.x = pk2(pv[0], pv[1]); o.y = pk2(pv[2], pv[3]);
      *(LAS u32x2*)(Pt + jj * LDT + 16 * I + 4 * fq) = o;
    }
    LBAR();
    const LAS bf16_t* Sr = St + (step & 1) * 32 * LDN; LAS bf16_t* Sw = St + ((step + 1) & 1) * 32 * LDN;
    { const int I = w; const int nks = I < 2 ? 1 : 2;
      const int ii = 16 * I + fr; const float eci = __expf(__shfl(cum, ii));
#pragma unroll
      for (int pt = 0; pt < 2; ++pt) {
        f32x4 y1 = (f32x4){0.f, 0.f, 0.f, 0.f}, y2 = (f32x4){0.f, 0.f, 0.f, 0.f};
        for (int k = 0; k < nks; ++k) y1 = mma16(frag_tr(Xd, LDP, 32 * k, 16 * pt, lane), frag_tr(Pt, LDT, 32 * k, 16 * I, lane), y1);
#pragma unroll
        for (int k = 0; k < 4; ++k) y2 = mma16(frag_row(Sr, LDN, 16 * pt, 32 * k, lane), frag_row(Cs, LDN, 16 * I, 32 * k, lane), y2);
        bf16_t* op = op0 + 16 * pt;
        float o0 = y1[0] + eci * y2[0], o1 = y1[1] + eci * y2[1], o2 = y1[2] + eci * y2[2], o3 = y1[3] + eci * y2[3];
        if (!first) { const unsigned long long pv = ppv[pt]; const unsigned lo = (unsigned)pv, hi = (unsigned)(pv >> 32); o0 += bflo(lo); o1 += bfhi(lo); o2 += bflo(hi); o3 += bfhi(hi); }
        u32x2 o; o.x = pk2(o0, o1); o.y = pk2(o2, o3); *(u32x2*)op = o;
      } }
    { const float el = __expf(cum_last);
#pragma unroll
      for (int a = 0; a < 2; ++a)
#pragma unroll
        for (int c = 0; c < 2; ++c) { f32x4 acc = Sacc[a][c] * el;
#pragma unroll
          for (int k = 0; k < 2; ++k) acc = mma16(frag_tr(Bs, LDN, 32 * k, 16 * (2 * w + a), lane), frag_tr(Xw, LDP, 32 * k, 16 * c, lane), acc);
          Sacc[a][c] = acc;
          u32x2 o; o.x = pk2(acc[0], acc[1]); o.y = pk2(acc[2], acc[3]);
          *(LAS u32x2*)(Sw + (16 * c + fr) * LDN + 16 * (2 * w + a) + 4 * fq) = o; } }
    LBAR();
  }
}

template <int N> __device__ __forceinline__ float dpp_shr(float oldv, float v) {
  return __builtin_bit_cast(float, __builtin_amdgcn_update_dpp(__builtin_bit_cast(int, oldv), __builtin_bit_cast(int, v), 0x110 + N, 0xf, 0xf, false));
}
__device__ __forceinline__ float fast_sigmoid(float x) { return __builtin_amdgcn_rcpf(1.f + __expf(-x)); }
__device__ __forceinline__ void rg_chain_wg(const Params& P, const Ctx& C, int task) {
  const int b = task >> 5, h = (task >> 2) & 7, q = task & 3;
  const int d = C.wave >> 2, w = C.wave & 3, td = C.tid & 255, lane = C.lane, fr = lane & 15, fq = lane >> 4;
  constexpr int LDN = 136, LDW = 72;
  constexpr int DIRSZ = 40 * 1024;
  LAS unsigned char* L = C.lds + d * DIRSZ;
  LAS bf16_t* Xc = (LAS bf16_t*)L;
  LAS bf16_t* Wl = Xc + 64 * LDN;
  LAS float* Sum = (LAS float*)(Wl + 128 * LDW);
  const bf16_t* Z = WS(OFF_Z0, bf16_t); bf16_t* MIX = WS(OFF_MIX0, bf16_t);
  const int ch0 = h * 128 + q * 32;
  __syncthreads();
#pragma unroll 2
  for (int i = td; i < 128 * 64; i += 256) { const int ii = i >> 6, j = i & 63, gate = j >> 5, jj = j & 31;
    const float* W = (gate ? GIN(I_RGXW) : GIN(I_RGAW)) + ((size_t)(d * 8 + h) * 128 + ii) * 128 + q * 32 + jj; Wl[ii * LDW + j] = (bf16_t)f2bf(*W); }
  float ba[8], bx[8], spl[8], hc[8];
#pragma unroll
  for (int e = 0; e < 8; ++e) { const int c = ch0 + 16 * (e >> 2) + 4 * fq + (e & 3);
    ba[e] = GIN(I_RGAB)[d * 1024 + c]; bx[e] = GIN(I_RGXB)[d * 1024 + c]; spl[e] = -8.f * softplusf_(-GIN(I_RGLAM)[d * 1024 + c]); hc[e] = 0.f; }
  const int st_t = td >> 2, st_p = td & 3;
  u32x4 rx[4];
  auto issue_loads = [&](int step) {
    const int chunk = seq_chunk(d, step); const size_t row = (size_t)b * TB + chunk * 64 + st_t;
    const u32x4* px = (const u32x4*)(Z + row * Z0W + Z0_RGX + h * 128 + st_p * 32);
#pragma unroll
    for (int i = 0; i < 4; ++i) rx[i] = px[i];
  };
  issue_loads(0);
  __syncthreads();
  const int ii = 16 * w + fr;
  const LAS bf16_t* xrow = Xc + ii * LDN + q * 32 + 4 * fq;
  for (int step = 0; step < 132; ++step) {
    const int chunk = seq_chunk(d, step); const int row0 = b * TB + chunk * 64;
    VMWAIT();
    { const int i = d ? 63 - st_t : st_t; LAS u32x4* dx = (LAS u32x4*)(Xc + i * LDN + st_p * 32);
#pragma unroll
      for (int k = 0; k < 4; ++k) dx[k] = rx[k]; }
    LBAR();
    if (step + 1 < 132) issue_loads(step + 1);
    const bool first = (d == 0) == fwd_first(chunk);
    const int t = d ? 63 - ii : ii;
    bf16_t* op = MIX + (size_t)(row0 + t) * MIXW + ch0 + 4 * fq;
    unsigned long long ppv[2] = {0ull, 0ull}; u32x2 gy[2] = {(u32x2){0u, 0u}, (u32x2){0u, 0u}};
    if (!first) { ppv[0] = ld_agent_u64(op); ppv[1] = ld_agent_u64(op + 16);
      const bf16_t* gp = Z + (size_t)(row0 + t) * Z0W + Z0_RGY + ch0 + 4 * fq; gy[0] = *(const u32x2*)gp; gy[1] = *(const u32x2*)(gp + 16); }
    f32x4 ga[2], gx[2];
#pragma unroll
    for (int jt = 0; jt < 2; ++jt) { ga[jt] = (f32x4){0.f, 0.f, 0.f, 0.f}; gx[jt] = (f32x4){0.f, 0.f, 0.f, 0.f}; }
#pragma unroll
    for (int k = 0; k < 4; ++k) { const bf16x8 fb = frag_row(Xc, LDN, 16 * w, 32 * k, lane);
#pragma unroll
      for (int jt = 0; jt < 2; ++jt) { ga[jt] = mma16(frag_tr(Wl, LDW, 32 * k, 16 * jt, lane), fb, ga[jt]); gx[jt] = mma16(frag_tr(Wl, LDW, 32 * k, 32 + 16 * jt, lane), fb, gx[jt]); } }
    float A[8], Bv[8];
#pragma unroll
    for (int jt = 0; jt < 2; ++jt) { const u32x2 xw = *(const LAS u32x2*)(xrow + 16 * jt); const float xv[4] = {bflo(xw.x), bfhi(xw.x), bflo(xw.y), bfhi(xw.y)};
#pragma unroll
      for (int r = 0; r < 4; ++r) { const int e = 4 * jt + r;
        const float rg = fast_sigmoid(ga[jt][r] + ba[e]), ig = fast_sigmoid(gx[jt][r] + bx[e]); const float la = rg * spl[e];
        const float a = __expf(la); A[e] = a; Bv[e] = sqrtf(fmaxf(1.f - a * a, 0.f)) * (ig * xv[r]); } }
#pragma unroll
    for (int e = 0; e < 8; ++e) {
      { const float Ap = dpp_shr<1>(1.f, A[e]), Bp = dpp_shr<1>(0.f, Bv[e]); Bv[e] = A[e] * Bp + Bv[e]; A[e] = A[e] * Ap; }
      { const float Ap = dpp_shr<2>(1.f, A[e]), Bp = dpp_shr<2>(0.f, Bv[e]); Bv[e] = A[e] * Bp + Bv[e]; A[e] = A[e] * Ap; }
      { const float Ap = dpp_shr<4>(1.f, A[e]), Bp = dpp_shr<4>(0.f, Bv[e]); Bv[e] = A[e] * Bp + Bv[e]; A[e] = A[e] * Ap; }
      { const float Ap = dpp_shr<8>(1.f, A[e]), Bp = dpp_shr<8>(0.f, Bv[e]); Bv[e] = A[e] * Bp + Bv[e]; A[e] = A[e] * Ap; } }
    if (fr == 15) {
#pragma unroll
      for (int e = 0; e < 8; ++e) { f32x2 sv; sv[0] = A[e]; sv[1] = Bv[e]; *(LAS f32x2*)(Sum + ((w * 32) + 16 * (e >> 2) + 4 * fq + (e & 3)) * 2) = sv; } }
    LBAR();
    float hin[8];
#pragma unroll
    for (int e = 0; e < 8; ++e) { float hh = hc[e]; const int c = 16 * (e >> 2) + 4 * fq + (e & 3);
#pragma unroll
      for (int tt = 0; tt < 4; ++tt) { const f32x2 sv = *(const LAS f32x2*)(Sum + (tt * 32 + c) * 2); if (tt == w) hin[e] = hh; hh = sv[0] * hh + sv[1]; }
      hc[e] = hh; }
#pragma unroll
    for (int jt = 0; jt < 2; ++jt) { float hv[4];
#pragma unroll
      for (int r = 0; r < 4; ++r) hv[r] = Bv[4 * jt + r] + A[4 * jt + r] * hin[4 * jt + r];
      if (!first) { const unsigned lo = (unsigned)ppv[jt], hi = (unsigned)(ppv[jt] >> 32);
        const float gyv[4] = {bflo(gy[jt].x), bfhi(gy[jt].x), bflo(gy[jt].y), bfhi(gy[jt].y)}; const float pf[4] = {bflo(lo), bfhi(lo), bflo(hi), bfhi(hi)};
#pragma unroll
        for (int r = 0; r < 4; ++r) { const float x = gyv[r]; const float u2 = 1.5957691216057308f * (x + 0.044715f * x * x * x); hv[r] = (hv[r] + pf[r]) * x * fast_sigmoid(u2); } }
      u32x2 o; o.x = pg8::cvt_pk_bf16(hv[0], hv[1]); o.y = pg8::cvt_pk_bf16(hv[2], hv[3]); *(u32x2*)(op + 16 * jt) = o; }
  }
}
__device__ __forceinline__ void phase_chain0(const Params& P, const Ctx& C, int mode) {
  if (mode != 2) for (int task = C.bid; task < 128; task += C.nblk) ssd_chain_wg(P, C, task);
  __builtin_amdgcn_sched_barrier(0);
  if (mode != 1) for (int task = C.bid < 128 ? C.bid + C.nblk : C.bid; task < 256; task += C.nblk) rg_chain_wg(P, C, task - 128);
}
__device__ __forceinline__ void phase_ssdfin(const Params& P, const Ctx& C) {
  const bf16_t* Z = WS(OFF_Z0, bf16_t); bf16_t* MIX = WS(OFF_MIX0, bf16_t);
  for (int r = C.gw; r < R; r += C.ngw) {
    f32x4 y[4];
#pragma unroll
    for (int j = 0; j < 4; ++j) { const int e = 4 * C.lane + 256 * j; const float dsk = GIN(I_SD)[e >> 6];
      const u32x2 ys = *(const u32x2*)(MIX + (size_t)r * MIXW + 1024 + e), xs = *(const u32x2*)(Z + (size_t)r * Z0W + Z0_XBC + e), zz = *(const u32x2*)(Z + (size_t)r * Z0W + Z0_SSDZ + e);
      y[j][0] = (bflo(ys.x) + dsk * bflo(xs.x)) * siluf_(bflo(zz.x)); y[j][1] = (bfhi(ys.x) + dsk * bfhi(xs.x)) * siluf_(bfhi(zz.x));
      y[j][2] = (bflo(ys.y) + dsk * bflo(xs.y)) * siluf_(bflo(zz.y)); y[j][3] = (bfhi(ys.y) + dsk * bfhi(xs.y)) * siluf_(bfhi(zz.y)); }
    float s0 = 0.f, s1 = 0.f;
#pragma unroll
    for (int i = 0; i < 4; ++i) { s0 += y[0][i] * y[0][i] + y[1][i] * y[1][i]; s1 += y[2][i] * y[2][i] + y[3][i] * y[3][i]; }
    const float r0 = rsqrtf(wave_sum(s0) * (1.f / 512.f) + RMS_EPS), r1 = rsqrtf(wave_sum(s1) * (1.f / 512.f) + RMS_EPS);
#pragma unroll
    for (int j = 0; j < 4; ++j) { const int e = 4 * C.lane + 256 * j; const f32x4 gn = *(const f32x4*)(GIN(I_SNG) + e); const float rr = j < 2 ? r0 : r1;
      u32x2 w; w.x = pk2(y[j][0] * rr * gn[0], y[j][1] * rr * gn[1]); w.y = pk2(y[j][2] * rr * gn[2], y[j][3] * rr * gn[3]);
      *(u32x2*)(MIX + (size_t)r * MIXW + 1024 + e) = w; }
  }
}

__device__ __forceinline__ void phase_outproj(const Params& P, const Ctx& C, int layer) {
  const float* MOD = WS(OFF_MOD, float) + (size_t)layer * 5 * 6144;
  pg8::Gemm g{layer ? WS(OFF_MIX1, bf16_t) : WS(OFF_MIX0, bf16_t), layer ? WS(OFF_WOUT1, bf16_t) : WS(OFF_WOUT0, bf16_t), MIXW, MIXW};
  pg8::GridOrder S; if (layer) S.init(128, 4, C.nblk, C.bid, 1); else S.init(132, 4, C.nblk, C.bid, 0);
  pg8::EpiResid E{layer ? GOUT : GIN(I_X), layer ? WS(OFF_HCTX, float) : GIN(I_CTX), GOUT, WS(OFF_TCTX, float), MOD + 2 * D};
  pg8::gemm_phase(C.lds, g, S, E);
}

__device__ __forceinline__ void phase_lnmix(const Params& P, const Ctx& C, int layer) {
  LAS float* Wt = (LAS float*)C.lds;
  { const float* gw = GIN(I_RGW) + (size_t)layer * D * 4; const float* ew = GIN(I_REW) + (size_t)layer * D * 32;
    for (int i = C.tid; i < 1024 * 4; i += NT) { const int k = i >> 2, c = i & 3; Wt[c * 1024 + k] = gw[i]; }
    for (int i = C.tid; i < 1024 * 32; i += NT) { const int k = i >> 5, c = i & 31; Wt[(4 + c) * 1024 + k] = ew[i]; } }
  __syncthreads();
  const float* MOD = WS(OFF_MOD, float) + (size_t)layer * 5 * 6144;
  const float* lng = GIN(I_LNMG) + layer * D; const float* lnb = GIN(I_LNMB) + layer * D;
  const float* rgb = GIN(I_RGB) + layer * 4; const float* reb = GIN(I_REB) + layer * 32;
  bf16_t* V = layer ? WS(OFF_V1, bf16_t) : WS(OFF_U0, bf16_t);
  int* cnt = WS(OFF_CTL, int) + layer * 32; int* route = WS(OFF_ROUTE, int);
  LAS int* lcnt = (LAS int*)(C.lds + 36 * 1024 * 4);
  if (C.tid < NEXP) lcnt[C.tid] = 0;
  __syncthreads();
  const int nrows = layer ? RLAT : R;
  f32x4 h[4], hn[4];
  if (C.gw < nrows) row_load(lat_or_ctx_w(GOUT, WS(OFF_TCTX, float), rmap(layer, C.gw)), C.lane, h);
  for (int q = C.gw; q < nrows; q += C.ngw) {
    const int r = rmap(layer, q);
    if (q + C.ngw < nrows) row_load(lat_or_ctx_w(GOUT, WS(OFF_TCTX, float), rmap(layer, q + C.ngw)), C.lane, hn);
    float* hrow = lat_or_ctx_w(GOUT, WS(OFF_HCTX, float), r);
    f32x4 v[4];
    row_layernorm(h, lng, lnb, C.lane);
    row_store(hrow, C.lane, h);
    const float* m = MOD + (size_t)row_b5(r) * 6144;
    row_modulate(h, m + 3 * D, m + 4 * D, C.lane, v);
    row_store_bf16(V + (size_t)r * D, C.lane, v);
    float lg[4];
#pragma unroll
    for (int c = 0; c < 4; ++c) { float s = 0.f;
#pragma unroll
      for (int j = 0; j < 4; ++j) { const f32x4 w = *(const LAS f32x4*)(Wt + c * 1024 + 4 * C.lane + 256 * j); s += (v[j][0] * w[0] + v[j][1] * w[1]) + (v[j][2] * w[2] + v[j][3] * w[3]); }
      lg[c] = wave_sum(s) + rgb[c]; }
    int gsel = 0; float gmax = lg[0];
#pragma unroll
    for (int i = 1; i < 4; ++i) if (lg[i] > gmax) { gmax = lg[i]; gsel = i; }
    gsel = __builtin_amdgcn_readfirstlane(gsel);
    float gden = 0.f;
#pragma unroll
    for (int i = 0; i < 4; ++i) gden += __expf(lg[i] - gmax);
    const float ptg = 1.f / gden;
    float le[8];
    { const LAS float* We = Wt + (4 + gsel * 8) * 1024 + 4 * C.lane;
#pragma unroll
      for (int c = 0; c < 8; ++c) { float s = 0.f;
#pragma unroll
        for (int j = 0; j < 4; ++j) { const f32x4 w = *(const LAS f32x4*)(We + c * 1024 + 256 * j); s += (v[j][0] * w[0] + v[j][1] * w[1]) + (v[j][2] * w[2] + v[j][3] * w[3]); }
        le[c] = wave_sum(s) + reb[gsel * 8 + c]; } }
    int e1 = 0; float m1 = le[0];
#pragma unroll
    for (int i = 1; i < 8; ++i) if (le[i] > m1) { m1 = le[i]; e1 = i; }
    int e2 = -1; float m2 = -3.0e38f;
#pragma unroll
    for (int i = 0; i < 8; ++i) if (i != e1 && le[i] > m2) { m2 = le[i]; e2 = i; }
    const float q2 = __expf(m2 - m1); const float w1 = ptg / (1.f + q2), w2 = ptg * q2 / (1.f + q2);
    if (C.lane == 0) {
      const int E1 = gsel * 8 + e1, E2 = gsel * 8 + e2;
      const int p1 = __hip_atomic_fetch_add(lcnt + E1, 1, __ATOMIC_RELAXED, __HIP_MEMORY_SCOPE_WORKGROUP), p2 = __hip_atomic_fetch_add(lcnt + E2, 1, __ATOMIC_RELAXED, __HIP_MEMORY_SCOPE_WORKGROUP);
      int* rr = route + (size_t)r * 8; rr[0] = E1; rr[1] = E2; ((float*)rr)[2] = w1; ((float*)rr)[3] = w2; rr[4] = p1; rr[5] = p2;
    }
#pragma unroll
    for (int j = 0; j < 4; ++j) h[j] = hn[j];
  }
  __syncthreads();
  if (C.tid < NEXP) lcnt[C.tid] = atomicAdd(cnt + C.tid, lcnt[C.tid]);
  __syncthreads();
  for (int k = C.tid >> 3; ; k += NT / 8) { const int q = (C.bid * NWAVES + (C.tid & 7)) + k * C.ngw; if (q >= nrows) break;
    int* rr = route + (size_t)rmap(layer, q) * 8; rr[4] += lcnt[rr[0]]; rr[5] += lcnt[rr[1]]; }
}

__device__ __forceinline__ void phase_dispatch(const Params& P, const Ctx& C, int layer) {
  LAS int* base = (LAS int*)C.lds;
  int* ctl = WS(OFF_CTL, int); const int* cnt = ctl + layer * 32;
  if (C.tid == 0) { int acc = 0; for (int e = 0; e < NEXP; ++e) { base[e] = acc; acc += (cnt[e] + 255) >> 8; } base[32] = acc; }
  __syncthreads();
  if (C.bid == 0) { if (C.tid == 0) ctl[64 + layer] = base[32];
    if (C.tid < NEXP) { for (int bk = base[C.tid]; bk < base[C.tid + 1]; ++bk) ctl[128 + layer * MAX_BLKS + bk] = C.tid; } }
  const bf16_t* V = layer ? WS(OFF_V1, bf16_t) : WS(OFF_U0, bf16_t);
  bf16_t* AM = layer ? WS(OFF_AM1, bf16_t) : WS(OFF_AM0, bf16_t);
  float* slotw = WS(OFF_SLOTW, float); int* route = WS(OFF_ROUTE, int);
  for (int r = C.gw; r < R; r += C.ngw) {
    const int pos = r % TB; if (layer && pos < CTXL) continue;
    int* rr = route + (size_t)r * 8;
    const int E1 = rr[0], E2 = rr[1]; const int s1 = base[E1] * 256 + rr[4], s2 = base[E2] * 256 + rr[5];
    const u32x4* src = (const u32x4*)(V + (size_t)r * D);
    const u32x4 a = src[C.lane], b = src[64 + C.lane];
    u32x4* d1 = (u32x4*)(AM + (size_t)s1 * D); u32x4* d2 = (u32x4*)(AM + (size_t)s2 * D);
    d1[C.lane] = a; d1[64 + C.lane] = b; d2[C.lane] = a; d2[64 + C.lane] = b;
    if (C.lane == 0) { rr[6] = s1; rr[7] = s2; slotw[s1] = ((const float*)rr)[2]; slotw[s2] = ((const float*)rr)[3]; }
  }
}
__device__ __forceinline__ void phase_moe1(const Params& P, const Ctx& C, int layer) {
  const int* ctl = WS(OFF_CTL, int);
  pg8::Gemm g{layer ? WS(OFF_AM1, bf16_t) : WS(OFF_AM0, bf16_t), layer ? WS(OFF_WE1, bf16_t) : WS(OFF_WE0, bf16_t), D, D};
  pg8::MoeOrder S{ctl + 128 + layer * MAX_BLKS, ctl[64 + layer] * 4, C.nblk, C.bid};
  pg8::EpiSwiGLU E{layer ? WS(OFF_HM1, bf16_t) : WS(OFF_HM0, bf16_t)};
  pg8::gemm_phase(C.lds, g, S, E);
}
__device__ __forceinline__ void phase_moe2(const Params& P, const Ctx& C, int layer) {
  const int* ctl = WS(OFF_CTL, int);
  pg8::Gemm g{layer ? WS(OFF_HM1, bf16_t) : WS(OFF_HM0, bf16_t), layer ? WS(OFF_WE1 + 64 * MiB, bf16_t) : WS(OFF_WE0 + 64 * MiB, bf16_t), DEXP, DEXP};
  pg8::MoeOrder S{ctl + 128 + layer * MAX_BLKS, ctl[64 + layer] * 4, C.nblk, C.bid};
  pg8::EpiMoeDown E{layer ? WS(OFF_YM1, bf16_t) : WS(OFF_YM0, bf16_t), WS(OFF_SLOTW, float)};
  pg8::gemm_phase(C.lds, g, S, E);
}

__device__ __forceinline__ void phase_lnffn(const Params& P, const Ctx& C, int layer) {
  const float* MOD = WS(OFF_MOD, float) + (size_t)layer * 5 * 6144;
  const float* lng = GIN(I_LNFG) + layer * D; const float* lnb = GIN(I_LNFB) + layer * D;
  const bf16_t* YM = layer ? WS(OFF_YM1, bf16_t) : WS(OFF_YM0, bf16_t); const int* route = WS(OFF_ROUTE, int);
  const int nrows = layer ? RLAT : R;
  f32x4 h[4], hn[4]; u32x2 ya[4], yb[4], yan[4], ybn[4]; int s1n = 0, s2n = 0;
  auto ldrow = [&](int q, f32x4 (&hh)[4], u32x2 (&a)[4], u32x2 (&bq)[4], int sa, int sb) {
    const int r = rmap(layer, q); row_load(lat_or_ctx_w(GOUT, WS(OFF_HCTX, float), r), C.lane, hh);
#pragma unroll
    for (int j = 0; j < 4; ++j) { a[j] = *(const u32x2*)(YM + (size_t)sa * D + 4 * C.lane + 256 * j); bq[j] = *(const u32x2*)(YM + (size_t)sb * D + 4 * C.lane + 256 * j); } };
  if (C.gw < nrows) { const int* rr = route + (size_t)rmap(layer, C.gw) * 8; ldrow(C.gw, h, ya, yb, rr[6], rr[7]); }
  if (C.gw + C.ngw < nrows) { const int* rr = route + (size_t)rmap(layer, C.gw + C.ngw) * 8; s1n = rr[6]; s2n = rr[7]; }
  for (int q = C.gw; q < nrows; q += C.ngw) {
    const int r = rmap(layer, q);
    if (q + C.ngw < nrows) ldrow(q + C.ngw, hn, yan, ybn, s1n, s2n);
    if (q + 2 * C.ngw < nrows) { const int* rr = route + (size_t)rmap(layer, q + 2 * C.ngw) * 8; s1n = rr[6]; s2n = rr[7]; }
    float* hrow = lat_or_ctx_w(GOUT, WS(OFF_HCTX, float), r);
    const float* m = MOD + (size_t)row_b5(r) * 6144;
#pragma unroll
    for (int j = 0; j < 4; ++j) { const u32x2 a = ya[j], b = yb[j];
      const f32x4 g5 = *(const f32x4*)(m + 5 * D + 4 * C.lane + 256 * j);
      f32x4 f; f[0] = bflo(a.x) + bflo(b.x); f[1] = bfhi(a.x) + bfhi(b.x); f[2] = bflo(a.y) + bflo(b.y); f[3] = bfhi(a.y) + bfhi(b.y);
      h[j] = h[j] * ALPHA + g5 * f; }
    row_layernorm(h, lng, lnb, C.lane);
    row_store(hrow, C.lane, h);
    if (layer == 0) {
      const float* m1 = WS(OFF_MOD, float) + (size_t)(5 + row_b5(r)) * 6144;
      f32x4 u[4]; row_modulate(h, m1, m1 + D, C.lane, u);
      row_store_bf16(WS(OFF_U1, bf16_t) + (size_t)r * D, C.lane, u);
    }
#pragma unroll
    for (int j = 0; j < 4; ++j) { h[j] = hn[j]; ya[j] = yan[j]; yb[j] = ybn[j]; }
  }
  if (layer == 0) {
    __syncthreads();
    LAS float* scr = (LAS float*)C.lds + C.wave * (64 * 33);
    constexpr int N_A = 16 * 96, N_B = 16 * 128;
    for (int it = C.gw; it < N_A + N_B + 16; it += C.ngw) {
      if (it < N_A) transpose_mat_item(GIN(I_CDW), CD_IN, 0, D, 3072, WS(OFF_WCD, bf16_t), D, 0, it, scr, C.lane);
      else if (it < N_A + N_B) transpose_mat_item(GIN(I_CDW), CD_IN, 4128, D, 4096, WS(OFF_WCD, bf16_t) + (size_t)3072 * D, D, 0, it - N_A, scr, C.lane);
      else transpose_mat_item(GIN(I_CDW), CD_IN, 4096, D, 32, WS(OFF_WCD, bf16_t) + (size_t)7168 * D, D, 0, it - N_A - N_B, scr, C.lane);
    }
    { u32x4* z = (u32x4*)(WS(OFF_WCD, bf16_t) + (size_t)7200 * D); const u32x4 zz = {0u, 0u, 0u, 0u};
      for (int i = C.bid * NT + C.tid; i < 224 * D * 2 / 16; i += C.nblk * NT) z[i] = zz; }
  }
}

__device__ __forceinline__ void gdn_task(const Params& P, const Ctx& C, int task) {
  const int b = task >> 9, h = (task >> 6) & 7, vs = task & 63; const int c = C.lane >> 5, kg = C.lane & 31;
  const bf16_t* Z = WS(OFF_Z1, bf16_t); bf16_t* MIX = WS(OFF_MIX1, bf16_t); const float* DT = WS(OFF_DT, float);
  const int colq = Z1_Q + h * 128 + 4 * kg, colk = Z1_K + h * 128 + 4 * kg, colv = Z1_V + h * 128 + 2 * vs + c, outc = h * 128 + 2 * vs + c;
  for (int d = 0; d < 2; ++d) {
    const float Aneg = -__expf(GIN(I_GALOG)[d * 8 + h]), dtb = GIN(I_GDTB)[d * 8 + h];
    float S0 = 0.f, S1 = 0.f, S2 = 0.f, S3 = 0.f;
    for (int j0 = 0; j0 < TB; j0 += 8) {
      u32x2 qv[8], kv[8]; unsigned short vv[8], yp[8]; float br[8], ar[8];
#pragma unroll
      for (int u = 0; u < 8; ++u) { const size_t row = (size_t)b * TB + seq_pos(d, j0 + u);
        qv[u] = *(const u32x2*)(Z + row * Z1W + colq); kv[u] = *(const u32x2*)(Z + row * Z1W + colk); vv[u] = Z[row * Z1W + colv];
        br[u] = DT[row * 32 + d * 8 + h]; ar[u] = DT[row * 32 + 16 + d * 8 + h]; yp[u] = d ? MIX[row * MIXW + outc] : (unsigned short)0; }
#pragma unroll
      for (int u = 0; u < 8; ++u) { const size_t row = (size_t)b * TB + seq_pos(d, j0 + u);
        const float al = __expf(Aneg * softplusf_(ar[u] + dtb)), be = sigmoidf_(br[u]);
        const float k0 = bflo(kv[u].x), k1 = bfhi(kv[u].x), k2 = bflo(kv[u].y), k3 = bfhi(kv[u].y);
        S0 *= al; S1 *= al; S2 *= al; S3 *= al;
        const float p = half_sum32((k0 * S0 + k1 * S1) + (k2 * S2 + k3 * S3));
        const float dl = be * (bf2f(vv[u]) - p);
        S0 += k0 * dl; S1 += k1 * dl; S2 += k2 * dl; S3 += k3 * dl;
        const float o = half_sum32((bflo(qv[u].x) * S0 + bfhi(qv[u].x) * S1) + (bflo(qv[u].y) * S2 + bfhi(qv[u].y) * S3));
        if (kg == 0) MIX[row * MIXW + outc] = (bf16_t)f2bf(o + bf2f(yp[u])); }
    }
    __threadfence_block();
  }
}
__device__ __forceinline__ void hgrn_task(const Params& P, const Ctx& C, int task) {
  const int b = task >> 9, h = (task >> 6) & 7, vs = task & 63; const int c = C.lane >> 5, kg = C.lane & 31;
  const bf16_t* Z = WS(OFF_Z1, bf16_t); bf16_t* MIX = WS(OFF_MIX1, bf16_t);
  const f32x4 lb = *(const f32x4*)(WS(OFF_LB1, float) + h * 128 + 4 * kg);
  const int colq = Z1_HQ + h * 128 + 4 * kg, colv = Z1_HI + h * 128 + 2 * vs + c, outc = 1024 + h * 128 + 2 * vs + c;
  for (int d = 0; d < 2; ++d) {
    const int colf = Z1_HF + d * 1024 + h * 128 + 4 * kg;
    float S0 = 0.f, S1 = 0.f, S2 = 0.f, S3 = 0.f;
    for (int j0 = 0; j0 < TB; j0 += 8) {
      u32x2 qv[8], fv[8]; unsigned short vv[8], yp[8];
#pragma unroll
      for (int u = 0; u < 8; ++u) { const size_t row = (size_t)b * TB + seq_pos(d, j0 + u);
        qv[u] = *(const u32x2*)(Z + row * Z1W + colq); fv[u] = *(const u32x2*)(Z + row * Z1W + colf); vv[u] = Z[row * Z1W + colv];
        yp[u] = d ? MIX[row * MIXW + outc] : (unsigned short)0; }
#pragma unroll
      for (int u = 0; u < 8; ++u) { const size_t row = (size_t)b * TB + seq_pos(d, j0 + u);
        const float f0 = lb[0] + (1.f - lb[0]) * sigmoidf_(bflo(fv[u].x)), f1 = lb[1] + (1.f - lb[1]) * sigmoidf_(bfhi(fv[u].x));
        const float f2 = lb[2] + (1.f - lb[2]) * sigmoidf_(bflo(fv[u].y)), f3 = lb[3] + (1.f - lb[3]) * sigmoidf_(bfhi(fv[u].y));
        const float v = bf2f(vv[u]);
        S0 = f0 * S0 + (1.f - f0) * v; S1 = f1 * S1 + (1.f - f1) * v; S2 = f2 * S2 + (1.f - f2) * v; S3 = f3 * S3 + (1.f - f3) * v;
        const float o = half_sum32((bflo(qv[u].x) * S0 + bfhi(qv[u].x) * S1) + (bflo(qv[u].y) * S2 + bfhi(qv[u].y) * S3));
        if (kg == 0) MIX[row * MIXW + outc] = (bf16_t)f2bf(o + bf2f(yp[u])); }
    }
    __threadfence_block();
  }
}

__device__ __forceinline__ int seq_chunk32(int dir, int j) { return dir == 0 ? j : (j < 8 ? 7 - j : 271 - j); }
__device__ __forceinline__ bool fwd_first32(int c) { return c < 8 ? (c <= 3) : (c <= 135); }

__device__ __forceinline__ void hgrn_chain_wg(const Params& P, const Ctx& C, int task) {
  const int b = task >> 5, h = (task >> 2) & 7, vs = task & 3;
  const int d = C.wave >> 2, w = C.wave & 3, td = C.tid & 255, lane = C.lane, fr = lane & 15, fq = lane >> 4;
  constexpr int LDN = 136, LDP = 40;
  constexpr int DIRSZ = 72 * 1024;
  LAS unsigned char* L = C.lds + d * DIRSZ;
  LAS bf16_t* Qt = (LAS bf16_t*)L;
  LAS bf16_t* Kh = Qt + 32 * LDN;
  LAS bf16_t* Kw = Kh + 32 * LDN;
  LAS bf16_t* Vs = Kw + 32 * LDN;
  LAS bf16_t* Pt = Vs + 32 * LDP;
  LAS bf16_t* St = Pt + 32 * LDP;
  LAS float* CUM = (LAS float*)(St + 2 * 32 * LDN);
  const bf16_t* Z = WS(OFF_Z1, bf16_t); bf16_t* MIX = WS(OFF_MIX1, bf16_t);
  const int colq = Z1_HQ + h * 128, colf = Z1_HF + d * 1024 + h * 128, colv = Z1_HI + h * 128 + vs * 32, outc = 1024 + h * 128 + vs * 32;
  __syncthreads();
  for (int i = td; i < 32 * LDP / 2; i += 256) ((LAS unsigned*)Pt)[i] = 0u;
  for (int i = td; i < 2 * 32 * LDN / 2; i += 256) ((LAS unsigned*)St)[i] = 0u;
  f32x4 Sacc[2][2];
#pragma unroll
  for (int a = 0; a < 2; ++a)
#pragma unroll
    for (int c = 0; c < 2; ++c) Sacc[a][c] = (f32x4){0.f, 0.f, 0.f, 0.f};
  const int st_t = td >> 3, st_s = td & 7;
  float lbv[16];
#pragma unroll
  for (int e = 0; e < 16; ++e) lbv[e] = WS(OFF_LB1, float)[h * 128 + st_s * 16 + e];
  u32x4 rq[2], rf[2]; u32x2 rv;
  auto issue_loads = [&](int step) {
    const int chunk = seq_chunk32(d, step); const size_t row = (size_t)b * TB + chunk * 32 + st_t;
    const u32x4* pq = (const u32x4*)(Z + row * Z1W + colq + st_s * 16); const u32x4* pf = (const u32x4*)(Z + row * Z1W + colf + st_s * 16);
    rq[0] = pq[0]; rq[1] = pq[1]; rf[0] = pf[0]; rf[1] = pf[1];
    rv = *(const u32x2*)(Z + row * Z1W + colv + st_s * 4);
  };
  issue_loads(0);
  for (int step = 0; step < 264; ++step) {
    const int chunk = seq_chunk32(d, step); const int row0 = b * TB + chunk * 32;
    const int si = d ? 31 - st_t : st_t;
    VMWAIT();
    float qv[16], kk[16];
    { const unsigned qw[8] = {rq[0].x, rq[0].y, rq[0].z, rq[0].w, rq[1].x, rq[1].y, rq[1].z, rq[1].w};
      const unsigned fw[8] = {rf[0].x, rf[0].y, rf[0].z, rf[0].w, rf[1].x, rf[1].y, rf[1].z, rf[1].w};
      f32x4 lf4[4];
#pragma unroll
      for (int e = 0; e < 8; ++e) { qv[2 * e] = bflo(qw[e]); qv[2 * e + 1] = bfhi(qw[e]);
        const float f0 = lbv[2 * e] + (1.f - lbv[2 * e]) * sigmoidf_(bflo(fw[e])), f1 = lbv[2 * e + 1] + (1.f - lbv[2 * e + 1]) * sigmoidf_(bfhi(fw[e]));
        kk[2 * e] = 1.f - f0; kk[2 * e + 1] = 1.f - f1; lf4[e >> 1][(2 * e) & 3] = __logf(f0); lf4[e >> 1][(2 * e + 1) & 3] = __logf(f1); }
#pragma unroll
      for (int e = 0; e < 4; ++e) *(LAS f32x4*)(CUM + si * 128 + st_s * 16 + 4 * e) = lf4[e];
      *(LAS u32x2*)(Vs + si * LDP + st_s * 4) = rv; }
    LBAR();
    if (step + 1 < 264) issue_loads(step + 1);
    const int vt = w & 1, it = w >> 1;
    const bool first = (d == 0) == fwd_first32(chunk);
    bf16_t* op; unsigned long long ppv = 0ull;
    { const int ii = 16 * it + fr; const int t = d ? 31 - ii : ii; op = MIX + (size_t)(row0 + t) * MIXW + outc + 16 * vt + 4 * fq; if (!first) ppv = ld_agent_u64(op); }
    if (td < 128) { float c = 0.f;
#pragma unroll 8
      for (int i = 0; i < 32; ++i) { c += CUM[i * 128 + td]; CUM[i * 128 + td] = c; } }
    LBAR();
    { unsigned oq[8], oh[8], ow[8];
#pragma unroll
      for (int e = 0; e < 8; ++e) { const int k0 = st_s * 16 + 2 * e;
        const float c0 = CUM[si * 128 + k0], c1 = CUM[si * 128 + k0 + 1], l0 = CUM[31 * 128 + k0], l1 = CUM[31 * 128 + k0 + 1];
        oq[e] = pk2(qv[2 * e] * __expf(c0), qv[2 * e + 1] * __expf(c1));
        oh[e] = pk2(kk[2 * e] * __expf(fminf(-c0, 80.f)), kk[2 * e + 1] * __expf(fminf(-c1, 80.f)));
        ow[e] = pk2(kk[2 * e] * __expf(l0 - c0), kk[2 * e + 1] * __expf(l1 - c1)); }
      LAS u32x4* dq = (LAS u32x4*)(Qt + si * LDN + st_s * 16); LAS u32x4* dh = (LAS u32x4*)(Kh + si * LDN + st_s * 16); LAS u32x4* dw = (LAS u32x4*)(Kw + si * LDN + st_s * 16);
      dq[0] = (u32x4){oq[0], oq[1], oq[2], oq[3]}; dq[1] = (u32x4){oq[4], oq[5], oq[6], oq[7]};
      dh[0] = (u32x4){oh[0], oh[1], oh[2], oh[3]}; dh[1] = (u32x4){oh[4], oh[5], oh[6], oh[7]};
      dw[0] = (u32x4){ow[0], ow[1], ow[2], ow[3]}; dw[1] = (u32x4){ow[4], ow[5], ow[6], ow[7]}; }
    LBAR();
    if (w < 3) { const int I = w >= 1 ? 1 : 0, J = w == 2 ? 1 : 0;
      f32x4 acc = (f32x4){0.f, 0.f, 0.f, 0.f};
#pragma unroll
      for (int k = 0; k < 4; ++k) acc = mma16(frag_row(Qt, LDN, 16 * I, 32 * k, lane), frag_row(Kh, LDN, 16 * J, 32 * k, lane), acc);
      const int jj = 16 * J + fr; float pv[4];
#pragma unroll
      for (int r = 0; r < 4; ++r) { const int ii = 16 * I + 4 * fq + r; pv[r] = (jj <= ii) ? acc[r] : 0.f; }
      u32x2 o; o.x = pk2(pv[0], pv[1]); o.y = pk2(pv[2], pv[3]);
      *(LAS u32x2*)(Pt + jj * LDP + 16 * I + 4 * fq) = o; }
    const LAS bf16_t* Sr = St + (step & 1) * 32 * LDN; LAS bf16_t* Sw = St + ((step + 1) & 1) * 32 * LDN;
    f32x4 o2 = (f32x4){0.f, 0.f, 0.f, 0.f};
#pragma unroll
    for (int k = 0; k < 4; ++k) o2 = mma16(frag_row(Sr, LDN, 16 * vt, 32 * k, lane), frag_row(Qt, LDN, 16 * it, 32 * k, lane), o2);
#pragma unroll
    for (int a = 0; a < 2; ++a) { const int kt = 2 * w + a; const f32x4 cl = *(const LAS f32x4*)(CUM + 31 * 128 + 16 * kt + 4 * fq);
      f32x4 dec; dec[0] = __expf(cl[0]); dec[1] = __expf(cl[1]); dec[2] = __expf(cl[2]); dec[3] = __expf(cl[3]);
#pragma unroll
      for (int c = 0; c < 2; ++c) { f32x4 acc = Sacc[a][c] * dec;
        acc = mma16(frag_tr(Kw, LDN, 0, 16 * kt, lane), frag_tr(Vs, LDP, 0, 16 * c, lane), acc);
        Sacc[a][c] = acc;
        u32x2 o; o.x = pk2(acc[0], acc[1]); o.y = pk2(acc[2], acc[3]);
        *(LAS u32x2*)(Sw + (16 * c + fr) * LDN + 16 * kt + 4 * fq) = o; } }
    LBAR();
    { f32x4 o1 = mma16(frag_tr(Vs, LDP, 0, 16 * vt, lane), frag_tr(Pt, LDP, 0, 16 * it, lane), (f32x4){0.f, 0.f, 0.f, 0.f});
      float o0 = o1[0] + o2[0], o1v = o1[1] + o2[1], o2v = o1[2] + o2[2], o3 = o1[3] + o2[3];
      if (!first) { const unsigned long long pv = ppv; const unsigned lo = (unsigned)pv, hi = (unsigned)(pv >> 32); o0 += bflo(lo); o1v += bfhi(lo); o2v += bflo(hi); o3 += bfhi(hi); }
      u32x2 o; o.x = pk2(o0, o1v); o.y = pk2(o2v, o3); *(u32x2*)op = o; }
    LBAR();
  }
}

__device__ __forceinline__ void gdn_chain_wg(const Params& P, const Ctx& C, int task) {
  const int b = task >> 5, h = (task >> 2) & 7, vs = task & 3;
  const int d = C.wave >> 2, w = C.wave & 3, td = C.tid & 255, lane = C.lane, fr = lane & 15, fq = lane >> 4;
  constexpr int LDN = 136, LDP = 40, LDT = 24;
  constexpr int DIRSZ = 72 * 1024;
  LAS unsigned char* L = C.lds + d * DIRSZ;
  LAS bf16_t* Qs = (LAS bf16_t*)L;
  LAS bf16_t* Ks = Qs + 32 * LDN;
  LAS bf16_t* Vs = Ks + 32 * LDN;
  LAS bf16_t* Mt = Vs + 32 * LDP;
  LAS bf16_t* At = Mt + 32 * LDP;
  LAS bf16_t* Tt = At + 32 * LDP;
  LAS bf16_t* Xt = Tt + 2 * 32 * LDT;
  LAS bf16_t* Rt = Xt + 160 * LDP;
  LAS bf16_t* Vn = Rt + 4 * 16 * LDP;
  LAS bf16_t* Vw = Vn + 32 * LDP;
  LAS bf16_t* St = Vw + 32 * LDP;
  LAS float* Md = (LAS float*)(St + 2 * 32 * LDN);
  LAS float* gL = Md + 2 * 256;
  LAS float* bL = gL + 32;
  const bf16_t* Z = WS(OFF_Z1, bf16_t); bf16_t* MIX = WS(OFF_MIX1, bf16_t); const float* DT = WS(OFF_DT, float);
  const float Aneg = -__expf(GIN(I_GALOG)[d * 8 + h]), dtb = GIN(I_GDTB)[d * 8 + h];
  const int colq = Z1_Q + h * 128, colk = Z1_K + h * 128, colv = Z1_V + h * 128 + vs * 32, outc = h * 128 + vs * 32;
  __syncthreads();
  for (int i = td; i < 71 * 1024 / 4; i += 256) ((LAS unsigned*)L)[i] = 0u;
  f32x4 Sacc[2][2];
#pragma unroll
  for (int a = 0; a < 2; ++a)
#pragma unroll
    for (int c = 0; c < 2; ++c) Sacc[a][c] = (f32x4){0.f, 0.f, 0.f, 0.f};
  const int st_t = td >> 3, st_s = td & 7;
  u32x4 rq[2], rk[2]; u32x2 rv; float ra = 0.f, rb = 0.f;
  auto issue_loads = [&](int step) {
    const int chunk = seq_chunk32(d, step); const size_t row = (size_t)b * TB + chunk * 32 + st_t;
    const u32x4* pq = (const u32x4*)(Z + row * Z1W + colq + st_s * 16); const u32x4* pk = (const u32x4*)(Z + row * Z1W + colk + st_s * 16);
    rq[0] = pq[0]; rq[1] = pq[1]; rk[0] = pk[0]; rk[1] = pk[1];
    rv = *(const u32x2*)(Z + row * Z1W + colv + st_s * 4);
    if (st_s == 0) { rb = DT[row * 32 + d * 8 + h]; ra = DT[row * 32 + 16 + d * 8 + h]; }
  };
  issue_loads(0);
  __syncthreads();
  LAS bf16_t* Rw = Rt + w * 16 * LDP;
  for (int step = 0; step < 264; ++step) {
    const int chunk = seq_chunk32(d, step); const int row0 = b * TB + chunk * 32;
    VMWAIT();
    { const int si = d ? 31 - st_t : st_t;
      LAS u32x4* dq = (LAS u32x4*)(Qs + si * LDN + st_s * 16); LAS u32x4* dk = (LAS u32x4*)(Ks + si * LDN + st_s * 16);
      dq[0] = rq[0]; dq[1] = rq[1]; dk[0] = rk[0]; dk[1] = rk[1];
      *(LAS u32x2*)(Vs + si * LDP + st_s * 4) = rv;
      if (st_s == 0) { gL[si] = Aneg * softplusf_(ra + dtb); bL[si] = sigmoidf_(rb); } }
    LBAR();
    if (step + 1 < 264) issue_loads(step + 1);
    const bool first = (d == 0) == fwd_first32(chunk);
    bf16_t* op; unsigned long long ppv = 0ull;
    { const int ii = 16 * (w >> 1) + fr; const int t = d ? 31 - ii : ii; op = MIX + (size_t)(row0 + t) * MIXW + outc + 16 * (w & 1) + 4 * fq; if (!first) ppv = ld_agent_u64(op); }
    const float cum = wave_incl_scan(lane < 32 ? gL[lane] : 0.f, lane);
    const float cum_last = __shfl(cum, 31);
    const LAS bf16_t* Sr = St + (step & 1) * 32 * LDN; LAS bf16_t* Sw = St + ((step + 1) & 1) * 32 * LDN;
    const int vt = w & 1, it = w >> 1;
    for (int job = w; job < 6; job += 4) {
      const int isq = job >= 3, tj = job - 3 * isq; const int I = tj >= 1 ? 1 : 0, J = tj == 2 ? 1 : 0;
      const LAS bf16_t* A = isq ? Qs : Ks;
      f32x4 acc = (f32x4){0.f, 0.f, 0.f, 0.f};
#pragma unroll
      for (int k = 0; k < 4; ++k) acc = mma16(frag_row(A, LDN, 16 * I, 32 * k, lane), frag_row(Ks, LDN, 16 * J, 32 * k, lane), acc);
      const int jj = 16 * J + fr; const float cj = __shfl(cum, jj); float pv[4];
#pragma unroll
      for (int r = 0; r < 4; ++r) { const int ii = 16 * I + 4 * fq + r; const float ci = __shfl(cum, ii); const float dec = __expf(ci - cj);
        if (isq) pv[r] = (jj <= ii) ? acc[r] * dec : 0.f;
        else { pv[r] = (jj < ii) ? acc[r] * dec * bL[ii] : 0.f; if (I == J) Md[I * 256 + (4 * fq + r) * 16 + fr] = pv[r]; } }
      u32x2 o; o.x = pk2(pv[0], pv[1]); o.y = pk2(pv[2], pv[3]);
      *(LAS u32x2*)((isq ? At : Mt) + jj * LDP + 16 * I + 4 * fq) = o;
    }
    f32x4 o2 = (f32x4){0.f, 0.f, 0.f, 0.f};
#pragma unroll
    for (int k = 0; k < 4; ++k) o2 = mma16(frag_row(Sr, LDN, 16 * vt, 32 * k, lane), frag_row(Qs, LDN, 16 * it, 32 * k, lane), o2);
    LBAR();
    if (w < 2) { const LAS float* M = Md + w * 256; const int c = lane & 15;
      float m[16];
#pragma unroll
      for (int q4 = 0; q4 < 4; ++q4) { const f32x4 t4 = *(const LAS f32x4*)(M + c * 16 + 4 * q4); m[4 * q4] = t4[0]; m[4 * q4 + 1] = t4[1]; m[4 * q4 + 2] = t4[2]; m[4 * q4 + 3] = t4[3]; }
      float T[16];
#pragma unroll
      for (int r = 0; r < 16; ++r) { float v = (r == c) ? 1.f : 0.f;
#pragma unroll
        for (int s2 = 0; s2 < r; ++s2) v -= __builtin_bit_cast(float, __builtin_amdgcn_readlane(__builtin_bit_cast(int, m[s2]), r)) * T[s2];
        T[r] = v; }
      if (lane < 16) { LAS u32x4* dst = (LAS u32x4*)(Tt + w * 32 * LDT + c * LDT);
        dst[0] = (u32x4){pk2(T[0], T[1]), pk2(T[2], T[3]), pk2(T[4], T[5]), pk2(T[6], T[7])};
        dst[1] = (u32x4){pk2(T[8], T[9]), pk2(T[10], T[11]), pk2(T[12], T[13]), pk2(T[14], T[15])}; } }
    LBAR();
    for (int ct = w; ct < 10; ct += 4) {
      const int cc = 16 * ct + fr;
      f32x4 rhs;
#pragma unroll
      for (int r = 0; r < 4; ++r) { const int ii = 4 * fq + r; const float bi = bL[ii];
        rhs[r] = ct < 2 ? bi * bf2f(Vs[ii * LDP + cc]) : bi * __expf(__shfl(cum, ii)) * bf2f(Ks[ii * LDN + cc - 32]); }
      { u32x2 o; o.x = pk2(rhs[0], rhs[1]); o.y = pk2(rhs[2], rhs[3]); *(LAS u32x2*)(Rw + fr * LDP + 4 * fq) = o; }
      asm volatile("s_waitcnt lgkmcnt(0)" ::: "memory");
      f32x4 x0 = mma16(frag_tr(Tt, LDT, 0, 0, lane), frag_row(Rw, LDP, 0, 0, lane), (f32x4){0.f, 0.f, 0.f, 0.f});
      { u32x2 o; o.x = pk2(x0[0], x0[1]); o.y = pk2(x0[2], x0[3]); *(LAS u32x2*)(Xt + cc * LDP + 4 * fq) = o; }
#pragma unroll
      for (int r = 0; r < 4; ++r) { const int ii = 16 + 4 * fq + r; const float bi = bL[ii];
        rhs[r] = ct < 2 ? bi * bf2f(Vs[ii * LDP + cc]) : bi * __expf(__shfl(cum, ii)) * bf2f(Ks[ii * LDN + cc - 32]); }
      asm volatile("s_waitcnt lgkmcnt(0)" ::: "memory");
      { bf16x8 fa = frag_tr(Mt, LDP, 0, 16, lane); if (fq >= 2) fa = (bf16x8){0, 0, 0, 0, 0, 0, 0, 0};
        bf16x8 fb = frag_row(Xt, LDP, 16 * ct, 0, lane); if (fq >= 2) fb = (bf16x8){0, 0, 0, 0, 0, 0, 0, 0};
        const f32x4 corr = mma16(fa, fb, (f32x4){0.f, 0.f, 0.f, 0.f});
        rhs = rhs - corr; }
      { u32x2 o; o.x = pk2(rhs[0], rhs[1]); o.y = pk2(rhs[2], rhs[3]); *(LAS u32x2*)(Rw + fr * LDP + 4 * fq) = o; }
      asm volatile("s_waitcnt lgkmcnt(0)" ::: "memory");
      f32x4 x1 = mma16(frag_tr(Tt + 32 * LDT, LDT, 0, 0, lane), frag_row(Rw, LDP, 0, 0, lane), (f32x4){0.f, 0.f, 0.f, 0.f});
      { u32x2 o; o.x = pk2(x1[0], x1[1]); o.y = pk2(x1[2], x1[3]); *(LAS u32x2*)(Xt + cc * LDP + 16 + 4 * fq) = o; }
    }
    LBAR();
    { f32x4 ws = (f32x4){0.f, 0.f, 0.f, 0.f};
#pragma unroll
      for (int k = 0; k < 4; ++k) ws = mma16(frag_tr(Xt + 32 * LDP, LDP, 32 * k, 16 * it, lane), frag_row(Sr, LDN, 16 * vt, 32 * k, lane), ws);
      const u32x2 uu = *(const LAS u32x2*)(Xt + (16 * vt + fr) * LDP + 16 * it + 4 * fq);
      float vn[4] = {bflo(uu.x) - ws[0], bfhi(uu.x) - ws[1], bflo(uu.y) - ws[2], bfhi(uu.y) - ws[3]};
      float vw[4];
#pragma unroll
      for (int r = 0; r < 4; ++r) vw[r] = vn[r] * __expf(cum_last - __shfl(cum, 16 * it + 4 * fq + r));
      u32x2 o; o.x = pk2(vn[0], vn[1]); o.y = pk2(vn[2], vn[3]); *(LAS u32x2*)(Vn + (16 * vt + fr) * LDP + 16 * it + 4 * fq) = o;
      o.x = pk2(vw[0], vw[1]); o.y = pk2(vw[2], vw[3]); *(LAS u32x2*)(Vw + (16 * vt + fr) * LDP + 16 * it + 4 * fq) = o; }
    LBAR();
    { const f32x4 o1 = mma16(frag_row(Vn, LDP, 16 * vt, 0, lane), frag_tr(At, LDP, 0, 16 * it, lane), (f32x4){0.f, 0.f, 0.f, 0.f});
      const int ii = 16 * it + fr; const float eci = __expf(__shfl(cum, ii));
      float o0 = o1[0] + eci * o2[0], o1v = o1[1] + eci * o2[1], o2v = o1[2] + eci * o2[2], o3 = o1[3] + eci * o2[3];
      if (!first) { const unsigned long long pv = ppv; const unsigned lo = (unsigned)pv, hi = (unsigned)(pv >> 32); o0 += bflo(lo); o1v += bfhi(lo); o2v += bflo(hi); o3 += bfhi(hi); }
      u32x2 o; o.x = pk2(o0, o1v); o.y = pk2(o2v, o3); *(u32x2*)op = o; }
    { const float el = __expf(cum_last);
#pragma unroll
      for (int a = 0; a < 2; ++a) { const int kt = 2 * w + a; const bf16x8 fa = frag_tr(Ks, LDN, 0, 16 * kt, lane);
#pragma unroll
        for (int c = 0; c < 2; ++c) { f32x4 acc = mma16(fa, frag_row(Vw, LDP, 16 * c, 0, lane), Sacc[a][c] * el);
          Sacc[a][c] = acc;
          u32x2 o; o.x = pk2(acc[0], acc[1]); o.y = pk2(acc[2], acc[3]);
          *(LAS u32x2*)(Sw + (16 * c + fr) * LDN + 16 * kt + 4 * fq) = o; } } }
    LBAR();
  }
}

__device__ __forceinline__ bf16x8 ldfr(const LAS bf16_t* p) { return *(const LAS bf16x8*)p; }
__device__ __forceinline__ bf16x8 ldft(const LAS bf16_t* p, int ld) {
  const s16x4 v0 = __builtin_amdgcn_ds_read_tr16_b64_v4i16((LAS s16x4*)p);
  const s16x4 v1 = __builtin_amdgcn_ds_read_tr16_b64_v4i16((LAS s16x4*)(p + 4 * ld));
  bf16x8 r; r[0] = v0[0]; r[1] = v0[1]; r[2] = v0[2]; r[3] = v0[3]; r[4] = v1[0]; r[5] = v1[1]; r[6] = v1[2]; r[7] = v1[3];
  return r;
}
__device__ __forceinline__ u32x2 pk4(float a, float b, float c, float dd) { u32x2 o; o.x = pg8::cvt_pk_bf16(a, b); o.y = pg8::cvt_pk_bf16(c, dd); return o; }
__device__ __forceinline__ float bcast_lane(float v, int l) { return __builtin_bit_cast(float, __builtin_amdgcn_readlane(__builtin_bit_cast(int, v), l)); }

__device__ __forceinline__ void gdn2_chain_wg(const Params& P, const Ctx& C, int task) {
  const int b = task >> 5, h = (task >> 2) & 7, vs = task & 3;
  const int d = C.wave >> 2, w = ((C.wave & 3) + 2 * d) & 3, td = C.tid & 255, lane = C.lane, fr = lane & 15, fq = lane >> 4;
  constexpr int LDN = 136, LDP = 40, LDT = 24;
  constexpr int DIRSZ = 64 * 1024;
  LAS unsigned char* L = C.lds + d * DIRSZ;
  LAS bf16_t* Qs = (LAS bf16_t*)L;
  LAS bf16_t* Ks = Qs + 32 * LDN;
  LAS bf16_t* Vt = Ks + 32 * LDN;
  LAS bf16_t* Mt = Vt + 32 * LDP;
  LAS bf16_t* At = Mt + 32 * LDP;
  LAS bf16_t* Rt = At + 32 * LDP;
  LAS bf16_t* Vn = Rt + 32 * LDP;
  LAS bf16_t* Vw = Vn + 32 * LDP;
  LAS bf16_t* Tt = Vw + 32 * LDP;
  LAS bf16_t* St = Tt + 2 * 32 * LDT;
  LAS float* Md = (LAS float*)(St + 2 * 32 * LDN);
  LAS float* gL = Md + 512;
  LAS float* bL = gL + 32; LAS float* becL = bL;
  LAS float* ecL = bL + 32 + (C.wave & 3) * 96; LAS float* encL = ecL + 32; LAS float* ewL = encL + 32;
  const bf16_t* Z = WS(OFF_Z1, bf16_t); bf16_t* MIX = WS(OFF_MIX1, bf16_t); const float* DT = WS(OFF_DT, float);
  const float Aneg = -__expf(GIN(I_GALOG)[d * 8 + h]), dtb = GIN(I_GDTB)[d * 8 + h];
  const int colq = Z1_Q + h * 128, colk = Z1_K + h * 128, colv = Z1_V + h * 128 + vs * 32, outc = h * 128 + vs * 32;
  __syncthreads();
  for (int i = td; i < 58 * 1024 / 4; i += 256) ((LAS unsigned*)L)[i] = 0u;
  f32x4 Sacc[2][2];
#pragma unroll
  for (int a = 0; a < 2; ++a)
#pragma unroll
    for (int c = 0; c < 2; ++c) Sacc[a][c] = (f32x4){0.f, 0.f, 0.f, 0.f};
  const int st_t = td >> 3, st_s = td & 7;
  u32x4 rq[2], rk[2]; u32x2 rv; float ra = 0.f, rb = 0.f;
  auto issue_loads = [&](int step) {
    const int chunk = seq_chunk32(d, step); const size_t row = (size_t)b * TB + chunk * 32 + st_t;
    const u32x4* pq = (const u32x4*)(Z + row * Z1W + colq + st_s * 16); const u32x4* pk = (const u32x4*)(Z + row * Z1W + colk + st_s * 16);
    rq[0] = pq[0]; rq[1] = pq[1]; rk[0] = pk[0]; rk[1] = pk[1];
    rv = *(const u32x2*)(Z + row * Z1W + colv + st_s * 4);
    if (st_s == 0) { rb = DT[row * 32 + d * 8 + h]; ra = DT[row * 32 + 16 + d * 8 + h]; }
  };
  issue_loads(0);
  __syncthreads();
  const int rL136 = fr * LDN + 8 * fq, rL40 = fr * LDP + 8 * fq;
  const int tq = fr >> 2, tp = fr & 3;
  const int tL136 = (8 * fq + tq) * LDN + 4 * tp, tL40 = (8 * fq + tq) * LDP + 4 * tp, tL24 = (8 * fq + tq) * LDT + 4 * tp;
  const int it = w >> 1, vt = w & 1;
  const int si = d ? 31 - st_t : st_t;
  LAS u32x4* stq = (LAS u32x4*)(Qs + si * LDN + st_s * 16); LAS u32x4* stk = (LAS u32x4*)(Ks + si * LDN + st_s * 16);
  LAS bf16_t* stv = Vt + (st_s * 4) * LDP + si;
  const LAS bf16_t* pK_it = Ks + 16 * it * LDN + rL136; const LAS bf16_t* pQ_it = Qs + 16 * it * LDN + rL136;
  for (int step = 0; step < 264; ++step) {
    const int chunk = seq_chunk32(d, step); const int row0 = b * TB + chunk * 32;
    VMWAIT();
    stq[0] = rq[0]; stq[1] = rq[1]; stk[0] = rk[0]; stk[1] = rk[1];
    stv[0] = (bf16_t)(rv.x & 0xffffu); stv[LDP] = (bf16_t)(rv.x >> 16); stv[2 * LDP] = (bf16_t)(rv.y & 0xffffu); stv[3 * LDP] = (bf16_t)(rv.y >> 16);
    if (st_s == 0) { gL[si] = Aneg * softplusf_(ra + dtb); bL[si] = fast_sigmoid(rb); }
    LBAR();
    if (step + 1 < 264) issue_loads(step + 1);
    const bool first = (d == 0) == fwd_first32(chunk);
    bf16_t* op; unsigned long long ppv = 0ull;
    { const int ii = 16 * it + fr; const int t = d ? 31 - ii : ii; op = MIX + (size_t)(row0 + t) * MIXW + outc + 16 * vt + 4 * fq; if (!first) ppv = ld_agent_u64(op); }
    float elast;
    { const float c = wave_incl_scan(lane < 32 ? gL[lane & 31] : 0.f, lane); const float cl = bcast_lane(c, 31); elast = __expf(cl);
      if (lane < 32) { const float ec = __expf(c); ecL[lane] = ec; encL[lane] = c; ewL[lane] = __expf(cl - c); } }
    asm volatile("s_waitcnt lgkmcnt(0)" ::: "memory");
    const LAS bf16_t* Sr = St + (step & 1) * 32 * LDN; LAS bf16_t* Sw = St + ((step + 1) & 1) * 32 * LDN;
    f32x4 o2 = (f32x4){0.f, 0.f, 0.f, 0.f};
    { f32x4 ks = (f32x4){0.f, 0.f, 0.f, 0.f};
      const LAS bf16_t* pS = Sr + 16 * vt * LDN + rL136;
#pragma unroll
      for (int k = 0; k < 4; ++k) { const bf16x8 fs = ldfr(pS + 32 * k); ks = mma16(ldfr(pK_it + 32 * k), fs, ks); o2 = mma16(fs, ldfr(pQ_it + 32 * k), o2); }
      const u32x2 vv = *(const LAS u32x2*)(Vt + (16 * vt + fr) * LDP + 16 * it + 4 * fq);
      const f32x4 ec4 = *(const LAS f32x4*)(ecL + 16 * it + 4 * fq), b4 = *(const LAS f32x4*)(bL + 16 * it + 4 * fq);
      *(LAS u32x2*)(Rt + (16 * vt + fr) * LDP + 16 * it + 4 * fq) =
        pk4(b4[0] * (bflo(vv.x) - ec4[0] * ks[0]), b4[1] * (bfhi(vv.x) - ec4[1] * ks[1]), b4[2] * (bflo(vv.y) - ec4[2] * ks[2]), b4[3] * (bfhi(vv.y) - ec4[3] * ks[3])); }
    { const int isq = w & 1; const LAS bf16_t* A = isq ? Qs : Ks;
      const int njobs = w < 2 ? 1 : 2;
      for (int jb = 0; jb < njobs; ++jb) {
        const int I = (w < 2) ? 1 : jb, J = (w < 2) ? 1 : 0;
        f32x4 acc = (f32x4){0.f, 0.f, 0.f, 0.f};
        const LAS bf16_t* pa = A + 16 * I * LDN + rL136; const LAS bf16_t* pb = Ks + 16 * J * LDN + rL136;
#pragma unroll
        for (int k = 0; k < 4; ++k) acc = mma16(ldfr(pa + 32 * k), ldfr(pb + 32 * k), acc);
        const int jj = 16 * J + fr, i0 = 16 * I + 4 * fq; const float cj = encL[jj];
        const f32x4 c4 = *(const LAS f32x4*)(encL + i0); const f32x4 b4 = *(const LAS f32x4*)(becL + i0);
        float pv[4];
#pragma unroll
        for (int r = 0; r < 4; ++r) { const bool keep = isq ? (jj <= i0 + r) : (jj < i0 + r); const float sc = isq ? 1.f : b4[r];
          pv[r] = keep ? acc[r] * sc * __expf(c4[r] - cj) : 0.f; }
        if (!isq && I == J) { LAS float* md = Md + I * 256 + (4 * fq) * 16 + fr; md[0] = pv[0]; md[16] = pv[1]; md[32] = pv[2]; md[48] = pv[3]; }
        *(LAS u32x2*)((isq ? At : Mt) + jj * LDP + i0) = pk4(pv[0], pv[1], pv[2], pv[3]);
      } }
    LBAR();
    if (w < 2) { const LAS float* M = Md + w * 256; const int c = fr;
      float m[16];
#pragma unroll
      for (int q4 = 0; q4 < 4; ++q4) { const f32x4 t4 = *(const LAS f32x4*)(M + c * 16 + 4 * q4); m[4 * q4] = t4[0]; m[4 * q4 + 1] = t4[1]; m[4 * q4 + 2] = t4[2]; m[4 * q4 + 3] = t4[3]; }
      float T[16];
#pragma unroll
      for (int r = 0; r < 16; ++r) { float v = (r == c) ? 1.f : 0.f;
#pragma unroll
        for (int s2 = 0; s2 < r; ++s2) v -= bcast_lane(m[s2], r) * T[s2];
        T[r] = v; }
      if (lane < 16) { LAS u32x4* dst = (LAS u32x4*)(Tt + w * 32 * LDT + c * LDT);
        dst[0] = (u32x4){pg8::cvt_pk_bf16(T[0], T[1]), pg8::cvt_pk_bf16(T[2], T[3]), pg8::cvt_pk_bf16(T[4], T[5]), pg8::cvt_pk_bf16(T[6], T[7])};
        dst[1] = (u32x4){pg8::cvt_pk_bf16(T[8], T[9]), pg8::cvt_pk_bf16(T[10], T[11]), pg8::cvt_pk_bf16(T[12], T[13]), pg8::cvt_pk_bf16(T[14], T[15])}; } }
    LBAR();
    if (w < 2) { const int ct = w; const int cc = 16 * ct + fr;
      const f32x4 x0 = mma16(ldft(Tt + tL24, LDT), ldfr(Rt + 16 * ct * LDP + rL40), (f32x4){0.f, 0.f, 0.f, 0.f});
      const f32x4 ew0 = *(const LAS f32x4*)(ewL + 4 * fq);
      *(LAS u32x2*)(Vn + cc * LDP + 4 * fq) = pk4(x0[0], x0[1], x0[2], x0[3]);
      *(LAS u32x2*)(Vw + cc * LDP + 4 * fq) = pk4(x0[0] * ew0[0], x0[1] * ew0[1], x0[2] * ew0[2], x0[3] * ew0[3]);
      const u32x2 r1 = *(const LAS u32x2*)(Rt + cc * LDP + 16 + 4 * fq);
      asm volatile("s_waitcnt lgkmcnt(0)" ::: "memory");
      bf16x8 fa = ldft(Mt + tL40 + 16, LDP); bf16x8 fb = ldfr(Vn + 16 * ct * LDP + rL40);
      if (fq >= 2) { fa = (bf16x8){0, 0, 0, 0, 0, 0, 0, 0}; fb = (bf16x8){0, 0, 0, 0, 0, 0, 0, 0}; }
      const f32x4 corr = mma16(fa, fb, (f32x4){0.f, 0.f, 0.f, 0.f});
      *(LAS u32x2*)(Rt + cc * LDP + 16 + 4 * fq) = pk4(bflo(r1.x) - corr[0], bfhi(r1.x) - corr[1], bflo(r1.y) - corr[2], bfhi(r1.y) - corr[3]);
      asm volatile("s_waitcnt lgkmcnt(0)" ::: "memory");
      const f32x4 x1 = mma16(ldft(Tt + 32 * LDT + tL24, LDT), ldfr(Rt + 16 * ct * LDP + 16 + rL40), (f32x4){0.f, 0.f, 0.f, 0.f});
      const f32x4 ew1 = *(const LAS f32x4*)(ewL + 16 + 4 * fq);
      *(LAS u32x2*)(Vn + cc * LDP + 16 + 4 * fq) = pk4(x1[0], x1[1], x1[2], x1[3]);
      *(LAS u32x2*)(Vw + cc * LDP + 16 + 4 * fq) = pk4(x1[0] * ew1[0], x1[1] * ew1[1], x1[2] * ew1[2], x1[3] * ew1[3]); }
    LBAR();
    { const f32x4 o1 = mma16(ldfr(Vn + 16 * vt * LDP + rL40), ldft(At + tL40 + 16 * it, LDP), (f32x4){0.f, 0.f, 0.f, 0.f});
      const float eci = ecL[16 * it + fr];
      float o0 = o1[0] + eci * o2[0], o1v = o1[1] + eci * o2[1], o2v = o1[2] + eci * o2[2], o3 = o1[3] + eci * o2[3];
      if (!first) { const unsigned lo = (unsigned)ppv, hi = (unsigned)(ppv >> 32); o0 += bflo(lo); o1v += bfhi(lo); o2v += bflo(hi); o3 += bfhi(hi); }
      *(u32x2*)op = pk4(o0, o1v, o2v, o3); }
    { const bf16x8 fv0 = ldfr(Vw + rL40), fv1 = ldfr(Vw + 16 * LDP + rL40);
#pragma unroll
      for (int a = 0; a < 2; ++a) { const int kt = 2 * w + a; const bf16x8 fa = ldft(Ks + tL136 + 16 * kt, LDN);
        f32x4 a0 = mma16(fa, fv0, Sacc[a][0] * elast), a1 = mma16(fa, fv1, Sacc[a][1] * elast);
        Sacc[a][0] = a0; Sacc[a][1] = a1;
        *(LAS u32x2*)(Sw + fr * LDN + 16 * kt + 4 * fq) = pk4(a0[0], a0[1], a0[2], a0[3]);
        *(LAS u32x2*)(Sw + (16 + fr) * LDN + 16 * kt + 4 * fq) = pk4(a1[0], a1[1], a1[2], a1[3]); } }
    LBAR();
  }
}

__device__ __forceinline__ void gdn3_chain_wg(const Params& P, const Ctx& C, int task) {
  const int b = task >> 5, h = (task >> 2) & 7, vs = task & 3;
  const int d = C.wave >> 2, w = ((C.wave & 3) + 2 * d) & 3, td = C.tid & 255, lane = C.lane, fr = lane & 15, fq = lane >> 4;
  constexpr int LDN = 136, LDP = 40, LDT = 24;
  constexpr int DIRSZ = 64 * 1024;
  LAS unsigned char* L = C.lds + d * DIRSZ;
  LAS bf16_t* Qs = (LAS bf16_t*)L;
  LAS bf16_t* Ks = Qs + 32 * LDN;
  LAS bf16_t* Vt = Ks + 32 * LDN;
  LAS bf16_t* Mt = Vt + 32 * LDP;
  LAS bf16_t* At = Mt + 32 * LDP;
  LAS bf16_t* Rt = At + 32 * LDP;
  LAS bf16_t* Vn = Rt + 32 * LDP;
  LAS bf16_t* Vw = Vn + 32 * LDP;
  LAS bf16_t* Tt = Vw + 32 * LDP;
  LAS bf16_t* St = Tt + 2 * 32 * LDT;
  LAS float* Md = (LAS float*)(St + 2 * 32 * LDN);
  LAS float* gL = Md + 512;
  LAS float* bL = gL + 32; LAS float* becL = bL;
  LAS float* ecL = bL + 32 + (C.wave & 3) * 96; LAS float* encL = ecL + 32; LAS float* ewL = encL + 32;
  LAS f32x4* O2x = (LAS f32x4*)(bL + 32 + 4 * 96);
  const bf16_t* Z = WS(OFF_Z1, bf16_t); bf16_t* MIX = WS(OFF_MIX1, bf16_t); const float* DT = WS(OFF_DT, float);
  const float Aneg = -__expf(GIN(I_GALOG)[d * 8 + h]), dtb = GIN(I_GDTB)[d * 8 + h];
  const int colq = Z1_Q + h * 128, colk = Z1_K + h * 128, colv = Z1_V + h * 128 + vs * 32, outc = h * 128 + vs * 32;
  __syncthreads();
  for (int i = td; i < 60 * 1024 / 4; i += 256) ((LAS unsigned*)L)[i] = 0u;
  f32x4 Sacc[2][2];
#pragma unroll
  for (int a = 0; a < 2; ++a)
#pragma unroll
    for (int c = 0; c < 2; ++c) Sacc[a][c] = (f32x4){0.f, 0.f, 0.f, 0.f};
  const int st_t = td >> 3, st_s = td & 7;
  u32x4 rq[2], rk[2]; u32x2 rv; float ra = 0.f, rb = 0.f;
  auto issue_loads = [&](int step) {
    const int chunk = seq_chunk32(d, step); const size_t row = (size_t)b * TB + chunk * 32 + st_t;
    const u32x4* pq = (const u32x4*)(Z + row * Z1W + colq + st_s * 16); const u32x4* pk = (const u32x4*)(Z + row * Z1W + colk + st_s * 16);
    rq[0] = pq[0]; rq[1] = pq[1]; rk[0] = pk[0]; rk[1] = pk[1];
    rv = *(const u32x2*)(Z + row * Z1W + colv + st_s * 4);
    if (st_s == 0) { rb = DT[row * 32 + d * 8 + h]; ra = DT[row * 32 + 16 + d * 8 + h]; }
  };
  issue_loads(0);
  __syncthreads();
  const int rL136 = fr * LDN + 8 * fq, rL40 = fr * LDP + 8 * fq;
  const int tq = fr >> 2, tp = fr & 3;
  const int tL136 = (8 * fq + tq) * LDN + 4 * tp, tL40 = (8 * fq + tq) * LDP + 4 * tp, tL24 = (8 * fq + tq) * LDT + 4 * tp;
  const int it = w >> 1, vt = w & 1;
  const int si = d ? 31 - st_t : st_t;
  LAS u32x4* stq = (LAS u32x4*)(Qs + si * LDN + st_s * 16); LAS u32x4* stk = (LAS u32x4*)(Ks + si * LDN + st_s * 16);
  LAS bf16_t* stv = Vt + (st_s * 4) * LDP + si;
  const LAS bf16_t* pK_it = Ks + 16 * it * LDN + rL136; const LAS bf16_t* pQ_it = Qs + 16 * it * LDN + rL136;
  for (int step = 0; step < 264; ++step) {
    const int chunk = seq_chunk32(d, step); const int row0 = b * TB + chunk * 32;
    VMWAIT();
    stq[0] = rq[0]; stq[1] = rq[1]; stk[0] = rk[0]; stk[1] = rk[1];
    stv[0] = (bf16_t)(rv.x & 0xffffu); stv[LDP] = (bf16_t)(rv.x >> 16); stv[2 * LDP] = (bf16_t)(rv.y & 0xffffu); stv[3 * LDP] = (bf16_t)(rv.y >> 16);
    if (st_s == 0) { gL[si] = Aneg * softplusf_(ra + dtb); bL[si] = fast_sigmoid(rb); }
    LBAR();
    if (step + 1 < 264) issue_loads(step + 1);
    const bool first = (d == 0) == fwd_first32(chunk);
    bf16_t* op; unsigned long long ppv = 0ull;
    { const int ii = 16 * it + fr; const int t = d ? 31 - ii : ii; op = MIX + (size_t)(row0 + t) * MIXW + outc + 16 * vt + 4 * fq; if (!first) ppv = ld_agent_u64(op); }
    float elast;
    { const float c = wave_incl_scan(lane < 32 ? gL[lane & 31] : 0.f, lane); const float cl = bcast_lane(c, 31); elast = __expf(cl);
      if (lane < 32) { const float ec = __expf(c); ecL[lane] = ec; encL[lane] = c; ewL[lane] = __expf(cl - c); } }
    asm volatile("s_waitcnt lgkmcnt(0)" ::: "memory");
    const LAS bf16_t* Sr = St + (step & 1) * 32 * LDN; LAS bf16_t* Sw = St + ((step + 1) & 1) * 32 * LDN;
    f32x4 o2 = (f32x4){0.f, 0.f, 0.f, 0.f};
    if (w < 2) {
      f32x4 acc = (f32x4){0.f, 0.f, 0.f, 0.f};
      { const LAS bf16_t* pk = Ks + 16 * w * LDN + rL136;
#pragma unroll
        for (int k = 0; k < 4; ++k) { const bf16x8 f = ldfr(pk + 32 * k); acc = mma16(f, f, acc); } }
      { const int jj = 16 * w + fr, i0 = 16 * w + 4 * fq; const float cj = encL[jj];
        const f32x4 c4 = *(const LAS f32x4*)(encL + i0); const f32x4 b4 = *(const LAS f32x4*)(becL + i0);
        LAS float* md = Md + w * 256 + (4 * fq) * 16 + fr;
#pragma unroll
        for (int r = 0; r < 4; ++r) md[16 * r] = (jj < i0 + r) ? acc[r] * b4[r] * __expf(c4[r] - cj) : 0.f; }
      asm volatile("s_waitcnt lgkmcnt(0)" ::: "memory");
      const LAS float* M = Md + w * 256; const int c = fr;
      float m[16];
#pragma unroll
      for (int q4 = 0; q4 < 4; ++q4) { const f32x4 t4 = *(const LAS f32x4*)(M + c * 16 + 4 * q4); m[4 * q4] = t4[0]; m[4 * q4 + 1] = t4[1]; m[4 * q4 + 2] = t4[2]; m[4 * q4 + 3] = t4[3]; }
      float T[16];
#pragma unroll
      for (int r = 0; r < 16; ++r) { float v = (r == c) ? 1.f : 0.f;
#pragma unroll
        for (int s2 = 0; s2 < r; ++s2) v -= bcast_lane(m[s2], r) * T[s2];
        T[r] = v; }
      if (lane < 16) { LAS u32x4* dst = (LAS u32x4*)(Tt + w * 32 * LDT + c * LDT);
        dst[0] = (u32x4){pk2(T[0], T[1]), pk2(T[2], T[3]), pk2(T[4], T[5]), pk2(T[6], T[7])};
        dst[1] = (u32x4){pk2(T[8], T[9]), pk2(T[10], T[11]), pk2(T[12], T[13]), pk2(T[14], T[15])}; }
    } else {
      const int pvt = w & 1;
#pragma unroll
      for (int pit = 1; pit >= 0; --pit) {
        f32x4 ks = (f32x4){0.f, 0.f, 0.f, 0.f}, qs = (f32x4){0.f, 0.f, 0.f, 0.f};
        const LAS bf16_t* pS = Sr + 16 * pvt * LDN + rL136; const LAS bf16_t* pK = Ks + 16 * pit * LDN + rL136; const LAS bf16_t* pQ = Qs + 16 * pit * LDN + rL136;
#pragma unroll
        for (int k = 0; k < 4; ++k) { const bf16x8 fs = ldfr(pS + 32 * k); ks = mma16(ldfr(pK + 32 * k), fs, ks); qs = mma16(fs, ldfr(pQ + 32 * k), qs); }
        const u32x2 vv = *(const LAS u32x2*)(Vt + (16 * pvt + fr) * LDP + 16 * pit + 4 * fq);
        const f32x4 ec4 = *(const LAS f32x4*)(ecL + 16 * pit + 4 * fq), b4 = *(const LAS f32x4*)(bL + 16 * pit + 4 * fq);
        *(LAS u32x2*)(Rt + (16 * pvt + fr) * LDP + 16 * pit + 4 * fq) =
          pk4(b4[0] * (bflo(vv.x) - ec4[0] * ks[0]), b4[1] * (bfhi(vv.x) - ec4[1] * ks[1]), b4[2] * (bflo(vv.y) - ec4[2] * ks[2]), b4[3] * (bfhi(vv.y) - ec4[3] * ks[3]));
        if (pit == 1) o2 = qs; else O2x[pvt * 64 + lane] = qs;
      }
#pragma unroll
      for (int jb = 0; jb < 2; ++jb) {
        const bool isq = (w == 3) || (jb == 1);
        const int I = (w == 2) ? 1 : jb, J = (w == 2) ? 0 : jb;
        f32x4 acc = (f32x4){0.f, 0.f, 0.f, 0.f};
        const LAS bf16_t* pa = (isq ? Qs : Ks) + 16 * I * LDN + rL136; const LAS bf16_t* pb = Ks + 16 * J * LDN + rL136;
#pragma unroll
        for (int k = 0; k < 4; ++k) acc = mma16(ldfr(pa + 32 * k), ldfr(pb + 32 * k), acc);
        const int jj = 16 * J + fr, i0 = 16 * I + 4 * fq; const float cj = encL[jj];
        const f32x4 c4 = *(const LAS f32x4*)(encL + i0); const f32x4 b4 = *(const LAS f32x4*)(becL + i0);
        float pv[4];
#pragma unroll
        for (int r = 0; r < 4; ++r) { const bool keep = isq ? (jj <= i0 + r) : (jj < i0 + r); const float sc = isq ? 1.f : b4[r];
          pv[r] = keep ? acc[r] * sc * __expf(c4[r] - cj) : 0.f; }
        *(LAS u32x2*)((isq ? At : Mt) + jj * LDP + i0) = pk4(pv[0], pv[1], pv[2], pv[3]);
      }
    }
    LBAR();
    if (w < 2) { const int ct = w; const int cc = 16 * ct + fr;
      const f32x4 x0 = mma16(ldft(Tt + tL24, LDT), ldfr(Rt + 16 * ct * LDP + rL40), (f32x4){0.f, 0.f, 0.f, 0.f});
      const f32x4 ew0 = *(const LAS f32x4*)(ewL + 4 * fq);
      *(LAS u32x2*)(Vn + cc * LDP + 4 * fq) = pk4(x0[0], x0[1], x0[2], x0[3]);
      *(LAS u32x2*)(Vw + cc * LDP + 4 * fq) = pk4(x0[0] * ew0[0], x0[1] * ew0[1], x0[2] * ew0[2], x0[3] * ew0[3]);
      const u32x2 r1 = *(const LAS u32x2*)(Rt + cc * LDP + 16 + 4 * fq);
      asm volatile("s_waitcnt lgkmcnt(0)" ::: "memory");
      bf16x8 fa = ldft(Mt + tL40 + 16, LDP); bf16x8 fb = ldfr(Vn + 16 * ct * LDP + rL40);
      if (fq >= 2) { fa = (bf16x8){0, 0, 0, 0, 0, 0, 0, 0}; fb = (bf16x8){0, 0, 0, 0, 0, 0, 0, 0}; }
      const f32x4 corr = mma16(fa, fb, (f32x4){0.f, 0.f, 0.f, 0.f});
      *(LAS u32x2*)(Rt + cc * LDP + 16 + 4 * fq) = pk4(bflo(r1.x) - corr[0], bfhi(r1.x) - corr[1], bflo(r1.y) - corr[2], bfhi(r1.y) - corr[3]);
      asm volatile("s_waitcnt lgkmcnt(0)" ::: "memory");
      const f32x4 x1 = mma16(ldft(Tt + 32 * LDT + tL24, LDT), ldfr(Rt + 16 * ct * LDP + 16 + rL40), (f32x4){0.f, 0.f, 0.f, 0.f});
      const f32x4 ew1 = *(const LAS f32x4*)(ewL + 16 + 4 * fq);
      *(LAS u32x2*)(Vn + cc * LDP + 16 + 4 * fq) = pk4(x1[0], x1[1], x1[2], x1[3]);
      *(LAS u32x2*)(Vw + cc * LDP + 16 + 4 * fq) = pk4(x1[0] * ew1[0], x1[1] * ew1[1], x1[2] * ew1[2], x1[3] * ew1[3]); }
    LBAR();
    if (w < 2) o2 = O2x[w * 64 + lane];
    { const f32x4 o1 = mma16(ldfr(Vn + 16 * vt * LDP + rL40), ldft(At + tL40 + 16 * it, LDP), (f32x4){0.f, 0.f, 0.f, 0.f});
      const float eci = ecL[16 * it + fr];
      float o0 = o1[0] + eci * o2[0], o1v = o1[1] + eci * o2[1], o2v = o1[2] + eci * o2[2], o3 = o1[3] + eci * o2[3];
      if (!first) { const unsigned lo = (unsigned)ppv, hi = (unsigned)(ppv >> 32); o0 += bflo(lo); o1v += bfhi(lo); o2v += bflo(hi); o3 += bfhi(hi); }
      *(u32x2*)op = pk4(o0, o1v, o2v, o3); }
    { const bf16x8 fv0 = ldfr(Vw + rL40), fv1 = ldfr(Vw + 16 * LDP + rL40);
#pragma unroll
      for (int a = 0; a < 2; ++a) { const int kt = 2 * w + a; const bf16x8 fa = ldft(Ks + tL136 + 16 * kt, LDN);
        f32x4 a0 = mma16(fa, fv0, Sacc[a][0] * elast), a1 = mma16(fa, fv1, Sacc[a][1] * elast);
        Sacc[a][0] = a0; Sacc[a][1] = a1;
        *(LAS u32x2*)(Sw + fr * LDN + 16 * kt + 4 * fq) = pk4(a0[0], a0[1], a0[2], a0[3]);
        *(LAS u32x2*)(Sw + (16 + fr) * LDN + 16 * kt + 4 * fq) = pk4(a1[0], a1[1], a1[2], a1[3]); } }
    LBAR();
  }
}

__device__ __forceinline__ void hgrn2_chain_wg(const Params& P, const Ctx& C, int task) {
  const int b = task >> 5, h = (task >> 2) & 7, vs = task & 3;
  const int d = C.wave >> 2, w = C.wave & 3, td = C.tid & 255, lane = C.lane, fr = lane & 15, fq = lane >> 4;
  constexpr int LDN = 136, LDP = 40;
  constexpr int DIRSZ = 72 * 1024;
  LAS unsigned char* L = C.lds + d * DIRSZ;
  LAS bf16_t* Qt = (LAS bf16_t*)L;
  LAS bf16_t* Kh = Qt + 32 * LDN;
  LAS bf16_t* Kw = Kh + 32 * LDN;
  LAS bf16_t* Vs = Kw + 32 * LDN;
  LAS bf16_t* Pt = Vs + 32 * LDP;
  LAS bf16_t* St = Pt + 32 * LDP;
  LAS float* PR = (LAS float*)(St + 2 * 32 * LDN);
  LAS float* PL = PR + 32 * 128;
  const bf16_t* Z = WS(OFF_Z1, bf16_t); bf16_t* MIX = WS(OFF_MIX1, bf16_t);
  const int colq = Z1_HQ + h * 128, colf = Z1_HF + d * 1024 + h * 128, colv = Z1_HI + h * 128 + vs * 32, outc = 1024 + h * 128 + vs * 32;
  __syncthreads();
  for (int i = td; i < 32 * LDP / 2; i += 256) ((LAS unsigned*)Pt)[i] = 0u;
  for (int i = td; i < 2 * 32 * LDN / 2; i += 256) ((LAS unsigned*)St)[i] = 0u;
  f32x4 Sacc[2][2];
#pragma unroll
  for (int a = 0; a < 2; ++a)
#pragma unroll
    for (int c = 0; c < 2; ++c) Sacc[a][c] = (f32x4){0.f, 0.f, 0.f, 0.f};
  const int st_t = td >> 3, st_s = td & 7;
  float lbv[16];
#pragma unroll
  for (int e = 0; e < 16; ++e) lbv[e] = WS(OFF_LB1, float)[h * 128 + st_s * 16 + e];
  u32x4 rq[2], rf[2]; u32x2 rv;
  auto issue_loads = [&](int step) {
    const int chunk = seq_chunk32(d, step); const size_t row = (size_t)b * TB + chunk * 32 + st_t;
    const u32x4* pq = (const u32x4*)(Z + row * Z1W + colq + st_s * 16); const u32x4* pf = (const u32x4*)(Z + row * Z1W + colf + st_s * 16);
    rq[0] = pq[0]; rq[1] = pq[1]; rf[0] = pf[0]; rf[1] = pf[1];
    rv = *(const u32x2*)(Z + row * Z1W + colv + st_s * 4);
  };
  issue_loads(0);
  __syncthreads();
  const int rL136 = fr * LDN + 8 * fq;
  const int tq = fr >> 2, tp = fr & 3;
  const int tL136 = (8 * fq + tq) * LDN + 4 * tp, tL40 = (8 * fq + tq) * LDP + 4 * tp;
  const int vt = w & 1, it = w >> 1;
  const int si = d ? 31 - st_t : st_t;
  LAS float* prow = PR + si * 128 + st_s * 16;
  LAS float* pscan = PR + (td >> 7) * 16 * 128 + (td & 127);
  for (int step = 0; step < 264; ++step) {
    const int chunk = seq_chunk32(d, step); const int row0 = b * TB + chunk * 32;
    VMWAIT();
    float qv[16], kk[16];
    { const unsigned qw[8] = {rq[0].x, rq[0].y, rq[0].z, rq[0].w, rq[1].x, rq[1].y, rq[1].z, rq[1].w};
      const unsigned fw[8] = {rf[0].x, rf[0].y, rf[0].z, rf[0].w, rf[1].x, rf[1].y, rf[1].z, rf[1].w};
      f32x4 f4[4];
#pragma unroll
      for (int e = 0; e < 8; ++e) { qv[2 * e] = bflo(qw[e]); qv[2 * e + 1] = bfhi(qw[e]);
        const float k0 = (1.f - lbv[2 * e]) * (1.f - fast_sigmoid(bflo(fw[e]))), k1 = (1.f - lbv[2 * e + 1]) * (1.f - fast_sigmoid(bfhi(fw[e])));
        kk[2 * e] = k0; kk[2 * e + 1] = k1; f4[e >> 1][(2 * e) & 3] = 1.f - k0; f4[e >> 1][(2 * e + 1) & 3] = 1.f - k1; }
#pragma unroll
      for (int e = 0; e < 4; ++e) *(LAS f32x4*)(prow + 4 * e) = f4[e];
      *(LAS u32x2*)(Vs + si * LDP + st_s * 4) = rv; }
    LBAR();
    if (step + 1 < 264) issue_loads(step + 1);
    const bool first = (d == 0) == fwd_first32(chunk);
    bf16_t* op; unsigned long long ppv = 0ull;
    { const int ii = 16 * it + fr; const int t = d ? 31 - ii : ii; op = MIX + (size_t)(row0 + t) * MIXW + outc + 16 * vt + 4 * fq; if (!first) ppv = ld_agent_u64(op); }
    { float pv[16];
#pragma unroll
      for (int i = 0; i < 16; ++i) pv[i] = pscan[i * 128];
#pragma unroll
      for (int i = 1; i < 16; ++i) pv[i] *= pv[i - 1];
#pragma unroll
      for (int i = 0; i < 16; ++i) pscan[i * 128] = pv[i]; }
    LBAR();
    { const bool hi = si >= 16;
      unsigned oq[8], oh[8], ow[8];
#pragma unroll
      for (int e4 = 0; e4 < 4; ++e4) {
        f32x4 p = *(const LAS f32x4*)(prow + 4 * e4); const f32x4 p15 = *(const LAS f32x4*)(PR + 15 * 128 + st_s * 16 + 4 * e4), p31 = *(const LAS f32x4*)(PR + 31 * 128 + st_s * 16 + 4 * e4);
        const f32x4 pl = p15 * p31; if (hi) p = p * p15;
        if (si == 0) *(LAS f32x4*)(PL + st_s * 16 + 4 * e4) = pl;
        float q_[4], h_[4], w_[4];
#pragma unroll
        for (int r = 0; r < 4; ++r) { const int e = 4 * e4 + r; const float rp = __builtin_amdgcn_rcpf(fmaxf(p[r], 1e-30f)); q_[r] = qv[e] * p[r]; h_[r] = kk[e] * rp; w_[r] = h_[r] * pl[r]; }
        oq[2 * e4] = pk2(q_[0], q_[1]); oq[2 * e4 + 1] = pk2(q_[2], q_[3]); oh[2 * e4] = pk2(h_[0], h_[1]); oh[2 * e4 + 1] = pk2(h_[2], h_[3]); ow[2 * e4] = pk2(w_[0], w_[1]); ow[2 * e4 + 1] = pk2(w_[2], w_[3]); }
      LAS u32x4* dq = (LAS u32x4*)(Qt + si * LDN + st_s * 16); LAS u32x4* dh = (LAS u32x4*)(Kh + si * LDN + st_s * 16); LAS u32x4* dw = (LAS u32x4*)(Kw + si * LDN + st_s * 16);
      dq[0] = (u32x4){oq[0], oq[1], oq[2], oq[3]}; dq[1] = (u32x4){oq[4], oq[5], oq[6], oq[7]};
      dh[0] = (u32x4){oh[0], oh[1], oh[2], oh[3]}; dh[1] = (u32x4){oh[4], oh[5], oh[6], oh[7]};
      dw[0] = (u32x4){ow[0], ow[1], ow[2], ow[3]}; dw[1] = (u32x4){ow[4], ow[5], ow[6], ow[7]}; }
    LBAR();
    if (w < 3) { const int I = w >= 1 ? 1 : 0, J = w == 2 ? 1 : 0;
      f32x4 acc = (f32x4){0.f, 0.f, 0.f, 0.f};
      const LAS bf16_t* pa = Qt + 16 * I * LDN + rL136; const LAS bf16_t* pb = Kh + 16 * J * LDN + rL136;
#pragma unroll
      for (int k = 0; k < 4; ++k) acc = mma16(ldfr(pa + 32 * k), ldfr(pb + 32 * k), acc);
      const int jj = 16 * J + fr, i0 = 16 * I + 4 * fq;
      *(LAS u32x2*)(Pt + jj * LDP + i0) = pk4(jj <= i0 ? acc[0] : 0.f, jj <= i0 + 1 ? acc[1] : 0.f, jj <= i0 + 2 ? acc[2] : 0.f, jj <= i0 + 3 ? acc[3] : 0.f); }
    const LAS bf16_t* Sr = St + (step & 1) * 32 * LDN; LAS bf16_t* Sw = St + ((step + 1) & 1) * 32 * LDN;
    f32x4 o2 = (f32x4){0.f, 0.f, 0.f, 0.f};
    { const LAS bf16_t* ps = Sr + 16 * vt * LDN + rL136; const LAS bf16_t* pq = Qt + 16 * it * LDN + rL136;
#pragma unroll
      for (int k = 0; k < 4; ++k) o2 = mma16(ldfr(ps + 32 * k), ldfr(pq + 32 * k), o2); }
    { const bf16x8 fv0 = ldft(Vs + tL40, LDP), fv1 = ldft(Vs + tL40 + 16, LDP);
#pragma unroll
      for (int a = 0; a < 2; ++a) { const int kt = 2 * w + a; const f32x4 dec = *(const LAS f32x4*)(PL + 16 * kt + 4 * fq);
        const bf16x8 fa = ldft(Kw + tL136 + 16 * kt, LDN);
        const f32x4 a0 = mma16(fa, fv0, Sacc[a][0] * dec), a1 = mma16(fa, fv1, Sacc[a][1] * dec);
        Sacc[a][0] = a0; Sacc[a][1] = a1;
        *(LAS u32x2*)(Sw + fr * LDN + 16 * kt + 4 * fq) = pk4(a0[0], a0[1], a0[2], a0[3]);
        *(LAS u32x2*)(Sw + (16 + fr) * LDN + 16 * kt + 4 * fq) = pk4(a1[0], a1[1], a1[2], a1[3]); } }
    LBAR();
    { const f32x4 o1 = mma16(ldft(Vs + tL40 + 16 * vt, LDP), ldft(Pt + tL40 + 16 * it, LDP), (f32x4){0.f, 0.f, 0.f, 0.f});
      float o0 = o1[0] + o2[0], o1v = o1[1] + o2[1], o2v = o1[2] + o2[2], o3 = o1[3] + o2[3];
      if (!first) { const unsigned lo = (unsigned)ppv, hi2 = (unsigned)(ppv >> 32); o0 += bflo(lo); o1v += bfhi(lo); o2v += bflo(hi2); o3 += bfhi(hi2); }
      *(u32x2*)op = pk4(o0, o1v, o2v, o3); }
    LBAR();
  }
}
__device__ __forceinline__ void phase_chain1(const Params& P, const Ctx& C, int mode) {
  if (mode != 2) for (int task = C.bid; task < 128; task += C.nblk) gdn3_chain_wg(P, C, task);
  __builtin_amdgcn_sched_barrier(0);
  if (mode != 1) for (int task = C.bid < 128 ? C.bid + C.nblk : C.bid; task < 256; task += C.nblk) hgrn2_chain_wg(P, C, task - 128);
}
__device__ __forceinline__ void phase_onorm(const Params& P, const Ctx& C) {
  bf16_t* MIX = WS(OFF_MIX1, bf16_t); bf16_t* U = WS(OFF_U1B, bf16_t);
  const float* m1 = WS(OFF_MOD, float) + (size_t)5 * 6144;
  for (int r = C.gw; r < R; r += C.ngw) {
    const int b = r / TB, pos = r % TB; if (pos < CTXL) continue;
#pragma unroll
    for (int half = 0; half < 2; ++half) {
      const float* gn = half ? GIN(I_HNG) : GIN(I_GNG);
#pragma unroll
      for (int j = 0; j < 4; ++j) { const int e = 4 * C.lane + 256 * j; bf16_t* p = MIX + (size_t)r * MIXW + half * 1024 + e;
        const u32x2 a = *(const u32x2*)p; const float o0 = bflo(a.x), o1 = bfhi(a.x), o2 = bflo(a.y), o3 = bfhi(a.y);
        const float ss = half_sum32((o0 * o0 + o1 * o1) + (o2 * o2 + o3 * o3)); const float rs = rsqrtf(ss * (1.f / 128.f) + RMS_EPS);
        const f32x4 g = *(const f32x4*)(gn + (e & 127));
        u32x2 w; w.x = pk2(o0 * rs * g[0], o1 * rs * g[1]); w.y = pk2(o2 * rs * g[2], o3 * rs * g[3]); *(u32x2*)p = w; }
    }
    f32x4 h[4], u[4]; row_load(GOUT + ((size_t)b * SEQ + (pos - CTXL)) * D, C.lane, h);
    row_modulate(h, m1 + (size_t)b * 6144, m1 + (size_t)b * 6144 + D, C.lane, u);
    row_store_bf16(U + (size_t)r * D, C.lane, u);
  }
  LAS float* scr = (LAS float*)C.lds + C.wave * (64 * 33);
  convert_experts(P, 1, WS(OFF_WE1, bf16_t), WS(OFF_WE1 + 64 * MiB, bf16_t), C, scr);
}
__device__ __forceinline__ void phase_gates(const Params& P, const Ctx& C) {
  pg8::Gemm g{WS(OFF_U1B, bf16_t), WS(OFF_WG1, bf16_t), D, D}; pg8::GridOrder S; S.init(128, 8, C.nblk, C.bid, 1);
  pg8::EpiGateMul E{WS(OFF_MIX1, bf16_t), MIXW};
  pg8::gemm_phase(C.lds, g, S, E);
}


#define XB_TMO      128
#define XB_XCNT(j)  (256  + 64 * (j))
#define XB_XSUB(j)  (1280 + 64 * (j))
#define XB_XGEN(j)  (2304 + 64 * (j))
#define XB_TOP      3328
#define XB_TOPGEN   3392
#define XCD_BAR_WORDS 3456
#define XB_SPIN_CAP (1u << 22)
constexpr size_t OFF_BAR = 16 * 1024;
constexpr int LDS_BAR_OFF = LDS_BYTES - 64;
__device__ __forceinline__ unsigned xb_ld(unsigned* p)              { return __hip_atomic_load(p, __ATOMIC_RELAXED, __HIP_MEMORY_SCOPE_AGENT); }
__device__ __forceinline__ unsigned xb_add(unsigned* p, unsigned v) { return __hip_atomic_fetch_add(p, v, __ATOMIC_RELAXED, __HIP_MEMORY_SCOPE_AGENT); }
__device__ __forceinline__ unsigned xb_xcc_id() { return (unsigned)__builtin_amdgcn_s_getreg((3 << 11) | 20) & 0xFu; }
#define XB_SPIN(cond, bar) do { unsigned _sp = 0; while (cond) { __builtin_amdgcn_s_sleep(1); \
    if ((++_sp & 255u) == 0u) { if (xb_ld(&(bar)[XB_TMO])) break; if (_sp > XB_SPIN_CAP) { atomicAdd(&(bar)[XB_TMO], 1u); break; } } } } while (0)
__device__ __forceinline__ void xcd_barrier_post(unsigned* bar) { if (threadIdx.x == 0) (void)xb_add(&bar[XB_XCNT(xb_xcc_id())], 1u); }
__device__ __forceinline__ void xcd_barrier_complete(unsigned* bar, unsigned x, unsigned& nloc, unsigned& nx) {
  const unsigned G = gridDim.x * gridDim.y * gridDim.z;
  unsigned sum, cnt, mine, sp = 0u;
  for (;;) {
    sum = 0u; cnt = 0u; mine = 0u;
#pragma unroll
    for (unsigned j = 0; j < 16; ++j) { const unsigned c = xb_ld(&bar[XB_XCNT(j)]); sum += c; cnt += (c > 0u) ? 1u : 0u; mine = (j == x) ? c : mine; }
    if (sum == G) break;
    __builtin_amdgcn_s_sleep(1);
    if ((++sp & 255u) == 0u) { if (xb_ld(&bar[XB_TMO])) break; if (sp > XB_SPIN_CAP) { atomicAdd(&bar[XB_TMO], 1u); break; } }
  }
  nloc = mine > 0u ? mine : 1u; nx = cnt > 0u ? cnt : 1u;
}
__device__ __forceinline__ void xcd_barrier(unsigned* bar, volatile LAS unsigned* st) {
  asm volatile("s_waitcnt vmcnt(0)" ::: "memory");
  __syncthreads();
  if (threadIdx.x == 0) {
    const unsigned x = xb_xcc_id();
    __builtin_amdgcn_s_waitcnt(0);
    unsigned nloc = st[0], nx = st[1];
    if (nloc == 0u) { xcd_barrier_complete(bar, x, nloc, nx); st[0] = nloc; st[1] = nx; }
    const unsigned old = xb_add(&bar[XB_XSUB(x)], 1u);
    const unsigned gen = old / nloc;
    if (old + 1u == (gen + 1u) * nloc) {
      __builtin_amdgcn_fence(__ATOMIC_RELEASE, "agent");
      asm volatile("s_waitcnt vmcnt(0)" ::: "memory");
      const unsigned og = xb_add(&bar[XB_TOP], 1u);
      const unsigned tg = og / nx;
      if (og + 1u == (tg + 1u) * nx) xb_add(&bar[XB_TOPGEN], 1u);
      else XB_SPIN(xb_ld(&bar[XB_TOPGEN]) == tg, bar);
      __builtin_amdgcn_fence(__ATOMIC_ACQUIRE, "agent");
      xb_add(&bar[XB_XGEN(x)], 1u);
      asm volatile("s_waitcnt vmcnt(0)" ::: "memory");
    } else {
      XB_SPIN(xb_ld(&bar[XB_XGEN(x)]) == gen, bar);
      __builtin_amdgcn_fence(__ATOMIC_ACQUIRE, "agent");
      asm volatile("s_waitcnt vmcnt(0)" ::: "memory");
    }
  }
  __syncthreads();
}
__global__ void __launch_bounds__(NT, 2) fwd_megakernel(Params Pk) {
  extern __shared__ __attribute__((aligned(16))) unsigned char lds_raw[];
  cg::grid_group grid = cg::this_grid();
#ifndef PROBE_DOUBLE
#define PROBE_DOUBLE -1
#endif
#ifndef PROBE_MODE
#define PROBE_MODE 0
#endif
#ifndef PHASE_MASK
#define PHASE_MASK 0xFFFFFFFFu
#endif
#define SYNC() do { const unsigned char* wsb_ = ((const Params*)(const __attribute__((address_space(4))) Params*)__builtin_amdgcn_kernarg_segment_ptr())->ws; \
    xcd_barrier((unsigned*)(GAS unsigned*)(wsb_ + OFF_BAR), (volatile LAS unsigned*)((LAS unsigned char*)lds_raw + LDS_BAR_OFF)); } while (0)
#define SYNC_CG() do { __syncthreads(); grid.sync(); } while (0)
  if (threadIdx.x < 16) ((LAS unsigned*)((LAS unsigned char*)lds_raw + LDS_BAR_OFF))[threadIdx.x] = 0u;
  __syncthreads();
  xcd_barrier_post((unsigned*)(GAS unsigned*)(Pk.ws + OFF_BAR));
#define LAUNDER() const Params* pp; { unsigned long long a_ = (unsigned long long)__builtin_amdgcn_kernarg_segment_ptr(); asm volatile("" : "+s"(a_)); \
    const unsigned lo_ = __builtin_amdgcn_readfirstlane((unsigned)a_), hi_ = __builtin_amdgcn_readfirstlane((unsigned)(a_ >> 32)); \
    pp = (const Params*)(const __attribute__((address_space(4))) Params*)(((unsigned long long)hi_ << 32) | lo_); } \
  Ctx C; { int t_ = threadIdx.x; asm volatile("" : "+v"(t_)); t_ &= 511; int b_ = blockIdx.x; asm volatile("" : "+s"(b_)); b_ = __builtin_amdgcn_readfirstlane(b_); int g_ = gridDim.x; asm volatile("" : "+s"(g_)); g_ = __builtin_amdgcn_readfirstlane(g_); \
    C.lds = (LAS unsigned char*)lds_raw; C.tid = t_; C.lane = t_ & 63; C.wave = __builtin_amdgcn_readfirstlane(t_ >> 6); \
    C.bid = b_; C.nblk = g_; C.gw = b_ * NWAVES + C.wave; C.ngw = g_ * NWAVES; }
#define WSP(off, T) ((T*)(GAS T*)(pp->ws + (off)))
  for (int rep_ = 0; rep_ < ((PROBE_DOUBLE == 0) ? 2 : 1); ++rep_) { if (PHASE_MASK & (1u << 0)) { LAUNDER(); phase0(*pp, C); }  SYNC_CG(); }
  for (int rep_ = 0; rep_ < ((PROBE_DOUBLE == 1) ? 2 : 1); ++rep_) { if (PHASE_MASK & (1u << 1)) { LAUNDER(); phase_u0(*pp, C); }  SYNC(); }
  for (int rep_ = 0; rep_ < ((PROBE_DOUBLE == 2) ? 2 : 1); ++rep_) { if (PHASE_MASK & (1u << 2)) { LAUNDER(); phase_inproj(*pp, C, WSP(OFF_U0, bf16_t), WSP(OFF_WAB, bf16_t), WSP(OFF_Z0, bf16_t), Z0W); }  SYNC(); }
  for (int rep_ = 0; rep_ < ((PROBE_DOUBLE == 3) ? 2 : 1); ++rep_) { if (PHASE_MASK & (1u << 3)) { LAUNDER(); phase_feat0(*pp, C, rep_); }  SYNC(); }
  for (int rep_ = 0; rep_ < ((PROBE_DOUBLE == 4) ? 2 : 1); ++rep_) { if (PHASE_MASK & (1u << 4)) { LAUNDER(); phase_chain0(*pp, C, rep_ ? PROBE_MODE : 0); }  SYNC(); }
  for (int rep_ = 0; rep_ < ((PROBE_DOUBLE == 5) ? 2 : 1); ++rep_) { if (PHASE_MASK & (1u << 5)) { LAUNDER(); phase_ssdfin(*pp, C); }  SYNC(); }
  for (int rep_ = 0; rep_ < ((PROBE_DOUBLE == 6) ? 2 : 1); ++rep_) { if (PHASE_MASK & (1u << 6)) { LAUNDER(); phase_outproj(*pp, C, 0); }  SYNC(); }
  for (int rep_ = 0; rep_ < ((PROBE_DOUBLE == 7) ? 2 : 1); ++rep_) { if (PHASE_MASK & (1u << 7)) { LAUNDER(); phase_lnmix(*pp, C, 0); }  SYNC(); }
  for (int rep_ = 0; rep_ < ((PROBE_DOUBLE == 8) ? 2 : 1); ++rep_) { if (PHASE_MASK & (1u << 8)) { LAUNDER(); phase_dispatch(*pp, C, 0); }  SYNC(); }
  for (int rep_ = 0; rep_ < ((PROBE_DOUBLE == 9) ? 2 : 1); ++rep_) { if (PHASE_MASK & (1u << 9)) { LAUNDER(); phase_moe1(*pp, C, 0); }  SYNC(); }
  for (int rep_ = 0; rep_ < ((PROBE_DOUBLE == 10) ? 2 : 1); ++rep_) { if (PHASE_MASK & (1u << 10)) { LAUNDER(); phase_moe2(*pp, C, 0); }  SYNC(); }
  for (int rep_ = 0; rep_ < ((PROBE_DOUBLE == 11) ? 2 : 1); ++rep_) { if (PHASE_MASK & (1u << 11)) { LAUNDER(); phase_lnffn(*pp, C, 0); }  SYNC(); }
  for (int rep_ = 0; rep_ < ((PROBE_DOUBLE == 12) ? 2 : 1); ++rep_) { if (PHASE_MASK & (1u << 12)) { LAUNDER(); phase_inproj(*pp, C, WSP(OFF_U1, bf16_t), WSP(OFF_WCD, bf16_t), WSP(OFF_Z1, bf16_t), Z1W); }  SYNC(); }
  for (int rep_ = 0; rep_ < ((PROBE_DOUBLE == 13) ? 2 : 1); ++rep_) { if (PHASE_MASK & (1u << 13)) { LAUNDER(); phase_feat1(*pp, C, rep_); }  SYNC(); }
  for (int rep_ = 0; rep_ < ((PROBE_DOUBLE == 14) ? 2 : 1); ++rep_) { if (PHASE_MASK & (1u << 14)) { LAUNDER(); phase_chain1(*pp, C, rep_ ? PROBE_MODE : 0); }  SYNC(); }
  for (int rep_ = 0; rep_ < ((PROBE_DOUBLE == 15) ? 2 : 1); ++rep_) { if (PHASE_MASK & (1u << 15)) { LAUNDER(); phase_onorm(*pp, C); }  SYNC(); }
  for (int rep_ = 0; rep_ < ((PROBE_DOUBLE == 16) ? 2 : 1); ++rep_) { if (PHASE_MASK & (1u << 16)) { LAUNDER(); phase_gates(*pp, C); }  SYNC(); }
  for (int rep_ = 0; rep_ < ((PROBE_DOUBLE == 17) ? 2 : 1); ++rep_) { if (PHASE_MASK & (1u << 17)) { LAUNDER(); phase_outproj(*pp, C, 1); }  SYNC(); }
  for (int rep_ = 0; rep_ < ((PROBE_DOUBLE == 18) ? 2 : 1); ++rep_) { if (PHASE_MASK & (1u << 18)) { LAUNDER(); phase_lnmix(*pp, C, 1); }  SYNC(); }
  for (int rep_ = 0; rep_ < ((PROBE_DOUBLE == 19) ? 2 : 1); ++rep_) { if (PHASE_MASK & (1u << 19)) { LAUNDER(); phase_dispatch(*pp, C, 1); }  SYNC(); }
  for (int rep_ = 0; rep_ < ((PROBE_DOUBLE == 20) ? 2 : 1); ++rep_) { if (PHASE_MASK & (1u << 20)) { LAUNDER(); phase_moe1(*pp, C, 1); }  SYNC(); }
  for (int rep_ = 0; rep_ < ((PROBE_DOUBLE == 21) ? 2 : 1); ++rep_) { if (PHASE_MASK & (1u << 21)) { LAUNDER(); phase_moe2(*pp, C, 1); }  SYNC(); }
  if (PHASE_MASK & (1u << 22)) { LAUNDER(); phase_lnffn(*pp, C, 1); }
}

extern "C" void kernel_launch(void* const* d_in, const int* in_sizes, int n_in, void* d_out, int out_size,
                              void* d_ws, size_t ws_size, hipStream_t stream) {
  static int grid_blocks = 0;
  if (!grid_blocks) {
    int dev = 0, cus = 0, per_cu = 0;
    (void)hipGetDevice(&dev);
    (void)hipDeviceGetAttribute(&cus, hipDeviceAttributeMultiprocessorCount, dev);
    (void)hipFuncSetAttribute((const void*)fwd_megakernel, hipFuncAttributeMaxDynamicSharedMemorySize, LDS_BYTES);
    (void)hipOccupancyMaxActiveBlocksPerMultiprocessor(&per_cu, (const void*)fwd_megakernel, NT, LDS_BYTES);
    if (per_cu < 1) per_cu = 1;
    grid_blocks = cus * 1;
    fprintf(stderr, "grid %d (cus %d per_cu %d) ws_size %zu need %zu n_in %d\n", grid_blocks, cus, per_cu, ws_size, (size_t)WS_NEED, n_in);
    if (ws_size < WS_NEED || n_in != 39) { fprintf(stderr, "kernel_launch: workspace too small or unexpected inputs\n"); grid_blocks = -1; }
  }
  if (grid_blocks < 0) return;
  (void)hipMemsetAsync(d_ws, 0, 64 * 1024, stream);
  Params p{};
  for (int i = 0; i < 39; ++i) p.in[i] = (const float*)d_in[i];
  p.out = (float*)d_out; p.ws = (unsigned char*)d_ws;
  void* args[] = {&p};
  hipError_t e = hipLaunchCooperativeKernel((const void*)fwd_megakernel, dim3(grid_blocks), dim3(NT), args, LDS_BYTES, stream);
  if (e != hipSuccess) fprintf(stderr, "cooperative launch failed: %s (grid %d)\n", hipGetErrorString(e), grid_blocks);
}
```

```cpp
#include <hip/hip_runtime.h>
#include <hip/hip_cooperative_groups.h>
#include <cstdio>
#include <cstdint>
namespace cg = cooperative_groups;

#define LAS __attribute__((address_space(3)))
typedef unsigned short bf16_t;
typedef short bf16x8 __attribute__((ext_vector_type(8)));
typedef float f32x4 __attribute__((ext_vector_type(4)));
typedef float f32x2 __attribute__((ext_vector_type(2)));
typedef unsigned u32x4 __attribute__((ext_vector_type(4)));
typedef unsigned u32x2 __attribute__((ext_vector_type(2)));

constexpr int D = 1024, NB = 4, SEQ = 8192, CTXL = 256, TB = SEQ + CTXL  , R = NB * TB  , RLAT = NB * SEQ;
constexpr int NT = 512, NWAVES = 8;
constexpr int LDS_BYTES = 163840;
constexpr int AB_IN = 4640, CD_IN = 9248;
constexpr int Z0W = 4608, Z1W = 7168, MIXW = 2048;
constexpr int NEXP = 32, DEXP = 512, MOE_BLK = 256, MAX_BLKS = 304, MAX_SLOTS = 296 * 256;
constexpr float ALPHA = 1.41421356237309515f;
constexpr float LN_EPS = 1e-5f, RMS_EPS = 1e-6f;
constexpr int Z0_RGX = 0, Z0_RGY = 1024, Z0_SSDZ = 2048, Z0_XBC = 3072, Z0_B = 4096, Z0_C = 4352;
constexpr int Z1_Q = 0, Z1_K = 1024, Z1_V = 2048, Z1_HQ = 3072, Z1_HF = 4096, Z1_HI = 6144;

constexpr size_t MiB = 1u << 20;
constexpr size_t OFF_CTL = 0;
constexpr size_t OFF_MOD = 64 * 1024;
constexpr size_t OFF_LB1 = 320 * 1024;
constexpr size_t OFF_ROUTE = 512 * 1024;
constexpr size_t OFF_SLOTW = 2 * MiB;
constexpr size_t OFF_DT = 3 * MiB;
constexpr size_t OFF_HCTX = 8 * MiB;
constexpr size_t OFF_TCTX = 12 * MiB;
constexpr size_t OFF_WOUT0 = 16 * MiB, OFF_WOUT1 = 20 * MiB, OFF_WG1 = 24 * MiB, OFF_WAB = 28 * MiB;
constexpr size_t OFF_TOK = 37 * MiB + 512 * 1024;
constexpr int TOKCAP = 33792;
constexpr size_t OFF_A = 40 * MiB;
constexpr size_t OFF_Z0 = OFF_A, OFF_MIX0 = OFF_A + 297 * MiB, OFF_WE0 = OFF_A + 429 * MiB, OFF_U0 = OFF_A + 525 * MiB;
constexpr size_t OFF_AM0 = OFF_A, OFF_HM0 = OFF_A + 148 * MiB, OFF_YM0 = OFF_A + 222 * MiB;
constexpr size_t OFF_Z1 = OFF_A, OFF_U1 = OFF_A + 462 * MiB, OFF_WCD = OFF_A + 528 * MiB, OFF_MIX1 = OFF_A + 462 * MiB;
constexpr size_t OFF_WE1 = OFF_A, OFF_U1B = OFF_A + 96 * MiB, OFF_AM1 = OFF_A + 96 * MiB, OFF_HM1 = OFF_A + 244 * MiB, OFF_YM1 = OFF_A + 318 * MiB, OFF_V1 = OFF_A + 470 * MiB;
constexpr size_t WS_NEED = OFF_A + 594 * MiB;
static_assert((size_t)R * Z0W * 2 <= 297 * MiB && (size_t)R * MIXW * 2 <= 132 * MiB && (size_t)R * Z1W * 2 <= 462 * MiB && (size_t)R * D * 2 <= 66 * MiB, "ws map");
static_assert((size_t)MAX_SLOTS * D * 2 <= 148 * MiB && (size_t)MAX_SLOTS * DEXP * 2 <= 74 * MiB, "ws map moe");
static_assert(OFF_DT + (size_t)R * 32 * 4 <= OFF_HCTX && OFF_ROUTE + (size_t)R * 32 <= OFF_SLOTW && OFF_SLOTW + MAX_SLOTS * 4 <= OFF_DT, "ws map small");

struct Params { const float* in[39]; float* out; unsigned char* ws; };
enum { I_X = 0, I_C, I_CTX, I_CCTX, I_HLB, I_ADAW, I_ADAB, I_LNMG, I_LNMB, I_LNFG, I_LNFB, I_OUTW, I_RGW, I_RGB, I_REW, I_REB, I_EWG, I_EWU, I_EWD,
       I_ABW, I_RGCW, I_RGCB, I_RGAW, I_RGAB, I_RGXW, I_RGXB, I_RGLAM, I_SCW, I_SCB, I_SALOG, I_SDTB, I_SD, I_SNG, I_CDW, I_GCW, I_GALOG, I_GDTB, I_GNG, I_HNG };

__device__ __forceinline__ unsigned f2bf(float f) { unsigned u = __float_as_uint(f); return (u + 0x7fffu + ((u >> 16) & 1u)) >> 16; }
__device__ __forceinline__ float bf2f(unsigned b) { return __uint_as_float(b << 16); }
typedef __bf16 bf16x2v_t __attribute__((ext_vector_type(2)));
__device__ __forceinline__ unsigned pk2(float lo, float hi) { const f32x2 v = {lo, hi}; const bf16x2v_t r = __builtin_convertvector(v, bf16x2v_t); return __builtin_bit_cast(unsigned, r); }
__device__ __forceinline__ float bflo(unsigned w) { return __uint_as_float(w << 16); }
__device__ __forceinline__ float bfhi(unsigned w) { return __uint_as_float(w & 0xffff0000u); }
__device__ __forceinline__ float sigmoidf_(float x) { return 1.f / (1.f + __expf(-x)); }
__device__ __forceinline__ float siluf_(float x) { return x / (1.f + __expf(-x)); }
__device__ __forceinline__ float softplusf_(float x) { return x > 20.f ? x : log1pf(__expf(x)); }
__device__ __forceinline__ float geluf_(float x) { const float u = 0.7978845608028654f * (x + 0.044715f * x * x * x); return 0.5f * x * (1.f + tanhf(u)); }
template <int CTRL> __device__ __forceinline__ float dpp_mov(float v) {
  return __builtin_bit_cast(float, __builtin_amdgcn_update_dpp(0, __builtin_bit_cast(int, v), CTRL, 0xf, 0xf, true));
}
__device__ __forceinline__ float row_sum16(float v) {
  v += dpp_mov<0xB1>(v); v += dpp_mov<0x4E>(v); v += dpp_mov<0x141>(v); v += dpp_mov<0x140>(v);
  return v;
}
__device__ __forceinline__ float wave_sum(float v) { v = row_sum16(v); v += __shfl_xor(v, 16); v += __shfl_xor(v, 32); return v; }
__device__ __forceinline__ float half_sum32(float v) { v = row_sum16(v); v += __shfl_xor(v, 16); return v; }
__device__ __forceinline__ int rmap(int latonly, int q) { return latonly ? (q >> 13) * TB + CTXL + (q & 8191) : q; }
__device__ __forceinline__ int row_batch(int r) { return r / TB; }

namespace pg8 {
constexpr int BM = 256, BK = 64, HALF = 128, HTB = HALF * BK * 2, STAGE_BYTES = 8 * HTB, NXCD = 8, WGM = 8;
__host__ __device__ __forceinline__ int lds_byte(int r, int c) { const int st = (r >> 4) * 2 + (c >> 5), rr = r & 15, cc = c & 31, ob = rr * 64 + cc * 2; return st * 1024 + (ob ^ (((ob >> 9) & 1) << 5)); }
__host__ __device__ __forceinline__ void stage_rc(int b, int& Rr, int& C) { const int st = b / 1024, sb = b % 1024, swz = sb ^ (((sb >> 9) & 1) << 5); Rr = (st >> 1) * 16 + swz / 64; C = (st & 1) * 32 + (swz % 64) / 2; }
__host__ __device__ __forceinline__ int perm32(int rho) { const int n = rho >> 4, i = rho & 15; return 8 * (i >> 2) + 4 * n + (i & 3); }
struct Unit { int pm, pn; };
struct Gemm { const bf16_t* A; const bf16_t* Bt; int lda, K; };

struct GridOrder {
  int nM, nN, nwg, G, c, skipctx;
  __device__ void init(int nM_, int nN_, int G_, int c_, int skipctx_) { nM = nM_; nN = nN_; nwg = nM * nN; G = G_; c = c_; skipctx = skipctx_; }
  __device__ bool next(int i, Unit& u) const {
    const long L = (long)i * G + c; if (L >= nwg) return false;
    int wgid = (int)L; { const int q = nwg / NXCD, r = nwg % NXCD, xcd = wgid % NXCD, off = wgid / NXCD; wgid = (xcd < r ? xcd * (q + 1) : r * (q + 1) + (xcd - r) * q) + off; }
    const int nig = WGM * nN, gid = wgid / nig, fm = gid * WGM, gsz = (nM - fm) < WGM ? (nM - fm) : WGM;
    int pm = fm + ((wgid % nig) % gsz); u.pn = (wgid % nig) / gsz;
    if (skipctx) pm = (pm >> 5) * 33 + 1 + (pm & 31);
    u.pm = pm; return true;
  }
};
struct MoeOrder {
  const LAS int* base; const LAS int* cntL; const LAS int* blk_e; const unsigned short* tok; int nunits, G, c;
  __device__ bool next(int i, Unit& u) const {
    const long L = (long)i * G + c; if (L >= nunits) return false;
    const int blk = (int)(L >> 2), j = (int)(L & 3);
    u.pm = blk; u.pn = blk_e[blk] * 4 + j; return true;
  }
  __device__ int arow(const Unit& u, int r) const {
    const int e = blk_e[u.pm]; const int pos = (u.pm - base[e]) * 256 + r;
    return pos < cntL[e] ? (int)tok[(size_t)e * TOKCAP + pos] : 0;
  }
};

__device__ __forceinline__ unsigned cvt_pk_bf16(float lo, float hi) { return pk2(lo, hi); }

template <class Epi, class Sched>
__device__ __forceinline__ void gemm_phase(LAS unsigned char* lds, const Gemm g, const Sched& S, const Epi& E) {
  int tid_ = threadIdx.x; asm volatile("" : "+v"(tid_)); tid_ &= 511; const int tid = tid_, wid = __builtin_amdgcn_readfirstlane(tid >> 6), lane = tid & 63, wr = wid >> 2, wc = wid & 3, fr = lane & 15, fq = lane >> 4;
  const int K = g.K, nt = K / BK, lda = g.lda;
  unsigned voffA[2], voffB[2];
#pragma unroll
  for (int i = 0; i < 2; ++i) { int Rr, C; stage_rc(tid * 16 + i * 8192, Rr, C); const int Rb = Epi::PERM ? ((Rr & ~31) + perm32(Rr & 31)) : Rr;
    voffA[i] = (unsigned)(Rr * lda + C) * 2u; voffB[i] = (unsigned)(Rb * K + C) * 2u; }
  const size_t kstep = (size_t)(BK * 2);
  const size_t hstepA = (size_t)HALF * lda * 2, hstepB = (size_t)HALF * K * 2;
  const size_t tstepA = 2 * hstepA, tstepB = 2 * hstepB;
  const unsigned ldsw = (unsigned)wid * 1024u;
  const int aoff = lds_byte(wr * 64 + fr, fq * 8), boff = lds_byte(wc * 32 + fr, fq * 8);
#define PG8_SA(b, h) (((b) * 2 + (h)) * HTB)
#define PG8_SB(b, h) ((4 + (b) * 2 + (h)) * HTB)
#define PG8_STAGE(bufoff, gbase, voff) do { _Pragma("unroll") for (int _i = 0; _i < 2; ++_i) \
    __builtin_amdgcn_global_load_lds((const unsigned*)((const char*)(gbase) + (voff)[_i]), (LAS unsigned*)(lds + (bufoff) + ldsw + _i * 8192), 16, 0, 0); } while (0)
#define PG8_LDA(dst, b, h) do { _Pragma("unroll") for (int m = 0; m < 4; ++m) _Pragma("unroll") for (int k = 0; k < 2; ++k) dst[m][k] = *(const LAS bf16x8*)(lds + PG8_SA(b, h) + aoff + m * 2048 + k * 1024); } while (0)
#define PG8_LDB(dst, b, h) do { _Pragma("unroll") for (int n = 0; n < 2; ++n) _Pragma("unroll") for (int k = 0; k < 2; ++k) dst[n][k] = *(const LAS bf16x8*)(lds + PG8_SB(b, h) + boff + n * 2048 + k * 1024); } while (0)
#define PG8_MMA(ai, bj, At, Bt) do { __builtin_amdgcn_s_setprio(1); _Pragma("unroll") for (int m = 0; m < 4; ++m) _Pragma("unroll") for (int n = 0; n < 2; ++n) _Pragma("unroll") for (int k = 0; k < 2; ++k) \
    acc[ai][bj][m][n] = __builtin_amdgcn_mfma_f32_16x16x32_bf16(Bt[n][k], At[m][k], acc[ai][bj][m][n], 0, 0, 0); __builtin_amdgcn_s_setprio(0); } while (0)
#define PG8_WAIT_V(n) asm volatile("s_waitcnt vmcnt(" #n ")" ::: "memory")
#define PG8_WAIT_L(n) asm volatile("s_waitcnt lgkmcnt(" #n ")" ::: "memory")
#define PG8_BAR __builtin_amdgcn_s_barrier()
#define PG8_SCHED __builtin_amdgcn_sched_barrier(0)
  Unit cur, nxt; int ui = 0;
  if (!S.next(0, cur)) return;
  f32x4 acc[2][2][4][2];
#pragma unroll
  for (int a = 0; a < 2; ++a)
#pragma unroll
    for (int b = 0; b < 2; ++b)
#pragma unroll
      for (int m = 0; m < 4; ++m)
#pragma unroll
        for (int n = 0; n < 2; ++n) acc[a][b][m][n] = (f32x4){0.f, 0.f, 0.f, 0.f};
  bf16x8 At[4][2], B0[2][2], B1[2][2];
  const char* cA = (const char*)g.A + (size_t)cur.pm * tstepA; const char* cB = (const char*)g.Bt + (size_t)cur.pn * tstepB;
  PG8_STAGE(PG8_SB(0, 0), cB, voffB); PG8_STAGE(PG8_SA(0, 0), cA, voffA); PG8_STAGE(PG8_SB(0, 1), cB + hstepB, voffB); PG8_STAGE(PG8_SA(0, 1), cA + hstepA, voffA);
  if (wr == 1) PG8_BAR;
  PG8_WAIT_V(4); PG8_BAR;
  PG8_STAGE(PG8_SB(1, 0), cB + kstep, voffB); PG8_STAGE(PG8_SA(1, 0), cA + kstep, voffA); PG8_STAGE(PG8_SB(1, 1), cB + hstepB + kstep, voffB);
  PG8_WAIT_V(6); PG8_BAR;
  for (;;) {
    const bool has_next = S.next(ui + 1, nxt);
    const char* nA = has_next ? (const char*)g.A + (size_t)nxt.pm * tstepA : cA; const char* nB = has_next ? (const char*)g.Bt + (size_t)nxt.pn * tstepB : cB;
    for (int t = 0; t < nt; t += 2) {
      const bool last = (t == nt - 2);
      const char* a1 = cA + (size_t)(t + 1) * kstep;
      const char* a2 = last ? nA : cA + (size_t)(t + 2) * kstep; const char* b2 = last ? nB : cB + (size_t)(t + 2) * kstep;
      const char* a3 = a2 + kstep; const char* b3 = b2 + kstep;
      PG8_LDB(B0, 0, 0); PG8_SCHED; PG8_LDA(At, 0, 0); PG8_STAGE(PG8_SA(1, 1), a1 + hstepA, voffA);
      PG8_WAIT_L(8); PG8_BAR; PG8_WAIT_L(0); PG8_MMA(0, 0, At, B0); PG8_BAR; PG8_SCHED;
      PG8_LDB(B1, 0, 1); PG8_STAGE(PG8_SB(0, 0), b2, voffB);
      PG8_BAR; PG8_WAIT_L(0); PG8_MMA(0, 1, At, B1); PG8_BAR;
      PG8_LDA(At, 0, 1); PG8_STAGE(PG8_SA(0, 0), a2, voffA);
      PG8_BAR; PG8_WAIT_L(0); PG8_MMA(1, 0, At, B0); PG8_BAR; PG8_SCHED;
      PG8_STAGE(PG8_SB(0, 1), b2 + hstepB, voffB);
      PG8_WAIT_V(6); PG8_BAR; PG8_MMA(1, 1, At, B1); PG8_BAR;
      PG8_LDB(B0, 1, 0); PG8_SCHED; PG8_LDA(At, 1, 0); PG8_STAGE(PG8_SA(0, 1), a2 + hstepA, voffA);
      PG8_WAIT_L(8); PG8_BAR; PG8_WAIT_L(0); PG8_MMA(0, 0, At, B0); PG8_BAR; PG8_SCHED;
      PG8_LDB(B1, 1, 1); PG8_STAGE(PG8_SB(1, 0), b3, voffB);
      PG8_BAR; PG8_WAIT_L(0); PG8_MMA(0, 1, At, B1); PG8_BAR;
      PG8_LDA(At, 1, 1); PG8_STAGE(PG8_SA(1, 0), a3, voffA);
      PG8_BAR; PG8_WAIT_L(0); PG8_MMA(1, 0, At, B0); PG8_BAR; PG8_SCHED;
      PG8_STAGE(PG8_SB(1, 1), b3 + hstepB, voffB);
      PG8_WAIT_V(6); PG8_BAR; PG8_MMA(1, 1, At, B1); PG8_BAR;
    }
    E(acc, cur, wr, wc, fr, fq);
    if (!has_next) break;
#pragma unroll
    for (int a = 0; a < 2; ++a)
#pragma unroll
      for (int b = 0; b < 2; ++b)
#pragma unroll
        for (int m = 0; m < 4; ++m)
#pragma unroll
          for (int n = 0; n < 2; ++n) acc[a][b][m][n] = (f32x4){0.f, 0.f, 0.f, 0.f};
    cur = nxt; cA = nA; cB = nB; ++ui;
  }
  PG8_WAIT_V(0);
  if (wr == 0) PG8_BAR;
  PG8_BAR;
#undef PG8_SA
#undef PG8_SB
#undef PG8_STAGE
#undef PG8_LDA
#undef PG8_LDB
#undef PG8_MMA
#undef PG8_WAIT_V
#undef PG8_WAIT_L
#undef PG8_BAR
#undef PG8_SCHED
}

template <class Epi, class Sched>
__device__ __forceinline__ void gemm_phase_ga(LAS unsigned char* lds, const Gemm g, const Sched& S, const Epi& E) {
  int tid_ = threadIdx.x; asm volatile("" : "+v"(tid_)); tid_ &= 511; const int tid = tid_, wid = __builtin_amdgcn_readfirstlane(tid >> 6), lane = tid & 63, wr = wid >> 2, wc = wid & 3, fr = lane & 15, fq = lane >> 4;
  const int K = g.K, nt = K / BK, lda = g.lda;
  unsigned voffB[2]; int rowA[2]; unsigned colA[2];
#pragma unroll
  for (int i = 0; i < 2; ++i) { int Rr, C; stage_rc(tid * 16 + i * 8192, Rr, C); const int Rb = Epi::PERM ? ((Rr & ~31) + perm32(Rr & 31)) : Rr;
    rowA[i] = Rr; colA[i] = (unsigned)C * 2u; voffB[i] = (unsigned)(Rb * K + C) * 2u; }
  unsigned oc[2][2], on[2][2];
  const size_t kstep = (size_t)(BK * 2);
  const size_t hstepB = (size_t)HALF * K * 2;
  const size_t tstepB = 2 * hstepB;
  const unsigned ldsw = (unsigned)wid * 1024u;
  const int aoff = lds_byte(wr * 64 + fr, fq * 8), boff = lds_byte(wc * 32 + fr, fq * 8);
#define PG8_SA(b, h) (((b) * 2 + (h)) * HTB)
#define PG8_SB(b, h) ((4 + (b) * 2 + (h)) * HTB)
#define PG8_STAGE_A(bufoff, off2, kbyte) do { _Pragma("unroll") for (int _i = 0; _i < 2; ++_i) \
    __builtin_amdgcn_global_load_lds((const unsigned*)((const char*)g.A + (size_t)(kbyte) + (off2)[_i]), (LAS unsigned*)(lds + (bufoff) + ldsw + _i * 8192), 16, 0, 0); } while (0)
#define PG8_OFFS(dst, un) do { _Pragma("unroll") for (int _h = 0; _h < 2; ++_h) _Pragma("unroll") for (int _i = 0; _i < 2; ++_i) \
    dst[_h][_i] = (unsigned)S.arow(un, _h * HALF + rowA[_i]) * (unsigned)(lda * 2) + colA[_i]; } while (0)
#define PG8_STAGE(bufoff, gbase, voff) do { _Pragma("unroll") for (int _i = 0; _i < 2; ++_i) \
    __builtin_amdgcn_global_load_lds((const unsigned*)((const char*)(gbase) + (voff)[_i]), (LAS unsigned*)(lds + (bufoff) + ldsw + _i * 8192), 16, 0, 0); } while (0)
#define PG8_LDA(dst, b, h) do { _Pragma("unroll") for (int m = 0; m < 4; ++m) _Pragma("unroll") for (int k = 0; k < 2; ++k) dst[m][k] = *(const LAS bf16x8*)(lds + PG8_SA(b, h) + aoff + m * 2048 + k * 1024); } while (0)
#define PG8_LDB(dst, b, h) do { _Pragma("unroll") for (int n = 0; n < 2; ++n) _Pragma("unroll") for (int k = 0; k < 2; ++k) dst[n][k] = *(const LAS bf16x8*)(lds + PG8_SB(b, h) + boff + n * 2048 + k * 1024); } while (0)
#define PG8_MMA(ai, bj, At, Bt) do { __builtin_amdgcn_s_setprio(1); _Pragma("unroll") for (int m = 0; m < 4; ++m) _Pragma("unroll") for (int n = 0; n < 2; ++n) _Pragma("unroll") for (int k = 0; k < 2; ++k) \
    acc[ai][bj][m][n] = __builtin_amdgcn_mfma_f32_16x16x32_bf16(Bt[n][k], At[m][k], acc[ai][bj][m][n], 0, 0, 0); __builtin_amdgcn_s_setprio(0); } while (0)
#define PG8_WAIT_V(n) asm volatile("s_waitcnt vmcnt(" #n ")" ::: "memory")
#define PG8_WAIT_L(n) asm volatile("s_waitcnt lgkmcnt(" #n ")" ::: "memory")
#define PG8_BAR __builtin_amdgcn_s_barrier()
#define PG8_SCHED __builtin_amdgcn_sched_barrier(0)
  Unit cur, nxt; int ui = 0;
  if (!S.next(0, cur)) return;
  f32x4 acc[2][2][4][2];
#pragma unroll
  for (int a = 0; a < 2; ++a)
#pragma unroll
    for (int b = 0; b < 2; ++b)
#pragma unroll
      for (int m = 0; m < 4; ++m)
#pragma unroll
        for (int n = 0; n < 2; ++n) acc[a][b][m][n] = (f32x4){0.f, 0.f, 0.f, 0.f};
  bf16x8 At[4][2], B0[2][2], B1[2][2];
  const char* cB = (const char*)g.Bt + (size_t)cur.pn * tstepB;
  PG8_OFFS(oc, cur);
  PG8_STAGE(PG8_SB(0, 0), cB, voffB); PG8_STAGE_A(PG8_SA(0, 0), oc[0], 0); PG8_STAGE(PG8_SB(0, 1), cB + hstepB, voffB); PG8_STAGE_A(PG8_SA(0, 1), oc[1], 0);
  if (wr == 1) PG8_BAR;
  PG8_WAIT_V(4); PG8_BAR;
  PG8_STAGE(PG8_SB(1, 0), cB + kstep, voffB); PG8_STAGE_A(PG8_SA(1, 0), oc[0], kstep); PG8_STAGE(PG8_SB(1, 1), cB + hstepB + kstep, voffB);
  PG8_WAIT_V(6); PG8_BAR;
  for (;;) {
    const bool has_next = S.next(ui + 1, nxt);
    const char* nB = has_next ? (const char*)g.Bt + (size_t)nxt.pn * tstepB : cB;
    if (has_next) { PG8_OFFS(on, nxt); } else {
#pragma unroll
      for (int _h = 0; _h < 2; ++_h) { on[_h][0] = oc[_h][0]; on[_h][1] = oc[_h][1]; } }
    for (int t = 0; t < nt; t += 2) {
      const bool last = (t == nt - 2);
      const size_t k1 = (size_t)(t + 1) * kstep, k2 = last ? 0 : (size_t)(t + 2) * kstep, k3 = k2 + kstep;
      const char* b2 = last ? nB : cB + (size_t)(t + 2) * kstep; const char* b3 = b2 + kstep;
      unsigned o2a[2], o2b[2];
      if (last) { asm volatile("" : "+v"(on[0][0]), "+v"(on[0][1]), "+v"(on[1][0]), "+v"(on[1][1])); o2a[0] = on[0][0]; o2a[1] = on[0][1]; o2b[0] = on[1][0]; o2b[1] = on[1][1]; }
      else { o2a[0] = oc[0][0]; o2a[1] = oc[0][1]; o2b[0] = oc[1][0]; o2b[1] = oc[1][1]; }
      PG8_LDB(B0, 0, 0); PG8_SCHED; PG8_LDA(At, 0, 0); PG8_STAGE_A(PG8_SA(1, 1), oc[1], k1);
      PG8_WAIT_L(8); PG8_BAR; PG8_WAIT_L(0); PG8_MMA(0, 0, At, B0); PG8_BAR; PG8_SCHED;
      PG8_LDB(B1, 0, 1); PG8_STAGE(PG8_SB(0, 0), b2, voffB);
      PG8_BAR; PG8_WAIT_L(0); PG8_MMA(0, 1, At, B1); PG8_BAR;
      PG8_LDA(At, 0, 1); PG8_STAGE_A(PG8_SA(0, 0), o2a, k2);
      PG8_BAR; PG8_WAIT_L(0); PG8_MMA(1, 0, At, B0); PG8_BAR; PG8_SCHED;
      PG8_STAGE(PG8_SB(0, 1), b2 + hstepB, voffB);
      PG8_WAIT_V(6); PG8_BAR; PG8_MMA(1, 1, At, B1); PG8_BAR;
      PG8_LDB(B0, 1, 0); PG8_SCHED; PG8_LDA(At, 1, 0); PG8_STAGE_A(PG8_SA(0, 1), o2b, k2);
      PG8_WAIT_L(8); PG8_BAR; PG8_WAIT_L(0); PG8_MMA(0, 0, At, B0); PG8_BAR; PG8_SCHED;
      PG8_LDB(B1, 1, 1); PG8_STAGE(PG8_SB(1, 0), b3, voffB);
      PG8_BAR; PG8_WAIT_L(0); PG8_MMA(0, 1, At, B1); PG8_BAR;
      PG8_LDA(At, 1, 1); PG8_STAGE_A(PG8_SA(1, 0), o2a, k3);
      PG8_BAR; PG8_WAIT_L(0); PG8_MMA(1, 0, At, B0); PG8_BAR; PG8_SCHED;
      PG8_STAGE(PG8_SB(1, 1), b3 + hstepB, voffB);
      PG8_WAIT_V(6); PG8_BAR; PG8_MMA(1, 1, At, B1); PG8_BAR;
    }
    E(acc, cur, wr, wc, fr, fq);
    if (!has_next) break;
#pragma unroll
    for (int a = 0; a < 2; ++a)
#pragma unroll
      for (int b = 0; b < 2; ++b)
#pragma unroll
        for (int m = 0; m < 4; ++m)
#pragma unroll
          for (int n = 0; n < 2; ++n) acc[a][b][m][n] = (f32x4){0.f, 0.f, 0.f, 0.f};
    cur = nxt; cB = nB; ++ui;
#pragma unroll
    for (int _h = 0; _h < 2; ++_h) { oc[_h][0] = on[_h][0]; oc[_h][1] = on[_h][1]; }
  }
  PG8_WAIT_V(0);
  if (wr == 0) PG8_BAR;
  PG8_BAR;
#undef PG8_SA
#undef PG8_SB
#undef PG8_STAGE
#undef PG8_STAGE_A
#undef PG8_OFFS
#undef PG8_LDA
#undef PG8_LDB
#undef PG8_MMA
#undef PG8_WAIT_V
#undef PG8_WAIT_L
#undef PG8_BAR
#undef PG8_SCHED
}

struct EpiBf16 {
  static constexpr bool PERM = true;
  bf16_t* O; int ldc;
  __device__ __forceinline__ void operator()(const f32x4 (&acc)[2][2][4][2], const Unit& u, int wr, int wc, int fr, int fq) const {
    const int row0 = u.pm * BM + wr * 64 + fr, col0 = u.pn * BM + wc * 32 + 8 * fq;
#pragma unroll
    for (int ai = 0; ai < 2; ++ai)
#pragma unroll
      for (int m = 0; m < 4; ++m) { bf16_t* rowp = O + (size_t)(row0 + ai * HALF + m * 16) * ldc + col0;
#pragma unroll
        for (int bj = 0; bj < 2; ++bj) { const f32x4 v0 = acc[ai][bj][m][0], v1 = acc[ai][bj][m][1];
          u32x4 w; w.x = cvt_pk_bf16(v0[0], v0[1]); w.y = cvt_pk_bf16(v0[2], v0[3]); w.z = cvt_pk_bf16(v1[0], v1[1]); w.w = cvt_pk_bf16(v1[2], v1[3]);
          *(u32x4*)(rowp + bj * HALF) = w; } }
  }
};
struct EpiInProj {
  static constexpr bool PERM = true;
  bf16_t* O; int ldc; int nz; float* DT;
  __device__ __forceinline__ void operator()(const f32x4 (&acc)[2][2][4][2], const Unit& u, int wr, int wc, int fr, int fq) const {
    const int row0 = u.pm * BM + wr * 64 + fr;
    if (u.pn < nz) {
      const int col0 = u.pn * BM + wc * 32 + 8 * fq;
#pragma unroll
      for (int ai = 0; ai < 2; ++ai)
#pragma unroll
        for (int m = 0; m < 4; ++m) { bf16_t* rowp = O + (size_t)(row0 + ai * HALF + m * 16) * ldc + col0;
#pragma unroll
          for (int bj = 0; bj < 2; ++bj) { const f32x4 v0 = acc[ai][bj][m][0], v1 = acc[ai][bj][m][1];
            u32x4 w; w.x = cvt_pk_bf16(v0[0], v0[1]); w.y = cvt_pk_bf16(v0[2], v0[3]); w.z = cvt_pk_bf16(v1[0], v1[1]); w.w = cvt_pk_bf16(v1[2], v1[3]);
            *(u32x4*)(rowp + bj * HALF) = w; } }
    } else if (wc == 0) {
#pragma unroll
      for (int ai = 0; ai < 2; ++ai)
#pragma unroll
        for (int m = 0; m < 4; ++m) { float* rowp = DT + (size_t)(row0 + ai * HALF + m * 16) * 32 + 8 * fq;
          *(f32x4*)rowp = acc[ai][0][m][0]; *(f32x4*)(rowp + 4) = acc[ai][0][m][1]; }
    }
  }
};
struct EpiResid {
  static constexpr bool PERM = false;
  const float* hlat; const float* hctx; float* tlat; float* tctx; const float* gate;
  __device__ __forceinline__ void operator()(const f32x4 (&acc)[2][2][4][2], const Unit& u, int wr, int wc, int fr, int fq) const {
    const int b = u.pm / 33, tt = u.pm % 33; const bool isctx = (tt == 0);
    const float* hs = isctx ? hctx + (size_t)b * CTXL * D : hlat + ((size_t)b * SEQ + (size_t)(tt - 1) * 256) * D;
    float* td = isctx ? tctx + (size_t)b * CTXL * D : tlat + ((size_t)b * SEQ + (size_t)(tt - 1) * 256) * D;
    const float* gt = gate + (size_t)(isctx ? 4 : b) * 6144;
    const int lrow0 = wr * 64 + fr, col0 = u.pn * BM + wc * 32 + 4 * fq;
#pragma unroll
    for (int bj = 0; bj < 2; ++bj)
#pragma unroll
      for (int n = 0; n < 2; ++n) { const f32x4 gvv = *(const f32x4*)(gt + col0 + bj * HALF + n * 16);
        f32x4 hv[2][4];
#pragma unroll
        for (int ai = 0; ai < 2; ++ai)
#pragma unroll
          for (int m = 0; m < 4; ++m) hv[ai][m] = *(const f32x4*)(hs + (size_t)(lrow0 + ai * HALF + m * 16) * D + col0 + bj * HALF + n * 16);
        asm volatile("" ::: "memory");
#pragma unroll
        for (int ai = 0; ai < 2; ++ai)
#pragma unroll
          for (int m = 0; m < 4; ++m) *(f32x4*)(td + (size_t)(lrow0 + ai * HALF + m * 16) * D + col0 + bj * HALF + n * 16) = hv[ai][m] * ALPHA + gvv * acc[ai][bj][m][n];
        asm volatile("" ::: "memory"); }
  }
};
struct EpiGateMul {
  static constexpr bool PERM = true;
  bf16_t* O; int ldc;
  __device__ __forceinline__ void operator()(const f32x4 (&acc)[2][2][4][2], const Unit& u, int wr, int wc, int fr, int fq) const {
    const int row0 = u.pm * BM + wr * 64 + fr, col0 = u.pn * BM + wc * 32 + 8 * fq;
#pragma unroll
    for (int ai = 0; ai < 2; ++ai) {
      u32x4 ov[4][2];
#pragma unroll
      for (int m = 0; m < 4; ++m)
#pragma unroll
        for (int bj = 0; bj < 2; ++bj) ov[m][bj] = *(const u32x4*)(O + (size_t)(row0 + ai * HALF + m * 16) * ldc + col0 + bj * HALF);
      asm volatile("" ::: "memory");
#pragma unroll
      for (int m = 0; m < 4; ++m) { bf16_t* rowp = O + (size_t)(row0 + ai * HALF + m * 16) * ldc + col0;
#pragma unroll
        for (int bj = 0; bj < 2; ++bj) { const f32x4 v0 = acc[ai][bj][m][0], v1 = acc[ai][bj][m][1]; const u32x4 o = ov[m][bj];
          u32x4 w;
          w.x = cvt_pk_bf16(bflo(o.x) * siluf_(v0[0]), bfhi(o.x) * siluf_(v0[1])); w.y = cvt_pk_bf16(bflo(o.y) * siluf_(v0[2]), bfhi(o.y) * siluf_(v0[3]));
          w.z = cvt_pk_bf16(bflo(o.z) * siluf_(v1[0]), bfhi(o.z) * siluf_(v1[1])); w.w = cvt_pk_bf16(bflo(o.w) * siluf_(v1[2]), bfhi(o.w) * siluf_(v1[3]));
          *(u32x4*)(rowp + bj * HALF) = w; } }
      asm volatile("" ::: "memory");
    }
  }
};
struct EpiSwiGLU {
  static constexpr bool PERM = true;
  bf16_t* H;
  __device__ __forceinline__ void operator()(const f32x4 (&acc)[2][2][4][2], const Unit& u, int wr, int wc, int fr, int fq) const {
    const int row0 = u.pm * BM + wr * 64 + fr, col0 = (u.pn & 3) * 128 + wc * 32 + 8 * fq;
#pragma unroll
    for (int ai = 0; ai < 2; ++ai)
#pragma unroll
      for (int m = 0; m < 4; ++m) { bf16_t* rowp = H + (size_t)(row0 + ai * HALF + m * 16) * DEXP + col0;
        const f32x4 g0 = acc[ai][0][m][0], g1 = acc[ai][0][m][1], u0 = acc[ai][1][m][0], u1 = acc[ai][1][m][1];
        u32x4 w; w.x = cvt_pk_bf16(siluf_(g0[0]) * u0[0], siluf_(g0[1]) * u0[1]); w.y = cvt_pk_bf16(siluf_(g0[2]) * u0[2], siluf_(g0[3]) * u0[3]);
        w.z = cvt_pk_bf16(siluf_(g1[0]) * u1[0], siluf_(g1[1]) * u1[1]); w.w = cvt_pk_bf16(siluf_(g1[2]) * u1[2], siluf_(g1[3]) * u1[3]);
        *(u32x4*)rowp = w; }
  }
};
struct EpiMoeDown {
  static constexpr bool PERM = true;
  bf16_t* Y;
  __device__ __forceinline__ void operator()(const f32x4 (&acc)[2][2][4][2], const Unit& u, int wr, int wc, int fr, int fq) const {
    const int row0 = u.pm * BM + wr * 64 + fr, col0 = (u.pn & 3) * BM + wc * 32 + 8 * fq;
#pragma unroll
    for (int ai = 0; ai < 2; ++ai)
#pragma unroll
      for (int m = 0; m < 4; ++m) { bf16_t* rowp = Y + (size_t)(row0 + ai * HALF + m * 16) * D + col0;
#pragma unroll
        for (int bj = 0; bj < 2; ++bj) { const f32x4 v0 = acc[ai][bj][m][0], v1 = acc[ai][bj][m][1];
          u32x4 w; w.x = cvt_pk_bf16(v0[0], v0[1]); w.y = cvt_pk_bf16(v0[2], v0[3]); w.z = cvt_pk_bf16(v1[0], v1[1]); w.w = cvt_pk_bf16(v1[2], v1[3]);
          *(u32x4*)(rowp + bj * HALF) = w; } }
  }
};
}

struct Ctx {
  LAS unsigned char* lds; int tid, lane, wave, gw, ngw, bid, nblk;
};
#define GAS __attribute__((address_space(1)))
#define WS(off, T) ((T*)(GAS T*)(P.ws + (off)))
#define GIN(i) ((const float*)(const GAS float*)P.in[i])
#define GOUT ((float*)(GAS float*)P.out)

__device__ __forceinline__ void transpose_item(const float* W, int ldw, int col0, int k0, bf16_t* dst_row0, int ldd, LAS float* scr, int lane) {
#pragma unroll 8
  for (int i = 0; i < 32; ++i) { const int kk = 2 * i + (lane >> 5); scr[kk * 33 + (lane & 31)] = W[(size_t)(k0 + kk) * ldw + col0 + (lane & 31)]; }
  asm volatile("s_waitcnt lgkmcnt(0)" ::: "memory");
  const int c = lane & 7;
#pragma unroll
  for (int j = 0; j < 4; ++j) { const int n = (lane >> 3) + 8 * j; const LAS float* s = scr + (8 * c) * 33 + n;
    u32x4 o; o.x = pk2(s[0 * 33], s[1 * 33]); o.y = pk2(s[2 * 33], s[3 * 33]); o.z = pk2(s[4 * 33], s[5 * 33]); o.w = pk2(s[6 * 33], s[7 * 33]);
    *(u32x4*)(dst_row0 + (size_t)n * ldd + k0 + 8 * c) = o; }
  asm volatile("s_waitcnt lgkmcnt(0)" ::: "memory");
}
__device__ __forceinline__ void transpose_mat_item(const float* W, int ldw, int col0, int K, int ncols, bf16_t* dst, int ldd, int gu, int it, LAS float* scr, int lane) {
  const int nblk = ncols / 32, kb = it / nblk, nb = it % nblk, n0 = 32 * nb;
  const int drow = gu ? (256 * (n0 >> 7) + (n0 & 127) + (gu == 2 ? 128 : 0)) : n0;
  transpose_item(W, ldw, col0 + n0, 64 * kb, dst + (size_t)drow * ldd, ldd, scr, lane);
}
__device__ __forceinline__ void convert_experts(const Params& P, int layer, bf16_t* wgu, bf16_t* wd, const Ctx& C, LAS float* scr) {
  for (int it = C.gw; it < NEXP * 768; it += C.ngw) {
    const int e = it / 768, r = it % 768;
    const size_t eoff = ((size_t)layer * NEXP + e) * (size_t)D * DEXP;
    if (r < 256) transpose_mat_item(GIN(I_EWG) + eoff, DEXP, 0, D, DEXP, wgu + (size_t)e * 1024 * D, D, 1, r, scr, C.lane);
    else if (r < 512) transpose_mat_item(GIN(I_EWU) + eoff, DEXP, 0, D, DEXP, wgu + (size_t)e * 1024 * D, D, 2, r - 256, scr, C.lane);
    else transpose_mat_item(GIN(I_EWD) + eoff, D, 0, DEXP, D, wd + (size_t)e * D * DEXP, DEXP, 0, r - 512, scr, C.lane);
  }
}

__device__ __forceinline__ void row_load(const float* row, int lane, f32x4 (&v)[4]) {
#pragma unroll
  for (int j = 0; j < 4; ++j) v[j] = *(const f32x4*)(row + 4 * lane + 256 * j);
}
__device__ __forceinline__ void row_store(float* row, int lane, const f32x4 (&v)[4]) {
#pragma unroll
  for (int j = 0; j < 4; ++j) *(f32x4*)(row + 4 * lane + 256 * j) = v[j];
}
__device__ __forceinline__ void row_store_bf16(bf16_t* row, int lane, const f32x4 (&v)[4]) {
#pragma unroll
  for (int j = 0; j < 4; ++j) { u32x2 w; w.x = pk2(v[j][0], v[j][1]); w.y = pk2(v[j][2], v[j][3]); *(u32x2*)(row + 4 * lane + 256 * j) = w; }
}
__device__ __forceinline__ void row_layernorm(f32x4 (&v)[4], const float* g, const float* b, int lane) {
  float s = 0.f;
#pragma unroll
  for (int j = 0; j < 4; ++j) s += (v[j][0] + v[j][1]) + (v[j][2] + v[j][3]);
  const float mean = wave_sum(s) * (1.f / D); float s2 = 0.f;
#pragma unroll
  for (int j = 0; j < 4; ++j) { v[j] = v[j] - mean; s2 += (v[j][0] * v[j][0] + v[j][1] * v[j][1]) + (v[j][2] * v[j][2] + v[j][3] * v[j][3]); }
  const float rstd = rsqrtf(wave_sum(s2) * (1.f / D) + LN_EPS);
#pragma unroll
  for (int j = 0; j < 4; ++j) { const f32x4 gg = *(const f32x4*)(g + 4 * lane + 256 * j), bb = *(const f32x4*)(b + 4 * lane + 256 * j); v[j] = v[j] * rstd * gg + bb; }
}
__device__ __forceinline__ void row_modulate(const f32x4 (&h)[4], const float* shift, const float* scale, int lane, f32x4 (&u)[4]) {
#pragma unroll
  for (int j = 0; j < 4; ++j) { const f32x4 sh = *(const f32x4*)(shift + 4 * lane + 256 * j), sc = *(const f32x4*)(scale + 4 * lane + 256 * j); u[j] = h[j] * (sc + 1.f) + sh; }
}
__device__ __forceinline__ void row_dot32(const f32x4 (&u)[4], const LAS float* Wt, int lane, float* out32) {
  float myv = 0.f;
#pragma unroll 4
  for (int c = 0; c < 32; ++c) {
    float s = 0.f;
#pragma unroll
    for (int j = 0; j < 4; ++j) { const f32x4 w = *(const LAS f32x4*)(Wt + c * 1024 + 4 * lane + 256 * j); s += (u[j][0] * w[0] + u[j][1] * w[1]) + (u[j][2] * w[2] + u[j][3] * w[3]); }
    s = wave_sum(s);
    if (lane == c) myv = s;
  }
  if (lane < 32) out32[lane] = myv;
}
__device__ __forceinline__ void stage_cols32(const float* W, int ldw, int col0, LAS float* Wt, int tid) {
  for (int i = tid; i < 1024 * 32; i += NT) { const int k = i >> 5, c = i & 31; Wt[c * 1024 + k] = W[(size_t)k * ldw + col0 + c]; }
}
__device__ __forceinline__ const float* lat_or_ctx(const float* lat, const float* ctxp, int r) {
  const int b = r / TB, pos = r % TB;
  return pos < CTXL ? ctxp + ((size_t)b * CTXL + pos) * D : lat + ((size_t)b * SEQ + (pos - CTXL)) * D;
}
__device__ __forceinline__ float* lat_or_ctx_w(float* lat, float* ctxp, int r) {
  const int b = r / TB, pos = r % TB;
  return pos < CTXL ? ctxp + ((size_t)b * CTXL + pos) * D : lat + ((size_t)b * SEQ + (pos - CTXL)) * D;
}
__device__ __forceinline__ int row_b5(int r) { const int b = r / TB, pos = r % TB; return pos < CTXL ? 4 : b; }

__device__ __forceinline__ void phase0(const Params& P, const Ctx& C) {
  LAS float* sv = (LAS float*)C.lds;
  LAS float* part = (LAS float*)(C.lds + 20480);
  LAS float* scr = (LAS float*)(C.lds + 32768) + C.wave * (64 * 33);
  for (int i = C.tid; i < 5 * 1024; i += NT) { const float x = i < 4096 ? GIN(I_C)[i] : GIN(I_CCTX)[i - 4096]; sv[i] = siluf_(x); }
  __syncthreads();
  float* MOD = WS(OFF_MOD, float);
  for (int task = C.bid; task < 2 * 96; task += C.nblk) {
    const int l = task / 96, n0 = (task % 96) * 64;
    const float* W = GIN(I_ADAW) + (size_t)l * D * 6144 + n0 + C.lane;
    float acc[5] = {0.f, 0.f, 0.f, 0.f, 0.f};
    const int kbeg = C.wave * 128;
#pragma unroll 8
    for (int k = kbeg; k < kbeg + 128; ++k) { const float w = W[(size_t)k * 6144];
#pragma unroll
      for (int r = 0; r < 5; ++r) acc[r] += sv[r * 1024 + k] * w; }
#pragma unroll
    for (int r = 0; r < 5; ++r) part[(C.wave * 5 + r) * 64 + C.lane] = acc[r];
    __syncthreads();
    if (C.tid < 320) { const int r = C.tid / 64, c = C.tid % 64; float s = GIN(I_ADAB)[l * 6144 + n0 + c];
#pragma unroll
      for (int w = 0; w < 8; ++w) s += part[(w * 5 + r) * 64 + c];
      MOD[((size_t)l * 5 + r) * 6144 + n0 + c] = s; }
    __syncthreads();
  }
  if (C.bid == C.nblk - 1) { float* LB = WS(OFF_LB1, float); for (int i = C.tid; i < 1024; i += NT) { const float a = GIN(I_HLB)[i], b = GIN(I_HLB)[1024 + i]; LB[i] = 1.f / (1.f + __expf(a - b)); } }
  constexpr int N_AB = 16 * 144, N_OUT = 32 * 32, N_G1 = 16 * 32;
  constexpr int TOT = N_AB + 2 * N_OUT + 2 * N_G1;
  for (int it = C.gw; it < TOT; it += C.ngw) {
    int r = it;
    if (r < N_AB) { transpose_mat_item(GIN(I_ABW), AB_IN, 0, D, Z0W, WS(OFF_WAB, bf16_t), D, 0, r, scr, C.lane); continue; } r -= N_AB;
    if (r < N_OUT) { transpose_mat_item(GIN(I_OUTW), D, 0, 2048, D, WS(OFF_WOUT0, bf16_t), 2048, 0, r, scr, C.lane); continue; } r -= N_OUT;
    if (r < N_OUT) { transpose_mat_item(GIN(I_OUTW) + (size_t)2048 * D, D, 0, 2048, D, WS(OFF_WOUT1, bf16_t), 2048, 0, r, scr, C.lane); continue; } r -= N_OUT;
    if (r < N_G1) { transpose_mat_item(GIN(I_CDW), CD_IN, 3072, D, 1024, WS(OFF_WG1, bf16_t), D, 0, r, scr, C.lane); continue; } r -= N_G1;
    transpose_mat_item(GIN(I_CDW), CD_IN, 8224, D, 1024, WS(OFF_WG1, bf16_t) + (size_t)1024 * D, D, 0, r, scr, C.lane);
  }
  for (int it = C.gw; it < 16; it += C.ngw) transpose_mat_item(GIN(I_ABW), AB_IN, 4608, D, 32, WS(OFF_WAB, bf16_t) + (size_t)4608 * D, D, 0, it, scr, C.lane);
  { u32x4* z = (u32x4*)(WS(OFF_WAB, bf16_t) + (size_t)4640 * D); const u32x4 zz = {0u, 0u, 0u, 0u};
    for (int i = C.bid * NT + C.tid; i < 224 * D * 2 / 16; i += C.nblk * NT) z[i] = zz; }
  convert_experts(P, 0, WS(OFF_WE0, bf16_t), WS(OFF_WE0 + 64 * MiB, bf16_t), C, scr);
}

__device__ __forceinline__ void phase_u0(const Params& P, const Ctx& C) {
  const float* MOD = WS(OFF_MOD, float); bf16_t* U = WS(OFF_U0, bf16_t);
  f32x4 h[4], hn[4];
  if (C.gw < R) row_load(lat_or_ctx(GIN(I_X), GIN(I_CTX), C.gw), C.lane, h);
  for (int r = C.gw; r < R; r += C.ngw) {
    if (r + C.ngw < R) row_load(lat_or_ctx(GIN(I_X), GIN(I_CTX), r + C.ngw), C.lane, hn);
    f32x4 u[4];
    const float* m = MOD + (size_t)row_b5(r) * 6144;
    row_modulate(h, m, m + D, C.lane, u);
    row_store_bf16(U + (size_t)r * D, C.lane, u);
#pragma unroll
    for (int j = 0; j < 4; ++j) h[j] = hn[j];
  }
}

__device__ __forceinline__ void phase_inproj(const Params& P, const Ctx& C, const bf16_t* U, const bf16_t* W, bf16_t* Z, int zw) {
  pg8::Gemm g{U, W, D, D}; pg8::GridOrder S; S.init(R / 256, zw / 256 + 1, C.nblk, C.bid, 0);
  pg8::EpiInProj E{Z, zw, zw / 256, WS(OFF_DT, float)};
  pg8::gemm_phase(C.lds, g, S, E);
}

__device__ __forceinline__ void conv_task(bf16_t* Z, int zw, int row0, int L, int col, const float* cw, int cwld, int cch, const float* cb, int mode, float qscale, int lane, int ident = 0) {
  float w[4][2];
#pragma unroll
  for (int j = 0; j < 4; ++j) { w[j][0] = cw[j * cwld + cch + 2 * lane]; w[j][1] = cw[j * cwld + cch + 2 * lane + 1]; }
  const float b0 = cb ? cb[cch + 2 * lane] : 0.f, b1 = cb ? cb[cch + 2 * lane + 1] : 0.f;
  unsigned* base = (unsigned*)(Z + (size_t)row0 * zw + col) + lane;
  const size_t rs = (size_t)zw / 2;
  float pm2[2] = {0.f, 0.f}, pm1[2] = {0.f, 0.f};
  for (int t0 = 0; t0 < L; t0 += 16) {
    unsigned v[17];
#pragma unroll
    for (int i = 0; i < 16; ++i) v[i] = base[(size_t)(t0 + i) * rs];
    v[16] = (t0 + 16 < L) ? base[(size_t)(t0 + 16) * rs] : 0u;
    unsigned o[16];
#pragma unroll
    for (int i = 0; i < 16; ++i) {
      const float x0 = bflo(v[i]), x1 = bfhi(v[i]), n0 = bflo(v[i + 1]), n1 = bfhi(v[i + 1]);
      float y0 = w[0][0] * pm2[0] + w[1][0] * pm1[0] + w[2][0] * x0 + w[3][0] * n0 + b0;
      float y1 = w[0][1] * pm2[1] + w[1][1] * pm1[1] + w[2][1] * x1 + w[3][1] * n1 + b1;
      pm2[0] = pm1[0]; pm2[1] = pm1[1]; pm1[0] = x0; pm1[1] = x1;
      if (mode >= 1) { y0 = siluf_(y0); y1 = siluf_(y1); }
      if (mode == 2) { const float ss = wave_sum(y0 * y0 + y1 * y1); const float sc = rsqrtf(ss + RMS_EPS) * qscale; y0 *= sc; y1 *= sc; }
      o[i] = ident ? v[i] : pk2(y0, y1);
    }
#pragma unroll
    for (int i = 0; i < 16; ++i) base[(size_t)(t0 + i) * rs] = o[i];
  }
}
__device__ __forceinline__ void seg_rows(int seg, int& row0, int& L) {
  const int b = seg / 129, s = seg % 129;
  if (s == 0) { row0 = b * TB; L = CTXL; } else { row0 = b * TB + CTXL + (s - 1) * 64; L = 64; }
}
__device__ __forceinline__ void phase_feat0(const Params& P, const Ctx& C, int ident) {
  bf16_t* Z = WS(OFF_Z0, bf16_t);
  for (int task = C.gw; task < NB * 129 * 20; task += C.ngw) {
    const int seg = task / 20, cg = task % 20; int row0, L; seg_rows(seg, row0, L);
    if (cg < 8) conv_task(Z, Z0W, row0, L, Z0_RGX + cg * 128, GIN(I_RGCW), 1024, cg * 128, GIN(I_RGCB), 0, 1.f, C.lane, ident);
    else conv_task(Z, Z0W, row0, L, Z0_XBC + (cg - 8) * 128, GIN(I_SCW), 1536, (cg - 8) * 128, GIN(I_SCB), 1, 1.f, C.lane, ident);
  }
}
__device__ __forceinline__ void phase_feat1(const Params& P, const Ctx& C, int ident) {
  bf16_t* Z = WS(OFF_Z1, bf16_t);
  for (int task = C.gw; task < NB * 129 * 24; task += C.ngw) {
    const int seg = task / 24, cg = task % 24; int row0, L; seg_rows(seg, row0, L);
    if (cg < 16) conv_task(Z, Z1W, row0, L, cg * 128, GIN(I_GCW), 3072, cg * 128, nullptr, 2, cg < 8 ? 0.08838834764831845f : 1.f, C.lane, ident);
    else conv_task(Z, Z1W, row0, L, cg * 128, GIN(I_GCW), 3072, cg * 128, nullptr, 1, 1.f, C.lane, ident);
  }
}

__device__ __forceinline__ int seq_pos(int dir, int j) { return dir == 0 ? j : (j < CTXL ? CTXL - 1 - j : TB - 1 - (j - CTXL)); }
__device__ __forceinline__ int seq_chunk(int dir, int j) { return dir == 0 ? j : (j < 4 ? 3 - j : 135 - j); }

__device__ __forceinline__ void rg_task(const Params& P, const Ctx& C, int task) {
  const int b = task >> 6, h = (task >> 3) & 7, q = task & 7;
  LAS float* Wl = (LAS float*)C.lds;
  LAS float* xc = Wl + 2 * 2 * 128 * 16;
  LAS float* SA = xc + 64 * 129;
  LAS float* SU = SA + 16 * 64;
  const bf16_t* Z = WS(OFF_Z0, bf16_t); bf16_t* MIX = WS(OFF_MIX0, bf16_t);
  __syncthreads();
  for (int i = C.tid; i < 2 * 2 * 128 * 16; i += NT) { const int j = i & 15, ii = (i >> 4) & 127, gate = (i >> 11) & 1, d = i >> 12;
    const float* W = (gate ? GIN(I_RGXW) : GIN(I_RGAW)) + ((size_t)(d * 8 + h) * 128 + ii) * 128 + q * 16 + j; Wl[i] = *W; }
  const int j = C.tid & 15, tg = C.tid >> 4;
  const int ch = h * 128 + q * 16 + j;
  const int sch = C.wave * 2;
  for (int d = 0; d < 2; ++d) {
    const float ba = GIN(I_RGAB)[d * 1024 + ch], bx = GIN(I_RGXB)[d * 1024 + ch], spl = softplusf_(-GIN(I_RGLAM)[d * 1024 + ch]);
    float hin0 = 0.f, hin1 = 0.f;
    for (int cs = 0; cs < 132; ++cs) {
      const int chunk = seq_chunk(d, cs), row0 = b * TB + chunk * 64;
      __syncthreads();
      { const int t = C.tid >> 3, sg = C.tid & 7; const u32x4* src = (const u32x4*)(Z + (size_t)(row0 + t) * Z0W + Z0_RGX + h * 128 + sg * 16);
        const u32x4 a = src[0], bb = src[1]; LAS float* dst = xc + t * 129 + sg * 16;
        dst[0] = bflo(a.x); dst[1] = bfhi(a.x); dst[2] = bflo(a.y); dst[3] = bfhi(a.y); dst[4] = bflo(a.z); dst[5] = bfhi(a.z); dst[6] = bflo(a.w); dst[7] = bfhi(a.w);
        dst[8] = bflo(bb.x); dst[9] = bfhi(bb.x); dst[10] = bflo(bb.y); dst[11] = bfhi(bb.y); dst[12] = bflo(bb.z); dst[13] = bfhi(bb.z); dst[14] = bflo(bb.w); dst[15] = bfhi(bb.w); }
      __syncthreads();
      { const LAS float* Wa = Wl + (d * 2 + 0) * 2048 + j; const LAS float* Wx = Wl + (d * 2 + 1) * 2048 + j;
        const LAS float* x0 = xc + (2 * tg) * 129; const LAS float* x1 = x0 + 129;
        float aa0 = 0.f, aa1 = 0.f, ax0 = 0.f, ax1 = 0.f;
#pragma unroll 8
        for (int i = 0; i < 128; ++i) { const float wa = Wa[i * 16], wx = Wx[i * 16], v0 = x0[i], v1 = x1[i]; aa0 += v0 * wa; aa1 += v1 * wa; ax0 += v0 * wx; ax1 += v1 * wx; }
#pragma unroll
        for (int tt = 0; tt < 2; ++tt) { const int t = 2 * tg + tt; const float pa = tt ? aa1 : aa0, px = tt ? ax1 : ax0;
          const float r = sigmoidf_(pa + ba), ig = sigmoidf_(px + bx); const float la = -8.f * r * spl; const float xv = xc[t * 129 + q * 16 + j];
          SA[j * 64 + t] = __expf(la); SU[j * 64 + t] = sqrtf(-expm1f(2.f * la)) * (ig * xv); } }
      __syncthreads();
#pragma unroll
      for (int cc = 0; cc < 2; ++cc) {
        const int lc = sch + cc; const int t = d == 0 ? C.lane : 63 - C.lane;
        float A = SA[lc * 64 + t], Bv = SU[lc * 64 + t];
#pragma unroll
        for (int off = 1; off < 64; off <<= 1) { const float Ap = __shfl_up(A, off), Bp = __shfl_up(Bv, off); if (C.lane >= off) { Bv = A * Bp + Bv; A = A * Ap; } }
        const float hin = cc ? hin1 : hin0; const float hv = Bv + A * hin;
        const float hlast = __shfl(hv, 63); if (cc) hin1 = hlast; else hin0 = hlast;
        const int gch = h * 128 + q * 16 + lc; bf16_t* o = MIX + (size_t)(row0 + t) * MIXW + gch;
        if (d == 0) *o = (bf16_t)f2bf(hv);
        else { const float hf = bf2f(*o); const float gy = bf2f(Z[(size_t)(row0 + t) * Z0W + Z0_RGY + gch]); *o = (bf16_t)f2bf((hf + hv) * geluf_(gy)); }
      }
    }
    __threadfence_block();
  }
}
__device__ __forceinline__ void ssd_task(const Params& P, const Ctx& C, int task) {
  const int b = task >> 9, hd = (task >> 5) & 15, ps = task & 31, g = hd >> 3;
  const int c = C.lane >> 5, ng = C.lane & 31;
  const bf16_t* Z = WS(OFF_Z0, bf16_t); bf16_t* MIX = WS(OFF_MIX0, bf16_t); const float* DT = WS(OFF_DT, float);
  const int colx = Z0_XBC + hd * 64 + 2 * ps + c, colB = Z0_B + g * 128 + 4 * ng, colC = Z0_C + g * 128 + 4 * ng, outc = 1024 + hd * 64 + 2 * ps + c;
  for (int d = 0; d < 2; ++d) {
    const float Aneg = -__expf(GIN(I_SALOG)[d * 16 + hd]), dtb = GIN(I_SDTB)[d * 16 + hd];
    float S0 = 0.f, S1 = 0.f, S2 = 0.f, S3 = 0.f;
    for (int j0 = 0; j0 < TB; j0 += 8) {
      u32x2 Bv[8], Cv[8]; unsigned short xv[8], yp[8]; float dtr[8];
#pragma unroll
      for (int u = 0; u < 8; ++u) { const size_t row = (size_t)b * TB + seq_pos(d, j0 + u);
        Bv[u] = *(const u32x2*)(Z + row * Z0W + colB); Cv[u] = *(const u32x2*)(Z + row * Z0W + colC); xv[u] = Z[row * Z0W + colx]; dtr[u] = DT[row * 32 + d * 16 + hd];
        yp[u] = d ? MIX[row * MIXW + outc] : (unsigned short)0; }
#pragma unroll
      for (int u = 0; u < 8; ++u) { const size_t row = (size_t)b * TB + seq_pos(d, j0 + u);
        const float dt = softplusf_(dtr[u] + dtb), a = __expf(Aneg * dt), xdt = bf2f(xv[u]) * dt;
        S0 = a * S0 + bflo(Bv[u].x) * xdt; S1 = a * S1 + bfhi(Bv[u].x) * xdt; S2 = a * S2 + bflo(Bv[u].y) * xdt; S3 = a * S3 + bfhi(Bv[u].y) * xdt;
        float y = (bflo(Cv[u].x) * S0 + bfhi(Cv[u].x) * S1) + (bflo(Cv[u].y) * S2 + bfhi(Cv[u].y) * S3);
        y = half_sum32(y);
        if (ng == 0) MIX[row * MIXW + outc] = (bf16_t)f2bf(y + bf2f(yp[u])); }
    }
    __threadfence_block();
  }
}

#define LBAR() do { asm volatile("s_waitcnt lgkmcnt(0)" ::: "memory"); __builtin_amdgcn_s_barrier(); asm volatile("" ::: "memory"); } while (0)
#define VMWAIT() asm volatile("s_waitcnt vmcnt(0)" ::: "memory")
typedef short s16x4 __attribute__((ext_vector_type(4)));
__device__ __forceinline__ bf16x8 frag_row(const LAS bf16_t* base, int ld, int r0, int k0, int lane) {
  return *(const LAS bf16x8*)(base + (r0 + (lane & 15)) * ld + k0 + 8 * (lane >> 4));
}
__device__ __forceinline__ bf16x8 frag_tr(const LAS bf16_t* base, int ld, int k0, int n0, int lane) {
  const int g = lane >> 4, q = (lane & 15) >> 2, p = lane & 3;
  const LAS bf16_t* a0 = base + (k0 + 8 * g + q) * ld + n0 + 4 * p;
  const s16x4 v0 = __builtin_amdgcn_ds_read_tr16_b64_v4i16((LAS s16x4*)a0);
  const s16x4 v1 = __builtin_amdgcn_ds_read_tr16_b64_v4i16((LAS s16x4*)(a0 + 4 * ld));
  bf16x8 r; r[0] = v0[0]; r[1] = v0[1]; r[2] = v0[2]; r[3] = v0[3]; r[4] = v1[0]; r[5] = v1[1]; r[6] = v1[2]; r[7] = v1[3];
  return r;
}
__device__ __forceinline__ f32x4 mma16(bf16x8 fa, bf16x8 fb, f32x4 acc) { return __builtin_amdgcn_mfma_f32_16x16x32_bf16(fa, fb, acc, 0, 0, 0); }
__device__ __forceinline__ float wave_incl_scan(float v, int lane) {
#pragma unroll
  for (int off = 1; off < 64; off <<= 1) { const float p = __shfl_up(v, off); if (lane >= off) v += p; }
  return v;
}
__device__ __forceinline__ void tri_tile(int tt, int& I, int& J) { I = tt >= 6 ? 3 : (tt >= 3 ? 2 : (tt >= 1 ? 1 : 0)); J = tt - (I * (I + 1)) / 2; }
__device__ __forceinline__ unsigned long long ld_agent_u64(const void* p) { return __hip_atomic_load((const unsigned long long*)p, __ATOMIC_RELAXED, __HIP_MEMORY_SCOPE_AGENT); }
__device__ __forceinline__ bool fwd_first(int c) { return c < 4 ? (c <= 1) : (c <= 67); }

__device__ __forceinline__ void ssd_chain_wg(const Params& P, const Ctx& C, int task) {
  const int b = task >> 5, hd = (task >> 1) & 15, ps = task & 1, g = hd >> 3;
  const int d = C.wave >> 2, w = C.wave & 3, td = C.tid & 255, lane = C.lane, fr = lane & 15, fq = lane >> 4;
  constexpr int LDN = 136, LDP = 40, LDT = 72;
  constexpr int DIRSZ = 78 * 1024;
  LAS unsigned char* L = C.lds + d * DIRSZ;
  LAS bf16_t* Cs = (LAS bf16_t*)L;
  LAS bf16_t* Bs = Cs + 64 * LDN;
  LAS bf16_t* Xd = Bs + 64 * LDN;
  LAS bf16_t* Xw = Xd + 64 * LDP;
  LAS bf16_t* Pt = Xw + 64 * LDP;
  LAS bf16_t* St = Pt + 64 * LDT;
  LAS float* dtL = (LAS float*)(St + 2 * 32 * LDN);
  const bf16_t* Z = WS(OFF_Z0, bf16_t); bf16_t* MIX = WS(OFF_MIX0, bf16_t); const float* DT = WS(OFF_DT, float);
  const float Aneg = -__expf(GIN(I_SALOG)[d * 16 + hd]), dtb = GIN(I_SDTB)[d * 16 + hd];
  const int colC = Z0_C + g * 128, colB = Z0_B + g * 128, colX = Z0_XBC + hd * 64 + ps * 32, outc = 1024 + hd * 64 + ps * 32;
  __syncthreads();
  for (int i = td; i < 64 * LDT / 2; i += 256) ((LAS unsigned*)Pt)[i] = 0u;
  for (int i = td; i < 2 * 32 * LDN / 2; i += 256) ((LAS unsigned*)St)[i] = 0u;
  f32x4 Sacc[2][2];
#pragma unroll
  for (int a = 0; a < 2; ++a)
#pragma unroll
    for (int c = 0; c < 2; ++c) Sacc[a][c] = (f32x4){0.f, 0.f, 0.f, 0.f};
  const int st_t = td >> 2, st_q = td & 3;
  u32x4 rc[4], rb[4], rx; float rdt = 0.f;
  auto issue_loads = [&](int step) {
    const int chunk = seq_chunk(d, step); const size_t row = (size_t)b * TB + chunk * 64 + st_t;
    const u32x4* pc = (const u32x4*)(Z + row * Z0W + colC + st_q * 32); const u32x4* pb = (const u32x4*)(Z + row * Z0W + colB + st_q * 32);
#pragma unroll
    for (int i = 0; i < 4; ++i) { rc[i] = pc[i]; rb[i] = pb[i]; }
    rx = *(const u32x4*)(Z + row * Z0W + colX + st_q * 8);
    rdt = DT[row * 32 + d * 16 + hd];
  };
  issue_loads(0);
  for (int step = 0; step < 132; ++step) {
    const int chunk = seq_chunk(d, step); const int row0 = b * TB + chunk * 64;
    VMWAIT();
    { const int i = d ? 63 - st_t : st_t; const float dt = softplusf_(rdt + dtb);
      LAS u32x4* dc = (LAS u32x4*)(Cs + i * LDN + st_q * 32); LAS u32x4* db = (LAS u32x4*)(Bs + i * LDN + st_q * 32);
#pragma unroll
      for (int k = 0; k < 4; ++k) { dc[k] = rc[k]; db[k] = rb[k]; }
      u32x4 xo; xo.x = pk2(bflo(rx.x) * dt, bfhi(rx.x) * dt); xo.y = pk2(bflo(rx.y) * dt, bfhi(rx.y) * dt); xo.z = pk2(bflo(rx.z) * dt, bfhi(rx.z) * dt); xo.w = pk2(bflo(rx.w) * dt, bfhi(rx.w) * dt);
      *(LAS u32x4*)(Xd + i * LDP + st_q * 8) = xo;
      if (st_q == 0) dtL[i] = dt; }
    LBAR();
    if (step + 1 < 132) issue_loads(step + 1);
    const bool first = (d == 0) == fwd_first(chunk);
    bf16_t* op0; unsigned long long ppv[2] = {0ull, 0ull};
    { const int ii = 16 * w + fr; const int t = d ? 63 - ii : ii; op0 = MIX + (size_t)(row0 + t) * MIXW + outc + 4 * fq;
      if (!first) { ppv[0] = ld_agent_u64(op0); ppv[1] = ld_agent_u64(op0 + 16); } }
    const float cum = wave_incl_scan(Aneg * dtL[lane], lane);
    const float cum_last = __shfl(cum, 63);
    { const int i = td >> 2; const float sc = __expf(cum_last - __shfl(cum, i & 63));
      const u32x4 v = *(const LAS u32x4*)(Xd + i * LDP + (td & 3) * 8);
      u32x4 o; o.x = pk2(bflo(v.x) * sc, bfhi(v.x) * sc); o.y = pk2(bflo(v.y) * sc, bfhi(v.y) * sc); o.z = pk2(bflo(v.z) * sc, bfhi(v.z) * sc); o.w = pk2(bflo(v.w) * sc, bfhi(v.w) * sc);
      *(LAS u32x4*)(Xw + i * LDP + (td & 3) * 8) = o; }
    for (int tt = w; tt < 10; tt += 4) {
      int I, J; tri_tile(tt, I, J);
      f32x4 acc = (f32x4){0.f, 0.f, 0.f, 0.f};
#pragma unroll
      for (int k = 0; k < 4; ++k) acc = mma16(frag_row(Cs, LDN, 16 * I, 32 * k, lane), frag_row(Bs, LDN, 16 * J, 32 * k, lane), acc);
      const int jj = 16 * J + fr; const float cj = __shfl(cum, jj);
      u32x2 o; float pv[4];
#pragma unroll
      for (int r = 0; r < 4; ++r) { const int ii = 16 * I + 4 * fq + r; const float ci = __shfl(cum, ii); pv[r] = (jj <= ii) ? acc[r] * __expf(ci - cj) : 0.f; }
      o.x = pk2(pv[0], pv[1]); o.y = pk2(pv[2], pv[3]);
      *(LAS u32x2*)(Pt + jj * LDT + 16 * I + 4 * fq) = o;
    }
    LBAR();
    const LAS bf16_t* Sr = St + (step & 1) * 32 * LDN; LAS bf16_t* Sw = St + ((step + 1) & 1) * 32 * LDN;
    { const int I = w; const int nks = I < 2 ? 1 : 2;
      const int ii = 16 * I + fr; const float eci = __expf(__shfl(cum, ii));
#pragma unroll
      for (int pt = 0; pt < 2; ++pt) {
        f32x4 y1 = (f32x4){0.f, 0.f, 0.f, 0.f}, y2 = (f32x4){0.f, 0.f, 0.f, 0.f};
        for (int k = 0; k < nks; ++k) y1 = mma16(frag_tr(Xd, LDP, 32 * k, 16 * pt, lane), frag_tr(Pt, LDT, 32 * k, 16 * I, lane), y1);
#pragma unroll
        for (int k = 0; k < 4; ++k) y2 = mma16(frag_row(Sr, LDN, 16 * pt, 32 * k, lane), frag_row(Cs, LDN, 16 * I, 32 * k, lane), y2);
        bf16_t* op = op0 + 16 * pt;
        float o0 = y1[0] + eci * y2[0], o1 = y1[1] + eci * y2[1], o2 = y1[2] + eci * y2[2], o3 = y1[3] + eci * y2[3];
        if (!first) { const unsigned long long pv = ppv[pt]; const unsigned lo = (unsigned)pv, hi = (unsigned)(pv >> 32); o0 += bflo(lo); o1 += bfhi(lo); o2 += bflo(hi); o3 += bfhi(hi); }
        u32x2 o; o.x = pk2(o0, o1); o.y = pk2(o2, o3); *(u32x2*)op = o;
      } }
    { const float el = __expf(cum_last);
#pragma unroll
      for (int a = 0; a < 2; ++a)
#pragma unroll
        for (int c = 0; c < 2; ++c) { f32x4 acc = Sacc[a][c] * el;
#pragma unroll
          for (int k = 0; k < 2; ++k) acc = mma16(frag_tr(Bs, LDN, 32 * k, 16 * (2 * w + a), lane), frag_tr(Xw, LDP, 32 * k, 16 * c, lane), acc);
          Sacc[a][c] = acc;
          u32x2 o; o.x = pk2(acc[0], acc[1]); o.y = pk2(acc[2], acc[3]);
          *(LAS u32x2*)(Sw + (16 * c + fr) * LDN + 16 * (2 * w + a) + 4 * fq) = o; } }
    LBAR();
  }
}

template <int N> __device__ __forceinline__ float dpp_shr(float oldv, float v) {
  return __builtin_bit_cast(float, __builtin_amdgcn_update_dpp(__builtin_bit_cast(int, oldv), __builtin_bit_cast(int, v), 0x110 + N, 0xf, 0xf, false));
}
__device__ __forceinline__ float fast_sigmoid(float x) { return __builtin_amdgcn_rcpf(1.f + __expf(-x)); }
__device__ __forceinline__ void rg_chain_wg(const Params& P, const Ctx& C, int task) {
  const int b = task >> 5, h = (task >> 2) & 7, q = task & 3;
  const int d = C.wave >> 2, w = C.wave & 3, td = C.tid & 255, lane = C.lane, fr = lane & 15, fq = lane >> 4;
  constexpr int LDN = 136, LDW = 72;
  constexpr int DIRSZ = 40 * 1024;
  LAS unsigned char* L = C.lds + d * DIRSZ;
  LAS bf16_t* Xc = (LAS bf16_t*)L;
  LAS bf16_t* Wl = Xc + 64 * LDN;
  LAS float* Sum = (LAS float*)(Wl + 128 * LDW);
  const bf16_t* Z = WS(OFF_Z0, bf16_t); bf16_t* MIX = WS(OFF_MIX0, bf16_t);
  const int ch0 = h * 128 + q * 32;
  __syncthreads();
#pragma unroll 2
  for (int i = td; i < 128 * 64; i += 256) { const int ii = i >> 6, j = i & 63, gate = j >> 5, jj = j & 31;
    const float* W = (gate ? GIN(I_RGXW) : GIN(I_RGAW)) + ((size_t)(d * 8 + h) * 128 + ii) * 128 + q * 32 + jj; Wl[ii * LDW + j] = (bf16_t)f2bf(*W); }
  float ba[8], bx[8], spl[8], hc[8];
#pragma unroll
  for (int e = 0; e < 8; ++e) { const int c = ch0 + 16 * (e >> 2) + 4 * fq + (e & 3);
    ba[e] = GIN(I_RGAB)[d * 1024 + c]; bx[e] = GIN(I_RGXB)[d * 1024 + c]; spl[e] = -8.f * softplusf_(-GIN(I_RGLAM)[d * 1024 + c]); hc[e] = 0.f; }
  const int st_t = td >> 2, st_p = td & 3;
  u32x4 rx[4];
  auto issue_loads = [&](int step) {
    const int chunk = seq_chunk(d, step); const size_t row = (size_t)b * TB + chunk * 64 + st_t;
    const u32x4* px = (const u32x4*)(Z + row * Z0W + Z0_RGX + h * 128 + st_p * 32);
#pragma unroll
    for (int i = 0; i < 4; ++i) rx[i] = px[i];
  };
  issue_loads(0);
  __syncthreads();
  const int ii = 16 * w + fr;
  const LAS bf16_t* xrow = Xc + ii * LDN + q * 32 + 4 * fq;
  for (int step = 0; step < 132; ++step) {
    const int chunk = seq_chunk(d, step); const int row0 = b * TB + chunk * 64;
    VMWAIT();
    { const int i = d ? 63 - st_t : st_t; LAS u32x4* dx = (LAS u32x4*)(Xc + i * LDN + st_p * 32);
#pragma unroll
      for (int k = 0; k < 4; ++k) dx[k] = rx[k]; }
    LBAR();
    if (step + 1 < 132) issue_loads(step + 1);
    const bool first = (d == 0) == fwd_first(chunk);
    const int t = d ? 63 - ii : ii;
    bf16_t* op = MIX + (size_t)(row0 + t) * MIXW + ch0 + 4 * fq;
    unsigned long long ppv[2] = {0ull, 0ull}; u32x2 gy[2] = {(u32x2){0u, 0u}, (u32x2){0u, 0u}};
    if (!first) { ppv[0] = ld_agent_u64(op); ppv[1] = ld_agent_u64(op + 16);
      const bf16_t* gp = Z + (size_t)(row0 + t) * Z0W + Z0_RGY + ch0 + 4 * fq; gy[0] = *(const u32x2*)gp; gy[1] = *(const u32x2*)(gp + 16); }
    f32x4 ga[2], gx[2];
#pragma unroll
    for (int jt = 0; jt < 2; ++jt) { ga[jt] = (f32x4){0.f, 0.f, 0.f, 0.f}; gx[jt] = (f32x4){0.f, 0.f, 0.f, 0.f}; }
#pragma unroll
    for (int k = 0; k < 4; ++k) { const bf16x8 fb = frag_row(Xc, LDN, 16 * w, 32 * k, lane);
#pragma unroll
      for (int jt = 0; jt < 2; ++jt) { ga[jt] = mma16(frag_tr(Wl, LDW, 32 * k, 16 * jt, lane), fb, ga[jt]); gx[jt] = mma16(frag_tr(Wl, LDW, 32 * k, 32 + 16 * jt, lane), fb, gx[jt]); } }
    float A[8], Bv[8];
#pragma unroll
    for (int jt = 0; jt < 2; ++jt) { const u32x2 xw = *(const LAS u32x2*)(xrow + 16 * jt); const float xv[4] = {bflo(xw.x), bfhi(xw.x), bflo(xw.y), bfhi(xw.y)};
#pragma unroll
      for (int r = 0; r < 4; ++r) { const int e = 4 * jt + r;
        const float rg = fast_sigmoid(ga[jt][r] + ba[e]), ig = fast_sigmoid(gx[jt][r] + bx[e]); const float la = rg * spl[e];
        const float a = __expf(la); A[e] = a; Bv[e] = sqrtf(fmaxf(1.f - a * a, 0.f)) * (ig * xv[r]); } }
#pragma unroll
    for (int e = 0; e < 8; ++e) {
      { const float Ap = dpp_shr<1>(1.f, A[e]), Bp = dpp_shr<1>(0.f, Bv[e]); Bv[e] = A[e] * Bp + Bv[e]; A[e] = A[e] * Ap; }
      { const float Ap = dpp_shr<2>(1.f, A[e]), Bp = dpp_shr<2>(0.f, Bv[e]); Bv[e] = A[e] * Bp + Bv[e]; A[e] = A[e] * Ap; }
      { const float Ap = dpp_shr<4>(1.f, A[e]), Bp = dpp_shr<4>(0.f, Bv[e]); Bv[e] = A[e] * Bp + Bv[e]; A[e] = A[e] * Ap; }
      { const float Ap = dpp_shr<8>(1.f, A[e]), Bp = dpp_shr<8>(0.f, Bv[e]); Bv[e] = A[e] * Bp + Bv[e]; A[e] = A[e] * Ap; } }
    if (fr == 15) {
#pragma unroll
      for (int e = 0; e < 8; ++e) { f32x2 sv; sv[0] = A[e]; sv[1] = Bv[e]; *(LAS f32x2*)(Sum + ((w * 32) + 16 * (e >> 2) + 4 * fq + (e & 3)) * 2) = sv; } }
    LBAR();
    float hin[8];
#pragma unroll
    for (int e = 0; e < 8; ++e) { float hh = hc[e]; const int c = 16 * (e >> 2) + 4 * fq + (e & 3);
#pragma unroll
      for (int tt = 0; tt < 4; ++tt) { const f32x2 sv = *(const LAS f32x2*)(Sum + (tt * 32 + c) * 2); if (tt == w) hin[e] = hh; hh = sv[0] * hh + sv[1]; }
      hc[e] = hh; }
#pragma unroll
    for (int jt = 0; jt < 2; ++jt) { float hv[4];
#pragma unroll
      for (int r = 0; r < 4; ++r) hv[r] = Bv[4 * jt + r] + A[4 * jt + r] * hin[4 * jt + r];
      if (!first) { const unsigned lo = (unsigned)ppv[jt], hi = (unsigned)(ppv[jt] >> 32);
        const float gyv[4] = {bflo(gy[jt].x), bfhi(gy[jt].x), bflo(gy[jt].y), bfhi(gy[jt].y)}; const float pf[4] = {bflo(lo), bfhi(lo), bflo(hi), bfhi(hi)};
#pragma unroll
        for (int r = 0; r < 4; ++r) { const float x = gyv[r]; const float u2 = 1.5957691216057308f * (x + 0.044715f * x * x * x); hv[r] = (hv[r] + pf[r]) * x * fast_sigmoid(u2); } }
      u32x2 o; o.x = pg8::cvt_pk_bf16(hv[0], hv[1]); o.y = pg8::cvt_pk_bf16(hv[2], hv[3]); *(u32x2*)(op + 16 * jt) = o; }
  }
}
__device__ __forceinline__ void phase_chain0(const Params& P, const Ctx& C, int mode) {
  if (mode != 2) for (int task = C.bid; task < 128; task += C.nblk) ssd_chain_wg(P, C, task);
  __builtin_amdgcn_sched_barrier(0);
  if (mode != 1) for (int task = C.bid < 128 ? C.bid + C.nblk : C.bid; task < 256; task += C.nblk) rg_chain_wg(P, C, task - 128);
}
__device__ __forceinline__ void phase_ssdfin(const Params& P, const Ctx& C, int ident) {
  const bf16_t* Z = WS(OFF_Z0, bf16_t); bf16_t* MIX = WS(OFF_MIX0, bf16_t);
  for (int r = C.gw; r < R; r += C.ngw) {
    f32x4 y[4];
#pragma unroll
    for (int j = 0; j < 4; ++j) { const int e = 4 * C.lane + 256 * j; const float dsk = GIN(I_SD)[e >> 6];
      const u32x2 ys = *(const u32x2*)(MIX + (size_t)r * MIXW + 1024 + e), xs = *(const u32x2*)(Z + (size_t)r * Z0W + Z0_XBC + e), zz = *(const u32x2*)(Z + (size_t)r * Z0W + Z0_SSDZ + e);
      y[j][0] = (bflo(ys.x) + dsk * bflo(xs.x)) * siluf_(bflo(zz.x)); y[j][1] = (bfhi(ys.x) + dsk * bfhi(xs.x)) * siluf_(bfhi(zz.x));
      y[j][2] = (bflo(ys.y) + dsk * bflo(xs.y)) * siluf_(bflo(zz.y)); y[j][3] = (bfhi(ys.y) + dsk * bfhi(xs.y)) * siluf_(bfhi(zz.y)); }
    float s0 = 0.f, s1 = 0.f;
#pragma unroll
    for (int i = 0; i < 4; ++i) { s0 += y[0][i] * y[0][i] + y[1][i] * y[1][i]; s1 += y[2][i] * y[2][i] + y[3][i] * y[3][i]; }
    const float r0 = rsqrtf(wave_sum(s0) * (1.f / 512.f) + RMS_EPS), r1 = rsqrtf(wave_sum(s1) * (1.f / 512.f) + RMS_EPS);
#pragma unroll
    for (int j = 0; j < 4; ++j) { const int e = 4 * C.lane + 256 * j; const f32x4 gn = *(const f32x4*)(GIN(I_SNG) + e); const float rr = j < 2 ? r0 : r1;
      u32x2 w; w.x = pk2(y[j][0] * rr * gn[0], y[j][1] * rr * gn[1]); w.y = pk2(y[j][2] * rr * gn[2], y[j][3] * rr * gn[3]);
      if (ident) w = *(const u32x2*)(MIX + (size_t)r * MIXW + 1024 + e);
      *(u32x2*)(MIX + (size_t)r * MIXW + 1024 + e) = w; }
  }
}

__device__ __forceinline__ void phase_outproj(const Params& P, const Ctx& C, int layer) {
  const float* MOD = WS(OFF_MOD, float) + (size_t)layer * 5 * 6144;
  pg8::Gemm g{layer ? WS(OFF_MIX1, bf16_t) : WS(OFF_MIX0, bf16_t), layer ? WS(OFF_WOUT1, bf16_t) : WS(OFF_WOUT0, bf16_t), MIXW, MIXW};
  pg8::GridOrder S; if (layer) S.init(128, 4, C.nblk, C.bid, 1); else S.init(132, 4, C.nblk, C.bid, 0);
  pg8::EpiResid E{layer ? GOUT : GIN(I_X), layer ? WS(OFF_HCTX, float) : GIN(I_CTX), GOUT, WS(OFF_TCTX, float), MOD + 2 * D};
  pg8::gemm_phase(C.lds, g, S, E);
}

__device__ __forceinline__ void phase_lnmix(const Params& P, const Ctx& C, int layer, int ident) {
  LAS float* Wt = (LAS float*)C.lds;
  { const float* gw = GIN(I_RGW) + (size_t)layer * D * 4; const float* ew = GIN(I_REW) + (size_t)layer * D * 32;
    for (int i = C.tid; i < 1024 * 4; i += NT) { const int k = i >> 2, c = i & 3; Wt[c * 1024 + k] = gw[i]; }
    for (int i = C.tid; i < 1024 * 32; i += NT) { const int k = i >> 5, c = i & 31; Wt[(4 + c) * 1024 + k] = ew[i]; } }
  __syncthreads();
  const float* MOD = WS(OFF_MOD, float) + (size_t)layer * 5 * 6144;
  const float* lng = GIN(I_LNMG) + layer * D; const float* lnb = GIN(I_LNMB) + layer * D;
  const float* rgb = GIN(I_RGB) + layer * 4; const float* reb = GIN(I_REB) + layer * 32;
  bf16_t* V = layer ? WS(OFF_V1, bf16_t) : WS(OFF_U0, bf16_t);
  int* cnt = WS(OFF_CTL, int) + layer * 32; int* route = WS(OFF_ROUTE, int); unsigned short* tok = WS(OFF_TOK, unsigned short);
  LAS int* lcnt = (LAS int*)(C.lds + 36 * 1024 * 4);
  if (C.tid < NEXP) lcnt[C.tid] = 0;
  __syncthreads();
  const int nrows = layer ? RLAT : R;
  f32x4 h[4], hn[4];
  if (C.gw < nrows) row_load(lat_or_ctx_w(GOUT, WS(OFF_TCTX, float), rmap(layer, C.gw)), C.lane, h);
  for (int q = C.gw; q < nrows; q += C.ngw) {
    const int r = rmap(layer, q);
    if (q + C.ngw < nrows) row_load(lat_or_ctx_w(GOUT, WS(OFF_TCTX, float), rmap(layer, q + C.ngw)), C.lane, hn);
    float* hrow = lat_or_ctx_w(GOUT, WS(OFF_HCTX, float), r);
    f32x4 v[4];
    if (!ident) row_layernorm(h, lng, lnb, C.lane);
    row_store(hrow, C.lane, h);
    const float* m = MOD + (size_t)row_b5(r) * 6144;
    row_modulate(h, m + 3 * D, m + 4 * D, C.lane, v);
    row_store_bf16(V + (size_t)r * D, C.lane, v);
    float lg[4];
#pragma unroll
    for (int c = 0; c < 4; ++c) { float s = 0.f;
#pragma unroll
      for (int j = 0; j < 4; ++j) { const f32x4 w = *(const LAS f32x4*)(Wt + c * 1024 + 4 * C.lane + 256 * j); s += (v[j][0] * w[0] + v[j][1] * w[1]) + (v[j][2] * w[2] + v[j][3] * w[3]); }
      lg[c] = wave_sum(s) + rgb[c]; }
    int gsel = 0; float gmax = lg[0];
#pragma unroll
    for (int i = 1; i < 4; ++i) if (lg[i] > gmax) { gmax = lg[i]; gsel = i; }
    gsel = __builtin_amdgcn_readfirstlane(gsel);
    float gden = 0.f;
#pragma unroll
    for (int i = 0; i < 4; ++i) gden += __expf(lg[i] - gmax);
    const float ptg = 1.f / gden;
    float le[8];
    { const LAS float* We = Wt + (4 + gsel * 8) * 1024 + 4 * C.lane;
#pragma unroll
      for (int c = 0; c < 8; ++c) { float s = 0.f;
#pragma unroll
        for (int j = 0; j < 4; ++j) { const f32x4 w = *(const LAS f32x4*)(We + c * 1024 + 256 * j); s += (v[j][0] * w[0] + v[j][1] * w[1]) + (v[j][2] * w[2] + v[j][3] * w[3]); }
        le[c] = wave_sum(s) + reb[gsel * 8 + c]; } }
    int e1 = 0; float m1 = le[0];
#pragma unroll
    for (int i = 1; i < 8; ++i) if (le[i] > m1) { m1 = le[i]; e1 = i; }
    int e2 = -1; float m2 = -3.0e38f;
#pragma unroll
    for (int i = 0; i < 8; ++i) if (i != e1 && le[i] > m2) { m2 = le[i]; e2 = i; }
    const float q2 = __expf(m2 - m1); const float w1 = ptg / (1.f + q2), w2 = ptg * q2 / (1.f + q2);
    if (C.lane == 0) {
      const int E1 = gsel * 8 + e1, E2 = gsel * 8 + e2;
      const int p1 = __hip_atomic_fetch_add(lcnt + E1, 1, __ATOMIC_RELAXED, __HIP_MEMORY_SCOPE_WORKGROUP), p2 = __hip_atomic_fetch_add(lcnt + E2, 1, __ATOMIC_RELAXED, __HIP_MEMORY_SCOPE_WORKGROUP);
      int* rr = route + (size_t)r * 8; if (!ident) { rr[0] = E1; rr[1] = E2; ((float*)rr)[2] = w1; ((float*)rr)[3] = w2; rr[4] = p1; rr[5] = p2; }
    }
#pragma unroll
    for (int j = 0; j < 4; ++j) h[j] = hn[j];
  }
  __syncthreads();
  if (ident) return;
  if (C.tid < NEXP) lcnt[C.tid] = atomicAdd(cnt + C.tid, lcnt[C.tid]);
  __syncthreads();
  for (int k = C.tid >> 3; ; k += NT / 8) { const int q = (C.bid * NWAVES + (C.tid & 7)) + k * C.ngw; if (q >= nrows) break;
    const int r = rmap(layer, q); int* rr = route + (size_t)r * 8; const int E1 = rr[0], E2 = rr[1]; const int p1 = rr[4] + lcnt[E1], p2 = rr[5] + lcnt[E2];
    rr[4] = p1; rr[5] = p2; tok[(size_t)E1 * TOKCAP + p1] = (unsigned short)r; tok[(size_t)E2 * TOKCAP + p2] = (unsigned short)r; }
}

__device__ __forceinline__ void phase_dispatch(const Params& P, const Ctx& C, int layer) {
  LAS int* base = (LAS int*)C.lds;
  int* ctl = WS(OFF_CTL, int); const int* cnt = ctl + layer * 32;
  if (C.tid == 0) { int acc = 0; for (int e = 0; e < NEXP; ++e) { base[e] = acc; acc += (cnt[e] + 255) >> 8; } base[32] = acc; }
  __syncthreads();
  if (C.bid == 0) { if (C.tid == 0) ctl[64 + layer] = base[32];
    if (C.tid < NEXP) { for (int bk = base[C.tid]; bk < base[C.tid + 1]; ++bk) ctl[128 + layer * MAX_BLKS + bk] = C.tid; } }
  const bf16_t* V = layer ? WS(OFF_V1, bf16_t) : WS(OFF_U0, bf16_t);
  bf16_t* AM = layer ? WS(OFF_AM1, bf16_t) : WS(OFF_AM0, bf16_t);
  float* slotw = WS(OFF_SLOTW, float); int* route = WS(OFF_ROUTE, int);
  for (int r = C.gw; r < R; r += C.ngw) {
    const int pos = r % TB; if (layer && pos < CTXL) continue;
    int* rr = route + (size_t)r * 8;
    const int E1 = rr[0], E2 = rr[1]; const int s1 = base[E1] * 256 + rr[4], s2 = base[E2] * 256 + rr[5];
    const u32x4* src = (const u32x4*)(V + (size_t)r * D);
    const u32x4 a = src[C.lane], b = src[64 + C.lane];
    u32x4* d1 = (u32x4*)(AM + (size_t)s1 * D); u32x4* d2 = (u32x4*)(AM + (size_t)s2 * D);
    d1[C.lane] = a; d1[64 + C.lane] = b; d2[C.lane] = a; d2[64 + C.lane] = b;
    if (C.lane == 0) { rr[6] = s1; rr[7] = s2; slotw[s1] = ((const float*)rr)[2]; slotw[s2] = ((const float*)rr)[3]; }
  }
}
__device__ __forceinline__ int moe_tables(const Params& P, const Ctx& C, int layer, LAS int* tb) {
  const int* cnt = WS(OFF_CTL, int) + layer * 32;
  __syncthreads();
  if (C.tid == 0) { int acc = 0; for (int e = 0; e < NEXP; ++e) { const int c = cnt[e]; tb[e] = acc; tb[40 + e] = c; acc += (c + 255) >> 8; } tb[32] = acc; }
  __syncthreads();
  if (C.tid < NEXP) { for (int bk = tb[C.tid]; bk < tb[C.tid + 1]; ++bk) tb[80 + bk] = C.tid; }
  __syncthreads();
  return tb[32];
}
__device__ __forceinline__ void phase_moe1(const Params& P, const Ctx& C, int layer) {
  LAS int* tb = (LAS int*)(C.lds + 131072);
  const int nblk = moe_tables(P, C, layer, tb);
  pg8::Gemm g{layer ? WS(OFF_V1, bf16_t) : WS(OFF_U0, bf16_t), layer ? WS(OFF_WE1, bf16_t) : WS(OFF_WE0, bf16_t), D, D};
  pg8::MoeOrder S{tb, tb + 40, tb + 80, WS(OFF_TOK, unsigned short), nblk * 4, C.nblk, C.bid};
  pg8::EpiSwiGLU E{layer ? WS(OFF_HM1, bf16_t) : WS(OFF_HM0, bf16_t)};
  pg8::gemm_phase_ga(C.lds, g, S, E);
}
__device__ __forceinline__ void phase_moe2(const Params& P, const Ctx& C, int layer) {
  LAS int* tb = (LAS int*)(C.lds + 131072);
  const int nblk = moe_tables(P, C, layer, tb);
  pg8::Gemm g{layer ? WS(OFF_HM1, bf16_t) : WS(OFF_HM0, bf16_t), layer ? WS(OFF_WE1 + 64 * MiB, bf16_t) : WS(OFF_WE0 + 64 * MiB, bf16_t), DEXP, DEXP};
  pg8::MoeOrder S{tb, tb + 40, tb + 80, WS(OFF_TOK, unsigned short), nblk * 4, C.nblk, C.bid};
  pg8::EpiMoeDown E{layer ? WS(OFF_YM1, bf16_t) : WS(OFF_YM0, bf16_t)};
  pg8::gemm_phase(C.lds, g, S, E);
}

__device__ __forceinline__ void phase_lnffn(const Params& P, const Ctx& C, int layer, int ident) {
  const float* MOD = WS(OFF_MOD, float) + (size_t)layer * 5 * 6144;
  const float* lng = GIN(I_LNFG) + layer * D; const float* lnb = GIN(I_LNFB) + layer * D;
  const bf16_t* YM = layer ? WS(OFF_YM1, bf16_t) : WS(OFF_YM0, bf16_t); const int* route = WS(OFF_ROUTE, int);
  LAS int* tb = (LAS int*)(C.lds + 131072);
  (void)moe_tables(P, C, layer, tb);
  const int nrows = layer ? RLAT : R;
  f32x4 h[4], hn[4]; u32x2 ya[4], yb[4], yan[4], ybn[4]; int s1n = 0, s2n = 0; float w1c = 0.f, w2c = 0.f, w1n = 0.f, w2n = 0.f, w1nn = 0.f, w2nn = 0.f;
  auto ldrow = [&](int q, f32x4 (&hh)[4], u32x2 (&a)[4], u32x2 (&bq)[4], int sa, int sb) {
    const int r = rmap(layer, q); row_load(lat_or_ctx_w(GOUT, WS(OFF_HCTX, float), r), C.lane, hh);
#pragma unroll
    for (int j = 0; j < 4; ++j) { a[j] = *(const u32x2*)(YM + (size_t)sa * D + 4 * C.lane + 256 * j); bq[j] = *(const u32x2*)(YM + (size_t)sb * D + 4 * C.lane + 256 * j); } };
  if (C.gw < nrows) { const int* rr = route + (size_t)rmap(layer, C.gw) * 8; ldrow(C.gw, h, ya, yb, tb[rr[0]] * 256 + rr[4], tb[rr[1]] * 256 + rr[5]); w1c = ((const float*)rr)[2]; w2c = ((const float*)rr)[3]; }
  if (C.gw + C.ngw < nrows) { const int* rr = route + (size_t)rmap(layer, C.gw + C.ngw) * 8; s1n = tb[rr[0]] * 256 + rr[4]; s2n = tb[rr[1]] * 256 + rr[5]; w1n = ((const float*)rr)[2]; w2n = ((const float*)rr)[3]; }
  for (int q = C.gw; q < nrows; q += C.ngw) {
    const int r = rmap(layer, q);
    if (q + C.ngw < nrows) ldrow(q + C.ngw, hn, yan, ybn, s1n, s2n);
    if (q + 2 * C.ngw < nrows) { const int* rr = route + (size_t)rmap(layer, q + 2 * C.ngw) * 8; s1n = tb[rr[0]] * 256 + rr[4]; s2n = tb[rr[1]] * 256 + rr[5]; w1nn = ((const float*)rr)[2]; w2nn = ((const float*)rr)[3]; }
    float* hrow = lat_or_ctx_w(GOUT, WS(OFF_HCTX, float), r);
    const float* m = MOD + (size_t)row_b5(r) * 6144;
#pragma unroll
    for (int j = 0; j < 4; ++j) { const u32x2 a = ya[j], b = yb[j];
      const f32x4 g5 = *(const f32x4*)(m + 5 * D + 4 * C.lane + 256 * j);
      f32x4 f; f[0] = w1c * bflo(a.x) + w2c * bflo(b.x); f[1] = w1c * bfhi(a.x) + w2c * bfhi(b.x); f[2] = w1c * bflo(a.y) + w2c * bflo(b.y); f[3] = w1c * bfhi(a.y) + w2c * bfhi(b.y);
      if (!ident) h[j] = h[j] * ALPHA + g5 * f; else h[j] = h[j] + f * 0.f; }
    if (!ident) row_layernorm(h, lng, lnb, C.lane);
    row_store(hrow, C.lane, h);
    if (layer == 0) {
      const float* m1 = WS(OFF_MOD, float) + (size_t)(5 + row_b5(r)) * 6144;
      f32x4 u[4]; row_modulate(h, m1, m1 + D, C.lane, u);
      row_store_bf16(WS(OFF_U1, bf16_t) + (size_t)r * D, C.lane, u);
    }
#pragma unroll
    for (int j = 0; j < 4; ++j) { h[j] = hn[j]; ya[j] = yan[j]; yb[j] = ybn[j]; }
    w1c = w1n; w2c = w2n; w1n = w1nn; w2n = w2nn;
  }
  if (layer == 0) {
    __syncthreads();
    LAS float* scr = (LAS float*)C.lds + C.wave * (64 * 33);
    constexpr int N_A = 16 * 96, N_B = 16 * 128;
    for (int it = C.gw; it < N_A + N_B + 16; it += C.ngw) {
      if (it < N_A) transpose_mat_item(GIN(I_CDW), CD_IN, 0, D, 3072, WS(OFF_WCD, bf16_t), D, 0, it, scr, C.lane);
      else if (it < N_A + N_B) transpose_mat_item(GIN(I_CDW), CD_IN, 4128, D, 4096, WS(OFF_WCD, bf16_t) + (size_t)3072 * D, D, 0, it - N_A, scr, C.lane);
      else transpose_mat_item(GIN(I_CDW), CD_IN, 4096, D, 32, WS(OFF_WCD, bf16_t) + (size_t)7168 * D, D, 0, it - N_A - N_B, scr, C.lane);
    }
    { u32x4* z = (u32x4*)(WS(OFF_WCD, bf16_t) + (size_t)7200 * D); const u32x4 zz = {0u, 0u, 0u, 0u};
      for (int i = C.bid * NT + C.tid; i < 224 * D * 2 / 16; i += C.nblk * NT) z[i] = zz; }
  }
}

__device__ __forceinline__ void gdn_task(const Params& P, const Ctx& C, int task) {
  const int b = task >> 9, h = (task >> 6) & 7, vs = task & 63; const int c = C.lane >> 5, kg = C.lane & 31;
  const bf16_t* Z = WS(OFF_Z1, bf16_t); bf16_t* MIX = WS(OFF_MIX1, bf16_t); const float* DT = WS(OFF_DT, float);
  const int colq = Z1_Q + h * 128 + 4 * kg, colk = Z1_K + h * 128 + 4 * kg, colv = Z1_V + h * 128 + 2 * vs + c, outc = h * 128 + 2 * vs + c;
  for (int d = 0; d < 2; ++d) {
    const float Aneg = -__expf(GIN(I_GALOG)[d * 8 + h]), dtb = GIN(I_GDTB)[d * 8 + h];
    float S0 = 0.f, S1 = 0.f, S2 = 0.f, S3 = 0.f;
    for (int j0 = 0; j0 < TB; j0 += 8) {
      u32x2 qv[8], kv[8]; unsigned short vv[8], yp[8]; float br[8], ar[8];
#pragma unroll
      for (int u = 0; u < 8; ++u) { const size_t row = (size_t)b * TB + seq_pos(d, j0 + u);
        qv[u] = *(const u32x2*)(Z + row * Z1W + colq); kv[u] = *(const u32x2*)(Z + row * Z1W + colk); vv[u] = Z[row * Z1W + colv];
        br[u] = DT[row * 32 + d * 8 + h]; ar[u] = DT[row * 32 + 16 + d * 8 + h]; yp[u] = d ? MIX[row * MIXW + outc] : (unsigned short)0; }
#pragma unroll
      for (int u = 0; u < 8; ++u) { const size_t row = (size_t)b * TB + seq_pos(d, j0 + u);
        const float al = __expf(Aneg * softplusf_(ar[u] + dtb)), be = sigmoidf_(br[u]);
        const float k0 = bflo(kv[u].x), k1 = bfhi(kv[u].x), k2 = bflo(kv[u].y), k3 = bfhi(kv[u].y);
        S0 *= al; S1 *= al; S2 *= al; S3 *= al;
        const float p = half_sum32((k0 * S0 + k1 * S1) + (k2 * S2 + k3 * S3));
        const float dl = be * (bf2f(vv[u]) - p);
        S0 += k0 * dl; S1 += k1 * dl; S2 += k2 * dl; S3 += k3 * dl;
        const float o = half_sum32((bflo(qv[u].x) * S0 + bfhi(qv[u].x) * S1) + (bflo(qv[u].y) * S2 + bfhi(qv[u].y) * S3));
        if (kg == 0) MIX[row * MIXW + outc] = (bf16_t)f2bf(o + bf2f(yp[u])); }
    }
    __threadfence_block();
  }
}
__device__ __forceinline__ void hgrn_task(const Params& P, const Ctx& C, int task) {
  const int b = task >> 9, h = (task >> 6) & 7, vs = task & 63; const int c = C.lane >> 5, kg = C.lane & 31;
  const bf16_t* Z = WS(OFF_Z1, bf16_t); bf16_t* MIX = WS(OFF_MIX1, bf16_t);
  const f32x4 lb = *(const f32x4*)(WS(OFF_LB1, float) + h * 128 + 4 * kg);
  const int colq = Z1_HQ + h * 128 + 4 * kg, colv = Z1_HI + h * 128 + 2 * vs + c, outc = 1024 + h * 128 + 2 * vs + c;
  for (int d = 0; d < 2; ++d) {
    const int colf = Z1_HF + d * 1024 + h * 128 + 4 * kg;
    float S0 = 0.f, S1 = 0.f, S2 = 0.f, S3 = 0.f;
    for (int j0 = 0; j0 < TB; j0 += 8) {
      u32x2 qv[8], fv[8]; unsigned short vv[8], yp[8];
#pragma unroll
      for (int u = 0; u < 8; ++u) { const size_t row = (size_t)b * TB + seq_pos(d, j0 + u);
        qv[u] = *(const u32x2*)(Z + row * Z1W + colq); fv[u] = *(const u32x2*)(Z + row * Z1W + colf); vv[u] = Z[row * Z1W + colv];
        yp[u] = d ? MIX[row * MIXW + outc] : (unsigned short)0; }
#pragma unroll
      for (int u = 0; u < 8; ++u) { const size_t row = (size_t)b * TB + seq_pos(d, j0 + u);
        const float f0 = lb[0] + (1.f - lb[0]) * sigmoidf_(bflo(fv[u].x)), f1 = lb[1] + (1.f - lb[1]) * sigmoidf_(bfhi(fv[u].x));
        const float f2 = lb[2] + (1.f - lb[2]) * sigmoidf_(bflo(fv[u].y)), f3 = lb[3] + (1.f - lb[3]) * sigmoidf_(bfhi(fv[u].y));
        const float v = bf2f(vv[u]);
        S0 = f0 * S0 + (1.f - f0) * v; S1 = f1 * S1 + (1.f - f1) * v; S2 = f2 * S2 + (1.f - f2) * v; S3 = f3 * S3 + (1.f - f3) * v;
        const float o = half_sum32((bflo(qv[u].x) * S0 + bfhi(qv[u].x) * S1) + (bflo(qv[u].y) * S2 + bfhi(qv[u].y) * S3));
        if (kg == 0) MIX[row * MIXW + outc] = (bf16_t)f2bf(o + bf2f(yp[u])); }
    }
    __threadfence_block();
  }
}

__device__ __forceinline__ int seq_chunk32(int dir, int j) { return dir == 0 ? j : (j < 8 ? 7 - j : 271 - j); }
__device__ __forceinline__ bool fwd_first32(int c) { return c < 8 ? (c <= 3) : (c <= 135); }

__device__ __forceinline__ void hgrn_chain_wg(const Params& P, const Ctx& C, int task) {
  const int b = task >> 5, h = (task >> 2) & 7, vs = task & 3;
  const int d = C.wave >> 2, w = C.wave & 3, td = C.tid & 255, lane = C.lane, fr = lane & 15, fq = lane >> 4;
  constexpr int LDN = 136, LDP = 40;
  constexpr int DIRSZ = 72 * 1024;
  LAS unsigned char* L = C.lds + d * DIRSZ;
  LAS bf16_t* Qt = (LAS bf16_t*)L;
  LAS bf16_t* Kh = Qt + 32 * LDN;
  LAS bf16_t* Kw = Kh + 32 * LDN;
  LAS bf16_t* Vs = Kw + 32 * LDN;
  LAS bf16_t* Pt = Vs + 32 * LDP;
  LAS bf16_t* St = Pt + 32 * LDP;
  LAS float* CUM = (LAS float*)(St + 2 * 32 * LDN);
  const bf16_t* Z = WS(OFF_Z1, bf16_t); bf16_t* MIX = WS(OFF_MIX1, bf16_t);
  const int colq = Z1_HQ + h * 128, colf = Z1_HF + d * 1024 + h * 128, colv = Z1_HI + h * 128 + vs * 32, outc = 1024 + h * 128 + vs * 32;
  __syncthreads();
  for (int i = td; i < 32 * LDP / 2; i += 256) ((LAS unsigned*)Pt)[i] = 0u;
  for (int i = td; i < 2 * 32 * LDN / 2; i += 256) ((LAS unsigned*)St)[i] = 0u;
  f32x4 Sacc[2][2];
#pragma unroll
  for (int a = 0; a < 2; ++a)
#pragma unroll
    for (int c = 0; c < 2; ++c) Sacc[a][c] = (f32x4){0.f, 0.f, 0.f, 0.f};
  const int st_t = td >> 3, st_s = td & 7;
  float lbv[16];
#pragma unroll
  for (int e = 0; e < 16; ++e) lbv[e] = WS(OFF_LB1, float)[h * 128 + st_s * 16 + e];
  u32x4 rq[2], rf[2]; u32x2 rv;
  auto issue_loads = [&](int step) {
    const int chunk = seq_chunk32(d, step); const size_t row = (size_t)b * TB + chunk * 32 + st_t;
    const u32x4* pq = (const u32x4*)(Z + row * Z1W + colq + st_s * 16); const u32x4* pf = (const u32x4*)(Z + row * Z1W + colf + st_s * 16);
    rq[0] = pq[0]; rq[1] = pq[1]; rf[0] = pf[0]; rf[1] = pf[1];
    rv = *(const u32x2*)(Z + row * Z1W + colv + st_s * 4);
  };
  issue_loads(0);
  for (int step = 0; step < 264; ++step) {
    const int chunk = seq_chunk32(d, step); const int row0 = b * TB + chunk * 32;
    const int si = d ? 31 - st_t : st_t;
    VMWAIT();
    float qv[16], kk[16];
    { const unsigned qw[8] = {rq[0].x, rq[0].y, rq[0].z, rq[0].w, rq[1].x, rq[1].y, rq[1].z, rq[1].w};
      const unsigned fw[8] = {rf[0].x, rf[0].y, rf[0].z, rf[0].w, rf[1].x, rf[1].y, rf[1].z, rf[1].w};
      f32x4 lf4[4];
#pragma unroll
      for (int e = 0; e < 8; ++e) { qv[2 * e] = bflo(qw[e]); qv[2 * e + 1] = bfhi(qw[e]);
        const float f0 = lbv[2 * e] + (1.f - lbv[2 * e]) * sigmoidf_(bflo(fw[e])), f1 = lbv[2 * e + 1] + (1.f - lbv[2 * e + 1]) * sigmoidf_(bfhi(fw[e]));
        kk[2 * e] = 1.f - f0; kk[2 * e + 1] = 1.f - f1; lf4[e >> 1][(2 * e) & 3] = __logf(f0); lf4[e >> 1][(2 * e + 1) & 3] = __logf(f1); }
#pragma unroll
      for (int e = 0; e < 4; ++e) *(LAS f32x4*)(CUM + si * 128 + st_s * 16 + 4 * e) = lf4[e];
      *(LAS u32x2*)(Vs + si * LDP + st_s * 4) = rv; }
    LBAR();
    if (step + 1 < 264) issue_loads(step + 1);
    const int vt = w & 1, it = w >> 1;
    const bool first = (d == 0) == fwd_first32(chunk);
    bf16_t* op; unsigned long long ppv = 0ull;
    { const int ii = 16 * it + fr; const int t = d ? 31 - ii : ii; op = MIX + (size_t)(row0 + t) * MIXW + outc + 16 * vt + 4 * fq; if (!first) ppv = ld_agent_u64(op); }
    if (td < 128) { float c = 0.f;
#pragma unroll 8
      for (int i = 0; i < 32; ++i) { c += CUM[i * 128 + td]; CUM[i * 128 + td] = c; } }
    LBAR();
    { unsigned oq[8], oh[8], ow[8];
#pragma unroll
      for (int e = 0; e < 8; ++e) { const int k0 = st_s * 16 + 2 * e;
        const float c0 = CUM[si * 128 + k0], c1 = CUM[si * 128 + k0 + 1], l0 = CUM[31 * 128 + k0], l1 = CUM[31 * 128 + k0 + 1];
        oq[e] = pk2(qv[2 * e] * __expf(c0), qv[2 * e + 1] * __expf(c1));
        oh[e] = pk2(kk[2 * e] * __expf(fminf(-c0, 80.f)), kk[2 * e + 1] * __expf(fminf(-c1, 80.f)));
        ow[e] = pk2(kk[2 * e] * __expf(l0 - c0), kk[2 * e + 1] * __expf(l1 - c1)); }
      LAS u32x4* dq = (LAS u32x4*)(Qt + si * LDN + st_s * 16); LAS u32x4* dh = (LAS u32x4*)(Kh + si * LDN + st_s * 16); LAS u32x4* dw = (LAS u32x4*)(Kw + si * LDN + st_s * 16);
      dq[0] = (u32x4){oq[0], oq[1], oq[2], oq[3]}; dq[1] = (u32x4){oq[4], oq[5], oq[6], oq[7]};
      dh[0] = (u32x4){oh[0], oh[1], oh[2], oh[3]}; dh[1] = (u32x4){oh[4], oh[5], oh[6], oh[7]};
      dw[0] = (u32x4){ow[0], ow[1], ow[2], ow[3]}; dw[1] = (u32x4){ow[4], ow[5], ow[6], ow[7]}; }
    LBAR();
    if (w < 3) { const int I = w >= 1 ? 1 : 0, J = w == 2 ? 1 : 0;
      f32x4 acc = (f32x4){0.f, 0.f, 0.f, 0.f};
#pragma unroll
      for (int k = 0; k < 4; ++k) acc = mma16(frag_row(Qt, LDN, 16 * I, 32 * k, lane), frag_row(Kh, LDN, 16 * J, 32 * k, lane), acc);
      const int jj = 16 * J + fr; float pv[4];
#pragma unroll
      for (int r = 0; r < 4; ++r) { const int ii = 16 * I + 4 * fq + r; pv[r] = (jj <= ii) ? acc[r] : 0.f; }
      u32x2 o; o.x = pk2(pv[0], pv[1]); o.y = pk2(pv[2], pv[3]);
      *(LAS u32x2*)(Pt + jj * LDP + 16 * I + 4 * fq) = o; }
    const LAS bf16_t* Sr = St + (step & 1) * 32 * LDN; LAS bf16_t* Sw = St + ((step + 1) & 1) * 32 * LDN;
    f32x4 o2 = (f32x4){0.f, 0.f, 0.f, 0.f};
#pragma unroll
    for (int k = 0; k < 4; ++k) o2 = mma16(frag_row(Sr, LDN, 16 * vt, 32 * k, lane), frag_row(Qt, LDN, 16 * it, 32 * k, lane), o2);
#pragma unroll
    for (int a = 0; a < 2; ++a) { const int kt = 2 * w + a; const f32x4 cl = *(const LAS f32x4*)(CUM + 31 * 128 + 16 * kt + 4 * fq);
      f32x4 dec; dec[0] = __expf(cl[0]); dec[1] = __expf(cl[1]); dec[2] = __expf(cl[2]); dec[3] = __expf(cl[3]);
#pragma unroll
      for (int c = 0; c < 2; ++c) { f32x4 acc = Sacc[a][c] * dec;
        acc = mma16(frag_tr(Kw, LDN, 0, 16 * kt, lane), frag_tr(Vs, LDP, 0, 16 * c, lane), acc);
        Sacc[a][c] = acc;
        u32x2 o; o.x = pk2(acc[0], acc[1]); o.y = pk2(acc[2], acc[3]);
        *(LAS u32x2*)(Sw + (16 * c + fr) * LDN + 16 * kt + 4 * fq) = o; } }
    LBAR();
    { f32x4 o1 = mma16(frag_tr(Vs, LDP, 0, 16 * vt, lane), frag_tr(Pt, LDP, 0, 16 * it, lane), (f32x4){0.f, 0.f, 0.f, 0.f});
      float o0 = o1[0] + o2[0], o1v = o1[1] + o2[1], o2v = o1[2] + o2[2], o3 = o1[3] + o2[3];
      if (!first) { const unsigned long long pv = ppv; const unsigned lo = (unsigned)pv, hi = (unsigned)(pv >> 32); o0 += bflo(lo); o1v += bfhi(lo); o2v += bflo(hi); o3 += bfhi(hi); }
      u32x2 o; o.x = pk2(o0, o1v); o.y = pk2(o2v, o3); *(u32x2*)op = o; }
    LBAR();
  }
}

__device__ __forceinline__ void gdn_chain_wg(const Params& P, const Ctx& C, int task) {
  const int b = task >> 5, h = (task >> 2) & 7, vs = task & 3;
  const int d = C.wave >> 2, w = C.wave & 3, td = C.tid & 255, lane = C.lane, fr = lane & 15, fq = lane >> 4;
  constexpr int LDN = 136, LDP = 40, LDT = 24;
  constexpr int DIRSZ = 72 * 1024;
  LAS unsigned char* L = C.lds + d * DIRSZ;
  LAS bf16_t* Qs = (LAS bf16_t*)L;
  LAS bf16_t* Ks = Qs + 32 * LDN;
  LAS bf16_t* Vs = Ks + 32 * LDN;
  LAS bf16_t* Mt = Vs + 32 * LDP;
  LAS bf16_t* At = Mt + 32 * LDP;
  LAS bf16_t* Tt = At + 32 * LDP;
  LAS bf16_t* Xt = Tt + 2 * 32 * LDT;
  LAS bf16_t* Rt = Xt + 160 * LDP;
  LAS bf16_t* Vn = Rt + 4 * 16 * LDP;
  LAS bf16_t* Vw = Vn + 32 * LDP;
  LAS bf16_t* St = Vw + 32 * LDP;
  LAS float* Md = (LAS float*)(St + 2 * 32 * LDN);
  LAS float* gL = Md + 2 * 256;
  LAS float* bL = gL + 32;
  const bf16_t* Z = WS(OFF_Z1, bf16_t); bf16_t* MIX = WS(OFF_MIX1, bf16_t); const float* DT = WS(OFF_DT, float);
  const float Aneg = -__expf(GIN(I_GALOG)[d * 8 + h]), dtb = GIN(I_GDTB)[d * 8 + h];
  const int colq = Z1_Q + h * 128, colk = Z1_K + h * 128, colv = Z1_V + h * 128 + vs * 32, outc = h * 128 + vs * 32;
  __syncthreads();
  for (int i = td; i < 71 * 1024 / 4; i += 256) ((LAS unsigned*)L)[i] = 0u;
  f32x4 Sacc[2][2];
#pragma unroll
  for (int a = 0; a < 2; ++a)
#pragma unroll
    for (int c = 0; c < 2; ++c) Sacc[a][c] = (f32x4){0.f, 0.f, 0.f, 0.f};
  const int st_t = td >> 3, st_s = td & 7;
  u32x4 rq[2], rk[2]; u32x2 rv; float ra = 0.f, rb = 0.f;
  auto issue_loads = [&](int step) {
    const int chunk = seq_chunk32(d, step); const size_t row = (size_t)b * TB + chunk * 32 + st_t;
    const u32x4* pq = (const u32x4*)(Z + row * Z1W + colq + st_s * 16); const u32x4* pk = (const u32x4*)(Z + row * Z1W + colk + st_s * 16);
    rq[0] = pq[0]; rq[1] = pq[1]; rk[0] = pk[0]; rk[1] = pk[1];
    rv = *(const u32x2*)(Z + row * Z1W + colv + st_s * 4);
    if (st_s == 0) { rb = DT[row * 32 + d * 8 + h]; ra = DT[row * 32 + 16 + d * 8 + h]; }
  };
  issue_loads(0);
  __syncthreads();
  LAS bf16_t* Rw = Rt + w * 16 * LDP;
  for (int step = 0; step < 264; ++step) {
    const int chunk = seq_chunk32(d, step); const int row0 = b * TB + chunk * 32;
    VMWAIT();
    { const int si = d ? 31 - st_t : st_t;
      LAS u32x4* dq = (LAS u32x4*)(Qs + si * LDN + st_s * 16); LAS u32x4* dk = (LAS u32x4*)(Ks + si * LDN + st_s * 16);
      dq[0] = rq[0]; dq[1] = rq[1]; dk[0] = rk[0]; dk[1] = rk[1];
      *(LAS u32x2*)(Vs + si * LDP + st_s * 4) = rv;
      if (st_s == 0) { gL[si] = Aneg * softplusf_(ra + dtb); bL[si] = sigmoidf_(rb); } }
    LBAR();
    if (step + 1 < 264) issue_loads(step + 1);
    const bool first = (d == 0) == fwd_first32(chunk);
    bf16_t* op; unsigned long long ppv = 0ull;
    { const int ii = 16 * (w >> 1) + fr; const int t = d ? 31 - ii : ii; op = MIX + (size_t)(row0 + t) * MIXW + outc + 16 * (w & 1) + 4 * fq; if (!first) ppv = ld_agent_u64(op); }
    const float cum = wave_incl_scan(lane < 32 ? gL[lane] : 0.f, lane);
    const float cum_last = __shfl(cum, 31);
    const LAS bf16_t* Sr = St + (step & 1) * 32 * LDN; LAS bf16_t* Sw = St + ((step + 1) & 1) * 32 * LDN;
    const int vt = w & 1, it = w >> 1;
    for (int job = w; job < 6; job += 4) {
      const int isq = job >= 3, tj = job - 3 * isq; const int I = tj >= 1 ? 1 : 0, J = tj == 2 ? 1 : 0;
      const LAS bf16_t* A = isq ? Qs : Ks;
      f32x4 acc = (f32x4){0.f, 0.f, 0.f, 0.f};
#pragma unroll
      for (int k = 0; k < 4; ++k) acc = mma16(frag_row(A, LDN, 16 * I, 32 * k, lane), frag_row(Ks, LDN, 16 * J, 32 * k, lane), acc);
      const int jj = 16 * J + fr; const float cj = __shfl(cum, jj); float pv[4];
#pragma unroll
      for (int r = 0; r < 4; ++r) { const int ii = 16 * I + 4 * fq + r; const float ci = __shfl(cum, ii); const float dec = __expf(ci - cj);
        if (isq) pv[r] = (jj <= ii) ? acc[r] * dec : 0.f;
        else { pv[r] = (jj < ii) ? acc[r] * dec * bL[ii] : 0.f; if (I == J) Md[I * 256 + (4 * fq + r) * 16 + fr] = pv[r]; } }
      u32x2 o; o.x = pk2(pv[0], pv[1]); o.y = pk2(pv[2], pv[3]);
      *(LAS u32x2*)((isq ? At : Mt) + jj * LDP + 16 * I + 4 * fq) = o;
    }
    f32x4 o2 = (f32x4){0.f, 0.f, 0.f, 0.f};
#pragma unroll
    for (int k = 0; k < 4; ++k) o2 = mma16(frag_row(Sr, LDN, 16 * vt, 32 * k, lane), frag_row(Qs, LDN, 16 * it, 32 * k, lane), o2);
    LBAR();
    if (w < 2) { const LAS float* M = Md + w * 256; const int c = lane & 15;
      float m[16];
#pragma unroll
      for (int q4 = 0; q4 < 4; ++q4) { const f32x4 t4 = *(const LAS f32x4*)(M + c * 16 + 4 * q4); m[4 * q4] = t4[0]; m[4 * q4 + 1] = t4[1]; m[4 * q4 + 2] = t4[2]; m[4 * q4 + 3] = t4[3]; }
      float T[16];
#pragma unroll
      for (int r = 0; r < 16; ++r) { float v = (r == c) ? 1.f : 0.f;
#pragma unroll
        for (int s2 = 0; s2 < r; ++s2) v -= __builtin_bit_cast(float, __builtin_amdgcn_readlane(__builtin_bit_cast(int, m[s2]), r)) * T[s2];
        T[r] = v; }
      if (lane < 16) { LAS u32x4* dst = (LAS u32x4*)(Tt + w * 32 * LDT + c * LDT);
        dst[0] = (u32x4){pk2(T[0], T[1]), pk2(T[2], T[3]), pk2(T[4], T[5]), pk2(T[6], T[7])};
        dst[1] = (u32x4){pk2(T[8], T[9]), pk2(T[10], T[11]), pk2(T[12], T[13]), pk2(T[14], T[15])}; } }
    LBAR();
    for (int ct = w; ct < 10; ct += 4) {
      const int cc = 16 * ct + fr;
      f32x4 rhs;
#pragma unroll
      for (int r = 0; r < 4; ++r) { const int ii = 4 * fq + r; const float bi = bL[ii];
        rhs[r] = ct < 2 ? bi * bf2f(Vs[ii * LDP + cc]) : bi * __expf(__shfl(cum, ii)) * bf2f(Ks[ii * LDN + cc - 32]); }
      { u32x2 o; o.x = pk2(rhs[0], rhs[1]); o.y = pk2(rhs[2], rhs[3]); *(LAS u32x2*)(Rw + fr * LDP + 4 * fq) = o; }
      asm volatile("s_waitcnt lgkmcnt(0)" ::: "memory");
      f32x4 x0 = mma16(frag_tr(Tt, LDT, 0, 0, lane), frag_row(Rw, LDP, 0, 0, lane), (f32x4){0.f, 0.f, 0.f, 0.f});
      { u32x2 o; o.x = pk2(x0[0], x0[1]); o.y = pk2(x0[2], x0[3]); *(LAS u32x2*)(Xt + cc * LDP + 4 * fq) = o; }
#pragma unroll
      for (int r = 0; r < 4; ++r) { const int ii = 16 + 4 * fq + r; const float bi = bL[ii];
        rhs[r] = ct < 2 ? bi * bf2f(Vs[ii * LDP + cc]) : bi * __expf(__shfl(cum, ii)) * bf2f(Ks[ii * LDN + cc - 32]); }
      asm volatile("s_waitcnt lgkmcnt(0)" ::: "memory");
      { bf16x8 fa = frag_tr(Mt, LDP, 0, 16, lane); if (fq >= 2) fa = (bf16x8){0, 0, 0, 0, 0, 0, 0, 0};
        bf16x8 fb = frag_row(Xt, LDP, 16 * ct, 0, lane); if (fq >= 2) fb = (bf16x8){0, 0, 0, 0, 0, 0, 0, 0};
        const f32x4 corr = mma16(fa, fb, (f32x4){0.f, 0.f, 0.f, 0.f});
        rhs = rhs - corr; }
      { u32x2 o; o.x = pk2(rhs[0], rhs[1]); o.y = pk2(rhs[2], rhs[3]); *(LAS u32x2*)(Rw + fr * LDP + 4 * fq) = o; }
      asm volatile("s_waitcnt lgkmcnt(0)" ::: "memory");
      f32x4 x1 = mma16(frag_tr(Tt + 32 * LDT, LDT, 0, 0, lane), frag_row(Rw, LDP, 0, 0, lane), (f32x4){0.f, 0.f, 0.f, 0.f});
      { u32x2 o; o.x = pk2(x1[0], x1[1]); o.y = pk2(x1[2], x1[3]); *(LAS u32x2*)(Xt + cc * LDP + 16 + 4 * fq) = o; }
    }
    LBAR();
    { f32x4 ws = (f32x4){0.f, 0.f, 0.f, 0.f};
#pragma unroll
      for (int k = 0; k < 4; ++k) ws = mma16(frag_tr(Xt + 32 * LDP, LDP, 32 * k, 16 * it, lane), frag_row(Sr, LDN, 16 * vt, 32 * k, lane), ws);
      const u32x2 uu = *(const LAS u32x2*)(Xt + (16 * vt + fr) * LDP + 16 * it + 4 * fq);
      float vn[4] = {bflo(uu.x) - ws[0], bfhi(uu.x) - ws[1], bflo(uu.y) - ws[2], bfhi(uu.y) - ws[3]};
      float vw[4];
#pragma unroll
      for (int r = 0; r < 4; ++r) vw[r] = vn[r] * __expf(cum_last - __shfl(cum, 16 * it + 4 * fq + r));
      u32x2 o; o.x = pk2(vn[0], vn[1]); o.y = pk2(vn[2], vn[3]); *(LAS u32x2*)(Vn + (16 * vt + fr) * LDP + 16 * it + 4 * fq) = o;
      o.x = pk2(vw[0], vw[1]); o.y = pk2(vw[2], vw[3]); *(LAS u32x2*)(Vw + (16 * vt + fr) * LDP + 16 * it + 4 * fq) = o; }
    LBAR();
    { const f32x4 o1 = mma16(frag_row(Vn, LDP, 16 * vt, 0, lane), frag_tr(At, LDP, 0, 16 * it, lane), (f32x4){0.f, 0.f, 0.f, 0.f});
      const int ii = 16 * it + fr; const float eci = __expf(__shfl(cum, ii));
      float o0 = o1[0] + eci * o2[0], o1v = o1[1] + eci * o2[1], o2v = o1[2] + eci * o2[2], o3 = o1[3] + eci * o2[3];
      if (!first) { const unsigned long long pv = ppv; const unsigned lo = (unsigned)pv, hi = (unsigned)(pv >> 32); o0 += bflo(lo); o1v += bfhi(lo); o2v += bflo(hi); o3 += bfhi(hi); }
      u32x2 o; o.x = pk2(o0, o1v); o.y = pk2(o2v, o3); *(u32x2*)op = o; }
    { const float el = __expf(cum_last);
#pragma unroll
      for (int a = 0; a < 2; ++a) { const int kt = 2 * w + a; const bf16x8 fa = frag_tr(Ks, LDN, 0, 16 * kt, lane);
#pragma unroll
        for (int c = 0; c < 2; ++c) { f32x4 acc = mma16(fa, frag_row(Vw, LDP, 16 * c, 0, lane), Sacc[a][c] * el);
          Sacc[a][c] = acc;
          u32x2 o; o.x = pk2(acc[0], acc[1]); o.y = pk2(acc[2], acc[3]);
          *(LAS u32x2*)(Sw + (16 * c + fr) * LDN + 16 * kt + 4 * fq) = o; } } }
    LBAR();
  }
}

__device__ __forceinline__ bf16x8 ldfr(const LAS bf16_t* p) { return *(const LAS bf16x8*)p; }
__device__ __forceinline__ bf16x8 ldft(const LAS bf16_t* p, int ld) {
  const s16x4 v0 = __builtin_amdgcn_ds_read_tr16_b64_v4i16((LAS s16x4*)p);
  const s16x4 v1 = __builtin_amdgcn_ds_read_tr16_b64_v4i16((LAS s16x4*)(p + 4 * ld));
  bf16x8 r; r[0] = v0[0]; r[1] = v0[1]; r[2] = v0[2]; r[3] = v0[3]; r[4] = v1[0]; r[5] = v1[1]; r[6] = v1[2]; r[7] = v1[3];
  return r;
}
__device__ __forceinline__ u32x2 pk4(float a, float b, float c, float dd) { u32x2 o; o.x = pg8::cvt_pk_bf16(a, b); o.y = pg8::cvt_pk_bf16(c, dd); return o; }
__device__ __forceinline__ float bcast_lane(float v, int l) { return __builtin_bit_cast(float, __builtin_amdgcn_readlane(__builtin_bit_cast(int, v), l)); }

__device__ __forceinline__ void gdn2_chain_wg(const Params& P, const Ctx& C, int task) {
  const int b = task >> 5, h = (task >> 2) & 7, vs = task & 3;
  const int d = C.wave >> 2, w = ((C.wave & 3) + 2 * d) & 3, td = C.tid & 255, lane = C.lane, fr = lane & 15, fq = lane >> 4;
  constexpr int LDN = 136, LDP = 40, LDT = 24;
  constexpr int DIRSZ = 64 * 1024;
  LAS unsigned char* L = C.lds + d * DIRSZ;
  LAS bf16_t* Qs = (LAS bf16_t*)L;
  LAS bf16_t* Ks = Qs + 32 * LDN;
  LAS bf16_t* Vt = Ks + 32 * LDN;
  LAS bf16_t* Mt = Vt + 32 * LDP;
  LAS bf16_t* At = Mt + 32 * LDP;
  LAS bf16_t* Rt = At + 32 * LDP;
  LAS bf16_t* Vn = Rt + 32 * LDP;
  LAS bf16_t* Vw = Vn + 32 * LDP;
  LAS bf16_t* Tt = Vw + 32 * LDP;
  LAS bf16_t* St = Tt + 2 * 32 * LDT;
  LAS float* Md = (LAS float*)(St + 2 * 32 * LDN);
  LAS float* gL = Md + 512;
  LAS float* bL = gL + 32; LAS float* becL = bL;
  LAS float* ecL = bL + 32 + (C.wave & 3) * 96; LAS float* encL = ecL + 32; LAS float* ewL = encL + 32;
  const bf16_t* Z = WS(OFF_Z1, bf16_t); bf16_t* MIX = WS(OFF_MIX1, bf16_t); const float* DT = WS(OFF_DT, float);
  const float Aneg = -__expf(GIN(I_GALOG)[d * 8 + h]), dtb = GIN(I_GDTB)[d * 8 + h];
  const int colq = Z1_Q + h * 128, colk = Z1_K + h * 128, colv = Z1_V + h * 128 + vs * 32, outc = h * 128 + vs * 32;
  __syncthreads();
  for (int i = td; i < 58 * 1024 / 4; i += 256) ((LAS unsigned*)L)[i] = 0u;
  f32x4 Sacc[2][2];
#pragma unroll
  for (int a = 0; a < 2; ++a)
#pragma unroll
    for (int c = 0; c < 2; ++c) Sacc[a][c] = (f32x4){0.f, 0.f, 0.f, 0.f};
  const int st_t = td >> 3, st_s = td & 7;
  u32x4 rq[2], rk[2]; u32x2 rv; float ra = 0.f, rb = 0.f;
  auto issue_loads = [&](int step) {
    const int chunk = seq_chunk32(d, step); const size_t row = (size_t)b * TB + chunk * 32 + st_t;
    const u32x4* pq = (const u32x4*)(Z + row * Z1W + colq + st_s * 16); const u32x4* pk = (const u32x4*)(Z + row * Z1W + colk + st_s * 16);
    rq[0] = pq[0]; rq[1] = pq[1]; rk[0] = pk[0]; rk[1] = pk[1];
    rv = *(const u32x2*)(Z + row * Z1W + colv + st_s * 4);
    if (st_s == 0) { rb = DT[row * 32 + d * 8 + h]; ra = DT[row * 32 + 16 + d * 8 + h]; }
  };
  issue_loads(0);
  __syncthreads();
  const int rL136 = fr * LDN + 8 * fq, rL40 = fr * LDP + 8 * fq;
  const int tq = fr >> 2, tp = fr & 3;
  const int tL136 = (8 * fq + tq) * LDN + 4 * tp, tL40 = (8 * fq + tq) * LDP + 4 * tp, tL24 = (8 * fq + tq) * LDT + 4 * tp;
  const int it = w >> 1, vt = w & 1;
  const int si = d ? 31 - st_t : st_t;
  LAS u32x4* stq = (LAS u32x4*)(Qs + si * LDN + st_s * 16); LAS u32x4* stk = (LAS u32x4*)(Ks + si * LDN + st_s * 16);
  LAS bf16_t* stv = Vt + (st_s * 4) * LDP + si;
  const LAS bf16_t* pK_it = Ks + 16 * it * LDN + rL136; const LAS bf16_t* pQ_it = Qs + 16 * it * LDN + rL136;
  for (int step = 0; step < 264; ++step) {
    const int chunk = seq_chunk32(d, step); const int row0 = b * TB + chunk * 32;
    VMWAIT();
    stq[0] = rq[0]; stq[1] = rq[1]; stk[0] = rk[0]; stk[1] = rk[1];
    stv[0] = (bf16_t)(rv.x & 0xffffu); stv[LDP] = (bf16_t)(rv.x >> 16); stv[2 * LDP] = (bf16_t)(rv.y & 0xffffu); stv[3 * LDP] = (bf16_t)(rv.y >> 16);
    if (st_s == 0) { gL[si] = Aneg * softplusf_(ra + dtb); bL[si] = fast_sigmoid(rb); }
    LBAR();
    if (step + 1 < 264) issue_loads(step + 1);
    const bool first = (d == 0) == fwd_first32(chunk);
    bf16_t* op; unsigned long long ppv = 0ull;
    { const int ii = 16 * it + fr; const int t = d ? 31 - ii : ii; op = MIX + (size_t)(row0 + t) * MIXW + outc + 16 * vt + 4 * fq; if (!first) ppv = ld_agent_u64(op); }
    float elast;
    { const float c = wave_incl_scan(lane < 32 ? gL[lane & 31] : 0.f, lane); const float cl = bcast_lane(c, 31); elast = __expf(cl);
      if (lane < 32) { const float ec = __expf(c); ecL[lane] = ec; encL[lane] = c; ewL[lane] = __expf(cl - c); } }
    asm volatile("s_waitcnt lgkmcnt(0)" ::: "memory");
    const LAS bf16_t* Sr = St + (step & 1) * 32 * LDN; LAS bf16_t* Sw = St + ((step + 1) & 1) * 32 * LDN;
    f32x4 o2 = (f32x4){0.f, 0.f, 0.f, 0.f};
    { f32x4 ks = (f32x4){0.f, 0.f, 0.f, 0.f};
      const LAS bf16_t* pS = Sr + 16 * vt * LDN + rL136;
#pragma unroll
      for (int k = 0; k < 4; ++k) { const bf16x8 fs = ldfr(pS + 32 * k); ks = mma16(ldfr(pK_it + 32 * k), fs, ks); o2 = mma16(fs, ldfr(pQ_it + 32 * k), o2); }
      const u32x2 vv = *(const LAS u32x2*)(Vt + (16 * vt + fr) * LDP + 16 * it + 4 * fq);
      const f32x4 ec4 = *(const LAS f32x4*)(ecL + 16 * it + 4 * fq), b4 = *(const LAS f32x4*)(bL + 16 * it + 4 * fq);
      *(LAS u32x2*)(Rt + (16 * vt + fr) * LDP + 16 * it + 4 * fq) =
        pk4(b4[0] * (bflo(vv.x) - ec4[0] * ks[0]), b4[1] * (bfhi(vv.x) - ec4[1] * ks[1]), b4[2] * (bflo(vv.y) - ec4[2] * ks[2]), b4[3] * (bfhi(vv.y) - ec4[3] * ks[3])); }
    { const int isq = w & 1; const LAS bf16_t* A = isq ? Qs : Ks;
      const int njobs = w < 2 ? 1 : 2;
      for (int jb = 0; jb < njobs; ++jb) {
        const int I = (w < 2) ? 1 : jb, J = (w < 2) ? 1 : 0;
        f32x4 acc = (f32x4){0.f, 0.f, 0.f, 0.f};
        const LAS bf16_t* pa = A + 16 * I * LDN + rL136; const LAS bf16_t* pb = Ks + 16 * J * LDN + rL136;
#pragma unroll
        for (int k = 0; k < 4; ++k) acc = mma16(ldfr(pa + 32 * k), ldfr(pb + 32 * k), acc);
        const int jj = 16 * J + fr, i0 = 16 * I + 4 * fq; const float cj = encL[jj];
        const f32x4 c4 = *(const LAS f32x4*)(encL + i0); const f32x4 b4 = *(const LAS f32x4*)(becL + i0);
        float pv[4];
#pragma unroll
        for (int r = 0; r < 4; ++r) { const bool keep = isq ? (jj <= i0 + r) : (jj < i0 + r); const float sc = isq ? 1.f : b4[r];
          pv[r] = keep ? acc[r] * sc * __expf(c4[r] - cj) : 0.f; }
        if (!isq && I == J) { LAS float* md = Md + I * 256 + (4 * fq) * 16 + fr; md[0] = pv[0]; md[16] = pv[1]; md[32] = pv[2]; md[48] = pv[3]; }
        *(LAS u32x2*)((isq ? At : Mt) + jj * LDP + i0) = pk4(pv[0], pv[1], pv[2], pv[3]);
      } }
    LBAR();
    if (w < 2) { const LAS float* M = Md + w * 256; const int c = fr;
      float m[16];
#pragma unroll
      for (int q4 = 0; q4 < 4; ++q4) { const f32x4 t4 = *(const LAS f32x4*)(M + c * 16 + 4 * q4); m[4 * q4] = t4[0]; m[4 * q4 + 1] = t4[1]; m[4 * q4 + 2] = t4[2]; m[4 * q4 + 3] = t4[3]; }
      float T[16];
#pragma unroll
      for (int r = 0; r < 16; ++r) { float v = (r == c) ? 1.f : 0.f;
#pragma unroll
        for (int s2 = 0; s2 < r; ++s2) v -= bcast_lane(m[s2], r) * T[s2];
        T[r] = v; }
      if (lane < 16) { LAS u32x4* dst = (LAS u32x4*)(Tt + w * 32 * LDT + c * LDT);
        dst[0] = (u32x4){pg8::cvt_pk_bf16(T[0], T[1]), pg8::cvt_pk_bf16(T[2], T[3]), pg8::cvt_pk_bf16(T[4], T[5]), pg8::cvt_pk_bf16(T[6], T[7])};
        dst[1] = (u32x4){pg8::cvt_pk_bf16(T[8], T[9]), pg8::cvt_pk_bf16(T[10], T[11]), pg8::cvt_pk_bf16(T[12], T[13]), pg8::cvt_pk_bf16(T[14], T[15])}; } }
    LBAR();
    if (w < 2) { const int ct = w; const int cc = 16 * ct + fr;
      const f32x4 x0 = mma16(ldft(Tt + tL24, LDT), ldfr(Rt + 16 * ct * LDP + rL40), (f32x4){0.f, 0.f, 0.f, 0.f});
      const f32x4 ew0 = *(const LAS f32x4*)(ewL + 4 * fq);
      *(LAS u32x2*)(Vn + cc * LDP + 4 * fq) = pk4(x0[0], x0[1], x0[2], x0[3]);
      *(LAS u32x2*)(Vw + cc * LDP + 4 * fq) = pk4(x0[0] * ew0[0], x0[1] * ew0[1], x0[2] * ew0[2], x0[3] * ew0[3]);
      const u32x2 r1 = *(const LAS u32x2*)(Rt + cc * LDP + 16 + 4 * fq);
      asm volatile("s_waitcnt lgkmcnt(0)" ::: "memory");
      bf16x8 fa = ldft(Mt + tL40 + 16, LDP); bf16x8 fb = ldfr(Vn + 16 * ct * LDP + rL40);
      if (fq >= 2) { fa = (bf16x8){0, 0, 0, 0, 0, 0, 0, 0}; fb = (bf16x8){0, 0, 0, 0, 0, 0, 0, 0}; }
      const f32x4 corr = mma16(fa, fb, (f32x4){0.f, 0.f, 0.f, 0.f});
      *(LAS u32x2*)(Rt + cc * LDP + 16 + 4 * fq) = pk4(bflo(r1.x) - corr[0], bfhi(r1.x) - corr[1], bflo(r1.y) - corr[2], bfhi(r1.y) - corr[3]);
      asm volatile("s_waitcnt lgkmcnt(0)" ::: "memory");
      const f32x4 x1 = mma16(ldft(Tt + 32 * LDT + tL24, LDT), ldfr(Rt + 16 * ct * LDP + 16 + rL40), (f32x4){0.f, 0.f, 0.f, 0.f});
      const f32x4 ew1 = *(const LAS f32x4*)(ewL + 16 + 4 * fq);
      *(LAS u32x2*)(Vn + cc * LDP + 16 + 4 * fq) = pk4(x1[0], x1[1], x1[2], x1[3]);
      *(LAS u32x2*)(Vw + cc * LDP + 16 + 4 * fq) = pk4(x1[0] * ew1[0], x1[1] * ew1[1], x1[2] * ew1[2], x1[3] * ew1[3]); }
    LBAR();
    { const f32x4 o1 = mma16(ldfr(Vn + 16 * vt * LDP + rL40), ldft(At + tL40 + 16 * it, LDP), (f32x4){0.f, 0.f, 0.f, 0.f});
      const float eci = ecL[16 * it + fr];
      float o0 = o1[0] + eci * o2[0], o1v = o1[1] + eci * o2[1], o2v = o1[2] + eci * o2[2], o3 = o1[3] + eci * o2[3];
      if (!first) { const unsigned lo = (unsigned)ppv, hi = (unsigned)(ppv >> 32); o0 += bflo(lo); o1v += bfhi(lo); o2v += bflo(hi); o3 += bfhi(hi); }
      *(u32x2*)op = pk4(o0, o1v, o2v, o3); }
    { const bf16x8 fv0 = ldfr(Vw + rL40), fv1 = ldfr(Vw + 16 * LDP + rL40);
#pragma unroll
      for (int a = 0; a < 2; ++a) { const int kt = 2 * w + a; const bf16x8 fa = ldft(Ks + tL136 + 16 * kt, LDN);
        f32x4 a0 = mma16(fa, fv0, Sacc[a][0] * elast), a1 = mma16(fa, fv1, Sacc[a][1] * elast);
        Sacc[a][0] = a0; Sacc[a][1] = a1;
        *(LAS u32x2*)(Sw + fr * LDN + 16 * kt + 4 * fq) = pk4(a0[0], a0[1], a0[2], a0[3]);
        *(LAS u32x2*)(Sw + (16 + fr) * LDN + 16 * kt + 4 * fq) = pk4(a1[0], a1[1], a1[2], a1[3]); } }
    LBAR();
  }
}

__device__ __forceinline__ void gdn3_chain_wg(const Params& P, const Ctx& C, int task) {
  const int b = task >> 5, h = (task >> 2) & 7, vs = task & 3;
  const int d = C.wave >> 2, w = ((C.wave & 3) + 2 * d) & 3, td = C.tid & 255, lane = C.lane, fr = lane & 15, fq = lane >> 4;
  constexpr int LDN = 136, LDP = 40, LDT = 24;
  constexpr int DIRSZ = 64 * 1024;
  LAS unsigned char* L = C.lds + d * DIRSZ;
  LAS bf16_t* Qs = (LAS bf16_t*)L;
  LAS bf16_t* Ks = Qs + 32 * LDN;
  LAS bf16_t* Vt = Ks + 32 * LDN;
  LAS bf16_t* Mt = Vt + 32 * LDP;
  LAS bf16_t* At = Mt + 32 * LDP;
  LAS bf16_t* Rt = At + 32 * LDP;
  LAS bf16_t* Vn = Rt + 32 * LDP;
  LAS bf16_t* Vw = Vn + 32 * LDP;
  LAS bf16_t* Tt = Vw + 32 * LDP;
  LAS bf16_t* St = Tt + 2 * 32 * LDT;
  LAS float* Md = (LAS float*)(St + 2 * 32 * LDN);
  LAS float* gL = Md + 512;
  LAS float* bL = gL + 32; LAS float* becL = bL;
  LAS float* ecL = bL + 32 + (C.wave & 3) * 96; LAS float* encL = ecL + 32; LAS float* ewL = encL + 32;
  LAS f32x4* O2x = (LAS f32x4*)(bL + 32 + 4 * 96);
  const bf16_t* Z = WS(OFF_Z1, bf16_t); bf16_t* MIX = WS(OFF_MIX1, bf16_t); const float* DT = WS(OFF_DT, float);
  const float Aneg = -__expf(GIN(I_GALOG)[d * 8 + h]), dtb = GIN(I_GDTB)[d * 8 + h];
  const int colq = Z1_Q + h * 128, colk = Z1_K + h * 128, colv = Z1_V + h * 128 + vs * 32, outc = h * 128 + vs * 32;
  __syncthreads();
  for (int i = td; i < 60 * 1024 / 4; i += 256) ((LAS unsigned*)L)[i] = 0u;
  f32x4 Sacc[2][2];
#pragma unroll
  for (int a = 0; a < 2; ++a)
#pragma unroll
    for (int c = 0; c < 2; ++c) Sacc[a][c] = (f32x4){0.f, 0.f, 0.f, 0.f};
  const int st_t = td >> 3, st_s = td & 7;
  u32x4 rq[2], rk[2]; u32x2 rv; float ra = 0.f, rb = 0.f;
  auto issue_loads = [&](int step) {
    const int chunk = seq_chunk32(d, step); const size_t row = (size_t)b * TB + chunk * 32 + st_t;
    const u32x4* pq = (const u32x4*)(Z + row * Z1W + colq + st_s * 16); const u32x4* pk = (const u32x4*)(Z + row * Z1W + colk + st_s * 16);
    rq[0] = pq[0]; rq[1] = pq[1]; rk[0] = pk[0]; rk[1] = pk[1];
    rv = *(const u32x2*)(Z + row * Z1W + colv + st_s * 4);
    if (st_s == 0) { rb = DT[row * 32 + d * 8 + h]; ra = DT[row * 32 + 16 + d * 8 + h]; }
  };
  issue_loads(0);
  __syncthreads();
  const int rL136 = fr * LDN + 8 * fq, rL40 = fr * LDP + 8 * fq;
  const int tq = fr >> 2, tp = fr & 3;
  const int tL136 = (8 * fq + tq) * LDN + 4 * tp, tL40 = (8 * fq + tq) * LDP + 4 * tp, tL24 = (8 * fq + tq) * LDT + 4 * tp;
  const int it = w >> 1, vt = w & 1;
  const int si = d ? 31 - st_t : st_t;
  LAS u32x4* stq = (LAS u32x4*)(Qs + si * LDN + st_s * 16); LAS u32x4* stk = (LAS u32x4*)(Ks + si * LDN + st_s * 16);
  LAS bf16_t* stv = Vt + (st_s * 4) * LDP + si;
  const LAS bf16_t* pK_it = Ks + 16 * it * LDN + rL136; const LAS bf16_t* pQ_it = Qs + 16 * it * LDN + rL136;
  for (int step = 0; step < 264; ++step) {
    const int chunk = seq_chunk32(d, step); const int row0 = b * TB + chunk * 32;
    VMWAIT();
    stq[0] = rq[0]; stq[1] = rq[1]; stk[0] = rk[0]; stk[1] = rk[1];
    stv[0] = (bf16_t)(rv.x & 0xffffu); stv[LDP] = (bf16_t)(rv.x >> 16); stv[2 * LDP] = (bf16_t)(rv.y & 0xffffu); stv[3 * LDP] = (bf16_t)(rv.y >> 16);
    if (st_s == 0) { gL[si] = Aneg * softplusf_(ra + dtb); bL[si] = fast_sigmoid(rb); }
    LBAR();
    if (step + 1 < 264) issue_loads(step + 1);
    const bool first = (d == 0) == fwd_first32(chunk);
    bf16_t* op; unsigned long long ppv = 0ull;
    { const int ii = 16 * it + fr; const int t = d ? 31 - ii : ii; op = MIX + (size_t)(row0 + t) * MIXW + outc + 16 * vt + 4 * fq; if (!first) ppv = ld_agent_u64(op); }
    float elast;
    { const float c = wave_incl_scan(lane < 32 ? gL[lane & 31] : 0.f, lane); const float cl = bcast_lane(c, 31); elast = __expf(cl);
      if (lane < 32) { const float ec = __expf(c); ecL[lane] = ec; encL[lane] = c; ewL[lane] = __expf(cl - c); } }
    asm volatile("s_waitcnt lgkmcnt(0)" ::: "memory");
    const LAS bf16_t* Sr = St + (step & 1) * 32 * LDN; LAS bf16_t* Sw = St + ((step + 1) & 1) * 32 * LDN;
    f32x4 o2 = (f32x4){0.f, 0.f, 0.f, 0.f};
    if (w < 2) {
      f32x4 acc = (f32x4){0.f, 0.f, 0.f, 0.f};
      { const LAS bf16_t* pk = Ks + 16 * w * LDN + rL136;
#pragma unroll
        for (int k = 0; k < 4; ++k) { const bf16x8 f = ldfr(pk + 32 * k); acc = mma16(f, f, acc); } }
      { const int jj = 16 * w + fr, i0 = 16 * w + 4 * fq; const float cj = encL[jj];
        const f32x4 c4 = *(const LAS f32x4*)(encL + i0); const f32x4 b4 = *(const LAS f32x4*)(becL + i0);
        LAS float* md = Md + w * 256 + (4 * fq) * 16 + fr;
#pragma unroll
        for (int r = 0; r < 4; ++r) md[16 * r] = (jj < i0 + r) ? acc[r] * b4[r] * __expf(c4[r] - cj) : 0.f; }
      asm volatile("s_waitcnt lgkmcnt(0)" ::: "memory");
      const LAS float* M = Md + w * 256; const int c = fr;
      float m[16];
#pragma unroll
      for (int q4 = 0; q4 < 4; ++q4) { const f32x4 t4 = *(const LAS f32x4*)(M + c * 16 + 4 * q4); m[4 * q4] = t4[0]; m[4 * q4 + 1] = t4[1]; m[4 * q4 + 2] = t4[2]; m[4 * q4 + 3] = t4[3]; }
      float T[16];
#pragma unroll
      for (int r = 0; r < 16; ++r) { float v = (r == c) ? 1.f : 0.f;
#pragma unroll
        for (int s2 = 0; s2 < r; ++s2) v -= bcast_lane(m[s2], r) * T[s2];
        T[r] = v; }
      if (lane < 16) { LAS u32x4* dst = (LAS u32x4*)(Tt + w * 32 * LDT + c * LDT);
        dst[0] = (u32x4){pk2(T[0], T[1]), pk2(T[2], T[3]), pk2(T[4], T[5]), pk2(T[6], T[7])};
        dst[1] = (u32x4){pk2(T[8], T[9]), pk2(T[10], T[11]), pk2(T[12], T[13]), pk2(T[14], T[15])}; }
    } else {
      const int pvt = w & 1;
#pragma unroll
      for (int pit = 1; pit >= 0; --pit) {
        f32x4 ks = (f32x4){0.f, 0.f, 0.f, 0.f}, qs = (f32x4){0.f, 0.f, 0.f, 0.f};
        const LAS bf16_t* pS = Sr + 16 * pvt * LDN + rL136; const LAS bf16_t* pK = Ks + 16 * pit * LDN + rL136; const LAS bf16_t* pQ = Qs + 16 * pit * LDN + rL136;
#pragma unroll
        for (int k = 0; k < 4; ++k) { const bf16x8 fs = ldfr(pS + 32 * k); ks = mma16(ldfr(pK + 32 * k), fs, ks); qs = mma16(fs, ldfr(pQ + 32 * k), qs); }
        const u32x2 vv = *(const LAS u32x2*)(Vt + (16 * pvt + fr) * LDP + 16 * pit + 4 * fq);
        const f32x4 ec4 = *(const LAS f32x4*)(ecL + 16 * pit + 4 * fq), b4 = *(const LAS f32x4*)(bL + 16 * pit + 4 * fq);
        *(LAS u32x2*)(Rt + (16 * pvt + fr) * LDP + 16 * pit + 4 * fq) =
          pk4(b4[0] * (bflo(vv.x) - ec4[0] * ks[0]), b4[1] * (bfhi(vv.x) - ec4[1] * ks[1]), b4[2] * (bflo(vv.y) - ec4[2] * ks[2]), b4[3] * (bfhi(vv.y) - ec4[3] * ks[3]));
        if (pit == 1) o2 = qs; else O2x[pvt * 64 + lane] = qs;
      }
#pragma unroll
      for (int jb = 0; jb < 2; ++jb) {
        const bool isq = (w == 3) || (jb == 1);
        const int I = (w == 2) ? 1 : jb, J = (w == 2) ? 0 : jb;
        f32x4 acc = (f32x4){0.f, 0.f, 0.f, 0.f};
        const LAS bf16_t* pa = (isq ? Qs : Ks) + 16 * I * LDN + rL136; const LAS bf16_t* pb = Ks + 16 * J * LDN + rL136;
#pragma unroll
        for (int k = 0; k < 4; ++k) acc = mma16(ldfr(pa + 32 * k), ldfr(pb + 32 * k), acc);
        const int jj = 16 * J + fr, i0 = 16 * I + 4 * fq; const float cj = encL[jj];
        const f32x4 c4 = *(const LAS f32x4*)(encL + i0); const f32x4 b4 = *(const LAS f32x4*)(becL + i0);
        float pv[4];
#pragma unroll
        for (int r = 0; r < 4; ++r) { const bool keep = isq ? (jj <= i0 + r) : (jj < i0 + r); const float sc = isq ? 1.f : b4[r];
          pv[r] = keep ? acc[r] * sc * __expf(c4[r] - cj) : 0.f; }
        *(LAS u32x2*)((isq ? At : Mt) + jj * LDP + i0) = pk4(pv[0], pv[1], pv[2], pv[3]);
      }
    }
    LBAR();
    if (w < 2) { const int ct = w; const int cc = 16 * ct + fr;
      const f32x4 x0 = mma16(ldft(Tt + tL24, LDT), ldfr(Rt + 16 * ct * LDP + rL40), (f32x4){0.f, 0.f, 0.f, 0.f});
      const f32x4 ew0 = *(const LAS f32x4*)(ewL + 4 * fq);
      *(LAS u32x2*)(Vn + cc * LDP + 4 * fq) = pk4(x0[0], x0[1], x0[2], x0[3]);
      *(LAS u32x2*)(Vw + cc * LDP + 4 * fq) = pk4(x0[0] * ew0[0], x0[1] * ew0[1], x0[2] * ew0[2], x0[3] * ew0[3]);
      const u32x2 r1 = *(const LAS u32x2*)(Rt + cc * LDP + 16 + 4 * fq);
      asm volatile("s_waitcnt lgkmcnt(0)" ::: "memory");
      bf16x8 fa = ldft(Mt + tL40 + 16, LDP); bf16x8 fb = ldfr(Vn + 16 * ct * LDP + rL40);
      if (fq >= 2) { fa = (bf16x8){0, 0, 0, 0, 0, 0, 0, 0}; fb = (bf16x8){0, 0, 0, 0, 0, 0, 0, 0}; }
      const f32x4 corr = mma16(fa, fb, (f32x4){0.f, 0.f, 0.f, 0.f});
      *(LAS u32x2*)(Rt + cc * LDP + 16 + 4 * fq) = pk4(bflo(r1.x) - corr[0], bfhi(r1.x) - corr[1], bflo(r1.y) - corr[2], bfhi(r1.y) - corr[3]);
      asm volatile("s_waitcnt lgkmcnt(0)" ::: "memory");
      const f32x4 x1 = mma16(ldft(Tt + 32 * LDT + tL24, LDT), ldfr(Rt + 16 * ct * LDP + 16 + rL40), (f32x4){0.f, 0.f, 0.f, 0.f});
      const f32x4 ew1 = *(const LAS f32x4*)(ewL + 16 + 4 * fq);
      *(LAS u32x2*)(Vn + cc * LDP + 16 + 4 * fq) = pk4(x1[0], x1[1], x1[2], x1[3]);
      *(LAS u32x2*)(Vw + cc * LDP + 16 + 4 * fq) = pk4(x1[0] * ew1[0], x1[1] * ew1[1], x1[2] * ew1[2], x1[3] * ew1[3]); }
    LBAR();
    if (w < 2) o2 = O2x[w * 64 + lane];
    { const f32x4 o1 = mma16(ldfr(Vn + 16 * vt * LDP + rL40), ldft(At + tL40 + 16 * it, LDP), (f32x4){0.f, 0.f, 0.f, 0.f});
      const float eci = ecL[16 * it + fr];
      float o0 = o1[0] + eci * o2[0], o1v = o1[1] + eci * o2[1], o2v = o1[2] + eci * o2[2], o3 = o1[3] + eci * o2[3];
      if (!first) { const unsigned lo = (unsigned)ppv, hi = (unsigned)(ppv >> 32); o0 += bflo(lo); o1v += bfhi(lo); o2v += bflo(hi); o3 += bfhi(hi); }
      *(u32x2*)op = pk4(o0, o1v, o2v, o3); }
    { const bf16x8 fv0 = ldfr(Vw + rL40), fv1 = ldfr(Vw + 16 * LDP + rL40);
#pragma unroll
      for (int a = 0; a < 2; ++a) { const int kt = 2 * w + a; const bf16x8 fa = ldft(Ks + tL136 + 16 * kt, LDN);
        f32x4 a0 = mma16(fa, fv0, Sacc[a][0] * elast), a1 = mma16(fa, fv1, Sacc[a][1] * elast);
        Sacc[a][0] = a0; Sacc[a][1] = a1;
        *(LAS u32x2*)(Sw + fr * LDN + 16 * kt + 4 * fq) = pk4(a0[0], a0[1], a0[2], a0[3]);
        *(LAS u32x2*)(Sw + (16 + fr) * LDN + 16 * kt + 4 * fq) = pk4(a1[0], a1[1], a1[2], a1[3]); } }
    LBAR();
  }
}

__device__ __forceinline__ void hgrn2_chain_wg(const Params& P, const Ctx& C, int task) {
  const int b = task >> 5, h = (task >> 2) & 7, vs = task & 3;
  const int d = C.wave >> 2, w = C.wave & 3, td = C.tid & 255, lane = C.lane, fr = lane & 15, fq = lane >> 4;
  constexpr int LDN = 136, LDP = 40;
  constexpr int DIRSZ = 72 * 1024;
  LAS unsigned char* L = C.lds + d * DIRSZ;
  LAS bf16_t* Qt = (LAS bf16_t*)L;
  LAS bf16_t* Kh = Qt + 32 * LDN;
  LAS bf16_t* Kw = Kh + 32 * LDN;
  LAS bf16_t* Vs = Kw + 32 * LDN;
  LAS bf16_t* Pt = Vs + 32 * LDP;
  LAS bf16_t* St = Pt + 32 * LDP;
  LAS float* PR = (LAS float*)(St + 2 * 32 * LDN);
  LAS float* PL = PR + 32 * 128;
  const bf16_t* Z = WS(OFF_Z1, bf16_t); bf16_t* MIX = WS(OFF_MIX1, bf16_t);
  const int colq = Z1_HQ + h * 128, colf = Z1_HF + d * 1024 + h * 128, colv = Z1_HI + h * 128 + vs * 32, outc = 1024 + h * 128 + vs * 32;
  __syncthreads();
  for (int i = td; i < 32 * LDP / 2; i += 256) ((LAS unsigned*)Pt)[i] = 0u;
  for (int i = td; i < 2 * 32 * LDN / 2; i += 256) ((LAS unsigned*)St)[i] = 0u;
  f32x4 Sacc[2][2];
#pragma unroll
  for (int a = 0; a < 2; ++a)
#pragma unroll
    for (int c = 0; c < 2; ++c) Sacc[a][c] = (f32x4){0.f, 0.f, 0.f, 0.f};
  const int st_t = td >> 3, st_s = td & 7;
  float lbv[16];
#pragma unroll
  for (int e = 0; e < 16; ++e) lbv[e] = WS(OFF_LB1, float)[h * 128 + st_s * 16 + e];
  u32x4 rq[2], rf[2]; u32x2 rv;
  auto issue_loads = [&](int step) {
    const int chunk = seq_chunk32(d, step); const size_t row = (size_t)b * TB + chunk * 32 + st_t;
    const u32x4* pq = (const u32x4*)(Z + row * Z1W + colq + st_s * 16); const u32x4* pf = (const u32x4*)(Z + row * Z1W + colf + st_s * 16);
    rq[0] = pq[0]; rq[1] = pq[1]; rf[0] = pf[0]; rf[1] = pf[1];
    rv = *(const u32x2*)(Z + row * Z1W + colv + st_s * 4);
  };
  issue_loads(0);
  __syncthreads();
  const int rL136 = fr * LDN + 8 * fq;
  const int tq = fr >> 2, tp = fr & 3;
  const int tL136 = (8 * fq + tq) * LDN + 4 * tp, tL40 = (8 * fq + tq) * LDP + 4 * tp;
  const int vt = w & 1, it = w >> 1;
  const int si = d ? 31 - st_t : st_t;
  LAS float* prow = PR + si * 128 + st_s * 16;
  LAS float* pscan = PR + (td >> 7) * 16 * 128 + (td & 127);
  for (int step = 0; step < 264; ++step) {
    const int chunk = seq_chunk32(d, step); const int row0 = b * TB + chunk * 32;
    VMWAIT();
    float qv[16], kk[16];
    { const unsigned qw[8] = {rq[0].x, rq[0].y, rq[0].z, rq[0].w, rq[1].x, rq[1].y, rq[1].z, rq[1].w};
      const unsigned fw[8] = {rf[0].x, rf[0].y, rf[0].z, rf[0].w, rf[1].x, rf[1].y, rf[1].z, rf[1].w};
      f32x4 f4[4];
#pragma unroll
      for (int e = 0; e < 8; ++e) { qv[2 * e] = bflo(qw[e]); qv[2 * e + 1] = bfhi(qw[e]);
        const float k0 = (1.f - lbv[2 * e]) * (1.f - fast_sigmoid(bflo(fw[e]))), k1 = (1.f - lbv[2 * e + 1]) * (1.f - fast_sigmoid(bfhi(fw[e])));
        kk[2 * e] = k0; kk[2 * e + 1] = k1; f4[e >> 1][(2 * e) & 3] = 1.f - k0; f4[e >> 1][(2 * e + 1) & 3] = 1.f - k1; }
#pragma unroll
      for (int e = 0; e < 4; ++e) *(LAS f32x4*)(prow + 4 * e) = f4[e];
      *(LAS u32x2*)(Vs + si * LDP + st_s * 4) = rv; }
    LBAR();
    if (step + 1 < 264) issue_loads(step + 1);
    const bool first = (d == 0) == fwd_first32(chunk);
    bf16_t* op; unsigned long long ppv = 0ull;
    { const int ii = 16 * it + fr; const int t = d ? 31 - ii : ii; op = MIX + (size_t)(row0 + t) * MIXW + outc + 16 * vt + 4 * fq; if (!first) ppv = ld_agent_u64(op); }
    { float pv[16];
#pragma unroll
      for (int i = 0; i < 16; ++i) pv[i] = pscan[i * 128];
#pragma unroll
      for (int i = 1; i < 16; ++i) pv[i] *= pv[i - 1];
#pragma unroll
      for (int i = 0; i < 16; ++i) pscan[i * 128] = pv[i]; }
    LBAR();
    { const bool hi = si >= 16;
      unsigned oq[8], oh[8], ow[8];
#pragma unroll
      for (int e4 = 0; e4 < 4; ++e4) {
        f32x4 p = *(const LAS f32x4*)(prow + 4 * e4); const f32x4 p15 = *(const LAS f32x4*)(PR + 15 * 128 + st_s * 16 + 4 * e4), p31 = *(const LAS f32x4*)(PR + 31 * 128 + st_s * 16 + 4 * e4);
        const f32x4 pl = p15 * p31; if (hi) p = p * p15;
        if (si == 0) *(LAS f32x4*)(PL + st_s * 16 + 4 * e4) = pl;
        float q_[4], h_[4], w_[4];
#pragma unroll
        for (int r = 0; r < 4; ++r) { const int e = 4 * e4 + r; const float rp = __builtin_amdgcn_rcpf(fmaxf(p[r], 1e-30f)); q_[r] = qv[e] * p[r]; h_[r] = kk[e] * rp; w_[r] = h_[r] * pl[r]; }
        oq[2 * e4] = pk2(q_[0], q_[1]); oq[2 * e4 + 1] = pk2(q_[2], q_[3]); oh[2 * e4] = pk2(h_[0], h_[1]); oh[2 * e4 + 1] = pk2(h_[2], h_[3]); ow[2 * e4] = pk2(w_[0], w_[1]); ow[2 * e4 + 1] = pk2(w_[2], w_[3]); }
      LAS u32x4* dq = (LAS u32x4*)(Qt + si * LDN + st_s * 16); LAS u32x4* dh = (LAS u32x4*)(Kh + si * LDN + st_s * 16); LAS u32x4* dw = (LAS u32x4*)(Kw + si * LDN + st_s * 16);
      dq[0] = (u32x4){oq[0], oq[1], oq[2], oq[3]}; dq[1] = (u32x4){oq[4], oq[5], oq[6], oq[7]};
      dh[0] = (u32x4){oh[0], oh[1], oh[2], oh[3]}; dh[1] = (u32x4){oh[4], oh[5], oh[6], oh[7]};
      dw[0] = (u32x4){ow[0], ow[1], ow[2], ow[3]}; dw[1] = (u32x4){ow[4], ow[5], ow[6], ow[7]}; }
    LBAR();
    if (w < 3) { const int I = w >= 1 ? 1 : 0, J = w == 2 ? 1 : 0;
      f32x4 acc = (f32x4){0.f, 0.f, 0.f, 0.f};
      const LAS bf16_t* pa = Qt + 16 * I * LDN + rL136; const LAS bf16_t* pb = Kh + 16 * J * LDN + rL136;
#pragma unroll
      for (int k = 0; k < 4; ++k) acc = mma16(ldfr(pa + 32 * k), ldfr(pb + 32 * k), acc);
      const int jj = 16 * J + fr, i0 = 16 * I + 4 * fq;
      *(LAS u32x2*)(Pt + jj * LDP + i0) = pk4(jj <= i0 ? acc[0] : 0.f, jj <= i0 + 1 ? acc[1] : 0.f, jj <= i0 + 2 ? acc[2] : 0.f, jj <= i0 + 3 ? acc[3] : 0.f); }
    const LAS bf16_t* Sr = St + (step & 1) * 32 * LDN; LAS bf16_t* Sw = St + ((step + 1) & 1) * 32 * LDN;
    f32x4 o2 = (f32x4){0.f, 0.f, 0.f, 0.f};
    { const LAS bf16_t* ps = Sr + 16 * vt * LDN + rL136; const LAS bf16_t* pq = Qt + 16 * it * LDN + rL136;
#pragma unroll
      for (int k = 0; k < 4; ++k) o2 = mma16(ldfr(ps + 32 * k), ldfr(pq + 32 * k), o2); }
    { const bf16x8 fv0 = ldft(Vs + tL40, LDP), fv1 = ldft(Vs + tL40 + 16, LDP);
#pragma unroll
      for (int a = 0; a < 2; ++a) { const int kt = 2 * w + a; const f32x4 dec = *(const LAS f32x4*)(PL + 16 * kt + 4 * fq);
        const bf16x8 fa = ldft(Kw + tL136 + 16 * kt, LDN);
        const f32x4 a0 = mma16(fa, fv0, Sacc[a][0] * dec), a1 = mma16(fa, fv1, Sacc[a][1] * dec);
        Sacc[a][0] = a0; Sacc[a][1] = a1;
        *(LAS u32x2*)(Sw + fr * LDN + 16 * kt + 4 * fq) = pk4(a0[0], a0[1], a0[2], a0[3]);
        *(LAS u32x2*)(Sw + (16 + fr) * LDN + 16 * kt + 4 * fq) = pk4(a1[0], a1[1], a1[2], a1[3]); } }
    LBAR();
    { const f32x4 o1 = mma16(ldft(Vs + tL40 + 16 * vt, LDP), ldft(Pt + tL40 + 16 * it, LDP), (f32x4){0.f, 0.f, 0.f, 0.f});
      float o0 = o1[0] + o2[0], o1v = o1[1] + o2[1], o2v = o1[2] + o2[2], o3 = o1[3] + o2[3];
      if (!first) { const unsigned lo = (unsigned)ppv, hi2 = (unsigned)(ppv >> 32); o0 += bflo(lo); o1v += bfhi(lo); o2v += bflo(hi2); o3 += bfhi(hi2); }
      *(u32x2*)op = pk4(o0, o1v, o2v, o3); }
    LBAR();
  }
}
__device__ __forceinline__ void phase_chain1(const Params& P, const Ctx& C, int mode) {
  if (mode != 2) for (int task = C.bid; task < 128; task += C.nblk) gdn3_chain_wg(P, C, task);
  __builtin_amdgcn_sched_barrier(0);
  if (mode != 1) for (int task = C.bid < 128 ? C.bid + C.nblk : C.bid; task < 256; task += C.nblk) hgrn2_chain_wg(P, C, task - 128);
}
__device__ __forceinline__ void phase_onorm(const Params& P, const Ctx& C, int ident) {
  bf16_t* MIX = WS(OFF_MIX1, bf16_t); bf16_t* U = WS(OFF_U1B, bf16_t);
  const float* m1 = WS(OFF_MOD, float) + (size_t)5 * 6144;
  for (int r = C.gw; r < R; r += C.ngw) {
    const int b = r / TB, pos = r % TB; if (pos < CTXL) continue;
#pragma unroll
    for (int half = 0; half < 2; ++half) {
      const float* gn = half ? GIN(I_HNG) : GIN(I_GNG);
#pragma unroll
      for (int j = 0; j < 4; ++j) { const int e = 4 * C.lane + 256 * j; bf16_t* p = MIX + (size_t)r * MIXW + half * 1024 + e;
        const u32x2 a = *(const u32x2*)p; const float o0 = bflo(a.x), o1 = bfhi(a.x), o2 = bflo(a.y), o3 = bfhi(a.y);
        const float ss = half_sum32((o0 * o0 + o1 * o1) + (o2 * o2 + o3 * o3)); const float rs = rsqrtf(ss * (1.f / 128.f) + RMS_EPS);
        const f32x4 g = *(const f32x4*)(gn + (e & 127));
        u32x2 w; w.x = pk2(o0 * rs * g[0], o1 * rs * g[1]); w.y = pk2(o2 * rs * g[2], o3 * rs * g[3]); if (ident) w = a; *(u32x2*)p = w; }
    }
    f32x4 h[4], u[4]; row_load(GOUT + ((size_t)b * SEQ + (pos - CTXL)) * D, C.lane, h);
    row_modulate(h, m1 + (size_t)b * 6144, m1 + (size_t)b * 6144 + D, C.lane, u);
    row_store_bf16(U + (size_t)r * D, C.lane, u);
  }
  LAS float* scr = (LAS float*)C.lds + C.wave * (64 * 33);
  convert_experts(P, 1, WS(OFF_WE1, bf16_t), WS(OFF_WE1 + 64 * MiB, bf16_t), C, scr);
}
__device__ __forceinline__ void phase_gates(const Params& P, const Ctx& C) {
  pg8::Gemm g{WS(OFF_U1B, bf16_t), WS(OFF_WG1, bf16_t), D, D}; pg8::GridOrder S; S.init(128, 8, C.nblk, C.bid, 1);
  pg8::EpiGateMul E{WS(OFF_MIX1, bf16_t), MIXW};
  pg8::gemm_phase(C.lds, g, S, E);
}


#define XB_TMO      128
#define XB_XCNT(j)  (256  + 64 * (j))
#define XB_XSUB(j)  (1280 + 64 * (j))
#define XB_XGEN(j)  (2304 + 64 * (j))
#define XB_TOP      3328
#define XB_TOPGEN   3392
#define XCD_BAR_WORDS 3456
#define XB_SPIN_CAP (1u << 22)
constexpr size_t OFF_BAR = 16 * 1024;
constexpr int LDS_BAR_OFF = LDS_BYTES - 64;
__device__ __forceinline__ unsigned xb_ld(unsigned* p)              { return __hip_atomic_load(p, __ATOMIC_RELAXED, __HIP_MEMORY_SCOPE_AGENT); }
__device__ __forceinline__ unsigned xb_add(unsigned* p, unsigned v) { return __hip_atomic_fetch_add(p, v, __ATOMIC_RELAXED, __HIP_MEMORY_SCOPE_AGENT); }
__device__ __forceinline__ unsigned xb_xcc_id() { return (unsigned)__builtin_amdgcn_s_getreg((3 << 11) | 20) & 0xFu; }
#define XB_SPIN(cond, bar) do { unsigned _sp = 0; while (cond) { __builtin_amdgcn_s_sleep(1); \
    if ((++_sp & 255u) == 0u) { if (xb_ld(&(bar)[XB_TMO])) break; if (_sp > XB_SPIN_CAP) { atomicAdd(&(bar)[XB_TMO], 1u); break; } } } } while (0)
__device__ __forceinline__ void xcd_barrier_post(unsigned* bar) { if (threadIdx.x == 0) (void)xb_add(&bar[XB_XCNT(xb_xcc_id())], 1u); }
__device__ __forceinline__ void xcd_barrier_complete(unsigned* bar, unsigned x, unsigned& nloc, unsigned& nx) {
  const unsigned G = gridDim.x * gridDim.y * gridDim.z;
  unsigned sum, cnt, mine, sp = 0u;
  for (;;) {
    sum = 0u; cnt = 0u; mine = 0u;
#pragma unroll
    for (unsigned j = 0; j < 16; ++j) { const unsigned c = xb_ld(&bar[XB_XCNT(j)]); sum += c; cnt += (c > 0u) ? 1u : 0u; mine = (j == x) ? c : mine; }
    if (sum == G) break;
    __builtin_amdgcn_s_sleep(1);
    if ((++sp & 255u) == 0u) { if (xb_ld(&bar[XB_TMO])) break; if (sp > XB_SPIN_CAP) { atomicAdd(&bar[XB_TMO], 1u); break; } }
  }
  nloc = mine > 0u ? mine : 1u; nx = cnt > 0u ? cnt : 1u;
}
__device__ __forceinline__ void xcd_barrier(unsigned* bar, volatile LAS unsigned* st) {
  asm volatile("s_waitcnt vmcnt(0)" ::: "memory");
  __syncthreads();
  if (threadIdx.x == 0) {
    const unsigned x = xb_xcc_id();
    __builtin_amdgcn_s_waitcnt(0);
    unsigned nloc = st[0], nx = st[1];
    if (nloc == 0u) { xcd_barrier_complete(bar, x, nloc, nx); st[0] = nloc; st[1] = nx; }
    const unsigned old = xb_add(&bar[XB_XSUB(x)], 1u);
    const unsigned gen = old / nloc;
    if (old + 1u == (gen + 1u) * nloc) {
      __builtin_amdgcn_fence(__ATOMIC_RELEASE, "agent");
      asm volatile("s_waitcnt vmcnt(0)" ::: "memory");
      const unsigned og = xb_add(&bar[XB_TOP], 1u);
      const unsigned tg = og / nx;
      if (og + 1u == (tg + 1u) * nx) xb_add(&bar[XB_TOPGEN], 1u);
      else XB_SPIN(xb_ld(&bar[XB_TOPGEN]) == tg, bar);
      __builtin_amdgcn_fence(__ATOMIC_ACQUIRE, "agent");
      xb_add(&bar[XB_XGEN(x)], 1u);
      asm volatile("s_waitcnt vmcnt(0)" ::: "memory");
    } else {
      XB_SPIN(xb_ld(&bar[XB_XGEN(x)]) == gen, bar);
      __builtin_amdgcn_fence(__ATOMIC_ACQUIRE, "agent");
      asm volatile("s_waitcnt vmcnt(0)" ::: "memory");
    }
  }
  __syncthreads();
}
__global__ void __launch_bounds__(NT, 2) fwd_megakernel(Params Pk) {
  extern __shared__ __attribute__((aligned(16))) unsigned char lds_raw[];
  cg::grid_group grid = cg::this_grid();
#ifndef PROBE_DOUBLE
#define PROBE_DOUBLE -1
#endif
#ifndef PROBE_MODE
#define PROBE_MODE 0
#endif
#ifndef PHASE_MASK
#define PHASE_MASK 0xFFFFFFFFu
#endif
#define SYNC() do { const unsigned char* wsb_ = ((const Params*)(const __attribute__((address_space(4))) Params*)__builtin_amdgcn_kernarg_segment_ptr())->ws; \
    xcd_barrier((unsigned*)(GAS unsigned*)(wsb_ + OFF_BAR), (volatile LAS unsigned*)((LAS unsigned char*)lds_raw + LDS_BAR_OFF)); } while (0)
#define SYNC_CG() do { __syncthreads(); grid.sync(); } while (0)
  if (threadIdx.x < 16) ((LAS unsigned*)((LAS unsigned char*)lds_raw + LDS_BAR_OFF))[threadIdx.x] = 0u;
  __syncthreads();
  xcd_barrier_post((unsigned*)(GAS unsigned*)(Pk.ws + OFF_BAR));
#define LAUNDER() const Params* pp; { unsigned long long a_ = (unsigned long long)__builtin_amdgcn_kernarg_segment_ptr(); asm volatile("" : "+s"(a_)); \
    const unsigned lo_ = __builtin_amdgcn_readfirstlane((unsigned)a_), hi_ = __builtin_amdgcn_readfirstlane((unsigned)(a_ >> 32)); \
    pp = (const Params*)(const __attribute__((address_space(4))) Params*)(((unsigned long long)hi_ << 32) | lo_); } \
  Ctx C; { int t_ = threadIdx.x; asm volatile("" : "+v"(t_)); t_ &= 511; int b_ = blockIdx.x; asm volatile("" : "+s"(b_)); b_ = __builtin_amdgcn_readfirstlane(b_); int g_ = gridDim.x; asm volatile("" : "+s"(g_)); g_ = __builtin_amdgcn_readfirstlane(g_); \
    C.lds = (LAS unsigned char*)lds_raw; C.tid = t_; C.lane = t_ & 63; C.wave = __builtin_amdgcn_readfirstlane(t_ >> 6); \
    C.bid = b_; C.nblk = g_; C.gw = b_ * NWAVES + C.wave; C.ngw = g_ * NWAVES; }
#define WSP(off, T) ((T*)(GAS T*)(pp->ws + (off)))
  for (int rep_ = 0; rep_ < ((PROBE_DOUBLE == 0) ? 2 : 1); ++rep_) { if (PHASE_MASK & (1u << 0)) { LAUNDER(); phase0(*pp, C); }  SYNC_CG(); }
  for (int rep_ = 0; rep_ < ((PROBE_DOUBLE == 1) ? 2 : 1); ++rep_) { if (PHASE_MASK & (1u << 1)) { LAUNDER(); phase_u0(*pp, C); }  SYNC(); }
  for (int rep_ = 0; rep_ < ((PROBE_DOUBLE == 2) ? 2 : 1); ++rep_) { if (PHASE_MASK & (1u << 2)) { LAUNDER(); phase_inproj(*pp, C, WSP(OFF_U0, bf16_t), WSP(OFF_WAB, bf16_t), WSP(OFF_Z0, bf16_t), Z0W); }  SYNC(); }
  for (int rep_ = 0; rep_ < ((PROBE_DOUBLE == 3) ? 2 : 1); ++rep_) { if (PHASE_MASK & (1u << 3)) { LAUNDER(); phase_feat0(*pp, C, rep_); }  SYNC(); }
  for (int rep_ = 0; rep_ < ((PROBE_DOUBLE == 4) ? 2 : 1); ++rep_) { if (PHASE_MASK & (1u << 4)) { LAUNDER(); phase_chain0(*pp, C, rep_ ? PROBE_MODE : 0); }  SYNC(); }
  for (int rep_ = 0; rep_ < ((PROBE_DOUBLE == 5) ? 2 : 1); ++rep_) { if (PHASE_MASK & (1u << 5)) { LAUNDER(); phase_ssdfin(*pp, C, rep_); }  SYNC(); }
  for (int rep_ = 0; rep_ < ((PROBE_DOUBLE == 6) ? 2 : 1); ++rep_) { if (PHASE_MASK & (1u << 6)) { LAUNDER(); phase_outproj(*pp, C, 0); }  SYNC(); }
  for (int rep_ = 0; rep_ < ((PROBE_DOUBLE == 7) ? 2 : 1); ++rep_) { if (PHASE_MASK & (1u << 7)) { LAUNDER(); phase_lnmix(*pp, C, 0, rep_); }  SYNC(); }
  for (int rep_ = 0; rep_ < ((PROBE_DOUBLE == 9) ? 2 : 1); ++rep_) { if (PHASE_MASK & (1u << 9)) { LAUNDER(); phase_moe1(*pp, C, 0); }  SYNC(); }
  for (int rep_ = 0; rep_ < ((PROBE_DOUBLE == 10) ? 2 : 1); ++rep_) { if (PHASE_MASK & (1u << 10)) { LAUNDER(); phase_moe2(*pp, C, 0); }  SYNC(); }
  for (int rep_ = 0; rep_ < ((PROBE_DOUBLE == 11) ? 2 : 1); ++rep_) { if (PHASE_MASK & (1u << 11)) { LAUNDER(); phase_lnffn(*pp, C, 0, rep_); }  SYNC(); }
  for (int rep_ = 0; rep_ < ((PROBE_DOUBLE == 12) ? 2 : 1); ++rep_) { if (PHASE_MASK & (1u << 12)) { LAUNDER(); phase_inproj(*pp, C, WSP(OFF_U1, bf16_t), WSP(OFF_WCD, bf16_t), WSP(OFF_Z1, bf16_t), Z1W); }  SYNC(); }
  for (int rep_ = 0; rep_ < ((PROBE_DOUBLE == 13) ? 2 : 1); ++rep_) { if (PHASE_MASK & (1u << 13)) { LAUNDER(); phase_feat1(*pp, C, rep_); }  SYNC(); }
  for (int rep_ = 0; rep_ < ((PROBE_DOUBLE == 14) ? 2 : 1); ++rep_) { if (PHASE_MASK & (1u << 14)) { LAUNDER(); phase_chain1(*pp, C, rep_ ? PROBE_MODE : 0); }  SYNC(); }
  for (int rep_ = 0; rep_ < ((PROBE_DOUBLE == 15) ? 2 : 1); ++rep_) { if (PHASE_MASK & (1u << 15)) { LAUNDER(); phase_onorm(*pp, C, rep_); }  SYNC(); }
  for (int rep_ = 0; rep_ < ((PROBE_DOUBLE == 16) ? 2 : 1); ++rep_) { if (PHASE_MASK & (1u << 16)) { LAUNDER(); phase_gates(*pp, C); }  SYNC(); }
  for (int rep_ = 0; rep_ < ((PROBE_DOUBLE == 17) ? 2 : 1); ++rep_) { if (PHASE_MASK & (1u << 17)) { LAUNDER(); phase_outproj(*pp, C, 1); }  SYNC(); }
  for (int rep_ = 0; rep_ < ((PROBE_DOUBLE == 18) ? 2 : 1); ++rep_) { if (PHASE_MASK & (1u << 18)) { LAUNDER(); phase_lnmix(*pp, C, 1, rep_); }  SYNC(); }
  for (int rep_ = 0; rep_ < ((PROBE_DOUBLE == 20) ? 2 : 1); ++rep_) { if (PHASE_MASK & (1u << 20)) { LAUNDER(); phase_moe1(*pp, C, 1); }  SYNC(); }
  for (int rep_ = 0; rep_ < ((PROBE_DOUBLE == 21) ? 2 : 1); ++rep_) { if (PHASE_MASK & (1u << 21)) { LAUNDER(); phase_moe2(*pp, C, 1); }  SYNC(); }
  for (int rep_ = 0; rep_ < ((PROBE_DOUBLE == 22) ? 2 : 1); ++rep_) { if (PHASE_MASK & (1u << 22)) { LAUNDER(); phase_lnffn(*pp, C, 1, rep_); } if (PROBE_DOUBLE == 22) SYNC(); }
}

extern "C" void kernel_launch(void* const* d_in, const int* in_sizes, int n_in, void* d_out, int out_size,
                              void* d_ws, size_t ws_size, hipStream_t stream) {
  static int grid_blocks = 0;
  if (!grid_blocks) {
    int dev = 0, cus = 0, per_cu = 0;
    (void)hipGetDevice(&dev);
    (void)hipDeviceGetAttribute(&cus, hipDeviceAttributeMultiprocessorCount, dev);
    (void)hipFuncSetAttribute((const void*)fwd_megakernel, hipFuncAttributeMaxDynamicSharedMemorySize, LDS_BYTES);
    (void)hipOccupancyMaxActiveBlocksPerMultiprocessor(&per_cu, (const void*)fwd_megakernel, NT, LDS_BYTES);
    if (per_cu < 1) per_cu = 1;
    grid_blocks = cus * 1;
    fprintf(stderr, "grid %d (cus %d per_cu %d) ws_size %zu need %zu n_in %d\n", grid_blocks, cus, per_cu, ws_size, (size_t)WS_NEED, n_in);
    if (ws_size < WS_NEED || n_in != 39) { fprintf(stderr, "kernel_launch: workspace too small or unexpected inputs\n"); grid_blocks = -1; }
  }
  if (grid_blocks < 0) return;
  (void)hipMemsetAsync(d_ws, 0, 64 * 1024, stream);
  Params p{};
  for (int i = 0; i < 39; ++i) p.in[i] = (const float*)d_in[i];
  p.out = (float*)d_out; p.ws = (unsigned char*)d_ws;
  void* args[] = {&p};
  hipError_t e = hipLaunchCooperativeKernel((const void*)fwd_megakernel, dim3(grid_blocks), dim3(NT), args, LDS_BYTES, stream);
  if (e != hipSuccess) fprintf(stderr, "cooperative launch failed: %s (grid %d)\n", hipGetErrorString(e), grid_blocks);
}
```

```cpp
#include <hip/hip_runtime.h>
#include <hip/hip_cooperative_groups.h>
#include <cstdio>
#include <cstdint>
namespace cg = cooperative_groups;

#define LAS __attribute__((address_space(3)))
typedef unsigned short bf16_t;
typedef short bf16x8 __attribute__((ext_vector_type(8)));
typedef float f32x4 __attribute__((ext_vector_type(4)));
typedef float f32x2 __attribute__((ext_vector_type(2)));
typedef unsigned u32x4 __attribute__((ext_vector_type(4)));
typedef unsigned u32x2 __attribute__((ext_vector_type(2)));

constexpr int D = 1024, NB = 4, SEQ = 8192, CTXL = 256, TB = SEQ + CTXL  , R = NB * TB  , RLAT = NB * SEQ;
constexpr int NT = 512, NWAVES = 8;
constexpr int LDS_BYTES = 163840;
constexpr int AB_IN = 4640, CD_IN = 9248;
constexpr int Z0W = 4608, Z1W = 7168, MIXW = 2048;
constexpr int NEXP = 32, DEXP = 512, MOE_BLK = 256, MAX_BLKS = 304, MAX_SLOTS = 296 * 256;
constexpr float ALPHA = 1.41421356237309515f;
constexpr float LN_EPS = 1e-5f, RMS_EPS = 1e-6f;
constexpr int Z0_RGX = 0, Z0_RGY = 1024, Z0_SSDZ = 2048, Z0_XBC = 3072, Z0_B = 4096, Z0_C = 4352;
constexpr int Z1_Q = 0, Z1_K = 1024, Z1_V = 2048, Z1_HQ = 3072, Z1_HF = 4096, Z1_HI = 6144;

constexpr size_t MiB = 1u << 20;
constexpr size_t OFF_CTL = 0;
constexpr size_t OFF_MOD = 64 * 1024;
constexpr size_t OFF_LB1 = 320 * 1024;
constexpr size_t OFF_ROUTE = 512 * 1024;
constexpr size_t OFF_SLOTW = 2 * MiB;
constexpr size_t OFF_DT = 3 * MiB;
constexpr size_t OFF_HCTX = 8 * MiB;
constexpr size_t OFF_TCTX = 12 * MiB;
constexpr size_t OFF_WOUT0 = 16 * MiB, OFF_WOUT1 = 20 * MiB, OFF_WG1 = 24 * MiB, OFF_WAB = 28 * MiB;
constexpr size_t OFF_TOK = 37 * MiB + 512 * 1024;
constexpr int TOKCAP = 33792;
constexpr size_t OFF_A = 40 * MiB;
constexpr size_t OFF_Z0 = OFF_A, OFF_MIX0 = OFF_A + 297 * MiB, OFF_WE0 = OFF_A + 429 * MiB, OFF_U0 = OFF_A + 525 * MiB;
constexpr size_t OFF_AM0 = OFF_A, OFF_HM0 = OFF_A + 148 * MiB, OFF_YM0 = OFF_A + 222 * MiB;
constexpr size_t OFF_Z1 = OFF_A, OFF_U1 = OFF_A + 462 * MiB, OFF_WCD = OFF_A + 528 * MiB, OFF_MIX1 = OFF_A + 462 * MiB;
constexpr size_t OFF_WE1 = OFF_A, OFF_U1B = OFF_A + 96 * MiB, OFF_AM1 = OFF_A + 96 * MiB, OFF_HM1 = OFF_A + 244 * MiB, OFF_YM1 = OFF_A + 318 * MiB, OFF_V1 = OFF_A + 470 * MiB;
constexpr size_t WS_NEED = OFF_A + 594 * MiB;
static_assert((size_t)R * Z0W * 2 <= 297 * MiB && (size_t)R * MIXW * 2 <= 132 * MiB && (size_t)R * Z1W * 2 <= 462 * MiB && (size_t)R * D * 2 <= 66 * MiB, "ws map");
static_assert((size_t)MAX_SLOTS * D * 2 <= 148 * MiB && (size_t)MAX_SLOTS * DEXP * 2 <= 74 * MiB, "ws map moe");
static_assert(OFF_DT + (size_t)R * 32 * 4 <= OFF_HCTX && OFF_ROUTE + (size_t)R * 32 <= OFF_SLOTW && OFF_SLOTW + MAX_SLOTS * 4 <= OFF_DT, "ws map small");

struct Params { const float* in[39]; float* out; unsigned char* ws; };
enum { I_X = 0, I_C, I_CTX, I_CCTX, I_HLB, I_ADAW, I_ADAB, I_LNMG, I_LNMB, I_LNFG, I_LNFB, I_OUTW, I_RGW, I_RGB, I_REW, I_REB, I_EWG, I_EWU, I_EWD,
       I_ABW, I_RGCW, I_RGCB, I_RGAW, I_RGAB, I_RGXW, I_RGXB, I_RGLAM, I_SCW, I_SCB, I_SALOG, I_SDTB, I_SD, I_SNG, I_CDW, I_GCW, I_GALOG, I_GDTB, I_GNG, I_HNG };

__device__ __forceinline__ unsigned f2bf(float f) { unsigned u = __float_as_uint(f); return (u + 0x7fffu + ((u >> 16) & 1u)) >> 16; }
__device__ __forceinline__ float bf2f(unsigned b) { return __uint_as_float(b << 16); }
typedef __bf16 bf16x2v_t __attribute__((ext_vector_type(2)));
__device__ __forceinline__ unsigned pk2(float lo, float hi) { const f32x2 v = {lo, hi}; const bf16x2v_t r = __builtin_convertvector(v, bf16x2v_t); return __builtin_bit_cast(unsigned, r); }
__device__ __forceinline__ float bflo(unsigned w) { return __uint_as_float(w << 16); }
__device__ __forceinline__ float bfhi(unsigned w) { return __uint_as_float(w & 0xffff0000u); }
__device__ __forceinline__ float sigmoidf_(float x) { return __builtin_amdgcn_rcpf(1.f + __expf(-x)); }
__device__ __forceinline__ float siluf_(float x) { return x * __builtin_amdgcn_rcpf(1.f + __expf(-x)); }
__device__ __forceinline__ float softplusf_(float x) { const float t = __expf(-fabsf(x)); return fmaxf(x, 0.f) + (t < 1e-4f ? t - 0.5f * t * t : __logf(1.f + t)); }
__device__ __forceinline__ float geluf_(float x) { const float u = 0.7978845608028654f * (x + 0.044715f * x * x * x); return 0.5f * x * (1.f + tanhf(u)); }
template <int CTRL> __device__ __forceinline__ float dpp_mov(float v) {
  return __builtin_bit_cast(float, __builtin_amdgcn_update_dpp(0, __builtin_bit_cast(int, v), CTRL, 0xf, 0xf, true));
}
__device__ __forceinline__ float row_sum16(float v) {
  v += dpp_mov<0xB1>(v); v += dpp_mov<0x4E>(v); v += dpp_mov<0x141>(v); v += dpp_mov<0x140>(v);
  return v;
}
__device__ __forceinline__ float wave_sum(float v) { v = row_sum16(v); v += __shfl_xor(v, 16); v += __shfl_xor(v, 32); return v; }
__device__ __forceinline__ float half_sum32(float v) { v = row_sum16(v); v += __shfl_xor(v, 16); return v; }
__device__ __forceinline__ int rmap(int latonly, int q) { return latonly ? (q >> 13) * TB + CTXL + (q & 8191) : q; }
__device__ __forceinline__ int row_batch(int r) { return r / TB; }

namespace pg8 {
constexpr int BM = 256, BK = 64, HALF = 128, HTB = HALF * BK * 2, STAGE_BYTES = 8 * HTB, NXCD = 8, WGM = 8;
__host__ __device__ __forceinline__ int lds_byte(int r, int c) { const int st = (r >> 4) * 2 + (c >> 5), rr = r & 15, cc = c & 31, ob = rr * 64 + cc * 2; return st * 1024 + (ob ^ (((ob >> 9) & 1) << 5)); }
__host__ __device__ __forceinline__ void stage_rc(int b, int& Rr, int& C) { const int st = b / 1024, sb = b % 1024, swz = sb ^ (((sb >> 9) & 1) << 5); Rr = (st >> 1) * 16 + swz / 64; C = (st & 1) * 32 + (swz % 64) / 2; }
__host__ __device__ __forceinline__ int perm32(int rho) { const int n = rho >> 4, i = rho & 15; return 8 * (i >> 2) + 4 * n + (i & 3); }
struct Unit { int pm, pn; };
struct Gemm { const bf16_t* A; const bf16_t* Bt; int lda, K; };

struct GridOrder {
  int nM, nN, nwg, G, c, skipctx;
  __device__ void init(int nM_, int nN_, int G_, int c_, int skipctx_) { nM = nM_; nN = nN_; nwg = nM * nN; G = G_; c = c_; skipctx = skipctx_; }
  __device__ bool next(int i, Unit& u) const {
    const long L = (long)i * G + c; if (L >= nwg) return false;
    int wgid = (int)L; { const int q = nwg / NXCD, r = nwg % NXCD, xcd = wgid % NXCD, off = wgid / NXCD; wgid = (xcd < r ? xcd * (q + 1) : r * (q + 1) + (xcd - r) * q) + off; }
    const int nig = WGM * nN, gid = wgid / nig, fm = gid * WGM, gsz = (nM - fm) < WGM ? (nM - fm) : WGM;
    int pm = fm + ((wgid % nig) % gsz); u.pn = (wgid % nig) / gsz;
    if (skipctx) pm = (pm >> 5) * 33 + 1 + (pm & 31);
    u.pm = pm; return true;
  }
};
struct MoeOrder {
  const LAS int* base; const LAS int* cntL; const LAS int* blk_e; const unsigned short* tok; int nunits, G, c;
  __device__ bool next(int i, Unit& u) const {
    const long L = (long)i * G + c; if (L >= nunits) return false;
    const int blk = (int)(L >> 2), j = (int)(L & 3);
    u.pm = blk; u.pn = blk_e[blk] * 4 + j; return true;
  }
  __device__ int arow(const Unit& u, int r) const {
    const int e = blk_e[u.pm]; const int pos = (u.pm - base[e]) * 256 + r;
    return pos < cntL[e] ? (int)tok[(size_t)e * TOKCAP + pos] : 0;
  }
};

__device__ __forceinline__ unsigned cvt_pk_bf16(float lo, float hi) { return pk2(lo, hi); }

template <class Epi, class Sched>
__device__ __forceinline__ void gemm_phase(LAS unsigned char* lds, const Gemm g, const Sched& S, const Epi& E) {
  int tid_ = threadIdx.x; asm volatile("" : "+v"(tid_)); tid_ &= 511; const int tid = tid_, wid = __builtin_amdgcn_readfirstlane(tid >> 6), lane = tid & 63, wr = wid >> 2, wc = wid & 3, fr = lane & 15, fq = lane >> 4;
  const int K = g.K, nt = K / BK, lda = g.lda;
  unsigned voffA[2], voffB[2];
#pragma unroll
  for (int i = 0; i < 2; ++i) { int Rr, C; stage_rc(tid * 16 + i * 8192, Rr, C); const int Rb = Epi::PERM ? ((Rr & ~31) + perm32(Rr & 31)) : Rr;
    voffA[i] = (unsigned)(Rr * lda + C) * 2u; voffB[i] = (unsigned)(Rb * K + C) * 2u; }
  const size_t kstep = (size_t)(BK * 2);
  const size_t hstepA = (size_t)HALF * lda * 2, hstepB = (size_t)HALF * K * 2;
  const size_t tstepA = 2 * hstepA, tstepB = 2 * hstepB;
  const unsigned ldsw = (unsigned)wid * 1024u;
  const int aoff = lds_byte(wr * 64 + fr, fq * 8), boff = lds_byte(wc * 32 + fr, fq * 8);
#define PG8_SA(b, h) (((b) * 2 + (h)) * HTB)
#define PG8_SB(b, h) ((4 + (b) * 2 + (h)) * HTB)
#define PG8_STAGE(bufoff, gbase, voff) do { _Pragma("unroll") for (int _i = 0; _i < 2; ++_i) \
    __builtin_amdgcn_global_load_lds((const unsigned*)((const char*)(gbase) + (voff)[_i]), (LAS unsigned*)(lds + (bufoff) + ldsw + _i * 8192), 16, 0, 0); } while (0)
#define PG8_LDA(dst, b, h) do { _Pragma("unroll") for (int m = 0; m < 4; ++m) _Pragma("unroll") for (int k = 0; k < 2; ++k) dst[m][k] = *(const LAS bf16x8*)(lds + PG8_SA(b, h) + aoff + m * 2048 + k * 1024); } while (0)
#define PG8_LDB(dst, b, h) do { _Pragma("unroll") for (int n = 0; n < 2; ++n) _Pragma("unroll") for (int k = 0; k < 2; ++k) dst[n][k] = *(const LAS bf16x8*)(lds + PG8_SB(b, h) + boff + n * 2048 + k * 1024); } while (0)
#define PG8_MMA(ai, bj, At, Bt) do { __builtin_amdgcn_s_setprio(1); _Pragma("unroll") for (int m = 0; m < 4; ++m) _Pragma("unroll") for (int n = 0; n < 2; ++n) _Pragma("unroll") for (int k = 0; k < 2; ++k) \
    acc[ai][bj][m][n] = __builtin_amdgcn_mfma_f32_16x16x32_bf16(Bt[n][k], At[m][k], acc[ai][bj][m][n], 0, 0, 0); __builtin_amdgcn_s_setprio(0); } while (0)
#define PG8_WAIT_V(n) asm volatile("s_waitcnt vmcnt(" #n ")" ::: "memory")
#define PG8_WAIT_L(n) asm volatile("s_waitcnt lgkmcnt(" #n ")" ::: "memory")
#define PG8_BAR __builtin_amdgcn_s_barrier()
#define PG8_SCHED __builtin_amdgcn_sched_barrier(0)
  Unit cur, nxt; int ui = 0;
  if (!S.next(0, cur)) return;
  f32x4 acc[2][2][4][2];
#pragma unroll
  for (int a = 0; a < 2; ++a)
#pragma unroll
    for (int b = 0; b < 2; ++b)
#pragma unroll
      for (int m = 0; m < 4; ++m)
#pragma unroll
        for (int n = 0; n < 2; ++n) acc[a][b][m][n] = (f32x4){0.f, 0.f, 0.f, 0.f};
  bf16x8 At[4][2], B0[2][2], B1[2][2];
  const char* cA = (const char*)g.A + (size_t)cur.pm * tstepA; const char* cB = (const char*)g.Bt + (size_t)cur.pn * tstepB;
  PG8_STAGE(PG8_SB(0, 0), cB, voffB); PG8_STAGE(PG8_SA(0, 0), cA, voffA); PG8_STAGE(PG8_SB(0, 1), cB + hstepB, voffB); PG8_STAGE(PG8_SA(0, 1), cA + hstepA, voffA);
  if (wr == 1) PG8_BAR;
  PG8_WAIT_V(4); PG8_BAR;
  PG8_STAGE(PG8_SB(1, 0), cB + kstep, voffB); PG8_STAGE(PG8_SA(1, 0), cA + kstep, voffA); PG8_STAGE(PG8_SB(1, 1), cB + hstepB + kstep, voffB);
  PG8_WAIT_V(6); PG8_BAR;
  for (;;) {
    const bool has_next = S.next(ui + 1, nxt);
    const char* nA = has_next ? (const char*)g.A + (size_t)nxt.pm * tstepA : cA; const char* nB = has_next ? (const char*)g.Bt + (size_t)nxt.pn * tstepB : cB;
    for (int t = 0; t < nt; t += 2) {
      const bool last = (t == nt - 2);
      const char* a1 = cA + (size_t)(t + 1) * kstep;
      const char* a2 = last ? nA : cA + (size_t)(t + 2) * kstep; const char* b2 = last ? nB : cB + (size_t)(t + 2) * kstep;
      const char* a3 = a2 + kstep; const char* b3 = b2 + kstep;
      PG8_LDB(B0, 0, 0); PG8_SCHED; PG8_LDA(At, 0, 0); PG8_STAGE(PG8_SA(1, 1), a1 + hstepA, voffA);
      PG8_WAIT_L(8); PG8_BAR; PG8_WAIT_L(0); PG8_MMA(0, 0, At, B0); PG8_BAR; PG8_SCHED;
      PG8_LDB(B1, 0, 1); PG8_STAGE(PG8_SB(0, 0), b2, voffB);
      PG8_BAR; PG8_WAIT_L(0); PG8_MMA(0, 1, At, B1); PG8_BAR;
      PG8_LDA(At, 0, 1); PG8_STAGE(PG8_SA(0, 0), a2, voffA);
      PG8_BAR; PG8_WAIT_L(0); PG8_MMA(1, 0, At, B0); PG8_BAR; PG8_SCHED;
      PG8_STAGE(PG8_SB(0, 1), b2 + hstepB, voffB);
      PG8_WAIT_V(6); PG8_BAR; PG8_MMA(1, 1, At, B1); PG8_BAR;
      PG8_LDB(B0, 1, 0); PG8_SCHED; PG8_LDA(At, 1, 0); PG8_STAGE(PG8_SA(0, 1), a2 + hstepA, voffA);
      PG8_WAIT_L(8); PG8_BAR; PG8_WAIT_L(0); PG8_MMA(0, 0, At, B0); PG8_BAR; PG8_SCHED;
      PG8_LDB(B1, 1, 1); PG8_STAGE(PG8_SB(1, 0), b3, voffB);
      PG8_BAR; PG8_WAIT_L(0); PG8_MMA(0, 1, At, B1); PG8_BAR;
      PG8_LDA(At, 1, 1); PG8_STAGE(PG8_SA(1, 0), a3, voffA);
      PG8_BAR; PG8_WAIT_L(0); PG8_MMA(1, 0, At, B0); PG8_BAR; PG8_SCHED;
      PG8_STAGE(PG8_SB(1, 1), b3 + hstepB, voffB);
      PG8_WAIT_V(6); PG8_BAR; PG8_MMA(1, 1, At, B1); PG8_BAR;
    }
    E(acc, cur, wr, wc, fr, fq);
    if (!has_next) break;
#pragma unroll
    for (int a = 0; a < 2; ++a)
#pragma unroll
      for (int b = 0; b < 2; ++b)
#pragma unroll
        for (int m = 0; m < 4; ++m)
#pragma unroll
          for (int n = 0; n < 2; ++n) acc[a][b][m][n] = (f32x4){0.f, 0.f, 0.f, 0.f};
    cur = nxt; cA = nA; cB = nB; ++ui;
  }
  PG8_WAIT_V(0);
  if (wr == 0) PG8_BAR;
  PG8_BAR;
#undef PG8_SA
#undef PG8_SB
#undef PG8_STAGE
#undef PG8_LDA
#undef PG8_LDB
#undef PG8_MMA
#undef PG8_WAIT_V
#undef PG8_WAIT_L
#undef PG8_BAR
#undef PG8_SCHED
}

template <class Epi, class Sched>
__device__ __forceinline__ void gemm_phase_ga(LAS unsigned char* lds, const Gemm g, const Sched& S, const Epi& E) {
  int tid_ = threadIdx.x; asm volatile("" : "+v"(tid_)); tid_ &= 511; const int tid = tid_, wid = __builtin_amdgcn_readfirstlane(tid >> 6), lane = tid & 63, wr = wid >> 2, wc = wid & 3, fr = lane & 15, fq = lane >> 4;
  const int K = g.K, nt = K / BK, lda = g.lda;
  unsigned voffB[2]; int rowA[2]; unsigned colA[2];
#pragma unroll
  for (int i = 0; i < 2; ++i) { int Rr, C; stage_rc(tid * 16 + i * 8192, Rr, C); const int Rb = Epi::PERM ? ((Rr & ~31) + perm32(Rr & 31)) : Rr;
    rowA[i] = Rr; colA[i] = (unsigned)C * 2u; voffB[i] = (unsigned)(Rb * K + C) * 2u; }
  unsigned oc[2][2], on[2][2];
  const size_t kstep = (size_t)(BK * 2);
  const size_t hstepB = (size_t)HALF * K * 2;
  const size_t tstepB = 2 * hstepB;
  const unsigned ldsw = (unsigned)wid * 1024u;
  const int aoff = lds_byte(wr * 64 + fr, fq * 8), boff = lds_byte(wc * 32 + fr, fq * 8);
#define PG8_SA(b, h) (((b) * 2 + (h)) * HTB)
#define PG8_SB(b, h) ((4 + (b) * 2 + (h)) * HTB)
#define PG8_STAGE_A(bufoff, off2, kbyte) do { _Pragma("unroll") for (int _i = 0; _i < 2; ++_i) \
    __builtin_amdgcn_global_load_lds((const unsigned*)((const char*)g.A + (size_t)(kbyte) + (off2)[_i]), (LAS unsigned*)(lds + (bufoff) + ldsw + _i * 8192), 16, 0, 0); } while (0)
#define PG8_OFFS(dst, un) do { _Pragma("unroll") for (int _h = 0; _h < 2; ++_h) _Pragma("unroll") for (int _i = 0; _i < 2; ++_i) \
    dst[_h][_i] = (unsigned)S.arow(un, _h * HALF + rowA[_i]) * (unsigned)(lda * 2) + colA[_i]; } while (0)
#define PG8_STAGE(bufoff, gbase, voff) do { _Pragma("unroll") for (int _i = 0; _i < 2; ++_i) \
    __builtin_amdgcn_global_load_lds((const unsigned*)((const char*)(gbase) + (voff)[_i]), (LAS unsigned*)(lds + (bufoff) + ldsw + _i * 8192), 16, 0, 0); } while (0)
#define PG8_LDA(dst, b, h) do { _Pragma("unroll") for (int m = 0; m < 4; ++m) _Pragma("unroll") for (int k = 0; k < 2; ++k) dst[m][k] = *(const LAS bf16x8*)(lds + PG8_SA(b, h) + aoff + m * 2048 + k * 1024); } while (0)
#define PG8_LDB(dst, b, h) do { _Pragma("unroll") for (int n = 0; n < 2; ++n) _Pragma("unroll") for (int k = 0; k < 2; ++k) dst[n][k] = *(const LAS bf16x8*)(lds + PG8_SB(b, h) + boff + n * 2048 + k * 1024); } while (0)
#define PG8_MMA(ai, bj, At, Bt) do { __builtin_amdgcn_s_setprio(1); _Pragma("unroll") for (int m = 0; m < 4; ++m) _Pragma("unroll") for (int n = 0; n < 2; ++n) _Pragma("unroll") for (int k = 0; k < 2; ++k) \
    acc[ai][bj][m][n] = __builtin_amdgcn_mfma_f32_16x16x32_bf16(Bt[n][k], At[m][k], acc[ai][bj][m][n], 0, 0, 0); __builtin_amdgcn_s_setprio(0); } while (0)
#define PG8_WAIT_V(n) asm volatile("s_waitcnt vmcnt(" #n ")" ::: "memory")
#define PG8_WAIT_L(n) asm volatile("s_waitcnt lgkmcnt(" #n ")" ::: "memory")
#define PG8_BAR __builtin_amdgcn_s_barrier()
#define PG8_SCHED __builtin_amdgcn_sched_barrier(0)
  Unit cur, nxt; int ui = 0;
  if (!S.next(0, cur)) return;
  f32x4 acc[2][2][4][2];
#pragma unroll
  for (int a = 0; a < 2; ++a)
#pragma unroll
    for (int b = 0; b < 2; ++b)
#pragma unroll
      for (int m = 0; m < 4; ++m)
#pragma unroll
        for (int n = 0; n < 2; ++n) acc[a][b][m][n] = (f32x4){0.f, 0.f, 0.f, 0.f};
  bf16x8 At[4][2], B0[2][2], B1[2][2];
  const char* cB = (const char*)g.Bt + (size_t)cur.pn * tstepB;
  PG8_OFFS(oc, cur);
  PG8_STAGE(PG8_SB(0, 0), cB, voffB); PG8_STAGE_A(PG8_SA(0, 0), oc[0], 0); PG8_STAGE(PG8_SB(0, 1), cB + hstepB, voffB); PG8_STAGE_A(PG8_SA(0, 1), oc[1], 0);
  if (wr == 1) PG8_BAR;
  PG8_WAIT_V(4); PG8_BAR;
  PG8_STAGE(PG8_SB(1, 0), cB + kstep, voffB); PG8_STAGE_A(PG8_SA(1, 0), oc[0], kstep); PG8_STAGE(PG8_SB(1, 1), cB + hstepB + kstep, voffB);
  PG8_WAIT_V(6); PG8_BAR;
  for (;;) {
    const bool has_next = S.next(ui + 1, nxt);
    const char* nB = has_next ? (const char*)g.Bt + (size_t)nxt.pn * tstepB : cB;
    if (has_next) { PG8_OFFS(on, nxt); } else {
#pragma unroll
      for (int _h = 0; _h < 2; ++_h) { on[_h][0] = oc[_h][0]; on[_h][1] = oc[_h][1]; } }
    for (int t = 0; t < nt; t += 2) {
      const bool last = (t == nt - 2);
      const size_t k1 = (size_t)(t + 1) * kstep, k2 = last ? 0 : (size_t)(t + 2) * kstep, k3 = k2 + kstep;
      const char* b2 = last ? nB : cB + (size_t)(t + 2) * kstep; const char* b3 = b2 + kstep;
      unsigned o2a[2], o2b[2];
      if (last) { asm volatile("" : "+v"(on[0][0]), "+v"(on[0][1]), "+v"(on[1][0]), "+v"(on[1][1])); o2a[0] = on[0][0]; o2a[1] = on[0][1]; o2b[0] = on[1][0]; o2b[1] = on[1][1]; }
      else { o2a[0] = oc[0][0]; o2a[1] = oc[0][1]; o2b[0] = oc[1][0]; o2b[1] = oc[1][1]; }
      PG8_LDB(B0, 0, 0); PG8_SCHED; PG8_LDA(At, 0, 0); PG8_STAGE_A(PG8_SA(1, 1), oc[1], k1);
      PG8_WAIT_L(8); PG8_BAR; PG8_WAIT_L(0); PG8_MMA(0, 0, At, B0); PG8_BAR; PG8_SCHED;
      PG8_LDB(B1, 0, 1); PG8_STAGE(PG8_SB(0, 0), b2, voffB);
      PG8_BAR; PG8_WAIT_L(0); PG8_MMA(0, 1, At, B1); PG8_BAR;
      PG8_LDA(At, 0, 1); PG8_STAGE_A(PG8_SA(0, 0), o2a, k2);
      PG8_BAR; PG8_WAIT_L(0); PG8_MMA(1, 0, At, B0); PG8_BAR; PG8_SCHED;
      PG8_STAGE(PG8_SB(0, 1), b2 + hstepB, voffB);
      PG8_WAIT_V(6); PG8_BAR; PG8_MMA(1, 1, At, B1); PG8_BAR;
      PG8_LDB(B0, 1, 0); PG8_SCHED; PG8_LDA(At, 1, 0); PG8_STAGE_A(PG8_SA(0, 1), o2b, k2);
      PG8_WAIT_L(8); PG8_BAR; PG8_WAIT_L(0); PG8_MMA(0, 0, At, B0); PG8_BAR; PG8_SCHED;
      PG8_LDB(B1, 1, 1); PG8_STAGE(PG8_SB(1, 0), b3, voffB);
      PG8_BAR; PG8_WAIT_L(0); PG8_MMA(0, 1, At, B1); PG8_BAR;
      PG8_LDA(At, 1, 1); PG8_STAGE_A(PG8_SA(1, 0), o2a, k3);
      PG8_BAR; PG8_WAIT_L(0); PG8_MMA(1, 0, At, B0); PG8_BAR; PG8_SCHED;
      PG8_STAGE(PG8_SB(1, 1), b3 + hstepB, voffB);
      PG8_WAIT_V(6); PG8_BAR; PG8_MMA(1, 1, At, B1); PG8_BAR;
    }
    E(acc, cur, wr, wc, fr, fq);
    if (!has_next) break;
#pragma unroll
    for (int a = 0; a < 2; ++a)
#pragma unroll
      for (int b = 0; b < 2; ++b)
#pragma unroll
        for (int m = 0; m < 4; ++m)
#pragma unroll
          for (int n = 0; n < 2; ++n) acc[a][b][m][n] = (f32x4){0.f, 0.f, 0.f, 0.f};
    cur = nxt; cB = nB; ++ui;
#pragma unroll
    for (int _h = 0; _h < 2; ++_h) { oc[_h][0] = on[_h][0]; oc[_h][1] = on[_h][1]; }
  }
  PG8_WAIT_V(0);
  if (wr == 0) PG8_BAR;
  PG8_BAR;
#undef PG8_SA
#undef PG8_SB
#undef PG8_STAGE
#undef PG8_STAGE_A
#undef PG8_OFFS
#undef PG8_LDA
#undef PG8_LDB
#undef PG8_MMA
#undef PG8_WAIT_V
#undef PG8_WAIT_L
#undef PG8_BAR
#undef PG8_SCHED
}

struct EpiBf16 {
  static constexpr bool PERM = true;
  bf16_t* O; int ldc;
  __device__ __forceinline__ void operator()(const f32x4 (&acc)[2][2][4][2], const Unit& u, int wr, int wc, int fr, int fq) const {
    const int row0 = u.pm * BM + wr * 64 + fr, col0 = u.pn * BM + wc * 32 + 8 * fq;
#pragma unroll
    for (int ai = 0; ai < 2; ++ai)
#pragma unroll
      for (int m = 0; m < 4; ++m) { bf16_t* rowp = O + (size_t)(row0 + ai * HALF + m * 16) * ldc + col0;
#pragma unroll
        for (int bj = 0; bj < 2; ++bj) { const f32x4 v0 = acc[ai][bj][m][0], v1 = acc[ai][bj][m][1];
          u32x4 w; w.x = cvt_pk_bf16(v0[0], v0[1]); w.y = cvt_pk_bf16(v0[2], v0[3]); w.z = cvt_pk_bf16(v1[0], v1[1]); w.w = cvt_pk_bf16(v1[2], v1[3]);
          *(u32x4*)(rowp + bj * HALF) = w; } }
  }
};
struct EpiInProj {
  static constexpr bool PERM = true;
  bf16_t* O; int ldc; int nz; float* DT;
  __device__ __forceinline__ void operator()(const f32x4 (&acc)[2][2][4][2], const Unit& u, int wr, int wc, int fr, int fq) const {
    const int row0 = u.pm * BM + wr * 64 + fr;
    if (u.pn < nz) {
      const int col0 = u.pn * BM + wc * 32 + 8 * fq;
#pragma unroll
      for (int ai = 0; ai < 2; ++ai)
#pragma unroll
        for (int m = 0; m < 4; ++m) { bf16_t* rowp = O + (size_t)(row0 + ai * HALF + m * 16) * ldc + col0;
#pragma unroll
          for (int bj = 0; bj < 2; ++bj) { const f32x4 v0 = acc[ai][bj][m][0], v1 = acc[ai][bj][m][1];
            u32x4 w; w.x = cvt_pk_bf16(v0[0], v0[1]); w.y = cvt_pk_bf16(v0[2], v0[3]); w.z = cvt_pk_bf16(v1[0], v1[1]); w.w = cvt_pk_bf16(v1[2], v1[3]);
            *(u32x4*)(rowp + bj * HALF) = w; } }
    } else if (wc == 0) {
#pragma unroll
      for (int ai = 0; ai < 2; ++ai)
#pragma unroll
        for (int m = 0; m < 4; ++m) { float* rowp = DT + (size_t)(row0 + ai * HALF + m * 16) * 32 + 8 * fq;
          *(f32x4*)rowp = acc[ai][0][m][0]; *(f32x4*)(rowp + 4) = acc[ai][0][m][1]; }
    }
  }
};
struct EpiResid {
  static constexpr bool PERM = false;
  const float* hlat; const float* hctx; float* tlat; float* tctx; const float* gate;
  __device__ __forceinline__ void operator()(const f32x4 (&acc)[2][2][4][2], const Unit& u, int wr, int wc, int fr, int fq) const {
    const int b = u.pm / 33, tt = u.pm % 33; const bool isctx = (tt == 0);
    const float* hs = isctx ? hctx + (size_t)b * CTXL * D : hlat + ((size_t)b * SEQ + (size_t)(tt - 1) * 256) * D;
    float* td = isctx ? tctx + (size_t)b * CTXL * D : tlat + ((size_t)b * SEQ + (size_t)(tt - 1) * 256) * D;
    const float* gt = gate + (size_t)(isctx ? 4 : b) * 6144;
    const int lrow0 = wr * 64 + fr, col0 = u.pn * BM + wc * 32 + 4 * fq;
#pragma unroll
    for (int bj = 0; bj < 2; ++bj)
#pragma unroll
      for (int n = 0; n < 2; ++n) { const f32x4 gvv = *(const f32x4*)(gt + col0 + bj * HALF + n * 16);
        f32x4 hv[2][4];
#pragma unroll
        for (int ai = 0; ai < 2; ++ai)
#pragma unroll
          for (int m = 0; m < 4; ++m) hv[ai][m] = *(const f32x4*)(hs + (size_t)(lrow0 + ai * HALF + m * 16) * D + col0 + bj * HALF + n * 16);
        asm volatile("" ::: "memory");
#pragma unroll
        for (int ai = 0; ai < 2; ++ai)
#pragma unroll
          for (int m = 0; m < 4; ++m) *(f32x4*)(td + (size_t)(lrow0 + ai * HALF + m * 16) * D + col0 + bj * HALF + n * 16) = hv[ai][m] * ALPHA + gvv * acc[ai][bj][m][n];
        asm volatile("" ::: "memory"); }
  }
};
struct EpiGateMul {
  static constexpr bool PERM = true;
  bf16_t* O; int ldc;
  __device__ __forceinline__ void operator()(const f32x4 (&acc)[2][2][4][2], const Unit& u, int wr, int wc, int fr, int fq) const {
    const int row0 = u.pm * BM + wr * 64 + fr, col0 = u.pn * BM + wc * 32 + 8 * fq;
#pragma unroll
    for (int ai = 0; ai < 2; ++ai) {
      u32x4 ov[4][2];
#pragma unroll
      for (int m = 0; m < 4; ++m)
#pragma unroll
        for (int bj = 0; bj < 2; ++bj) ov[m][bj] = *(const u32x4*)(O + (size_t)(row0 + ai * HALF + m * 16) * ldc + col0 + bj * HALF);
      asm volatile("" ::: "memory");
#pragma unroll
      for (int m = 0; m < 4; ++m) { bf16_t* rowp = O + (size_t)(row0 + ai * HALF + m * 16) * ldc + col0;
#pragma unroll
        for (int bj = 0; bj < 2; ++bj) { const f32x4 v0 = acc[ai][bj][m][0], v1 = acc[ai][bj][m][1]; const u32x4 o = ov[m][bj];
          u32x4 w;
          w.x = cvt_pk_bf16(bflo(o.x) * siluf_(v0[0]), bfhi(o.x) * siluf_(v0[1])); w.y = cvt_pk_bf16(bflo(o.y) * siluf_(v0[2]), bfhi(o.y) * siluf_(v0[3]));
          w.z = cvt_pk_bf16(bflo(o.z) * siluf_(v1[0]), bfhi(o.z) * siluf_(v1[1])); w.w = cvt_pk_bf16(bflo(o.w) * siluf_(v1[2]), bfhi(o.w) * siluf_(v1[3]));
          *(u32x4*)(rowp + bj * HALF) = w; } }
      asm volatile("" ::: "memory");
    }
  }
};
struct EpiSwiGLU {
  static constexpr bool PERM = true;
  bf16_t* H;
  __device__ __forceinline__ void operator()(const f32x4 (&acc)[2][2][4][2], const Unit& u, int wr, int wc, int fr, int fq) const {
    const int row0 = u.pm * BM + wr * 64 + fr, col0 = (u.pn & 3) * 128 + wc * 32 + 8 * fq;
#pragma unroll
    for (int ai = 0; ai < 2; ++ai)
#pragma unroll
      for (int m = 0; m < 4; ++m) { bf16_t* rowp = H + (size_t)(row0 + ai * HALF + m * 16) * DEXP + col0;
        const f32x4 g0 = acc[ai][0][m][0], g1 = acc[ai][0][m][1], u0 = acc[ai][1][m][0], u1 = acc[ai][1][m][1];
        u32x4 w; w.x = cvt_pk_bf16(siluf_(g0[0]) * u0[0], siluf_(g0[1]) * u0[1]); w.y = cvt_pk_bf16(siluf_(g0[2]) * u0[2], siluf_(g0[3]) * u0[3]);
        w.z = cvt_pk_bf16(siluf_(g1[0]) * u1[0], siluf_(g1[1]) * u1[1]); w.w = cvt_pk_bf16(siluf_(g1[2]) * u1[2], siluf_(g1[3]) * u1[3]);
        *(u32x4*)rowp = w; }
  }
};
struct EpiMoeDown {
  static constexpr bool PERM = true;
  bf16_t* Y;
  __device__ __forceinline__ void operator()(const f32x4 (&acc)[2][2][4][2], const Unit& u, int wr, int wc, int fr, int fq) const {
    const int row0 = u.pm * BM + wr * 64 + fr, col0 = (u.pn & 3) * BM + wc * 32 + 8 * fq;
#pragma unroll
    for (int ai = 0; ai < 2; ++ai)
#pragma unroll
      for (int m = 0; m < 4; ++m) { bf16_t* rowp = Y + (size_t)(row0 + ai * HALF + m * 16) * D + col0;
#pragma unroll
        for (int bj = 0; bj < 2; ++bj) { const f32x4 v0 = acc[ai][bj][m][0], v1 = acc[ai][bj][m][1];
          u32x4 w; w.x = cvt_pk_bf16(v0[0], v0[1]); w.y = cvt_pk_bf16(v0[2], v0[3]); w.z = cvt_pk_bf16(v1[0], v1[1]); w.w = cvt_pk_bf16(v1[2], v1[3]);
          *(u32x4*)(rowp + bj * HALF) = w; } }
  }
};
}

struct Ctx {
  LAS unsigned char* lds; int tid, lane, wave, gw, ngw, bid, nblk;
};
#define GAS __attribute__((address_space(1)))
#define WS(off, T) ((T*)(GAS T*)(P.ws + (off)))
#define GIN(i) ((const float*)(const GAS float*)P.in[i])
#define GOUT ((float*)(GAS float*)P.out)

__device__ __forceinline__ void transpose_item(const float* W, int ldw, int col0, int k0, bf16_t* dst_row0, int ldd, LAS float* scr, int lane) {
  { f32x4 v[8];
#pragma unroll
    for (int i = 0; i < 8; ++i) v[i] = *(const f32x4*)(W + (size_t)(k0 + 8 * i + (lane >> 3)) * ldw + col0 + 4 * (lane & 7));
#pragma unroll
    for (int i = 0; i < 8; ++i) { LAS float* d = scr + (8 * i + (lane >> 3)) * 33 + 4 * (lane & 7); d[0] = v[i][0]; d[1] = v[i][1]; d[2] = v[i][2]; d[3] = v[i][3]; } }
  asm volatile("s_waitcnt lgkmcnt(0)" ::: "memory");
  const int c = lane & 7;
#pragma unroll
  for (int j = 0; j < 4; ++j) { const int n = (lane >> 3) + 8 * j; const LAS float* s = scr + (8 * c) * 33 + n;
    u32x4 o; o.x = pk2(s[0 * 33], s[1 * 33]); o.y = pk2(s[2 * 33], s[3 * 33]); o.z = pk2(s[4 * 33], s[5 * 33]); o.w = pk2(s[6 * 33], s[7 * 33]);
    *(u32x4*)(dst_row0 + (size_t)n * ldd + k0 + 8 * c) = o; }
  asm volatile("s_waitcnt lgkmcnt(0)" ::: "memory");
}
__device__ __forceinline__ void transpose_mat_item(const float* W, int ldw, int col0, int K, int ncols, bf16_t* dst, int ldd, int gu, int it, LAS float* scr, int lane) {
  const int nblk = ncols / 32, kb = it / nblk, nb = it % nblk, n0 = 32 * nb;
  const int drow = gu ? (256 * (n0 >> 7) + (n0 & 127) + (gu == 2 ? 128 : 0)) : n0;
  transpose_item(W, ldw, col0 + n0, 64 * kb, dst + (size_t)drow * ldd, ldd, scr, lane);
}
__device__ __forceinline__ void convert_experts(const Params& P, int layer, bf16_t* wgu, bf16_t* wd, const Ctx& C, LAS float* scr) {
  for (int it = C.gw; it < NEXP * 768; it += C.ngw) {
    const int e = it / 768, r = it % 768;
    const size_t eoff = ((size_t)layer * NEXP + e) * (size_t)D * DEXP;
    if (r < 256) transpose_mat_item(GIN(I_EWG) + eoff, DEXP, 0, D, DEXP, wgu + (size_t)e * 1024 * D, D, 1, r, scr, C.lane);
    else if (r < 512) transpose_mat_item(GIN(I_EWU) + eoff, DEXP, 0, D, DEXP, wgu + (size_t)e * 1024 * D, D, 2, r - 256, scr, C.lane);
    else transpose_mat_item(GIN(I_EWD) + eoff, D, 0, DEXP, D, wd + (size_t)e * D * DEXP, DEXP, 0, r - 512, scr, C.lane);
  }
}

__device__ __forceinline__ void row_load(const float* row, int lane, f32x4 (&v)[4]) {
#pragma unroll
  for (int j = 0; j < 4; ++j) v[j] = *(const f32x4*)(row + 4 * lane + 256 * j);
}
__device__ __forceinline__ void row_store(float* row, int lane, const f32x4 (&v)[4]) {
#pragma unroll
  for (int j = 0; j < 4; ++j) *(f32x4*)(row + 4 * lane + 256 * j) = v[j];
}
__device__ __forceinline__ void row_store_bf16(bf16_t* row, int lane, const f32x4 (&v)[4]) {
#pragma unroll
  for (int j = 0; j < 4; ++j) { u32x2 w; w.x = pk2(v[j][0], v[j][1]); w.y = pk2(v[j][2], v[j][3]); *(u32x2*)(row + 4 * lane + 256 * j) = w; }
}
__device__ __forceinline__ void row_layernorm(f32x4 (&v)[4], const float* g, const float* b, int lane) {
  float s = 0.f;
#pragma unroll
  for (int j = 0; j < 4; ++j) s += (v[j][0] + v[j][1]) + (v[j][2] + v[j][3]);
  const float mean = wave_sum(s) * (1.f / D); float s2 = 0.f;
#pragma unroll
  for (int j = 0; j < 4; ++j) { v[j] = v[j] - mean; s2 += (v[j][0] * v[j][0] + v[j][1] * v[j][1]) + (v[j][2] * v[j][2] + v[j][3] * v[j][3]); }
  const float rstd = rsqrtf(wave_sum(s2) * (1.f / D) + LN_EPS);
#pragma unroll
  for (int j = 0; j < 4; ++j) { const f32x4 gg = *(const f32x4*)(g + 4 * lane + 256 * j), bb = *(const f32x4*)(b + 4 * lane + 256 * j); v[j] = v[j] * rstd * gg + bb; }
}
__device__ __forceinline__ void row_modulate(const f32x4 (&h)[4], const float* shift, const float* scale, int lane, f32x4 (&u)[4]) {
#pragma unroll
  for (int j = 0; j < 4; ++j) { const f32x4 sh = *(const f32x4*)(shift + 4 * lane + 256 * j), sc = *(const f32x4*)(scale + 4 * lane + 256 * j); u[j] = h[j] * (sc + 1.f) + sh; }
}
__device__ __forceinline__ void row_dot32(const f32x4 (&u)[4], const LAS float* Wt, int lane, float* out32) {
  float myv = 0.f;
#pragma unroll 4
  for (int c = 0; c < 32; ++c) {
    float s = 0.f;
#pragma unroll
    for (int j = 0; j < 4; ++j) { const f32x4 w = *(const LAS f32x4*)(Wt + c * 1024 + 4 * lane + 256 * j); s += (u[j][0] * w[0] + u[j][1] * w[1]) + (u[j][2] * w[2] + u[j][3] * w[3]); }
    s = wave_sum(s);
    if (lane == c) myv = s;
  }
  if (lane < 32) out32[lane] = myv;
}
__device__ __forceinline__ void stage_cols32(const float* W, int ldw, int col0, LAS float* Wt, int tid) {
  for (int i = tid; i < 1024 * 32; i += NT) { const int k = i >> 5, c = i & 31; Wt[c * 1024 + k] = W[(size_t)k * ldw + col0 + c]; }
}
__device__ __forceinline__ const float* lat_or_ctx(const float* lat, const float* ctxp, int r) {
  const int b = r / TB, pos = r % TB;
  return pos < CTXL ? ctxp + ((size_t)b * CTXL + pos) * D : lat + ((size_t)b * SEQ + (pos - CTXL)) * D;
}
__device__ __forceinline__ float* lat_or_ctx_w(float* lat, float* ctxp, int r) {
  const int b = r / TB, pos = r % TB;
  return pos < CTXL ? ctxp + ((size_t)b * CTXL + pos) * D : lat + ((size_t)b * SEQ + (pos - CTXL)) * D;
}
__device__ __forceinline__ int row_b5(int r) { const int b = r / TB, pos = r % TB; return pos < CTXL ? 4 : b; }

__device__ __forceinline__ void phase0(const Params& P, const Ctx& C) {
  LAS float* sv = (LAS float*)C.lds;
  LAS float* part = (LAS float*)(C.lds + 20480);
  LAS float* scr = (LAS float*)(C.lds + 32768) + C.wave * (64 * 33);
  for (int i = C.tid; i < 5 * 1024; i += NT) { const float x = i < 4096 ? GIN(I_C)[i] : GIN(I_CCTX)[i - 4096]; sv[i] = siluf_(x); }
  __syncthreads();
  float* MOD = WS(OFF_MOD, float);
  for (int task = C.bid; task < 2 * 96; task += C.nblk) {
    const int l = task / 96, n0 = (task % 96) * 64;
    const float* W = GIN(I_ADAW) + (size_t)l * D * 6144 + n0 + C.lane;
    float acc[5] = {0.f, 0.f, 0.f, 0.f, 0.f};
    const int kbeg = C.wave * 128;
#pragma unroll 8
    for (int k = kbeg; k < kbeg + 128; ++k) { const float w = W[(size_t)k * 6144];
#pragma unroll
      for (int r = 0; r < 5; ++r) acc[r] += sv[r * 1024 + k] * w; }
#pragma unroll
    for (int r = 0; r < 5; ++r) part[(C.wave * 5 + r) * 64 + C.lane] = acc[r];
    __syncthreads();
    if (C.tid < 320) { const int r = C.tid / 64, c = C.tid % 64; float s = GIN(I_ADAB)[l * 6144 + n0 + c];
#pragma unroll
      for (int w = 0; w < 8; ++w) s += part[(w * 5 + r) * 64 + c];
      MOD[((size_t)l * 5 + r) * 6144 + n0 + c] = s; }
    __syncthreads();
  }
  if (C.bid == C.nblk - 1) { float* LB = WS(OFF_LB1, float); for (int i = C.tid; i < 1024; i += NT) { const float a = GIN(I_HLB)[i], b = GIN(I_HLB)[1024 + i]; LB[i] = 1.f / (1.f + __expf(a - b)); } }
  constexpr int N_AB = 16 * 144, N_OUT = 32 * 32, N_G1 = 16 * 32;
  constexpr int TOT = N_AB + 2 * N_OUT + 2 * N_G1;
  for (int it = C.gw; it < TOT; it += C.ngw) {
    int r = it;
    if (r < N_AB) { transpose_mat_item(GIN(I_ABW), AB_IN, 0, D, Z0W, WS(OFF_WAB, bf16_t), D, 0, r, scr, C.lane); continue; } r -= N_AB;
    if (r < N_OUT) { transpose_mat_item(GIN(I_OUTW), D, 0, 2048, D, WS(OFF_WOUT0, bf16_t), 2048, 0, r, scr, C.lane); continue; } r -= N_OUT;
    if (r < N_OUT) { transpose_mat_item(GIN(I_OUTW) + (size_t)2048 * D, D, 0, 2048, D, WS(OFF_WOUT1, bf16_t), 2048, 0, r, scr, C.lane); continue; } r -= N_OUT;
    if (r < N_G1) { transpose_mat_item(GIN(I_CDW), CD_IN, 3072, D, 1024, WS(OFF_WG1, bf16_t), D, 0, r, scr, C.lane); continue; } r -= N_G1;
    transpose_mat_item(GIN(I_CDW), CD_IN, 8224, D, 1024, WS(OFF_WG1, bf16_t) + (size_t)1024 * D, D, 0, r, scr, C.lane);
  }
  for (int it = C.gw; it < 16; it += C.ngw) transpose_mat_item(GIN(I_ABW), AB_IN, 4608, D, 32, WS(OFF_WAB, bf16_t) + (size_t)4608 * D, D, 0, it, scr, C.lane);
  { u32x4* z = (u32x4*)(WS(OFF_WAB, bf16_t) + (size_t)4640 * D); const u32x4 zz = {0u, 0u, 0u, 0u};
    for (int i = C.bid * NT + C.tid; i < 224 * D * 2 / 16; i += C.nblk * NT) z[i] = zz; }
  convert_experts(P, 0, WS(OFF_WE0, bf16_t), WS(OFF_WE0 + 64 * MiB, bf16_t), C, scr);
}

__device__ __forceinline__ void phase_u0(const Params& P, const Ctx& C) {
  const float* MOD = WS(OFF_MOD, float); bf16_t* U = WS(OFF_U0, bf16_t);
  f32x4 h[4], hn[4];
  if (C.gw < R) row_load(lat_or_ctx(GIN(I_X), GIN(I_CTX), C.gw), C.lane, h);
  for (int r = C.gw; r < R; r += C.ngw) {
    if (r + C.ngw < R) row_load(lat_or_ctx(GIN(I_X), GIN(I_CTX), r + C.ngw), C.lane, hn);
    f32x4 u[4];
    const float* m = MOD + (size_t)row_b5(r) * 6144;
    row_modulate(h, m, m + D, C.lane, u);
    row_store_bf16(U + (size_t)r * D, C.lane, u);
#pragma unroll
    for (int j = 0; j < 4; ++j) h[j] = hn[j];
  }
}

__device__ __forceinline__ void phase_inproj(const Params& P, const Ctx& C, const bf16_t* U, const bf16_t* W, bf16_t* Z, int zw) {
  pg8::Gemm g{U, W, D, D}; pg8::GridOrder S; S.init(R / 256, zw / 256 + 1, C.nblk, C.bid, 0);
  pg8::EpiInProj E{Z, zw, zw / 256, WS(OFF_DT, float)};
  pg8::gemm_phase(C.lds, g, S, E);
}

__device__ __forceinline__ void conv_task(bf16_t* Z, int zw, int row0, int L, int col, const float* cw, int cwld, int cch, const float* cb, int mode, float qscale, int lane, int ident = 0) {
  float w[4][2];
#pragma unroll
  for (int j = 0; j < 4; ++j) { w[j][0] = cw[j * cwld + cch + 2 * lane]; w[j][1] = cw[j * cwld + cch + 2 * lane + 1]; }
  const float b0 = cb ? cb[cch + 2 * lane] : 0.f, b1 = cb ? cb[cch + 2 * lane + 1] : 0.f;
  unsigned* base = (unsigned*)(Z + (size_t)row0 * zw + col) + lane;
  const size_t rs = (size_t)zw / 2;
  float pm2[2] = {0.f, 0.f}, pm1[2] = {0.f, 0.f};
  for (int t0 = 0; t0 < L; t0 += 32) {
    unsigned v[33];
#pragma unroll
    for (int i = 0; i < 32; ++i) v[i] = base[(size_t)(t0 + i) * rs];
    v[32] = (t0 + 32 < L) ? base[(size_t)(t0 + 32) * rs] : 0u;
    unsigned o[32];
#pragma unroll
    for (int i = 0; i < 32; ++i) {
      const float x0 = bflo(v[i]), x1 = bfhi(v[i]), n0 = bflo(v[i + 1]), n1 = bfhi(v[i + 1]);
      float y0 = w[0][0] * pm2[0] + w[1][0] * pm1[0] + w[2][0] * x0 + w[3][0] * n0 + b0;
      float y1 = w[0][1] * pm2[1] + w[1][1] * pm1[1] + w[2][1] * x1 + w[3][1] * n1 + b1;
      pm2[0] = pm1[0]; pm2[1] = pm1[1]; pm1[0] = x0; pm1[1] = x1;
      if (mode >= 1) { y0 = siluf_(y0); y1 = siluf_(y1); }
      if (mode == 2) { const float ss = wave_sum(y0 * y0 + y1 * y1); const float sc = rsqrtf(ss + RMS_EPS) * qscale; y0 *= sc; y1 *= sc; }
      o[i] = ident ? v[i] : pk2(y0, y1);
    }
#pragma unroll
    for (int i = 0; i < 32; ++i) base[(size_t)(t0 + i) * rs] = o[i];
  }
}
__device__ __forceinline__ void seg_rows(int seg, int& row0, int& L) {
  const int b = seg / 129, s = seg % 129;
  if (s == 0) { row0 = b * TB; L = CTXL; } else { row0 = b * TB + CTXL + (s - 1) * 64; L = 64; }
}
__device__ __forceinline__ void phase_feat0(const Params& P, const Ctx& C, int ident) {
  bf16_t* Z = WS(OFF_Z0, bf16_t);
  for (int task = C.gw; task < NB * 129 * 20; task += C.ngw) {
    const int seg = task / 20, cg = task % 20; int row0, L; seg_rows(seg, row0, L);
    if (cg < 8) conv_task(Z, Z0W, row0, L, Z0_RGX + cg * 128, GIN(I_RGCW), 1024, cg * 128, GIN(I_RGCB), 0, 1.f, C.lane, ident);
    else conv_task(Z, Z0W, row0, L, Z0_XBC + (cg - 8) * 128, GIN(I_SCW), 1536, (cg - 8) * 128, GIN(I_SCB), 1, 1.f, C.lane, ident);
  }
}
__device__ __forceinline__ void phase_feat1(const Params& P, const Ctx& C, int ident) {
  bf16_t* Z = WS(OFF_Z1, bf16_t);
  for (int task = C.gw; task < NB * 129 * 24; task += C.ngw) {
    const int seg = task / 24, cg = task % 24; int row0, L; seg_rows(seg, row0, L);
    if (cg < 16) conv_task(Z, Z1W, row0, L, cg * 128, GIN(I_GCW), 3072, cg * 128, nullptr, 2, cg < 8 ? 0.08838834764831845f : 1.f, C.lane, ident);
    else conv_task(Z, Z1W, row0, L, cg * 128, GIN(I_GCW), 3072, cg * 128, nullptr, 1, 1.f, C.lane, ident);
  }
}

__device__ __forceinline__ int seq_pos(int dir, int j) { return dir == 0 ? j : (j < CTXL ? CTXL - 1 - j : TB - 1 - (j - CTXL)); }
__device__ __forceinline__ int seq_chunk(int dir, int j) { return dir == 0 ? j : (j < 4 ? 3 - j : 135 - j); }

__device__ __forceinline__ void rg_task(const Params& P, const Ctx& C, int task) {
  const int b = task >> 6, h = (task >> 3) & 7, q = task & 7;
  LAS float* Wl = (LAS float*)C.lds;
  LAS float* xc = Wl + 2 * 2 * 128 * 16;
  LAS float* SA = xc + 64 * 129;
  LAS float* SU = SA + 16 * 64;
  const bf16_t* Z = WS(OFF_Z0, bf16_t); bf16_t* MIX = WS(OFF_MIX0, bf16_t);
  __syncthreads();
  for (int i = C.tid; i < 2 * 2 * 128 * 16; i += NT) { const int j = i & 15, ii = (i >> 4) & 127, gate = (i >> 11) & 1, d = i >> 12;
    const float* W = (gate ? GIN(I_RGXW) : GIN(I_RGAW)) + ((size_t)(d * 8 + h) * 128 + ii) * 128 + q * 16 + j; Wl[i] = *W; }
  const int j = C.tid & 15, tg = C.tid >> 4;
  const int ch = h * 128 + q * 16 + j;
  const int sch = C.wave * 2;
  for (int d = 0; d < 2; ++d) {
    const float ba = GIN(I_RGAB)[d * 1024 + ch], bx = GIN(I_RGXB)[d * 1024 + ch], spl = softplusf_(-GIN(I_RGLAM)[d * 1024 + ch]);
    float hin0 = 0.f, hin1 = 0.f;
    for (int cs = 0; cs < 132; ++cs) {
      const int chunk = seq_chunk(d, cs), row0 = b * TB + chunk * 64;
      __syncthreads();
      { const int t = C.tid >> 3, sg = C.tid & 7; const u32x4* src = (const u32x4*)(Z + (size_t)(row0 + t) * Z0W + Z0_RGX + h * 128 + sg * 16);
        const u32x4 a = src[0], bb = src[1]; LAS float* dst = xc + t * 129 + sg * 16;
        dst[0] = bflo(a.x); dst[1] = bfhi(a.x); dst[2] = bflo(a.y); dst[3] = bfhi(a.y); dst[4] = bflo(a.z); dst[5] = bfhi(a.z); dst[6] = bflo(a.w); dst[7] = bfhi(a.w);
        dst[8] = bflo(bb.x); dst[9] = bfhi(bb.x); dst[10] = bflo(bb.y); dst[11] = bfhi(bb.y); dst[12] = bflo(bb.z); dst[13] = bfhi(bb.z); dst[14] = bflo(bb.w); dst[15] = bfhi(bb.w); }
      __syncthreads();
      { const LAS float* Wa = Wl + (d * 2 + 0) * 2048 + j; const LAS float* Wx = Wl + (d * 2 + 1) * 2048 + j;
        const LAS float* x0 = xc + (2 * tg) * 129; const LAS float* x1 = x0 + 129;
        float aa0 = 0.f, aa1 = 0.f, ax0 = 0.f, ax1 = 0.f;
#pragma unroll 8
        for (int i = 0; i < 128; ++i) { const float wa = Wa[i * 16], wx = Wx[i * 16], v0 = x0[i], v1 = x1[i]; aa0 += v0 * wa; aa1 += v1 * wa; ax0 += v0 * wx; ax1 += v1 * wx; }
#pragma unroll
        for (int tt = 0; tt < 2; ++tt) { const int t = 2 * tg + tt; const float pa = tt ? aa1 : aa0, px = tt ? ax1 : ax0;
          const float r = sigmoidf_(pa + ba), ig = sigmoidf_(px + bx); const float la = -8.f * r * spl; const float xv = xc[t * 129 + q * 16 + j];
          SA[j * 64 + t] = __expf(la); SU[j * 64 + t] = sqrtf(-expm1f(2.f * la)) * (ig * xv); } }
      __syncthreads();
#pragma unroll
      for (int cc = 0; cc < 2; ++cc) {
        const int lc = sch + cc; const int t = d == 0 ? C.lane : 63 - C.lane;
        float A = SA[lc * 64 + t], Bv = SU[lc * 64 + t];
#pragma unroll
        for (int off = 1; off < 64; off <<= 1) { const float Ap = __shfl_up(A, off), Bp = __shfl_up(Bv, off); if (C.lane >= off) { Bv = A * Bp + Bv; A = A * Ap; } }
        const float hin = cc ? hin1 : hin0; const float hv = Bv + A * hin;
        const float hlast = __shfl(hv, 63); if (cc) hin1 = hlast; else hin0 = hlast;
        const int gch = h * 128 + q * 16 + lc; bf16_t* o = MIX + (size_t)(row0 + t) * MIXW + gch;
        if (d == 0) *o = (bf16_t)f2bf(hv);
        else { const float hf = bf2f(*o); const float gy = bf2f(Z[(size_t)(row0 + t) * Z0W + Z0_RGY + gch]); *o = (bf16_t)f2bf((hf + hv) * geluf_(gy)); }
      }
    }
    __threadfence_block();
  }
}
__device__ __forceinline__ void ssd_task(const Params& P, const Ctx& C, int task) {
  const int b = task >> 9, hd = (task >> 5) & 15, ps = task & 31, g = hd >> 3;
  const int c = C.lane >> 5, ng = C.lane & 31;
  const bf16_t* Z = WS(OFF_Z0, bf16_t); bf16_t* MIX = WS(OFF_MIX0, bf16_t); const float* DT = WS(OFF_DT, float);
  const int colx = Z0_XBC + hd * 64 + 2 * ps + c, colB = Z0_B + g * 128 + 4 * ng, colC = Z0_C + g * 128 + 4 * ng, outc = 1024 + hd * 64 + 2 * ps + c;
  for (int d = 0; d < 2; ++d) {
    const float Aneg = -__expf(GIN(I_SALOG)[d * 16 + hd]), dtb = GIN(I_SDTB)[d * 16 + hd];
    float S0 = 0.f, S1 = 0.f, S2 = 0.f, S3 = 0.f;
    for (int j0 = 0; j0 < TB; j0 += 8) {
      u32x2 Bv[8], Cv[8]; unsigned short xv[8], yp[8]; float dtr[8];
#pragma unroll
      for (int u = 0; u < 8; ++u) { const size_t row = (size_t)b * TB + seq_pos(d, j0 + u);
        Bv[u] = *(const u32x2*)(Z + row * Z0W + colB); Cv[u] = *(const u32x2*)(Z + row * Z0W + colC); xv[u] = Z[row * Z0W + colx]; dtr[u] = DT[row * 32 + d * 16 + hd];
        yp[u] = d ? MIX[row * MIXW + outc] : (unsigned short)0; }
#pragma unroll
      for (int u = 0; u < 8; ++u) { const size_t row = (size_t)b * TB + seq_pos(d, j0 + u);
        const float dt = softplusf_(dtr[u] + dtb), a = __expf(Aneg * dt), xdt = bf2f(xv[u]) * dt;
        S0 = a * S0 + bflo(Bv[u].x) * xdt; S1 = a * S1 + bfhi(Bv[u].x) * xdt; S2 = a * S2 + bflo(Bv[u].y) * xdt; S3 = a * S3 + bfhi(Bv[u].y) * xdt;
        float y = (bflo(Cv[u].x) * S0 + bfhi(Cv[u].x) * S1) + (bflo(Cv[u].y) * S2 + bfhi(Cv[u].y) * S3);
        y = half_sum32(y);
        if (ng == 0) MIX[row * MIXW + outc] = (bf16_t)f2bf(y + bf2f(yp[u])); }
    }
    __threadfence_block();
  }
}

#define LBAR() do { asm volatile("s_waitcnt lgkmcnt(0)" ::: "memory"); __builtin_amdgcn_s_barrier(); asm volatile("" ::: "memory"); } while (0)
#define VMWAIT() asm volatile("s_waitcnt vmcnt(0)" ::: "memory")
typedef short s16x4 __attribute__((ext_vector_type(4)));
__device__ __forceinline__ bf16x8 frag_row(const LAS bf16_t* base, int ld, int r0, int k0, int lane) {
  return *(const LAS bf16x8*)(base + (r0 + (lane & 15)) * ld + k0 + 8 * (lane >> 4));
}
__device__ __forceinline__ bf16x8 frag_tr(const LAS bf16_t* base, int ld, int k0, int n0, int lane) {
  const int g = lane >> 4, q = (lane & 15) >> 2, p = lane & 3;
  const LAS bf16_t* a0 = base + (k0 + 8 * g + q) * ld + n0 + 4 * p;
  const s16x4 v0 = __builtin_amdgcn_ds_read_tr16_b64_v4i16((LAS s16x4*)a0);
  const s16x4 v1 = __builtin_amdgcn_ds_read_tr16_b64_v4i16((LAS s16x4*)(a0 + 4 * ld));
  bf16x8 r; r[0] = v0[0]; r[1] = v0[1]; r[2] = v0[2]; r[3] = v0[3]; r[4] = v1[0]; r[5] = v1[1]; r[6] = v1[2]; r[7] = v1[3];
  return r;
}
__device__ __forceinline__ f32x4 mma16(bf16x8 fa, bf16x8 fb, f32x4 acc) { return __builtin_amdgcn_mfma_f32_16x16x32_bf16(fa, fb, acc, 0, 0, 0); }
__device__ __forceinline__ float wave_incl_scan(float v, int lane) {
#pragma unroll
  for (int off = 1; off < 64; off <<= 1) { const float p = __shfl_up(v, off); if (lane >= off) v += p; }
  return v;
}
__device__ __forceinline__ void tri_tile(int tt, int& I, int& J) { I = tt >= 6 ? 3 : (tt >= 3 ? 2 : (tt >= 1 ? 1 : 0)); J = tt - (I * (I + 1)) / 2; }
__device__ __forceinline__ unsigned long long ld_agent_u64(const void* p) { return __hip_atomic_load((const unsigned long long*)p, __ATOMIC_RELAXED, __HIP_MEMORY_SCOPE_AGENT); }
__device__ __forceinline__ bool fwd_first(int c) { return c < 4 ? (c <= 1) : (c <= 67); }

__device__ __forceinline__ void ssd_chain_wg(const Params& P, const Ctx& C, int task) {
  const int b = task >> 5, hd = (task >> 1) & 15, ps = task & 1, g = hd >> 3;
  const int d = C.wave >> 2, w = C.wave & 3, td = C.tid & 255, lane = C.lane, fr = lane & 15, fq = lane >> 4;
  constexpr int LDN = 136, LDP = 40, LDT = 72;
  constexpr int DIRSZ = 78 * 1024;
  LAS unsigned char* L = C.lds + d * DIRSZ;
  LAS bf16_t* Cs = (LAS bf16_t*)L;
  LAS bf16_t* Bs = Cs + 64 * LDN;
  LAS bf16_t* Xd = Bs + 64 * LDN;
  LAS bf16_t* Xw = Xd + 64 * LDP;
  LAS bf16_t* Pt = Xw + 64 * LDP;
  LAS bf16_t* St = Pt + 64 * LDT;
  LAS float* dtL = (LAS float*)(St + 2 * 32 * LDN);
  const bf16_t* Z = WS(OFF_Z0, bf16_t); bf16_t* MIX = WS(OFF_MIX0, bf16_t); const float* DT = WS(OFF_DT, float);
  const float Aneg = -__expf(GIN(I_SALOG)[d * 16 + hd]), dtb = GIN(I_SDTB)[d * 16 + hd];
  const int colC = Z0_C + g * 128, colB = Z0_B + g * 128, colX = Z0_XBC + hd * 64 + ps * 32, outc = 1024 + hd * 64 + ps * 32;
  __syncthreads();
  for (int i = td; i < 64 * LDT / 2; i += 256) ((LAS unsigned*)Pt)[i] = 0u;
  for (int i = td; i < 2 * 32 * LDN / 2; i += 256) ((LAS unsigned*)St)[i] = 0u;
  f32x4 Sacc[2][2];
#pragma unroll
  for (int a = 0; a < 2; ++a)
#pragma unroll
    for (int c = 0; c < 2; ++c) Sacc[a][c] = (f32x4){0.f, 0.f, 0.f, 0.f};
  const int st_t = td >> 2, st_q = td & 3;
  u32x4 rc[4], rb[4], rx; float rdt = 0.f;
  auto issue_loads = [&](int step) {
    const int chunk = seq_chunk(d, step); const size_t row = (size_t)b * TB + chunk * 64 + st_t;
    const u32x4* pc = (const u32x4*)(Z + row * Z0W + colC + st_q * 32); const u32x4* pb = (const u32x4*)(Z + row * Z0W + colB + st_q * 32);
#pragma unroll
    for (int i = 0; i < 4; ++i) { rc[i] = pc[i]; rb[i] = pb[i]; }
    rx = *(const u32x4*)(Z + row * Z0W + colX + st_q * 8);
    rdt = DT[row * 32 + d * 16 + hd];
  };
  issue_loads(0);
  for (int step = 0; step < 132; ++step) {
    const int chunk = seq_chunk(d, step); const int row0 = b * TB + chunk * 64;
    VMWAIT();
    { const int i = d ? 63 - st_t : st_t; const float dt = softplusf_(rdt + dtb);
      LAS u32x4* dc = (LAS u32x4*)(Cs + i * LDN + st_q * 32); LAS u32x4* db = (LAS u32x4*)(Bs + i * LDN + st_q * 32);
#pragma unroll
      for (int k = 0; k < 4; ++k) { dc[k] = rc[k]; db[k] = rb[k]; }
      u32x4 xo; xo.x = pk2(bflo(rx.x) * dt, bfhi(rx.x) * dt); xo.y = pk2(bflo(rx.y) * dt, bfhi(rx.y) * dt); xo.z = pk2(bflo(rx.z) * dt, bfhi(rx.z) * dt); xo.w = pk2(bflo(rx.w) * dt, bfhi(rx.w) * dt);
      *(LAS u32x4*)(Xd + i * LDP + st_q * 8) = xo;
      if (st_q == 0) dtL[i] = dt; }
    LBAR();
    if (step + 1 < 132) issue_loads(step + 1);
    const bool first = (d == 0) == fwd_first(chunk);
    bf16_t* op0; unsigned long long ppv[2] = {0ull, 0ull};
    { const int ii = 16 * w + fr; const int t = d ? 63 - ii : ii; op0 = MIX + (size_t)(row0 + t) * MIXW + outc + 4 * fq;
      if (!first) { ppv[0] = ld_agent_u64(op0); ppv[1] = ld_agent_u64(op0 + 16); } }
    const float cum = wave_incl_scan(Aneg * dtL[lane], lane);
    const float cum_last = __shfl(cum, 63);
    { const int i = td >> 2; const float sc = __expf(cum_last - __shfl(cum, i & 63));
      const u32x4 v = *(const LAS u32x4*)(Xd + i * LDP + (td & 3) * 8);
      u32x4 o; o.x = pk2(bflo(v.x) * sc, bfhi(v.x) * sc); o.y = pk2(bflo(v.y) * sc, bfhi(v.y) * sc); o.z = pk2(bflo(v.z) * sc, bfhi(v.z) * sc); o.w = pk2(bflo(v.w) * sc, bfhi(v.w) * sc);
      *(LAS u32x4*)(Xw + i * LDP + (td & 3) * 8) = o; }
    for (int tt = w; tt < 10; tt += 4) {
      int I, J; tri_tile(tt, I, J);
      f32x4 acc = (f32x4){0.f, 0.f, 0.f, 0.f};
#pragma unroll
      for (int k = 0; k < 4; ++k) acc = mma16(frag_row(Cs, LDN, 16 * I, 32 * k, lane), frag_row(Bs, LDN, 16 * J, 32 * k, lane), acc);
      const int jj = 16 * J + fr; const float cj = __shfl(cum, jj);
      u32x2 o; float pv[4];
#pragma unroll
      for (int r = 0; r < 4; ++r) { const int ii = 16 * I + 4 * fq + r; const float ci = __shfl(cum, ii); pv[r] = (jj <= ii) ? acc[r] * __expf(ci - cj) : 0.f; }
      o.x = pk2(pv[0], pv[1]); o.y = pk2(pv[2], pv[3]);
      *(LAS u32x2*)(Pt + jj * LDT + 16 * I + 4 * fq) = o;
    }
    LBAR();
    const LAS bf16_t* Sr = St + (step & 1) * 32 * LDN; LAS bf16_t* Sw = St + ((step + 1) & 1) * 32 * LDN;
    { const int I = w; const int nks = I < 2 ? 1 : 2;
      const int ii = 16 * I + fr; const float eci = __expf(__shfl(cum, ii));
#pragma unroll
      for (int pt = 0; pt < 2; ++pt) {
        f32x4 y1 = (f32x4){0.f, 0.f, 0.f, 0.f}, y2 = (f32x4){0.f, 0.f, 0.f, 0.f};
        for (int k = 0; k < nks; ++k) y1 = mma16(frag_tr(Xd, LDP, 32 * k, 16 * pt, lane), frag_tr(Pt, LDT, 32 * k, 16 * I, lane), y1);
#pragma unroll
        for (int k = 0; k < 4; ++k) y2 = mma16(frag_row(Sr, LDN, 16 * pt, 32 * k, lane), frag_row(Cs, LDN, 16 * I, 32 * k, lane), y2);
        bf16_t* op = op0 + 16 * pt;
        float o0 = y1[0] + eci * y2[0], o1 = y1[1] + eci * y2[1], o2 = y1[2] + eci * y2[2], o3 = y1[3] + eci * y2[3];
        if (!first) { const unsigned long long pv = ppv[pt]; const unsigned lo = (unsigned)pv, hi = (unsigned)(pv >> 32); o0 += bflo(lo); o1 += bfhi(lo); o2 += bflo(hi); o3 += bfhi(hi); }
        u32x2 o; o.x = pk2(o0, o1); o.y = pk2(o2, o3); *(u32x2*)op = o;
      } }
    { const float el = __expf(cum_last);
#pragma unroll
      for (int a = 0; a < 2; ++a)
#pragma unroll
        for (int c = 0; c < 2; ++c) { f32x4 acc = Sacc[a][c] * el;
#pragma unroll
          for (int k = 0; k < 2; ++k) acc = mma16(frag_tr(Bs, LDN, 32 * k, 16 * (2 * w + a), lane), frag_tr(Xw, LDP, 32 * k, 16 * c, lane), acc);
          Sacc[a][c] = acc;
          u32x2 o; o.x = pk2(acc[0], acc[1]); o.y = pk2(acc[2], acc[3]);
          *(LAS u32x2*)(Sw + (16 * c + fr) * LDN + 16 * (2 * w + a) + 4 * fq) = o; } }
    LBAR();
  }
}

template <int N> __device__ __forceinline__ float dpp_shr(float oldv, float v) {
  return __builtin_bit_cast(float, __builtin_amdgcn_update_dpp(__builtin_bit_cast(int, oldv), __builtin_bit_cast(int, v), 0x110 + N, 0xf, 0xf, false));
}
__device__ __forceinline__ float fast_sigmoid(float x) { return __builtin_amdgcn_rcpf(1.f + __expf(-x)); }
__device__ __forceinline__ void rg_chain_wg(const Params& P, const Ctx& C, int task) {
  const int b = task >> 5, h = (task >> 2) & 7, q = task & 3;
  const int d = C.wave >> 2, w = C.wave & 3, td = C.tid & 255, lane = C.lane, fr = lane & 15, fq = lane >> 4;
  constexpr int LDN = 136, LDW = 72;
  constexpr int DIRSZ = 40 * 1024;
  LAS unsigned char* L = C.lds + d * DIRSZ;
  LAS bf16_t* Xc = (LAS bf16_t*)L;
  LAS bf16_t* Wl = Xc + 64 * LDN;
  LAS float* Sum = (LAS float*)(Wl + 128 * LDW);
  const bf16_t* Z = WS(OFF_Z0, bf16_t); bf16_t* MIX = WS(OFF_MIX0, bf16_t);
  const int ch0 = h * 128 + q * 32;
  __syncthreads();
#pragma unroll 2
  for (int i = td; i < 128 * 64; i += 256) { const int ii = i >> 6, j = i & 63, gate = j >> 5, jj = j & 31;
    const float* W = (gate ? GIN(I_RGXW) : GIN(I_RGAW)) + ((size_t)(d * 8 + h) * 128 + ii) * 128 + q * 32 + jj; Wl[ii * LDW + j] = (bf16_t)f2bf(*W); }
  float ba[8], bx[8], spl[8], hc[8];
#pragma unroll
  for (int e = 0; e < 8; ++e) { const int c = ch0 + 16 * (e >> 2) + 4 * fq + (e & 3);
    ba[e] = GIN(I_RGAB)[d * 1024 + c]; bx[e] = GIN(I_RGXB)[d * 1024 + c]; spl[e] = -8.f * softplusf_(-GIN(I_RGLAM)[d * 1024 + c]); hc[e] = 0.f; }
  const int st_t = td >> 2, st_p = td & 3;
  u32x4 rx[4];
  auto issue_loads = [&](int step) {
    const int chunk = seq_chunk(d, step); const size_t row = (size_t)b * TB + chunk * 64 + st_t;
    const u32x4* px = (const u32x4*)(Z + row * Z0W + Z0_RGX + h * 128 + st_p * 32);
#pragma unroll
    for (int i = 0; i < 4; ++i) rx[i] = px[i];
  };
  issue_loads(0);
  __syncthreads();
  const int ii = 16 * w + fr;
  const LAS bf16_t* xrow = Xc + ii * LDN + q * 32 + 4 * fq;
  for (int step = 0; step < 132; ++step) {
    const int chunk = seq_chunk(d, step); const int row0 = b * TB + chunk * 64;
    VMWAIT();
    { const int i = d ? 63 - st_t : st_t; LAS u32x4* dx = (LAS u32x4*)(Xc + i * LDN + st_p * 32);
#pragma unroll
      for (int k = 0; k < 4; ++k) dx[k] = rx[k]; }
    LBAR();
    if (step + 1 < 132) issue_loads(step + 1);
    const bool first = (d == 0) == fwd_first(chunk);
    const int t = d ? 63 - ii : ii;
    bf16_t* op = MIX + (size_t)(row0 + t) * MIXW + ch0 + 4 * fq;
    unsigned long long ppv[2] = {0ull, 0ull}; u32x2 gy[2] = {(u32x2){0u, 0u}, (u32x2){0u, 0u}};
    if (!first) { ppv[0] = ld_agent_u64(op); ppv[1] = ld_agent_u64(op + 16);
      const bf16_t* gp = Z + (size_t)(row0 + t) * Z0W + Z0_RGY + ch0 + 4 * fq; gy[0] = *(const u32x2*)gp; gy[1] = *(const u32x2*)(gp + 16); }
    f32x4 ga[2], gx[2];
#pragma unroll
    for (int jt = 0; jt < 2; ++jt) { ga[jt] = (f32x4){0.f, 0.f, 0.f, 0.f}; gx[jt] = (f32x4){0.f, 0.f, 0.f, 0.f}; }
#pragma unroll
    for (int k = 0; k < 4; ++k) { const bf16x8 fb = frag_row(Xc, LDN, 16 * w, 32 * k, lane);
#pragma unroll
      for (int jt = 0; jt < 2; ++jt) { ga[jt] = mma16(frag_tr(Wl, LDW, 32 * k, 16 * jt, lane), fb, ga[jt]); gx[jt] = mma16(frag_tr(Wl, LDW, 32 * k, 32 + 16 * jt, lane), fb, gx[jt]); } }
    float A[8], Bv[8];
#pragma unroll
    for (int jt = 0; jt < 2; ++jt) { const u32x2 xw = *(const LAS u32x2*)(xrow + 16 * jt); const float xv[4] = {bflo(xw.x), bfhi(xw.x), bflo(xw.y), bfhi(xw.y)};
#pragma unroll
      for (int r = 0; r < 4; ++r) { const int e = 4 * jt + r;
        const float rg = fast_sigmoid(ga[jt][r] + ba[e]), ig = fast_sigmoid(gx[jt][r] + bx[e]); const float la = rg * spl[e];
        const float a = __expf(la); A[e] = a; Bv[e] = sqrtf(fmaxf(1.f - a * a, 0.f)) * (ig * xv[r]); } }
#pragma unroll
    for (int e = 0; e < 8; ++e) {
      { const float Ap = dpp_shr<1>(1.f, A[e]), Bp = dpp_shr<1>(0.f, Bv[e]); Bv[e] = A[e] * Bp + Bv[e]; A[e] = A[e] * Ap; }
      { const float Ap = dpp_shr<2>(1.f, A[e]), Bp = dpp_shr<2>(0.f, Bv[e]); Bv[e] = A[e] * Bp + Bv[e]; A[e] = A[e] * Ap; }
      { const float Ap = dpp_shr<4>(1.f, A[e]), Bp = dpp_shr<4>(0.f, Bv[e]); Bv[e] = A[e] * Bp + Bv[e]; A[e] = A[e] * Ap; }
      { const float Ap = dpp_shr<8>(1.f, A[e]), Bp = dpp_shr<8>(0.f, Bv[e]); Bv[e] = A[e] * Bp + Bv[e]; A[e] = A[e] * Ap; } }
    if (fr == 15) {
#pragma unroll
      for (int e = 0; e < 8; ++e) { f32x2 sv; sv[0] = A[e]; sv[1] = Bv[e]; *(LAS f32x2*)(Sum + ((w * 32) + 16 * (e >> 2) + 4 * fq + (e & 3)) * 2) = sv; } }
    LBAR();
    float hin[8];
#pragma unroll
    for (int e = 0; e < 8; ++e) { float hh = hc[e]; const int c = 16 * (e >> 2) + 4 * fq + (e & 3);
#pragma unroll
      for (int tt = 0; tt < 4; ++tt) { const f32x2 sv = *(const LAS f32x2*)(Sum + (tt * 32 + c) * 2); if (tt == w) hin[e] = hh; hh = sv[0] * hh + sv[1]; }
      hc[e] = hh; }
#pragma unroll
    for (int jt = 0; jt < 2; ++jt) { float hv[4];
#pragma unroll
      for (int r = 0; r < 4; ++r) hv[r] = Bv[4 * jt + r] + A[4 * jt + r] * hin[4 * jt + r];
      if (!first) { const unsigned lo = (unsigned)ppv[jt], hi = (unsigned)(ppv[jt] >> 32);
        const float gyv[4] = {bflo(gy[jt].x), bfhi(gy[jt].x), bflo(gy[jt].y), bfhi(gy[jt].y)}; const float pf[4] = {bflo(lo), bfhi(lo), bflo(hi), bfhi(hi)};
#pragma unroll
        for (int r = 0; r < 4; ++r) { const float x = gyv[r]; const float u2 = 1.5957691216057308f * (x + 0.044715f * x * x * x); hv[r] = (hv[r] + pf[r]) * x * fast_sigmoid(u2); } }
      u32x2 o; o.x = pg8::cvt_pk_bf16(hv[0], hv[1]); o.y = pg8::cvt_pk_bf16(hv[2], hv[3]); *(u32x2*)(op + 16 * jt) = o; }
  }
}
__device__ __forceinline__ void phase_chain0(const Params& P, const Ctx& C, int mode) {
  if (mode != 2) for (int task = C.bid; task < 128; task += C.nblk) ssd_chain_wg(P, C, task);
  __builtin_amdgcn_sched_barrier(0);
  if (mode != 1) for (int task = C.bid < 128 ? C.bid + C.nblk : C.bid; task < 256; task += C.nblk) rg_chain_wg(P, C, task - 128);
}
__device__ __forceinline__ void phase_ssdfin(const Params& P, const Ctx& C, int ident) {
  const bf16_t* Z = WS(OFF_Z0, bf16_t); bf16_t* MIX = WS(OFF_MIX0, bf16_t);
  for (int r = C.gw; r < R; r += C.ngw) {
    f32x4 y[4];
#pragma unroll
    for (int j = 0; j < 4; ++j) { const int e = 4 * C.lane + 256 * j; const float dsk = GIN(I_SD)[e >> 6];
      const u32x2 ys = *(const u32x2*)(MIX + (size_t)r * MIXW + 1024 + e), xs = *(const u32x2*)(Z + (size_t)r * Z0W + Z0_XBC + e), zz = *(const u32x2*)(Z + (size_t)r * Z0W + Z0_SSDZ + e);
      y[j][0] = (bflo(ys.x) + dsk * bflo(xs.x)) * siluf_(bflo(zz.x)); y[j][1] = (bfhi(ys.x) + dsk * bfhi(xs.x)) * siluf_(bfhi(zz.x));
      y[j][2] = (bflo(ys.y) + dsk * bflo(xs.y)) * siluf_(bflo(zz.y)); y[j][3] = (bfhi(ys.y) + dsk * bfhi(xs.y)) * siluf_(bfhi(zz.y)); }
    float s0 = 0.f, s1 = 0.f;
#pragma unroll
    for (int i = 0; i < 4; ++i) { s0 += y[0][i] * y[0][i] + y[1][i] * y[1][i]; s1 += y[2][i] * y[2][i] + y[3][i] * y[3][i]; }
    const float r0 = rsqrtf(wave_sum(s0) * (1.f / 512.f) + RMS_EPS), r1 = rsqrtf(wave_sum(s1) * (1.f / 512.f) + RMS_EPS);
#pragma unroll
    for (int j = 0; j < 4; ++j) { const int e = 4 * C.lane + 256 * j; const f32x4 gn = *(const f32x4*)(GIN(I_SNG) + e); const float rr = j < 2 ? r0 : r1;
      u32x2 w; w.x = pk2(y[j][0] * rr * gn[0], y[j][1] * rr * gn[1]); w.y = pk2(y[j][2] * rr * gn[2], y[j][3] * rr * gn[3]);
      if (ident) w = *(const u32x2*)(MIX + (size_t)r * MIXW + 1024 + e);
      *(u32x2*)(MIX + (size_t)r * MIXW + 1024 + e) = w; }
  }
}

__device__ __forceinline__ void phase_outproj(const Params& P, const Ctx& C, int layer) {
  const float* MOD = WS(OFF_MOD, float) + (size_t)layer * 5 * 6144;
  pg8::Gemm g{layer ? WS(OFF_MIX1, bf16_t) : WS(OFF_MIX0, bf16_t), layer ? WS(OFF_WOUT1, bf16_t) : WS(OFF_WOUT0, bf16_t), MIXW, MIXW};
  pg8::GridOrder S; if (layer) S.init(128, 4, C.nblk, C.bid, 1); else S.init(132, 4, C.nblk, C.bid, 0);
  pg8::EpiResid E{layer ? GOUT : GIN(I_X), layer ? WS(OFF_HCTX, float) : GIN(I_CTX), GOUT, WS(OFF_TCTX, float), MOD + 2 * D};
  pg8::gemm_phase(C.lds, g, S, E);
}

__device__ __forceinline__ void phase_lnmix(const Params& P, const Ctx& C, int layer, int ident) {
  LAS float* Wt = (LAS float*)C.lds;
  { const float* gw = GIN(I_RGW) + (size_t)layer * D * 4; const float* ew = GIN(I_REW) + (size_t)layer * D * 32;
    for (int i = C.tid; i < 1024 * 4; i += NT) { const int k = i >> 2, c = i & 3; Wt[c * 1024 + k] = gw[i]; }
    for (int i = C.tid; i < 1024 * 32; i += NT) { const int k = i >> 5, c = i & 31; Wt[(4 + c) * 1024 + k] = ew[i]; } }
  __syncthreads();
  const float* MOD = WS(OFF_MOD, float) + (size_t)layer * 5 * 6144;
  const float* lng = GIN(I_LNMG) + layer * D; const float* lnb = GIN(I_LNMB) + layer * D;
  const float* rgb = GIN(I_RGB) + layer * 4; const float* reb = GIN(I_REB) + layer * 32;
  bf16_t* V = layer ? WS(OFF_V1, bf16_t) : WS(OFF_U0, bf16_t);
  int* cnt = WS(OFF_CTL, int) + layer * 32; int* route = WS(OFF_ROUTE, int); unsigned short* tok = WS(OFF_TOK, unsigned short);
  LAS int* lcnt = (LAS int*)(C.lds + 36 * 1024 * 4);
  if (C.tid < NEXP) lcnt[C.tid] = 0;
  __syncthreads();
  const int nrows = layer ? RLAT : R;
  f32x4 h[4], hn[4];
  if (C.gw < nrows) row_load(lat_or_ctx_w(GOUT, WS(OFF_TCTX, float), rmap(layer, C.gw)), C.lane, h);
  for (int q = C.gw; q < nrows; q += C.ngw) {
    const int r = rmap(layer, q);
    if (q + C.ngw < nrows) row_load(lat_or_ctx_w(GOUT, WS(OFF_TCTX, float), rmap(layer, q + C.ngw)), C.lane, hn);
    float* hrow = lat_or_ctx_w(GOUT, WS(OFF_HCTX, float), r);
    f32x4 v[4];
    if (!ident) row_layernorm(h, lng, lnb, C.lane);
    row_store(hrow, C.lane, h);
    const float* m = MOD + (size_t)row_b5(r) * 6144;
    row_modulate(h, m + 3 * D, m + 4 * D, C.lane, v);
    row_store_bf16(V + (size_t)r * D, C.lane, v);
    float lg[4];
#pragma unroll
    for (int c = 0; c < 4; ++c) { float s = 0.f;
#pragma unroll
      for (int j = 0; j < 4; ++j) { const f32x4 w = *(const LAS f32x4*)(Wt + c * 1024 + 4 * C.lane + 256 * j); s += (v[j][0] * w[0] + v[j][1] * w[1]) + (v[j][2] * w[2] + v[j][3] * w[3]); }
      lg[c] = wave_sum(s) + rgb[c]; }
    int gsel = 0; float gmax = lg[0];
#pragma unroll
    for (int i = 1; i < 4; ++i) if (lg[i] > gmax) { gmax = lg[i]; gsel = i; }
    gsel = __builtin_amdgcn_readfirstlane(gsel);
    float gden = 0.f;
#pragma unroll
    for (int i = 0; i < 4; ++i) gden += __expf(lg[i] - gmax);
    const float ptg = 1.f / gden;
    float le[8];
    { const LAS float* We = Wt + (4 + gsel * 8) * 1024 + 4 * C.lane;
#pragma unroll
      for (int c = 0; c < 8; ++c) { float s = 0.f;
#pragma unroll
        for (int j = 0; j < 4; ++j) { const f32x4 w = *(const LAS f32x4*)(We + c * 1024 + 256 * j); s += (v[j][0] * w[0] + v[j][1] * w[1]) + (v[j][2] * w[2] + v[j][3] * w[3]); }
        le[c] = wave_sum(s) + reb[gsel * 8 + c]; } }
    int e1 = 0; float m1 = le[0];
#pragma unroll
    for (int i = 1; i < 8; ++i) if (le[i] > m1) { m1 = le[i]; e1 = i; }
    int e2 = -1; float m2 = -3.0e38f;
#pragma unroll
    for (int i = 0; i < 8; ++i) if (i != e1 && le[i] > m2) { m2 = le[i]; e2 = i; }
    const float q2 = __expf(m2 - m1); const float w1 = ptg / (1.f + q2), w2 = ptg * q2 / (1.f + q2);
    if (C.lane == 0) {
      const int E1 = gsel * 8 + e1, E2 = gsel * 8 + e2;
      const int p1 = __hip_atomic_fetch_add(lcnt + E1, 1, __ATOMIC_RELAXED, __HIP_MEMORY_SCOPE_WORKGROUP), p2 = __hip_atomic_fetch_add(lcnt + E2, 1, __ATOMIC_RELAXED, __HIP_MEMORY_SCOPE_WORKGROUP);
      int* rr = route + (size_t)r * 8; if (!ident) { rr[0] = E1; rr[1] = E2; ((float*)rr)[2] = w1; ((float*)rr)[3] = w2; rr[4] = p1; rr[5] = p2; }
    }
#pragma unroll
    for (int j = 0; j < 4; ++j) h[j] = hn[j];
  }
  __syncthreads();
  if (ident) return;
  if (C.tid < NEXP) lcnt[C.tid] = atomicAdd(cnt + C.tid, lcnt[C.tid]);
  __syncthreads();
  for (int k = C.tid >> 3; ; k += NT / 8) { const int q = (C.bid * NWAVES + (C.tid & 7)) + k * C.ngw; if (q >= nrows) break;
    const int r = rmap(layer, q); int* rr = route + (size_t)r * 8; const int E1 = rr[0], E2 = rr[1]; const int p1 = rr[4] + lcnt[E1], p2 = rr[5] + lcnt[E2];
    rr[4] = p1; rr[5] = p2; tok[(size_t)E1 * TOKCAP + p1] = (unsigned short)r; tok[(size_t)E2 * TOKCAP + p2] = (unsigned short)r; }
}

__device__ __forceinline__ void phase_dispatch(const Params& P, const Ctx& C, int layer) {
  LAS int* base = (LAS int*)C.lds;
  int* ctl = WS(OFF_CTL, int); const int* cnt = ctl + layer * 32;
  if (C.tid == 0) { int acc = 0; for (int e = 0; e < NEXP; ++e) { base[e] = acc; acc += (cnt[e] + 255) >> 8; } base[32] = acc; }
  __syncthreads();
  if (C.bid == 0) { if (C.tid == 0) ctl[64 + layer] = base[32];
    if (C.tid < NEXP) { for (int bk = base[C.tid]; bk < base[C.tid + 1]; ++bk) ctl[128 + layer * MAX_BLKS + bk] = C.tid; } }
  const bf16_t* V = layer ? WS(OFF_V1, bf16_t) : WS(OFF_U0, bf16_t);
  bf16_t* AM = layer ? WS(OFF_AM1, bf16_t) : WS(OFF_AM0, bf16_t);
  float* slotw = WS(OFF_SLOTW, float); int* route = WS(OFF_ROUTE, int);
  for (int r = C.gw; r < R; r += C.ngw) {
    const int pos = r % TB; if (layer && pos < CTXL) continue;
    int* rr = route + (size_t)r * 8;
    const int E1 = rr[0], E2 = rr[1]; const int s1 = base[E1] * 256 + rr[4], s2 = base[E2] * 256 + rr[5];
    const u32x4* src = (const u32x4*)(V + (size_t)r * D);
    const u32x4 a = src[C.lane], b = src[64 + C.lane];
    u32x4* d1 = (u32x4*)(AM + (size_t)s1 * D); u32x4* d2 = (u32x4*)(AM + (size_t)s2 * D);
    d1[C.lane] = a; d1[64 + C.lane] = b; d2[C.lane] = a; d2[64 + C.lane] = b;
    if (C.lane == 0) { rr[6] = s1; rr[7] = s2; slotw[s1] = ((const float*)rr)[2]; slotw[s2] = ((const float*)rr)[3]; }
  }
}
__device__ __forceinline__ int moe_tables(const Params& P, const Ctx& C, int layer, LAS int* tb) {
  const int* cnt = WS(OFF_CTL, int) + layer * 32;
  __syncthreads();
  if (C.tid == 0) { int acc = 0; for (int e = 0; e < NEXP; ++e) { const int c = cnt[e]; tb[e] = acc; tb[40 + e] = c; acc += (c + 255) >> 8; } tb[32] = acc; }
  __syncthreads();
  if (C.tid < NEXP) { for (int bk = tb[C.tid]; bk < tb[C.tid + 1]; ++bk) tb[80 + bk] = C.tid; }
  __syncthreads();
  return tb[32];
}
__device__ __forceinline__ void phase_moe1(const Params& P, const Ctx& C, int layer) {
  LAS int* tb = (LAS int*)(C.lds + 131072);
  const int nblk = moe_tables(P, C, layer, tb);
  pg8::Gemm g{layer ? WS(OFF_V1, bf16_t) : WS(OFF_U0, bf16_t), layer ? WS(OFF_WE1, bf16_t) : WS(OFF_WE0, bf16_t), D, D};
  pg8::MoeOrder S{tb, tb + 40, tb + 80, WS(OFF_TOK, unsigned short), nblk * 4, C.nblk, C.bid};
  pg8::EpiSwiGLU E{layer ? WS(OFF_HM1, bf16_t) : WS(OFF_HM0, bf16_t)};
  pg8::gemm_phase_ga(C.lds, g, S, E);
}
__device__ __forceinline__ void phase_moe2(const Params& P, const Ctx& C, int layer) {
  LAS int* tb = (LAS int*)(C.lds + 131072);
  const int nblk = moe_tables(P, C, layer, tb);
  pg8::Gemm g{layer ? WS(OFF_HM1, bf16_t) : WS(OFF_HM0, bf16_t), layer ? WS(OFF_WE1 + 64 * MiB, bf16_t) : WS(OFF_WE0 + 64 * MiB, bf16_t), DEXP, DEXP};
  pg8::MoeOrder S{tb, tb + 40, tb + 80, WS(OFF_TOK, unsigned short), nblk * 4, C.nblk, C.bid};
  pg8::EpiMoeDown E{layer ? WS(OFF_YM1, bf16_t) : WS(OFF_YM0, bf16_t)};
  pg8::gemm_phase(C.lds, g, S, E);
}

__device__ __forceinline__ void phase_lnffn(const Params& P, const Ctx& C, int layer, int ident) {
  const float* MOD = WS(OFF_MOD, float) + (size_t)layer * 5 * 6144;
  const float* lng = GIN(I_LNFG) + layer * D; const float* lnb = GIN(I_LNFB) + layer * D;
  const bf16_t* YM = layer ? WS(OFF_YM1, bf16_t) : WS(OFF_YM0, bf16_t); const int* route = WS(OFF_ROUTE, int);
  LAS int* tb = (LAS int*)(C.lds + 131072);
  (void)moe_tables(P, C, layer, tb);
  const int nrows = layer ? RLAT : R;
  f32x4 h[4], hn[4]; u32x2 ya[4], yb[4], yan[4], ybn[4]; int s1n = 0, s2n = 0; float w1c = 0.f, w2c = 0.f, w1n = 0.f, w2n = 0.f, w1nn = 0.f, w2nn = 0.f;
  auto ldrow = [&](int q, f32x4 (&hh)[4], u32x2 (&a)[4], u32x2 (&bq)[4], int sa, int sb) {
    const int r = rmap(layer, q); row_load(lat_or_ctx_w(GOUT, WS(OFF_HCTX, float), r), C.lane, hh);
#pragma unroll
    for (int j = 0; j < 4; ++j) { a[j] = *(const u32x2*)(YM + (size_t)sa * D + 4 * C.lane + 256 * j); bq[j] = *(const u32x2*)(YM + (size_t)sb * D + 4 * C.lane + 256 * j); } };
  if (C.gw < nrows) { const int* rr = route + (size_t)rmap(layer, C.gw) * 8; ldrow(C.gw, h, ya, yb, tb[rr[0]] * 256 + rr[4], tb[rr[1]] * 256 + rr[5]); w1c = ((const float*)rr)[2]; w2c = ((const float*)rr)[3]; }
  if (C.gw + C.ngw < nrows) { const int* rr = route + (size_t)rmap(layer, C.gw + C.ngw) * 8; s1n = tb[rr[0]] * 256 + rr[4]; s2n = tb[rr[1]] * 256 + rr[5]; w1n = ((const float*)rr)[2]; w2n = ((const float*)rr)[3]; }
  for (int q = C.gw; q < nrows; q += C.ngw) {
    const int r = rmap(layer, q);
    if (q + C.ngw < nrows) ldrow(q + C.ngw, hn, yan, ybn, s1n, s2n);
    if (q + 2 * C.ngw < nrows) { const int* rr = route + (size_t)rmap(layer, q + 2 * C.ngw) * 8; s1n = tb[rr[0]] * 256 + rr[4]; s2n = tb[rr[1]] * 256 + rr[5]; w1nn = ((const float*)rr)[2]; w2nn = ((const float*)rr)[3]; }
    float* hrow = lat_or_ctx_w(GOUT, WS(OFF_HCTX, float), r);
    const float* m = MOD + (size_t)row_b5(r) * 6144;
#pragma unroll
    for (int j = 0; j < 4; ++j) { const u32x2 a = ya[j], b = yb[j];
      const f32x4 g5 = *(const f32x4*)(m + 5 * D + 4 * C.lane + 256 * j);
      f32x4 f; f[0] = w1c * bflo(a.x) + w2c * bflo(b.x); f[1] = w1c * bfhi(a.x) + w2c * bfhi(b.x); f[2] = w1c * bflo(a.y) + w2c * bflo(b.y); f[3] = w1c * bfhi(a.y) + w2c * bfhi(b.y);
      if (!ident) h[j] = h[j] * ALPHA + g5 * f; else h[j] = h[j] + f * 0.f; }
    if (!ident) row_layernorm(h, lng, lnb, C.lane);
    row_store(hrow, C.lane, h);
    if (layer == 0) {
      const float* m1 = WS(OFF_MOD, float) + (size_t)(5 + row_b5(r)) * 6144;
      f32x4 u[4]; row_modulate(h, m1, m1 + D, C.lane, u);
      row_store_bf16(WS(OFF_U1, bf16_t) + (size_t)r * D, C.lane, u);
    }
#pragma unroll
    for (int j = 0; j < 4; ++j) { h[j] = hn[j]; ya[j] = yan[j]; yb[j] = ybn[j]; }
    w1c = w1n; w2c = w2n; w1n = w1nn; w2n = w2nn;
  }
  if (layer == 0) {
    __syncthreads();
    LAS float* scr = (LAS float*)C.lds + C.wave * (64 * 33);
    constexpr int N_A = 16 * 96, N_B = 16 * 128;
    for (int it = C.gw; it < N_A + N_B + 16; it += C.ngw) {
      if (it < N_A) transpose_mat_item(GIN(I_CDW), CD_IN, 0, D, 3072, WS(OFF_WCD, bf16_t), D, 0, it, scr, C.lane);
      else if (it < N_A + N_B) transpose_mat_item(GIN(I_CDW), CD_IN, 4128, D, 4096, WS(OFF_WCD, bf16_t) + (size_t)3072 * D, D, 0, it - N_A, scr, C.lane);
      else transpose_mat_item(GIN(I_CDW), CD_IN, 4096, D, 32, WS(OFF_WCD, bf16_t) + (size_t)7168 * D, D, 0, it - N_A - N_B, scr, C.lane);
    }
    { u32x4* z = (u32x4*)(WS(OFF_WCD, bf16_t) + (size_t)7200 * D); const u32x4 zz = {0u, 0u, 0u, 0u};
      for (int i = C.bid * NT + C.tid; i < 224 * D * 2 / 16; i += C.nblk * NT) z[i] = zz; }
  }
}

__device__ __forceinline__ void gdn_task(const Params& P, const Ctx& C, int task) {
  const int b = task >> 9, h = (task >> 6) & 7, vs = task & 63; const int c = C.lane >> 5, kg = C.lane & 31;
  const bf16_t* Z = WS(OFF_Z1, bf16_t); bf16_t* MIX = WS(OFF_MIX1, bf16_t); const float* DT = WS(OFF_DT, float);
  const int colq = Z1_Q + h * 128 + 4 * kg, colk = Z1_K + h * 128 + 4 * kg, colv = Z1_V + h * 128 + 2 * vs + c, outc = h * 128 + 2 * vs + c;
  for (int d = 0; d < 2; ++d) {
    const float Aneg = -__expf(GIN(I_GALOG)[d * 8 + h]), dtb = GIN(I_GDTB)[d * 8 + h];
    float S0 = 0.f, S1 = 0.f, S2 = 0.f, S3 = 0.f;
    for (int j0 = 0; j0 < TB; j0 += 8) {
      u32x2 qv[8], kv[8]; unsigned short vv[8], yp[8]; float br[8], ar[8];
#pragma unroll
      for (int u = 0; u < 8; ++u) { const size_t row = (size_t)b * TB + seq_pos(d, j0 + u);
        qv[u] = *(const u32x2*)(Z + row * Z1W + colq); kv[u] = *(const u32x2*)(Z + row * Z1W + colk); vv[u] = Z[row * Z1W + colv];
        br[u] = DT[row * 32 + d * 8 + h]; ar[u] = DT[row * 32 + 16 + d * 8 + h]; yp[u] = d ? MIX[row * MIXW + outc] : (unsigned short)0; }
#pragma unroll
      for (int u = 0; u < 8; ++u) { const size_t row = (size_t)b * TB + seq_pos(d, j0 + u);
        const float al = __expf(Aneg * softplusf_(ar[u] + dtb)), be = sigmoidf_(br[u]);
        const float k0 = bflo(kv[u].x), k1 = bfhi(kv[u].x), k2 = bflo(kv[u].y), k3 = bfhi(kv[u].y);
        S0 *= al; S1 *= al; S2 *= al; S3 *= al;
        const float p = half_sum32((k0 * S0 + k1 * S1) + (k2 * S2 + k3 * S3));
        const float dl = be * (bf2f(vv[u]) - p);
        S0 += k0 * dl; S1 += k1 * dl; S2 += k2 * dl; S3 += k3 * dl;
        const float o = half_sum32((bflo(qv[u].x) * S0 + bfhi(qv[u].x) * S1) + (bflo(qv[u].y) * S2 + bfhi(qv[u].y) * S3));
        if (kg == 0) MIX[row * MIXW + outc] = (bf16_t)f2bf(o + bf2f(yp[u])); }
    }
    __threadfence_block();
  }
}
__device__ __forceinline__ void hgrn_task(const Params& P, const Ctx& C, int task) {
  const int b = task >> 9, h = (task >> 6) & 7, vs = task & 63; const int c = C.lane >> 5, kg = C.lane & 31;
  const bf16_t* Z = WS(OFF_Z1, bf16_t); bf16_t* MIX = WS(OFF_MIX1, bf16_t);
  const f32x4 lb = *(const f32x4*)(WS(OFF_LB1, float) + h * 128 + 4 * kg);
  const int colq = Z1_HQ + h * 128 + 4 * kg, colv = Z1_HI + h * 128 + 2 * vs + c, outc = 1024 + h * 128 + 2 * vs + c;
  for (int d = 0; d < 2; ++d) {
    const int colf = Z1_HF + d * 1024 + h * 128 + 4 * kg;
    float S0 = 0.f, S1 = 0.f, S2 = 0.f, S3 = 0.f;
    for (int j0 = 0; j0 < TB; j0 += 8) {
      u32x2 qv[8], fv[8]; unsigned short vv[8], yp[8];
#pragma unroll
      for (int u = 0; u < 8; ++u) { const size_t row = (size_t)b * TB + seq_pos(d, j0 + u);
        qv[u] = *(const u32x2*)(Z + row * Z1W + colq); fv[u] = *(const u32x2*)(Z + row * Z1W + colf); vv[u] = Z[row * Z1W + colv];
        yp[u] = d ? MIX[row * MIXW + outc] : (unsigned short)0; }
#pragma unroll
      for (int u = 0; u < 8; ++u) { const size_t row = (size_t)b * TB + seq_pos(d, j0 + u);
        const float f0 = lb[0] + (1.f - lb[0]) * sigmoidf_(bflo(fv[u].x)), f1 = lb[1] + (1.f - lb[1]) * sigmoidf_(bfhi(fv[u].x));
        const float f2 = lb[2] + (1.f - lb[2]) * sigmoidf_(bflo(fv[u].y)), f3 = lb[3] + (1.f - lb[3]) * sigmoidf_(bfhi(fv[u].y));
        const float v = bf2f(vv[u]);
        S0 = f0 * S0 + (1.f - f0) * v; S1 = f1 * S1 + (1.f - f1) * v; S2 = f2 * S2 + (1.f - f2) * v; S3 = f3 * S3 + (1.f - f3) * v;
        const float o = half_sum32((bflo(qv[u].x) * S0 + bfhi(qv[u].x) * S1) + (bflo(qv[u].y) * S2 + bfhi(qv[u].y) * S3));
        if (kg == 0) MIX[row * MIXW + outc] = (bf16_t)f2bf(o + bf2f(yp[u])); }
    }
    __threadfence_block();
  }
}

__device__ __forceinline__ int seq_chunk32(int dir, int j) { return dir == 0 ? j : (j < 8 ? 7 - j : 271 - j); }
__device__ __forceinline__ bool fwd_first32(int c) { return c < 8 ? (c <= 3) : (c <= 135); }

__device__ __forceinline__ void hgrn_chain_wg(const Params& P, const Ctx& C, int task) {
  const int b = task >> 5, h = (task >> 2) & 7, vs = task & 3;
  const int d = C.wave >> 2, w = C.wave & 3, td = C.tid & 255, lane = C.lane, fr = lane & 15, fq = lane >> 4;
  constexpr int LDN = 136, LDP = 40;
  constexpr int DIRSZ = 72 * 1024;
  LAS unsigned char* L = C.lds + d * DIRSZ;
  LAS bf16_t* Qt = (LAS bf16_t*)L;
  LAS bf16_t* Kh = Qt + 32 * LDN;
  LAS bf16_t* Kw = Kh + 32 * LDN;
  LAS bf16_t* Vs = Kw + 32 * LDN;
  LAS bf16_t* Pt = Vs + 32 * LDP;
  LAS bf16_t* St = Pt + 32 * LDP;
  LAS float* CUM = (LAS float*)(St + 2 * 32 * LDN);
  const bf16_t* Z = WS(OFF_Z1, bf16_t); bf16_t* MIX = WS(OFF_MIX1, bf16_t);
  const int colq = Z1_HQ + h * 128, colf = Z1_HF + d * 1024 + h * 128, colv = Z1_HI + h * 128 + vs * 32, outc = 1024 + h * 128 + vs * 32;
  __syncthreads();
  for (int i = td; i < 32 * LDP / 2; i += 256) ((LAS unsigned*)Pt)[i] = 0u;
  for (int i = td; i < 2 * 32 * LDN / 2; i += 256) ((LAS unsigned*)St)[i] = 0u;
  f32x4 Sacc[2][2];
#pragma unroll
  for (int a = 0; a < 2; ++a)
#pragma unroll
    for (int c = 0; c < 2; ++c) Sacc[a][c] = (f32x4){0.f, 0.f, 0.f, 0.f};
  const int st_t = td >> 3, st_s = td & 7;
  float lbv[16];
#pragma unroll
  for (int e = 0; e < 16; ++e) lbv[e] = WS(OFF_LB1, float)[h * 128 + st_s * 16 + e];
  u32x4 rq[2], rf[2]; u32x2 rv;
  auto issue_loads = [&](int step) {
    const int chunk = seq_chunk32(d, step); const size_t row = (size_t)b * TB + chunk * 32 + st_t;
    const u32x4* pq = (const u32x4*)(Z + row * Z1W + colq + st_s * 16); const u32x4* pf = (const u32x4*)(Z + row * Z1W + colf + st_s * 16);
    rq[0] = pq[0]; rq[1] = pq[1]; rf[0] = pf[0]; rf[1] = pf[1];
    rv = *(const u32x2*)(Z + row * Z1W + colv + st_s * 4);
  };
  issue_loads(0);
  for (int step = 0; step < 264; ++step) {
    const int chunk = seq_chunk32(d, step); const int row0 = b * TB + chunk * 32;
    const int si = d ? 31 - st_t : st_t;
    VMWAIT();
    float qv[16], kk[16];
    { const unsigned qw[8] = {rq[0].x, rq[0].y, rq[0].z, rq[0].w, rq[1].x, rq[1].y, rq[1].z, rq[1].w};
      const unsigned fw[8] = {rf[0].x, rf[0].y, rf[0].z, rf[0].w, rf[1].x, rf[1].y, rf[1].z, rf[1].w};
      f32x4 lf4[4];
#pragma unroll
      for (int e = 0; e < 8; ++e) { qv[2 * e] = bflo(qw[e]); qv[2 * e + 1] = bfhi(qw[e]);
        const float f0 = lbv[2 * e] + (1.f - lbv[2 * e]) * sigmoidf_(bflo(fw[e])), f1 = lbv[2 * e + 1] + (1.f - lbv[2 * e + 1]) * sigmoidf_(bfhi(fw[e]));
        kk[2 * e] = 1.f - f0; kk[2 * e + 1] = 1.f - f1; lf4[e >> 1][(2 * e) & 3] = __logf(f0); lf4[e >> 1][(2 * e + 1) & 3] = __logf(f1); }
#pragma unroll
      for (int e = 0; e < 4; ++e) *(LAS f32x4*)(CUM + si * 128 + st_s * 16 + 4 * e) = lf4[e];
      *(LAS u32x2*)(Vs + si * LDP + st_s * 4) = rv; }
    LBAR();
    if (step + 1 < 264) issue_loads(step + 1);
    const int vt = w & 1, it = w >> 1;
    const bool first = (d == 0) == fwd_first32(chunk);
    bf16_t* op; unsigned long long ppv = 0ull;
    { const int ii = 16 * it + fr; const int t = d ? 31 - ii : ii; op = MIX + (size_t)(row0 + t) * MIXW + outc + 16 * vt + 4 * fq; if (!first) ppv = ld_agent_u64(op); }
    if (td < 128) { float c = 0.f;
#pragma unroll 8
      for (int i = 0; i < 32; ++i) { c += CUM[i * 128 + td]; CUM[i * 128 + td] = c; } }
    LBAR();
    { unsigned oq[8], oh[8], ow[8];
#pragma unroll
      for (int e = 0; e < 8; ++e) { const int k0 = st_s * 16 + 2 * e;
        const float c0 = CUM[si * 128 + k0], c1 = CUM[si * 128 + k0 + 1], l0 = CUM[31 * 128 + k0], l1 = CUM[31 * 128 + k0 + 1];
        oq[e] = pk2(qv[2 * e] * __expf(c0), qv[2 * e + 1] * __expf(c1));
        oh[e] = pk2(kk[2 * e] * __expf(fminf(-c0, 80.f)), kk[2 * e + 1] * __expf(fminf(-c1, 80.f)));
        ow[e] = pk2(kk[2 * e] * __expf(l0 - c0), kk[2 * e + 1] * __expf(l1 - c1)); }
      LAS u32x4* dq = (LAS u32x4*)(Qt + si * LDN + st_s * 16); LAS u32x4* dh = (LAS u32x4*)(Kh + si * LDN + st_s * 16); LAS u32x4* dw = (LAS u32x4*)(Kw + si * LDN + st_s * 16);
      dq[0] = (u32x4){oq[0], oq[1], oq[2], oq[3]}; dq[1] = (u32x4){oq[4], oq[5], oq[6], oq[7]};
      dh[0] = (u32x4){oh[0], oh[1], oh[2], oh[3]}; dh[1] = (u32x4){oh[4], oh[5], oh[6], oh[7]};
      dw[0] = (u32x4){ow[0], ow[1], ow[2], ow[3]}; dw[1] = (u32x4){ow[4], ow[5], ow[6], ow[7]}; }
    LBAR();
    if (w < 3) { const int I = w >= 1 ? 1 : 0, J = w == 2 ? 1 : 0;
      f32x4 acc = (f32x4){0.f, 0.f, 0.f, 0.f};
#pragma unroll
      for (int k = 0; k < 4; ++k) acc = mma16(frag_row(Qt, LDN, 16 * I, 32 * k, lane), frag_row(Kh, LDN, 16 * J, 32 * k, lane), acc);
      const int jj = 16 * J + fr; float pv[4];
#pragma unroll
      for (int r = 0; r < 4; ++r) { const int ii = 16 * I + 4 * fq + r; pv[r] = (jj <= ii) ? acc[r] : 0.f; }
      u32x2 o; o.x = pk2(pv[0], pv[1]); o.y = pk2(pv[2], pv[3]);
      *(LAS u32x2*)(Pt + jj * LDP + 16 * I + 4 * fq) = o; }
    const LAS bf16_t* Sr = St + (step & 1) * 32 * LDN; LAS bf16_t* Sw = St + ((step + 1) & 1) * 32 * LDN;
    f32x4 o2 = (f32x4){0.f, 0.f, 0.f, 0.f};
#pragma unroll
    for (int k = 0; k < 4; ++k) o2 = mma16(frag_row(Sr, LDN, 16 * vt, 32 * k, lane), frag_row(Qt, LDN, 16 * it, 32 * k, lane), o2);
#pragma unroll
    for (int a = 0; a < 2; ++a) { const int kt = 2 * w + a; const f32x4 cl = *(const LAS f32x4*)(CUM + 31 * 128 + 16 * kt + 4 * fq);
      f32x4 dec; dec[0] = __expf(cl[0]); dec[1] = __expf(cl[1]); dec[2] = __expf(cl[2]); dec[3] = __expf(cl[3]);
#pragma unroll
      for (int c = 0; c < 2; ++c) { f32x4 acc = Sacc[a][c] * dec;
        acc = mma16(frag_tr(Kw, LDN, 0, 16 * kt, lane), frag_tr(Vs, LDP, 0, 16 * c, lane), acc);
        Sacc[a][c] = acc;
        u32x2 o; o.x = pk2(acc[0], acc[1]); o.y = pk2(acc[2], acc[3]);
        *(LAS u32x2*)(Sw + (16 * c + fr) * LDN + 16 * kt + 4 * fq) = o; } }
    LBAR();
    { f32x4 o1 = mma16(frag_tr(Vs, LDP, 0, 16 * vt, lane), frag_tr(Pt, LDP, 0, 16 * it, lane), (f32x4){0.f, 0.f, 0.f, 0.f});
      float o0 = o1[0] + o2[0], o1v = o1[1] + o2[1], o2v = o1[2] + o2[2], o3 = o1[3] + o2[3];
      if (!first) { const unsigned long long pv = ppv; const unsigned lo = (unsigned)pv, hi = (unsigned)(pv >> 32); o0 += bflo(lo); o1v += bfhi(lo); o2v += bflo(hi); o3 += bfhi(hi); }
      u32x2 o; o.x = pk2(o0, o1v); o.y = pk2(o2v, o3); *(u32x2*)op = o; }
    LBAR();
  }
}

__device__ __forceinline__ void gdn_chain_wg(const Params& P, const Ctx& C, int task) {
  const int b = task >> 5, h = (task >> 2) & 7, vs = task & 3;
  const int d = C.wave >> 2, w = C.wave & 3, td = C.tid & 255, lane = C.lane, fr = lane & 15, fq = lane >> 4;
  constexpr int LDN = 136, LDP = 40, LDT = 24;
  constexpr int DIRSZ = 72 * 1024;
  LAS unsigned char* L = C.lds + d * DIRSZ;
  LAS bf16_t* Qs = (LAS bf16_t*)L;
  LAS bf16_t* Ks = Qs + 32 * LDN;
  LAS bf16_t* Vs = Ks + 32 * LDN;
  LAS bf16_t* Mt = Vs + 32 * LDP;
  LAS bf16_t* At = Mt + 32 * LDP;
  LAS bf16_t* Tt = At + 32 * LDP;
  LAS bf16_t* Xt = Tt + 2 * 32 * LDT;
  LAS bf16_t* Rt = Xt + 160 * LDP;
  LAS bf16_t* Vn = Rt + 4 * 16 * LDP;
  LAS bf16_t* Vw = Vn + 32 * LDP;
  LAS bf16_t* St = Vw + 32 * LDP;
  LAS float* Md = (LAS float*)(St + 2 * 32 * LDN);
  LAS float* gL = Md + 2 * 256;
  LAS float* bL = gL + 32;
  const bf16_t* Z = WS(OFF_Z1, bf16_t); bf16_t* MIX = WS(OFF_MIX1, bf16_t); const float* DT = WS(OFF_DT, float);
  const float Aneg = -__expf(GIN(I_GALOG)[d * 8 + h]), dtb = GIN(I_GDTB)[d * 8 + h];
  const int colq = Z1_Q + h * 128, colk = Z1_K + h * 128, colv = Z1_V + h * 128 + vs * 32, outc = h * 128 + vs * 32;
  __syncthreads();
  for (int i = td; i < 71 * 1024 / 4; i += 256) ((LAS unsigned*)L)[i] = 0u;
  f32x4 Sacc[2][2];
#pragma unroll
  for (int a = 0; a < 2; ++a)
#pragma unroll
    for (int c = 0; c < 2; ++c) Sacc[a][c] = (f32x4){0.f, 0.f, 0.f, 0.f};
  const int st_t = td >> 3, st_s = td & 7;
  u32x4 rq[2], rk[2]; u32x2 rv; float ra = 0.f, rb = 0.f;
  auto issue_loads = [&](int step) {
    const int chunk = seq_chunk32(d, step); const size_t row = (size_t)b * TB + chunk * 32 + st_t;
    const u32x4* pq = (const u32x4*)(Z + row * Z1W + colq + st_s * 16); const u32x4* pk = (const u32x4*)(Z + row * Z1W + colk + st_s * 16);
    rq[0] = pq[0]; rq[1] = pq[1]; rk[0] = pk[0]; rk[1] = pk[1];
    rv = *(const u32x2*)(Z + row * Z1W + colv + st_s * 4);
    if (st_s == 0) { rb = DT[row * 32 + d * 8 + h]; ra = DT[row * 32 + 16 + d * 8 + h]; }
  };
  issue_loads(0);
  __syncthreads();
  LAS bf16_t* Rw = Rt + w * 16 * LDP;
  for (int step = 0; step < 264; ++step) {
    const int chunk = seq_chunk32(d, step); const int row0 = b * TB + chunk * 32;
    VMWAIT();
    { const int si = d ? 31 - st_t : st_t;
      LAS u32x4* dq = (LAS u32x4*)(Qs + si * LDN + st_s * 16); LAS u32x4* dk = (LAS u32x4*)(Ks + si * LDN + st_s * 16);
      dq[0] = rq[0]; dq[1] = rq[1]; dk[0] = rk[0]; dk[1] = rk[1];
      *(LAS u32x2*)(Vs + si * LDP + st_s * 4) = rv;
      if (st_s == 0) { gL[si] = Aneg * softplusf_(ra + dtb); bL[si] = sigmoidf_(rb); } }
    LBAR();
    if (step + 1 < 264) issue_loads(step + 1);
    const bool first = (d == 0) == fwd_first32(chunk);
    bf16_t* op; unsigned long long ppv = 0ull;
    { const int ii = 16 * (w >> 1) + fr; const int t = d ? 31 - ii : ii; op = MIX + (size_t)(row0 + t) * MIXW + outc + 16 * (w & 1) + 4 * fq; if (!first) ppv = ld_agent_u64(op); }
    const float cum = wave_incl_scan(lane < 32 ? gL[lane] : 0.f, lane);
    const float cum_last = __shfl(cum, 31);
    const LAS bf16_t* Sr = St + (step & 1) * 32 * LDN; LAS bf16_t* Sw = St + ((step + 1) & 1) * 32 * LDN;
    const int vt = w & 1, it = w >> 1;
    for (int job = w; job < 6; job += 4) {
      const int isq = job >= 3, tj = job - 3 * isq; const int I = tj >= 1 ? 1 : 0, J = tj == 2 ? 1 : 0;
      const LAS bf16_t* A = isq ? Qs : Ks;
      f32x4 acc = (f32x4){0.f, 0.f, 0.f, 0.f};
#pragma unroll
      for (int k = 0; k < 4; ++k) acc = mma16(frag_row(A, LDN, 16 * I, 32 * k, lane), frag_row(Ks, LDN, 16 * J, 32 * k, lane), acc);
      const int jj = 16 * J + fr; const float cj = __shfl(cum, jj); float pv[4];
#pragma unroll
      for (int r = 0; r < 4; ++r) { const int ii = 16 * I + 4 * fq + r; const float ci = __shfl(cum, ii); const float dec = __expf(ci - cj);
        if (isq) pv[r] = (jj <= ii) ? acc[r] * dec : 0.f;
        else { pv[r] = (jj < ii) ? acc[r] * dec * bL[ii] : 0.f; if (I == J) Md[I * 256 + (4 * fq + r) * 16 + fr] = pv[r]; } }
      u32x2 o; o.x = pk2(pv[0], pv[1]); o.y = pk2(pv[2], pv[3]);
      *(LAS u32x2*)((isq ? At : Mt) + jj * LDP + 16 * I + 4 * fq) = o;
    }
    f32x4 o2 = (f32x4){0.f, 0.f, 0.f, 0.f};
#pragma unroll
    for (int k = 0; k < 4; ++k) o2 = mma16(frag_row(Sr, LDN, 16 * vt, 32 * k, lane), frag_row(Qs, LDN, 16 * it, 32 * k, lane), o2);
    LBAR();
    if (w < 2) { const LAS float* M = Md + w * 256; const int c = lane & 15;
      float m[16];
#pragma unroll
      for (int q4 = 0; q4 < 4; ++q4) { const f32x4 t4 = *(const LAS f32x4*)(M + c * 16 + 4 * q4); m[4 * q4] = t4[0]; m[4 * q4 + 1] = t4[1]; m[4 * q4 + 2] = t4[2]; m[4 * q4 + 3] = t4[3]; }
      float T[16];
#pragma unroll
      for (int r = 0; r < 16; ++r) { float v = (r == c) ? 1.f : 0.f;
#pragma unroll
        for (int s2 = 0; s2 < r; ++s2) v -= __builtin_bit_cast(float, __builtin_amdgcn_readlane(__builtin_bit_cast(int, m[s2]), r)) * T[s2];
        T[r] = v; }
      if (lane < 16) { LAS u32x4* dst = (LAS u32x4*)(Tt + w * 32 * LDT + c * LDT);
        dst[0] = (u32x4){pk2(T[0], T[1]), pk2(T[2], T[3]), pk2(T[4], T[5]), pk2(T[6], T[7])};
        dst[1] = (u32x4){pk2(T[8], T[9]), pk2(T[10], T[11]), pk2(T[12], T[13]), pk2(T[14], T[15])}; } }
    LBAR();
    for (int ct = w; ct < 10; ct += 4) {
      const int cc = 16 * ct + fr;
      f32x4 rhs;
#pragma unroll
      for (int r = 0; r < 4; ++r) { const int ii = 4 * fq + r; const float bi = bL[ii];
        rhs[r] = ct < 2 ? bi * bf2f(Vs[ii * LDP + cc]) : bi * __expf(__shfl(cum, ii)) * bf2f(Ks[ii * LDN + cc - 32]); }
      { u32x2 o; o.x = pk2(rhs[0], rhs[1]); o.y = pk2(rhs[2], rhs[3]); *(LAS u32x2*)(Rw + fr * LDP + 4 * fq) = o; }
      asm volatile("s_waitcnt lgkmcnt(0)" ::: "memory");
      f32x4 x0 = mma16(frag_tr(Tt, LDT, 0, 0, lane), frag_row(Rw, LDP, 0, 0, lane), (f32x4){0.f, 0.f, 0.f, 0.f});
      { u32x2 o; o.x = pk2(x0[0], x0[1]); o.y = pk2(x0[2], x0[3]); *(LAS u32x2*)(Xt + cc * LDP + 4 * fq) = o; }
#pragma unroll
      for (int r = 0; r < 4; ++r) { const int ii = 16 + 4 * fq + r; const float bi = bL[ii];
        rhs[r] = ct < 2 ? bi * bf2f(Vs[ii * LDP + cc]) : bi * __expf(__shfl(cum, ii)) * bf2f(Ks[ii * LDN + cc - 32]); }
      asm volatile("s_waitcnt lgkmcnt(0)" ::: "memory");
      { bf16x8 fa = frag_tr(Mt, LDP, 0, 16, lane); if (fq >= 2) fa = (bf16x8){0, 0, 0, 0, 0, 0, 0, 0};
        bf16x8 fb = frag_row(Xt, LDP, 16 * ct, 0, lane); if (fq >= 2) fb = (bf16x8){0, 0, 0, 0, 0, 0, 0, 0};
        const f32x4 corr = mma16(fa, fb, (f32x4){0.f, 0.f, 0.f, 0.f});
        rhs = rhs - corr; }
      { u32x2 o; o.x = pk2(rhs[0], rhs[1]); o.y = pk2(rhs[2], rhs[3]); *(LAS u32x2*)(Rw + fr * LDP + 4 * fq) = o; }
      asm volatile("s_waitcnt lgkmcnt(0)" ::: "memory");
      f32x4 x1 = mma16(frag_tr(Tt + 32 * LDT, LDT, 0, 0, lane), frag_row(Rw, LDP, 0, 0, lane), (f32x4){0.f, 0.f, 0.f, 0.f});
      { u32x2 o; o.x = pk2(x1[0], x1[1]); o.y = pk2(x1[2], x1[3]); *(LAS u32x2*)(Xt + cc * LDP + 16 + 4 * fq) = o; }
    }
    LBAR();
    { f32x4 ws = (f32x4){0.f, 0.f, 0.f, 0.f};
#pragma unroll
      for (int k = 0; k < 4; ++k) ws = mma16(frag_tr(Xt + 32 * LDP, LDP, 32 * k, 16 * it, lane), frag_row(Sr, LDN, 16 * vt, 32 * k, lane), ws);
      const u32x2 uu = *(const LAS u32x2*)(Xt + (16 * vt + fr) * LDP + 16 * it + 4 * fq);
      float vn[4] = {bflo(uu.x) - ws[0], bfhi(uu.x) - ws[1], bflo(uu.y) - ws[2], bfhi(uu.y) - ws[3]};
      float vw[4];
#pragma unroll
      for (int r = 0; r < 4; ++r) vw[r] = vn[r] * __expf(cum_last - __shfl(cum, 16 * it + 4 * fq + r));
      u32x2 o; o.x = pk2(vn[0], vn[1]); o.y = pk2(vn[2], vn[3]); *(LAS u32x2*)(Vn + (16 * vt + fr) * LDP + 16 * it + 4 * fq) = o;
      o.x = pk2(vw[0], vw[1]); o.y = pk2(vw[2], vw[3]); *(LAS u32x2*)(Vw + (16 * vt + fr) * LDP + 16 * it + 4 * fq) = o; }
    LBAR();
    { const f32x4 o1 = mma16(frag_row(Vn, LDP, 16 * vt, 0, lane), frag_tr(At, LDP, 0, 16 * it, lane), (f32x4){0.f, 0.f, 0.f, 0.f});
      const int ii = 16 * it + fr; const float eci = __expf(__shfl(cum, ii));
      float o0 = o1[0] + eci * o2[0], o1v = o1[1] + eci * o2[1], o2v = o1[2] + eci * o2[2], o3 = o1[3] + eci * o2[3];
      if (!first) { const unsigned long long pv = ppv; const unsigned lo = (unsigned)pv, hi = (unsigned)(pv >> 32); o0 += bflo(lo); o1v += bfhi(lo); o2v += bflo(hi); o3 += bfhi(hi); }
      u32x2 o; o.x = pk2(o0, o1v); o.y = pk2(o2v, o3); *(u32x2*)op = o; }
    { const float el = __expf(cum_last);
#pragma unroll
      for (int a = 0; a < 2; ++a) { const int kt = 2 * w + a; const bf16x8 fa = frag_tr(Ks, LDN, 0, 16 * kt, lane);
#pragma unroll
        for (int c = 0; c < 2; ++c) { f32x4 acc = mma16(fa, frag_row(Vw, LDP, 16 * c, 0, lane), Sacc[a][c] * el);
          Sacc[a][c] = acc;
          u32x2 o; o.x = pk2(acc[0], acc[1]); o.y = pk2(acc[2], acc[3]);
          *(LAS u32x2*)(Sw + (16 * c + fr) * LDN + 16 * kt + 4 * fq) = o; } } }
    LBAR();
  }
}

__device__ __forceinline__ bf16x8 ldfr(const LAS bf16_t* p) { return *(const LAS bf16x8*)p; }
__device__ __forceinline__ bf16x8 ldft(const LAS bf16_t* p, int ld) {
  const s16x4 v0 = __builtin_amdgcn_ds_read_tr16_b64_v4i16((LAS s16x4*)p);
  const s16x4 v1 = __builtin_amdgcn_ds_read_tr16_b64_v4i16((LAS s16x4*)(p + 4 * ld));
  bf16x8 r; r[0] = v0[0]; r[1] = v0[1]; r[2] = v0[2]; r[3] = v0[3]; r[4] = v1[0]; r[5] = v1[1]; r[6] = v1[2]; r[7] = v1[3];
  return r;
}
__device__ __forceinline__ u32x2 pk4(float a, float b, float c, float dd) { u32x2 o; o.x = pg8::cvt_pk_bf16(a, b); o.y = pg8::cvt_pk_bf16(c, dd); return o; }
__device__ __forceinline__ float bcast_lane(float v, int l) { return __builtin_bit_cast(float, __builtin_amdgcn_readlane(__builtin_bit_cast(int, v), l)); }

__device__ __forceinline__ void gdn2_chain_wg(const Params& P, const Ctx& C, int task) {
  const int b = task >> 5, h = (task >> 2) & 7, vs = task & 3;
  const int d = C.wave >> 2, w = ((C.wave & 3) + 2 * d) & 3, td = C.tid & 255, lane = C.lane, fr = lane & 15, fq = lane >> 4;
  constexpr int LDN = 136, LDP = 40, LDT = 24;
  constexpr int DIRSZ = 64 * 1024;
  LAS unsigned char* L = C.lds + d * DIRSZ;
  LAS bf16_t* Qs = (LAS bf16_t*)L;
  LAS bf16_t* Ks = Qs + 32 * LDN;
  LAS bf16_t* Vt = Ks + 32 * LDN;
  LAS bf16_t* Mt = Vt + 32 * LDP;
  LAS bf16_t* At = Mt + 32 * LDP;
  LAS bf16_t* Rt = At + 32 * LDP;
  LAS bf16_t* Vn = Rt + 32 * LDP;
  LAS bf16_t* Vw = Vn + 32 * LDP;
  LAS bf16_t* Tt = Vw + 32 * LDP;
  LAS bf16_t* St = Tt + 2 * 32 * LDT;
  LAS float* Md = (LAS float*)(St + 2 * 32 * LDN);
  LAS float* gL = Md + 512;
  LAS float* bL = gL + 32; LAS float* becL = bL;
  LAS float* ecL = bL + 32 + (C.wave & 3) * 96; LAS float* encL = ecL + 32; LAS float* ewL = encL + 32;
  const bf16_t* Z = WS(OFF_Z1, bf16_t); bf16_t* MIX = WS(OFF_MIX1, bf16_t); const float* DT = WS(OFF_DT, float);
  const float Aneg = -__expf(GIN(I_GALOG)[d * 8 + h]), dtb = GIN(I_GDTB)[d * 8 + h];
  const int colq = Z1_Q + h * 128, colk = Z1_K + h * 128, colv = Z1_V + h * 128 + vs * 32, outc = h * 128 + vs * 32;
  __syncthreads();
  for (int i = td; i < 58 * 1024 / 4; i += 256) ((LAS unsigned*)L)[i] = 0u;
  f32x4 Sacc[2][2];
#pragma unroll
  for (int a = 0; a < 2; ++a)
#pragma unroll
    for (int c = 0; c < 2; ++c) Sacc[a][c] = (f32x4){0.f, 0.f, 0.f, 0.f};
  const int st_t = td >> 3, st_s = td & 7;
  u32x4 rq[2], rk[2]; u32x2 rv; float ra = 0.f, rb = 0.f;
  auto issue_loads = [&](int step) {
    const int chunk = seq_chunk32(d, step); const size_t row = (size_t)b * TB + chunk * 32 + st_t;
    const u32x4* pq = (const u32x4*)(Z + row * Z1W + colq + st_s * 16); const u32x4* pk = (const u32x4*)(Z + row * Z1W + colk + st_s * 16);
    rq[0] = pq[0]; rq[1] = pq[1]; rk[0] = pk[0]; rk[1] = pk[1];
    rv = *(const u32x2*)(Z + row * Z1W + colv + st_s * 4);
    if (st_s == 0) { rb = DT[row * 32 + d * 8 + h]; ra = DT[row * 32 + 16 + d * 8 + h]; }
  };
  issue_loads(0);
  __syncthreads();
  const int rL136 = fr * LDN + 8 * fq, rL40 = fr * LDP + 8 * fq;
  const int tq = fr >> 2, tp = fr & 3;
  const int tL136 = (8 * fq + tq) * LDN + 4 * tp, tL40 = (8 * fq + tq) * LDP + 4 * tp, tL24 = (8 * fq + tq) * LDT + 4 * tp;
  const int it = w >> 1, vt = w & 1;
  const int si = d ? 31 - st_t : st_t;
  LAS u32x4* stq = (LAS u32x4*)(Qs + si * LDN + st_s * 16); LAS u32x4* stk = (LAS u32x4*)(Ks + si * LDN + st_s * 16);
  LAS bf16_t* stv = Vt + (st_s * 4) * LDP + si;
  const LAS bf16_t* pK_it = Ks + 16 * it * LDN + rL136; const LAS bf16_t* pQ_it = Qs + 16 * it * LDN + rL136;
  for (int step = 0; step < 264; ++step) {
    const int chunk = seq_chunk32(d, step); const int row0 = b * TB + chunk * 32;
    VMWAIT();
    stq[0] = rq[0]; stq[1] = rq[1]; stk[0] = rk[0]; stk[1] = rk[1];
    stv[0] = (bf16_t)(rv.x & 0xffffu); stv[LDP] = (bf16_t)(rv.x >> 16); stv[2 * LDP] = (bf16_t)(rv.y & 0xffffu); stv[3 * LDP] = (bf16_t)(rv.y >> 16);
    if (st_s == 0) { gL[si] = Aneg * softplusf_(ra + dtb); bL[si] = fast_sigmoid(rb); }
    LBAR();
    if (step + 1 < 264) issue_loads(step + 1);
    const bool first = (d == 0) == fwd_first32(chunk);
    bf16_t* op; unsigned long long ppv = 0ull;
    { const int ii = 16 * it + fr; const int t = d ? 31 - ii : ii; op = MIX + (size_t)(row0 + t) * MIXW + outc + 16 * vt + 4 * fq; if (!first) ppv = ld_agent_u64(op); }
    float elast;
    { const float c = wave_incl_scan(lane < 32 ? gL[lane & 31] : 0.f, lane); const float cl = bcast_lane(c, 31); elast = __expf(cl);
      if (lane < 32) { const float ec = __expf(c); ecL[lane] = ec; encL[lane] = c; ewL[lane] = __expf(cl - c); } }
    asm volatile("s_waitcnt lgkmcnt(0)" ::: "memory");
    const LAS bf16_t* Sr = St + (step & 1) * 32 * LDN; LAS bf16_t* Sw = St + ((step + 1) & 1) * 32 * LDN;
    f32x4 o2 = (f32x4){0.f, 0.f, 0.f, 0.f};
    { f32x4 ks = (f32x4){0.f, 0.f, 0.f, 0.f};
      const LAS bf16_t* pS = Sr + 16 * vt * LDN + rL136;
#pragma unroll
      for (int k = 0; k < 4; ++k) { const bf16x8 fs = ldfr(pS + 32 * k); ks = mma16(ldfr(pK_it + 32 * k), fs, ks); o2 = mma16(fs, ldfr(pQ_it + 32 * k), o2); }
      const u32x2 vv = *(const LAS u32x2*)(Vt + (16 * vt + fr) * LDP + 16 * it + 4 * fq);
      const f32x4 ec4 = *(const LAS f32x4*)(ecL + 16 * it + 4 * fq), b4 = *(const LAS f32x4*)(bL + 16 * it + 4 * fq);
      *(LAS u32x2*)(Rt + (16 * vt + fr) * LDP + 16 * it + 4 * fq) =
        pk4(b4[0] * (bflo(vv.x) - ec4[0] * ks[0]), b4[1] * (bfhi(vv.x) - ec4[1] * ks[1]), b4[2] * (bflo(vv.y) - ec4[2] * ks[2]), b4[3] * (bfhi(vv.y) - ec4[3] * ks[3])); }
    { const int isq = w & 1; const LAS bf16_t* A = isq ? Qs : Ks;
      const int njobs = w < 2 ? 1 : 2;
      for (int jb = 0; jb < njobs; ++jb) {
        const int I = (w < 2) ? 1 : jb, J = (w < 2) ? 1 : 0;
        f32x4 acc = (f32x4){0.f, 0.f, 0.f, 0.f};
        const LAS bf16_t* pa = A + 16 * I * LDN + rL136; const LAS bf16_t* pb = Ks + 16 * J * LDN + rL136;
#pragma unroll
        for (int k = 0; k < 4; ++k) acc = mma16(ldfr(pa + 32 * k), ldfr(pb + 32 * k), acc);
        const int jj = 16 * J + fr, i0 = 16 * I + 4 * fq; const float cj = encL[jj];
        const f32x4 c4 = *(const LAS f32x4*)(encL + i0); const f32x4 b4 = *(const LAS f32x4*)(becL + i0);
        float pv[4];
#pragma unroll
        for (int r = 0; r < 4; ++r) { const bool keep = isq ? (jj <= i0 + r) : (jj < i0 + r); const float sc = isq ? 1.f : b4[r];
          pv[r] = keep ? acc[r] * sc * __expf(c4[r] - cj) : 0.f; }
        if (!isq && I == J) { LAS float* md = Md + I * 256 + (4 * fq) * 16 + fr; md[0] = pv[0]; md[16] = pv[1]; md[32] = pv[2]; md[48] = pv[3]; }
        *(LAS u32x2*)((isq ? At : Mt) + jj * LDP + i0) = pk4(pv[0], pv[1], pv[2], pv[3]);
      } }
    LBAR();
    if (w < 2) { const LAS float* M = Md + w * 256; const int c = fr;
      float m[16];
#pragma unroll
      for (int q4 = 0; q4 < 4; ++q4) { const f32x4 t4 = *(const LAS f32x4*)(M + c * 16 + 4 * q4); m[4 * q4] = t4[0]; m[4 * q4 + 1] = t4[1]; m[4 * q4 + 2] = t4[2]; m[4 * q4 + 3] = t4[3]; }
      float T[16];
#pragma unroll
      for (int r = 0; r < 16; ++r) { float v = (r == c) ? 1.f : 0.f;
#pragma unroll
        for (int s2 = 0; s2 < r; ++s2) v -= bcast_lane(m[s2], r) * T[s2];
        T[r] = v; }
      if (lane < 16) { LAS u32x4* dst = (LAS u32x4*)(Tt + w * 32 * LDT + c * LDT);
        dst[0] = (u32x4){pg8::cvt_pk_bf16(T[0], T[1]), pg8::cvt_pk_bf16(T[2], T[3]), pg8::cvt_pk_bf16(T[4], T[5]), pg8::cvt_pk_bf16(T[6], T[7])};
        dst[1] = (u32x4){pg8::cvt_pk_bf16(T[8], T[9]), pg8::cvt_pk_bf16(T[10], T[11]), pg8::cvt_pk_bf16(T[12], T[13]), pg8::cvt_pk_bf16(T[14], T[15])}; } }
    LBAR();
    if (w < 2) { const int ct = w; const int cc = 16 * ct + fr;
      const f32x4 x0 = mma16(ldft(Tt + tL24, LDT), ldfr(Rt + 16 * ct * LDP + rL40), (f32x4){0.f, 0.f, 0.f, 0.f});
      const f32x4 ew0 = *(const LAS f32x4*)(ewL + 4 * fq);
      *(LAS u32x2*)(Vn + cc * LDP + 4 * fq) = pk4(x0[0], x0[1], x0[2], x0[3]);
      *(LAS u32x2*)(Vw + cc * LDP + 4 * fq) = pk4(x0[0] * ew0[0], x0[1] * ew0[1], x0[2] * ew0[2], x0[3] * ew0[3]);
      const u32x2 r1 = *(const LAS u32x2*)(Rt + cc * LDP + 16 + 4 * fq);
      asm volatile("s_waitcnt lgkmcnt(0)" ::: "memory");
      bf16x8 fa = ldft(Mt + tL40 + 16, LDP); bf16x8 fb = ldfr(Vn + 16 * ct * LDP + rL40);
      if (fq >= 2) { fa = (bf16x8){0, 0, 0, 0, 0, 0, 0, 0}; fb = (bf16x8){0, 0, 0, 0, 0, 0, 0, 0}; }
      const f32x4 corr = mma16(fa, fb, (f32x4){0.f, 0.f, 0.f, 0.f});
      *(LAS u32x2*)(Rt + cc * LDP + 16 + 4 * fq) = pk4(bflo(r1.x) - corr[0], bfhi(r1.x) - corr[1], bflo(r1.y) - corr[2], bfhi(r1.y) - corr[3]);
      asm volatile("s_waitcnt lgkmcnt(0)" ::: "memory");
      const f32x4 x1 = mma16(ldft(Tt + 32 * LDT + tL24, LDT), ldfr(Rt + 16 * ct * LDP + 16 + rL40), (f32x4){0.f, 0.f, 0.f, 0.f});
      const f32x4 ew1 = *(const LAS f32x4*)(ewL + 16 + 4 * fq);
      *(LAS u32x2*)(Vn + cc * LDP + 16 + 4 * fq) = pk4(x1[0], x1[1], x1[2], x1[3]);
      *(LAS u32x2*)(Vw + cc * LDP + 16 + 4 * fq) = pk4(x1[0] * ew1[0], x1[1] * ew1[1], x1[2] * ew1[2], x1[3] * ew1[3]); }
    LBAR();
    { const f32x4 o1 = mma16(ldfr(Vn + 16 * vt * LDP + rL40), ldft(At + tL40 + 16 * it, LDP), (f32x4){0.f, 0.f, 0.f, 0.f});
      const float eci = ecL[16 * it + fr];
      float o0 = o1[0] + eci * o2[0], o1v = o1[1] + eci * o2[1], o2v = o1[2] + eci * o2[2], o3 = o1[3] + eci * o2[3];
      if (!first) { const unsigned lo = (unsigned)ppv, hi = (unsigned)(ppv >> 32); o0 += bflo(lo); o1v += bfhi(lo); o2v += bflo(hi); o3 += bfhi(hi); }
      *(u32x2*)op = pk4(o0, o1v, o2v, o3); }
    { const bf16x8 fv0 = ldfr(Vw + rL40), fv1 = ldfr(Vw + 16 * LDP + rL40);
#pragma unroll
      for (int a = 0; a < 2; ++a) { const int kt = 2 * w + a; const bf16x8 fa = ldft(Ks + tL136 + 16 * kt, LDN);
        f32x4 a0 = mma16(fa, fv0, Sacc[a][0] * elast), a1 = mma16(fa, fv1, Sacc[a][1] * elast);
        Sacc[a][0] = a0; Sacc[a][1] = a1;
        *(LAS u32x2*)(Sw + fr * LDN + 16 * kt + 4 * fq) = pk4(a0[0], a0[1], a0[2], a0[3]);
        *(LAS u32x2*)(Sw + (16 + fr) * LDN + 16 * kt + 4 * fq) = pk4(a1[0], a1[1], a1[2], a1[3]); } }
    LBAR();
  }
}

__device__ __forceinline__ void gdn3_chain_wg(const Params& P, const Ctx& C, int task) {
  const int b = task >> 5, h = (task >> 2) & 7, vs = task & 3;
  const int d = C.wave >> 2, w = ((C.wave & 3) + 2 * d) & 3, td = C.tid & 255, lane = C.lane, fr = lane & 15, fq = lane >> 4;
  constexpr int LDN = 136, LDP = 40, LDT = 24;
  constexpr int DIRSZ = 64 * 1024;
  LAS unsigned char* L = C.lds + d * DIRSZ;
  LAS bf16_t* Qs = (LAS bf16_t*)L;
  LAS bf16_t* Ks = Qs + 32 * LDN;
  LAS bf16_t* Vt = Ks + 32 * LDN;
  LAS bf16_t* Mt = Vt + 32 * LDP;
  LAS bf16_t* At = Mt + 32 * LDP;
  LAS bf16_t* Rt = At + 32 * LDP;
  LAS bf16_t* Vn = Rt + 32 * LDP;
  LAS bf16_t* Vw = Vn + 32 * LDP;
  LAS bf16_t* Tt = Vw + 32 * LDP;
  LAS bf16_t* St = Tt + 2 * 32 * LDT;
  LAS float* Md = (LAS float*)(St + 2 * 32 * LDN);
  LAS float* gL = Md + 512;
  LAS float* bL = gL + 32; LAS float* becL = bL;
  LAS float* ecL = bL + 32 + (C.wave & 3) * 96; LAS float* encL = ecL + 32; LAS float* ewL = encL + 32;
  LAS f32x4* O2x = (LAS f32x4*)(bL + 32 + 4 * 96);
  const bf16_t* Z = WS(OFF_Z1, bf16_t); bf16_t* MIX = WS(OFF_MIX1, bf16_t); const float* DT = WS(OFF_DT, float);
  const float Aneg = -__expf(GIN(I_GALOG)[d * 8 + h]), dtb = GIN(I_GDTB)[d * 8 + h];
  const int colq = Z1_Q + h * 128, colk = Z1_K + h * 128, colv = Z1_V + h * 128 + vs * 32, outc = h * 128 + vs * 32;
  __syncthreads();
  for (int i = td; i < 60 * 1024 / 4; i += 256) ((LAS unsigned*)L)[i] = 0u;
  f32x4 Sacc[2][2];
#pragma unroll
  for (int a = 0; a < 2; ++a)
#pragma unroll
    for (int c = 0; c < 2; ++c) Sacc[a][c] = (f32x4){0.f, 0.f, 0.f, 0.f};
  const int st_t = td >> 3, st_s = td & 7;
  u32x4 rq[2], rk[2]; u32x2 rv; float ra = 0.f, rb = 0.f;
  auto issue_loads = [&](int step) {
    const int chunk = seq_chunk32(d, step); const size_t row = (size_t)b * TB + chunk * 32 + st_t;
    const u32x4* pq = (const u32x4*)(Z + row * Z1W + colq + st_s * 16); const u32x4* pk = (const u32x4*)(Z + row * Z1W + colk + st_s * 16);
    rq[0] = pq[0]; rq[1] = pq[1]; rk[0] = pk[0]; rk[1] = pk[1];
    rv = *(const u32x2*)(Z + row * Z1W + colv + st_s * 4);
    if (st_s == 0) { rb = DT[row * 32 + d * 8 + h]; ra = DT[row * 32 + 16 + d * 8 + h]; }
  };
  issue_loads(0);
  __syncthreads();
  const int rL136 = fr * LDN + 8 * fq, rL40 = fr * LDP + 8 * fq;
  const int tq = fr >> 2, tp = fr & 3;
  const int tL136 = (8 * fq + tq) * LDN + 4 * tp, tL40 = (8 * fq + tq) * LDP + 4 * tp, tL24 = (8 * fq + tq) * LDT + 4 * tp;
  const int it = w >> 1, vt = w & 1;
  const int si = d ? 31 - st_t : st_t;
  LAS u32x4* stq = (LAS u32x4*)(Qs + si * LDN + st_s * 16); LAS u32x4* stk = (LAS u32x4*)(Ks + si * LDN + st_s * 16);
  LAS bf16_t* stv = Vt + (st_s * 4) * LDP + si;
  const LAS bf16_t* pK_it = Ks + 16 * it * LDN + rL136; const LAS bf16_t* pQ_it = Qs + 16 * it * LDN + rL136;
  for (int step = 0; step < 264; ++step) {
    const int chunk = seq_chunk32(d, step); const int row0 = b * TB + chunk * 32;
    VMWAIT();
    stq[0] = rq[0]; stq[1] = rq[1]; stk[0] = rk[0]; stk[1] = rk[1];
    stv[0] = (bf16_t)(rv.x & 0xffffu); stv[LDP] = (bf16_t)(rv.x >> 16); stv[2 * LDP] = (bf16_t)(rv.y & 0xffffu); stv[3 * LDP] = (bf16_t)(rv.y >> 16);
    if (st_s == 0) { gL[si] = Aneg * softplusf_(ra + dtb); bL[si] = fast_sigmoid(rb); }
    LBAR();
    if (step + 1 < 264) issue_loads(step + 1);
    const bool first = (d == 0) == fwd_first32(chunk);
    bf16_t* op; unsigned long long ppv = 0ull;
    { const int ii = 16 * it + fr; const int t = d ? 31 - ii : ii; op = MIX + (size_t)(row0 + t) * MIXW + outc + 16 * vt + 4 * fq; if (!first) ppv = ld_agent_u64(op); }
    float elast;
    { const float c = wave_incl_scan(lane < 32 ? gL[lane & 31] : 0.f, lane); const float cl = bcast_lane(c, 31); elast = __expf(cl);
      if (lane < 32) { const float ec = __expf(c); ecL[lane] = ec; encL[lane] = c; ewL[lane] = __expf(cl - c); } }
    asm volatile("s_waitcnt lgkmcnt(0)" ::: "memory");
    const LAS bf16_t* Sr = St + (step & 1) * 32 * LDN; LAS bf16_t* Sw = St + ((step + 1) & 1) * 32 * LDN;
    f32x4 o2 = (f32x4){0.f, 0.f, 0.f, 0.f};
    if (w < 2) {
      f32x4 acc = (f32x4){0.f, 0.f, 0.f, 0.f};
      { const LAS bf16_t* pk = Ks + 16 * w * LDN + rL136;
#pragma unroll
        for (int k = 0; k < 4; ++k) { const bf16x8 f = ldfr(pk + 32 * k); acc = mma16(f, f, acc); } }
      { const int jj = 16 * w + fr, i0 = 16 * w + 4 * fq; const float cj = encL[jj];
        const f32x4 c4 = *(const LAS f32x4*)(encL + i0); const f32x4 b4 = *(const LAS f32x4*)(becL + i0);
        LAS float* md = Md + w * 256 + (4 * fq) * 16 + fr;
#pragma unroll
        for (int r = 0; r < 4; ++r) md[16 * r] = (jj < i0 + r) ? acc[r] * b4[r] * __expf(c4[r] - cj) : 0.f; }
      asm volatile("s_waitcnt lgkmcnt(0)" ::: "memory");
      const LAS float* M = Md + w * 256; const int c = fr;
      float m[16];
#pragma unroll
      for (int q4 = 0; q4 < 4; ++q4) { const f32x4 t4 = *(const LAS f32x4*)(M + c * 16 + 4 * q4); m[4 * q4] = t4[0]; m[4 * q4 + 1] = t4[1]; m[4 * q4 + 2] = t4[2]; m[4 * q4 + 3] = t4[3]; }
      float T[16];
#pragma unroll
      for (int r = 0; r < 16; ++r) { float v = (r == c) ? 1.f : 0.f;
#pragma unroll
        for (int s2 = 0; s2 < r; ++s2) v -= bcast_lane(m[s2], r) * T[s2];
        T[r] = v; }
      if (lane < 16) { LAS u32x4* dst = (LAS u32x4*)(Tt + w * 32 * LDT + c * LDT);
        dst[0] = (u32x4){pk2(T[0], T[1]), pk2(T[2], T[3]), pk2(T[4], T[5]), pk2(T[6], T[7])};
        dst[1] = (u32x4){pk2(T[8], T[9]), pk2(T[10], T[11]), pk2(T[12], T[13]), pk2(T[14], T[15])}; }
    } else {
      const int pvt = w & 1;
#pragma unroll
      for (int pit = 1; pit >= 0; --pit) {
        f32x4 ks = (f32x4){0.f, 0.f, 0.f, 0.f}, qs = (f32x4){0.f, 0.f, 0.f, 0.f};
        const LAS bf16_t* pS = Sr + 16 * pvt * LDN + rL136; const LAS bf16_t* pK = Ks + 16 * pit * LDN + rL136; const LAS bf16_t* pQ = Qs + 16 * pit * LDN + rL136;
#pragma unroll
        for (int k = 0; k < 4; ++k) { const bf16x8 fs = ldfr(pS + 32 * k); ks = mma16(ldfr(pK + 32 * k), fs, ks); qs = mma16(fs, ldfr(pQ + 32 * k), qs); }
        const u32x2 vv = *(const LAS u32x2*)(Vt + (16 * pvt + fr) * LDP + 16 * pit + 4 * fq);
        const f32x4 ec4 = *(const LAS f32x4*)(ecL + 16 * pit + 4 * fq), b4 = *(const LAS f32x4*)(bL + 16 * pit + 4 * fq);
        *(LAS u32x2*)(Rt + (16 * pvt + fr) * LDP + 16 * pit + 4 * fq) =
          pk4(b4[0] * (bflo(vv.x) - ec4[0] * ks[0]), b4[1] * (bfhi(vv.x) - ec4[1] * ks[1]), b4[2] * (bflo(vv.y) - ec4[2] * ks[2]), b4[3] * (bfhi(vv.y) - ec4[3] * ks[3]));
        if (pit == 1) o2 = qs; else O2x[pvt * 64 + lane] = qs;
      }
#pragma unroll
      for (int jb = 0; jb < 2; ++jb) {
        const bool isq = (w == 3) || (jb == 1);
        const int I = (w == 2) ? 1 : jb, J = (w == 2) ? 0 : jb;
        f32x4 acc = (f32x4){0.f, 0.f, 0.f, 0.f};
        const LAS bf16_t* pa = (isq ? Qs : Ks) + 16 * I * LDN + rL136; const LAS bf16_t* pb = Ks + 16 * J * LDN + rL136;
#pragma unroll
        for (int k = 0; k < 4; ++k) acc = mma16(ldfr(pa + 32 * k), ldfr(pb + 32 * k), acc);
        const int jj = 16 * J + fr, i0 = 16 * I + 4 * fq; const float cj = encL[jj];
        const f32x4 c4 = *(const LAS f32x4*)(encL + i0); const f32x4 b4 = *(const LAS f32x4*)(becL + i0);
        float pv[4];
#pragma unroll
        for (int r = 0; r < 4; ++r) { const bool keep = isq ? (jj <= i0 + r) : (jj < i0 + r); const float sc = isq ? 1.f : b4[r];
          pv[r] = keep ? acc[r] * sc * __expf(c4[r] - cj) : 0.f; }
        *(LAS u32x2*)((isq ? At : Mt) + jj * LDP + i0) = pk4(pv[0], pv[1], pv[2], pv[3]);
      }
    }
    LBAR();
    if (w < 2) { const int ct = w; const int cc = 16 * ct + fr;
      const f32x4 x0 = mma16(ldft(Tt + tL24, LDT), ldfr(Rt + 16 * ct * LDP + rL40), (f32x4){0.f, 0.f, 0.f, 0.f});
      const f32x4 ew0 = *(const LAS f32x4*)(ewL + 4 * fq);
      *(LAS u32x2*)(Vn + cc * LDP + 4 * fq) = pk4(x0[0], x0[1], x0[2], x0[3]);
      *(LAS u32x2*)(Vw + cc * LDP + 4 * fq) = pk4(x0[0] * ew0[0], x0[1] * ew0[1], x0[2] * ew0[2], x0[3] * ew0[3]);
      const u32x2 r1 = *(const LAS u32x2*)(Rt + cc * LDP + 16 + 4 * fq);
      asm volatile("s_waitcnt lgkmcnt(0)" ::: "memory");
      bf16x8 fa = ldft(Mt + tL40 + 16, LDP); bf16x8 fb = ldfr(Vn + 16 * ct * LDP + rL40);
      if (fq >= 2) { fa = (bf16x8){0, 0, 0, 0, 0, 0, 0, 0}; fb = (bf16x8){0, 0, 0, 0, 0, 0, 0, 0}; }
      const f32x4 corr = mma16(fa, fb, (f32x4){0.f, 0.f, 0.f, 0.f});
      *(LAS u32x2*)(Rt + cc * LDP + 16 + 4 * fq) = pk4(bflo(r1.x) - corr[0], bfhi(r1.x) - corr[1], bflo(r1.y) - corr[2], bfhi(r1.y) - corr[3]);
      asm volatile("s_waitcnt lgkmcnt(0)" ::: "memory");
      const f32x4 x1 = mma16(ldft(Tt + 32 * LDT + tL24, LDT), ldfr(Rt + 16 * ct * LDP + 16 + rL40), (f32x4){0.f, 0.f, 0.f, 0.f});
      const f32x4 ew1 = *(const LAS f32x4*)(ewL + 16 + 4 * fq);
      *(LAS u32x2*)(Vn + cc * LDP + 16 + 4 * fq) = pk4(x1[0], x1[1], x1[2], x1[3]);
      *(LAS u32x2*)(Vw + cc * LDP + 16 + 4 * fq) = pk4(x1[0] * ew1[0], x1[1] * ew1[1], x1[2] * ew1[2], x1[3] * ew1[3]); }
    LBAR();
    if (w < 2) o2 = O2x[w * 64 + lane];
    { const f32x4 o1 = mma16(ldfr(Vn + 16 * vt * LDP + rL40), ldft(At + tL40 + 16 * it, LDP), (f32x4){0.f, 0.f, 0.f, 0.f});
      const float eci = ecL[16 * it + fr];
      float o0 = o1[0] + eci * o2[0], o1v = o1[1] + eci * o2[1], o2v = o1[2] + eci * o2[2], o3 = o1[3] + eci * o2[3];
      if (!first) { const unsigned lo = (unsigned)ppv, hi = (unsigned)(ppv >> 32); o0 += bflo(lo); o1v += bfhi(lo); o2v += bflo(hi); o3 += bfhi(hi); }
      *(u32x2*)op = pk4(o0, o1v, o2v, o3); }
    { const bf16x8 fv0 = ldfr(Vw + rL40), fv1 = ldfr(Vw + 16 * LDP + rL40);
#pragma unroll
      for (int a = 0; a < 2; ++a) { const int kt = 2 * w + a; const bf16x8 fa = ldft(Ks + tL136 + 16 * kt, LDN);
        f32x4 a0 = mma16(fa, fv0, Sacc[a][0] * elast), a1 = mma16(fa, fv1, Sacc[a][1] * elast);
        Sacc[a][0] = a0; Sacc[a][1] = a1;
        *(LAS u32x2*)(Sw + fr * LDN + 16 * kt + 4 * fq) = pk4(a0[0], a0[1], a0[2], a0[3]);
        *(LAS u32x2*)(Sw + (16 + fr) * LDN + 16 * kt + 4 * fq) = pk4(a1[0], a1[1], a1[2], a1[3]); } }
    LBAR();
  }
}

__device__ __forceinline__ void hgrn2_chain_wg(const Params& P, const Ctx& C, int task) {
  const int b = task >> 5, h = (task >> 2) & 7, vs = task & 3;
  const int d = C.wave >> 2, w = C.wave & 3, td = C.tid & 255, lane = C.lane, fr = lane & 15, fq = lane >> 4;
  constexpr int LDN = 136, LDP = 40;
  constexpr int DIRSZ = 72 * 1024;
  LAS unsigned char* L = C.lds + d * DIRSZ;
  LAS bf16_t* Qt = (LAS bf16_t*)L;
  LAS bf16_t* Kh = Qt + 32 * LDN;
  LAS bf16_t* Kw = Kh + 32 * LDN;
  LAS bf16_t* Vs = Kw + 32 * LDN;
  LAS bf16_t* Pt = Vs + 32 * LDP;
  LAS bf16_t* St = Pt + 32 * LDP;
  LAS float* PR = (LAS float*)(St + 2 * 32 * LDN);
  LAS float* PL = PR + 32 * 128;
  const bf16_t* Z = WS(OFF_Z1, bf16_t); bf16_t* MIX = WS(OFF_MIX1, bf16_t);
  const int colq = Z1_HQ + h * 128, colf = Z1_HF + d * 1024 + h * 128, colv = Z1_HI + h * 128 + vs * 32, outc = 1024 + h * 128 + vs * 32;
  __syncthreads();
  for (int i = td; i < 32 * LDP / 2; i += 256) ((LAS unsigned*)Pt)[i] = 0u;
  for (int i = td; i < 2 * 32 * LDN / 2; i += 256) ((LAS unsigned*)St)[i] = 0u;
  f32x4 Sacc[2][2];
#pragma unroll
  for (int a = 0; a < 2; ++a)
#pragma unroll
    for (int c = 0; c < 2; ++c) Sacc[a][c] = (f32x4){0.f, 0.f, 0.f, 0.f};
  const int st_t = td >> 3, st_s = td & 7;
  float lbv[16];
#pragma unroll
  for (int e = 0; e < 16; ++e) lbv[e] = WS(OFF_LB1, float)[h * 128 + st_s * 16 + e];
  u32x4 rq[2], rf[2]; u32x2 rv;
  auto issue_loads = [&](int step) {
    const int chunk = seq_chunk32(d, step); const size_t row = (size_t)b * TB + chunk * 32 + st_t;
    const u32x4* pq = (const u32x4*)(Z + row * Z1W + colq + st_s * 16); const u32x4* pf = (const u32x4*)(Z + row * Z1W + colf + st_s * 16);
    rq[0] = pq[0]; rq[1] = pq[1]; rf[0] = pf[0]; rf[1] = pf[1];
    rv = *(const u32x2*)(Z + row * Z1W + colv + st_s * 4);
  };
  issue_loads(0);
  __syncthreads();
  const int rL136 = fr * LDN + 8 * fq;
  const int tq = fr >> 2, tp = fr & 3;
  const int tL136 = (8 * fq + tq) * LDN + 4 * tp, tL40 = (8 * fq + tq) * LDP + 4 * tp;
  const int vt = w & 1, it = w >> 1;
  const int si = d ? 31 - st_t : st_t;
  LAS float* prow = PR + si * 128 + st_s * 16;
  LAS float* pscan = PR + (td >> 7) * 16 * 128 + (td & 127);
  for (int step = 0; step < 264; ++step) {
    const int chunk = seq_chunk32(d, step); const int row0 = b * TB + chunk * 32;
    VMWAIT();
    float qv[16], kk[16];
    { const unsigned qw[8] = {rq[0].x, rq[0].y, rq[0].z, rq[0].w, rq[1].x, rq[1].y, rq[1].z, rq[1].w};
      const unsigned fw[8] = {rf[0].x, rf[0].y, rf[0].z, rf[0].w, rf[1].x, rf[1].y, rf[1].z, rf[1].w};
      f32x4 f4[4];
#pragma unroll
      for (int e = 0; e < 8; ++e) { qv[2 * e] = bflo(qw[e]); qv[2 * e + 1] = bfhi(qw[e]);
        const float k0 = (1.f - lbv[2 * e]) * (1.f - fast_sigmoid(bflo(fw[e]))), k1 = (1.f - lbv[2 * e + 1]) * (1.f - fast_sigmoid(bfhi(fw[e])));
        kk[2 * e] = k0; kk[2 * e + 1] = k1; f4[e >> 1][(2 * e) & 3] = 1.f - k0; f4[e >> 1][(2 * e + 1) & 3] = 1.f - k1; }
#pragma unroll
      for (int e = 0; e < 4; ++e) *(LAS f32x4*)(prow + 4 * e) = f4[e];
      *(LAS u32x2*)(Vs + si * LDP + st_s * 4) = rv; }
    LBAR();
    if (step + 1 < 264) issue_loads(step + 1);
    const bool first = (d == 0) == fwd_first32(chunk);
    bf16_t* op; unsigned long long ppv = 0ull;
    { const int ii = 16 * it + fr; const int t = d ? 31 - ii : ii; op = MIX + (size_t)(row0 + t) * MIXW + outc + 16 * vt + 4 * fq; if (!first) ppv = ld_agent_u64(op); }
    { float pv[16];
#pragma unroll
      for (int i = 0; i < 16; ++i) pv[i] = pscan[i * 128];
#pragma unroll
      for (int i = 1; i < 16; ++i) pv[i] *= pv[i - 1];
#pragma unroll
      for (int i = 0; i < 16; ++i) pscan[i * 128] = pv[i]; }
    LBAR();
    { const bool hi = si >= 16;
      unsigned oq[8], oh[8], ow[8];
#pragma unroll
      for (int e4 = 0; e4 < 4; ++e4) {
        f32x4 p = *(const LAS f32x4*)(prow + 4 * e4); const f32x4 p15 = *(const LAS f32x4*)(PR + 15 * 128 + st_s * 16 + 4 * e4), p31 = *(const LAS f32x4*)(PR + 31 * 128 + st_s * 16 + 4 * e4);
        const f32x4 pl = p15 * p31; if (hi) p = p * p15;
        if (si == 0) *(LAS f32x4*)(PL + st_s * 16 + 4 * e4) = pl;
        float q_[4], h_[4], w_[4];
#pragma unroll
        for (int r = 0; r < 4; ++r) { const int e = 4 * e4 + r; const float rp = __builtin_amdgcn_rcpf(fmaxf(p[r], 1e-30f)); q_[r] = qv[e] * p[r]; h_[r] = kk[e] * rp; w_[r] = h_[r] * pl[r]; }
        oq[2 * e4] = pk2(q_[0], q_[1]); oq[2 * e4 + 1] = pk2(q_[2], q_[3]); oh[2 * e4] = pk2(h_[0], h_[1]); oh[2 * e4 + 1] = pk2(h_[2], h_[3]); ow[2 * e4] = pk2(w_[0], w_[1]); ow[2 * e4 + 1] = pk2(w_[2], w_[3]); }
      LAS u32x4* dq = (LAS u32x4*)(Qt + si * LDN + st_s * 16); LAS u32x4* dh = (LAS u32x4*)(Kh + si * LDN + st_s * 16); LAS u32x4* dw = (LAS u32x4*)(Kw + si * LDN + st_s * 16);
      dq[0] = (u32x4){oq[0], oq[1], oq[2], oq[3]}; dq[1] = (u32x4){oq[4], oq[5], oq[6], oq[7]};
      dh[0] = (u32x4){oh[0], oh[1], oh[2], oh[3]}; dh[1] = (u32x4){oh[4], oh[5], oh[6], oh[7]};
      dw[0] = (u32x4){ow[0], ow[1], ow[2], ow[3]}; dw[1] = (u32x4){ow[4], ow[5], ow[6], ow[7]}; }
    LBAR();
    if (w < 3) { const int I = w >= 1 ? 1 : 0, J = w == 2 ? 1 : 0;
      f32x4 acc = (f32x4){0.f, 0.f, 0.f, 0.f};
      const LAS bf16_t* pa = Qt + 16 * I * LDN + rL136; const LAS bf16_t* pb = Kh + 16 * J * LDN + rL136;
#pragma unroll
      for (int k = 0; k < 4; ++k) acc = mma16(ldfr(pa + 32 * k), ldfr(pb + 32 * k), acc);
      const int jj = 16 * J + fr, i0 = 16 * I + 4 * fq;
      *(LAS u32x2*)(Pt + jj * LDP + i0) = pk4(jj <= i0 ? acc[0] : 0.f, jj <= i0 + 1 ? acc[1] : 0.f, jj <= i0 + 2 ? acc[2] : 0.f, jj <= i0 + 3 ? acc[3] : 0.f); }
    const LAS bf16_t* Sr = St + (step & 1) * 32 * LDN; LAS bf16_t* Sw = St + ((step + 1) & 1) * 32 * LDN;
    f32x4 o2 = (f32x4){0.f, 0.f, 0.f, 0.f};
    { const LAS bf16_t* ps = Sr + 16 * vt * LDN + rL136; const LAS bf16_t* pq = Qt + 16 * it * LDN + rL136;
#pragma unroll
      for (int k = 0; k < 4; ++k) o2 = mma16(ldfr(ps + 32 * k), ldfr(pq + 32 * k), o2); }
    { const bf16x8 fv0 = ldft(Vs + tL40, LDP), fv1 = ldft(Vs + tL40 + 16, LDP);
#pragma unroll
      for (int a = 0; a < 2; ++a) { const int kt = 2 * w + a; const f32x4 dec = *(const LAS f32x4*)(PL + 16 * kt + 4 * fq);
        const bf16x8 fa = ldft(Kw + tL136 + 16 * kt, LDN);
        const f32x4 a0 = mma16(fa, fv0, Sacc[a][0] * dec), a1 = mma16(fa, fv1, Sacc[a][1] * dec);
        Sacc[a][0] = a0; Sacc[a][1] = a1;
        *(LAS u32x2*)(Sw + fr * LDN + 16 * kt + 4 * fq) = pk4(a0[0], a0[1], a0[2], a0[3]);
        *(LAS u32x2*)(Sw + (16 + fr) * LDN + 16 * kt + 4 * fq) = pk4(a1[0], a1[1], a1[2], a1[3]); } }
    LBAR();
    { const f32x4 o1 = mma16(ldft(Vs + tL40 + 16 * vt, LDP), ldft(Pt + tL40 + 16 * it, LDP), (f32x4){0.f, 0.f, 0.f, 0.f});
      float o0 = o1[0] + o2[0], o1v = o1[1] + o2[1], o2v = o1[2] + o2[2], o3 = o1[3] + o2[3];
      if (!first) { const unsigned lo = (unsigned)ppv, hi2 = (unsigned)(ppv >> 32); o0 += bflo(lo); o1v += bfhi(lo); o2v += bflo(hi2); o3 += bfhi(hi2); }
      *(u32x2*)op = pk4(o0, o1v, o2v, o3); }
    LBAR();
  }
}
__device__ __forceinline__ void phase_chain1(const Params& P, const Ctx& C, int mode) {
  if (mode != 2) for (int task = C.bid; task < 128; task += C.nblk) gdn3_chain_wg(P, C, task);
  __builtin_amdgcn_sched_barrier(0);
  if (mode != 1) for (int task = C.bid < 128 ? C.bid + C.nblk : C.bid; task < 256; task += C.nblk) hgrn2_chain_wg(P, C, task - 128);
}
__device__ __forceinline__ void phase_onorm(const Params& P, const Ctx& C, int ident) {
  bf16_t* MIX = WS(OFF_MIX1, bf16_t); bf16_t* U = WS(OFF_U1B, bf16_t);
  const float* m1 = WS(OFF_MOD, float) + (size_t)5 * 6144;
  for (int r = C.gw; r < R; r += C.ngw) {
    const int b = r / TB, pos = r % TB; if (pos < CTXL) continue;
#pragma unroll
    for (int half = 0; half < 2; ++half) {
      const float* gn = half ? GIN(I_HNG) : GIN(I_GNG);
#pragma unroll
      for (int j = 0; j < 4; ++j) { const int e = 4 * C.lane + 256 * j; bf16_t* p = MIX + (size_t)r * MIXW + half * 1024 + e;
        const u32x2 a = *(const u32x2*)p; const float o0 = bflo(a.x), o1 = bfhi(a.x), o2 = bflo(a.y), o3 = bfhi(a.y);
        const float ss = half_sum32((o0 * o0 + o1 * o1) + (o2 * o2 + o3 * o3)); const float rs = rsqrtf(ss * (1.f / 128.f) + RMS_EPS);
        const f32x4 g = *(const f32x4*)(gn + (e & 127));
        u32x2 w; w.x = pk2(o0 * rs * g[0], o1 * rs * g[1]); w.y = pk2(o2 * rs * g[2], o3 * rs * g[3]); if (ident) w = a; *(u32x2*)p = w; }
    }
    f32x4 h[4], u[4]; row_load(GOUT + ((size_t)b * SEQ + (pos - CTXL)) * D, C.lane, h);
    row_modulate(h, m1 + (size_t)b * 6144, m1 + (size_t)b * 6144 + D, C.lane, u);
    row_store_bf16(U + (size_t)r * D, C.lane, u);
  }
  LAS float* scr = (LAS float*)C.lds + C.wave * (64 * 33);
  convert_experts(P, 1, WS(OFF_WE1, bf16_t), WS(OFF_WE1 + 64 * MiB, bf16_t), C, scr);
}
__device__ __forceinline__ void phase_gates(const Params& P, const Ctx& C) {
  pg8::Gemm g{WS(OFF_U1B, bf16_t), WS(OFF_WG1, bf16_t), D, D}; pg8::GridOrder S; S.init(128, 8, C.nblk, C.bid, 1);
  pg8::EpiGateMul E{WS(OFF_MIX1, bf16_t), MIXW};
  pg8::gemm_phase(C.lds, g, S, E);
}


#define XB_TMO      128
#define XB_XCNT(j)  (256  + 64 * (j))
#define XB_XSUB(j)  (1280 + 64 * (j))
#define XB_XGEN(j)  (2304 + 64 * (j))
#define XB_TOP      3328
#define XB_TOPGEN   3392
#define XCD_BAR_WORDS 3456
#define XB_SPIN_CAP (1u << 22)
constexpr size_t OFF_BAR = 16 * 1024;
constexpr int LDS_BAR_OFF = LDS_BYTES - 64;
__device__ __forceinline__ unsigned xb_ld(unsigned* p)              { return __hip_atomic_load(p, __ATOMIC_RELAXED, __HIP_MEMORY_SCOPE_AGENT); }
__device__ __forceinline__ unsigned xb_add(unsigned* p, unsigned v) { return __hip_atomic_fetch_add(p, v, __ATOMIC_RELAXED, __HIP_MEMORY_SCOPE_AGENT); }
__device__ __forceinline__ unsigned xb_xcc_id() { return (unsigned)__builtin_amdgcn_s_getreg((3 << 11) | 20) & 0xFu; }
#define XB_SPIN(cond, bar) do { unsigned _sp = 0; while (cond) { __builtin_amdgcn_s_sleep(1); \
    if ((++_sp & 255u) == 0u) { if (xb_ld(&(bar)[XB_TMO])) break; if (_sp > XB_SPIN_CAP) { atomicAdd(&(bar)[XB_TMO], 1u); break; } } } } while (0)
__device__ __forceinline__ void xcd_barrier_post(unsigned* bar) { if (threadIdx.x == 0) (void)xb_add(&bar[XB_XCNT(xb_xcc_id())], 1u); }
__device__ __forceinline__ void xcd_barrier_complete(unsigned* bar, unsigned x, unsigned& nloc, unsigned& nx) {
  const unsigned G = gridDim.x * gridDim.y * gridDim.z;
  unsigned sum, cnt, mine, sp = 0u;
  for (;;) {
    sum = 0u; cnt = 0u; mine = 0u;
#pragma unroll
    for (unsigned j = 0; j < 16; ++j) { const unsigned c = xb_ld(&bar[XB_XCNT(j)]); sum += c; cnt += (c > 0u) ? 1u : 0u; mine = (j == x) ? c : mine; }
    if (sum == G) break;
    __builtin_amdgcn_s_sleep(1);
    if ((++sp & 255u) == 0u) { if (xb_ld(&bar[XB_TMO])) break; if (sp > XB_SPIN_CAP) { atomicAdd(&bar[XB_TMO], 1u); break; } }
  }
  nloc = mine > 0u ? mine : 1u; nx = cnt > 0u ? cnt : 1u;
}
__device__ __forceinline__ void xcd_barrier(unsigned* bar, volatile LAS unsigned* st) {
  asm volatile("s_waitcnt vmcnt(0)" ::: "memory");
  __syncthreads();
  if (threadIdx.x == 0) {
    const unsigned x = xb_xcc_id();
    __builtin_amdgcn_s_waitcnt(0);
    unsigned nloc = st[0], nx = st[1];
    if (nloc == 0u) { xcd_barrier_complete(bar, x, nloc, nx); st[0] = nloc; st[1] = nx; }
    const unsigned old = xb_add(&bar[XB_XSUB(x)], 1u);
    const unsigned gen = old / nloc;
    if (old + 1u == (gen + 1u) * nloc) {
      __builtin_amdgcn_fence(__ATOMIC_RELEASE, "agent");
      asm volatile("s_waitcnt vmcnt(0)" ::: "memory");
      const unsigned og = xb_add(&bar[XB_TOP], 1u);
      const unsigned tg = og / nx;
      if (og + 1u == (tg + 1u) * nx) xb_add(&bar[XB_TOPGEN], 1u);
      else XB_SPIN(xb_ld(&bar[XB_TOPGEN]) == tg, bar);
      __builtin_amdgcn_fence(__ATOMIC_ACQUIRE, "agent");
      xb_add(&bar[XB_XGEN(x)], 1u);
      asm volatile("s_waitcnt vmcnt(0)" ::: "memory");
    } else {
      XB_SPIN(xb_ld(&bar[XB_XGEN(x)]) == gen, bar);
      __builtin_amdgcn_fence(__ATOMIC_ACQUIRE, "agent");
      asm volatile("s_waitcnt vmcnt(0)" ::: "memory");
    }
  }
  __syncthreads();
}
__global__ void __launch_bounds__(NT, 2) fwd_megakernel(Params Pk) {
  extern __shared__ __attribute__((aligned(16))) unsigned char lds_raw[];
  cg::grid_group grid = cg::this_grid();
#ifndef PROBE_DOUBLE
#define PROBE_DOUBLE -1
#endif
#ifndef PROBE_MODE
#define PROBE_MODE 0
#endif
#ifndef PHASE_MASK
#define PHASE_MASK 0xFFFFFFFFu
#endif
#define SYNC() do { const unsigned char* wsb_ = ((const Params*)(const __attribute__((address_space(4))) Params*)__builtin_amdgcn_kernarg_segment_ptr())->ws; \
    xcd_barrier((unsigned*)(GAS unsigned*)(wsb_ + OFF_BAR), (volatile LAS unsigned*)((LAS unsigned char*)lds_raw + LDS_BAR_OFF)); } while (0)
#define SYNC_CG() do { __syncthreads(); grid.sync(); } while (0)
  if (threadIdx.x < 16) ((LAS unsigned*)((LAS unsigned char*)lds_raw + LDS_BAR_OFF))[threadIdx.x] = 0u;
  __syncthreads();
  xcd_barrier_post((unsigned*)(GAS unsigned*)(Pk.ws + OFF_BAR));
#define LAUNDER() const Params* pp; { unsigned long long a_ = (unsigned long long)__builtin_amdgcn_kernarg_segment_ptr(); asm volatile("" : "+s"(a_)); \
    const unsigned lo_ = __builtin_amdgcn_readfirstlane((unsigned)a_), hi_ = __builtin_amdgcn_readfirstlane((unsigned)(a_ >> 32)); \
    pp = (const Params*)(const __attribute__((address_space(4))) Params*)(((unsigned long long)hi_ << 32) | lo_); } \
  Ctx C; { int t_ = threadIdx.x; asm volatile("" : "+v"(t_)); t_ &= 511; int b_ = blockIdx.x; asm volatile("" : "+s"(b_)); b_ = __builtin_amdgcn_readfirstlane(b_); int g_ = gridDim.x; asm volatile("" : "+s"(g_)); g_ = __builtin_amdgcn_readfirstlane(g_); \
    C.lds = (LAS unsigned char*)lds_raw; C.tid = t_; C.lane = t_ & 63; C.wave = __builtin_amdgcn_readfirstlane(t_ >> 6); \
    C.bid = b_; C.nblk = g_; C.gw = b_ * NWAVES + C.wave; C.ngw = g_ * NWAVES; }
#define WSP(off, T) ((T*)(GAS T*)(pp->ws + (off)))
  for (int rep_ = 0; rep_ < ((PROBE_DOUBLE == 0) ? 2 : 1); ++rep_) { if (PHASE_MASK & (1u << 0)) { LAUNDER(); phase0(*pp, C); }  SYNC_CG(); }
  for (int rep_ = 0; rep_ < ((PROBE_DOUBLE == 1) ? 2 : 1); ++rep_) { if (PHASE_MASK & (1u << 1)) { LAUNDER(); phase_u0(*pp, C); }  SYNC(); }
  for (int rep_ = 0; rep_ < ((PROBE_DOUBLE == 2) ? 2 : 1); ++rep_) { if (PHASE_MASK & (1u << 2)) { LAUNDER(); phase_inproj(*pp, C, WSP(OFF_U0, bf16_t), WSP(OFF_WAB, bf16_t), WSP(OFF_Z0, bf16_t), Z0W); }  SYNC(); }
  for (int rep_ = 0; rep_ < ((PROBE_DOUBLE == 3) ? 2 : 1); ++rep_) { if (PHASE_MASK & (1u << 3)) { LAUNDER(); phase_feat0(*pp, C, rep_); }  SYNC(); }
  for (int rep_ = 0; rep_ < ((PROBE_DOUBLE == 4) ? 2 : 1); ++rep_) { if (PHASE_MASK & (1u << 4)) { LAUNDER(); phase_chain0(*pp, C, rep_ ? PROBE_MODE : 0); }  SYNC(); }
  for (int rep_ = 0; rep_ < ((PROBE_DOUBLE == 5) ? 2 : 1); ++rep_) { if (PHASE_MASK & (1u << 5)) { LAUNDER(); phase_ssdfin(*pp, C, rep_); }  SYNC(); }
  for (int rep_ = 0; rep_ < ((PROBE_DOUBLE == 6) ? 2 : 1); ++rep_) { if (PHASE_MASK & (1u << 6)) { LAUNDER(); phase_outproj(*pp, C, 0); }  SYNC(); }
  for (int rep_ = 0; rep_ < ((PROBE_DOUBLE == 7) ? 2 : 1); ++rep_) { if (PHASE_MASK & (1u << 7)) { LAUNDER(); phase_lnmix(*pp, C, 0, rep_); }  SYNC(); }
  for (int rep_ = 0; rep_ < ((PROBE_DOUBLE == 9) ? 2 : 1); ++rep_) { if (PHASE_MASK & (1u << 9)) { LAUNDER(); phase_moe1(*pp, C, 0); }  SYNC(); }
  for (int rep_ = 0; rep_ < ((PROBE_DOUBLE == 10) ? 2 : 1); ++rep_) { if (PHASE_MASK & (1u << 10)) { LAUNDER(); phase_moe2(*pp, C, 0); }  SYNC(); }
  for (int rep_ = 0; rep_ < ((PROBE_DOUBLE == 11) ? 2 : 1); ++rep_) { if (PHASE_MASK & (1u << 11)) { LAUNDER(); phase_lnffn(*pp, C, 0, rep_); }  SYNC(); }
  for (int rep_ = 0; rep_ < ((PROBE_DOUBLE == 12) ? 2 : 1); ++rep_) { if (PHASE_MASK & (1u << 12)) { LAUNDER(); phase_inproj(*pp, C, WSP(OFF_U1, bf16_t), WSP(OFF_WCD, bf16_t), WSP(OFF_Z1, bf16_t), Z1W); }  SYNC(); }
  for (int rep_ = 0; rep_ < ((PROBE_DOUBLE == 13) ? 2 : 1); ++rep_) { if (PHASE_MASK & (1u << 13)) { LAUNDER(); phase_feat1(*pp, C, rep_); }  SYNC(); }
  for (int rep_ = 0; rep_ < ((PROBE_DOUBLE == 14) ? 2 : 1); ++rep_) { if (PHASE_MASK & (1u << 14)) { LAUNDER(); phase_chain1(*pp, C, rep_ ? PROBE_MODE : 0); }  SYNC(); }
  for (int rep_ = 0; rep_ < ((PROBE_DOUBLE == 15) ? 2 : 1); ++rep_) { if (PHASE_MASK & (1u << 15)) { LAUNDER(); phase_onorm(*pp, C, rep_); }  SYNC(); }
  for (int rep_ = 0; rep_ < ((PROBE_DOUBLE == 16) ? 2 : 1); ++rep_) { if (PHASE_MASK & (1u << 16)) { LAUNDER(); phase_gates(*pp, C); }  SYNC(); }
  for (int rep_ = 0; rep_ < ((PROBE_DOUBLE == 17) ? 2 : 1); ++rep_) { if (PHASE_MASK & (1u << 17)) { LAUNDER(); phase_outproj(*pp, C, 1); }  SYNC(); }
  for (int rep_ = 0; rep_ < ((PROBE_DOUBLE == 18) ? 2 : 1); ++rep_) { if (PHASE_MASK & (1u << 18)) { LAUNDER(); phase_lnmix(*pp, C, 1, rep_); }  SYNC(); }
  for (int rep_ = 0; rep_ < ((PROBE_DOUBLE == 20) ? 2 : 1); ++rep_) { if (PHASE_MASK & (1u << 20)) { LAUNDER(); phase_moe1(*pp, C, 1); }  SYNC(); }
  for (int rep_ = 0; rep_ < ((PROBE_DOUBLE == 21) ? 2 : 1); ++rep_) { if (PHASE_MASK & (1u << 21)) { LAUNDER(); phase_moe2(*pp, C, 1); }  SYNC(); }
  for (int rep_ = 0; rep_ < ((PROBE_DOUBLE == 22) ? 2 : 1); ++rep_) { if (PHASE_MASK & (1u << 22)) { LAUNDER(); phase_lnffn(*pp, C, 1, rep_); } if (PROBE_DOUBLE == 22) SYNC(); }
}

extern "C" void kernel_launch(void* const* d_in, const int* in_sizes, int n_in, void* d_out, int out_size,
                              void* d_ws, size_t ws_size, hipStream_t stream) {
  static int grid_blocks = 0;
  if (!grid_blocks) {
    int dev = 0, cus = 0, per_cu = 0;
    (void)hipGetDevice(&dev);
    (void)hipDeviceGetAttribute(&cus, hipDeviceAttributeMultiprocessorCount, dev);
    (void)hipFuncSetAttribute((const void*)fwd_megakernel, hipFuncAttributeMaxDynamicSharedMemorySize, LDS_BYTES);
    (void)hipOccupancyMaxActiveBlocksPerMultiprocessor(&per_cu, (const void*)fwd_megakernel, NT, LDS_BYTES);
    if (per_cu < 1) per_cu = 1;
    grid_blocks = cus * 1;
    fprintf(stderr, "grid %d (cus %d per_cu %d) ws_size %zu need %zu n_in %d\n", grid_blocks, cus, per_cu, ws_size, (size_t)WS_NEED, n_in);
    if (ws_size < WS_NEED || n_in != 39) { fprintf(stderr, "kernel_launch: workspace too small or unexpected inputs\n"); grid_blocks = -1; }
  }
  if (grid_blocks < 0) return;
  (void)hipMemsetAsync(d_ws, 0, 64 * 1024, stream);
  Params p{};
  for (int i = 0; i < 39; ++i) p.in[i] = (const float*)d_in[i];
  p.out = (float*)d_out; p.ws = (unsigned char*)d_ws;
  void* args[] = {&p};
  hipError_t e = hipLaunchCooperativeKernel((const void*)fwd_megakernel, dim3(grid_blocks), dim3(NT), args, LDS_BYTES, stream);
  if (e != hipSuccess) fprintf(stderr, "cooperative launch failed: %s (grid %d)\n", hipGetErrorString(e), grid_blocks);
}
```

```cpp
#include <hip/hip_runtime.h>
#include <hip/hip_cooperative_groups.h>
#include <cstdio>
#include <cstdint>
namespace cg = cooperative_groups;

#define LAS __attribute__((address_space(3)))
typedef unsigned short bf16_t;
typedef short bf16x8 __attribute__((ext_vector_type(8)));
typedef float f32x4 __attribute__((ext_vector_type(4)));
typedef float f32x2 __attribute__((ext_vector_type(2)));
typedef unsigned u32x4 __attribute__((ext_vector_type(4)));
typedef unsigned u32x2 __attribute__((ext_vector_type(2)));

constexpr int D = 1024, NB = 4, SEQ = 8192, CTXL = 256, TB = SEQ + CTXL  , R = NB * TB  , RLAT = NB * SEQ;
constexpr int NT = 512, NWAVES = 8;
constexpr int LDS_BYTES = 163840;
constexpr int AB_IN = 4640, CD_IN = 9248;
constexpr int Z0W = 4608, Z1W = 7168, MIXW = 2048;
constexpr int NEXP = 32, DEXP = 512, MOE_BLK = 256, MAX_BLKS = 304, MAX_SLOTS = 296 * 256;
constexpr float ALPHA = 1.41421356237309515f;
constexpr float LN_EPS = 1e-5f, RMS_EPS = 1e-6f;
constexpr int Z0_RGX = 0, Z0_RGY = 1024, Z0_SSDZ = 2048, Z0_XBC = 3072, Z0_B = 4096, Z0_C = 4352;
constexpr int Z1_Q = 0, Z1_K = 1024, Z1_V = 2048, Z1_HQ = 3072, Z1_HF = 4096, Z1_HI = 6144;

constexpr size_t MiB = 1u << 20;
constexpr size_t OFF_CTL = 0;
constexpr size_t OFF_MOD = 64 * 1024;
constexpr size_t OFF_LB1 = 320 * 1024;
constexpr size_t OFF_ROUTE = 512 * 1024;
constexpr size_t OFF_SLOTW = 2 * MiB;
constexpr size_t OFF_DT = 3 * MiB;
constexpr size_t OFF_HCTX = 8 * MiB;
constexpr size_t OFF_TCTX = 12 * MiB;
constexpr size_t OFF_WOUT0 = 16 * MiB, OFF_WOUT1 = 20 * MiB, OFF_WG1 = 24 * MiB, OFF_WAB = 28 * MiB;
constexpr size_t OFF_TOK = 37 * MiB + 512 * 1024;
constexpr int TOKCAP = 33792;
constexpr size_t OFF_A = 40 * MiB;
constexpr size_t OFF_Z0 = OFF_A, OFF_MIX0 = OFF_A + 297 * MiB, OFF_WE0 = OFF_A + 429 * MiB, OFF_U0 = OFF_A + 525 * MiB;
constexpr size_t OFF_AM0 = OFF_A, OFF_HM0 = OFF_A + 148 * MiB, OFF_YM0 = OFF_A + 222 * MiB;
constexpr size_t OFF_Z1 = OFF_A, OFF_U1 = OFF_A + 462 * MiB, OFF_WCD = OFF_A + 528 * MiB, OFF_MIX1 = OFF_A + 462 * MiB;
constexpr size_t OFF_WE1 = OFF_A, OFF_U1B = OFF_A + 96 * MiB, OFF_AM1 = OFF_A + 96 * MiB, OFF_HM1 = OFF_A + 244 * MiB, OFF_YM1 = OFF_A + 318 * MiB, OFF_V1 = OFF_A + 470 * MiB;
constexpr size_t WS_NEED = OFF_A + 594 * MiB;
static_assert((size_t)R * Z0W * 2 <= 297 * MiB && (size_t)R * MIXW * 2 <= 132 * MiB && (size_t)R * Z1W * 2 <= 462 * MiB && (size_t)R * D * 2 <= 66 * MiB, "ws map");
static_assert((size_t)MAX_SLOTS * D * 2 <= 148 * MiB && (size_t)MAX_SLOTS * DEXP * 2 <= 74 * MiB, "ws map moe");
static_assert(OFF_DT + (size_t)R * 32 * 4 <= OFF_HCTX && OFF_ROUTE + (size_t)R * 32 <= OFF_SLOTW && OFF_SLOTW + MAX_SLOTS * 4 <= OFF_DT, "ws map small");

struct Params { const float* in[39]; float* out; unsigned char* ws; };
enum { I_X = 0, I_C, I_CTX, I_CCTX, I_HLB, I_ADAW, I_ADAB, I_LNMG, I_LNMB, I_LNFG, I_LNFB, I_OUTW, I_RGW, I_RGB, I_REW, I_REB, I_EWG, I_EWU, I_EWD,
       I_ABW, I_RGCW, I_RGCB, I_RGAW, I_RGAB, I_RGXW, I_RGXB, I_RGLAM, I_SCW, I_SCB, I_SALOG, I_SDTB, I_SD, I_SNG, I_CDW, I_GCW, I_GALOG, I_GDTB, I_GNG, I_HNG };

__device__ __forceinline__ unsigned f2bf(float f) { unsigned u = __float_as_uint(f); return (u + 0x7fffu + ((u >> 16) & 1u)) >> 16; }
__device__ __forceinline__ float bf2f(unsigned b) { return __uint_as_float(b << 16); }
typedef __bf16 bf16x2v_t __attribute__((ext_vector_type(2)));
__device__ __forceinline__ unsigned pk2(float lo, float hi) { const f32x2 v = {lo, hi}; const bf16x2v_t r = __builtin_convertvector(v, bf16x2v_t); return __builtin_bit_cast(unsigned, r); }
__device__ __forceinline__ float bflo(unsigned w) { return __uint_as_float(w << 16); }
__device__ __forceinline__ float bfhi(unsigned w) { return __uint_as_float(w & 0xffff0000u); }
__device__ __forceinline__ float sigmoidf_(float x) { return __builtin_amdgcn_rcpf(1.f + __expf(-x)); }
__device__ __forceinline__ float siluf_(float x) { return x * __builtin_amdgcn_rcpf(1.f + __expf(-x)); }
__device__ __forceinline__ float softplusf_(float x) { const float t = __expf(-fabsf(x)); return fmaxf(x, 0.f) + (t < 1e-4f ? t - 0.5f * t * t : __logf(1.f + t)); }
__device__ __forceinline__ float geluf_(float x) { const float u = 0.7978845608028654f * (x + 0.044715f * x * x * x); return 0.5f * x * (1.f + tanhf(u)); }
template <int CTRL> __device__ __forceinline__ float dpp_mov(float v) {
  return __builtin_bit_cast(float, __builtin_amdgcn_update_dpp(0, __builtin_bit_cast(int, v), CTRL, 0xf, 0xf, true));
}
__device__ __forceinline__ float row_sum16(float v) {
  v += dpp_mov<0xB1>(v); v += dpp_mov<0x4E>(v); v += dpp_mov<0x141>(v); v += dpp_mov<0x140>(v);
  return v;
}
__device__ __forceinline__ float wave_sum(float v) { v = row_sum16(v); v += __shfl_xor(v, 16); v += __shfl_xor(v, 32); return v; }
__device__ __forceinline__ float half_sum32(float v) { v = row_sum16(v); v += __shfl_xor(v, 16); return v; }
__device__ __forceinline__ int rmap(int latonly, int q) { return latonly ? (q >> 13) * TB + CTXL + (q & 8191) : q; }
__device__ __forceinline__ int row_batch(int r) { return r / TB; }

namespace pg8 {
constexpr int BM = 256, BK = 64, HALF = 128, HTB = HALF * BK * 2, STAGE_BYTES = 8 * HTB, NXCD = 8, WGM = 8;
__host__ __device__ __forceinline__ int lds_byte(int r, int c) { const int st = (r >> 4) * 2 + (c >> 5), rr = r & 15, cc = c & 31, ob = rr * 64 + cc * 2; return st * 1024 + (ob ^ (((ob >> 9) & 1) << 5)); }
__host__ __device__ __forceinline__ void stage_rc(int b, int& Rr, int& C) { const int st = b / 1024, sb = b % 1024, swz = sb ^ (((sb >> 9) & 1) << 5); Rr = (st >> 1) * 16 + swz / 64; C = (st & 1) * 32 + (swz % 64) / 2; }
__host__ __device__ __forceinline__ int perm32(int rho) { const int n = rho >> 4, i = rho & 15; return 8 * (i >> 2) + 4 * n + (i & 3); }
struct Unit { int pm, pn; };
struct Gemm { const bf16_t* A; const bf16_t* Bt; int lda, K; };

struct GridOrder {
  int nM, nN, nwg, G, c, skipctx;
  __device__ void init(int nM_, int nN_, int G_, int c_, int skipctx_) { nM = nM_; nN = nN_; nwg = nM * nN; G = G_; c = c_; skipctx = skipctx_; }
  __device__ bool next(int i, Unit& u) const {
    const long L = (long)i * G + c; if (L >= nwg) return false;
    int wgid = (int)L; { const int q = nwg / NXCD, r = nwg % NXCD, xcd = wgid % NXCD, off = wgid / NXCD; wgid = (xcd < r ? xcd * (q + 1) : r * (q + 1) + (xcd - r) * q) + off; }
    const int nig = WGM * nN, gid = wgid / nig, fm = gid * WGM, gsz = (nM - fm) < WGM ? (nM - fm) : WGM;
    int pm = fm + ((wgid % nig) % gsz); u.pn = (wgid % nig) / gsz;
    if (skipctx) pm = (pm >> 5) * 33 + 1 + (pm & 31);
    u.pm = pm; return true;
  }
};
struct MoeOrder {
  const LAS int* base; const LAS int* cntL; const LAS int* blk_e; const unsigned short* tok; int nunits, G, c;
  __device__ bool next(int i, Unit& u) const {
    const long L = (long)i * G + c; if (L >= nunits) return false;
    const int blk = (int)(L >> 2), j = (int)(L & 3);
    u.pm = blk; u.pn = blk_e[blk] * 4 + j; return true;
  }
  __device__ int arow(const Unit& u, int r) const {
    const int e = blk_e[u.pm]; const int pos = (u.pm - base[e]) * 256 + r;
    return pos < cntL[e] ? (int)tok[(size_t)e * TOKCAP + pos] : 0;
  }
};

__device__ __forceinline__ unsigned cvt_pk_bf16(float lo, float hi) { return pk2(lo, hi); }

template <class Epi, class Sched>
__device__ __forceinline__ void gemm_phase(LAS unsigned char* lds, const Gemm g, const Sched& S, const Epi& E) {
  int tid_ = threadIdx.x; asm volatile("" : "+v"(tid_)); tid_ &= 511; const int tid = tid_, wid = __builtin_amdgcn_readfirstlane(tid >> 6), lane = tid & 63, wr = wid >> 2, wc = wid & 3, fr = lane & 15, fq = lane >> 4;
  const int K = g.K, nt = K / BK, lda = g.lda;
  unsigned voffA[2], voffB[2];
#pragma unroll
  for (int i = 0; i < 2; ++i) { int Rr, C; stage_rc(tid * 16 + i * 8192, Rr, C); const int Rb = Epi::PERM ? ((Rr & ~31) + perm32(Rr & 31)) : Rr;
    voffA[i] = (unsigned)(Rr * lda + C) * 2u; voffB[i] = (unsigned)(Rb * K + C) * 2u; }
  const size_t kstep = (size_t)(BK * 2);
  const size_t hstepA = (size_t)HALF * lda * 2, hstepB = (size_t)HALF * K * 2;
  const size_t tstepA = 2 * hstepA, tstepB = 2 * hstepB;
  const unsigned ldsw = (unsigned)wid * 1024u;
  const int aoff = lds_byte(wr * 64 + fr, fq * 8), boff = lds_byte(wc * 32 + fr, fq * 8);
#define PG8_SA(b, h) (((b) * 2 + (h)) * HTB)
#define PG8_SB(b, h) ((4 + (b) * 2 + (h)) * HTB)
#define PG8_STAGE(bufoff, gbase, voff) do { _Pragma("unroll") for (int _i = 0; _i < 2; ++_i) \
    __builtin_amdgcn_global_load_lds((const unsigned*)((const char*)(gbase) + (voff)[_i]), (LAS unsigned*)(lds + (bufoff) + ldsw + _i * 8192), 16, 0, 0); } while (0)
#define PG8_LDA(dst, b, h) do { _Pragma("unroll") for (int m = 0; m < 4; ++m) _Pragma("unroll") for (int k = 0; k < 2; ++k) dst[m][k] = *(const LAS bf16x8*)(lds + PG8_SA(b, h) + aoff + m * 2048 + k * 1024); } while (0)
#define PG8_LDB(dst, b, h) do { _Pragma("unroll") for (int n = 0; n < 2; ++n) _Pragma("unroll") for (int k = 0; k < 2; ++k) dst[n][k] = *(const LAS bf16x8*)(lds + PG8_SB(b, h) + boff + n * 2048 + k * 1024); } while (0)
#define PG8_MMA(ai, bj, At, Bt) do { __builtin_amdgcn_s_setprio(1); _Pragma("unroll") for (int m = 0; m < 4; ++m) _Pragma("unroll") for (int n = 0; n < 2; ++n) _Pragma("unroll") for (int k = 0; k < 2; ++k) \
    acc[ai][bj][m][n] = __builtin_amdgcn_mfma_f32_16x16x32_bf16(Bt[n][k], At[m][k], acc[ai][bj][m][n], 0, 0, 0); __builtin_amdgcn_s_setprio(0); } while (0)
#define PG8_WAIT_V(n) asm volatile("s_waitcnt vmcnt(" #n ")" ::: "memory")
#define PG8_WAIT_L(n) asm volatile("s_waitcnt lgkmcnt(" #n ")" ::: "memory")
#define PG8_BAR __builtin_amdgcn_s_barrier()
#define PG8_SCHED __builtin_amdgcn_sched_barrier(0)
  Unit cur, nxt; int ui = 0;
  if (!S.next(0, cur)) return;
  f32x4 acc[2][2][4][2];
#pragma unroll
  for (int a = 0; a < 2; ++a)
#pragma unroll
    for (int b = 0; b < 2; ++b)
#pragma unroll
      for (int m = 0; m < 4; ++m)
#pragma unroll
        for (int n = 0; n < 2; ++n) acc[a][b][m][n] = (f32x4){0.f, 0.f, 0.f, 0.f};
  bf16x8 At[4][2], B0[2][2], B1[2][2];
  const char* cA = (const char*)g.A + (size_t)cur.pm * tstepA; const char* cB = (const char*)g.Bt + (size_t)cur.pn * tstepB;
  PG8_STAGE(PG8_SB(0, 0), cB, voffB); PG8_STAGE(PG8_SA(0, 0), cA, voffA); PG8_STAGE(PG8_SB(0, 1), cB + hstepB, voffB); PG8_STAGE(PG8_SA(0, 1), cA + hstepA, voffA);
  if (wr == 1) PG8_BAR;
  PG8_WAIT_V(4); PG8_BAR;
  PG8_STAGE(PG8_SB(1, 0), cB + kstep, voffB); PG8_STAGE(PG8_SA(1, 0), cA + kstep, voffA); PG8_STAGE(PG8_SB(1, 1), cB + hstepB + kstep, voffB);
  PG8_WAIT_V(6); PG8_BAR;
  for (;;) {
    const bool has_next = S.next(ui + 1, nxt);
    const char* nA = has_next ? (const char*)g.A + (size_t)nxt.pm * tstepA : cA; const char* nB = has_next ? (const char*)g.Bt + (size_t)nxt.pn * tstepB : cB;
    for (int t = 0; t < nt; t += 2) {
      const bool last = (t == nt - 2);
      const char* a1 = cA + (size_t)(t + 1) * kstep;
      const char* a2 = last ? nA : cA + (size_t)(t + 2) * kstep; const char* b2 = last ? nB : cB + (size_t)(t + 2) * kstep;
      const char* a3 = a2 + kstep; const char* b3 = b2 + kstep;
      PG8_LDB(B0, 0, 0); PG8_SCHED; PG8_LDA(At, 0, 0); PG8_STAGE(PG8_SA(1, 1), a1 + hstepA, voffA);
      PG8_WAIT_L(8); PG8_BAR; PG8_WAIT_L(0); PG8_MMA(0, 0, At, B0); PG8_BAR; PG8_SCHED;
      PG8_LDB(B1, 0, 1); PG8_STAGE(PG8_SB(0, 0), b2, voffB);
      PG8_BAR; PG8_WAIT_L(0); PG8_MMA(0, 1, At, B1); PG8_BAR;
      PG8_LDA(At, 0, 1); PG8_STAGE(PG8_SA(0, 0), a2, voffA);
      PG8_BAR; PG8_WAIT_L(0); PG8_MMA(1, 0, At, B0); PG8_BAR; PG8_SCHED;
      PG8_STAGE(PG8_SB(0, 1), b2 + hstepB, voffB);
      PG8_WAIT_V(6); PG8_BAR; PG8_MMA(1, 1, At, B1); PG8_BAR;
      PG8_LDB(B0, 1, 0); PG8_SCHED; PG8_LDA(At, 1, 0); PG8_STAGE(PG8_SA(0, 1), a2 + hstepA, voffA);
      PG8_WAIT_L(8); PG8_BAR; PG8_WAIT_L(0); PG8_MMA(0, 0, At, B0); PG8_BAR; PG8_SCHED;
      PG8_LDB(B1, 1, 1); PG8_STAGE(PG8_SB(1, 0), b3, voffB);
      PG8_BAR; PG8_WAIT_L(0); PG8_MMA(0, 1, At, B1); PG8_BAR;
      PG8_LDA(At, 1, 1); PG8_STAGE(PG8_SA(1, 0), a3, voffA);
      PG8_BAR; PG8_WAIT_L(0); PG8_MMA(1, 0, At, B0); PG8_BAR; PG8_SCHED;
      PG8_STAGE(PG8_SB(1, 1), b3 + hstepB, voffB);
      PG8_WAIT_V(6); PG8_BAR; PG8_MMA(1, 1, At, B1); PG8_BAR;
    }
    E(acc, cur, wr, wc, fr, fq);
    if (!has_next) break;
#pragma unroll
    for (int a = 0; a < 2; ++a)
#pragma unroll
      for (int b = 0; b < 2; ++b)
#pragma unroll
        for (int m = 0; m < 4; ++m)
#pragma unroll
          for (int n = 0; n < 2; ++n) acc[a][b][m][n] = (f32x4){0.f, 0.f, 0.f, 0.f};
    cur = nxt; cA = nA; cB = nB; ++ui;
  }
  PG8_WAIT_V(0);
  if (wr == 0) PG8_BAR;
  PG8_BAR;
#undef PG8_SA
#undef PG8_SB
#undef PG8_STAGE
#undef PG8_LDA
#undef PG8_LDB
#undef PG8_MMA
#undef PG8_WAIT_V
#undef PG8_WAIT_L
#undef PG8_BAR
#undef PG8_SCHED
}

template <class Epi, class Sched>
__device__ __forceinline__ void gemm_phase_ga(LAS unsigned char* lds, const Gemm g, const Sched& S, const Epi& E) {
  int tid_ = threadIdx.x; asm volatile("" : "+v"(tid_)); tid_ &= 511; const int tid = tid_, wid = __builtin_amdgcn_readfirstlane(tid >> 6), lane = tid & 63, wr = wid >> 2, wc = wid & 3, fr = lane & 15, fq = lane >> 4;
  const int K = g.K, nt = K / BK, lda = g.lda;
  unsigned voffB[2]; int rowA[2]; unsigned colA[2];
#pragma unroll
  for (int i = 0; i < 2; ++i) { int Rr, C; stage_rc(tid * 16 + i * 8192, Rr, C); const int Rb = Epi::PERM ? ((Rr & ~31) + perm32(Rr & 31)) : Rr;
    rowA[i] = Rr; colA[i] = (unsigned)C * 2u; voffB[i] = (unsigned)(Rb * K + C) * 2u; }
  unsigned oc[2][2], on[2][2];
  const size_t kstep = (size_t)(BK * 2);
  const size_t hstepB = (size_t)HALF * K * 2;
  const size_t tstepB = 2 * hstepB;
  const unsigned ldsw = (unsigned)wid * 1024u;
  const int aoff = lds_byte(wr * 64 + fr, fq * 8), boff = lds_byte(wc * 32 + fr, fq * 8);
#define PG8_SA(b, h) (((b) * 2 + (h)) * HTB)
#define PG8_SB(b, h) ((4 + (b) * 2 + (h)) * HTB)
#define PG8_STAGE_A(bufoff, off2, kbyte) do { _Pragma("unroll") for (int _i = 0; _i < 2; ++_i) \
    __builtin_amdgcn_global_load_lds((const unsigned*)((const char*)g.A + (size_t)(kbyte) + (off2)[_i]), (LAS unsigned*)(lds + (bufoff) + ldsw + _i * 8192), 16, 0, 0); } while (0)
#define PG8_OFFS(dst, un) do { _Pragma("unroll") for (int _h = 0; _h < 2; ++_h) _Pragma("unroll") for (int _i = 0; _i < 2; ++_i) \
    dst[_h][_i] = (unsigned)S.arow(un, _h * HALF + rowA[_i]) * (unsigned)(lda * 2) + colA[_i]; } while (0)
#define PG8_STAGE(bufoff, gbase, voff) do { _Pragma("unroll") for (int _i = 0; _i < 2; ++_i) \
    __builtin_amdgcn_global_load_lds((const unsigned*)((const char*)(gbase) + (voff)[_i]), (LAS unsigned*)(lds + (bufoff) + ldsw + _i * 8192), 16, 0, 0); } while (0)
#define PG8_LDA(dst, b, h) do { _Pragma("unroll") for (int m = 0; m < 4; ++m) _Pragma("unroll") for (int k = 0; k < 2; ++k) dst[m][k] = *(const LAS bf16x8*)(lds + PG8_SA(b, h) + aoff + m * 2048 + k * 1024); } while (0)
#define PG8_LDB(dst, b, h) do { _Pragma("unroll") for (int n = 0; n < 2; ++n) _Pragma("unroll") for (int k = 0; k < 2; ++k) dst[n][k] = *(const LAS bf16x8*)(lds + PG8_SB(b, h) + boff + n * 2048 + k * 1024); } while (0)
#define PG8_MMA(ai, bj, At, Bt) do { __builtin_amdgcn_s_setprio(1); _Pragma("unroll") for (int m = 0; m < 4; ++m) _Pragma("unroll") for (int n = 0; n < 2; ++n) _Pragma("unroll") for (int k = 0; k < 2; ++k) \
    acc[ai][bj][m][n] = __builtin_amdgcn_mfma_f32_16x16x32_bf16(Bt[n][k], At[m][k], acc[ai][bj][m][n], 0, 0, 0); __builtin_amdgcn_s_setprio(0); } while (0)
#define PG8_WAIT_V(n) asm volatile("s_waitcnt vmcnt(" #n ")" ::: "memory")
#define PG8_WAIT_L(n) asm volatile("s_waitcnt lgkmcnt(" #n ")" ::: "memory")
#define PG8_BAR __builtin_amdgcn_s_barrier()
#define PG8_SCHED __builtin_amdgcn_sched_barrier(0)
  Unit cur, nxt; int ui = 0;
  if (!S.next(0, cur)) return;
  f32x4 acc[2][2][4][2];
#pragma unroll
  for (int a = 0; a < 2; ++a)
#pragma unroll
    for (int b = 0; b < 2; ++b)
#pragma unroll
      for (int m = 0; m < 4; ++m)
#pragma unroll
        for (int n = 0; n < 2; ++n) acc[a][b][m][n] = (f32x4){0.f, 0.f, 0.f, 0.f};
  bf16x8 At[4][2], B0[2][2], B1[2][2];
  const char* cB = (const char*)g.Bt + (size_t)cur.pn * tstepB;
  PG8_OFFS(oc, cur);
  PG8_STAGE(PG8_SB(0, 0), cB, voffB); PG8_STAGE_A(PG8_SA(0, 0), oc[0], 0); PG8_STAGE(PG8_SB(0, 1), cB + hstepB, voffB); PG8_STAGE_A(PG8_SA(0, 1), oc[1], 0);
  if (wr == 1) PG8_BAR;
  PG8_WAIT_V(4); PG8_BAR;
  PG8_STAGE(PG8_SB(1, 0), cB + kstep, voffB); PG8_STAGE_A(PG8_SA(1, 0), oc[0], kstep); PG8_STAGE(PG8_SB(1, 1), cB + hstepB + kstep, voffB);
  PG8_WAIT_V(6); PG8_BAR;
  for (;;) {
    const bool has_next = S.next(ui + 1, nxt);
    const char* nB = has_next ? (const char*)g.Bt + (size_t)nxt.pn * tstepB : cB;
    if (has_next) { PG8_OFFS(on, nxt); } else {
#pragma unroll
      for (int _h = 0; _h < 2; ++_h) { on[_h][0] = oc[_h][0]; on[_h][1] = oc[_h][1]; } }
    for (int t = 0; t < nt; t += 2) {
      const bool last = (t == nt - 2);
      const size_t k1 = (size_t)(t + 1) * kstep, k2 = last ? 0 : (size_t)(t + 2) * kstep, k3 = k2 + kstep;
      const char* b2 = last ? nB : cB + (size_t)(t + 2) * kstep; const char* b3 = b2 + kstep;
      unsigned o2a[2], o2b[2];
      if (last) { asm volatile("" : "+v"(on[0][0]), "+v"(on[0][1]), "+v"(on[1][0]), "+v"(on[1][1])); o2a[0] = on[0][0]; o2a[1] = on[0][1]; o2b[0] = on[1][0]; o2b[1] = on[1][1]; }
      else { o2a[0] = oc[0][0]; o2a[1] = oc[0][1]; o2b[0] = oc[1][0]; o2b[1] = oc[1][1]; }
      PG8_LDB(B0, 0, 0); PG8_SCHED; PG8_LDA(At, 0, 0); PG8_STAGE_A(PG8_SA(1, 1), oc[1], k1);
      PG8_WAIT_L(8); PG8_BAR; PG8_WAIT_L(0); PG8_MMA(0, 0, At, B0); PG8_BAR; PG8_SCHED;
      PG8_LDB(B1, 0, 1); PG8_STAGE(PG8_SB(0, 0), b2, voffB);
      PG8_BAR; PG8_WAIT_L(0); PG8_MMA(0, 1, At, B1); PG8_BAR;
      PG8_LDA(At, 0, 1); PG8_STAGE_A(PG8_SA(0, 0), o2a, k2);
      PG8_BAR; PG8_WAIT_L(0); PG8_MMA(1, 0, At, B0); PG8_BAR; PG8_SCHED;
      PG8_STAGE(PG8_SB(0, 1), b2 + hstepB, voffB);
      PG8_WAIT_V(6); PG8_BAR; PG8_MMA(1, 1, At, B1); PG8_BAR;
      PG8_LDB(B0, 1, 0); PG8_SCHED; PG8_LDA(At, 1, 0); PG8_STAGE_A(PG8_SA(0, 1), o2b, k2);
      PG8_WAIT_L(8); PG8_BAR; PG8_WAIT_L(0); PG8_MMA(0, 0, At, B0); PG8_BAR; PG8_SCHED;
      PG8_LDB(B1, 1, 1); PG8_STAGE(PG8_SB(1, 0), b3, voffB);
      PG8_BAR; PG8_WAIT_L(0); PG8_MMA(0, 1, At, B1); PG8_BAR;
      PG8_LDA(At, 1, 1); PG8_STAGE_A(PG8_SA(1, 0), o2a, k3);
      PG8_BAR; PG8_WAIT_L(0); PG8_MMA(1, 0, At, B0); PG8_BAR; PG8_SCHED;
      PG8_STAGE(PG8_SB(1, 1), b3 + hstepB, voffB);
      PG8_WAIT_V(6); PG8_BAR; PG8_MMA(1, 1, At, B1); PG8_BAR;
    }
    E(acc, cur, wr, wc, fr, fq);
    if (!has_next) break;
#pragma unroll
    for (int a = 0; a < 2; ++a)
#pragma unroll
      for (int b = 0; b < 2; ++b)
#pragma unroll
        for (int m = 0; m < 4; ++m)
#pragma unroll
          for (int n = 0; n < 2; ++n) acc[a][b][m][n] = (f32x4){0.f, 0.f, 0.f, 0.f};
    cur = nxt; cB = nB; ++ui;
#pragma unroll
    for (int _h = 0; _h < 2; ++_h) { oc[_h][0] = on[_h][0]; oc[_h][1] = on[_h][1]; }
  }
  PG8_WAIT_V(0);
  if (wr == 0) PG8_BAR;
  PG8_BAR;
#undef PG8_SA
#undef PG8_SB
#undef PG8_STAGE
#undef PG8_STAGE_A
#undef PG8_OFFS
#undef PG8_LDA
#undef PG8_LDB
#undef PG8_MMA
#undef PG8_WAIT_V
#undef PG8_WAIT_L
#undef PG8_BAR
#undef PG8_SCHED
}

struct EpiBf16 {
  static constexpr bool PERM = true;
  bf16_t* O; int ldc;
  __device__ __forceinline__ void operator()(const f32x4 (&acc)[2][2][4][2], const Unit& u, int wr, int wc, int fr, int fq) const {
    const int row0 = u.pm * BM + wr * 64 + fr, col0 = u.pn * BM + wc * 32 + 8 * fq;
#pragma unroll
    for (int ai = 0; ai < 2; ++ai)
#pragma unroll
      for (int m = 0; m < 4; ++m) { bf16_t* rowp = O + (size_t)(row0 + ai * HALF + m * 16) * ldc + col0;
#pragma unroll
        for (int bj = 0; bj < 2; ++bj) { const f32x4 v0 = acc[ai][bj][m][0], v1 = acc[ai][bj][m][1];
          u32x4 w; w.x = cvt_pk_bf16(v0[0], v0[1]); w.y = cvt_pk_bf16(v0[2], v0[3]); w.z = cvt_pk_bf16(v1[0], v1[1]); w.w = cvt_pk_bf16(v1[2], v1[3]);
          *(u32x4*)(rowp + bj * HALF) = w; } }
  }
};
struct EpiInProj {
  static constexpr bool PERM = true;
  bf16_t* O; int ldc; int nz; float* DT;
  __device__ __forceinline__ void operator()(const f32x4 (&acc)[2][2][4][2], const Unit& u, int wr, int wc, int fr, int fq) const {
    const int row0 = u.pm * BM + wr * 64 + fr;
    if (u.pn < nz) {
      const int col0 = u.pn * BM + wc * 32 + 8 * fq;
#pragma unroll
      for (int ai = 0; ai < 2; ++ai)
#pragma unroll
        for (int m = 0; m < 4; ++m) { bf16_t* rowp = O + (size_t)(row0 + ai * HALF + m * 16) * ldc + col0;
#pragma unroll
          for (int bj = 0; bj < 2; ++bj) { const f32x4 v0 = acc[ai][bj][m][0], v1 = acc[ai][bj][m][1];
            u32x4 w; w.x = cvt_pk_bf16(v0[0], v0[1]); w.y = cvt_pk_bf16(v0[2], v0[3]); w.z = cvt_pk_bf16(v1[0], v1[1]); w.w = cvt_pk_bf16(v1[2], v1[3]);
            *(u32x4*)(rowp + bj * HALF) = w; } }
    } else if (wc == 0) {
#pragma unroll
      for (int ai = 0; ai < 2; ++ai)
#pragma unroll
        for (int m = 0; m < 4; ++m) { float* rowp = DT + (size_t)(row0 + ai * HALF + m * 16) * 32 + 8 * fq;
          *(f32x4*)rowp = acc[ai][0][m][0]; *(f32x4*)(rowp + 4) = acc[ai][0][m][1]; }
    }
  }
};
struct EpiResid {
  static constexpr bool PERM = false;
  const float* hlat; const float* hctx; float* tlat; float* tctx; const float* gate;
  __device__ __forceinline__ void operator()(const f32x4 (&acc)[2][2][4][2], const Unit& u, int wr, int wc, int fr, int fq) const {
    const int b = u.pm / 33, tt = u.pm % 33; const bool isctx = (tt == 0);
    const float* hs = isctx ? hctx + (size_t)b * CTXL * D : hlat + ((size_t)b * SEQ + (size_t)(tt - 1) * 256) * D;
    float* td = isctx ? tctx + (size_t)b * CTXL * D : tlat + ((size_t)b * SEQ + (size_t)(tt - 1) * 256) * D;
    const float* gt = gate + (size_t)(isctx ? 4 : b) * 6144;
    const int lrow0 = wr * 64 + fr, col0 = u.pn * BM + wc * 32 + 4 * fq;
#pragma unroll
    for (int bj = 0; bj < 2; ++bj)
#pragma unroll
      for (int n = 0; n < 2; ++n) { const f32x4 gvv = *(const f32x4*)(gt + col0 + bj * HALF + n * 16);
        f32x4 hv[2][4];
#pragma unroll
        for (int ai = 0; ai < 2; ++ai)
#pragma unroll
          for (int m = 0; m < 4; ++m) hv[ai][m] = *(const f32x4*)(hs + (size_t)(lrow0 + ai * HALF + m * 16) * D + col0 + bj * HALF + n * 16);
        asm volatile("" ::: "memory");
#pragma unroll
        for (int ai = 0; ai < 2; ++ai)
#pragma unroll
          for (int m = 0; m < 4; ++m) *(f32x4*)(td + (size_t)(lrow0 + ai * HALF + m * 16) * D + col0 + bj * HALF + n * 16) = hv[ai][m] * ALPHA + gvv * acc[ai][bj][m][n];
        asm volatile("" ::: "memory"); }
  }
};
struct EpiGateMul {
  static constexpr bool PERM = true;
  bf16_t* O; int ldc; LAS float* Pl; const float* gn_gdn; const float* gn_hg;
  __device__ __forceinline__ void operator()(const f32x4 (&acc)[2][2][4][2], const Unit& u, int wr, int wc, int fr, int fq) const {
    const int row0 = u.pm * BM + wr * 64 + fr, col0 = u.pn * BM + wc * 32 + 8 * fq;
#pragma unroll
    for (int ai = 0; ai < 2; ++ai) {
      u32x4 ov[4][2];
#pragma unroll
      for (int m = 0; m < 4; ++m)
#pragma unroll
        for (int bj = 0; bj < 2; ++bj) ov[m][bj] = *(const u32x4*)(O + (size_t)(row0 + ai * HALF + m * 16) * ldc + col0 + bj * HALF);
#pragma unroll
      for (int m = 0; m < 4; ++m)
#pragma unroll
        for (int bj = 0; bj < 2; ++bj) { const u32x4 o = ov[m][bj];
          float v = (bflo(o.x) * bflo(o.x) + bfhi(o.x) * bfhi(o.x)) + (bflo(o.y) * bflo(o.y) + bfhi(o.y) * bfhi(o.y)) + (bflo(o.z) * bflo(o.z) + bfhi(o.z) * bfhi(o.z)) + (bflo(o.w) * bflo(o.w) + bfhi(o.w) * bfhi(o.w));
          v += __shfl_xor(v, 16); v += __shfl_xor(v, 32);
          if (fq == 0) Pl[(((ai * HALF + wr * 64 + m * 16 + fr) * 2 + bj) << 2) + wc] = v; }
    }
    asm volatile("s_waitcnt lgkmcnt(0)" ::: "memory"); __builtin_amdgcn_s_barrier(); asm volatile("" ::: "memory");
    const float* gn = (u.pn < 4) ? gn_gdn : gn_hg;
    const f32x4 g0 = *(const f32x4*)(gn + wc * 32 + 8 * fq), g1 = *(const f32x4*)(gn + wc * 32 + 8 * fq + 4);
#pragma unroll
    for (int ai = 0; ai < 2; ++ai) {
      u32x4 ov[4][2];
#pragma unroll
      for (int m = 0; m < 4; ++m)
#pragma unroll
        for (int bj = 0; bj < 2; ++bj) ov[m][bj] = *(const u32x4*)(O + (size_t)(row0 + ai * HALF + m * 16) * ldc + col0 + bj * HALF);
      asm volatile("" ::: "memory");
#pragma unroll
      for (int m = 0; m < 4; ++m) { bf16_t* rowp = O + (size_t)(row0 + ai * HALF + m * 16) * ldc + col0;
#pragma unroll
        for (int bj = 0; bj < 2; ++bj) { const f32x4 v0 = acc[ai][bj][m][0], v1 = acc[ai][bj][m][1]; const u32x4 o = ov[m][bj];
          const f32x4 p4 = *(const LAS f32x4*)(Pl + (((ai * HALF + wr * 64 + m * 16 + fr) * 2 + bj) << 2));
          const float rs = rsqrtf(((p4[0] + p4[1]) + (p4[2] + p4[3])) * (1.f / 128.f) + RMS_EPS);
          u32x4 w;
          w.x = cvt_pk_bf16(bflo(o.x) * rs * g0[0] * siluf_(v0[0]), bfhi(o.x) * rs * g0[1] * siluf_(v0[1])); w.y = cvt_pk_bf16(bflo(o.y) * rs * g0[2] * siluf_(v0[2]), bfhi(o.y) * rs * g0[3] * siluf_(v0[3]));
          w.z = cvt_pk_bf16(bflo(o.z) * rs * g1[0] * siluf_(v1[0]), bfhi(o.z) * rs * g1[1] * siluf_(v1[1])); w.w = cvt_pk_bf16(bflo(o.w) * rs * g1[2] * siluf_(v1[2]), bfhi(o.w) * rs * g1[3] * siluf_(v1[3]));
          *(u32x4*)(rowp + bj * HALF) = w; } }
      asm volatile("" ::: "memory");
    }
  }
};
struct EpiSwiGLU {
  static constexpr bool PERM = true;
  bf16_t* H;
  __device__ __forceinline__ void operator()(const f32x4 (&acc)[2][2][4][2], const Unit& u, int wr, int wc, int fr, int fq) const {
    const int row0 = u.pm * BM + wr * 64 + fr, col0 = (u.pn & 3) * 128 + wc * 32 + 8 * fq;
#pragma unroll
    for (int ai = 0; ai < 2; ++ai)
#pragma unroll
      for (int m = 0; m < 4; ++m) { bf16_t* rowp = H + (size_t)(row0 + ai * HALF + m * 16) * DEXP + col0;
        const f32x4 g0 = acc[ai][0][m][0], g1 = acc[ai][0][m][1], u0 = acc[ai][1][m][0], u1 = acc[ai][1][m][1];
        u32x4 w; w.x = cvt_pk_bf16(siluf_(g0[0]) * u0[0], siluf_(g0[1]) * u0[1]); w.y = cvt_pk_bf16(siluf_(g0[2]) * u0[2], siluf_(g0[3]) * u0[3]);
        w.z = cvt_pk_bf16(siluf_(g1[0]) * u1[0], siluf_(g1[1]) * u1[1]); w.w = cvt_pk_bf16(siluf_(g1[2]) * u1[2], siluf_(g1[3]) * u1[3]);
        *(u32x4*)rowp = w; }
  }
};
struct EpiMoeDown {
  static constexpr bool PERM = true;
  bf16_t* Y;
  __device__ __forceinline__ void operator()(const f32x4 (&acc)[2][2][4][2], const Unit& u, int wr, int wc, int fr, int fq) const {
    const int row0 = u.pm * BM + wr * 64 + fr, col0 = (u.pn & 3) * BM + wc * 32 + 8 * fq;
#pragma unroll
    for (int ai = 0; ai < 2; ++ai)
#pragma unroll
      for (int m = 0; m < 4; ++m) { bf16_t* rowp = Y + (size_t)(row0 + ai * HALF + m * 16) * D + col0;
#pragma unroll
        for (int bj = 0; bj < 2; ++bj) { const f32x4 v0 = acc[ai][bj][m][0], v1 = acc[ai][bj][m][1];
          u32x4 w; w.x = cvt_pk_bf16(v0[0], v0[1]); w.y = cvt_pk_bf16(v0[2], v0[3]); w.z = cvt_pk_bf16(v1[0], v1[1]); w.w = cvt_pk_bf16(v1[2], v1[3]);
          *(u32x4*)(rowp + bj * HALF) = w; } }
  }
};
}

struct Ctx {
  LAS unsigned char* lds; int tid, lane, wave, gw, ngw, bid, nblk;
};
#define GAS __attribute__((address_space(1)))
#define WS(off, T) ((T*)(GAS T*)(P.ws + (off)))
#define GIN(i) ((const float*)(const GAS float*)P.in[i])
#define GOUT ((float*)(GAS float*)P.out)

__device__ __forceinline__ void transpose_item(const float* W, int ldw, int col0, int k0, bf16_t* dst_row0, int ldd, LAS float* scr, int lane) {
  { f32x4 v[8];
#pragma unroll
    for (int i = 0; i < 8; ++i) v[i] = *(const f32x4*)(W + (size_t)(k0 + 8 * i + (lane >> 3)) * ldw + col0 + 4 * (lane & 7));
#pragma unroll
    for (int i = 0; i < 8; ++i) { LAS float* d = scr + (8 * i + (lane >> 3)) * 33 + 4 * (lane & 7); d[0] = v[i][0]; d[1] = v[i][1]; d[2] = v[i][2]; d[3] = v[i][3]; } }
  asm volatile("s_waitcnt lgkmcnt(0)" ::: "memory");
  const int c = lane & 7;
#pragma unroll
  for (int j = 0; j < 4; ++j) { const int n = (lane >> 3) + 8 * j; const LAS float* s = scr + (8 * c) * 33 + n;
    u32x4 o; o.x = pk2(s[0 * 33], s[1 * 33]); o.y = pk2(s[2 * 33], s[3 * 33]); o.z = pk2(s[4 * 33], s[5 * 33]); o.w = pk2(s[6 * 33], s[7 * 33]);
    *(u32x4*)(dst_row0 + (size_t)n * ldd + k0 + 8 * c) = o; }
  asm volatile("s_waitcnt lgkmcnt(0)" ::: "memory");
}
__device__ __forceinline__ void transpose_mat_item(const float* W, int ldw, int col0, int K, int ncols, bf16_t* dst, int ldd, int gu, int it, LAS float* scr, int lane) {
  const int nblk = ncols / 32, kb = it / nblk, nb = it % nblk, n0 = 32 * nb;
  const int drow = gu ? (256 * (n0 >> 7) + (n0 & 127) + (gu == 2 ? 128 : 0)) : n0;
  transpose_item(W, ldw, col0 + n0, 64 * kb, dst + (size_t)drow * ldd, ldd, scr, lane);
}
__device__ __forceinline__ void convert_experts(const Params& P, int layer, bf16_t* wgu, bf16_t* wd, const Ctx& C, LAS float* scr) {
  for (int it = C.gw; it < NEXP * 768; it += C.ngw) {
    const int e = it / 768, r = it % 768;
    const size_t eoff = ((size_t)layer * NEXP + e) * (size_t)D * DEXP;
    if (r < 256) transpose_mat_item(GIN(I_EWG) + eoff, DEXP, 0, D, DEXP, wgu + (size_t)e * 1024 * D, D, 1, r, scr, C.lane);
    else if (r < 512) transpose_mat_item(GIN(I_EWU) + eoff, DEXP, 0, D, DEXP, wgu + (size_t)e * 1024 * D, D, 2, r - 256, scr, C.lane);
    else transpose_mat_item(GIN(I_EWD) + eoff, D, 0, DEXP, D, wd + (size_t)e * D * DEXP, DEXP, 0, r - 512, scr, C.lane);
  }
}

__device__ __forceinline__ void row_load(const float* row, int lane, f32x4 (&v)[4]) {
#pragma unroll
  for (int j = 0; j < 4; ++j) v[j] = *(const f32x4*)(row + 4 * lane + 256 * j);
}
__device__ __forceinline__ void row_store(float* row, int lane, const f32x4 (&v)[4]) {
#pragma unroll
  for (int j = 0; j < 4; ++j) *(f32x4*)(row + 4 * lane + 256 * j) = v[j];
}
__device__ __forceinline__ void row_store_bf16(bf16_t* row, int lane, const f32x4 (&v)[4]) {
#pragma unroll
  for (int j = 0; j < 4; ++j) { u32x2 w; w.x = pk2(v[j][0], v[j][1]); w.y = pk2(v[j][2], v[j][3]); *(u32x2*)(row + 4 * lane + 256 * j) = w; }
}
__device__ __forceinline__ void row_layernorm(f32x4 (&v)[4], const float* g, const float* b, int lane) {
  float s = 0.f;
#pragma unroll
  for (int j = 0; j < 4; ++j) s += (v[j][0] + v[j][1]) + (v[j][2] + v[j][3]);
  const float mean = wave_sum(s) * (1.f / D); float s2 = 0.f;
#pragma unroll
  for (int j = 0; j < 4; ++j) { v[j] = v[j] - mean; s2 += (v[j][0] * v[j][0] + v[j][1] * v[j][1]) + (v[j][2] * v[j][2] + v[j][3] * v[j][3]); }
  const float rstd = rsqrtf(wave_sum(s2) * (1.f / D) + LN_EPS);
#pragma unroll
  for (int j = 0; j < 4; ++j) { const f32x4 gg = *(const f32x4*)(g + 4 * lane + 256 * j), bb = *(const f32x4*)(b + 4 * lane + 256 * j); v[j] = v[j] * rstd * gg + bb; }
}
__device__ __forceinline__ void row_modulate(const f32x4 (&h)[4], const float* shift, const float* scale, int lane, f32x4 (&u)[4]) {
#pragma unroll
  for (int j = 0; j < 4; ++j) { const f32x4 sh = *(const f32x4*)(shift + 4 * lane + 256 * j), sc = *(const f32x4*)(scale + 4 * lane + 256 * j); u[j] = h[j] * (sc + 1.f) + sh; }
}
__device__ __forceinline__ void row_dot32(const f32x4 (&u)[4], const LAS float* Wt, int lane, float* out32) {
  float myv = 0.f;
#pragma unroll 4
  for (int c = 0; c < 32; ++c) {
    float s = 0.f;
#pragma unroll
    for (int j = 0; j < 4; ++j) { const f32x4 w = *(const LAS f32x4*)(Wt + c * 1024 + 4 * lane + 256 * j); s += (u[j][0] * w[0] + u[j][1] * w[1]) + (u[j][2] * w[2] + u[j][3] * w[3]); }
    s = wave_sum(s);
    if (lane == c) myv = s;
  }
  if (lane < 32) out32[lane] = myv;
}
__device__ __forceinline__ void stage_cols32(const float* W, int ldw, int col0, LAS float* Wt, int tid) {
  for (int i = tid; i < 1024 * 32; i += NT) { const int k = i >> 5, c = i & 31; Wt[c * 1024 + k] = W[(size_t)k * ldw + col0 + c]; }
}
__device__ __forceinline__ const float* lat_or_ctx(const float* lat, const float* ctxp, int r) {
  const int b = r / TB, pos = r % TB;
  return pos < CTXL ? ctxp + ((size_t)b * CTXL + pos) * D : lat + ((size_t)b * SEQ + (pos - CTXL)) * D;
}
__device__ __forceinline__ float* lat_or_ctx_w(float* lat, float* ctxp, int r) {
  const int b = r / TB, pos = r % TB;
  return pos < CTXL ? ctxp + ((size_t)b * CTXL + pos) * D : lat + ((size_t)b * SEQ + (pos - CTXL)) * D;
}
__device__ __forceinline__ int row_b5(int r) { const int b = r / TB, pos = r % TB; return pos < CTXL ? 4 : b; }

__device__ __forceinline__ void phase0(const Params& P, const Ctx& C) {
  LAS float* sv = (LAS float*)C.lds;
  LAS float* part = (LAS float*)(C.lds + 20480);
  LAS float* scr = (LAS float*)(C.lds + 32768) + C.wave * (64 * 33);
  for (int i = C.tid; i < 5 * 1024; i += NT) { const float x = i < 4096 ? GIN(I_C)[i] : GIN(I_CCTX)[i - 4096]; sv[i] = siluf_(x); }
  __syncthreads();
  float* MOD = WS(OFF_MOD, float);
  for (int task = C.bid; task < 2 * 96; task += C.nblk) {
    const int l = task / 96, n0 = (task % 96) * 64;
    const float* W = GIN(I_ADAW) + (size_t)l * D * 6144 + n0 + C.lane;
    float acc[5] = {0.f, 0.f, 0.f, 0.f, 0.f};
    const int kbeg = C.wave * 128;
#pragma unroll 8
    for (int k = kbeg; k < kbeg + 128; ++k) { const float w = W[(size_t)k * 6144];
#pragma unroll
      for (int r = 0; r < 5; ++r) acc[r] += sv[r * 1024 + k] * w; }
#pragma unroll
    for (int r = 0; r < 5; ++r) part[(C.wave * 5 + r) * 64 + C.lane] = acc[r];
    __syncthreads();
    if (C.tid < 320) { const int r = C.tid / 64, c = C.tid % 64; float s = GIN(I_ADAB)[l * 6144 + n0 + c];
#pragma unroll
      for (int w = 0; w < 8; ++w) s += part[(w * 5 + r) * 64 + c];
      MOD[((size_t)l * 5 + r) * 6144 + n0 + c] = s; }
    __syncthreads();
  }
  if (C.bid == C.nblk - 1) { float* LB = WS(OFF_LB1, float); for (int i = C.tid; i < 1024; i += NT) { const float a = GIN(I_HLB)[i], b = GIN(I_HLB)[1024 + i]; LB[i] = 1.f / (1.f + __expf(a - b)); } }
  constexpr int N_AB = 16 * 144, N_OUT = 32 * 32, N_G1 = 16 * 32;
  constexpr int TOT = N_AB + 2 * N_OUT + 2 * N_G1;
  for (int it = C.gw; it < TOT; it += C.ngw) {
    int r = it;
    if (r < N_AB) { transpose_mat_item(GIN(I_ABW), AB_IN, 0, D, Z0W, WS(OFF_WAB, bf16_t), D, 0, r, scr, C.lane); continue; } r -= N_AB;
    if (r < N_OUT) { transpose_mat_item(GIN(I_OUTW), D, 0, 2048, D, WS(OFF_WOUT0, bf16_t), 2048, 0, r, scr, C.lane); continue; } r -= N_OUT;
    if (r < N_OUT) { transpose_mat_item(GIN(I_OUTW) + (size_t)2048 * D, D, 0, 2048, D, WS(OFF_WOUT1, bf16_t), 2048, 0, r, scr, C.lane); continue; } r -= N_OUT;
    if (r < N_G1) { transpose_mat_item(GIN(I_CDW), CD_IN, 3072, D, 1024, WS(OFF_WG1, bf16_t), D, 0, r, scr, C.lane); continue; } r -= N_G1;
    transpose_mat_item(GIN(I_CDW), CD_IN, 8224, D, 1024, WS(OFF_WG1, bf16_t) + (size_t)1024 * D, D, 0, r, scr, C.lane);
  }
  for (int it = C.gw; it < 16; it += C.ngw) transpose_mat_item(GIN(I_ABW), AB_IN, 4608, D, 32, WS(OFF_WAB, bf16_t) + (size_t)4608 * D, D, 0, it, scr, C.lane);
  { u32x4* z = (u32x4*)(WS(OFF_WAB, bf16_t) + (size_t)4640 * D); const u32x4 zz = {0u, 0u, 0u, 0u};
    for (int i = C.bid * NT + C.tid; i < 224 * D * 2 / 16; i += C.nblk * NT) z[i] = zz; }
  convert_experts(P, 0, WS(OFF_WE0, bf16_t), WS(OFF_WE0 + 64 * MiB, bf16_t), C, scr);
}

__device__ __forceinline__ void phase_u0(const Params& P, const Ctx& C) {
  const float* MOD = WS(OFF_MOD, float); bf16_t* U = WS(OFF_U0, bf16_t);
  f32x4 h[4], hn[4];
  if (C.gw < R) row_load(lat_or_ctx(GIN(I_X), GIN(I_CTX), C.gw), C.lane, h);
  for (int r = C.gw; r < R; r += C.ngw) {
    if (r + C.ngw < R) row_load(lat_or_ctx(GIN(I_X), GIN(I_CTX), r + C.ngw), C.lane, hn);
    f32x4 u[4];
    const float* m = MOD + (size_t)row_b5(r) * 6144;
    row_modulate(h, m, m + D, C.lane, u);
    row_store_bf16(U + (size_t)r * D, C.lane, u);
#pragma unroll
    for (int j = 0; j < 4; ++j) h[j] = hn[j];
  }
}

__device__ __forceinline__ void phase_inproj(const Params& P, const Ctx& C, const bf16_t* U, const bf16_t* W, bf16_t* Z, int zw) {
  pg8::Gemm g{U, W, D, D}; pg8::GridOrder S; S.init(R / 256, zw / 256 + 1, C.nblk, C.bid, 0);
  pg8::EpiInProj E{Z, zw, zw / 256, WS(OFF_DT, float)};
  pg8::gemm_phase(C.lds, g, S, E);
}

__device__ __forceinline__ void conv_task(bf16_t* Z, int zw, int row0, int L, int col, const float* cw, int cwld, int cch, const float* cb, int mode, float qscale, int lane, int ident = 0) {
  float w[4][2];
#pragma unroll
  for (int j = 0; j < 4; ++j) { w[j][0] = cw[j * cwld + cch + 2 * lane]; w[j][1] = cw[j * cwld + cch + 2 * lane + 1]; }
  const float b0 = cb ? cb[cch + 2 * lane] : 0.f, b1 = cb ? cb[cch + 2 * lane + 1] : 0.f;
  unsigned* base = (unsigned*)(Z + (size_t)row0 * zw + col) + lane;
  const size_t rs = (size_t)zw / 2;
  float pm2[2] = {0.f, 0.f}, pm1[2] = {0.f, 0.f};
  for (int t0 = 0; t0 < L; t0 += 32) {
    unsigned v[33];
#pragma unroll
    for (int i = 0; i < 32; ++i) v[i] = base[(size_t)(t0 + i) * rs];
    v[32] = (t0 + 32 < L) ? base[(size_t)(t0 + 32) * rs] : 0u;
    unsigned o[32];
#pragma unroll
    for (int i = 0; i < 32; ++i) {
      const float x0 = bflo(v[i]), x1 = bfhi(v[i]), n0 = bflo(v[i + 1]), n1 = bfhi(v[i + 1]);
      float y0 = w[0][0] * pm2[0] + w[1][0] * pm1[0] + w[2][0] * x0 + w[3][0] * n0 + b0;
      float y1 = w[0][1] * pm2[1] + w[1][1] * pm1[1] + w[2][1] * x1 + w[3][1] * n1 + b1;
      pm2[0] = pm1[0]; pm2[1] = pm1[1]; pm1[0] = x0; pm1[1] = x1;
      if (mode >= 1) { y0 = siluf_(y0); y1 = siluf_(y1); }
      if (mode == 2) { const float ss = wave_sum(y0 * y0 + y1 * y1); const float sc = rsqrtf(ss + RMS_EPS) * qscale; y0 *= sc; y1 *= sc; }
      o[i] = ident ? v[i] : pk2(y0, y1);
    }
#pragma unroll
    for (int i = 0; i < 32; ++i) base[(size_t)(t0 + i) * rs] = o[i];
  }
}
__device__ __forceinline__ void seg_rows(int seg, int& row0, int& L) {
  const int b = seg / 129, s = seg % 129;
  if (s == 0) { row0 = b * TB; L = CTXL; } else { row0 = b * TB + CTXL + (s - 1) * 64; L = 64; }
}
__device__ __forceinline__ void phase_feat0(const Params& P, const Ctx& C, int ident) {
  bf16_t* Z = WS(OFF_Z0, bf16_t);
  for (int task = C.gw; task < NB * 129 * 20; task += C.ngw) {
    const int seg = task / 20, cg = task % 20; int row0, L; seg_rows(seg, row0, L);
    if (cg < 8) conv_task(Z, Z0W, row0, L, Z0_RGX + cg * 128, GIN(I_RGCW), 1024, cg * 128, GIN(I_RGCB), 0, 1.f, C.lane, ident);
    else conv_task(Z, Z0W, row0, L, Z0_XBC + (cg - 8) * 128, GIN(I_SCW), 1536, (cg - 8) * 128, GIN(I_SCB), 1, 1.f, C.lane, ident);
  }
}
__device__ __forceinline__ void phase_feat1(const Params& P, const Ctx& C, int ident) {
  bf16_t* Z = WS(OFF_Z1, bf16_t);
  for (int task = C.gw; task < NB * 129 * 24; task += C.ngw) {
    const int seg = task / 24, cg = task % 24; int row0, L; seg_rows(seg, row0, L);
    if (cg < 16) conv_task(Z, Z1W, row0, L, cg * 128, GIN(I_GCW), 3072, cg * 128, nullptr, 2, cg < 8 ? 0.08838834764831845f : 1.f, C.lane, ident);
    else conv_task(Z, Z1W, row0, L, cg * 128, GIN(I_GCW), 3072, cg * 128, nullptr, 1, 1.f, C.lane, ident);
  }
}

__device__ __forceinline__ int seq_pos(int dir, int j) { return dir == 0 ? j : (j < CTXL ? CTXL - 1 - j : TB - 1 - (j - CTXL)); }
__device__ __forceinline__ int seq_chunk(int dir, int j) { return dir == 0 ? j : (j < 4 ? 3 - j : 135 - j); }

__device__ __forceinline__ void rg_task(const Params& P, const Ctx& C, int task) {
  const int b = task >> 6, h = (task >> 3) & 7, q = task & 7;
  LAS float* Wl = (LAS float*)C.lds;
  LAS float* xc = Wl + 2 * 2 * 128 * 16;
  LAS float* SA = xc + 64 * 129;
  LAS float* SU = SA + 16 * 64;
  const bf16_t* Z = WS(OFF_Z0, bf16_t); bf16_t* MIX = WS(OFF_MIX0, bf16_t);
  __syncthreads();
  for (int i = C.tid; i < 2 * 2 * 128 * 16; i += NT) { const int j = i & 15, ii = (i >> 4) & 127, gate = (i >> 11) & 1, d = i >> 12;
    const float* W = (gate ? GIN(I_RGXW) : GIN(I_RGAW)) + ((size_t)(d * 8 + h) * 128 + ii) * 128 + q * 16 + j; Wl[i] = *W; }
  const int j = C.tid & 15, tg = C.tid >> 4;
  const int ch = h * 128 + q * 16 + j;
  const int sch = C.wave * 2;
  for (int d = 0; d < 2; ++d) {
    const float ba = GIN(I_RGAB)[d * 1024 + ch], bx = GIN(I_RGXB)[d * 1024 + ch], spl = softplusf_(-GIN(I_RGLAM)[d * 1024 + ch]);
    float hin0 = 0.f, hin1 = 0.f;
    for (int cs = 0; cs < 132; ++cs) {
      const int chunk = seq_chunk(d, cs), row0 = b * TB + chunk * 64;
      __syncthreads();
      { const int t = C.tid >> 3, sg = C.tid & 7; const u32x4* src = (const u32x4*)(Z + (size_t)(row0 + t) * Z0W + Z0_RGX + h * 128 + sg * 16);
        const u32x4 a = src[0], bb = src[1]; LAS float* dst = xc + t * 129 + sg * 16;
        dst[0] = bflo(a.x); dst[1] = bfhi(a.x); dst[2] = bflo(a.y); dst[3] = bfhi(a.y); dst[4] = bflo(a.z); dst[5] = bfhi(a.z); dst[6] = bflo(a.w); dst[7] = bfhi(a.w);
        dst[8] = bflo(bb.x); dst[9] = bfhi(bb.x); dst[10] = bflo(bb.y); dst[11] = bfhi(bb.y); dst[12] = bflo(bb.z); dst[13] = bfhi(bb.z); dst[14] = bflo(bb.w); dst[15] = bfhi(bb.w); }
      __syncthreads();
      { const LAS float* Wa = Wl + (d * 2 + 0) * 2048 + j; const LAS float* Wx = Wl + (d * 2 + 1) * 2048 + j;
        const LAS float* x0 = xc + (2 * tg) * 129; const LAS float* x1 = x0 + 129;
        float aa0 = 0.f, aa1 = 0.f, ax0 = 0.f, ax1 = 0.f;
#pragma unroll 8
        for (int i = 0; i < 128; ++i) { const float wa = Wa[i * 16], wx = Wx[i * 16], v0 = x0[i], v1 = x1[i]; aa0 += v0 * wa; aa1 += v1 * wa; ax0 += v0 * wx; ax1 += v1 * wx; }
#pragma unroll
        for (int tt = 0; tt < 2; ++tt) { const int t = 2 * tg + tt; const float pa = tt ? aa1 : aa0, px = tt ? ax1 : ax0;
          const float r = sigmoidf_(pa + ba), ig = sigmoidf_(px + bx); const float la = -8.f * r * spl; const float xv = xc[t * 129 + q * 16 + j];
          SA[j * 64 + t] = __expf(la); SU[j * 64 + t] = sqrtf(-expm1f(2.f * la)) * (ig * xv); } }
      __syncthreads();
#pragma unroll
      for (int cc = 0; cc < 2; ++cc) {
        const int lc = sch + cc; const int t = d == 0 ? C.lane : 63 - C.lane;
        float A = SA[lc * 64 + t], Bv = SU[lc * 64 + t];
#pragma unroll
        for (int off = 1; off < 64; off <<= 1) { const float Ap = __shfl_up(A, off), Bp = __shfl_up(Bv, off); if (C.lane >= off) { Bv = A * Bp + Bv; A = A * Ap; } }
        const float hin = cc ? hin1 : hin0; const float hv = Bv + A * hin;
        const float hlast = __shfl(hv, 63); if (cc) hin1 = hlast; else hin0 = hlast;
        const int gch = h * 128 + q * 16 + lc; bf16_t* o = MIX + (size_t)(row0 + t) * MIXW + gch;
        if (d == 0) *o = (bf16_t)f2bf(hv);
        else { const float hf = bf2f(*o); const float gy = bf2f(Z[(size_t)(row0 + t) * Z0W + Z0_RGY + gch]); *o = (bf16_t)f2bf((hf + hv) * geluf_(gy)); }
      }
    }
    __threadfence_block();
  }
}
__device__ __forceinline__ void ssd_task(const Params& P, const Ctx& C, int task) {
  const int b = task >> 9, hd = (task >> 5) & 15, ps = task & 31, g = hd >> 3;
  const int c = C.lane >> 5, ng = C.lane & 31;
  const bf16_t* Z = WS(OFF_Z0, bf16_t); bf16_t* MIX = WS(OFF_MIX0, bf16_t); const float* DT = WS(OFF_DT, float);
  const int colx = Z0_XBC + hd * 64 + 2 * ps + c, colB = Z0_B + g * 128 + 4 * ng, colC = Z0_C + g * 128 + 4 * ng, outc = 1024 + hd * 64 + 2 * ps + c;
  for (int d = 0; d < 2; ++d) {
    const float Aneg = -__expf(GIN(I_SALOG)[d * 16 + hd]), dtb = GIN(I_SDTB)[d * 16 + hd];
    float S0 = 0.f, S1 = 0.f, S2 = 0.f, S3 = 0.f;
    for (int j0 = 0; j0 < TB; j0 += 8) {
      u32x2 Bv[8], Cv[8]; unsigned short xv[8], yp[8]; float dtr[8];
#pragma unroll
      for (int u = 0; u < 8; ++u) { const size_t row = (size_t)b * TB + seq_pos(d, j0 + u);
        Bv[u] = *(const u32x2*)(Z + row * Z0W + colB); Cv[u] = *(const u32x2*)(Z + row * Z0W + colC); xv[u] = Z[row * Z0W + colx]; dtr[u] = DT[row * 32 + d * 16 + hd];
        yp[u] = d ? MIX[row * MIXW + outc] : (unsigned short)0; }
#pragma unroll
      for (int u = 0; u < 8; ++u) { const size_t row = (size_t)b * TB + seq_pos(d, j0 + u);
        const float dt = softplusf_(dtr[u] + dtb), a = __expf(Aneg * dt), xdt = bf2f(xv[u]) * dt;
        S0 = a * S0 + bflo(Bv[u].x) * xdt; S1 = a * S1 + bfhi(Bv[u].x) * xdt; S2 = a * S2 + bflo(Bv[u].y) * xdt; S3 = a * S3 + bfhi(Bv[u].y) * xdt;
        float y = (bflo(Cv[u].x) * S0 + bfhi(Cv[u].x) * S1) + (bflo(Cv[u].y) * S2 + bfhi(Cv[u].y) * S3);
        y = half_sum32(y);
        if (ng == 0) MIX[row * MIXW + outc] = (bf16_t)f2bf(y + bf2f(yp[u])); }
    }
    __threadfence_block();
  }
}

#define LBAR() do { asm volatile("s_waitcnt lgkmcnt(0)" ::: "memory"); __builtin_amdgcn_s_barrier(); asm volatile("" ::: "memory"); } while (0)
#define VMWAIT() asm volatile("s_waitcnt vmcnt(0)" ::: "memory")
typedef short s16x4 __attribute__((ext_vector_type(4)));
__device__ __forceinline__ bf16x8 frag_row(const LAS bf16_t* base, int ld, int r0, int k0, int lane) {
  return *(const LAS bf16x8*)(base + (r0 + (lane & 15)) * ld + k0 + 8 * (lane >> 4));
}
__device__ __forceinline__ bf16x8 frag_tr(const LAS bf16_t* base, int ld, int k0, int n0, int lane) {
  const int g = lane >> 4, q = (lane & 15) >> 2, p = lane & 3;
  const LAS bf16_t* a0 = base + (k0 + 8 * g + q) * ld + n0 + 4 * p;
  const s16x4 v0 = __builtin_amdgcn_ds_read_tr16_b64_v4i16((LAS s16x4*)a0);
  const s16x4 v1 = __builtin_amdgcn_ds_read_tr16_b64_v4i16((LAS s16x4*)(a0 + 4 * ld));
  bf16x8 r; r[0] = v0[0]; r[1] = v0[1]; r[2] = v0[2]; r[3] = v0[3]; r[4] = v1[0]; r[5] = v1[1]; r[6] = v1[2]; r[7] = v1[3];
  return r;
}
__device__ __forceinline__ f32x4 mma16(bf16x8 fa, bf16x8 fb, f32x4 acc) { return __builtin_amdgcn_mfma_f32_16x16x32_bf16(fa, fb, acc, 0, 0, 0); }
__device__ __forceinline__ float wave_incl_scan(float v, int lane) {
#pragma unroll
  for (int off = 1; off < 64; off <<= 1) { const float p = __shfl_up(v, off); if (lane >= off) v += p; }
  return v;
}
__device__ __forceinline__ void tri_tile(int tt, int& I, int& J) { I = tt >= 6 ? 3 : (tt >= 3 ? 2 : (tt >= 1 ? 1 : 0)); J = tt - (I * (I + 1)) / 2; }
__device__ __forceinline__ unsigned long long ld_agent_u64(const void* p) { return __hip_atomic_load((const unsigned long long*)p, __ATOMIC_RELAXED, __HIP_MEMORY_SCOPE_AGENT); }
__device__ __forceinline__ bool fwd_first(int c) { return c < 4 ? (c <= 1) : (c <= 67); }

__device__ __forceinline__ void ssd_chain_wg(const Params& P, const Ctx& C, int task) {
  const int b = task >> 5, hd = (task >> 1) & 15, ps = task & 1, g = hd >> 3;
  const int d = C.wave >> 2, w = C.wave & 3, td = C.tid & 255, lane = C.lane, fr = lane & 15, fq = lane >> 4;
  constexpr int LDN = 136, LDP = 40, LDT = 72;
  constexpr int DIRSZ = 78 * 1024;
  LAS unsigned char* L = C.lds + d * DIRSZ;
  LAS bf16_t* Cs = (LAS bf16_t*)L;
  LAS bf16_t* Bs = Cs + 64 * LDN;
  LAS bf16_t* Xd = Bs + 64 * LDN;
  LAS bf16_t* Xw = Xd + 64 * LDP;
  LAS bf16_t* Pt = Xw + 64 * LDP;
  LAS bf16_t* St = Pt + 64 * LDT;
  LAS float* dtL = (LAS float*)(St + 2 * 32 * LDN);
  const bf16_t* Z = WS(OFF_Z0, bf16_t); bf16_t* MIX = WS(OFF_MIX0, bf16_t); const float* DT = WS(OFF_DT, float);
  const float Aneg = -__expf(GIN(I_SALOG)[d * 16 + hd]), dtb = GIN(I_SDTB)[d * 16 + hd];
  const int colC = Z0_C + g * 128, colB = Z0_B + g * 128, colX = Z0_XBC + hd * 64 + ps * 32, outc = 1024 + hd * 64 + ps * 32;
  __syncthreads();
  for (int i = td; i < 64 * LDT / 2; i += 256) ((LAS unsigned*)Pt)[i] = 0u;
  for (int i = td; i < 2 * 32 * LDN / 2; i += 256) ((LAS unsigned*)St)[i] = 0u;
  f32x4 Sacc[2][2];
#pragma unroll
  for (int a = 0; a < 2; ++a)
#pragma unroll
    for (int c = 0; c < 2; ++c) Sacc[a][c] = (f32x4){0.f, 0.f, 0.f, 0.f};
  const int st_t = td >> 2, st_q = td & 3;
  u32x4 rc[4], rb[4], rx; float rdt = 0.f;
  auto issue_loads = [&](int step) {
    const int chunk = seq_chunk(d, step); const size_t row = (size_t)b * TB + chunk * 64 + st_t;
    const u32x4* pc = (const u32x4*)(Z + row * Z0W + colC + st_q * 32); const u32x4* pb = (const u32x4*)(Z + row * Z0W + colB + st_q * 32);
#pragma unroll
    for (int i = 0; i < 4; ++i) { rc[i] = pc[i]; rb[i] = pb[i]; }
    rx = *(const u32x4*)(Z + row * Z0W + colX + st_q * 8);
    rdt = DT[row * 32 + d * 16 + hd];
  };
  issue_loads(0);
  for (int step = 0; step < 132; ++step) {
    const int chunk = seq_chunk(d, step); const int row0 = b * TB + chunk * 64;
    VMWAIT();
    { const int i = d ? 63 - st_t : st_t; const float dt = softplusf_(rdt + dtb);
      LAS u32x4* dc = (LAS u32x4*)(Cs + i * LDN + st_q * 32); LAS u32x4* db = (LAS u32x4*)(Bs + i * LDN + st_q * 32);
#pragma unroll
      for (int k = 0; k < 4; ++k) { dc[k] = rc[k]; db[k] = rb[k]; }
      u32x4 xo; xo.x = pk2(bflo(rx.x) * dt, bfhi(rx.x) * dt); xo.y = pk2(bflo(rx.y) * dt, bfhi(rx.y) * dt); xo.z = pk2(bflo(rx.z) * dt, bfhi(rx.z) * dt); xo.w = pk2(bflo(rx.w) * dt, bfhi(rx.w) * dt);
      *(LAS u32x4*)(Xd + i * LDP + st_q * 8) = xo;
      if (st_q == 0) dtL[i] = dt; }
    LBAR();
    if (step + 1 < 132) issue_loads(step + 1);
    const bool first = (d == 0) == fwd_first(chunk);
    bf16_t* op0; unsigned long long ppv[2] = {0ull, 0ull};
    { const int ii = 16 * w + fr; const int t = d ? 63 - ii : ii; op0 = MIX + (size_t)(row0 + t) * MIXW + outc + 4 * fq;
      if (!first) { ppv[0] = ld_agent_u64(op0); ppv[1] = ld_agent_u64(op0 + 16); } }
    const float cum = wave_incl_scan(Aneg * dtL[lane], lane);
    const float cum_last = __shfl(cum, 63);
    { const int i = td >> 2; const float sc = __expf(cum_last - __shfl(cum, i & 63));
      const u32x4 v = *(const LAS u32x4*)(Xd + i * LDP + (td & 3) * 8);
      u32x4 o; o.x = pk2(bflo(v.x) * sc, bfhi(v.x) * sc); o.y = pk2(bflo(v.y) * sc, bfhi(v.y) * sc); o.z = pk2(bflo(v.z) * sc, bfhi(v.z) * sc); o.w = pk2(bflo(v.w) * sc, bfhi(v.w) * sc);
      *(LAS u32x4*)(Xw + i * LDP + (td & 3) * 8) = o; }
    for (int tt = w; tt < 10; tt += 4) {
      int I, J; tri_tile(tt, I, J);
      f32x4 acc = (f32x4){0.f, 0.f, 0.f, 0.f};
#pragma unroll
      for (int k = 0; k < 4; ++k) acc = mma16(frag_row(Cs, LDN, 16 * I, 32 * k, lane), frag_row(Bs, LDN, 16 * J, 32 * k, lane), acc);
      const int jj = 16 * J + fr; const float cj = __shfl(cum, jj);
      u32x2 o; float pv[4];
#pragma unroll
      for (int r = 0; r < 4; ++r) { const int ii = 16 * I + 4 * fq + r; const float ci = __shfl(cum, ii); pv[r] = (jj <= ii) ? acc[r] * __expf(ci - cj) : 0.f; }
      o.x = pk2(pv[0], pv[1]); o.y = pk2(pv[2], pv[3]);
      *(LAS u32x2*)(Pt + jj * LDT + 16 * I + 4 * fq) = o;
    }
    LBAR();
    const LAS bf16_t* Sr = St + (step & 1) * 32 * LDN; LAS bf16_t* Sw = St + ((step + 1) & 1) * 32 * LDN;
    { const int I = w; const int nks = I < 2 ? 1 : 2;
      const int ii = 16 * I + fr; const float eci = __expf(__shfl(cum, ii));
#pragma unroll
      for (int pt = 0; pt < 2; ++pt) {
        f32x4 y1 = (f32x4){0.f, 0.f, 0.f, 0.f}, y2 = (f32x4){0.f, 0.f, 0.f, 0.f};
        for (int k = 0; k < nks; ++k) y1 = mma16(frag_tr(Xd, LDP, 32 * k, 16 * pt, lane), frag_tr(Pt, LDT, 32 * k, 16 * I, lane), y1);
#pragma unroll
        for (int k = 0; k < 4; ++k) y2 = mma16(frag_row(Sr, LDN, 16 * pt, 32 * k, lane), frag_row(Cs, LDN, 16 * I, 32 * k, lane), y2);
        bf16_t* op = op0 + 16 * pt;
        float o0 = y1[0] + eci * y2[0], o1 = y1[1] + eci * y2[1], o2 = y1[2] + eci * y2[2], o3 = y1[3] + eci * y2[3];
        if (!first) { const unsigned long long pv = ppv[pt]; const unsigned lo = (unsigned)pv, hi = (unsigned)(pv >> 32); o0 += bflo(lo); o1 += bfhi(lo); o2 += bflo(hi); o3 += bfhi(hi); }
        u32x2 o; o.x = pk2(o0, o1); o.y = pk2(o2, o3); *(u32x2*)op = o;
      } }
    { const float el = __expf(cum_last);
#pragma unroll
      for (int a = 0; a < 2; ++a)
#pragma unroll
        for (int c = 0; c < 2; ++c) { f32x4 acc = Sacc[a][c] * el;
#pragma unroll
          for (int k = 0; k < 2; ++k) acc = mma16(frag_tr(Bs, LDN, 32 * k, 16 * (2 * w + a), lane), frag_tr(Xw, LDP, 32 * k, 16 * c, lane), acc);
          Sacc[a][c] = acc;
          u32x2 o; o.x = pk2(acc[0], acc[1]); o.y = pk2(acc[2], acc[3]);
          *(LAS u32x2*)(Sw + (16 * c + fr) * LDN + 16 * (2 * w + a) + 4 * fq) = o; } }
    LBAR();
  }
}

template <int N> __device__ __forceinline__ float dpp_shr(float oldv, float v) {
  return __builtin_bit_cast(float, __builtin_amdgcn_update_dpp(__builtin_bit_cast(int, oldv), __builtin_bit_cast(int, v), 0x110 + N, 0xf, 0xf, false));
}
__device__ __forceinline__ float fast_sigmoid(float x) { return __builtin_amdgcn_rcpf(1.f + __expf(-x)); }
__device__ __forceinline__ void rg_chain_wg(const Params& P, const Ctx& C, int task) {
  const int b = task >> 5, h = (task >> 2) & 7, q = task & 3;
  const int d = C.wave >> 2, w = C.wave & 3, td = C.tid & 255, lane = C.lane, fr = lane & 15, fq = lane >> 4;
  constexpr int LDN = 136, LDW = 72;
  constexpr int DIRSZ = 40 * 1024;
  LAS unsigned char* L = C.lds + d * DIRSZ;
  LAS bf16_t* Xc = (LAS bf16_t*)L;
  LAS bf16_t* Wl = Xc + 64 * LDN;
  LAS float* Sum = (LAS float*)(Wl + 128 * LDW);
  const bf16_t* Z = WS(OFF_Z0, bf16_t); bf16_t* MIX = WS(OFF_MIX0, bf16_t);
  const int ch0 = h * 128 + q * 32;
  __syncthreads();
#pragma unroll 2
  for (int i = td; i < 128 * 64; i += 256) { const int ii = i >> 6, j = i & 63, gate = j >> 5, jj = j & 31;
    const float* W = (gate ? GIN(I_RGXW) : GIN(I_RGAW)) + ((size_t)(d * 8 + h) * 128 + ii) * 128 + q * 32 + jj; Wl[ii * LDW + j] = (bf16_t)f2bf(*W); }
  float ba[8], bx[8], spl[8], hc[8];
#pragma unroll
  for (int e = 0; e < 8; ++e) { const int c = ch0 + 16 * (e >> 2) + 4 * fq + (e & 3);
    ba[e] = GIN(I_RGAB)[d * 1024 + c]; bx[e] = GIN(I_RGXB)[d * 1024 + c]; spl[e] = -8.f * softplusf_(-GIN(I_RGLAM)[d * 1024 + c]); hc[e] = 0.f; }
  const int st_t = td >> 2, st_p = td & 3;
  u32x4 rx[4];
  auto issue_loads = [&](int step) {
    const int chunk = seq_chunk(d, step); const size_t row = (size_t)b * TB + chunk * 64 + st_t;
    const u32x4* px = (const u32x4*)(Z + row * Z0W + Z0_RGX + h * 128 + st_p * 32);
#pragma unroll
    for (int i = 0; i < 4; ++i) rx[i] = px[i];
  };
  issue_loads(0);
  __syncthreads();
  const int ii = 16 * w + fr;
  const LAS bf16_t* xrow = Xc + ii * LDN + q * 32 + 4 * fq;
  for (int step = 0; step < 132; ++step) {
    const int chunk = seq_chunk(d, step); const int row0 = b * TB + chunk * 64;
    VMWAIT();
    { const int i = d ? 63 - st_t : st_t; LAS u32x4* dx = (LAS u32x4*)(Xc + i * LDN + st_p * 32);
#pragma unroll
      for (int k = 0; k < 4; ++k) dx[k] = rx[k]; }
    LBAR();
    if (step + 1 < 132) issue_loads(step + 1);
    const bool first = (d == 0) == fwd_first(chunk);
    const int t = d ? 63 - ii : ii;
    bf16_t* op = MIX + (size_t)(row0 + t) * MIXW + ch0 + 4 * fq;
    unsigned long long ppv[2] = {0ull, 0ull}; u32x2 gy[2] = {(u32x2){0u, 0u}, (u32x2){0u, 0u}};
    if (!first) { ppv[0] = ld_agent_u64(op); ppv[1] = ld_agent_u64(op + 16);
      const bf16_t* gp = Z + (size_t)(row0 + t) * Z0W + Z0_RGY + ch0 + 4 * fq; gy[0] = *(const u32x2*)gp; gy[1] = *(const u32x2*)(gp + 16); }
    f32x4 ga[2], gx[2];
#pragma unroll
    for (int jt = 0; jt < 2; ++jt) { ga[jt] = (f32x4){0.f, 0.f, 0.f, 0.f}; gx[jt] = (f32x4){0.f, 0.f, 0.f, 0.f}; }
#pragma unroll
    for (int k = 0; k < 4; ++k) { const bf16x8 fb = frag_row(Xc, LDN, 16 * w, 32 * k, lane);
#pragma unroll
      for (int jt = 0; jt < 2; ++jt) { ga[jt] = mma16(frag_tr(Wl, LDW, 32 * k, 16 * jt, lane), fb, ga[jt]); gx[jt] = mma16(frag_tr(Wl, LDW, 32 * k, 32 + 16 * jt, lane), fb, gx[jt]); } }
    float A[8], Bv[8];
#pragma unroll
    for (int jt = 0; jt < 2; ++jt) { const u32x2 xw = *(const LAS u32x2*)(xrow + 16 * jt); const float xv[4] = {bflo(xw.x), bfhi(xw.x), bflo(xw.y), bfhi(xw.y)};
#pragma unroll
      for (int r = 0; r < 4; ++r) { const int e = 4 * jt + r;
        const float rg = fast_sigmoid(ga[jt][r] + ba[e]), ig = fast_sigmoid(gx[jt][r] + bx[e]); const float la = rg * spl[e];
        const float a = __expf(la); A[e] = a; Bv[e] = sqrtf(fmaxf(1.f - a * a, 0.f)) * (ig * xv[r]); } }
#pragma unroll
    for (int e = 0; e < 8; ++e) {
      { const float Ap = dpp_shr<1>(1.f, A[e]), Bp = dpp_shr<1>(0.f, Bv[e]); Bv[e] = A[e] * Bp + Bv[e]; A[e] = A[e] * Ap; }
      { const float Ap = dpp_shr<2>(1.f, A[e]), Bp = dpp_shr<2>(0.f, Bv[e]); Bv[e] = A[e] * Bp + Bv[e]; A[e] = A[e] * Ap; }
      { const float Ap = dpp_shr<4>(1.f, A[e]), Bp = dpp_shr<4>(0.f, Bv[e]); Bv[e] = A[e] * Bp + Bv[e]; A[e] = A[e] * Ap; }
      { const float Ap = dpp_shr<8>(1.f, A[e]), Bp = dpp_shr<8>(0.f, Bv[e]); Bv[e] = A[e] * Bp + Bv[e]; A[e] = A[e] * Ap; } }
    if (fr == 15) {
#pragma unroll
      for (int e = 0; e < 8; ++e) { f32x2 sv; sv[0] = A[e]; sv[1] = Bv[e]; *(LAS f32x2*)(Sum + ((w * 32) + 16 * (e >> 2) + 4 * fq + (e & 3)) * 2) = sv; } }
    LBAR();
    float hin[8];
#pragma unroll
    for (int e = 0; e < 8; ++e) { float hh = hc[e]; const int c = 16 * (e >> 2) + 4 * fq + (e & 3);
#pragma unroll
      for (int tt = 0; tt < 4; ++tt) { const f32x2 sv = *(const LAS f32x2*)(Sum + (tt * 32 + c) * 2); if (tt == w) hin[e] = hh; hh = sv[0] * hh + sv[1]; }
      hc[e] = hh; }
#pragma unroll
    for (int jt = 0; jt < 2; ++jt) { float hv[4];
#pragma unroll
      for (int r = 0; r < 4; ++r) hv[r] = Bv[4 * jt + r] + A[4 * jt + r] * hin[4 * jt + r];
      if (!first) { const unsigned lo = (unsigned)ppv[jt], hi = (unsigned)(ppv[jt] >> 32);
        const float gyv[4] = {bflo(gy[jt].x), bfhi(gy[jt].x), bflo(gy[jt].y), bfhi(gy[jt].y)}; const float pf[4] = {bflo(lo), bfhi(lo), bflo(hi), bfhi(hi)};
#pragma unroll
        for (int r = 0; r < 4; ++r) { const float x = gyv[r]; const float u2 = 1.5957691216057308f * (x + 0.044715f * x * x * x); hv[r] = (hv[r] + pf[r]) * x * fast_sigmoid(u2); } }
      u32x2 o; o.x = pg8::cvt_pk_bf16(hv[0], hv[1]); o.y = pg8::cvt_pk_bf16(hv[2], hv[3]); *(u32x2*)(op + 16 * jt) = o; }
  }
}
__device__ __forceinline__ void phase_chain0(const Params& P, const Ctx& C, int mode) {
  if (mode != 2) for (int task = C.bid; task < 128; task += C.nblk) ssd_chain_wg(P, C, task);
  __builtin_amdgcn_sched_barrier(0);
  if (mode != 1) for (int task = C.bid < 128 ? C.bid + C.nblk : C.bid; task < 256; task += C.nblk) rg_chain_wg(P, C, task - 128);
}
__device__ __forceinline__ void phase_ssdfin(const Params& P, const Ctx& C, int ident) {
  const bf16_t* Z = WS(OFF_Z0, bf16_t); bf16_t* MIX = WS(OFF_MIX0, bf16_t);
  for (int r = C.gw; r < R; r += C.ngw) {
    f32x4 y[4];
#pragma unroll
    for (int j = 0; j < 4; ++j) { const int e = 4 * C.lane + 256 * j; const float dsk = GIN(I_SD)[e >> 6];
      const u32x2 ys = *(const u32x2*)(MIX + (size_t)r * MIXW + 1024 + e), xs = *(const u32x2*)(Z + (size_t)r * Z0W + Z0_XBC + e), zz = *(const u32x2*)(Z + (size_t)r * Z0W + Z0_SSDZ + e);
      y[j][0] = (bflo(ys.x) + dsk * bflo(xs.x)) * siluf_(bflo(zz.x)); y[j][1] = (bfhi(ys.x) + dsk * bfhi(xs.x)) * siluf_(bfhi(zz.x));
      y[j][2] = (bflo(ys.y) + dsk * bflo(xs.y)) * siluf_(bflo(zz.y)); y[j][3] = (bfhi(ys.y) + dsk * bfhi(xs.y)) * siluf_(bfhi(zz.y)); }
    float s0 = 0.f, s1 = 0.f;
#pragma unroll
    for (int i = 0; i < 4; ++i) { s0 += y[0][i] * y[0][i] + y[1][i] * y[1][i]; s1 += y[2][i] * y[2][i] + y[3][i] * y[3][i]; }
    const float r0 = rsqrtf(wave_sum(s0) * (1.f / 512.f) + RMS_EPS), r1 = rsqrtf(wave_sum(s1) * (1.f / 512.f) + RMS_EPS);
#pragma unroll
    for (int j = 0; j < 4; ++j) { const int e = 4 * C.lane + 256 * j; const f32x4 gn = *(const f32x4*)(GIN(I_SNG) + e); const float rr = j < 2 ? r0 : r1;
      u32x2 w; w.x = pk2(y[j][0] * rr * gn[0], y[j][1] * rr * gn[1]); w.y = pk2(y[j][2] * rr * gn[2], y[j][3] * rr * gn[3]);
      if (ident) w = *(const u32x2*)(MIX + (size_t)r * MIXW + 1024 + e);
      *(u32x2*)(MIX + (size_t)r * MIXW + 1024 + e) = w; }
  }
}

__device__ __forceinline__ void phase_outproj(const Params& P, const Ctx& C, int layer) {
  const float* MOD = WS(OFF_MOD, float) + (size_t)layer * 5 * 6144;
  pg8::Gemm g{layer ? WS(OFF_MIX1, bf16_t) : WS(OFF_MIX0, bf16_t), layer ? WS(OFF_WOUT1, bf16_t) : WS(OFF_WOUT0, bf16_t), MIXW, MIXW};
  pg8::GridOrder S; if (layer) S.init(128, 4, C.nblk, C.bid, 1); else S.init(132, 4, C.nblk, C.bid, 0);
  pg8::EpiResid E{layer ? GOUT : GIN(I_X), layer ? WS(OFF_HCTX, float) : GIN(I_CTX), GOUT, WS(OFF_TCTX, float), MOD + 2 * D};
  pg8::gemm_phase(C.lds, g, S, E);
}

__device__ __forceinline__ void phase_lnmix(const Params& P, const Ctx& C, int layer, int ident) {
  LAS float* Wt = (LAS float*)C.lds;
  { const float* gw = GIN(I_RGW) + (size_t)layer * D * 4; const float* ew = GIN(I_REW) + (size_t)layer * D * 32;
    for (int i = C.tid; i < 1024 * 4; i += NT) { const int k = i >> 2, c = i & 3; Wt[c * 1024 + k] = gw[i]; }
    for (int i = C.tid; i < 1024 * 32; i += NT) { const int k = i >> 5, c = i & 31; Wt[(4 + c) * 1024 + k] = ew[i]; } }
  __syncthreads();
  const float* MOD = WS(OFF_MOD, float) + (size_t)layer * 5 * 6144;
  const float* lng = GIN(I_LNMG) + layer * D; const float* lnb = GIN(I_LNMB) + layer * D;
  const float* rgb = GIN(I_RGB) + layer * 4; const float* reb = GIN(I_REB) + layer * 32;
  bf16_t* V = layer ? WS(OFF_V1, bf16_t) : WS(OFF_U0, bf16_t);
  int* cnt = WS(OFF_CTL, int) + layer * 32; int* route = WS(OFF_ROUTE, int); unsigned short* tok = WS(OFF_TOK, unsigned short);
  LAS int* lcnt = (LAS int*)(C.lds + 36 * 1024 * 4);
  if (C.tid < NEXP) lcnt[C.tid] = 0;
  __syncthreads();
  const int nrows = layer ? RLAT : R;
  f32x4 h[4], hn[4];
  if (C.gw < nrows) row_load(lat_or_ctx_w(GOUT, WS(OFF_TCTX, float), rmap(layer, C.gw)), C.lane, h);
  for (int q = C.gw; q < nrows; q += C.ngw) {
    const int r = rmap(layer, q);
    if (q + C.ngw < nrows) row_load(lat_or_ctx_w(GOUT, WS(OFF_TCTX, float), rmap(layer, q + C.ngw)), C.lane, hn);
    float* hrow = lat_or_ctx_w(GOUT, WS(OFF_HCTX, float), r);
    f32x4 v[4];
    if (!ident) row_layernorm(h, lng, lnb, C.lane);
    row_store(hrow, C.lane, h);
    const float* m = MOD + (size_t)row_b5(r) * 6144;
    row_modulate(h, m + 3 * D, m + 4 * D, C.lane, v);
    row_store_bf16(V + (size_t)r * D, C.lane, v);
    float lg[4];
#pragma unroll
    for (int c = 0; c < 4; ++c) { float s = 0.f;
#pragma unroll
      for (int j = 0; j < 4; ++j) { const f32x4 w = *(const LAS f32x4*)(Wt + c * 1024 + 4 * C.lane + 256 * j); s += (v[j][0] * w[0] + v[j][1] * w[1]) + (v[j][2] * w[2] + v[j][3] * w[3]); }
      lg[c] = wave_sum(s) + rgb[c]; }
    int gsel = 0; float gmax = lg[0];
#pragma unroll
    for (int i = 1; i < 4; ++i) if (lg[i] > gmax) { gmax = lg[i]; gsel = i; }
    gsel = __builtin_amdgcn_readfirstlane(gsel);
    float gden = 0.f;
#pragma unroll
    for (int i = 0; i < 4; ++i) gden += __expf(lg[i] - gmax);
    const float ptg = 1.f / gden;
    float le[8];
    { const LAS float* We = Wt + (4 + gsel * 8) * 1024 + 4 * C.lane;
#pragma unroll
      for (int c = 0; c < 8; ++c) { float s = 0.f;
#pragma unroll
        for (int j = 0; j < 4; ++j) { const f32x4 w = *(const LAS f32x4*)(We + c * 1024 + 256 * j); s += (v[j][0] * w[0] + v[j][1] * w[1]) + (v[j][2] * w[2] + v[j][3] * w[3]); }
        le[c] = wave_sum(s) + reb[gsel * 8 + c]; } }
    int e1 = 0; float m1 = le[0];
#pragma unroll
    for (int i = 1; i < 8; ++i) if (le[i] > m1) { m1 = le[i]; e1 = i; }
    int e2 = -1; float m2 = -3.0e38f;
#pragma unroll
    for (int i = 0; i < 8; ++i) if (i != e1 && le[i] > m2) { m2 = le[i]; e2 = i; }
    const float q2 = __expf(m2 - m1); const float w1 = ptg / (1.f + q2), w2 = ptg * q2 / (1.f + q2);
    if (C.lane == 0) {
      const int E1 = gsel * 8 + e1, E2 = gsel * 8 + e2;
      const int p1 = __hip_atomic_fetch_add(lcnt + E1, 1, __ATOMIC_RELAXED, __HIP_MEMORY_SCOPE_WORKGROUP), p2 = __hip_atomic_fetch_add(lcnt + E2, 1, __ATOMIC_RELAXED, __HIP_MEMORY_SCOPE_WORKGROUP);
      int* rr = route + (size_t)r * 8; if (!ident) { rr[0] = E1; rr[1] = E2; ((float*)rr)[2] = w1; ((float*)rr)[3] = w2; rr[4] = p1; rr[5] = p2; }
    }
#pragma unroll
    for (int j = 0; j < 4; ++j) h[j] = hn[j];
  }
  __syncthreads();
  if (ident) return;
  if (C.tid < NEXP) lcnt[C.tid] = atomicAdd(cnt + C.tid, lcnt[C.tid]);
  __syncthreads();
  for (int k = C.tid >> 3; ; k += NT / 8) { const int q = (C.bid * NWAVES + (C.tid & 7)) + k * C.ngw; if (q >= nrows) break;
    const int r = rmap(layer, q); int* rr = route + (size_t)r * 8; const int E1 = rr[0], E2 = rr[1]; const int p1 = rr[4] + lcnt[E1], p2 = rr[5] + lcnt[E2];
    rr[4] = p1; rr[5] = p2; tok[(size_t)E1 * TOKCAP + p1] = (unsigned short)r; tok[(size_t)E2 * TOKCAP + p2] = (unsigned short)r; }
}

__device__ __forceinline__ void phase_dispatch(const Params& P, const Ctx& C, int layer) {
  LAS int* base = (LAS int*)C.lds;
  int* ctl = WS(OFF_CTL, int); const int* cnt = ctl + layer * 32;
  if (C.tid == 0) { int acc = 0; for (int e = 0; e < NEXP; ++e) { base[e] = acc; acc += (cnt[e] + 255) >> 8; } base[32] = acc; }
  __syncthreads();
  if (C.bid == 0) { if (C.tid == 0) ctl[64 + layer] = base[32];
    if (C.tid < NEXP) { for (int bk = base[C.tid]; bk < base[C.tid + 1]; ++bk) ctl[128 + layer * MAX_BLKS + bk] = C.tid; } }
  const bf16_t* V = layer ? WS(OFF_V1, bf16_t) : WS(OFF_U0, bf16_t);
  bf16_t* AM = layer ? WS(OFF_AM1, bf16_t) : WS(OFF_AM0, bf16_t);
  float* slotw = WS(OFF_SLOTW, float); int* route = WS(OFF_ROUTE, int);
  for (int r = C.gw; r < R; r += C.ngw) {
    const int pos = r % TB; if (layer && pos < CTXL) continue;
    int* rr = route + (size_t)r * 8;
    const int E1 = rr[0], E2 = rr[1]; const int s1 = base[E1] * 256 + rr[4], s2 = base[E2] * 256 + rr[5];
    const u32x4* src = (const u32x4*)(V + (size_t)r * D);
    const u32x4 a = src[C.lane], b = src[64 + C.lane];
    u32x4* d1 = (u32x4*)(AM + (size_t)s1 * D); u32x4* d2 = (u32x4*)(AM + (size_t)s2 * D);
    d1[C.lane] = a; d1[64 + C.lane] = b; d2[C.lane] = a; d2[64 + C.lane] = b;
    if (C.lane == 0) { rr[6] = s1; rr[7] = s2; slotw[s1] = ((const float*)rr)[2]; slotw[s2] = ((const float*)rr)[3]; }
  }
}
__device__ __forceinline__ int moe_tables(const Params& P, const Ctx& C, int layer, LAS int* tb) {
  const int* cnt = WS(OFF_CTL, int) + layer * 32;
  __syncthreads();
  if (C.tid == 0) { int acc = 0; for (int e = 0; e < NEXP; ++e) { const int c = cnt[e]; tb[e] = acc; tb[40 + e] = c; acc += (c + 255) >> 8; } tb[32] = acc; }
  __syncthreads();
  if (C.tid < NEXP) { for (int bk = tb[C.tid]; bk < tb[C.tid + 1]; ++bk) tb[80 + bk] = C.tid; }
  __syncthreads();
  return tb[32];
}
__device__ __forceinline__ void phase_moe1(const Params& P, const Ctx& C, int layer) {
  LAS int* tb = (LAS int*)(C.lds + 131072);
  const int nblk = moe_tables(P, C, layer, tb);
  pg8::Gemm g{layer ? WS(OFF_V1, bf16_t) : WS(OFF_U0, bf16_t), layer ? WS(OFF_WE1, bf16_t) : WS(OFF_WE0, bf16_t), D, D};
  pg8::MoeOrder S{tb, tb + 40, tb + 80, WS(OFF_TOK, unsigned short), nblk * 4, C.nblk, C.bid};
  pg8::EpiSwiGLU E{layer ? WS(OFF_HM1, bf16_t) : WS(OFF_HM0, bf16_t)};
  pg8::gemm_phase_ga(C.lds, g, S, E);
}
__device__ __forceinline__ void phase_moe2(const Params& P, const Ctx& C, int layer) {
  LAS int* tb = (LAS int*)(C.lds + 131072);
  const int nblk = moe_tables(P, C, layer, tb);
  pg8::Gemm g{layer ? WS(OFF_HM1, bf16_t) : WS(OFF_HM0, bf16_t), layer ? WS(OFF_WE1 + 64 * MiB, bf16_t) : WS(OFF_WE0 + 64 * MiB, bf16_t), DEXP, DEXP};
  pg8::MoeOrder S{tb, tb + 40, tb + 80, WS(OFF_TOK, unsigned short), nblk * 4, C.nblk, C.bid};
  pg8::EpiMoeDown E{layer ? WS(OFF_YM1, bf16_t) : WS(OFF_YM0, bf16_t)};
  pg8::gemm_phase(C.lds, g, S, E);
}

__device__ __forceinline__ void phase_lnffn(const Params& P, const Ctx& C, int layer, int ident) {
  const float* MOD = WS(OFF_MOD, float) + (size_t)layer * 5 * 6144;
  const float* lng = GIN(I_LNFG) + layer * D; const float* lnb = GIN(I_LNFB) + layer * D;
  const bf16_t* YM = layer ? WS(OFF_YM1, bf16_t) : WS(OFF_YM0, bf16_t); const int* route = WS(OFF_ROUTE, int);
  LAS int* tb = (LAS int*)(C.lds + 131072);
  (void)moe_tables(P, C, layer, tb);
  const int nrows = layer ? RLAT : R;
  f32x4 h[4], hn[4]; u32x2 ya[4], yb[4], yan[4], ybn[4]; int s1n = 0, s2n = 0; float w1c = 0.f, w2c = 0.f, w1n = 0.f, w2n = 0.f, w1nn = 0.f, w2nn = 0.f;
  auto ldrow = [&](int q, f32x4 (&hh)[4], u32x2 (&a)[4], u32x2 (&bq)[4], int sa, int sb) {
    const int r = rmap(layer, q); row_load(lat_or_ctx_w(GOUT, WS(OFF_HCTX, float), r), C.lane, hh);
#pragma unroll
    for (int j = 0; j < 4; ++j) { a[j] = *(const u32x2*)(YM + (size_t)sa * D + 4 * C.lane + 256 * j); bq[j] = *(const u32x2*)(YM + (size_t)sb * D + 4 * C.lane + 256 * j); } };
  if (C.gw < nrows) { const int* rr = route + (size_t)rmap(layer, C.gw) * 8; ldrow(C.gw, h, ya, yb, tb[rr[0]] * 256 + rr[4], tb[rr[1]] * 256 + rr[5]); w1c = ((const float*)rr)[2]; w2c = ((const float*)rr)[3]; }
  if (C.gw + C.ngw < nrows) { const int* rr = route + (size_t)rmap(layer, C.gw + C.ngw) * 8; s1n = tb[rr[0]] * 256 + rr[4]; s2n = tb[rr[1]] * 256 + rr[5]; w1n = ((const float*)rr)[2]; w2n = ((const float*)rr)[3]; }
  for (int q = C.gw; q < nrows; q += C.ngw) {
    const int r = rmap(layer, q);
    if (q + C.ngw < nrows) ldrow(q + C.ngw, hn, yan, ybn, s1n, s2n);
    if (q + 2 * C.ngw < nrows) { const int* rr = route + (size_t)rmap(layer, q + 2 * C.ngw) * 8; s1n = tb[rr[0]] * 256 + rr[4]; s2n = tb[rr[1]] * 256 + rr[5]; w1nn = ((const float*)rr)[2]; w2nn = ((const float*)rr)[3]; }
    float* hrow = lat_or_ctx_w(GOUT, WS(OFF_HCTX, float), r);
    const float* m = MOD + (size_t)row_b5(r) * 6144;
#pragma unroll
    for (int j = 0; j < 4; ++j) { const u32x2 a = ya[j], b = yb[j];
      const f32x4 g5 = *(const f32x4*)(m + 5 * D + 4 * C.lane + 256 * j);
      f32x4 f; f[0] = w1c * bflo(a.x) + w2c * bflo(b.x); f[1] = w1c * bfhi(a.x) + w2c * bfhi(b.x); f[2] = w1c * bflo(a.y) + w2c * bflo(b.y); f[3] = w1c * bfhi(a.y) + w2c * bfhi(b.y);
      if (!ident) h[j] = h[j] * ALPHA + g5 * f; else h[j] = h[j] + f * 0.f; }
    if (!ident) row_layernorm(h, lng, lnb, C.lane);
    row_store(hrow, C.lane, h);
    if (layer == 0) {
      const float* m1 = WS(OFF_MOD, float) + (size_t)(5 + row_b5(r)) * 6144;
      f32x4 u[4]; row_modulate(h, m1, m1 + D, C.lane, u);
      row_store_bf16(WS(OFF_U1, bf16_t) + (size_t)r * D, C.lane, u);
    }
#pragma unroll
    for (int j = 0; j < 4; ++j) { h[j] = hn[j]; ya[j] = yan[j]; yb[j] = ybn[j]; }
    w1c = w1n; w2c = w2n; w1n = w1nn; w2n = w2nn;
  }
  if (layer == 0) {
    __syncthreads();
    LAS float* scr = (LAS float*)C.lds + C.wave * (64 * 33);
    constexpr int N_A = 16 * 96, N_B = 16 * 128;
    for (int it = C.gw; it < N_A + N_B + 16; it += C.ngw) {
      if (it < N_A) transpose_mat_item(GIN(I_CDW), CD_IN, 0, D, 3072, WS(OFF_WCD, bf16_t), D, 0, it, scr, C.lane);
      else if (it < N_A + N_B) transpose_mat_item(GIN(I_CDW), CD_IN, 4128, D, 4096, WS(OFF_WCD, bf16_t) + (size_t)3072 * D, D, 0, it - N_A, scr, C.lane);
      else transpose_mat_item(GIN(I_CDW), CD_IN, 4096, D, 32, WS(OFF_WCD, bf16_t) + (size_t)7168 * D, D, 0, it - N_A - N_B, scr, C.lane);
    }
    { u32x4* z = (u32x4*)(WS(OFF_WCD, bf16_t) + (size_t)7200 * D); const u32x4 zz = {0u, 0u, 0u, 0u};
      for (int i = C.bid * NT + C.tid; i < 224 * D * 2 / 16; i += C.nblk * NT) z[i] = zz; }
  }
}

__device__ __forceinline__ void gdn_task(const Params& P, const Ctx& C, int task) {
  const int b = task >> 9, h = (task >> 6) & 7, vs = task & 63; const int c = C.lane >> 5, kg = C.lane & 31;
  const bf16_t* Z = WS(OFF_Z1, bf16_t); bf16_t* MIX = WS(OFF_MIX1, bf16_t); const float* DT = WS(OFF_DT, float);
  const int colq = Z1_Q + h * 128 + 4 * kg, colk = Z1_K + h * 128 + 4 * kg, colv = Z1_V + h * 128 + 2 * vs + c, outc = h * 128 + 2 * vs + c;
  for (int d = 0; d < 2; ++d) {
    const float Aneg = -__expf(GIN(I_GALOG)[d * 8 + h]), dtb = GIN(I_GDTB)[d * 8 + h];
    float S0 = 0.f, S1 = 0.f, S2 = 0.f, S3 = 0.f;
    for (int j0 = 0; j0 < TB; j0 += 8) {
      u32x2 qv[8], kv[8]; unsigned short vv[8], yp[8]; float br[8], ar[8];
#pragma unroll
      for (int u = 0; u < 8; ++u) { const size_t row = (size_t)b * TB + seq_pos(d, j0 + u);
        qv[u] = *(const u32x2*)(Z + row * Z1W + colq); kv[u] = *(const u32x2*)(Z + row * Z1W + colk); vv[u] = Z[row * Z1W + colv];
        br[u] = DT[row * 32 + d * 8 + h]; ar[u] = DT[row * 32 + 16 + d * 8 + h]; yp[u] = d ? MIX[row * MIXW + outc] : (unsigned short)0; }
#pragma unroll
      for (int u = 0; u < 8; ++u) { const size_t row = (size_t)b * TB + seq_pos(d, j0 + u);
        const float al = __expf(Aneg * softplusf_(ar[u] + dtb)), be = sigmoidf_(br[u]);
        const float k0 = bflo(kv[u].x), k1 = bfhi(kv[u].x), k2 = bflo(kv[u].y), k3 = bfhi(kv[u].y);
        S0 *= al; S1 *= al; S2 *= al; S3 *= al;
        const float p = half_sum32((k0 * S0 + k1 * S1) + (k2 * S2 + k3 * S3));
        const float dl = be * (bf2f(vv[u]) - p);
        S0 += k0 * dl; S1 += k1 * dl; S2 += k2 * dl; S3 += k3 * dl;
        const float o = half_sum32((bflo(qv[u].x) * S0 + bfhi(qv[u].x) * S1) + (bflo(qv[u].y) * S2 + bfhi(qv[u].y) * S3));
        if (kg == 0) MIX[row * MIXW + outc] = (bf16_t)f2bf(o + bf2f(yp[u])); }
    }
    __threadfence_block();
  }
}
__device__ __forceinline__ void hgrn_task(const Params& P, const Ctx& C, int task) {
  const int b = task >> 9, h = (task >> 6) & 7, vs = task & 63; const int c = C.lane >> 5, kg = C.lane & 31;
  const bf16_t* Z = WS(OFF_Z1, bf16_t); bf16_t* MIX = WS(OFF_MIX1, bf16_t);
  const f32x4 lb = *(const f32x4*)(WS(OFF_LB1, float) + h * 128 + 4 * kg);
  const int colq = Z1_HQ + h * 128 + 4 * kg, colv = Z1_HI + h * 128 + 2 * vs + c, outc = 1024 + h * 128 + 2 * vs + c;
  for (int d = 0; d < 2; ++d) {
    const int colf = Z1_HF + d * 1024 + h * 128 + 4 * kg;
    float S0 = 0.f, S1 = 0.f, S2 = 0.f, S3 = 0.f;
    for (int j0 = 0; j0 < TB; j0 += 8) {
      u32x2 qv[8], fv[8]; unsigned short vv[8], yp[8];
#pragma unroll
      for (int u = 0; u < 8; ++u) { const size_t row = (size_t)b * TB + seq_pos(d, j0 + u);
        qv[u] = *(const u32x2*)(Z + row * Z1W + colq); fv[u] = *(const u32x2*)(Z + row * Z1W + colf); vv[u] = Z[row * Z1W + colv];
        yp[u] = d ? MIX[row * MIXW + outc] : (unsigned short)0; }
#pragma unroll
      for (int u = 0; u < 8; ++u) { const size_t row = (size_t)b * TB + seq_pos(d, j0 + u);
        const float f0 = lb[0] + (1.f - lb[0]) * sigmoidf_(bflo(fv[u].x)), f1 = lb[1] + (1.f - lb[1]) * sigmoidf_(bfhi(fv[u].x));
        const float f2 = lb[2] + (1.f - lb[2]) * sigmoidf_(bflo(fv[u].y)), f3 = lb[3] + (1.f - lb[3]) * sigmoidf_(bfhi(fv[u].y));
        const float v = bf2f(vv[u]);
        S0 = f0 * S0 + (1.f - f0) * v; S1 = f1 * S1 + (1.f - f1) * v; S2 = f2 * S2 + (1.f - f2) * v; S3 = f3 * S3 + (1.f - f3) * v;
        const float o = half_sum32((bflo(qv[u].x) * S0 + bfhi(qv[u].x) * S1) + (bflo(qv[u].y) * S2 + bfhi(qv[u].y) * S3));
        if (kg == 0) MIX[row * MIXW + outc] = (bf16_t)f2bf(o + bf2f(yp[u])); }
    }
    __threadfence_block();
  }
}

__device__ __forceinline__ int seq_chunk32(int dir, int j) { return dir == 0 ? j : (j < 8 ? 7 - j : 271 - j); }
__device__ __forceinline__ bool fwd_first32(int c) { return c < 8 ? (c <= 3) : (c <= 135); }

__device__ __forceinline__ void hgrn_chain_wg(const Params& P, const Ctx& C, int task) {
  const int b = task >> 5, h = (task >> 2) & 7, vs = task & 3;
  const int d = C.wave >> 2, w = C.wave & 3, td = C.tid & 255, lane = C.lane, fr = lane & 15, fq = lane >> 4;
  constexpr int LDN = 136, LDP = 40;
  constexpr int DIRSZ = 72 * 1024;
  LAS unsigned char* L = C.lds + d * DIRSZ;
  LAS bf16_t* Qt = (LAS bf16_t*)L;
  LAS bf16_t* Kh = Qt + 32 * LDN;
  LAS bf16_t* Kw = Kh + 32 * LDN;
  LAS bf16_t* Vs = Kw + 32 * LDN;
  LAS bf16_t* Pt = Vs + 32 * LDP;
  LAS bf16_t* St = Pt + 32 * LDP;
  LAS float* CUM = (LAS float*)(St + 2 * 32 * LDN);
  const bf16_t* Z = WS(OFF_Z1, bf16_t); bf16_t* MIX = WS(OFF_MIX1, bf16_t);
  const int colq = Z1_HQ + h * 128, colf = Z1_HF + d * 1024 + h * 128, colv = Z1_HI + h * 128 + vs * 32, outc = 1024 + h * 128 + vs * 32;
  __syncthreads();
  for (int i = td; i < 32 * LDP / 2; i += 256) ((LAS unsigned*)Pt)[i] = 0u;
  for (int i = td; i < 2 * 32 * LDN / 2; i += 256) ((LAS unsigned*)St)[i] = 0u;
  f32x4 Sacc[2][2];
#pragma unroll
  for (int a = 0; a < 2; ++a)
#pragma unroll
    for (int c = 0; c < 2; ++c) Sacc[a][c] = (f32x4){0.f, 0.f, 0.f, 0.f};
  const int st_t = td >> 3, st_s = td & 7;
  float lbv[16];
#pragma unroll
  for (int e = 0; e < 16; ++e) lbv[e] = WS(OFF_LB1, float)[h * 128 + st_s * 16 + e];
  u32x4 rq[2], rf[2]; u32x2 rv;
  auto issue_loads = [&](int step) {
    const int chunk = seq_chunk32(d, step); const size_t row = (size_t)b * TB + chunk * 32 + st_t;
    const u32x4* pq = (const u32x4*)(Z + row * Z1W + colq + st_s * 16); const u32x4* pf = (const u32x4*)(Z + row * Z1W + colf + st_s * 16);
    rq[0] = pq[0]; rq[1] = pq[1]; rf[0] = pf[0]; rf[1] = pf[1];
    rv = *(const u32x2*)(Z + row * Z1W + colv + st_s * 4);
  };
  issue_loads(0);
  for (int step = 0; step < 264; ++step) {
    const int chunk = seq_chunk32(d, step); const int row0 = b * TB + chunk * 32;
    const int si = d ? 31 - st_t : st_t;
    VMWAIT();
    float qv[16], kk[16];
    { const unsigned qw[8] = {rq[0].x, rq[0].y, rq[0].z, rq[0].w, rq[1].x, rq[1].y, rq[1].z, rq[1].w};
      const unsigned fw[8] = {rf[0].x, rf[0].y, rf[0].z, rf[0].w, rf[1].x, rf[1].y, rf[1].z, rf[1].w};
      f32x4 lf4[4];
#pragma unroll
      for (int e = 0; e < 8; ++e) { qv[2 * e] = bflo(qw[e]); qv[2 * e + 1] = bfhi(qw[e]);
        const float f0 = lbv[2 * e] + (1.f - lbv[2 * e]) * sigmoidf_(bflo(fw[e])), f1 = lbv[2 * e + 1] + (1.f - lbv[2 * e + 1]) * sigmoidf_(bfhi(fw[e]));
        kk[2 * e] = 1.f - f0; kk[2 * e + 1] = 1.f - f1; lf4[e >> 1][(2 * e) & 3] = __logf(f0); lf4[e >> 1][(2 * e + 1) & 3] = __logf(f1); }
#pragma unroll
      for (int e = 0; e < 4; ++e) *(LAS f32x4*)(CUM + si * 128 + st_s * 16 + 4 * e) = lf4[e];
      *(LAS u32x2*)(Vs + si * LDP + st_s * 4) = rv; }
    LBAR();
    if (step + 1 < 264) issue_loads(step + 1);
    const int vt = w & 1, it = w >> 1;
    const bool first = (d == 0) == fwd_first32(chunk);
    bf16_t* op; unsigned long long ppv = 0ull;
    { const int ii = 16 * it + fr; const int t = d ? 31 - ii : ii; op = MIX + (size_t)(row0 + t) * MIXW + outc + 16 * vt + 4 * fq; if (!first) ppv = ld_agent_u64(op); }
    if (td < 128) { float c = 0.f;
#pragma unroll 8
      for (int i = 0; i < 32; ++i) { c += CUM[i * 128 + td]; CUM[i * 128 + td] = c; } }
    LBAR();
    { unsigned oq[8], oh[8], ow[8];
#pragma unroll
      for (int e = 0; e < 8; ++e) { const int k0 = st_s * 16 + 2 * e;
        const float c0 = CUM[si * 128 + k0], c1 = CUM[si * 128 + k0 + 1], l0 = CUM[31 * 128 + k0], l1 = CUM[31 * 128 + k0 + 1];
        oq[e] = pk2(qv[2 * e] * __expf(c0), qv[2 * e + 1] * __expf(c1));
        oh[e] = pk2(kk[2 * e] * __expf(fminf(-c0, 80.f)), kk[2 * e + 1] * __expf(fminf(-c1, 80.f)));
        ow[e] = pk2(kk[2 * e] * __expf(l0 - c0), kk[2 * e + 1] * __expf(l1 - c1)); }
      LAS u32x4* dq = (LAS u32x4*)(Qt + si * LDN + st_s * 16); LAS u32x4* dh = (LAS u32x4*)(Kh + si * LDN + st_s * 16); LAS u32x4* dw = (LAS u32x4*)(Kw + si * LDN + st_s * 16);
      dq[0] = (u32x4){oq[0], oq[1], oq[2], oq[3]}; dq[1] = (u32x4){oq[4], oq[5], oq[6], oq[7]};
      dh[0] = (u32x4){oh[0], oh[1], oh[2], oh[3]}; dh[1] = (u32x4){oh[4], oh[5], oh[6], oh[7]};
      dw[0] = (u32x4){ow[0], ow[1], ow[2], ow[3]}; dw[1] = (u32x4){ow[4], ow[5], ow[6], ow[7]}; }
    LBAR();
    if (w < 3) { const int I = w >= 1 ? 1 : 0, J = w == 2 ? 1 : 0;
      f32x4 acc = (f32x4){0.f, 0.f, 0.f, 0.f};
#pragma unroll
      for (int k = 0; k < 4; ++k) acc = mma16(frag_row(Qt, LDN, 16 * I, 32 * k, lane), frag_row(Kh, LDN, 16 * J, 32 * k, lane), acc);
      const int jj = 16 * J + fr; float pv[4];
#pragma unroll
      for (int r = 0; r < 4; ++r) { const int ii = 16 * I + 4 * fq + r; pv[r] = (jj <= ii) ? acc[r] : 0.f; }
      u32x2 o; o.x = pk2(pv[0], pv[1]); o.y = pk2(pv[2], pv[3]);
      *(LAS u32x2*)(Pt + jj * LDP + 16 * I + 4 * fq) = o; }
    const LAS bf16_t* Sr = St + (step & 1) * 32 * LDN; LAS bf16_t* Sw = St + ((step + 1) & 1) * 32 * LDN;
    f32x4 o2 = (f32x4){0.f, 0.f, 0.f, 0.f};
#pragma unroll
    for (int k = 0; k < 4; ++k) o2 = mma16(frag_row(Sr, LDN, 16 * vt, 32 * k, lane), frag_row(Qt, LDN, 16 * it, 32 * k, lane), o2);
#pragma unroll
    for (int a = 0; a < 2; ++a) { const int kt = 2 * w + a; const f32x4 cl = *(const LAS f32x4*)(CUM + 31 * 128 + 16 * kt + 4 * fq);
      f32x4 dec; dec[0] = __expf(cl[0]); dec[1] = __expf(cl[1]); dec[2] = __expf(cl[2]); dec[3] = __expf(cl[3]);
#pragma unroll
      for (int c = 0; c < 2; ++c) { f32x4 acc = Sacc[a][c] * dec;
        acc = mma16(frag_tr(Kw, LDN, 0, 16 * kt, lane), frag_tr(Vs, LDP, 0, 16 * c, lane), acc);
        Sacc[a][c] = acc;
        u32x2 o; o.x = pk2(acc[0], acc[1]); o.y = pk2(acc[2], acc[3]);
        *(LAS u32x2*)(Sw + (16 * c + fr) * LDN + 16 * kt + 4 * fq) = o; } }
    LBAR();
    { f32x4 o1 = mma16(frag_tr(Vs, LDP, 0, 16 * vt, lane), frag_tr(Pt, LDP, 0, 16 * it, lane), (f32x4){0.f, 0.f, 0.f, 0.f});
      float o0 = o1[0] + o2[0], o1v = o1[1] + o2[1], o2v = o1[2] + o2[2], o3 = o1[3] + o2[3];
      if (!first) { const unsigned long long pv = ppv; const unsigned lo = (unsigned)pv, hi = (unsigned)(pv >> 32); o0 += bflo(lo); o1v += bfhi(lo); o2v += bflo(hi); o3 += bfhi(hi); }
      u32x2 o; o.x = pk2(o0, o1v); o.y = pk2(o2v, o3); *(u32x2*)op = o; }
    LBAR();
  }
}

__device__ __forceinline__ void gdn_chain_wg(const Params& P, const Ctx& C, int task) {
  const int b = task >> 5, h = (task >> 2) & 7, vs = task & 3;
  const int d = C.wave >> 2, w = C.wave & 3, td = C.tid & 255, lane = C.lane, fr = lane & 15, fq = lane >> 4;
  constexpr int LDN = 136, LDP = 40, LDT = 24;
  constexpr int DIRSZ = 72 * 1024;
  LAS unsigned char* L = C.lds + d * DIRSZ;
  LAS bf16_t* Qs = (LAS bf16_t*)L;
  LAS bf16_t* Ks = Qs + 32 * LDN;
  LAS bf16_t* Vs = Ks + 32 * LDN;
  LAS bf16_t* Mt = Vs + 32 * LDP;
  LAS bf16_t* At = Mt + 32 * LDP;
  LAS bf16_t* Tt = At + 32 * LDP;
  LAS bf16_t* Xt = Tt + 2 * 32 * LDT;
  LAS bf16_t* Rt = Xt + 160 * LDP;
  LAS bf16_t* Vn = Rt + 4 * 16 * LDP;
  LAS bf16_t* Vw = Vn + 32 * LDP;
  LAS bf16_t* St = Vw + 32 * LDP;
  LAS float* Md = (LAS float*)(St + 2 * 32 * LDN);
  LAS float* gL = Md + 2 * 256;
  LAS float* bL = gL + 32;
  const bf16_t* Z = WS(OFF_Z1, bf16_t); bf16_t* MIX = WS(OFF_MIX1, bf16_t); const float* DT = WS(OFF_DT, float);
  const float Aneg = -__expf(GIN(I_GALOG)[d * 8 + h]), dtb = GIN(I_GDTB)[d * 8 + h];
  const int colq = Z1_Q + h * 128, colk = Z1_K + h * 128, colv = Z1_V + h * 128 + vs * 32, outc = h * 128 + vs * 32;
  __syncthreads();
  for (int i = td; i < 71 * 1024 / 4; i += 256) ((LAS unsigned*)L)[i] = 0u;
  f32x4 Sacc[2][2];
#pragma unroll
  for (int a = 0; a < 2; ++a)
#pragma unroll
    for (int c = 0; c < 2; ++c) Sacc[a][c] = (f32x4){0.f, 0.f, 0.f, 0.f};
  const int st_t = td >> 3, st_s = td & 7;
  u32x4 rq[2], rk[2]; u32x2 rv; float ra = 0.f, rb = 0.f;
  auto issue_loads = [&](int step) {
    const int chunk = seq_chunk32(d, step); const size_t row = (size_t)b * TB + chunk * 32 + st_t;
    const u32x4* pq = (const u32x4*)(Z + row * Z1W + colq + st_s * 16); const u32x4* pk = (const u32x4*)(Z + row * Z1W + colk + st_s * 16);
    rq[0] = pq[0]; rq[1] = pq[1]; rk[0] = pk[0]; rk[1] = pk[1];
    rv = *(const u32x2*)(Z + row * Z1W + colv + st_s * 4);
    if (st_s == 0) { rb = DT[row * 32 + d * 8 + h]; ra = DT[row * 32 + 16 + d * 8 + h]; }
  };
  issue_loads(0);
  __syncthreads();
  LAS bf16_t* Rw = Rt + w * 16 * LDP;
  for (int step = 0; step < 264; ++step) {
    const int chunk = seq_chunk32(d, step); const int row0 = b * TB + chunk * 32;
    VMWAIT();
    { const int si = d ? 31 - st_t : st_t;
      LAS u32x4* dq = (LAS u32x4*)(Qs + si * LDN + st_s * 16); LAS u32x4* dk = (LAS u32x4*)(Ks + si * LDN + st_s * 16);
      dq[0] = rq[0]; dq[1] = rq[1]; dk[0] = rk[0]; dk[1] = rk[1];
      *(LAS u32x2*)(Vs + si * LDP + st_s * 4) = rv;
      if (st_s == 0) { gL[si] = Aneg * softplusf_(ra + dtb); bL[si] = sigmoidf_(rb); } }
    LBAR();
    if (step + 1 < 264) issue_loads(step + 1);
    const bool first = (d == 0) == fwd_first32(chunk);
    bf16_t* op; unsigned long long ppv = 0ull;
    { const int ii = 16 * (w >> 1) + fr; const int t = d ? 31 - ii : ii; op = MIX + (size_t)(row0 + t) * MIXW + outc + 16 * (w & 1) + 4 * fq; if (!first) ppv = ld_agent_u64(op); }
    const float cum = wave_incl_scan(lane < 32 ? gL[lane] : 0.f, lane);
    const float cum_last = __shfl(cum, 31);
    const LAS bf16_t* Sr = St + (step & 1) * 32 * LDN; LAS bf16_t* Sw = St + ((step + 1) & 1) * 32 * LDN;
    const int vt = w & 1, it = w >> 1;
    for (int job = w; job < 6; job += 4) {
      const int isq = job >= 3, tj = job - 3 * isq; const int I = tj >= 1 ? 1 : 0, J = tj == 2 ? 1 : 0;
      const LAS bf16_t* A = isq ? Qs : Ks;
      f32x4 acc = (f32x4){0.f, 0.f, 0.f, 0.f};
#pragma unroll
      for (int k = 0; k < 4; ++k) acc = mma16(frag_row(A, LDN, 16 * I, 32 * k, lane), frag_row(Ks, LDN, 16 * J, 32 * k, lane), acc);
      const int jj = 16 * J + fr; const float cj = __shfl(cum, jj); float pv[4];
#pragma unroll
      for (int r = 0; r < 4; ++r) { const int ii = 16 * I + 4 * fq + r; const float ci = __shfl(cum, ii); const float dec = __expf(ci - cj);
        if (isq) pv[r] = (jj <= ii) ? acc[r] * dec : 0.f;
        else { pv[r] = (jj < ii) ? acc[r] * dec * bL[ii] : 0.f; if (I == J) Md[I * 256 + (4 * fq + r) * 16 + fr] = pv[r]; } }
      u32x2 o; o.x = pk2(pv[0], pv[1]); o.y = pk2(pv[2], pv[3]);
      *(LAS u32x2*)((isq ? At : Mt) + jj * LDP + 16 * I + 4 * fq) = o;
    }
    f32x4 o2 = (f32x4){0.f, 0.f, 0.f, 0.f};
#pragma unroll
    for (int k = 0; k < 4; ++k) o2 = mma16(frag_row(Sr, LDN, 16 * vt, 32 * k, lane), frag_row(Qs, LDN, 16 * it, 32 * k, lane), o2);
    LBAR();
    if (w < 2) { const LAS float* M = Md + w * 256; const int c = lane & 15;
      float m[16];
#pragma unroll
      for (int q4 = 0; q4 < 4; ++q4) { const f32x4 t4 = *(const LAS f32x4*)(M + c * 16 + 4 * q4); m[4 * q4] = t4[0]; m[4 * q4 + 1] = t4[1]; m[4 * q4 + 2] = t4[2]; m[4 * q4 + 3] = t4[3]; }
      float T[16];
#pragma unroll
      for (int r = 0; r < 16; ++r) { float v = (r == c) ? 1.f : 0.f;
#pragma unroll
        for (int s2 = 0; s2 < r; ++s2) v -= __builtin_bit_cast(float, __builtin_amdgcn_readlane(__builtin_bit_cast(int, m[s2]), r)) * T[s2];
        T[r] = v; }
      if (lane < 16) { LAS u32x4* dst = (LAS u32x4*)(Tt + w * 32 * LDT + c * LDT);
        dst[0] = (u32x4){pk2(T[0], T[1]), pk2(T[2], T[3]), pk2(T[4], T[5]), pk2(T[6], T[7])};
        dst[1] = (u32x4){pk2(T[8], T[9]), pk2(T[10], T[11]), pk2(T[12], T[13]), pk2(T[14], T[15])}; } }
    LBAR();
    for (int ct = w; ct < 10; ct += 4) {
      const int cc = 16 * ct + fr;
      f32x4 rhs;
#pragma unroll
      for (int r = 0; r < 4; ++r) { const int ii = 4 * fq + r; const float bi = bL[ii];
        rhs[r] = ct < 2 ? bi * bf2f(Vs[ii * LDP + cc]) : bi * __expf(__shfl(cum, ii)) * bf2f(Ks[ii * LDN + cc - 32]); }
      { u32x2 o; o.x = pk2(rhs[0], rhs[1]); o.y = pk2(rhs[2], rhs[3]); *(LAS u32x2*)(Rw + fr * LDP + 4 * fq) = o; }
      asm volatile("s_waitcnt lgkmcnt(0)" ::: "memory");
      f32x4 x0 = mma16(frag_tr(Tt, LDT, 0, 0, lane), frag_row(Rw, LDP, 0, 0, lane), (f32x4){0.f, 0.f, 0.f, 0.f});
      { u32x2 o; o.x = pk2(x0[0], x0[1]); o.y = pk2(x0[2], x0[3]); *(LAS u32x2*)(Xt + cc * LDP + 4 * fq) = o; }
#pragma unroll
      for (int r = 0; r < 4; ++r) { const int ii = 16 + 4 * fq + r; const float bi = bL[ii];
        rhs[r] = ct < 2 ? bi * bf2f(Vs[ii * LDP + cc]) : bi * __expf(__shfl(cum, ii)) * bf2f(Ks[ii * LDN + cc - 32]); }
      asm volatile("s_waitcnt lgkmcnt(0)" ::: "memory");
      { bf16x8 fa = frag_tr(Mt, LDP, 0, 16, lane); if (fq >= 2) fa = (bf16x8){0, 0, 0, 0, 0, 0, 0, 0};
        bf16x8 fb = frag_row(Xt, LDP, 16 * ct, 0, lane); if (fq >= 2) fb = (bf16x8){0, 0, 0, 0, 0, 0, 0, 0};
        const f32x4 corr = mma16(fa, fb, (f32x4){0.f, 0.f, 0.f, 0.f});
        rhs = rhs - corr; }
      { u32x2 o; o.x = pk2(rhs[0], rhs[1]); o.y = pk2(rhs[2], rhs[3]); *(LAS u32x2*)(Rw + fr * LDP + 4 * fq) = o; }
      asm volatile("s_waitcnt lgkmcnt(0)" ::: "memory");
      f32x4 x1 = mma16(frag_tr(Tt + 32 * LDT, LDT, 0, 0, lane), frag_row(Rw, LDP, 0, 0, lane), (f32x4){0.f, 0.f, 0.f, 0.f});
      { u32x2 o; o.x = pk2(x1[0], x1[1]); o.y = pk2(x1[2], x1[3]); *(LAS u32x2*)(Xt + cc * LDP + 16 + 4 * fq) = o; }
    }
    LBAR();
    { f32x4 ws = (f32x4){0.f, 0.f, 0.f, 0.f};
#pragma unroll
      for (int k = 0; k < 4; ++k) ws = mma16(frag_tr(Xt + 32 * LDP, LDP, 32 * k, 16 * it, lane), frag_row(Sr, LDN, 16 * vt, 32 * k, lane), ws);
      const u32x2 uu = *(const LAS u32x2*)(Xt + (16 * vt + fr) * LDP + 16 * it + 4 * fq);
      float vn[4] = {bflo(uu.x) - ws[0], bfhi(uu.x) - ws[1], bflo(uu.y) - ws[2], bfhi(uu.y) - ws[3]};
      float vw[4];
#pragma unroll
      for (int r = 0; r < 4; ++r) vw[r] = vn[r] * __expf(cum_last - __shfl(cum, 16 * it + 4 * fq + r));
      u32x2 o; o.x = pk2(vn[0], vn[1]); o.y = pk2(vn[2], vn[3]); *(LAS u32x2*)(Vn + (16 * vt + fr) * LDP + 16 * it + 4 * fq) = o;
      o.x = pk2(vw[0], vw[1]); o.y = pk2(vw[2], vw[3]); *(LAS u32x2*)(Vw + (16 * vt + fr) * LDP + 16 * it + 4 * fq) = o; }
    LBAR();
    { const f32x4 o1 = mma16(frag_row(Vn, LDP, 16 * vt, 0, lane), frag_tr(At, LDP, 0, 16 * it, lane), (f32x4){0.f, 0.f, 0.f, 0.f});
      const int ii = 16 * it + fr; const float eci = __expf(__shfl(cum, ii));
      float o0 = o1[0] + eci * o2[0], o1v = o1[1] + eci * o2[1], o2v = o1[2] + eci * o2[2], o3 = o1[3] + eci * o2[3];
      if (!first) { const unsigned long long pv = ppv; const unsigned lo = (unsigned)pv, hi = (unsigned)(pv >> 32); o0 += bflo(lo); o1v += bfhi(lo); o2v += bflo(hi); o3 += bfhi(hi); }
      u32x2 o; o.x = pk2(o0, o1v); o.y = pk2(o2v, o3); *(u32x2*)op = o; }
    { const float el = __expf(cum_last);
#pragma unroll
      for (int a = 0; a < 2; ++a) { const int kt = 2 * w + a; const bf16x8 fa = frag_tr(Ks, LDN, 0, 16 * kt, lane);
#pragma unroll
        for (int c = 0; c < 2; ++c) { f32x4 acc = mma16(fa, frag_row(Vw, LDP, 16 * c, 0, lane), Sacc[a][c] * el);
          Sacc[a][c] = acc;
          u32x2 o; o.x = pk2(acc[0], acc[1]); o.y = pk2(acc[2], acc[3]);
          *(LAS u32x2*)(Sw + (16 * c + fr) * LDN + 16 * kt + 4 * fq) = o; } } }
    LBAR();
  }
}

__device__ __forceinline__ bf16x8 ldfr(const LAS bf16_t* p) { return *(const LAS bf16x8*)p; }
__device__ __forceinline__ bf16x8 ldft(const LAS bf16_t* p, int ld) {
  const s16x4 v0 = __builtin_amdgcn_ds_read_tr16_b64_v4i16((LAS s16x4*)p);
  const s16x4 v1 = __builtin_amdgcn_ds_read_tr16_b64_v4i16((LAS s16x4*)(p + 4 * ld));
  bf16x8 r; r[0] = v0[0]; r[1] = v0[1]; r[2] = v0[2]; r[3] = v0[3]; r[4] = v1[0]; r[5] = v1[1]; r[6] = v1[2]; r[7] = v1[3];
  return r;
}
__device__ __forceinline__ u32x2 pk4(float a, float b, float c, float dd) { u32x2 o; o.x = pg8::cvt_pk_bf16(a, b); o.y = pg8::cvt_pk_bf16(c, dd); return o; }
__device__ __forceinline__ float bcast_lane(float v, int l) { return __builtin_bit_cast(float, __builtin_amdgcn_readlane(__builtin_bit_cast(int, v), l)); }

__device__ __forceinline__ void gdn2_chain_wg(const Params& P, const Ctx& C, int task) {
  const int b = task >> 5, h = (task >> 2) & 7, vs = task & 3;
  const int d = C.wave >> 2, w = ((C.wave & 3) + 2 * d) & 3, td = C.tid & 255, lane = C.lane, fr = lane & 15, fq = lane >> 4;
  constexpr int LDN = 136, LDP = 40, LDT = 24;
  constexpr int DIRSZ = 64 * 1024;
  LAS unsigned char* L = C.lds + d * DIRSZ;
  LAS bf16_t* Qs = (LAS bf16_t*)L;
  LAS bf16_t* Ks = Qs + 32 * LDN;
  LAS bf16_t* Vt = Ks + 32 * LDN;
  LAS bf16_t* Mt = Vt + 32 * LDP;
  LAS bf16_t* At = Mt + 32 * LDP;
  LAS bf16_t* Rt = At + 32 * LDP;
  LAS bf16_t* Vn = Rt + 32 * LDP;
  LAS bf16_t* Vw = Vn + 32 * LDP;
  LAS bf16_t* Tt = Vw + 32 * LDP;
  LAS bf16_t* St = Tt + 2 * 32 * LDT;
  LAS float* Md = (LAS float*)(St + 2 * 32 * LDN);
  LAS float* gL = Md + 512;
  LAS float* bL = gL + 32; LAS float* becL = bL;
  LAS float* ecL = bL + 32 + (C.wave & 3) * 96; LAS float* encL = ecL + 32; LAS float* ewL = encL + 32;
  const bf16_t* Z = WS(OFF_Z1, bf16_t); bf16_t* MIX = WS(OFF_MIX1, bf16_t); const float* DT = WS(OFF_DT, float);
  const float Aneg = -__expf(GIN(I_GALOG)[d * 8 + h]), dtb = GIN(I_GDTB)[d * 8 + h];
  const int colq = Z1_Q + h * 128, colk = Z1_K + h * 128, colv = Z1_V + h * 128 + vs * 32, outc = h * 128 + vs * 32;
  __syncthreads();
  for (int i = td; i < 58 * 1024 / 4; i += 256) ((LAS unsigned*)L)[i] = 0u;
  f32x4 Sacc[2][2];
#pragma unroll
  for (int a = 0; a < 2; ++a)
#pragma unroll
    for (int c = 0; c < 2; ++c) Sacc[a][c] = (f32x4){0.f, 0.f, 0.f, 0.f};
  const int st_t = td >> 3, st_s = td & 7;
  u32x4 rq[2], rk[2]; u32x2 rv; float ra = 0.f, rb = 0.f;
  auto issue_loads = [&](int step) {
    const int chunk = seq_chunk32(d, step); const size_t row = (size_t)b * TB + chunk * 32 + st_t;
    const u32x4* pq = (const u32x4*)(Z + row * Z1W + colq + st_s * 16); const u32x4* pk = (const u32x4*)(Z + row * Z1W + colk + st_s * 16);
    rq[0] = pq[0]; rq[1] = pq[1]; rk[0] = pk[0]; rk[1] = pk[1];
    rv = *(const u32x2*)(Z + row * Z1W + colv + st_s * 4);
    if (st_s == 0) { rb = DT[row * 32 + d * 8 + h]; ra = DT[row * 32 + 16 + d * 8 + h]; }
  };
  issue_loads(0);
  __syncthreads();
  const int rL136 = fr * LDN + 8 * fq, rL40 = fr * LDP + 8 * fq;
  const int tq = fr >> 2, tp = fr & 3;
  const int tL136 = (8 * fq + tq) * LDN + 4 * tp, tL40 = (8 * fq + tq) * LDP + 4 * tp, tL24 = (8 * fq + tq) * LDT + 4 * tp;
  const int it = w >> 1, vt = w & 1;
  const int si = d ? 31 - st_t : st_t;
  LAS u32x4* stq = (LAS u32x4*)(Qs + si * LDN + st_s * 16); LAS u32x4* stk = (LAS u32x4*)(Ks + si * LDN + st_s * 16);
  LAS bf16_t* stv = Vt + (st_s * 4) * LDP + si;
  const LAS bf16_t* pK_it = Ks + 16 * it * LDN + rL136; const LAS bf16_t* pQ_it = Qs + 16 * it * LDN + rL136;
  for (int step = 0; step < 264; ++step) {
    const int chunk = seq_chunk32(d, step); const int row0 = b * TB + chunk * 32;
    VMWAIT();
    stq[0] = rq[0]; stq[1] = rq[1]; stk[0] = rk[0]; stk[1] = rk[1];
    stv[0] = (bf16_t)(rv.x & 0xffffu); stv[LDP] = (bf16_t)(rv.x >> 16); stv[2 * LDP] = (bf16_t)(rv.y & 0xffffu); stv[3 * LDP] = (bf16_t)(rv.y >> 16);
    if (st_s == 0) { gL[si] = Aneg * softplusf_(ra + dtb); bL[si] = fast_sigmoid(rb); }
    LBAR();
    if (step + 1 < 264) issue_loads(step + 1);
    const bool first = (d == 0) == fwd_first32(chunk);
    bf16_t* op; unsigned long long ppv = 0ull;
    { const int ii = 16 * it + fr; const int t = d ? 31 - ii : ii; op = MIX + (size_t)(row0 + t) * MIXW + outc + 16 * vt + 4 * fq; if (!first) ppv = ld_agent_u64(op); }
    float elast;
    { const float c = wave_incl_scan(lane < 32 ? gL[lane & 31] : 0.f, lane); const float cl = bcast_lane(c, 31); elast = __expf(cl);
      if (lane < 32) { const float ec = __expf(c); ecL[lane] = ec; encL[lane] = c; ewL[lane] = __expf(cl - c); } }
    asm volatile("s_waitcnt lgkmcnt(0)" ::: "memory");
    const LAS bf16_t* Sr = St + (step & 1) * 32 * LDN; LAS bf16_t* Sw = St + ((step + 1) & 1) * 32 * LDN;
    f32x4 o2 = (f32x4){0.f, 0.f, 0.f, 0.f};
    { f32x4 ks = (f32x4){0.f, 0.f, 0.f, 0.f};
      const LAS bf16_t* pS = Sr + 16 * vt * LDN + rL136;
#pragma unroll
      for (int k = 0; k < 4; ++k) { const bf16x8 fs = ldfr(pS + 32 * k); ks = mma16(ldfr(pK_it + 32 * k), fs, ks); o2 = mma16(fs, ldfr(pQ_it + 32 * k), o2); }
      const u32x2 vv = *(const LAS u32x2*)(Vt + (16 * vt + fr) * LDP + 16 * it + 4 * fq);
      const f32x4 ec4 = *(const LAS f32x4*)(ecL + 16 * it + 4 * fq), b4 = *(const LAS f32x4*)(bL + 16 * it + 4 * fq);
      *(LAS u32x2*)(Rt + (16 * vt + fr) * LDP + 16 * it + 4 * fq) =
        pk4(b4[0] * (bflo(vv.x) - ec4[0] * ks[0]), b4[1] * (bfhi(vv.x) - ec4[1] * ks[1]), b4[2] * (bflo(vv.y) - ec4[2] * ks[2]), b4[3] * (bfhi(vv.y) - ec4[3] * ks[3])); }
    { const int isq = w & 1; const LAS bf16_t* A = isq ? Qs : Ks;
      const int njobs = w < 2 ? 1 : 2;
      for (int jb = 0; jb < njobs; ++jb) {
        const int I = (w < 2) ? 1 : jb, J = (w < 2) ? 1 : 0;
        f32x4 acc = (f32x4){0.f, 0.f, 0.f, 0.f};
        const LAS bf16_t* pa = A + 16 * I * LDN + rL136; const LAS bf16_t* pb = Ks + 16 * J * LDN + rL136;
#pragma unroll
        for (int k = 0; k < 4; ++k) acc = mma16(ldfr(pa + 32 * k), ldfr(pb + 32 * k), acc);
        const int jj = 16 * J + fr, i0 = 16 * I + 4 * fq; const float cj = encL[jj];
        const f32x4 c4 = *(const LAS f32x4*)(encL + i0); const f32x4 b4 = *(const LAS f32x4*)(becL + i0);
        float pv[4];
#pragma unroll
        for (int r = 0; r < 4; ++r) { const bool keep = isq ? (jj <= i0 + r) : (jj < i0 + r); const float sc = isq ? 1.f : b4[r];
          pv[r] = keep ? acc[r] * sc * __expf(c4[r] - cj) : 0.f; }
        if (!isq && I == J) { LAS float* md = Md + I * 256 + (4 * fq) * 16 + fr; md[0] = pv[0]; md[16] = pv[1]; md[32] = pv[2]; md[48] = pv[3]; }
        *(LAS u32x2*)((isq ? At : Mt) + jj * LDP + i0) = pk4(pv[0], pv[1], pv[2], pv[3]);
      } }
    LBAR();
    if (w < 2) { const LAS float* M = Md + w * 256; const int c = fr;
      float m[16];
#pragma unroll
      for (int q4 = 0; q4 < 4; ++q4) { const f32x4 t4 = *(const LAS f32x4*)(M + c * 16 + 4 * q4); m[4 * q4] = t4[0]; m[4 * q4 + 1] = t4[1]; m[4 * q4 + 2] = t4[2]; m[4 * q4 + 3] = t4[3]; }
      float T[16];
#pragma unroll
      for (int r = 0; r < 16; ++r) { float v = (r == c) ? 1.f : 0.f;
#pragma unroll
        for (int s2 = 0; s2 < r; ++s2) v -= bcast_lane(m[s2], r) * T[s2];
        T[r] = v; }
      if (lane < 16) { LAS u32x4* dst = (LAS u32x4*)(Tt + w * 32 * LDT + c * LDT);
        dst[0] = (u32x4){pg8::cvt_pk_bf16(T[0], T[1]), pg8::cvt_pk_bf16(T[2], T[3]), pg8::cvt_pk_bf16(T[4], T[5]), pg8::cvt_pk_bf16(T[6], T[7])};
        dst[1] = (u32x4){pg8::cvt_pk_bf16(T[8], T[9]), pg8::cvt_pk_bf16(T[10], T[11]), pg8::cvt_pk_bf16(T[12], T[13]), pg8::cvt_pk_bf16(T[14], T[15])}; } }
    LBAR();
    if (w < 2) { const int ct = w; const int cc = 16 * ct + fr;
      const f32x4 x0 = mma16(ldft(Tt + tL24, LDT), ldfr(Rt + 16 * ct * LDP + rL40), (f32x4){0.f, 0.f, 0.f, 0.f});
      const f32x4 ew0 = *(const LAS f32x4*)(ewL + 4 * fq);
      *(LAS u32x2*)(Vn + cc * LDP + 4 * fq) = pk4(x0[0], x0[1], x0[2], x0[3]);
      *(LAS u32x2*)(Vw + cc * LDP + 4 * fq) = pk4(x0[0] * ew0[0], x0[1] * ew0[1], x0[2] * ew0[2], x0[3] * ew0[3]);
      const u32x2 r1 = *(const LAS u32x2*)(Rt + cc * LDP + 16 + 4 * fq);
      asm volatile("s_waitcnt lgkmcnt(0)" ::: "memory");
      bf16x8 fa = ldft(Mt + tL40 + 16, LDP); bf16x8 fb = ldfr(Vn + 16 * ct * LDP + rL40);
      if (fq >= 2) { fa = (bf16x8){0, 0, 0, 0, 0, 0, 0, 0}; fb = (bf16x8){0, 0, 0, 0, 0, 0, 0, 0}; }
      const f32x4 corr = mma16(fa, fb, (f32x4){0.f, 0.f, 0.f, 0.f});
      *(LAS u32x2*)(Rt + cc * LDP + 16 + 4 * fq) = pk4(bflo(r1.x) - corr[0], bfhi(r1.x) - corr[1], bflo(r1.y) - corr[2], bfhi(r1.y) - corr[3]);
      asm volatile("s_waitcnt lgkmcnt(0)" ::: "memory");
      const f32x4 x1 = mma16(ldft(Tt + 32 * LDT + tL24, LDT), ldfr(Rt + 16 * ct * LDP + 16 + rL40), (f32x4){0.f, 0.f, 0.f, 0.f});
      const f32x4 ew1 = *(const LAS f32x4*)(ewL + 16 + 4 * fq);
      *(LAS u32x2*)(Vn + cc * LDP + 16 + 4 * fq) = pk4(x1[0], x1[1], x1[2], x1[3]);
      *(LAS u32x2*)(Vw + cc * LDP + 16 + 4 * fq) = pk4(x1[0] * ew1[0], x1[1] * ew1[1], x1[2] * ew1[2], x1[3] * ew1[3]); }
    LBAR();
    { const f32x4 o1 = mma16(ldfr(Vn + 16 * vt * LDP + rL40), ldft(At + tL40 + 16 * it, LDP), (f32x4){0.f, 0.f, 0.f, 0.f});
      const float eci = ecL[16 * it + fr];
      float o0 = o1[0] + eci * o2[0], o1v = o1[1] + eci * o2[1], o2v = o1[2] + eci * o2[2], o3 = o1[3] + eci * o2[3];
      if (!first) { const unsigned lo = (unsigned)ppv, hi = (unsigned)(ppv >> 32); o0 += bflo(lo); o1v += bfhi(lo); o2v += bflo(hi); o3 += bfhi(hi); }
      *(u32x2*)op = pk4(o0, o1v, o2v, o3); }
    { const bf16x8 fv0 = ldfr(Vw + rL40), fv1 = ldfr(Vw + 16 * LDP + rL40);
#pragma unroll
      for (int a = 0; a < 2; ++a) { const int kt = 2 * w + a; const bf16x8 fa = ldft(Ks + tL136 + 16 * kt, LDN);
        f32x4 a0 = mma16(fa, fv0, Sacc[a][0] * elast), a1 = mma16(fa, fv1, Sacc[a][1] * elast);
        Sacc[a][0] = a0; Sacc[a][1] = a1;
        *(LAS u32x2*)(Sw + fr * LDN + 16 * kt + 4 * fq) = pk4(a0[0], a0[1], a0[2], a0[3]);
        *(LAS u32x2*)(Sw + (16 + fr) * LDN + 16 * kt + 4 * fq) = pk4(a1[0], a1[1], a1[2], a1[3]); } }
    LBAR();
  }
}

__device__ __forceinline__ void gdn3_chain_wg(const Params& P, const Ctx& C, int task) {
  const int b = task >> 5, h = (task >> 2) & 7, vs = task & 3;
  const int d = C.wave >> 2, w = ((C.wave & 3) + 2 * d) & 3, td = C.tid & 255, lane = C.lane, fr = lane & 15, fq = lane >> 4;
  constexpr int LDN = 136, LDP = 40, LDT = 24;
  constexpr int DIRSZ = 64 * 1024;
  LAS unsigned char* L = C.lds + d * DIRSZ;
  LAS bf16_t* Qs = (LAS bf16_t*)L;
  LAS bf16_t* Ks = Qs + 32 * LDN;
  LAS bf16_t* Vt = Ks + 32 * LDN;
  LAS bf16_t* Mt = Vt + 32 * LDP;
  LAS bf16_t* At = Mt + 32 * LDP;
  LAS bf16_t* Rt = At + 32 * LDP;
  LAS bf16_t* Vn = Rt + 32 * LDP;
  LAS bf16_t* Vw = Vn + 32 * LDP;
  LAS bf16_t* Tt = Vw + 32 * LDP;
  LAS bf16_t* St = Tt + 2 * 32 * LDT;
  LAS float* Md = (LAS float*)(St + 2 * 32 * LDN);
  LAS float* gL = Md + 512;
  LAS float* bL = gL + 32; LAS float* becL = bL;
  LAS float* ecL = bL + 32 + (C.wave & 3) * 96; LAS float* encL = ecL + 32; LAS float* ewL = encL + 32;
  LAS f32x4* O2x = (LAS f32x4*)(bL + 32 + 4 * 96);
  const bf16_t* Z = WS(OFF_Z1, bf16_t); bf16_t* MIX = WS(OFF_MIX1, bf16_t); const float* DT = WS(OFF_DT, float);
  const float Aneg = -__expf(GIN(I_GALOG)[d * 8 + h]), dtb = GIN(I_GDTB)[d * 8 + h];
  const int colq = Z1_Q + h * 128, colk = Z1_K + h * 128, colv = Z1_V + h * 128 + vs * 32, outc = h * 128 + vs * 32;
  __syncthreads();
  for (int i = td; i < 60 * 1024 / 4; i += 256) ((LAS unsigned*)L)[i] = 0u;
  f32x4 Sacc[2][2];
#pragma unroll
  for (int a = 0; a < 2; ++a)
#pragma unroll
    for (int c = 0; c < 2; ++c) Sacc[a][c] = (f32x4){0.f, 0.f, 0.f, 0.f};
  const int st_t = td >> 3, st_s = td & 7;
  u32x4 rq[2], rk[2]; u32x2 rv; float ra = 0.f, rb = 0.f;
  auto issue_loads = [&](int step) {
    const int chunk = seq_chunk32(d, step); const size_t row = (size_t)b * TB + chunk * 32 + st_t;
    const u32x4* pq = (const u32x4*)(Z + row * Z1W + colq + st_s * 16); const u32x4* pk = (const u32x4*)(Z + row * Z1W + colk + st_s * 16);
    rq[0] = pq[0]; rq[1] = pq[1]; rk[0] = pk[0]; rk[1] = pk[1];
    rv = *(const u32x2*)(Z + row * Z1W + colv + st_s * 4);
    if (st_s == 0) { rb = DT[row * 32 + d * 8 + h]; ra = DT[row * 32 + 16 + d * 8 + h]; }
  };
  issue_loads(0);
  __syncthreads();
  const int rL136 = fr * LDN + 8 * fq, rL40 = fr * LDP + 8 * fq;
  const int tq = fr >> 2, tp = fr & 3;
  const int tL136 = (8 * fq + tq) * LDN + 4 * tp, tL40 = (8 * fq + tq) * LDP + 4 * tp, tL24 = (8 * fq + tq) * LDT + 4 * tp;
  const int it = w >> 1, vt = w & 1;
  const int si = d ? 31 - st_t : st_t;
  LAS u32x4* stq = (LAS u32x4*)(Qs + si * LDN + st_s * 16); LAS u32x4* stk = (LAS u32x4*)(Ks + si * LDN + st_s * 16);
  LAS bf16_t* stv = Vt + (st_s * 4) * LDP + si;
  const LAS bf16_t* pK_it = Ks + 16 * it * LDN + rL136; const LAS bf16_t* pQ_it = Qs + 16 * it * LDN + rL136;
  for (int step = 0; step < 264; ++step) {
    const int chunk = seq_chunk32(d, step); const int row0 = b * TB + chunk * 32;
    VMWAIT();
    stq[0] = rq[0]; stq[1] = rq[1]; stk[0] = rk[0]; stk[1] = rk[1];
    stv[0] = (bf16_t)(rv.x & 0xffffu); stv[LDP] = (bf16_t)(rv.x >> 16); stv[2 * LDP] = (bf16_t)(rv.y & 0xffffu); stv[3 * LDP] = (bf16_t)(rv.y >> 16);
    if (st_s == 0) { gL[si] = Aneg * softplusf_(ra + dtb); bL[si] = fast_sigmoid(rb); }
    LBAR();
    if (step + 1 < 264) issue_loads(step + 1);
    const bool first = (d == 0) == fwd_first32(chunk);
    bf16_t* op; unsigned long long ppv = 0ull;
    { const int ii = 16 * it + fr; const int t = d ? 31 - ii : ii; op = MIX + (size_t)(row0 + t) * MIXW + outc + 16 * vt + 4 * fq; if (!first) ppv = ld_agent_u64(op); }
    float elast;
    { const float c = wave_incl_scan(lane < 32 ? gL[lane & 31] : 0.f, lane); const float cl = bcast_lane(c, 31); elast = __expf(cl);
      if (lane < 32) { const float ec = __expf(c); ecL[lane] = ec; encL[lane] = c; ewL[lane] = __expf(cl - c); } }
    asm volatile("s_waitcnt lgkmcnt(0)" ::: "memory");
    const LAS bf16_t* Sr = St + (step & 1) * 32 * LDN; LAS bf16_t* Sw = St + ((step + 1) & 1) * 32 * LDN;
    f32x4 o2 = (f32x4){0.f, 0.f, 0.f, 0.f};
    if (w < 2) {
      f32x4 acc = (f32x4){0.f, 0.f, 0.f, 0.f};
      { const LAS bf16_t* pk = Ks + 16 * w * LDN + rL136;
#pragma unroll
        for (int k = 0; k < 4; ++k) { const bf16x8 f = ldfr(pk + 32 * k); acc = mma16(f, f, acc); } }
      { const int jj = 16 * w + fr, i0 = 16 * w + 4 * fq; const float cj = encL[jj];
        const f32x4 c4 = *(const LAS f32x4*)(encL + i0); const f32x4 b4 = *(const LAS f32x4*)(becL + i0);
        LAS float* md = Md + w * 256 + (4 * fq) * 16 + fr;
#pragma unroll
        for (int r = 0; r < 4; ++r) md[16 * r] = (jj < i0 + r) ? acc[r] * b4[r] * __expf(c4[r] - cj) : 0.f; }
      asm volatile("s_waitcnt lgkmcnt(0)" ::: "memory");
      const LAS float* M = Md + w * 256; const int c = fr;
      float m[16];
#pragma unroll
      for (int q4 = 0; q4 < 4; ++q4) { const f32x4 t4 = *(const LAS f32x4*)(M + c * 16 + 4 * q4); m[4 * q4] = t4[0]; m[4 * q4 + 1] = t4[1]; m[4 * q4 + 2] = t4[2]; m[4 * q4 + 3] = t4[3]; }
      float T[16];
#pragma unroll
      for (int r = 0; r < 16; ++r) { float v = (r == c) ? 1.f : 0.f;
#pragma unroll
        for (int s2 = 0; s2 < r; ++s2) v -= bcast_lane(m[s2], r) * T[s2];
        T[r] = v; }
      if (lane < 16) { LAS u32x4* dst = (LAS u32x4*)(Tt + w * 32 * LDT + c * LDT);
        dst[0] = (u32x4){pk2(T[0], T[1]), pk2(T[2], T[3]), pk2(T[4], T[5]), pk2(T[6], T[7])};
        dst[1] = (u32x4){pk2(T[8], T[9]), pk2(T[10], T[11]), pk2(T[12], T[13]), pk2(T[14], T[15])}; }
    } else {
      const int pvt = w & 1;
#pragma unroll
      for (int pit = 1; pit >= 0; --pit) {
        f32x4 ks = (f32x4){0.f, 0.f, 0.f, 0.f}, qs = (f32x4){0.f, 0.f, 0.f, 0.f};
        const LAS bf16_t* pS = Sr + 16 * pvt * LDN + rL136; const LAS bf16_t* pK = Ks + 16 * pit * LDN + rL136; const LAS bf16_t* pQ = Qs + 16 * pit * LDN + rL136;
#pragma unroll
        for (int k = 0; k < 4; ++k) { const bf16x8 fs = ldfr(pS + 32 * k); ks = mma16(ldfr(pK + 32 * k), fs, ks); qs = mma16(fs, ldfr(pQ + 32 * k), qs); }
        const u32x2 vv = *(const LAS u32x2*)(Vt + (16 * pvt + fr) * LDP + 16 * pit + 4 * fq);
        const f32x4 ec4 = *(const LAS f32x4*)(ecL + 16 * pit + 4 * fq), b4 = *(const LAS f32x4*)(bL + 16 * pit + 4 * fq);
        *(LAS u32x2*)(Rt + (16 * pvt + fr) * LDP + 16 * pit + 4 * fq) =
          pk4(b4[0] * (bflo(vv.x) - ec4[0] * ks[0]), b4[1] * (bfhi(vv.x) - ec4[1] * ks[1]), b4[2] * (bflo(vv.y) - ec4[2] * ks[2]), b4[3] * (bfhi(vv.y) - ec4[3] * ks[3]));
        if (pit == 1) o2 = qs; else O2x[pvt * 64 + lane] = qs;
      }
#pragma unroll
      for (int jb = 0; jb < 2; ++jb) {
        const bool isq = (w == 3) || (jb == 1);
        const int I = (w == 2) ? 1 : jb, J = (w == 2) ? 0 : jb;
        f32x4 acc = (f32x4){0.f, 0.f, 0.f, 0.f};
        const LAS bf16_t* pa = (isq ? Qs : Ks) + 16 * I * LDN + rL136; const LAS bf16_t* pb = Ks + 16 * J * LDN + rL136;
#pragma unroll
        for (int k = 0; k < 4; ++k) acc = mma16(ldfr(pa + 32 * k), ldfr(pb + 32 * k), acc);
        const int jj = 16 * J + fr, i0 = 16 * I + 4 * fq; const float cj = encL[jj];
        const f32x4 c4 = *(const LAS f32x4*)(encL + i0); const f32x4 b4 = *(const LAS f32x4*)(becL + i0);
        float pv[4];
#pragma unroll
        for (int r = 0; r < 4; ++r) { const bool keep = isq ? (jj <= i0 + r) : (jj < i0 + r); const float sc = isq ? 1.f : b4[r];
          pv[r] = keep ? acc[r] * sc * __expf(c4[r] - cj) : 0.f; }
        *(LAS u32x2*)((isq ? At : Mt) + jj * LDP + i0) = pk4(pv[0], pv[1], pv[2], pv[3]);
      }
    }
    LBAR();
    if (w < 2) { const int ct = w; const int cc = 16 * ct + fr;
      const f32x4 x0 = mma16(ldft(Tt + tL24, LDT), ldfr(Rt + 16 * ct * LDP + rL40), (f32x4){0.f, 0.f, 0.f, 0.f});
      const f32x4 ew0 = *(const LAS f32x4*)(ewL + 4 * fq);
      *(LAS u32x2*)(Vn + cc * LDP + 4 * fq) = pk4(x0[0], x0[1], x0[2], x0[3]);
      *(LAS u32x2*)(Vw + cc * LDP + 4 * fq) = pk4(x0[0] * ew0[0], x0[1] * ew0[1], x0[2] * ew0[2], x0[3] * ew0[3]);
      const u32x2 r1 = *(const LAS u32x2*)(Rt + cc * LDP + 16 + 4 * fq);
      asm volatile("s_waitcnt lgkmcnt(0)" ::: "memory");
      bf16x8 fa = ldft(Mt + tL40 + 16, LDP); bf16x8 fb = ldfr(Vn + 16 * ct * LDP + rL40);
      if (fq >= 2) { fa = (bf16x8){0, 0, 0, 0, 0, 0, 0, 0}; fb = (bf16x8){0, 0, 0, 0, 0, 0, 0, 0}; }
      const f32x4 corr = mma16(fa, fb, (f32x4){0.f, 0.f, 0.f, 0.f});
      *(LAS u32x2*)(Rt + cc * LDP + 16 + 4 * fq) = pk4(bflo(r1.x) - corr[0], bfhi(r1.x) - corr[1], bflo(r1.y) - corr[2], bfhi(r1.y) - corr[3]);
      asm volatile("s_waitcnt lgkmcnt(0)" ::: "memory");
      const f32x4 x1 = mma16(ldft(Tt + 32 * LDT + tL24, LDT), ldfr(Rt + 16 * ct * LDP + 16 + rL40), (f32x4){0.f, 0.f, 0.f, 0.f});
      const f32x4 ew1 = *(const LAS f32x4*)(ewL + 16 + 4 * fq);
      *(LAS u32x2*)(Vn + cc * LDP + 16 + 4 * fq) = pk4(x1[0], x1[1], x1[2], x1[3]);
      *(LAS u32x2*)(Vw + cc * LDP + 16 + 4 * fq) = pk4(x1[0] * ew1[0], x1[1] * ew1[1], x1[2] * ew1[2], x1[3] * ew1[3]); }
    LBAR();
    if (w < 2) o2 = O2x[w * 64 + lane];
    { const f32x4 o1 = mma16(ldfr(Vn + 16 * vt * LDP + rL40), ldft(At + tL40 + 16 * it, LDP), (f32x4){0.f, 0.f, 0.f, 0.f});
      const float eci = ecL[16 * it + fr];
      float o0 = o1[0] + eci * o2[0], o1v = o1[1] + eci * o2[1], o2v = o1[2] + eci * o2[2], o3 = o1[3] + eci * o2[3];
      if (!first) { const unsigned lo = (unsigned)ppv, hi = (unsigned)(ppv >> 32); o0 += bflo(lo); o1v += bfhi(lo); o2v += bflo(hi); o3 += bfhi(hi); }
      *(u32x2*)op = pk4(o0, o1v, o2v, o3); }
    { const bf16x8 fv0 = ldfr(Vw + rL40), fv1 = ldfr(Vw + 16 * LDP + rL40);
#pragma unroll
      for (int a = 0; a < 2; ++a) { const int kt = 2 * w + a; const bf16x8 fa = ldft(Ks + tL136 + 16 * kt, LDN);
        f32x4 a0 = mma16(fa, fv0, Sacc[a][0] * elast), a1 = mma16(fa, fv1, Sacc[a][1] * elast);
        Sacc[a][0] = a0; Sacc[a][1] = a1;
        *(LAS u32x2*)(Sw + fr * LDN + 16 * kt + 4 * fq) = pk4(a0[0], a0[1], a0[2], a0[3]);
        *(LAS u32x2*)(Sw + (16 + fr) * LDN + 16 * kt + 4 * fq) = pk4(a1[0], a1[1], a1[2], a1[3]); } }
    LBAR();
  }
}

__device__ __forceinline__ void hgrn2_chain_wg(const Params& P, const Ctx& C, int task) {
  const int b = task >> 5, h = (task >> 2) & 7, vs = task & 3;
  const int d = C.wave >> 2, w = C.wave & 3, td = C.tid & 255, lane = C.lane, fr = lane & 15, fq = lane >> 4;
  constexpr int LDN = 136, LDP = 40;
  constexpr int DIRSZ = 72 * 1024;
  LAS unsigned char* L = C.lds + d * DIRSZ;
  LAS bf16_t* Qt = (LAS bf16_t*)L;
  LAS bf16_t* Kh = Qt + 32 * LDN;
  LAS bf16_t* Kw = Kh + 32 * LDN;
  LAS bf16_t* Vs = Kw + 32 * LDN;
  LAS bf16_t* Pt = Vs + 32 * LDP;
  LAS bf16_t* St = Pt + 32 * LDP;
  LAS float* PR = (LAS float*)(St + 2 * 32 * LDN);
  LAS float* PL = PR + 32 * 128;
  const bf16_t* Z = WS(OFF_Z1, bf16_t); bf16_t* MIX = WS(OFF_MIX1, bf16_t);
  const int colq = Z1_HQ + h * 128, colf = Z1_HF + d * 1024 + h * 128, colv = Z1_HI + h * 128 + vs * 32, outc = 1024 + h * 128 + vs * 32;
  __syncthreads();
  for (int i = td; i < 32 * LDP / 2; i += 256) ((LAS unsigned*)Pt)[i] = 0u;
  for (int i = td; i < 2 * 32 * LDN / 2; i += 256) ((LAS unsigned*)St)[i] = 0u;
  f32x4 Sacc[2][2];
#pragma unroll
  for (int a = 0; a < 2; ++a)
#pragma unroll
    for (int c = 0; c < 2; ++c) Sacc[a][c] = (f32x4){0.f, 0.f, 0.f, 0.f};
  const int st_t = td >> 3, st_s = td & 7;
  float lbv[16];
#pragma unroll
  for (int e = 0; e < 16; ++e) lbv[e] = WS(OFF_LB1, float)[h * 128 + st_s * 16 + e];
  u32x4 rq[2], rf[2]; u32x2 rv;
  auto issue_loads = [&](int step) {
    const int chunk = seq_chunk32(d, step); const size_t row = (size_t)b * TB + chunk * 32 + st_t;
    const u32x4* pq = (const u32x4*)(Z + row * Z1W + colq + st_s * 16); const u32x4* pf = (const u32x4*)(Z + row * Z1W + colf + st_s * 16);
    rq[0] = pq[0]; rq[1] = pq[1]; rf[0] = pf[0]; rf[1] = pf[1];
    rv = *(const u32x2*)(Z + row * Z1W + colv + st_s * 4);
  };
  issue_loads(0);
  __syncthreads();
  const int rL136 = fr * LDN + 8 * fq;
  const int tq = fr >> 2, tp = fr & 3;
  const int tL136 = (8 * fq + tq) * LDN + 4 * tp, tL40 = (8 * fq + tq) * LDP + 4 * tp;
  const int vt = w & 1, it = w >> 1;
  const int si = d ? 31 - st_t : st_t;
  LAS float* prow = PR + si * 128 + st_s * 16;
  LAS float* pscan = PR + (td >> 7) * 16 * 128 + (td & 127);
  for (int step = 0; step < 264; ++step) {
    const int chunk = seq_chunk32(d, step); const int row0 = b * TB + chunk * 32;
    VMWAIT();
    float qv[16], kk[16];
    { const unsigned qw[8] = {rq[0].x, rq[0].y, rq[0].z, rq[0].w, rq[1].x, rq[1].y, rq[1].z, rq[1].w};
      const unsigned fw[8] = {rf[0].x, rf[0].y, rf[0].z, rf[0].w, rf[1].x, rf[1].y, rf[1].z, rf[1].w};
      f32x4 f4[4];
#pragma unroll
      for (int e = 0; e < 8; ++e) { qv[2 * e] = bflo(qw[e]); qv[2 * e + 1] = bfhi(qw[e]);
        const float k0 = (1.f - lbv[2 * e]) * (1.f - fast_sigmoid(bflo(fw[e]))), k1 = (1.f - lbv[2 * e + 1]) * (1.f - fast_sigmoid(bfhi(fw[e])));
        kk[2 * e] = k0; kk[2 * e + 1] = k1; f4[e >> 1][(2 * e) & 3] = 1.f - k0; f4[e >> 1][(2 * e + 1) & 3] = 1.f - k1; }
#pragma unroll
      for (int e = 0; e < 4; ++e) *(LAS f32x4*)(prow + 4 * e) = f4[e];
      *(LAS u32x2*)(Vs + si * LDP + st_s * 4) = rv; }
    LBAR();
    if (step + 1 < 264) issue_loads(step + 1);
    const bool first = (d == 0) == fwd_first32(chunk);
    bf16_t* op; unsigned long long ppv = 0ull;
    { const int ii = 16 * it + fr; const int t = d ? 31 - ii : ii; op = MIX + (size_t)(row0 + t) * MIXW + outc + 16 * vt + 4 * fq; if (!first) ppv = ld_agent_u64(op); }
    { float pv[16];
#pragma unroll
      for (int i = 0; i < 16; ++i) pv[i] = pscan[i * 128];
#pragma unroll
      for (int i = 1; i < 16; ++i) pv[i] *= pv[i - 1];
#pragma unroll
      for (int i = 0; i < 16; ++i) pscan[i * 128] = pv[i]; }
    LBAR();
    { const bool hi = si >= 16;
      unsigned oq[8], oh[8], ow[8];
#pragma unroll
      for (int e4 = 0; e4 < 4; ++e4) {
        f32x4 p = *(const LAS f32x4*)(prow + 4 * e4); const f32x4 p15 = *(const LAS f32x4*)(PR + 15 * 128 + st_s * 16 + 4 * e4), p31 = *(const LAS f32x4*)(PR + 31 * 128 + st_s * 16 + 4 * e4);
        const f32x4 pl = p15 * p31; if (hi) p = p * p15;
        if (si == 0) *(LAS f32x4*)(PL + st_s * 16 + 4 * e4) = pl;
        float q_[4], h_[4], w_[4];
#pragma unroll
        for (int r = 0; r < 4; ++r) { const int e = 4 * e4 + r; const float rp = __builtin_amdgcn_rcpf(fmaxf(p[r], 1e-30f)); q_[r] = qv[e] * p[r]; h_[r] = kk[e] * rp; w_[r] = h_[r] * pl[r]; }
        oq[2 * e4] = pk2(q_[0], q_[1]); oq[2 * e4 + 1] = pk2(q_[2], q_[3]); oh[2 * e4] = pk2(h_[0], h_[1]); oh[2 * e4 + 1] = pk2(h_[2], h_[3]); ow[2 * e4] = pk2(w_[0], w_[1]); ow[2 * e4 + 1] = pk2(w_[2], w_[3]); }
      LAS u32x4* dq = (LAS u32x4*)(Qt + si * LDN + st_s * 16); LAS u32x4* dh = (LAS u32x4*)(Kh + si * LDN + st_s * 16); LAS u32x4* dw = (LAS u32x4*)(Kw + si * LDN + st_s * 16);
      dq[0] = (u32x4){oq[0], oq[1], oq[2], oq[3]}; dq[1] = (u32x4){oq[4], oq[5], oq[6], oq[7]};
      dh[0] = (u32x4){oh[0], oh[1], oh[2], oh[3]}; dh[1] = (u32x4){oh[4], oh[5], oh[6], oh[7]};
      dw[0] = (u32x4){ow[0], ow[1], ow[2], ow[3]}; dw[1] = (u32x4){ow[4], ow[5], ow[6], ow[7]}; }
    LBAR();
    if (w < 3) { const int I = w >= 1 ? 1 : 0, J = w == 2 ? 1 : 0;
      f32x4 acc = (f32x4){0.f, 0.f, 0.f, 0.f};
      const LAS bf16_t* pa = Qt + 16 * I * LDN + rL136; const LAS bf16_t* pb = Kh + 16 * J * LDN + rL136;
#pragma unroll
      for (int k = 0; k < 4; ++k) acc = mma16(ldfr(pa + 32 * k), ldfr(pb + 32 * k), acc);
      const int jj = 16 * J + fr, i0 = 16 * I + 4 * fq;
      *(LAS u32x2*)(Pt + jj * LDP + i0) = pk4(jj <= i0 ? acc[0] : 0.f, jj <= i0 + 1 ? acc[1] : 0.f, jj <= i0 + 2 ? acc[2] : 0.f, jj <= i0 + 3 ? acc[3] : 0.f); }
    const LAS bf16_t* Sr = St + (step & 1) * 32 * LDN; LAS bf16_t* Sw = St + ((step + 1) & 1) * 32 * LDN;
    f32x4 o2 = (f32x4){0.f, 0.f, 0.f, 0.f};
    { const LAS bf16_t* ps = Sr + 16 * vt * LDN + rL136; const LAS bf16_t* pq = Qt + 16 * it * LDN + rL136;
#pragma unroll
      for (int k = 0; k < 4; ++k) o2 = mma16(ldfr(ps + 32 * k), ldfr(pq + 32 * k), o2); }
    { const bf16x8 fv0 = ldft(Vs + tL40, LDP), fv1 = ldft(Vs + tL40 + 16, LDP);
#pragma unroll
      for (int a = 0; a < 2; ++a) { const int kt = 2 * w + a; const f32x4 dec = *(const LAS f32x4*)(PL + 16 * kt + 4 * fq);
        const bf16x8 fa = ldft(Kw + tL136 + 16 * kt, LDN);
        const f32x4 a0 = mma16(fa, fv0, Sacc[a][0] * dec), a1 = mma16(fa, fv1, Sacc[a][1] * dec);
        Sacc[a][0] = a0; Sacc[a][1] = a1;
        *(LAS u32x2*)(Sw + fr * LDN + 16 * kt + 4 * fq) = pk4(a0[0], a0[1], a0[2], a0[3]);
        *(LAS u32x2*)(Sw + (16 + fr) * LDN + 16 * kt + 4 * fq) = pk4(a1[0], a1[1], a1[2], a1[3]); } }
    LBAR();
    { const f32x4 o1 = mma16(ldft(Vs + tL40 + 16 * vt, LDP), ldft(Pt + tL40 + 16 * it, LDP), (f32x4){0.f, 0.f, 0.f, 0.f});
      float o0 = o1[0] + o2[0], o1v = o1[1] + o2[1], o2v = o1[2] + o2[2], o3 = o1[3] + o2[3];
      if (!first) { const unsigned lo = (unsigned)ppv, hi2 = (unsigned)(ppv >> 32); o0 += bflo(lo); o1v += bfhi(lo); o2v += bflo(hi2); o3 += bfhi(hi2); }
      *(u32x2*)op = pk4(o0, o1v, o2v, o3); }
    LBAR();
  }
}
__device__ __forceinline__ void phase_chain1(const Params& P, const Ctx& C, int mode) {
  if (mode != 2) for (int task = C.bid; task < 128; task += C.nblk) gdn3_chain_wg(P, C, task);
  __builtin_amdgcn_sched_barrier(0);
  if (mode != 1) for (int task = C.bid < 128 ? C.bid + C.nblk : C.bid; task < 256; task += C.nblk) hgrn2_chain_wg(P, C, task - 128);
}
__device__ __forceinline__ void phase_onorm(const Params& P, const Ctx& C, int ident) {
  bf16_t* MIX = WS(OFF_MIX1, bf16_t); bf16_t* U = WS(OFF_U1B, bf16_t);
  const float* m1 = WS(OFF_MOD, float) + (size_t)5 * 6144;
  for (int r = C.gw; r < R; r += C.ngw) {
    const int b = r / TB, pos = r % TB; if (pos < CTXL) continue;
    f32x4 h[4], u[4]; row_load(GOUT + ((size_t)b * SEQ + (pos - CTXL)) * D, C.lane, h);
    row_modulate(h, m1 + (size_t)b * 6144, m1 + (size_t)b * 6144 + D, C.lane, u);
    row_store_bf16(U + (size_t)r * D, C.lane, u);
  }
  LAS float* scr = (LAS float*)C.lds + C.wave * (64 * 33);
  convert_experts(P, 1, WS(OFF_WE1, bf16_t), WS(OFF_WE1 + 64 * MiB, bf16_t), C, scr);
}
__device__ __forceinline__ void phase_gates(const Params& P, const Ctx& C) {
  pg8::Gemm g{WS(OFF_U1B, bf16_t), WS(OFF_WG1, bf16_t), D, D}; pg8::GridOrder S; S.init(128, 8, C.nblk, C.bid, 1);
  pg8::EpiGateMul E{WS(OFF_MIX1, bf16_t), MIXW, (LAS float*)(C.lds + 131072), GIN(I_GNG), GIN(I_HNG)};
  pg8::gemm_phase(C.lds, g, S, E);
}


#define XB_TMO      128
#define XB_XCNT(j)  (256  + 64 * (j))
#define XB_XSUB(j)  (1280 + 64 * (j))
#define XB_XGEN(j)  (2304 + 64 * (j))
#define XB_TOP      3328
#define XB_TOPGEN   3392
#define XCD_BAR_WORDS 3456
#define XB_SPIN_CAP (1u << 22)
constexpr size_t OFF_BAR = 16 * 1024;
constexpr int LDS_BAR_OFF = LDS_BYTES - 64;
__device__ __forceinline__ unsigned xb_ld(unsigned* p)              { return __hip_atomic_load(p, __ATOMIC_RELAXED, __HIP_MEMORY_SCOPE_AGENT); }
__device__ __forceinline__ unsigned xb_add(unsigned* p, unsigned v) { return __hip_atomic_fetch_add(p, v, __ATOMIC_RELAXED, __HIP_MEMORY_SCOPE_AGENT); }
__device__ __forceinline__ unsigned xb_xcc_id() { return (unsigned)__builtin_amdgcn_s_getreg((3 << 11) | 20) & 0xFu; }
#define XB_SPIN(cond, bar) do { unsigned _sp = 0; while (cond) { __builtin_amdgcn_s_sleep(1); \
    if ((++_sp & 255u) == 0u) { if (xb_ld(&(bar)[XB_TMO])) break; if (_sp > XB_SPIN_CAP) { atomicAdd(&(bar)[XB_TMO], 1u); break; } } } } while (0)
__device__ __forceinline__ void xcd_barrier_post(unsigned* bar) { if (threadIdx.x == 0) (void)xb_add(&bar[XB_XCNT(xb_xcc_id())], 1u); }
__device__ __forceinline__ void xcd_barrier_complete(unsigned* bar, unsigned x, unsigned& nloc, unsigned& nx) {
  const unsigned G = gridDim.x * gridDim.y * gridDim.z;
  unsigned sum, cnt, mine, sp = 0u;
  for (;;) {
    sum = 0u; cnt = 0u; mine = 0u;
#pragma unroll
    for (unsigned j = 0; j < 16; ++j) { const unsigned c = xb_ld(&bar[XB_XCNT(j)]); sum += c; cnt += (c > 0u) ? 1u : 0u; mine = (j == x) ? c : mine; }
    if (sum == G) break;
    __builtin_amdgcn_s_sleep(1);
    if ((++sp & 255u) == 0u) { if (xb_ld(&bar[XB_TMO])) break; if (sp > XB_SPIN_CAP) { atomicAdd(&bar[XB_TMO], 1u); break; } }
  }
  nloc = mine > 0u ? mine : 1u; nx = cnt > 0u ? cnt : 1u;
}
__device__ __forceinline__ void xcd_barrier(unsigned* bar, volatile LAS unsigned* st) {
  asm volatile("s_waitcnt vmcnt(0)" ::: "memory");
  __syncthreads();
  if (threadIdx.x == 0) {
    const unsigned x = xb_xcc_id();
    __builtin_amdgcn_s_waitcnt(0);
    unsigned nloc = st[0], nx = st[1];
    if (nloc == 0u) { xcd_barrier_complete(bar, x, nloc, nx); st[0] = nloc; st[1] = nx; }
    const unsigned old = xb_add(&bar[XB_XSUB(x)], 1u);
    const unsigned gen = old / nloc;
    if (old + 1u == (gen + 1u) * nloc) {
      __builtin_amdgcn_fence(__ATOMIC_RELEASE, "agent");
      asm volatile("s_waitcnt vmcnt(0)" ::: "memory");
      const unsigned og = xb_add(&bar[XB_TOP], 1u);
      const unsigned tg = og / nx;
      if (og + 1u == (tg + 1u) * nx) xb_add(&bar[XB_TOPGEN], 1u);
      else XB_SPIN(xb_ld(&bar[XB_TOPGEN]) == tg, bar);
      __builtin_amdgcn_fence(__ATOMIC_ACQUIRE, "agent");
      xb_add(&bar[XB_XGEN(x)], 1u);
      asm volatile("s_waitcnt vmcnt(0)" ::: "memory");
    } else {
      XB_SPIN(xb_ld(&bar[XB_XGEN(x)]) == gen, bar);
      __builtin_amdgcn_fence(__ATOMIC_ACQUIRE, "agent");
      asm volatile("s_waitcnt vmcnt(0)" ::: "memory");
    }
  }
  __syncthreads();
}
__global__ void __launch_bounds__(NT, 2) fwd_megakernel(Params Pk) {
  extern __shared__ __attribute__((aligned(16))) unsigned char lds_raw[];
  cg::grid_group grid = cg::this_grid();
#ifndef PROBE_DOUBLE
#define PROBE_DOUBLE -1
#endif
#ifndef PROBE_MODE
#define PROBE_MODE 0
#endif
#ifndef PHASE_MASK
#define PHASE_MASK 0xFFFFFFFFu
#endif
#define SYNC() do { const unsigned char* wsb_ = ((const Params*)(const __attribute__((address_space(4))) Params*)__builtin_amdgcn_kernarg_segment_ptr())->ws; \
    xcd_barrier((unsigned*)(GAS unsigned*)(wsb_ + OFF_BAR), (volatile LAS unsigned*)((LAS unsigned char*)lds_raw + LDS_BAR_OFF)); } while (0)
#define SYNC_CG() do { __syncthreads(); grid.sync(); } while (0)
  asm volatile("s_nop 0\n\ts_nop 0\n\ts_nop 0\n\ts_nop 0");
  if (threadIdx.x < 16) ((LAS unsigned*)((LAS unsigned char*)lds_raw + LDS_BAR_OFF))[threadIdx.x] = 0u;
  __syncthreads();
  xcd_barrier_post((unsigned*)(GAS unsigned*)(Pk.ws + OFF_BAR));
#define LAUNDER() const Params* pp; { unsigned long long a_ = (unsigned long long)__builtin_amdgcn_kernarg_segment_ptr(); asm volatile("" : "+s"(a_)); \
    const unsigned lo_ = __builtin_amdgcn_readfirstlane((unsigned)a_), hi_ = __builtin_amdgcn_readfirstlane((unsigned)(a_ >> 32)); \
    pp = (const Params*)(const __attribute__((address_space(4))) Params*)(((unsigned long long)hi_ << 32) | lo_); } \
  Ctx C; { int t_ = threadIdx.x; asm volatile("" : "+v"(t_)); t_ &= 511; int b_ = blockIdx.x; asm volatile("" : "+s"(b_)); b_ = __builtin_amdgcn_readfirstlane(b_); int g_ = gridDim.x; asm volatile("" : "+s"(g_)); g_ = __builtin_amdgcn_readfirstlane(g_); \
    C.lds = (LAS unsigned char*)lds_raw; C.tid = t_; C.lane = t_ & 63; C.wave = __builtin_amdgcn_readfirstlane(t_ >> 6); \
    C.bid = b_; C.nblk = g_; C.gw = b_ * NWAVES + C.wave; C.ngw = g_ * NWAVES; }
#define WSP(off, T) ((T*)(GAS T*)(pp->ws + (off)))
  for (int rep_ = 0; rep_ < ((PROBE_DOUBLE == 0) ? 2 : 1); ++rep_) { if (PHASE_MASK & (1u << 0)) { LAUNDER(); phase0(*pp, C); }  SYNC_CG(); }
  for (int rep_ = 0; rep_ < ((PROBE_DOUBLE == 1) ? 2 : 1); ++rep_) { if (PHASE_MASK & (1u << 1)) { LAUNDER(); phase_u0(*pp, C); }  SYNC(); }
  for (int rep_ = 0; rep_ < ((PROBE_DOUBLE == 2) ? 2 : 1); ++rep_) { if (PHASE_MASK & (1u << 2)) { LAUNDER(); phase_inproj(*pp, C, WSP(OFF_U0, bf16_t), WSP(OFF_WAB, bf16_t), WSP(OFF_Z0, bf16_t), Z0W); }  SYNC(); }
  for (int rep_ = 0; rep_ < ((PROBE_DOUBLE == 3) ? 2 : 1); ++rep_) { if (PHASE_MASK & (1u << 3)) { LAUNDER(); phase_feat0(*pp, C, rep_); }  SYNC(); }
  for (int rep_ = 0; rep_ < ((PROBE_DOUBLE == 4) ? 2 : 1); ++rep_) { if (PHASE_MASK & (1u << 4)) { LAUNDER(); phase_chain0(*pp, C, rep_ ? PROBE_MODE : 0); }  SYNC(); }
  for (int rep_ = 0; rep_ < ((PROBE_DOUBLE == 5) ? 2 : 1); ++rep_) { if (PHASE_MASK & (1u << 5)) { LAUNDER(); phase_ssdfin(*pp, C, rep_); }  SYNC(); }
  for (int rep_ = 0; rep_ < ((PROBE_DOUBLE == 6) ? 2 : 1); ++rep_) { if (PHASE_MASK & (1u << 6)) { LAUNDER(); phase_outproj(*pp, C, 0); }  SYNC(); }
  for (int rep_ = 0; rep_ < ((PROBE_DOUBLE == 7) ? 2 : 1); ++rep_) { if (PHASE_MASK & (1u << 7)) { LAUNDER(); phase_lnmix(*pp, C, 0, rep_); }  SYNC(); }
  for (int rep_ = 0; rep_ < ((PROBE_DOUBLE == 9) ? 2 : 1); ++rep_) { if (PHASE_MASK & (1u << 9)) { LAUNDER(); phase_moe1(*pp, C, 0); }  SYNC(); }
  for (int rep_ = 0; rep_ < ((PROBE_DOUBLE == 10) ? 2 : 1); ++rep_) { if (PHASE_MASK & (1u << 10)) { LAUNDER(); phase_moe2(*pp, C, 0); }  SYNC(); }
  for (int rep_ = 0; rep_ < ((PROBE_DOUBLE == 11) ? 2 : 1); ++rep_) { if (PHASE_MASK & (1u << 11)) { LAUNDER(); phase_lnffn(*pp, C, 0, rep_); }  SYNC(); }
  for (int rep_ = 0; rep_ < ((PROBE_DOUBLE == 12) ? 2 : 1); ++rep_) { if (PHASE_MASK & (1u << 12)) { LAUNDER(); phase_inproj(*pp, C, WSP(OFF_U1, bf16_t), WSP(OFF_WCD, bf16_t), WSP(OFF_Z1, bf16_t), Z1W); }  SYNC(); }
  for (int rep_ = 0; rep_ < ((PROBE_DOUBLE == 13) ? 2 : 1); ++rep_) { if (PHASE_MASK & (1u << 13)) { LAUNDER(); phase_feat1(*pp, C, rep_); }  SYNC(); }
  for (int rep_ = 0; rep_ < ((PROBE_DOUBLE == 14) ? 2 : 1); ++rep_) { if (PHASE_MASK & (1u << 14)) { LAUNDER(); phase_chain1(*pp, C, rep_ ? PROBE_MODE : 0); }  SYNC(); }
  for (int rep_ = 0; rep_ < ((PROBE_DOUBLE == 15) ? 2 : 1); ++rep_) { if (PHASE_MASK & (1u << 15)) { LAUNDER(); phase_onorm(*pp, C, rep_); }  SYNC(); }
  for (int rep_ = 0; rep_ < ((PROBE_DOUBLE == 16) ? 2 : 1); ++rep_) { if (PHASE_MASK & (1u << 16)) { LAUNDER(); phase_gates(*pp, C); }  SYNC(); }
  for (int rep_ = 0; rep_ < ((PROBE_DOUBLE == 17) ? 2 : 1); ++rep_) { if (PHASE_MASK & (1u << 17)) { LAUNDER(); phase_outproj(*pp, C, 1); }  SYNC(); }
  for (int rep_ = 0; rep_ < ((PROBE_DOUBLE == 18) ? 2 : 1); ++rep_) { if (PHASE_MASK & (1u << 18)) { LAUNDER(); phase_lnmix(*pp, C, 1, rep_); }  SYNC(); }
  for (int rep_ = 0; rep_ < ((PROBE_DOUBLE == 20) ? 2 : 1); ++rep_) { if (PHASE_MASK & (1u << 20)) { LAUNDER(); phase_moe1(*pp, C, 1); }  SYNC(); }
  for (int rep_ = 0; rep_ < ((PROBE_DOUBLE == 21) ? 2 : 1); ++rep_) { if (PHASE_MASK & (1u << 21)) { LAUNDER(); phase_moe2(*pp, C, 1); }  SYNC(); }
  for (int rep_ = 0; rep_ < ((PROBE_DOUBLE == 22) ? 2 : 1); ++rep_) { if (PHASE_MASK & (1u << 22)) { LAUNDER(); phase_lnffn(*pp, C, 1, rep_); } if (PROBE_DOUBLE == 22) SYNC(); }
}

extern "C" void kernel_launch(void* const* d_in, const int* in_sizes, int n_in, void* d_out, int out_size,
                              void* d_ws, size_t ws_size, hipStream_t stream) {
  static int grid_blocks = 0;
  if (!grid_blocks) {
    int dev = 0, cus = 0, per_cu = 0;
    (void)hipGetDevice(&dev);
    (void)hipDeviceGetAttribute(&cus, hipDeviceAttributeMultiprocessorCount, dev);
    (void)hipFuncSetAttribute((const void*)fwd_megakernel, hipFuncAttributeMaxDynamicSharedMemorySize, LDS_BYTES);
    (void)hipOccupancyMaxActiveBlocksPerMultiprocessor(&per_cu, (const void*)fwd_megakernel, NT, LDS_BYTES);
    if (per_cu < 1) per_cu = 1;
    grid_blocks = cus * 1;
    fprintf(stderr, "grid %d (cus %d per_cu %d) ws_size %zu need %zu n_in %d\n", grid_blocks, cus, per_cu, ws_size, (size_t)WS_NEED, n_in);
    if (ws_size < WS_NEED || n_in != 39) { fprintf(stderr, "kernel_launch: workspace too small or unexpected inputs\n"); grid_blocks = -1; }
  }
  if (grid_blocks < 0) return;
  (void)hipMemsetAsync(d_ws, 0, 64 * 1024, stream);
  Params p{};
  for (int i = 0; i < 39; ++i) p.in[i] = (const float*)d_in[i];
  p.out = (float*)d_out; p.ws = (unsigned char*)d_ws;
  void* args[] = {&p};
  hipError_t e = hipLaunchCooperativeKernel((const void*)fwd_megakernel, dim3(grid_blocks), dim3(NT), args, LDS_BYTES, stream);
  if (e != hipSuccess) fprintf(stderr, "cooperative launch failed: %s (grid %d)\n", hipGetErrorString(e), grid_blocks);
}
```

```cpp
#include <hip/hip_runtime.h>
#include <hip/hip_cooperative_groups.h>
#include <cstdio>
#include <cstdint>
#include <type_traits>
namespace cg = cooperative_groups;

#define LAS __attribute__((address_space(3)))
typedef unsigned short bf16_t;
typedef short bf16x8 __attribute__((ext_vector_type(8)));
typedef float f32x4 __attribute__((ext_vector_type(4)));
typedef float f32x2 __attribute__((ext_vector_type(2)));
typedef unsigned u32x4 __attribute__((ext_vector_type(4)));
typedef unsigned u32x2 __attribute__((ext_vector_type(2)));

constexpr int D = 1024, NB = 4, SEQ = 8192, CTXL = 256, TB = SEQ + CTXL  , R = NB * TB  , RLAT = NB * SEQ;
constexpr int NT = 512, NWAVES = 8;
constexpr int LDS_BYTES = 163840;
constexpr int AB_IN = 4640, CD_IN = 9248;
constexpr int Z0W = 4608, Z1W = 7168, MIXW = 2048;
constexpr int NEXP = 32, DEXP = 512, MOE_BLK = 256, MAX_BLKS = 304, MAX_SLOTS = 296 * 256;
constexpr float ALPHA = 1.41421356237309515f;
constexpr float LN_EPS = 1e-5f, RMS_EPS = 1e-6f;
constexpr int Z0_RGX = 0, Z0_RGY = 1024, Z0_SSDZ = 2048, Z0_XBC = 3072, Z0_B = 4096, Z0_C = 4352;
constexpr int Z1_Q = 0, Z1_K = 1024, Z1_V = 2048, Z1_HQ = 3072, Z1_HF = 4096, Z1_HI = 6144;

constexpr size_t MiB = 1u << 20;
constexpr size_t OFF_CTL = 0;
constexpr size_t OFF_MOD = 64 * 1024;
constexpr size_t OFF_LB1 = 320 * 1024;
constexpr size_t OFF_ROUTE = 512 * 1024;
constexpr size_t OFF_SLOTW = 2 * MiB;
constexpr size_t OFF_DT = 3 * MiB;
constexpr size_t OFF_GV = 28 * MiB;
constexpr size_t OFF_HCTX = 8 * MiB;
constexpr size_t OFF_TCTX = 12 * MiB;
constexpr size_t OFF_WOUT0 = 16 * MiB, OFF_WOUT1 = 20 * MiB, OFF_WG1 = 24 * MiB, OFF_WAB = 28 * MiB;
constexpr size_t OFF_TOK = 37 * MiB + 512 * 1024;
constexpr int TOKCAP = 33792;
constexpr size_t OFF_A = 40 * MiB;
constexpr size_t OFF_Z0 = OFF_A, OFF_MIX0 = OFF_A + 297 * MiB, OFF_WE0 = OFF_A + 429 * MiB, OFF_U0 = OFF_A + 525 * MiB;
constexpr size_t OFF_AM0 = OFF_A, OFF_HM0 = OFF_A + 148 * MiB, OFF_YM0 = OFF_A + 222 * MiB;
constexpr size_t OFF_Z1 = OFF_A, OFF_U1 = OFF_A + 462 * MiB, OFF_WCD = OFF_A + 528 * MiB, OFF_MIX1 = OFF_A + 462 * MiB;
constexpr size_t OFF_WE1 = OFF_A, OFF_U1B = OFF_A + 96 * MiB, OFF_AM1 = OFF_A + 96 * MiB, OFF_HM1 = OFF_A + 244 * MiB, OFF_YM1 = OFF_A + 318 * MiB, OFF_V1 = OFF_A + 470 * MiB;
constexpr size_t WS_NEED = OFF_A + 594 * MiB;
static_assert((size_t)R * Z0W * 2 <= 297 * MiB && (size_t)R * MIXW * 2 <= 132 * MiB && (size_t)R * Z1W * 2 <= 462 * MiB && (size_t)R * D * 2 <= 66 * MiB, "ws map");
static_assert((size_t)MAX_SLOTS * D * 2 <= 148 * MiB && (size_t)MAX_SLOTS * DEXP * 2 <= 74 * MiB, "ws map moe");
static_assert(OFF_DT + (size_t)R * 32 * 4 <= OFF_HCTX && OFF_ROUTE + (size_t)R * 32 <= OFF_SLOTW && OFF_SLOTW + MAX_SLOTS * 4 <= OFF_DT, "ws map small");

struct Params { const float* in[39]; float* out; unsigned char* ws; };
enum { I_X = 0, I_C, I_CTX, I_CCTX, I_HLB, I_ADAW, I_ADAB, I_LNMG, I_LNMB, I_LNFG, I_LNFB, I_OUTW, I_RGW, I_RGB, I_REW, I_REB, I_EWG, I_EWU, I_EWD,
       I_ABW, I_RGCW, I_RGCB, I_RGAW, I_RGAB, I_RGXW, I_RGXB, I_RGLAM, I_SCW, I_SCB, I_SALOG, I_SDTB, I_SD, I_SNG, I_CDW, I_GCW, I_GALOG, I_GDTB, I_GNG, I_HNG };

__device__ __forceinline__ unsigned f2bf(float f) { unsigned u = __float_as_uint(f); return (u + 0x7fffu + ((u >> 16) & 1u)) >> 16; }
__device__ __forceinline__ float bf2f(unsigned b) { return __uint_as_float(b << 16); }
typedef __bf16 bf16x2v_t __attribute__((ext_vector_type(2)));
__device__ __forceinline__ unsigned pk2(float lo, float hi) { const f32x2 v = {lo, hi}; const bf16x2v_t r = __builtin_convertvector(v, bf16x2v_t); return __builtin_bit_cast(unsigned, r); }
__device__ __forceinline__ float bflo(unsigned w) { return __uint_as_float(w << 16); }
__device__ __forceinline__ float bfhi(unsigned w) { return __uint_as_float(w & 0xffff0000u); }
__device__ __forceinline__ float sigmoidf_(float x) { return __builtin_amdgcn_rcpf(1.f + __expf(-x)); }
__device__ __forceinline__ float siluf_(float x) { return x * __builtin_amdgcn_rcpf(1.f + __expf(-x)); }
__device__ __forceinline__ float softplusf_(float x) { const float t = __expf(-fabsf(x)); return fmaxf(x, 0.f) + (t < 1e-4f ? t - 0.5f * t * t : __logf(1.f + t)); }
__device__ __forceinline__ float geluf_(float x) { const float u = 0.7978845608028654f * (x + 0.044715f * x * x * x); return 0.5f * x * (1.f + tanhf(u)); }
template <int CTRL> __device__ __forceinline__ float dpp_mov(float v) {
  return __builtin_bit_cast(float, __builtin_amdgcn_update_dpp(0, __builtin_bit_cast(int, v), CTRL, 0xf, 0xf, true));
}
__device__ __forceinline__ float row_sum16(float v) {
  v += dpp_mov<0xB1>(v); v += dpp_mov<0x4E>(v); v += dpp_mov<0x141>(v); v += dpp_mov<0x140>(v);
  return v;
}
__device__ __forceinline__ float xrow16_sum(float x) {
  auto s = __builtin_amdgcn_permlane16_swap(__float_as_uint(x), __float_as_uint(x), false, false);
  x = __uint_as_float(s[0]) + __uint_as_float(s[1]);
  auto t = __builtin_amdgcn_permlane32_swap(__float_as_uint(x), __float_as_uint(x), false, false);
  return __uint_as_float(t[0]) + __uint_as_float(t[1]);
}
__device__ __forceinline__ float wave_sum(float v) { v = row_sum16(v); v += __shfl_xor(v, 16); v += __shfl_xor(v, 32); return v; }
__device__ __forceinline__ float half_sum32(float v) { v = row_sum16(v); v += __shfl_xor(v, 16); return v; }
__device__ __forceinline__ int rmap(int latonly, int q) { return latonly ? (q >> 13) * TB + CTXL + (q & 8191) : q; }
__device__ __forceinline__ int row_batch(int r) { return r / TB; }

namespace pg8 {
constexpr int BM = 256, BK = 64, HALF = 128, HTB = HALF * BK * 2, STAGE_BYTES = 8 * HTB, NXCD = 8, WGM = 8;
__host__ __device__ __forceinline__ int lds_byte(int r, int c) { const int st = (r >> 4) * 2 + (c >> 5), rr = r & 15, cc = c & 31, ob = rr * 64 + cc * 2; return st * 1024 + (ob ^ (((ob >> 9) & 1) << 5)); }
__host__ __device__ __forceinline__ void stage_rc(int b, int& Rr, int& C) { const int st = b / 1024, sb = b % 1024, swz = sb ^ (((sb >> 9) & 1) << 5); Rr = (st >> 1) * 16 + swz / 64; C = (st & 1) * 32 + (swz % 64) / 2; }
__host__ __device__ __forceinline__ int perm32(int rho) { const int n = rho >> 4, i = rho & 15; return 8 * (i >> 2) + 4 * n + (i & 3); }
struct Unit { int pm, pn; };
struct Gemm { const bf16_t* A; const bf16_t* Bt; int lda, K; };

struct GridOrder {
  int nM, nN, nwg, G, c, skipctx;
  __device__ void init(int nM_, int nN_, int G_, int c_, int skipctx_) { nM = nM_; nN = nN_; nwg = nM * nN; G = G_; c = c_; skipctx = skipctx_; }
  __device__ bool next(int i, Unit& u) const {
    const long L = (long)i * G + c; if (L >= nwg) return false;
    int wgid = (int)L; { const int q = nwg / NXCD, r = nwg % NXCD, xcd = wgid % NXCD, off = wgid / NXCD; wgid = (xcd < r ? xcd * (q + 1) : r * (q + 1) + (xcd - r) * q) + off; }
    const int nig = WGM * nN, gid = wgid / nig, fm = gid * WGM, gsz = (nM - fm) < WGM ? (nM - fm) : WGM;
    int pm = fm + ((wgid % nig) % gsz); u.pn = (wgid % nig) / gsz;
    if (skipctx) pm = (pm >> 5) * 33 + 1 + (pm & 31);
    u.pm = pm; return true;
  }
};
struct MoeOrder {
  const LAS int* base; const LAS int* cntL; const LAS int* blk_e; const unsigned short* tok; int nunits, G, c;
  __device__ bool next(int i, Unit& u) const {
    const long L = (long)i * G + c; if (L >= nunits) return false;
    const int blk = (int)(L >> 2), j = (int)(L & 3);
    u.pm = blk; u.pn = blk_e[blk] * 4 + j; return true;
  }
  __device__ int arow(const Unit& u, int r) const {
    const int e = blk_e[u.pm]; const int pos = (u.pm - base[e]) * 256 + r;
    return pos < cntL[e] ? (int)tok[(size_t)e * TOKCAP + pos] : 0;
  }
};

__device__ __forceinline__ unsigned cvt_pk_bf16(float lo, float hi) { return pk2(lo, hi); }
typedef _Float16 f16x2v_t __attribute__((ext_vector_type(2)));
__device__ __forceinline__ unsigned pk2h(float lo, float hi) { const f32x2 v = {lo, hi}; const f16x2v_t r = __builtin_convertvector(v, f16x2v_t); return __builtin_bit_cast(unsigned, r); }
__device__ __forceinline__ f32x2 unpk2h(unsigned w) { return __builtin_convertvector(__builtin_bit_cast(f16x2v_t, w), f32x2); }

template <class Epi, class Sched>
__device__ __forceinline__ void gemm_phase(LAS unsigned char* lds, const Gemm g, const Sched& S, const Epi& E) {
  int tid_ = threadIdx.x; asm volatile("" : "+v"(tid_)); tid_ &= 511; const int tid = tid_, wid = __builtin_amdgcn_readfirstlane(tid >> 6), lane = tid & 63, wr = wid >> 2, wc = wid & 3, fr = lane & 15, fq = lane >> 4;
  const int K = g.K, nt = K / BK, lda = g.lda;
  unsigned voffA[2], voffB[2];
#pragma unroll
  for (int i = 0; i < 2; ++i) { int Rr, C; stage_rc(tid * 16 + i * 8192, Rr, C); const int Rb = Epi::PERM ? ((Rr & ~31) + perm32(Rr & 31)) : Rr;
    voffA[i] = (unsigned)(Rr * lda + C) * 2u; voffB[i] = (unsigned)(Rb * K + C) * 2u; }
  const size_t kstep = (size_t)(BK * 2);
  const size_t hstepA = (size_t)HALF * lda * 2, hstepB = (size_t)HALF * K * 2;
  const size_t tstepA = 2 * hstepA, tstepB = 2 * hstepB;
  const unsigned ldsw = (unsigned)wid * 1024u;
  const int aoff = lds_byte(wr * 64 + fr, fq * 8), boff = lds_byte(wc * 32 + fr, fq * 8);
#define PG8_SA(b, h) (((b) * 2 + (h)) * HTB)
#define PG8_SB(b, h) ((4 + (b) * 2 + (h)) * HTB)
#define PG8_STAGE(bufoff, gbase, voff) do { _Pragma("unroll") for (int _i = 0; _i < 2; ++_i) \
    __builtin_amdgcn_global_load_lds((const unsigned*)((const char*)(gbase) + (voff)[_i]), (LAS unsigned*)(lds + (bufoff) + ldsw + _i * 8192), 16, 0, 0); } while (0)
#define PG8_LDA(dst, b, h) do { _Pragma("unroll") for (int m = 0; m < 4; ++m) _Pragma("unroll") for (int k = 0; k < 2; ++k) dst[m][k] = *(const LAS bf16x8*)(lds + PG8_SA(b, h) + aoff + m * 2048 + k * 1024); } while (0)
#define PG8_LDB(dst, b, h) do { _Pragma("unroll") for (int n = 0; n < 2; ++n) _Pragma("unroll") for (int k = 0; k < 2; ++k) dst[n][k] = *(const LAS bf16x8*)(lds + PG8_SB(b, h) + boff + n * 2048 + k * 1024); } while (0)
#define PG8_MMA(ai, bj, At, Bt) do { __builtin_amdgcn_s_setprio(1); _Pragma("unroll") for (int m = 0; m < 4; ++m) _Pragma("unroll") for (int n = 0; n < 2; ++n) _Pragma("unroll") for (int k = 0; k < 2; ++k) \
    acc[ai][bj][m][n] = __builtin_amdgcn_mfma_f32_16x16x32_bf16(Bt[n][k], At[m][k], acc[ai][bj][m][n], 0, 0, 0); __builtin_amdgcn_s_setprio(0); } while (0)
#define PG8_WAIT_V(n) asm volatile("s_waitcnt vmcnt(" #n ")" ::: "memory")
#define PG8_WAIT_L(n) asm volatile("s_waitcnt lgkmcnt(" #n ")" ::: "memory")
#define PG8_BAR __builtin_amdgcn_s_barrier()
#define PG8_SCHED __builtin_amdgcn_sched_barrier(0)
  Unit cur, nxt; int ui = 0;
  if (!S.next(0, cur)) return;
  f32x4 acc[2][2][4][2];
#pragma unroll
  for (int a = 0; a < 2; ++a)
#pragma unroll
    for (int b = 0; b < 2; ++b)
#pragma unroll
      for (int m = 0; m < 4; ++m)
#pragma unroll
        for (int n = 0; n < 2; ++n) acc[a][b][m][n] = (f32x4){0.f, 0.f, 0.f, 0.f};
  bf16x8 At[4][2], B0[2][2], B1[2][2];
  const char* cA = (const char*)g.A + (size_t)cur.pm * tstepA; const char* cB = (const char*)g.Bt + (size_t)cur.pn * tstepB;
  PG8_STAGE(PG8_SB(0, 0), cB, voffB); PG8_STAGE(PG8_SA(0, 0), cA, voffA); PG8_STAGE(PG8_SB(0, 1), cB + hstepB, voffB); PG8_STAGE(PG8_SA(0, 1), cA + hstepA, voffA);
  if (wr == 1) PG8_BAR;
  PG8_WAIT_V(4); PG8_BAR;
  PG8_STAGE(PG8_SB(1, 0), cB + kstep, voffB); PG8_STAGE(PG8_SA(1, 0), cA + kstep, voffA); PG8_STAGE(PG8_SB(1, 1), cB + hstepB + kstep, voffB);
  PG8_WAIT_V(6); PG8_BAR;
  for (;;) {
    const bool has_next = S.next(ui + 1, nxt);
    const char* nA = has_next ? (const char*)g.A + (size_t)nxt.pm * tstepA : cA; const char* nB = has_next ? (const char*)g.Bt + (size_t)nxt.pn * tstepB : cB;
    for (int t = 0; t < nt; t += 2) {
      const bool last = (t == nt - 2);
      const char* a1 = cA + (size_t)(t + 1) * kstep;
      const char* a2 = last ? nA : cA + (size_t)(t + 2) * kstep; const char* b2 = last ? nB : cB + (size_t)(t + 2) * kstep;
      const char* a3 = a2 + kstep; const char* b3 = b2 + kstep;
      PG8_LDB(B0, 0, 0); PG8_SCHED; PG8_LDA(At, 0, 0); PG8_STAGE(PG8_SA(1, 1), a1 + hstepA, voffA);
      PG8_WAIT_L(8); PG8_BAR; PG8_WAIT_L(0); PG8_MMA(0, 0, At, B0); PG8_BAR; PG8_SCHED;
      PG8_LDB(B1, 0, 1); PG8_STAGE(PG8_SB(0, 0), b2, voffB);
      PG8_BAR; PG8_WAIT_L(0); PG8_MMA(0, 1, At, B1); PG8_BAR;
      PG8_LDA(At, 0, 1); PG8_STAGE(PG8_SA(0, 0), a2, voffA);
      PG8_BAR; PG8_WAIT_L(0); PG8_MMA(1, 0, At, B0); PG8_BAR; PG8_SCHED;
      PG8_STAGE(PG8_SB(0, 1), b2 + hstepB, voffB);
      PG8_WAIT_V(6); PG8_BAR; PG8_MMA(1, 1, At, B1); PG8_BAR;
      PG8_LDB(B0, 1, 0); PG8_SCHED; PG8_LDA(At, 1, 0); PG8_STAGE(PG8_SA(0, 1), a2 + hstepA, voffA);
      PG8_WAIT_L(8); PG8_BAR; PG8_WAIT_L(0); PG8_MMA(0, 0, At, B0); PG8_BAR; PG8_SCHED;
      PG8_LDB(B1, 1, 1); PG8_STAGE(PG8_SB(1, 0), b3, voffB);
      PG8_BAR; PG8_WAIT_L(0); PG8_MMA(0, 1, At, B1); PG8_BAR;
      PG8_LDA(At, 1, 1); PG8_STAGE(PG8_SA(1, 0), a3, voffA);
      PG8_BAR; PG8_WAIT_L(0); PG8_MMA(1, 0, At, B0); PG8_BAR; PG8_SCHED;
      PG8_STAGE(PG8_SB(1, 1), b3 + hstepB, voffB);
      PG8_WAIT_V(6); PG8_BAR; PG8_MMA(1, 1, At, B1); PG8_BAR;
    }
    E(acc, cur, wr, wc, fr, fq);
    if (!has_next) break;
#pragma unroll
    for (int a = 0; a < 2; ++a)
#pragma unroll
      for (int b = 0; b < 2; ++b)
#pragma unroll
        for (int m = 0; m < 4; ++m)
#pragma unroll
          for (int n = 0; n < 2; ++n) acc[a][b][m][n] = (f32x4){0.f, 0.f, 0.f, 0.f};
    cur = nxt; cA = nA; cB = nB; ++ui;
  }
  PG8_WAIT_V(0);
  if (wr == 0) PG8_BAR;
  PG8_BAR;
#undef PG8_SA
#undef PG8_SB
#undef PG8_STAGE
#undef PG8_LDA
#undef PG8_LDB
#undef PG8_MMA
#undef PG8_WAIT_V
#undef PG8_WAIT_L
#undef PG8_BAR
#undef PG8_SCHED
}

template <class Epi, class Sched>
__device__ __forceinline__ void gemm_phase_ga(LAS unsigned char* lds, const Gemm g, const Sched& S, const Epi& E) {
  int tid_ = threadIdx.x; asm volatile("" : "+v"(tid_)); tid_ &= 511; const int tid = tid_, wid = __builtin_amdgcn_readfirstlane(tid >> 6), lane = tid & 63, wr = wid >> 2, wc = wid & 3, fr = lane & 15, fq = lane >> 4;
  const int K = g.K, nt = K / BK, lda = g.lda;
  unsigned voffB[2]; int rowA[2]; unsigned colA[2];
#pragma unroll
  for (int i = 0; i < 2; ++i) { int Rr, C; stage_rc(tid * 16 + i * 8192, Rr, C); const int Rb = Epi::PERM ? ((Rr & ~31) + perm32(Rr & 31)) : Rr;
    rowA[i] = Rr; colA[i] = (unsigned)C * 2u; voffB[i] = (unsigned)(Rb * K + C) * 2u; }
  unsigned oc[2][2], on[2][2];
  const size_t kstep = (size_t)(BK * 2);
  const size_t hstepB = (size_t)HALF * K * 2;
  const size_t tstepB = 2 * hstepB;
  const unsigned ldsw = (unsigned)wid * 1024u;
  const int aoff = lds_byte(wr * 64 + fr, fq * 8), boff = lds_byte(wc * 32 + fr, fq * 8);
#define PG8_SA(b, h) (((b) * 2 + (h)) * HTB)
#define PG8_SB(b, h) ((4 + (b) * 2 + (h)) * HTB)
#define PG8_STAGE_A(bufoff, off2, kbyte) do { _Pragma("unroll") for (int _i = 0; _i < 2; ++_i) \
    __builtin_amdgcn_global_load_lds((const unsigned*)((const char*)g.A + (size_t)(kbyte) + (off2)[_i]), (LAS unsigned*)(lds + (bufoff) + ldsw + _i * 8192), 16, 0, 0); } while (0)
#define PG8_OFFS(dst, un) do { _Pragma("unroll") for (int _h = 0; _h < 2; ++_h) _Pragma("unroll") for (int _i = 0; _i < 2; ++_i) \
    dst[_h][_i] = (unsigned)S.arow(un, _h * HALF + rowA[_i]) * (unsigned)(lda * 2) + colA[_i]; } while (0)
#define PG8_STAGE(bufoff, gbase, voff) do { _Pragma("unroll") for (int _i = 0; _i < 2; ++_i) \
    __builtin_amdgcn_global_load_lds((const unsigned*)((const char*)(gbase) + (voff)[_i]), (LAS unsigned*)(lds + (bufoff) + ldsw + _i * 8192), 16, 0, 0); } while (0)
#define PG8_LDA(dst, b, h) do { _Pragma("unroll") for (int m = 0; m < 4; ++m) _Pragma("unroll") for (int k = 0; k < 2; ++k) dst[m][k] = *(const LAS bf16x8*)(lds + PG8_SA(b, h) + aoff + m * 2048 + k * 1024); } while (0)
#define PG8_LDB(dst, b, h) do { _Pragma("unroll") for (int n = 0; n < 2; ++n) _Pragma("unroll") for (int k = 0; k < 2; ++k) dst[n][k] = *(const LAS bf16x8*)(lds + PG8_SB(b, h) + boff + n * 2048 + k * 1024); } while (0)
#define PG8_MMA(ai, bj, At, Bt) do { __builtin_amdgcn_s_setprio(1); _Pragma("unroll") for (int m = 0; m < 4; ++m) _Pragma("unroll") for (int n = 0; n < 2; ++n) _Pragma("unroll") for (int k = 0; k < 2; ++k) \
    acc[ai][bj][m][n] = __builtin_amdgcn_mfma_f32_16x16x32_bf16(Bt[n][k], At[m][k], acc[ai][bj][m][n], 0, 0, 0); __builtin_amdgcn_s_setprio(0); } while (0)
#define PG8_WAIT_V(n) asm volatile("s_waitcnt vmcnt(" #n ")" ::: "memory")
#define PG8_WAIT_L(n) asm volatile("s_waitcnt lgkmcnt(" #n ")" ::: "memory")
#define PG8_BAR __builtin_amdgcn_s_barrier()
#define PG8_SCHED __builtin_amdgcn_sched_barrier(0)
  Unit cur, nxt; int ui = 0;
  if (!S.next(0, cur)) return;
  f32x4 acc[2][2][4][2];
#pragma unroll
  for (int a = 0; a < 2; ++a)
#pragma unroll
    for (int b = 0; b < 2; ++b)
#pragma unroll
      for (int m = 0; m < 4; ++m)
#pragma unroll
        for (int n = 0; n < 2; ++n) acc[a][b][m][n] = (f32x4){0.f, 0.f, 0.f, 0.f};
  bf16x8 At[4][2], B0[2][2], B1[2][2];
  const char* cB = (const char*)g.Bt + (size_t)cur.pn * tstepB;
  PG8_OFFS(oc, cur);
  PG8_STAGE(PG8_SB(0, 0), cB, voffB); PG8_STAGE_A(PG8_SA(0, 0), oc[0], 0); PG8_STAGE(PG8_SB(0, 1), cB + hstepB, voffB); PG8_STAGE_A(PG8_SA(0, 1), oc[1], 0);
  if (wr == 1) PG8_BAR;
  PG8_WAIT_V(4); PG8_BAR;
  PG8_STAGE(PG8_SB(1, 0), cB + kstep, voffB); PG8_STAGE_A(PG8_SA(1, 0), oc[0], kstep); PG8_STAGE(PG8_SB(1, 1), cB + hstepB + kstep, voffB);
  PG8_WAIT_V(6); PG8_BAR;
  for (;;) {
    const bool has_next = S.next(ui + 1, nxt);
    const char* nB = has_next ? (const char*)g.Bt + (size_t)nxt.pn * tstepB : cB;
    if (has_next) { PG8_OFFS(on, nxt); } else {
#pragma unroll
      for (int _h = 0; _h < 2; ++_h) { on[_h][0] = oc[_h][0]; on[_h][1] = oc[_h][1]; } }
    for (int t = 0; t < nt; t += 2) {
      const bool last = (t == nt - 2);
      const size_t k1 = (size_t)(t + 1) * kstep, k2 = last ? 0 : (size_t)(t + 2) * kstep, k3 = k2 + kstep;
      const char* b2 = last ? nB : cB + (size_t)(t + 2) * kstep; const char* b3 = b2 + kstep;
      unsigned o2a[2], o2b[2];
      if (last) { asm volatile("" : "+v"(on[0][0]), "+v"(on[0][1]), "+v"(on[1][0]), "+v"(on[1][1])); o2a[0] = on[0][0]; o2a[1] = on[0][1]; o2b[0] = on[1][0]; o2b[1] = on[1][1]; }
      else { o2a[0] = oc[0][0]; o2a[1] = oc[0][1]; o2b[0] = oc[1][0]; o2b[1] = oc[1][1]; }
      PG8_LDB(B0, 0, 0); PG8_SCHED; PG8_LDA(At, 0, 0); PG8_STAGE_A(PG8_SA(1, 1), oc[1], k1);
      PG8_WAIT_L(8); PG8_BAR; PG8_WAIT_L(0); PG8_MMA(0, 0, At, B0); PG8_BAR; PG8_SCHED;
      PG8_LDB(B1, 0, 1); PG8_STAGE(PG8_SB(0, 0), b2, voffB);
      PG8_BAR; PG8_WAIT_L(0); PG8_MMA(0, 1, At, B1); PG8_BAR;
      PG8_LDA(At, 0, 1); PG8_STAGE_A(PG8_SA(0, 0), o2a, k2);
      PG8_BAR; PG8_WAIT_L(0); PG8_MMA(1, 0, At, B0); PG8_BAR; PG8_SCHED;
      PG8_STAGE(PG8_SB(0, 1), b2 + hstepB, voffB);
      PG8_WAIT_V(6); PG8_BAR; PG8_MMA(1, 1, At, B1); PG8_BAR;
      PG8_LDB(B0, 1, 0); PG8_SCHED; PG8_LDA(At, 1, 0); PG8_STAGE_A(PG8_SA(0, 1), o2b, k2);
      PG8_WAIT_L(8); PG8_BAR; PG8_WAIT_L(0); PG8_MMA(0, 0, At, B0); PG8_BAR; PG8_SCHED;
      PG8_LDB(B1, 1, 1); PG8_STAGE(PG8_SB(1, 0), b3, voffB);
      PG8_BAR; PG8_WAIT_L(0); PG8_MMA(0, 1, At, B1); PG8_BAR;
      PG8_LDA(At, 1, 1); PG8_STAGE_A(PG8_SA(1, 0), o2a, k3);
      PG8_BAR; PG8_WAIT_L(0); PG8_MMA(1, 0, At, B0); PG8_BAR; PG8_SCHED;
      PG8_STAGE(PG8_SB(1, 1), b3 + hstepB, voffB);
      PG8_WAIT_V(6); PG8_BAR; PG8_MMA(1, 1, At, B1); PG8_BAR;
    }
    E(acc, cur, wr, wc, fr, fq);
    if (!has_next) break;
#pragma unroll
    for (int a = 0; a < 2; ++a)
#pragma unroll
      for (int b = 0; b < 2; ++b)
#pragma unroll
        for (int m = 0; m < 4; ++m)
#pragma unroll
          for (int n = 0; n < 2; ++n) acc[a][b][m][n] = (f32x4){0.f, 0.f, 0.f, 0.f};
    cur = nxt; cB = nB; ++ui;
#pragma unroll
    for (int _h = 0; _h < 2; ++_h) { oc[_h][0] = on[_h][0]; oc[_h][1] = on[_h][1]; }
  }
  PG8_WAIT_V(0);
  if (wr == 0) PG8_BAR;
  PG8_BAR;
#undef PG8_SA
#undef PG8_SB
#undef PG8_STAGE
#undef PG8_STAGE_A
#undef PG8_OFFS
#undef PG8_LDA
#undef PG8_LDB
#undef PG8_MMA
#undef PG8_WAIT_V
#undef PG8_WAIT_L
#undef PG8_BAR
#undef PG8_SCHED
}

struct EpiBf16 {
  static constexpr bool PERM = true;
  bf16_t* O; int ldc;
  __device__ __forceinline__ void operator()(const f32x4 (&acc)[2][2][4][2], const Unit& u, int wr, int wc, int fr, int fq) const {
    const int row0 = u.pm * BM + wr * 64 + fr, col0 = u.pn * BM + wc * 32 + 8 * fq;
#pragma unroll
    for (int ai = 0; ai < 2; ++ai)
#pragma unroll
      for (int m = 0; m < 4; ++m) { bf16_t* rowp = O + (size_t)(row0 + ai * HALF + m * 16) * ldc + col0;
#pragma unroll
        for (int bj = 0; bj < 2; ++bj) { const f32x4 v0 = acc[ai][bj][m][0], v1 = acc[ai][bj][m][1];
          u32x4 w; w.x = cvt_pk_bf16(v0[0], v0[1]); w.y = cvt_pk_bf16(v0[2], v0[3]); w.z = cvt_pk_bf16(v1[0], v1[1]); w.w = cvt_pk_bf16(v1[2], v1[3]);
          *(u32x4*)(rowp + bj * HALF) = w; } }
  }
};
struct EpiInProj {
  static constexpr bool PERM = true;
  bf16_t* O; int ldc; int nz; float* DT; int hf0, hf1; const float* lb;
  __device__ __forceinline__ void operator()(const f32x4 (&acc)[2][2][4][2], const Unit& u, int wr, int wc, int fr, int fq) const {
    const int row0 = u.pm * BM + wr * 64 + fr;
    if (u.pn >= hf0 && u.pn < hf1) {
      const int col0 = u.pn * BM + wc * 32 + 8 * fq;
#pragma unroll
      for (int bj = 0; bj < 2; ++bj) { const float* lp = lb + ((col0 + bj * HALF) & 1023);
        const f32x4 l0 = 1.f - *(const f32x4*)lp, l1 = 1.f - *(const f32x4*)(lp + 4);
#pragma unroll
        for (int ai = 0; ai < 2; ++ai)
#pragma unroll
          for (int m = 0; m < 4; ++m) { const f32x4 v0 = acc[ai][bj][m][0], v1 = acc[ai][bj][m][1]; float k0[4], k1[4];
#pragma unroll
            for (int r = 0; r < 4; ++r) { k0[r] = l0[r] * __builtin_amdgcn_rcpf(1.f + __expf(v0[r])); k1[r] = l1[r] * __builtin_amdgcn_rcpf(1.f + __expf(v1[r])); }
            u32x4 w; w.x = pk2h(k0[0], k0[1]); w.y = pk2h(k0[2], k0[3]); w.z = pk2h(k1[0], k1[1]); w.w = pk2h(k1[2], k1[3]);
            *(u32x4*)(O + (size_t)(row0 + ai * HALF + m * 16) * ldc + col0 + bj * HALF) = w; } }
    } else if (u.pn < nz) {
      const int col0 = u.pn * BM + wc * 32 + 8 * fq;
#pragma unroll
      for (int ai = 0; ai < 2; ++ai)
#pragma unroll
        for (int m = 0; m < 4; ++m) { bf16_t* rowp = O + (size_t)(row0 + ai * HALF + m * 16) * ldc + col0;
#pragma unroll
          for (int bj = 0; bj < 2; ++bj) { const f32x4 v0 = acc[ai][bj][m][0], v1 = acc[ai][bj][m][1];
            u32x4 w; w.x = cvt_pk_bf16(v0[0], v0[1]); w.y = cvt_pk_bf16(v0[2], v0[3]); w.z = cvt_pk_bf16(v1[0], v1[1]); w.w = cvt_pk_bf16(v1[2], v1[3]);
            *(u32x4*)(rowp + bj * HALF) = w; } }
    } else if (wc == 0) {
#pragma unroll
      for (int ai = 0; ai < 2; ++ai)
#pragma unroll
        for (int m = 0; m < 4; ++m) { float* rowp = DT + (size_t)(row0 + ai * HALF + m * 16) * 32 + 8 * fq;
          *(f32x4*)rowp = acc[ai][0][m][0]; *(f32x4*)(rowp + 4) = acc[ai][0][m][1]; }
    }
  }
};
struct EpiResid {
  static constexpr bool PERM = false;
  const float* hlat; const float* hctx; float* tlat; float* tctx; const float* gate;
  __device__ __forceinline__ void operator()(const f32x4 (&acc)[2][2][4][2], const Unit& u, int wr, int wc, int fr, int fq) const {
    const int b = u.pm / 33, tt = u.pm % 33; const bool isctx = (tt == 0);
    const float* hs = isctx ? hctx + (size_t)b * CTXL * D : hlat + ((size_t)b * SEQ + (size_t)(tt - 1) * 256) * D;
    float* td = isctx ? tctx + (size_t)b * CTXL * D : tlat + ((size_t)b * SEQ + (size_t)(tt - 1) * 256) * D;
    const float* gt = gate + (size_t)(isctx ? 4 : b) * 6144;
    const int lrow0 = wr * 64 + fr, col0 = u.pn * BM + wc * 32 + 4 * fq;
#pragma unroll
    for (int bj = 0; bj < 2; ++bj)
#pragma unroll
      for (int n = 0; n < 2; ++n) { const f32x4 gvv = *(const f32x4*)(gt + col0 + bj * HALF + n * 16);
        f32x4 hv[2][4];
#pragma unroll
        for (int ai = 0; ai < 2; ++ai)
#pragma unroll
          for (int m = 0; m < 4; ++m) hv[ai][m] = *(const f32x4*)(hs + (size_t)(lrow0 + ai * HALF + m * 16) * D + col0 + bj * HALF + n * 16);
        asm volatile("" ::: "memory");
#pragma unroll
        for (int ai = 0; ai < 2; ++ai)
#pragma unroll
          for (int m = 0; m < 4; ++m) *(f32x4*)(td + (size_t)(lrow0 + ai * HALF + m * 16) * D + col0 + bj * HALF + n * 16) = hv[ai][m] * ALPHA + gvv * acc[ai][bj][m][n];
        asm volatile("" ::: "memory"); }
  }
};
struct EpiGateMul {
  static constexpr bool PERM = true;
  bf16_t* O; int ldc; LAS float* Pl; const float* gn_gdn; const float* gn_hg;
  __device__ __forceinline__ void operator()(const f32x4 (&acc)[2][2][4][2], const Unit& u, int wr, int wc, int fr_in, int fq_in) const {
    int fr = fr_in, fq = fq_in; asm volatile("" : "+v"(fr), "+v"(fq));
    const int bidx = ((fr + 16 * fq + 32) & 63) << 2;
    const int row0 = u.pm * BM + wr * 64 + fr, col0 = u.pn * BM + wc * 32 + 8 * fq;
    const float* gn = ((u.pn < 4) ? gn_gdn : gn_hg) + wc * 32 + 8 * fq;
#pragma unroll
    for (int ai = 0; ai < 2; ++ai) {
      u32x4 ov[4][2];
#pragma unroll
      for (int m = 0; m < 4; ++m)
#pragma unroll
        for (int bj = 0; bj < 2; ++bj) ov[m][bj] = *(const u32x4*)(O + (size_t)(row0 + ai * HALF + m * 16) * ldc + col0 + bj * HALF);
      asm volatile("" ::: "memory");
#pragma unroll
      for (int m = 0; m < 4; ++m)
#pragma unroll
        for (int bj = 0; bj < 2; ++bj) { const u32x4 o = ov[m][bj];
          float v = (bflo(o.x) * bflo(o.x) + bfhi(o.x) * bfhi(o.x)) + (bflo(o.y) * bflo(o.y) + bfhi(o.y) * bfhi(o.y)) + (bflo(o.z) * bflo(o.z) + bfhi(o.z) * bfhi(o.z)) + (bflo(o.w) * bflo(o.w) + bfhi(o.w) * bfhi(o.w));
          v += __builtin_bit_cast(float, __builtin_amdgcn_ds_swizzle(__builtin_bit_cast(int, v), 0x401F));
          v += __builtin_bit_cast(float, __builtin_amdgcn_ds_bpermute(bidx, __builtin_bit_cast(int, v)));
          if (fq == 0) Pl[(((ai * HALF + wr * 64 + m * 16 + fr) * 2 + bj) << 2) + wc] = v; }
      asm volatile("s_waitcnt lgkmcnt(0)" ::: "memory"); __builtin_amdgcn_s_barrier(); asm volatile("" ::: "memory");
      const f32x4 g0 = *(const f32x4*)gn, g1 = *(const f32x4*)(gn + 4);
#pragma unroll
      for (int m = 0; m < 4; ++m) { bf16_t* rowp = O + (size_t)(row0 + ai * HALF + m * 16) * ldc + col0;
#pragma unroll
        for (int bj = 0; bj < 2; ++bj) { const f32x4 v0 = acc[ai][bj][m][0], v1 = acc[ai][bj][m][1]; const u32x4 o = ov[m][bj];
          const f32x4 p4 = *(const LAS f32x4*)(Pl + (((ai * HALF + wr * 64 + m * 16 + fr) * 2 + bj) << 2));
          const float rs = rsqrtf(((p4[0] + p4[1]) + (p4[2] + p4[3])) * (1.f / 128.f) + RMS_EPS);
          u32x4 w;
          w.x = cvt_pk_bf16(bflo(o.x) * rs * g0[0] * siluf_(v0[0]), bfhi(o.x) * rs * g0[1] * siluf_(v0[1])); w.y = cvt_pk_bf16(bflo(o.y) * rs * g0[2] * siluf_(v0[2]), bfhi(o.y) * rs * g0[3] * siluf_(v0[3]));
          w.z = cvt_pk_bf16(bflo(o.z) * rs * g1[0] * siluf_(v1[0]), bfhi(o.z) * rs * g1[1] * siluf_(v1[1])); w.w = cvt_pk_bf16(bflo(o.w) * rs * g1[2] * siluf_(v1[2]), bfhi(o.w) * rs * g1[3] * siluf_(v1[3]));
          *(u32x4*)(rowp + bj * HALF) = w; } }
      asm volatile("" ::: "memory");
    }
  }
};
struct EpiSwiGLU {
  static constexpr bool PERM = true;
  bf16_t* H;
  __device__ __forceinline__ void operator()(const f32x4 (&acc)[2][2][4][2], const Unit& u, int wr, int wc, int fr, int fq) const {
    const int row0 = u.pm * BM + wr * 64 + fr, col0 = (u.pn & 3) * 128 + wc * 32 + 8 * fq;
#pragma unroll
    for (int ai = 0; ai < 2; ++ai)
#pragma unroll
      for (int m = 0; m < 4; ++m) { bf16_t* rowp = H + (size_t)(row0 + ai * HALF + m * 16) * DEXP + col0;
        const f32x4 g0 = acc[ai][0][m][0], g1 = acc[ai][0][m][1], u0 = acc[ai][1][m][0], u1 = acc[ai][1][m][1];
        u32x4 w; w.x = cvt_pk_bf16(siluf_(g0[0]) * u0[0], siluf_(g0[1]) * u0[1]); w.y = cvt_pk_bf16(siluf_(g0[2]) * u0[2], siluf_(g0[3]) * u0[3]);
        w.z = cvt_pk_bf16(siluf_(g1[0]) * u1[0], siluf_(g1[1]) * u1[1]); w.w = cvt_pk_bf16(siluf_(g1[2]) * u1[2], siluf_(g1[3]) * u1[3]);
        *(u32x4*)rowp = w; }
  }
};
struct EpiMoeDown {
  static constexpr bool PERM = true;
  bf16_t* Y;
  __device__ __forceinline__ void operator()(const f32x4 (&acc)[2][2][4][2], const Unit& u, int wr, int wc, int fr, int fq) const {
    const int row0 = u.pm * BM + wr * 64 + fr, col0 = (u.pn & 3) * BM + wc * 32 + 8 * fq;
#pragma unroll
    for (int ai = 0; ai < 2; ++ai)
#pragma unroll
      for (int m = 0; m < 4; ++m) { bf16_t* rowp = Y + (size_t)(row0 + ai * HALF + m * 16) * D + col0;
#pragma unroll
        for (int bj = 0; bj < 2; ++bj) { const f32x4 v0 = acc[ai][bj][m][0], v1 = acc[ai][bj][m][1];
          u32x4 w; w.x = cvt_pk_bf16(v0[0], v0[1]); w.y = cvt_pk_bf16(v0[2], v0[3]); w.z = cvt_pk_bf16(v1[0], v1[1]); w.w = cvt_pk_bf16(v1[2], v1[3]);
          *(u32x4*)(rowp + bj * HALF) = w; } }
  }
};
}

struct Ctx {
  LAS unsigned char* lds; int tid, lane, wave, gw, ngw, bid, nblk;
};
#define GAS __attribute__((address_space(1)))
#define WS(off, T) ((T*)(GAS T*)(P.ws + (off)))
#define GIN(i) ((const float*)(const GAS float*)P.in[i])
#define GOUT ((float*)(GAS float*)P.out)

__device__ __forceinline__ void transpose_item(const float* W, int ldw, int col0, int k0, bf16_t* dst_row0, int ldd, LAS float* scr, int lane) {
  { f32x4 v[8];
#pragma unroll
    for (int i = 0; i < 8; ++i) v[i] = *(const f32x4*)(W + (size_t)(k0 + 8 * i + (lane >> 3)) * ldw + col0 + 4 * (lane & 7));
#pragma unroll
    for (int i = 0; i < 8; ++i) { LAS float* d = scr + (8 * i + (lane >> 3)) * 33 + 4 * (lane & 7); d[0] = v[i][0]; d[1] = v[i][1]; d[2] = v[i][2]; d[3] = v[i][3]; } }
  asm volatile("s_waitcnt lgkmcnt(0)" ::: "memory");
  const int c = lane & 7;
#pragma unroll
  for (int j = 0; j < 4; ++j) { const int n = (lane >> 3) + 8 * j; const LAS float* s = scr + (8 * c) * 33 + n;
    u32x4 o; o.x = pk2(s[0 * 33], s[1 * 33]); o.y = pk2(s[2 * 33], s[3 * 33]); o.z = pk2(s[4 * 33], s[5 * 33]); o.w = pk2(s[6 * 33], s[7 * 33]);
    *(u32x4*)(dst_row0 + (size_t)n * ldd + k0 + 8 * c) = o; }
  asm volatile("s_waitcnt lgkmcnt(0)" ::: "memory");
}
__device__ __forceinline__ void transpose_mat_item(const float* W, int ldw, int col0, int K, int ncols, bf16_t* dst, int ldd, int gu, int it, LAS float* scr, int lane) {
  const int nblk = ncols / 32, kb = it / nblk, nb = it % nblk, n0 = 32 * nb;
  const int drow = gu ? (256 * (n0 >> 7) + (n0 & 127) + (gu == 2 ? 128 : 0)) : n0;
  transpose_item(W, ldw, col0 + n0, 64 * kb, dst + (size_t)drow * ldd, ldd, scr, lane);
}
__device__ __forceinline__ void convert_experts(const Params& P, int layer, bf16_t* wgu, bf16_t* wd, const Ctx& C, LAS float* scr) {
  for (int it = C.gw; it < NEXP * 768; it += C.ngw) {
    const int e = it / 768, r = it % 768;
    const size_t eoff = ((size_t)layer * NEXP + e) * (size_t)D * DEXP;
    if (r < 256) transpose_mat_item(GIN(I_EWG) + eoff, DEXP, 0, D, DEXP, wgu + (size_t)e * 1024 * D, D, 1, r, scr, C.lane);
    else if (r < 512) transpose_mat_item(GIN(I_EWU) + eoff, DEXP, 0, D, DEXP, wgu + (size_t)e * 1024 * D, D, 2, r - 256, scr, C.lane);
    else transpose_mat_item(GIN(I_EWD) + eoff, D, 0, DEXP, D, wd + (size_t)e * D * DEXP, DEXP, 0, r - 512, scr, C.lane);
  }
}

__device__ __forceinline__ void row_load(const float* row, int lane, f32x4 (&v)[4]) {
#pragma unroll
  for (int j = 0; j < 4; ++j) v[j] = *(const f32x4*)(row + 4 * lane + 256 * j);
}
__device__ __forceinline__ void row_store(float* row, int lane, const f32x4 (&v)[4]) {
#pragma unroll
  for (int j = 0; j < 4; ++j) *(f32x4*)(row + 4 * lane + 256 * j) = v[j];
}
__device__ __forceinline__ void row_store_bf16(bf16_t* row, int lane, const f32x4 (&v)[4]) {
#pragma unroll
  for (int j = 0; j < 4; ++j) { u32x2 w; w.x = pk2(v[j][0], v[j][1]); w.y = pk2(v[j][2], v[j][3]); *(u32x2*)(row + 4 * lane + 256 * j) = w; }
}
__device__ __forceinline__ void row_layernorm(f32x4 (&v)[4], const float* g, const float* b, int lane) {
  float s = 0.f;
#pragma unroll
  for (int j = 0; j < 4; ++j) s += (v[j][0] + v[j][1]) + (v[j][2] + v[j][3]);
  const float mean = wave_sum(s) * (1.f / D); float s2 = 0.f;
#pragma unroll
  for (int j = 0; j < 4; ++j) { v[j] = v[j] - mean; s2 += (v[j][0] * v[j][0] + v[j][1] * v[j][1]) + (v[j][2] * v[j][2] + v[j][3] * v[j][3]); }
  const float rstd = rsqrtf(wave_sum(s2) * (1.f / D) + LN_EPS);
#pragma unroll
  for (int j = 0; j < 4; ++j) { const f32x4 gg = *(const f32x4*)(g + 4 * lane + 256 * j), bb = *(const f32x4*)(b + 4 * lane + 256 * j); v[j] = v[j] * rstd * gg + bb; }
}
__device__ __forceinline__ void row_modulate(const f32x4 (&h)[4], const float* shift, const float* scale, int lane, f32x4 (&u)[4]) {
#pragma unroll
  for (int j = 0; j < 4; ++j) { const f32x4 sh = *(const f32x4*)(shift + 4 * lane + 256 * j), sc = *(const f32x4*)(scale + 4 * lane + 256 * j); u[j] = h[j] * (sc + 1.f) + sh; }
}
__device__ __forceinline__ void row_dot32(const f32x4 (&u)[4], const LAS float* Wt, int lane, float* out32) {
  float myv = 0.f;
#pragma unroll 4
  for (int c = 0; c < 32; ++c) {
    float s = 0.f;
#pragma unroll
    for (int j = 0; j < 4; ++j) { const f32x4 w = *(const LAS f32x4*)(Wt + c * 1024 + 4 * lane + 256 * j); s += (u[j][0] * w[0] + u[j][1] * w[1]) + (u[j][2] * w[2] + u[j][3] * w[3]); }
    s = wave_sum(s);
    if (lane == c) myv = s;
  }
  if (lane < 32) out32[lane] = myv;
}
__device__ __forceinline__ void stage_cols32(const float* W, int ldw, int col0, LAS float* Wt, int tid) {
  for (int i = tid; i < 1024 * 32; i += NT) { const int k = i >> 5, c = i & 31; Wt[c * 1024 + k] = W[(size_t)k * ldw + col0 + c]; }
}
__device__ __forceinline__ const float* lat_or_ctx(const float* lat, const float* ctxp, int r) {
  const int b = r / TB, pos = r % TB;
  return pos < CTXL ? ctxp + ((size_t)b * CTXL + pos) * D : lat + ((size_t)b * SEQ + (pos - CTXL)) * D;
}
__device__ __forceinline__ float* lat_or_ctx_w(float* lat, float* ctxp, int r) {
  const int b = r / TB, pos = r % TB;
  return pos < CTXL ? ctxp + ((size_t)b * CTXL + pos) * D : lat + ((size_t)b * SEQ + (pos - CTXL)) * D;
}
__device__ __forceinline__ int row_b5(int r) { const int b = r / TB, pos = r % TB; return pos < CTXL ? 4 : b; }

__device__ __forceinline__ void phase0(const Params& P, const Ctx& C) {
  LAS float* sv = (LAS float*)C.lds;
  LAS float* part = (LAS float*)(C.lds + 20480);
  LAS float* scr = (LAS float*)(C.lds + 32768) + C.wave * (64 * 33);
  for (int i = C.tid; i < 5 * 1024; i += NT) { const float x = i < 4096 ? GIN(I_C)[i] : GIN(I_CCTX)[i - 4096]; sv[i] = siluf_(x); }
  __syncthreads();
  float* MOD = WS(OFF_MOD, float);
  for (int task = C.bid; task < 2 * 96; task += C.nblk) {
    const int l = task / 96, n0 = (task % 96) * 64;
    const float* W = GIN(I_ADAW) + (size_t)l * D * 6144 + n0 + C.lane;
    float acc[5] = {0.f, 0.f, 0.f, 0.f, 0.f};
    const int kbeg = C.wave * 128;
#pragma unroll 8
    for (int k = kbeg; k < kbeg + 128; ++k) { const float w = W[(size_t)k * 6144];
#pragma unroll
      for (int r = 0; r < 5; ++r) acc[r] += sv[r * 1024 + k] * w; }
#pragma unroll
    for (int r = 0; r < 5; ++r) part[(C.wave * 5 + r) * 64 + C.lane] = acc[r];
    __syncthreads();
    if (C.tid < 320) { const int r = C.tid / 64, c = C.tid % 64; float s = GIN(I_ADAB)[l * 6144 + n0 + c];
#pragma unroll
      for (int w = 0; w < 8; ++w) s += part[(w * 5 + r) * 64 + c];
      MOD[((size_t)l * 5 + r) * 6144 + n0 + c] = s; }
    __syncthreads();
  }
  if (C.bid == C.nblk - 1) { float* LB = WS(OFF_LB1, float); for (int i = C.tid; i < 1024; i += NT) { const float a = GIN(I_HLB)[i], b = GIN(I_HLB)[1024 + i]; LB[i] = 1.f / (1.f + __expf(a - b)); } }
  constexpr int N_AB = 16 * 144, N_OUT = 32 * 32, N_G1 = 16 * 32;
  constexpr int TOT = N_AB + 2 * N_OUT + 2 * N_G1;
  for (int it = C.gw; it < TOT; it += C.ngw) {
    int r = it;
    if (r < N_AB) { transpose_mat_item(GIN(I_ABW), AB_IN, 0, D, Z0W, WS(OFF_WAB, bf16_t), D, 0, r, scr, C.lane); continue; } r -= N_AB;
    if (r < N_OUT) { transpose_mat_item(GIN(I_OUTW), D, 0, 2048, D, WS(OFF_WOUT0, bf16_t), 2048, 0, r, scr, C.lane); continue; } r -= N_OUT;
    if (r < N_OUT) { transpose_mat_item(GIN(I_OUTW) + (size_t)2048 * D, D, 0, 2048, D, WS(OFF_WOUT1, bf16_t), 2048, 0, r, scr, C.lane); continue; } r -= N_OUT;
    if (r < N_G1) { transpose_mat_item(GIN(I_CDW), CD_IN, 3072, D, 1024, WS(OFF_WG1, bf16_t), D, 0, r, scr, C.lane); continue; } r -= N_G1;
    transpose_mat_item(GIN(I_CDW), CD_IN, 8224, D, 1024, WS(OFF_WG1, bf16_t) + (size_t)1024 * D, D, 0, r, scr, C.lane);
  }
  for (int it = C.gw; it < 16; it += C.ngw) transpose_mat_item(GIN(I_ABW), AB_IN, 4608, D, 32, WS(OFF_WAB, bf16_t) + (size_t)4608 * D, D, 0, it, scr, C.lane);
  { u32x4* z = (u32x4*)(WS(OFF_WAB, bf16_t) + (size_t)4640 * D); const u32x4 zz = {0u, 0u, 0u, 0u};
    for (int i = C.bid * NT + C.tid; i < 224 * D * 2 / 16; i += C.nblk * NT) z[i] = zz; }
  convert_experts(P, 0, WS(OFF_WE0, bf16_t), WS(OFF_WE0 + 64 * MiB, bf16_t), C, scr);
}

__device__ __forceinline__ void phase_u0(const Params& P, const Ctx& C) {
  const float* MOD = WS(OFF_MOD, float); bf16_t* U = WS(OFF_U0, bf16_t);
  f32x4 h[4], hn[4];
  if (C.gw < R) row_load(lat_or_ctx(GIN(I_X), GIN(I_CTX), C.gw), C.lane, h);
  for (int r = C.gw; r < R; r += C.ngw) {
    if (r + C.ngw < R) row_load(lat_or_ctx(GIN(I_X), GIN(I_CTX), r + C.ngw), C.lane, hn);
    f32x4 u[4];
    const float* m = MOD + (size_t)row_b5(r) * 6144;
    row_modulate(h, m, m + D, C.lane, u);
    row_store_bf16(U + (size_t)r * D, C.lane, u);
#pragma unroll
    for (int j = 0; j < 4; ++j) h[j] = hn[j];
  }
}

__device__ __forceinline__ void phase_inproj(const Params& P, const Ctx& C, const bf16_t* U, const bf16_t* W, bf16_t* Z, int zw) {
  pg8::Gemm g{U, W, D, D}; pg8::GridOrder S; S.init(R / 256, zw / 256 + 1, C.nblk, C.bid, 0);
  pg8::EpiInProj E{Z, zw, zw / 256, WS(OFF_DT, float), zw == Z1W ? Z1_HF / 256 : 0, zw == Z1W ? Z1_HI / 256 : 0, WS(OFF_LB1, float)};
  pg8::gemm_phase(C.lds, g, S, E);
}

__device__ __forceinline__ void conv_task(bf16_t* Z, int zw, int row0, int L, int col, const float* cw, int cwld, int cch, const float* cb, int mode, float qscale, int lane, int ident = 0) {
  float w[4][2];
#pragma unroll
  for (int j = 0; j < 4; ++j) { w[j][0] = cw[j * cwld + cch + 2 * lane]; w[j][1] = cw[j * cwld + cch + 2 * lane + 1]; }
  const float b0 = cb ? cb[cch + 2 * lane] : 0.f, b1 = cb ? cb[cch + 2 * lane + 1] : 0.f;
  unsigned* base = (unsigned*)(Z + (size_t)row0 * zw + col) + lane;
  const size_t rs = (size_t)zw / 2;
  float pm2[2] = {0.f, 0.f}, pm1[2] = {0.f, 0.f};
  for (int t0 = 0; t0 < L; t0 += 32) {
    unsigned v[33];
#pragma unroll
    for (int i = 0; i < 32; ++i) v[i] = base[(size_t)(t0 + i) * rs];
    v[32] = (t0 + 32 < L) ? base[(size_t)(t0 + 32) * rs] : 0u;
    unsigned o[32];
#pragma unroll
    for (int i = 0; i < 32; ++i) {
      const float x0 = bflo(v[i]), x1 = bfhi(v[i]), n0 = bflo(v[i + 1]), n1 = bfhi(v[i + 1]);
      float y0 = w[0][0] * pm2[0] + w[1][0] * pm1[0] + w[2][0] * x0 + w[3][0] * n0 + b0;
      float y1 = w[0][1] * pm2[1] + w[1][1] * pm1[1] + w[2][1] * x1 + w[3][1] * n1 + b1;
      pm2[0] = pm1[0]; pm2[1] = pm1[1]; pm1[0] = x0; pm1[1] = x1;
      if (mode >= 1) { y0 = siluf_(y0); y1 = siluf_(y1); }
      if (mode == 2) { const float ss = wave_sum(y0 * y0 + y1 * y1); const float sc = rsqrtf(ss + RMS_EPS) * qscale; y0 *= sc; y1 *= sc; }
      o[i] = ident ? v[i] : pk2(y0, y1);
    }
#pragma unroll
    for (int i = 0; i < 32; ++i) base[(size_t)(t0 + i) * rs] = o[i];
  }
}
__device__ __forceinline__ void seg_rows(int seg, int& row0, int& L) {
  const int b = seg / 129, s = seg % 129;
  if (s == 0) { row0 = b * TB; L = CTXL; } else { row0 = b * TB + CTXL + (s - 1) * 64; L = 64; }
}
template <class F> __device__ __forceinline__ void feat_tasks(const Ctx& C, int ncg, int nextra, F&& f) {
  const int nctx = NB * ncg, nnorm = NB * 128 * ncg;
  if (C.nblk < nctx + 8) { for (int task = C.gw; task < NB * 129 * ncg; task += C.ngw) f(task / ncg, task % ncg); return; }
  auto norm = [&](int n) { const int cg = n % ncg, sg = n / ncg; f((sg >> 7) * 129 + 1 + (sg & 127), cg); };
  if (C.wave == 0 && C.bid < nctx) {
    f((C.bid / ncg) * 129, C.bid % ncg);
    for (int j = 0; j < nextra; ++j) norm(nnorm - 1 - (C.bid + nctx * j));
  } else {
    const int g = C.gw - (C.bid < nctx ? C.bid + 1 : nctx), ng = C.ngw - nctx;
    for (int n = g; n < nnorm - nctx * nextra; n += ng) norm(n);
  }
}
__device__ __forceinline__ void phase_feat0(const Params& P, const Ctx& C, int ident) {
  bf16_t* Z = WS(OFF_Z0, bf16_t);
  feat_tasks(C, 20, 2, [&](int seg, int cg) {
    int row0, L; seg_rows(seg, row0, L);
    if (cg < 8) conv_task(Z, Z0W, row0, L, Z0_RGX + cg * 128, GIN(I_RGCW), 1024, cg * 128, GIN(I_RGCB), 0, 1.f, C.lane, ident);
    else conv_task(Z, Z0W, row0, L, Z0_XBC + (cg - 8) * 128, GIN(I_SCW), 1536, (cg - 8) * 128, GIN(I_SCB), 1, 1.f, C.lane, ident);
  });
}
__device__ __forceinline__ void phase_feat1(const Params& P, const Ctx& C, int ident) {
  bf16_t* Z = WS(OFF_Z1, bf16_t);
  feat_tasks(C, 24, 3, [&](int seg, int cg) {
    int row0, L; seg_rows(seg, row0, L);
    if (cg < 16) conv_task(Z, Z1W, row0, L, cg * 128, GIN(I_GCW), 3072, cg * 128, nullptr, 2, cg < 8 ? 0.08838834764831845f : 1.f, C.lane, ident);
    else conv_task(Z, Z1W, row0, L, cg * 128, GIN(I_GCW), 3072, cg * 128, nullptr, 1, 1.f, C.lane, ident);
  });
  { const float* DT = WS(OFF_DT, float); f32x4* GV = WS(OFF_GV, f32x4);
    for (int chunk = C.ngw - 1 - C.gw; chunk < R / 32; chunk += C.ngw) {
      const int si = C.lane & 31;
#pragma unroll 2
      for (int it = 0; it < 8; ++it) {
        const int dh = 2 * it + (C.lane >> 5), d = dh >> 3; const int row = chunk * 32 + (d ? 31 - si : si);
        const float rb = DT[(size_t)row * 32 + dh], ra = DT[(size_t)row * 32 + 16 + dh];
        const float g = -__expf(GIN(I_GALOG)[dh]) * softplusf_(ra + GIN(I_GDTB)[dh]);
        float c = g;
        c += __builtin_bit_cast(float, __builtin_amdgcn_update_dpp(0, __builtin_bit_cast(int, c), 0x111, 0xf, 0xf, false));
        c += __builtin_bit_cast(float, __builtin_amdgcn_update_dpp(0, __builtin_bit_cast(int, c), 0x112, 0xf, 0xf, false));
        c += __builtin_bit_cast(float, __builtin_amdgcn_update_dpp(0, __builtin_bit_cast(int, c), 0x114, 0xf, 0xf, false));
        c += __builtin_bit_cast(float, __builtin_amdgcn_update_dpp(0, __builtin_bit_cast(int, c), 0x118, 0xf, 0xf, false));
        c += __builtin_bit_cast(float, __builtin_amdgcn_update_dpp(0, __builtin_bit_cast(int, c), 0x142, 0xa, 0xf, false));
        const float cl = __shfl(c, (C.lane & 32) | 31);
        GV[(size_t)row * 16 + dh] = (f32x4){__builtin_amdgcn_rcpf(1.f + __expf(-rb)), c, __expf(c), __expf(cl - c)};
      }
    } }
}

__device__ __forceinline__ int seq_pos(int dir, int j) { return dir == 0 ? j : (j < CTXL ? CTXL - 1 - j : TB - 1 - (j - CTXL)); }
__device__ __forceinline__ int seq_chunk(int dir, int j) { return dir == 0 ? j : (j < 4 ? 3 - j : 135 - j); }

__device__ __forceinline__ void rg_task(const Params& P, const Ctx& C, int task) {
  const int b = task >> 6, h = (task >> 3) & 7, q = task & 7;
  LAS float* Wl = (LAS float*)C.lds;
  LAS float* xc = Wl + 2 * 2 * 128 * 16;
  LAS float* SA = xc + 64 * 129;
  LAS float* SU = SA + 16 * 64;
  const bf16_t* Z = WS(OFF_Z0, bf16_t); bf16_t* MIX = WS(OFF_MIX0, bf16_t);
  __syncthreads();
  for (int i = C.tid; i < 2 * 2 * 128 * 16; i += NT) { const int j = i & 15, ii = (i >> 4) & 127, gate = (i >> 11) & 1, d = i >> 12;
    const float* W = (gate ? GIN(I_RGXW) : GIN(I_RGAW)) + ((size_t)(d * 8 + h) * 128 + ii) * 128 + q * 16 + j; Wl[i] = *W; }
  const int j = C.tid & 15, tg = C.tid >> 4;
  const int ch = h * 128 + q * 16 + j;
  const int sch = C.wave * 2;
  for (int d = 0; d < 2; ++d) {
    const float ba = GIN(I_RGAB)[d * 1024 + ch], bx = GIN(I_RGXB)[d * 1024 + ch], spl = softplusf_(-GIN(I_RGLAM)[d * 1024 + ch]);
    float hin0 = 0.f, hin1 = 0.f;
    for (int cs = 0; cs < 132; ++cs) {
      const int chunk = seq_chunk(d, cs), row0 = b * TB + chunk * 64;
      __syncthreads();
      { const int t = C.tid >> 3, sg = C.tid & 7; const u32x4* src = (const u32x4*)(Z + (size_t)(row0 + t) * Z0W + Z0_RGX + h * 128 + sg * 16);
        const u32x4 a = src[0], bb = src[1]; LAS float* dst = xc + t * 129 + sg * 16;
        dst[0] = bflo(a.x); dst[1] = bfhi(a.x); dst[2] = bflo(a.y); dst[3] = bfhi(a.y); dst[4] = bflo(a.z); dst[5] = bfhi(a.z); dst[6] = bflo(a.w); dst[7] = bfhi(a.w);
        dst[8] = bflo(bb.x); dst[9] = bfhi(bb.x); dst[10] = bflo(bb.y); dst[11] = bfhi(bb.y); dst[12] = bflo(bb.z); dst[13] = bfhi(bb.z); dst[14] = bflo(bb.w); dst[15] = bfhi(bb.w); }
      __syncthreads();
      { const LAS float* Wa = Wl + (d * 2 + 0) * 2048 + j; const LAS float* Wx = Wl + (d * 2 + 1) * 2048 + j;
        const LAS float* x0 = xc + (2 * tg) * 129; const LAS float* x1 = x0 + 129;
        float aa0 = 0.f, aa1 = 0.f, ax0 = 0.f, ax1 = 0.f;
#pragma unroll 8
        for (int i = 0; i < 128; ++i) { const float wa = Wa[i * 16], wx = Wx[i * 16], v0 = x0[i], v1 = x1[i]; aa0 += v0 * wa; aa1 += v1 * wa; ax0 += v0 * wx; ax1 += v1 * wx; }
#pragma unroll
        for (int tt = 0; tt < 2; ++tt) { const int t = 2 * tg + tt; const float pa = tt ? aa1 : aa0, px = tt ? ax1 : ax0;
          const float r = sigmoidf_(pa + ba), ig = sigmoidf_(px + bx); const float la = -8.f * r * spl; const float xv = xc[t * 129 + q * 16 + j];
          SA[j * 64 + t] = __expf(la); SU[j * 64 + t] = sqrtf(-expm1f(2.f * la)) * (ig * xv); } }
      __syncthreads();
#pragma unroll
      for (int cc = 0; cc < 2; ++cc) {
        const int lc = sch + cc; const int t = d == 0 ? C.lane : 63 - C.lane;
        float A = SA[lc * 64 + t], Bv = SU[lc * 64 + t];
#pragma unroll
        for (int off = 1; off < 64; off <<= 1) { const float Ap = __shfl_up(A, off), Bp = __shfl_up(Bv, off); if (C.lane >= off) { Bv = A * Bp + Bv; A = A * Ap; } }
        const float hin = cc ? hin1 : hin0; const float hv = Bv + A * hin;
        const float hlast = __shfl(hv, 63); if (cc) hin1 = hlast; else hin0 = hlast;
        const int gch = h * 128 + q * 16 + lc; bf16_t* o = MIX + (size_t)(row0 + t) * MIXW + gch;
        if (d == 0) *o = (bf16_t)f2bf(hv);
        else { const float hf = bf2f(*o); const float gy = bf2f(Z[(size_t)(row0 + t) * Z0W + Z0_RGY + gch]); *o = (bf16_t)f2bf((hf + hv) * geluf_(gy)); }
      }
    }
    __threadfence_block();
  }
}
__device__ __forceinline__ void ssd_task(const Params& P, const Ctx& C, int task) {
  const int b = task >> 9, hd = (task >> 5) & 15, ps = task & 31, g = hd >> 3;
  const int c = C.lane >> 5, ng = C.lane & 31;
  const bf16_t* Z = WS(OFF_Z0, bf16_t); bf16_t* MIX = WS(OFF_MIX0, bf16_t); const float* DT = WS(OFF_DT, float);
  const int colx = Z0_XBC + hd * 64 + 2 * ps + c, colB = Z0_B + g * 128 + 4 * ng, colC = Z0_C + g * 128 + 4 * ng, outc = 1024 + hd * 64 + 2 * ps + c;
  for (int d = 0; d < 2; ++d) {
    const float Aneg = -__expf(GIN(I_SALOG)[d * 16 + hd]), dtb = GIN(I_SDTB)[d * 16 + hd];
    float S0 = 0.f, S1 = 0.f, S2 = 0.f, S3 = 0.f;
    for (int j0 = 0; j0 < TB; j0 += 8) {
      u32x2 Bv[8], Cv[8]; unsigned short xv[8], yp[8]; float dtr[8];
#pragma unroll
      for (int u = 0; u < 8; ++u) { const size_t row = (size_t)b * TB + seq_pos(d, j0 + u);
        Bv[u] = *(const u32x2*)(Z + row * Z0W + colB); Cv[u] = *(const u32x2*)(Z + row * Z0W + colC); xv[u] = Z[row * Z0W + colx]; dtr[u] = DT[row * 32 + d * 16 + hd];
        yp[u] = d ? MIX[row * MIXW + outc] : (unsigned short)0; }
#pragma unroll
      for (int u = 0; u < 8; ++u) { const size_t row = (size_t)b * TB + seq_pos(d, j0 + u);
        const float dt = softplusf_(dtr[u] + dtb), a = __expf(Aneg * dt), xdt = bf2f(xv[u]) * dt;
        S0 = a * S0 + bflo(Bv[u].x) * xdt; S1 = a * S1 + bfhi(Bv[u].x) * xdt; S2 = a * S2 + bflo(Bv[u].y) * xdt; S3 = a * S3 + bfhi(Bv[u].y) * xdt;
        float y = (bflo(Cv[u].x) * S0 + bfhi(Cv[u].x) * S1) + (bflo(Cv[u].y) * S2 + bfhi(Cv[u].y) * S3);
        y = half_sum32(y);
        if (ng == 0) MIX[row * MIXW + outc] = (bf16_t)f2bf(y + bf2f(yp[u])); }
    }
    __threadfence_block();
  }
}

#define LBAR() do { asm volatile("s_waitcnt lgkmcnt(0)" ::: "memory"); __builtin_amdgcn_s_barrier(); asm volatile("" ::: "memory"); } while (0)
#define VMWAIT() asm volatile("s_waitcnt vmcnt(0)" ::: "memory")
#define VMWAIT32(step) do { if ((step) == 4 || (step) == 136) asm volatile("s_waitcnt vmcnt(0)" ::: "memory"); else asm volatile("s_waitcnt vmcnt(1)" ::: "memory"); } while (0)
typedef short s16x4 __attribute__((ext_vector_type(4)));
__device__ __forceinline__ bf16x8 frag_row(const LAS bf16_t* base, int ld, int r0, int k0, int lane) {
  return *(const LAS bf16x8*)(base + (r0 + (lane & 15)) * ld + k0 + 8 * (lane >> 4));
}
__device__ __forceinline__ bf16x8 frag_tr(const LAS bf16_t* base, int ld, int k0, int n0, int lane) {
  const int g = lane >> 4, q = (lane & 15) >> 2, p = lane & 3;
  const LAS bf16_t* a0 = base + (k0 + 8 * g + q) * ld + n0 + 4 * p;
  const s16x4 v0 = __builtin_amdgcn_ds_read_tr16_b64_v4i16((LAS s16x4*)a0);
  const s16x4 v1 = __builtin_amdgcn_ds_read_tr16_b64_v4i16((LAS s16x4*)(a0 + 4 * ld));
  bf16x8 r; r[0] = v0[0]; r[1] = v0[1]; r[2] = v0[2]; r[3] = v0[3]; r[4] = v1[0]; r[5] = v1[1]; r[6] = v1[2]; r[7] = v1[3];
  return r;
}
__device__ __forceinline__ f32x4 mma16(bf16x8 fa, bf16x8 fb, f32x4 acc) { return __builtin_amdgcn_mfma_f32_16x16x32_bf16(fa, fb, acc, 0, 0, 0); }
__device__ __forceinline__ float wave_incl_scan(float v, int lane) {
  (void)lane;
  auto shr = [](float x, auto N) { return __builtin_bit_cast(float, __builtin_amdgcn_update_dpp(0, __builtin_bit_cast(int, x), 0x110 + decltype(N)::value, 0xf, 0xf, false)); };
  v += shr(v, std::integral_constant<int, 1>{}); v += shr(v, std::integral_constant<int, 2>{}); v += shr(v, std::integral_constant<int, 4>{}); v += shr(v, std::integral_constant<int, 8>{});
  v += __builtin_bit_cast(float, __builtin_amdgcn_update_dpp(0, __builtin_bit_cast(int, v), 0x142, 0xa, 0xf, false));
  v += __builtin_bit_cast(float, __builtin_amdgcn_update_dpp(0, __builtin_bit_cast(int, v), 0x143, 0xc, 0xf, false));
  return v;
}
__device__ __forceinline__ void tri_tile(int tt, int& I, int& J) { I = tt >= 6 ? 3 : (tt >= 3 ? 2 : (tt >= 1 ? 1 : 0)); J = tt - (I * (I + 1)) / 2; }
__device__ __forceinline__ unsigned long long ld_agent_u64(const void* p) { return __hip_atomic_load((const unsigned long long*)p, __ATOMIC_RELAXED, __HIP_MEMORY_SCOPE_AGENT); }
__device__ __forceinline__ bool fwd_first(int c) { return c < 4 ? (c <= 1) : (c <= 67); }

__device__ __forceinline__ void ssd_chain_wg(const Params& P, const Ctx& C, int task) {
  const int b = task >> 5, hd = (task >> 1) & 15, ps = task & 1, g = hd >> 3;
  const int d = C.wave >> 2, w = C.wave & 3, td = C.tid & 255, lane = C.lane, fr = lane & 15, fq = lane >> 4;
  constexpr int LDN = 136, LDP = 40, LDT = 72;
  constexpr int DIRSZ = 78 * 1024;
  LAS unsigned char* L = C.lds + d * DIRSZ;
  LAS bf16_t* Cs = (LAS bf16_t*)L;
  LAS bf16_t* Bs = Cs + 64 * LDN;
  LAS bf16_t* Xd = Bs + 64 * LDN;
  LAS bf16_t* Xw = Xd + 64 * LDP;
  LAS bf16_t* Pt = Xw + 64 * LDP;
  LAS bf16_t* St = Pt + 64 * LDT;
  LAS float* dtL = (LAS float*)(St + 2 * 32 * LDN);
  LAS float* cumL = dtL + 64 + w * 64;
  const bf16_t* Z = WS(OFF_Z0, bf16_t); bf16_t* MIX = WS(OFF_MIX0, bf16_t); const float* DT = WS(OFF_DT, float);
  const float Aneg = -__expf(GIN(I_SALOG)[d * 16 + hd]), dtb = GIN(I_SDTB)[d * 16 + hd];
  const int colC = Z0_C + g * 128, colB = Z0_B + g * 128, colX = Z0_XBC + hd * 64 + ps * 32, outc = 1024 + hd * 64 + ps * 32;
  __syncthreads();
  for (int i = td; i < 64 * LDT / 2; i += 256) ((LAS unsigned*)Pt)[i] = 0u;
  for (int i = td; i < 2 * 32 * LDN / 2; i += 256) ((LAS unsigned*)St)[i] = 0u;
  f32x4 Sacc[2][2];
#pragma unroll
  for (int a = 0; a < 2; ++a)
#pragma unroll
    for (int c = 0; c < 2; ++c) Sacc[a][c] = (f32x4){0.f, 0.f, 0.f, 0.f};
  const int st_t = td >> 2, st_q = td & 3;
  u32x4 rc[4], rb[4], rx; float rdt = 0.f;
  const int cb_t = 16 * (td >> 6) + (lane >> 4), cb_p = lane & 15;
  const unsigned offC = (unsigned)(cb_t * Z0W + colC + 8 * cb_p), offB = (unsigned)(cb_t * Z0W + colB + 8 * cb_p), offX = (unsigned)(st_t * Z0W + colX + st_q * 8);
  auto issue_loads = [&](int step) {
    const int chunk = seq_chunk(d, step); const size_t crow = (size_t)b * TB + chunk * 64;
    const bf16_t* zb = Z + crow * Z0W;
#pragma unroll
    for (int i = 0; i < 4; ++i) { const bf16_t* zj = zb + (size_t)(4 * i) * Z0W; rc[i] = *(const u32x4*)(zj + offC); rb[i] = *(const u32x4*)(zj + offB); }
    rx = *(const u32x4*)(zb + offX);
    rdt = (DT + crow * 32 + d * 16 + hd)[(unsigned)(st_t * 32)];
  };
  issue_loads(0);
  for (int step = 0; step < 132; ++step) {
    const int chunk = seq_chunk(d, step); const int row0 = b * TB + chunk * 64;
    VMWAIT();
    { const int i = d ? 63 - st_t : st_t; const float dt = softplusf_(rdt + dtb);
#pragma unroll
      for (int k = 0; k < 4; ++k) { const int tk = cb_t + 4 * k, ik = d ? 63 - tk : tk;
        *(LAS u32x4*)(Cs + ik * LDN + 8 * cb_p) = rc[k]; *(LAS u32x4*)(Bs + ik * LDN + 8 * cb_p) = rb[k]; }
      u32x4 xo; xo.x = pk2(bflo(rx.x) * dt, bfhi(rx.x) * dt); xo.y = pk2(bflo(rx.y) * dt, bfhi(rx.y) * dt); xo.z = pk2(bflo(rx.z) * dt, bfhi(rx.z) * dt); xo.w = pk2(bflo(rx.w) * dt, bfhi(rx.w) * dt);
      *(LAS u32x4*)(Xd + i * LDP + st_q * 8) = xo;
      if (st_q == 0) dtL[i] = dt; }
    LBAR();
    if (step + 1 < 132) issue_loads(step + 1);
    const bool first = (d == 0) == fwd_first(chunk);
    bf16_t* op0; unsigned long long ppv[2] = {0ull, 0ull};
    { const int ii = 16 * w + fr; const int t = d ? 63 - ii : ii; op0 = MIX + (size_t)(row0 + t) * MIXW + outc + 4 * fq;
      if (!first) { ppv[0] = ld_agent_u64(op0); ppv[1] = ld_agent_u64(op0 + 16); } }
    const float cum = wave_incl_scan(Aneg * dtL[lane], lane);
    const float cum_last = __builtin_bit_cast(float, __builtin_amdgcn_readlane(__builtin_bit_cast(int, cum), 63));
    cumL[lane] = cum;
    bf16x8 fc[4], fb0[4], fb1[4], fb2[4];
    { const int I0 = w == 3 ? 3 : 3 - w;
      const LAS bf16_t* pc = Cs + (16 * I0 + fr) * LDN + 8 * fq; const LAS bf16_t* pb0 = Bs + (16 * (w == 3 ? 3 : 0) + fr) * LDN + 8 * fq;
      const LAS bf16_t* pb1 = Bs + (16 * (w == 3 ? 0 : 1) + fr) * LDN + 8 * fq; const LAS bf16_t* pb2 = (w == 3 ? Cs : Bs + 32 * LDN) + fr * LDN + 8 * fq;
#pragma unroll
      for (int k = 0; k < 4; ++k) { fc[k] = *(const LAS bf16x8*)(pc + 32 * k); fb0[k] = *(const LAS bf16x8*)(pb0 + 32 * k); fb1[k] = *(const LAS bf16x8*)(pb1 + 32 * k); }
      if (w != 2) {
#pragma unroll
        for (int k = 0; k < 4; ++k) fb2[k] = *(const LAS bf16x8*)(pb2 + 32 * k); }
      else {
#pragma unroll
        for (int k = 0; k < 4; ++k) fb2[k] = fb1[k]; } }
    { const int i = td >> 2; const float sc = __expf(cum_last - cumL[i]);
      const u32x4 v = *(const LAS u32x4*)(Xd + i * LDP + (td & 3) * 8);
      u32x4 o; o.x = pk2(bflo(v.x) * sc, bfhi(v.x) * sc); o.y = pk2(bflo(v.y) * sc, bfhi(v.y) * sc); o.z = pk2(bflo(v.z) * sc, bfhi(v.z) * sc); o.w = pk2(bflo(v.w) * sc, bfhi(v.w) * sc);
      *(LAS u32x4*)(Xw + i * LDP + (td & 3) * 8) = o; }
    { f32x4 a0 = (f32x4){0.f, 0.f, 0.f, 0.f}, a1 = a0, a2 = a0;
      if (w < 3) {
#pragma unroll
        for (int k = 0; k < 4; ++k) { a0 = mma16(fc[k], fb0[k], a0); a1 = mma16(fc[k], fb1[k], a1); a2 = mma16(fc[k], fb2[k], a2); } }
      else {
#pragma unroll
        for (int k = 0; k < 4; ++k) { a0 = mma16(fc[k], fb0[k], a0); a1 = mma16(fb2[k], fb1[k], a1); } }
      auto epi = [&](const f32x4& acc, int I, int J) {
        const int jj = 16 * J + fr, i0 = 16 * I + 4 * fq; const float cj = cumL[jj]; const f32x4 c4 = *(const LAS f32x4*)(cumL + i0);
        float pv[4];
#pragma unroll
        for (int r = 0; r < 4; ++r) pv[r] = (jj <= i0 + r) ? acc[r] * __expf(c4[r] - cj) : 0.f;
        u32x2 o; o.x = pk2(pv[0], pv[1]); o.y = pk2(pv[2], pv[3]);
        *(LAS u32x2*)(Pt + jj * LDT + i0) = o; };
      if (w < 3) { epi(a0, 3 - w, 0); epi(a1, 3 - w, 1); if (w < 2) epi(a2, 3 - w, 2); }
      else { epi(a0, 3, 3); epi(a1, 0, 0); } }
    LBAR();
    const LAS bf16_t* Sr = St + (step & 1) * 32 * LDN; LAS bf16_t* Sw = St + ((step + 1) & 1) * 32 * LDN;
    { const int I = w; const bool k2 = I >= 2;
      const int ii = 16 * I + fr; const float eci = __expf(cumL[ii]); const float el = __expf(cum_last);
      bf16x8 fpt[2], fxd[2][2], fsr[2][4], fcs[4], fbs[2][2], fxw[2][2];
      fpt[0] = frag_tr(Pt, LDT, 0, 16 * I, lane); fxd[0][0] = frag_tr(Xd, LDP, 0, 0, lane); fxd[0][1] = frag_tr(Xd, LDP, 0, 16, lane);
      if (k2) { fpt[1] = frag_tr(Pt, LDT, 32, 16 * I, lane); fxd[1][0] = frag_tr(Xd, LDP, 32, 0, lane); fxd[1][1] = frag_tr(Xd, LDP, 32, 16, lane); }
      else { fpt[1] = fpt[0]; fxd[1][0] = fxd[0][0]; fxd[1][1] = fxd[0][1]; }
#pragma unroll
      for (int k = 0; k < 4; ++k) { fcs[k] = frag_row(Cs, LDN, 16 * I, 32 * k, lane); fsr[0][k] = frag_row(Sr, LDN, 0, 32 * k, lane); fsr[1][k] = frag_row(Sr, LDN, 16, 32 * k, lane); }
#pragma unroll
      for (int k = 0; k < 2; ++k) { fbs[k][0] = frag_tr(Bs, LDN, 32 * k, 16 * (2 * w), lane); fbs[k][1] = frag_tr(Bs, LDN, 32 * k, 16 * (2 * w + 1), lane);
        fxw[k][0] = frag_tr(Xw, LDP, 32 * k, 0, lane); fxw[k][1] = frag_tr(Xw, LDP, 32 * k, 16, lane); }
      f32x4 y1[2], y2[2];
#pragma unroll
      for (int pt = 0; pt < 2; ++pt) { y1[pt] = mma16(fxd[0][pt], fpt[0], (f32x4){0.f, 0.f, 0.f, 0.f}); y2[pt] = (f32x4){0.f, 0.f, 0.f, 0.f}; }
      if (k2) {
#pragma unroll
        for (int pt = 0; pt < 2; ++pt) y1[pt] = mma16(fxd[1][pt], fpt[1], y1[pt]); }
#pragma unroll
      for (int k = 0; k < 4; ++k)
#pragma unroll
        for (int pt = 0; pt < 2; ++pt) y2[pt] = mma16(fsr[pt][k], fcs[k], y2[pt]);
      f32x4 sa[2][2];
#pragma unroll
      for (int a = 0; a < 2; ++a)
#pragma unroll
        for (int c = 0; c < 2; ++c) sa[a][c] = Sacc[a][c] * el;
#pragma unroll
      for (int k = 0; k < 2; ++k)
#pragma unroll
        for (int a = 0; a < 2; ++a)
#pragma unroll
          for (int c = 0; c < 2; ++c) sa[a][c] = mma16(fbs[k][a], fxw[k][c], sa[a][c]);
#pragma unroll
      for (int pt = 0; pt < 2; ++pt) {
        bf16_t* op = op0 + 16 * pt;
        float o0 = y1[pt][0] + eci * y2[pt][0], o1 = y1[pt][1] + eci * y2[pt][1], o2 = y1[pt][2] + eci * y2[pt][2], o3 = y1[pt][3] + eci * y2[pt][3];
        if (!first) { const unsigned long long pv = ppv[pt]; const unsigned lo = (unsigned)pv, hi = (unsigned)(pv >> 32); o0 += bflo(lo); o1 += bfhi(lo); o2 += bflo(hi); o3 += bfhi(hi); }
        u32x2 o; o.x = pk2(o0, o1); o.y = pk2(o2, o3); *(u32x2*)op = o; }
#pragma unroll
      for (int a = 0; a < 2; ++a)
#pragma unroll
        for (int c = 0; c < 2; ++c) { Sacc[a][c] = sa[a][c];
          u32x2 o; o.x = pk2(sa[a][c][0], sa[a][c][1]); o.y = pk2(sa[a][c][2], sa[a][c][3]);
          *(LAS u32x2*)(Sw + (16 * c + fr) * LDN + 16 * (2 * w + a) + 4 * fq) = o; } }
    LBAR();
  }
}

template <int N> __device__ __forceinline__ float dpp_shr(float oldv, float v) {
  return __builtin_bit_cast(float, __builtin_amdgcn_update_dpp(__builtin_bit_cast(int, oldv), __builtin_bit_cast(int, v), 0x110 + N, 0xf, 0xf, false));
}
__device__ __forceinline__ float fast_sigmoid(float x) { return __builtin_amdgcn_rcpf(1.f + __expf(-x)); }
__device__ __forceinline__ void rg_chain_wg(const Params& P, const Ctx& C, int task) {
  const int b = task >> 5, h = (task >> 2) & 7, q = task & 3;
  const int d = C.wave >> 2, w = C.wave & 3, td = C.tid & 255, lane = C.lane, fr = lane & 15, fq = lane >> 4;
  constexpr int LDN = 136, LDW = 72;
  constexpr int DIRSZ = 40 * 1024;
  LAS unsigned char* L = C.lds + d * DIRSZ;
  LAS bf16_t* Xc = (LAS bf16_t*)L;
  LAS bf16_t* Wl = Xc + 64 * LDN;
  LAS float* Sum = (LAS float*)(Wl + 128 * LDW);
  const bf16_t* Z = WS(OFF_Z0, bf16_t); bf16_t* MIX = WS(OFF_MIX0, bf16_t);
  const int ch0 = h * 128 + q * 32;
  __syncthreads();
#pragma unroll 2
  for (int i = td; i < 128 * 64; i += 256) { const int ii = i >> 6, j = i & 63, gate = j >> 5, jj = j & 31;
    const float* W = (gate ? GIN(I_RGXW) : GIN(I_RGAW)) + ((size_t)(d * 8 + h) * 128 + ii) * 128 + q * 32 + jj; Wl[ii * LDW + j] = (bf16_t)f2bf(*W); }
  float ba[8], bx[8], spl[8], hc[8];
#pragma unroll
  for (int e = 0; e < 8; ++e) { const int c = ch0 + 16 * (e >> 2) + 4 * fq + (e & 3);
    ba[e] = GIN(I_RGAB)[d * 1024 + c]; bx[e] = GIN(I_RGXB)[d * 1024 + c]; spl[e] = -8.f * softplusf_(-GIN(I_RGLAM)[d * 1024 + c]); hc[e] = 0.f; }
  const int st_t = td >> 2, st_p = td & 3;
  u32x4 rx[4];
  const int cb_t = 16 * (td >> 6) + (lane >> 4), cb_p = lane & 15;
  const unsigned offX = (unsigned)(cb_t * Z0W + Z0_RGX + h * 128 + 8 * cb_p);
  auto issue_loads = [&](int step) {
    const int chunk = seq_chunk(d, step); const bf16_t* zb = Z + ((size_t)b * TB + chunk * 64) * Z0W;
#pragma unroll
    for (int i = 0; i < 4; ++i) rx[i] = *(const u32x4*)(zb + (size_t)(4 * i) * Z0W + offX);
  };
  issue_loads(0);
  __syncthreads();
  const int ii = 16 * w + fr;
  const LAS bf16_t* xrow = Xc + ii * LDN + q * 32 + 4 * fq;
  for (int step = 0; step < 132; ++step) {
    const int chunk = seq_chunk(d, step); const int row0 = b * TB + chunk * 64;
    VMWAIT();
    {
#pragma unroll
      for (int k = 0; k < 4; ++k) { const int tk = cb_t + 4 * k, ik = d ? 63 - tk : tk; *(LAS u32x4*)(Xc + ik * LDN + 8 * cb_p) = rx[k]; } }
    LBAR();
    if (step + 1 < 132) issue_loads(step + 1);
    const bool first = (d == 0) == fwd_first(chunk);
    const int t = d ? 63 - ii : ii;
    bf16_t* op = MIX + (size_t)(row0 + t) * MIXW + ch0 + 4 * fq;
    unsigned long long ppv[2] = {0ull, 0ull}; u32x2 gy[2] = {(u32x2){0u, 0u}, (u32x2){0u, 0u}};
    if (!first) { ppv[0] = ld_agent_u64(op); ppv[1] = ld_agent_u64(op + 16);
      const bf16_t* gp = Z + (size_t)(row0 + t) * Z0W + Z0_RGY + ch0 + 4 * fq; gy[0] = *(const u32x2*)gp; gy[1] = *(const u32x2*)(gp + 16); }
    f32x4 ga[2], gx[2];
#pragma unroll
    for (int jt = 0; jt < 2; ++jt) { ga[jt] = (f32x4){0.f, 0.f, 0.f, 0.f}; gx[jt] = (f32x4){0.f, 0.f, 0.f, 0.f}; }
#pragma unroll
    for (int k = 0; k < 4; ++k) { const bf16x8 fb = frag_row(Xc, LDN, 16 * w, 32 * k, lane);
#pragma unroll
      for (int jt = 0; jt < 2; ++jt) { ga[jt] = mma16(frag_tr(Wl, LDW, 32 * k, 16 * jt, lane), fb, ga[jt]); gx[jt] = mma16(frag_tr(Wl, LDW, 32 * k, 32 + 16 * jt, lane), fb, gx[jt]); } }
    float A[8], Bv[8];
#pragma unroll
    for (int jt = 0; jt < 2; ++jt) { const u32x2 xw = *(const LAS u32x2*)(xrow + 16 * jt); const float xv[4] = {bflo(xw.x), bfhi(xw.x), bflo(xw.y), bfhi(xw.y)};
#pragma unroll
      for (int r = 0; r < 4; ++r) { const int e = 4 * jt + r;
        const float rg = fast_sigmoid(ga[jt][r] + ba[e]), ig = fast_sigmoid(gx[jt][r] + bx[e]); const float la = rg * spl[e];
        const float a = __expf(la); A[e] = a; Bv[e] = sqrtf(fmaxf(1.f - a * a, 0.f)) * (ig * xv[r]); } }
#pragma unroll
    for (int e = 0; e < 8; ++e) {
      { const float Ap = dpp_shr<1>(1.f, A[e]), Bp = dpp_shr<1>(0.f, Bv[e]); Bv[e] = A[e] * Bp + Bv[e]; A[e] = A[e] * Ap; }
      { const float Ap = dpp_shr<2>(1.f, A[e]), Bp = dpp_shr<2>(0.f, Bv[e]); Bv[e] = A[e] * Bp + Bv[e]; A[e] = A[e] * Ap; }
      { const float Ap = dpp_shr<4>(1.f, A[e]), Bp = dpp_shr<4>(0.f, Bv[e]); Bv[e] = A[e] * Bp + Bv[e]; A[e] = A[e] * Ap; }
      { const float Ap = dpp_shr<8>(1.f, A[e]), Bp = dpp_shr<8>(0.f, Bv[e]); Bv[e] = A[e] * Bp + Bv[e]; A[e] = A[e] * Ap; } }
    if (fr == 15) {
#pragma unroll
      for (int e = 0; e < 8; ++e) { f32x2 sv; sv[0] = A[e]; sv[1] = Bv[e]; *(LAS f32x2*)(Sum + ((w * 32) + 16 * (e >> 2) + 4 * fq + (e & 3)) * 2) = sv; } }
    LBAR();
    float hin[8];
#pragma unroll
    for (int e = 0; e < 8; ++e) { float hh = hc[e]; const int c = 16 * (e >> 2) + 4 * fq + (e & 3);
#pragma unroll
      for (int tt = 0; tt < 4; ++tt) { const f32x2 sv = *(const LAS f32x2*)(Sum + (tt * 32 + c) * 2); if (tt == w) hin[e] = hh; hh = sv[0] * hh + sv[1]; }
      hc[e] = hh; }
#pragma unroll
    for (int jt = 0; jt < 2; ++jt) { float hv[4];
#pragma unroll
      for (int r = 0; r < 4; ++r) hv[r] = Bv[4 * jt + r] + A[4 * jt + r] * hin[4 * jt + r];
      if (!first) { const unsigned lo = (unsigned)ppv[jt], hi = (unsigned)(ppv[jt] >> 32);
        const float gyv[4] = {bflo(gy[jt].x), bfhi(gy[jt].x), bflo(gy[jt].y), bfhi(gy[jt].y)}; const float pf[4] = {bflo(lo), bfhi(lo), bflo(hi), bfhi(hi)};
#pragma unroll
        for (int r = 0; r < 4; ++r) { const float x = gyv[r]; const float u2 = 1.5957691216057308f * (x + 0.044715f * x * x * x); hv[r] = (hv[r] + pf[r]) * x * fast_sigmoid(u2); } }
      u32x2 o; o.x = pg8::cvt_pk_bf16(hv[0], hv[1]); o.y = pg8::cvt_pk_bf16(hv[2], hv[3]); *(u32x2*)(op + 16 * jt) = o; }
  }
}
__device__ __forceinline__ void phase_chain0(const Params& P, const Ctx& C, int mode) {
  auto ssd_slot = [](int t) { return ((t & 7) << 4) | (t >> 3); };
  auto sib = [](int t) { return ((t & 31) << 2) | (t >> 5); };
  if (mode != 2) for (int task = C.bid; task < 128; task += C.nblk) ssd_chain_wg(P, C, ssd_slot(task));
  __builtin_amdgcn_sched_barrier(0);
  if (mode != 1) for (int task = C.bid < 128 ? C.bid + C.nblk : C.bid; task < 256; task += C.nblk) rg_chain_wg(P, C, sib(task - 128));
}
__device__ __forceinline__ void phase_ssdfin(const Params& P, const Ctx& C, int ident) {
  const bf16_t* Z = WS(OFF_Z0, bf16_t); bf16_t* MIX = WS(OFF_MIX0, bf16_t);
  for (int r = C.gw; r < R; r += C.ngw) {
    f32x4 y[4];
#pragma unroll
    for (int j = 0; j < 4; ++j) { const int e = 4 * C.lane + 256 * j; const float dsk = GIN(I_SD)[e >> 6];
      const u32x2 ys = *(const u32x2*)(MIX + (size_t)r * MIXW + 1024 + e), xs = *(const u32x2*)(Z + (size_t)r * Z0W + Z0_XBC + e), zz = *(const u32x2*)(Z + (size_t)r * Z0W + Z0_SSDZ + e);
      y[j][0] = (bflo(ys.x) + dsk * bflo(xs.x)) * siluf_(bflo(zz.x)); y[j][1] = (bfhi(ys.x) + dsk * bfhi(xs.x)) * siluf_(bfhi(zz.x));
      y[j][2] = (bflo(ys.y) + dsk * bflo(xs.y)) * siluf_(bflo(zz.y)); y[j][3] = (bfhi(ys.y) + dsk * bfhi(xs.y)) * siluf_(bfhi(zz.y)); }
    float s0 = 0.f, s1 = 0.f;
#pragma unroll
    for (int i = 0; i < 4; ++i) { s0 += y[0][i] * y[0][i] + y[1][i] * y[1][i]; s1 += y[2][i] * y[2][i] + y[3][i] * y[3][i]; }
    const float r0 = rsqrtf(wave_sum(s0) * (1.f / 512.f) + RMS_EPS), r1 = rsqrtf(wave_sum(s1) * (1.f / 512.f) + RMS_EPS);
#pragma unroll
    for (int j = 0; j < 4; ++j) { const int e = 4 * C.lane + 256 * j; const f32x4 gn = *(const f32x4*)(GIN(I_SNG) + e); const float rr = j < 2 ? r0 : r1;
      u32x2 w; w.x = pk2(y[j][0] * rr * gn[0], y[j][1] * rr * gn[1]); w.y = pk2(y[j][2] * rr * gn[2], y[j][3] * rr * gn[3]);
      if (ident) w = *(const u32x2*)(MIX + (size_t)r * MIXW + 1024 + e);
      *(u32x2*)(MIX + (size_t)r * MIXW + 1024 + e) = w; }
  }
}

constexpr int CTXHOIST_MINGRID = 64, CTXHOIST_WGS = 16;
constexpr size_t OFF_CTXBAR = OFF_CTL + 8192;
struct OneUnit { int pm, pn; __device__ __forceinline__ bool next(int i, pg8::Unit& u) const { if (i != 0) return false; u.pm = pm; u.pn = pn; return true; } };
__device__ __forceinline__ void phase_outproj(const Params& P, const Ctx& C, int layer) {
  const float* MOD = WS(OFF_MOD, float) + (size_t)layer * 5 * 6144;
  pg8::Gemm g{layer ? WS(OFF_MIX1, bf16_t) : WS(OFF_MIX0, bf16_t), layer ? WS(OFF_WOUT1, bf16_t) : WS(OFF_WOUT0, bf16_t), MIXW, MIXW};
  pg8::GridOrder S; if (layer || C.nblk >= CTXHOIST_MINGRID) S.init(128, 4, C.nblk, C.bid, 1); else S.init(132, 4, C.nblk, C.bid, 0);
  pg8::EpiResid E{layer ? GOUT : GIN(I_X), layer ? WS(OFF_HCTX, float) : GIN(I_CTX), GOUT, WS(OFF_TCTX, float), MOD + 2 * D};
  pg8::gemm_phase(C.lds, g, S, E);
}

__device__ __forceinline__ void phase_lnmix(const Params& P, const Ctx& C, int layer, int ident) {
  const bool split0 = (layer == 0) && (C.nblk >= CTXHOIST_MINGRID), ctxwg = split0 && (C.bid < CTXHOIST_WGS);
  if (ctxwg) {
    const float* MODo = WS(OFF_MOD, float);
    pg8::Gemm g{WS(OFF_MIX0, bf16_t), WS(OFF_WOUT0, bf16_t), MIXW, MIXW};
    OneUnit S{33 * (C.bid >> 2), C.bid & 3};
    pg8::EpiResid E{GIN(I_X), GIN(I_CTX), GOUT, WS(OFF_TCTX, float), MODo + 2 * D};
    pg8::gemm_phase(C.lds, g, S, E);
    asm volatile("s_waitcnt vmcnt(0)" ::: "memory");
    __syncthreads();
    if (C.tid == 0) {
      unsigned* cb = WS(OFF_CTXBAR, unsigned);
      __builtin_amdgcn_fence(__ATOMIC_RELEASE, "agent");
      asm volatile("s_waitcnt vmcnt(0)" ::: "memory");
      (void)__hip_atomic_fetch_add(cb, 1u, __ATOMIC_RELAXED, __HIP_MEMORY_SCOPE_AGENT);
      unsigned sp = 0;
      while (__hip_atomic_load(cb, __ATOMIC_RELAXED, __HIP_MEMORY_SCOPE_AGENT) < (unsigned)CTXHOIST_WGS) { __builtin_amdgcn_s_sleep(2); if (++sp > (1u << 24)) break; }
      __builtin_amdgcn_fence(__ATOMIC_ACQUIRE, "agent");
      asm volatile("s_waitcnt vmcnt(0)" ::: "memory");
    }
    __syncthreads();
  }
  int gw0 = C.gw, ngw0 = C.ngw, nrows0 = layer ? RLAT : R;
  if (split0) { if (ctxwg) { ngw0 = CTXHOIST_WGS * NWAVES; nrows0 = NB * CTXL; } else { gw0 = C.gw - CTXHOIST_WGS * NWAVES; ngw0 = C.ngw - CTXHOIST_WGS * NWAVES; nrows0 = RLAT; } }
  auto rowof = [&](int q) { return split0 ? (ctxwg ? (q >> 8) * TB + (q & 255) : rmap(1, q)) : rmap(layer, q); };
  LAS float* Wt = (LAS float*)C.lds;
  { const float* gw = GIN(I_RGW) + (size_t)layer * D * 4; const float* ew = GIN(I_REW) + (size_t)layer * D * 32;
    for (int i = C.tid; i < 1024 * 4; i += NT) { const int k = i >> 2, c = i & 3; Wt[c * 1024 + k] = gw[i]; }
    for (int i = C.tid; i < 1024 * 32; i += NT) { const int k = i >> 5, c = i & 31; Wt[(4 + c) * 1024 + k] = ew[i]; } }
  __syncthreads();
  const float* MOD = WS(OFF_MOD, float) + (size_t)layer * 5 * 6144;
  const float* lng = GIN(I_LNMG) + layer * D; const float* lnb = GIN(I_LNMB) + layer * D;
  const float* rgb = GIN(I_RGB) + layer * 4; const float* reb = GIN(I_REB) + layer * 32;
  bf16_t* V = layer ? WS(OFF_V1, bf16_t) : WS(OFF_U0, bf16_t);
  int* cnt = WS(OFF_CTL, int) + layer * 32; int* route = WS(OFF_ROUTE, int); unsigned short* tok = WS(OFF_TOK, unsigned short);
  LAS int* lcnt = (LAS int*)(C.lds + 36 * 1024 * 4);
  if (C.tid < NEXP) lcnt[C.tid] = 0;
  __syncthreads();
  f32x4 wgr[4][4];
#pragma unroll
  for (int c = 0; c < 4; ++c)
#pragma unroll
    for (int j = 0; j < 4; ++j) wgr[c][j] = *(const LAS f32x4*)(Wt + c * 1024 + 4 * C.lane + 256 * j);
  f32x4 h[4], hn[4];
  if (gw0 < nrows0) row_load(lat_or_ctx_w(GOUT, WS(OFF_TCTX, float), rowof(gw0)), C.lane, h);
  for (int q = gw0; q < nrows0; q += ngw0) {
    const int r = rowof(q);
    if (q + ngw0 < nrows0) row_load(lat_or_ctx_w(GOUT, WS(OFF_TCTX, float), rowof(q + ngw0)), C.lane, hn);
    float* hrow = lat_or_ctx_w(GOUT, WS(OFF_HCTX, float), r);
    f32x4 v[4];
    if (!ident) row_layernorm(h, lng, lnb, C.lane);
    row_store(hrow, C.lane, h);
    const float* m = MOD + (size_t)row_b5(r) * 6144;
    row_modulate(h, m + 3 * D, m + 4 * D, C.lane, v);
    row_store_bf16(V + (size_t)r * D, C.lane, v);
    float lg[4];
#pragma unroll
    for (int c = 0; c < 4; ++c) { float s = 0.f;
#pragma unroll
      for (int j = 0; j < 4; ++j) { const f32x4 w = wgr[c][j]; s += (v[j][0] * w[0] + v[j][1] * w[1]) + (v[j][2] * w[2] + v[j][3] * w[3]); }
      lg[c] = wave_sum(s) + rgb[c]; }
    int gsel = 0; float gmax = lg[0];
#pragma unroll
    for (int i = 1; i < 4; ++i) if (lg[i] > gmax) { gmax = lg[i]; gsel = i; }
    gsel = __builtin_amdgcn_readfirstlane(gsel);
    float gden = 0.f;
#pragma unroll
    for (int i = 0; i < 4; ++i) gden += __expf(lg[i] - gmax);
    const float ptg = 1.f / gden;
    float le[8];
    { const LAS float* We = Wt + (4 + gsel * 8) * 1024 + 4 * C.lane;
#pragma unroll
      for (int c = 0; c < 8; ++c) { float s = 0.f;
#pragma unroll
        for (int j = 0; j < 4; ++j) { const f32x4 w = *(const LAS f32x4*)(We + c * 1024 + 256 * j); s += (v[j][0] * w[0] + v[j][1] * w[1]) + (v[j][2] * w[2] + v[j][3] * w[3]); }
        le[c] = wave_sum(s) + reb[gsel * 8 + c]; } }
    int e1 = 0; float m1 = le[0];
#pragma unroll
    for (int i = 1; i < 8; ++i) if (le[i] > m1) { m1 = le[i]; e1 = i; }
    int e2 = -1; float m2 = -3.0e38f;
#pragma unroll
    for (int i = 0; i < 8; ++i) if (i != e1 && le[i] > m2) { m2 = le[i]; e2 = i; }
    const float q2 = __expf(m2 - m1); const float w1 = ptg / (1.f + q2), w2 = ptg * q2 / (1.f + q2);
    if (C.lane == 0) {
      const int E1 = gsel * 8 + e1, E2 = gsel * 8 + e2;
      const int p1 = __hip_atomic_fetch_add(lcnt + E1, 1, __ATOMIC_RELAXED, __HIP_MEMORY_SCOPE_WORKGROUP), p2 = __hip_atomic_fetch_add(lcnt + E2, 1, __ATOMIC_RELAXED, __HIP_MEMORY_SCOPE_WORKGROUP);
      int* rr = route + (size_t)r * 8; if (!ident) { rr[0] = E1; rr[1] = E2; ((float*)rr)[2] = w1; ((float*)rr)[3] = w2; rr[4] = p1; rr[5] = p2; }
    }
#pragma unroll
    for (int j = 0; j < 4; ++j) h[j] = hn[j];
  }
  __syncthreads();
  if (ident) return;
  if (C.tid < NEXP) lcnt[C.tid] = atomicAdd(cnt + C.tid, lcnt[C.tid]);
  __syncthreads();
  for (int k = C.tid >> 3; ; k += NT / 8) { const int q = (gw0 - C.wave + (C.tid & 7)) + k * ngw0; if (q >= nrows0) break;
    const int r = rowof(q); int* rr = route + (size_t)r * 8; const int E1 = rr[0], E2 = rr[1]; const int p1 = rr[4] + lcnt[E1], p2 = rr[5] + lcnt[E2];
    rr[4] = p1; rr[5] = p2; tok[(size_t)E1 * TOKCAP + p1] = (unsigned short)r; tok[(size_t)E2 * TOKCAP + p2] = (unsigned short)r; }
}

__device__ __forceinline__ void phase_dispatch(const Params& P, const Ctx& C, int layer) {
  LAS int* base = (LAS int*)C.lds;
  int* ctl = WS(OFF_CTL, int); const int* cnt = ctl + layer * 32;
  if (C.tid == 0) { int acc = 0; for (int e = 0; e < NEXP; ++e) { base[e] = acc; acc += (cnt[e] + 255) >> 8; } base[32] = acc; }
  __syncthreads();
  if (C.bid == 0) { if (C.tid == 0) ctl[64 + layer] = base[32];
    if (C.tid < NEXP) { for (int bk = base[C.tid]; bk < base[C.tid + 1]; ++bk) ctl[128 + layer * MAX_BLKS + bk] = C.tid; } }
  const bf16_t* V = layer ? WS(OFF_V1, bf16_t) : WS(OFF_U0, bf16_t);
  bf16_t* AM = layer ? WS(OFF_AM1, bf16_t) : WS(OFF_AM0, bf16_t);
  float* slotw = WS(OFF_SLOTW, float); int* route = WS(OFF_ROUTE, int);
  for (int r = C.gw; r < R; r += C.ngw) {
    const int pos = r % TB; if (layer && pos < CTXL) continue;
    int* rr = route + (size_t)r * 8;
    const int E1 = rr[0], E2 = rr[1]; const int s1 = base[E1] * 256 + rr[4], s2 = base[E2] * 256 + rr[5];
    const u32x4* src = (const u32x4*)(V + (size_t)r * D);
    const u32x4 a = src[C.lane], b = src[64 + C.lane];
    u32x4* d1 = (u32x4*)(AM + (size_t)s1 * D); u32x4* d2 = (u32x4*)(AM + (size_t)s2 * D);
    d1[C.lane] = a; d1[64 + C.lane] = b; d2[C.lane] = a; d2[64 + C.lane] = b;
    if (C.lane == 0) { rr[6] = s1; rr[7] = s2; slotw[s1] = ((const float*)rr)[2]; slotw[s2] = ((const float*)rr)[3]; }
  }
}
__device__ __forceinline__ int moe_tables(const Params& P, const Ctx& C, int layer, LAS int* tb) {
  const int* cnt = WS(OFF_CTL, int) + layer * 32;
  __syncthreads();
  if (C.tid == 0) { int acc = 0; for (int e = 0; e < NEXP; ++e) { const int c = cnt[e]; tb[e] = acc; tb[40 + e] = c; acc += (c + 255) >> 8; } tb[32] = acc; }
  __syncthreads();
  if (C.tid < NEXP) { for (int bk = tb[C.tid]; bk < tb[C.tid + 1]; ++bk) tb[80 + bk] = C.tid; }
  __syncthreads();
  return tb[32];
}
__device__ __forceinline__ void phase_moe1(const Params& P, const Ctx& C, int layer) {
  LAS int* tb = (LAS int*)(C.lds + 131072);
  const int nblk = moe_tables(P, C, layer, tb);
  pg8::Gemm g{layer ? WS(OFF_V1, bf16_t) : WS(OFF_U0, bf16_t), layer ? WS(OFF_WE1, bf16_t) : WS(OFF_WE0, bf16_t), D, D};
  pg8::MoeOrder S{tb, tb + 40, tb + 80, WS(OFF_TOK, unsigned short), nblk * 4, C.nblk, C.bid};
  pg8::EpiSwiGLU E{layer ? WS(OFF_HM1, bf16_t) : WS(OFF_HM0, bf16_t)};
  pg8::gemm_phase_ga(C.lds, g, S, E);
}
__device__ __forceinline__ void phase_moe2(const Params& P, const Ctx& C, int layer) {
  LAS int* tb = (LAS int*)(C.lds + 131072);
  const int nblk = moe_tables(P, C, layer, tb);
  pg8::Gemm g{layer ? WS(OFF_HM1, bf16_t) : WS(OFF_HM0, bf16_t), layer ? WS(OFF_WE1 + 64 * MiB, bf16_t) : WS(OFF_WE0 + 64 * MiB, bf16_t), DEXP, DEXP};
  pg8::MoeOrder S{tb, tb + 40, tb + 80, WS(OFF_TOK, unsigned short), nblk * 4, C.nblk, C.bid};
  pg8::EpiMoeDown E{layer ? WS(OFF_YM1, bf16_t) : WS(OFF_YM0, bf16_t)};
  pg8::gemm_phase(C.lds, g, S, E);
}

__device__ __forceinline__ void phase_lnffn(const Params& P, const Ctx& C, int layer, int ident) {
  const float* MOD = WS(OFF_MOD, float) + (size_t)layer * 5 * 6144;
  const float* lng = GIN(I_LNFG) + layer * D; const float* lnb = GIN(I_LNFB) + layer * D;
  const bf16_t* YM = layer ? WS(OFF_YM1, bf16_t) : WS(OFF_YM0, bf16_t); const int* route = WS(OFF_ROUTE, int);
  LAS int* tb = (LAS int*)(C.lds + 131072);
  (void)moe_tables(P, C, layer, tb);
  const int nrows = layer ? RLAT : R;
  f32x4 h[4], hn[4]; u32x2 ya[4], yb[4], yan[4], ybn[4]; int s1n = 0, s2n = 0; float w1c = 0.f, w2c = 0.f, w1n = 0.f, w2n = 0.f, w1nn = 0.f, w2nn = 0.f;
  auto ldrow = [&](int q, f32x4 (&hh)[4], u32x2 (&a)[4], u32x2 (&bq)[4], int sa, int sb) {
    const int r = rmap(layer, q); row_load(lat_or_ctx_w(GOUT, WS(OFF_HCTX, float), r), C.lane, hh);
#pragma unroll
    for (int j = 0; j < 4; ++j) { a[j] = *(const u32x2*)(YM + (size_t)sa * D + 4 * C.lane + 256 * j); bq[j] = *(const u32x2*)(YM + (size_t)sb * D + 4 * C.lane + 256 * j); } };
  if (C.gw < nrows) { const int* rr = route + (size_t)rmap(layer, C.gw) * 8; ldrow(C.gw, h, ya, yb, tb[rr[0]] * 256 + rr[4], tb[rr[1]] * 256 + rr[5]); w1c = ((const float*)rr)[2]; w2c = ((const float*)rr)[3]; }
  if (C.gw + C.ngw < nrows) { const int* rr = route + (size_t)rmap(layer, C.gw + C.ngw) * 8; s1n = tb[rr[0]] * 256 + rr[4]; s2n = tb[rr[1]] * 256 + rr[5]; w1n = ((const float*)rr)[2]; w2n = ((const float*)rr)[3]; }
  for (int q = C.gw; q < nrows; q += C.ngw) {
    const int r = rmap(layer, q);
    if (q + C.ngw < nrows) ldrow(q + C.ngw, hn, yan, ybn, s1n, s2n);
    if (q + 2 * C.ngw < nrows) { const int* rr = route + (size_t)rmap(layer, q + 2 * C.ngw) * 8; s1n = tb[rr[0]] * 256 + rr[4]; s2n = tb[rr[1]] * 256 + rr[5]; w1nn = ((const float*)rr)[2]; w2nn = ((const float*)rr)[3]; }
    float* hrow = lat_or_ctx_w(GOUT, WS(OFF_HCTX, float), r);
    const float* m = MOD + (size_t)row_b5(r) * 6144;
#pragma unroll
    for (int j = 0; j < 4; ++j) { const u32x2 a = ya[j], b = yb[j];
      const f32x4 g5 = *(const f32x4*)(m + 5 * D + 4 * C.lane + 256 * j);
      f32x4 f; f[0] = w1c * bflo(a.x) + w2c * bflo(b.x); f[1] = w1c * bfhi(a.x) + w2c * bfhi(b.x); f[2] = w1c * bflo(a.y) + w2c * bflo(b.y); f[3] = w1c * bfhi(a.y) + w2c * bfhi(b.y);
      if (!ident) h[j] = h[j] * ALPHA + g5 * f; else h[j] = h[j] + f * 0.f; }
    if (!ident) row_layernorm(h, lng, lnb, C.lane);
    row_store(hrow, C.lane, h);
    if (layer == 0) {
      const float* m1 = WS(OFF_MOD, float) + (size_t)(5 + row_b5(r)) * 6144;
      f32x4 u[4]; row_modulate(h, m1, m1 + D, C.lane, u);
      row_store_bf16(WS(OFF_U1, bf16_t) + (size_t)r * D, C.lane, u);
    }
#pragma unroll
    for (int j = 0; j < 4; ++j) { h[j] = hn[j]; ya[j] = yan[j]; yb[j] = ybn[j]; }
    w1c = w1n; w2c = w2n; w1n = w1nn; w2n = w2nn;
  }
  if (layer == 0) {
    __syncthreads();
    LAS float* scr = (LAS float*)C.lds + C.wave * (64 * 33);
    constexpr int N_A = 16 * 96, N_B = 16 * 128;
    for (int it = C.gw; it < N_A + N_B + 16; it += C.ngw) {
      if (it < N_A) transpose_mat_item(GIN(I_CDW), CD_IN, 0, D, 3072, WS(OFF_WCD, bf16_t), D, 0, it, scr, C.lane);
      else if (it < N_A + N_B) transpose_mat_item(GIN(I_CDW), CD_IN, 4128, D, 4096, WS(OFF_WCD, bf16_t) + (size_t)3072 * D, D, 0, it - N_A, scr, C.lane);
      else transpose_mat_item(GIN(I_CDW), CD_IN, 4096, D, 32, WS(OFF_WCD, bf16_t) + (size_t)7168 * D, D, 0, it - N_A - N_B, scr, C.lane);
    }
    { u32x4* z = (u32x4*)(WS(OFF_WCD, bf16_t) + (size_t)7200 * D); const u32x4 zz = {0u, 0u, 0u, 0u};
      for (int i = C.bid * NT + C.tid; i < 224 * D * 2 / 16; i += C.nblk * NT) z[i] = zz; }
  }
}

__device__ __forceinline__ void gdn_task(const Params& P, const Ctx& C, int task) {
  const int b = task >> 9, h = (task >> 6) & 7, vs = task & 63; const int c = C.lane >> 5, kg = C.lane & 31;
  const bf16_t* Z = WS(OFF_Z1, bf16_t); bf16_t* MIX = WS(OFF_MIX1, bf16_t); const float* DT = WS(OFF_DT, float);
  const int colq = Z1_Q + h * 128 + 4 * kg, colk = Z1_K + h * 128 + 4 * kg, colv = Z1_V + h * 128 + 2 * vs + c, outc = h * 128 + 2 * vs + c;
  for (int d = 0; d < 2; ++d) {
    const float Aneg = -__expf(GIN(I_GALOG)[d * 8 + h]), dtb = GIN(I_GDTB)[d * 8 + h];
    float S0 = 0.f, S1 = 0.f, S2 = 0.f, S3 = 0.f;
    for (int j0 = 0; j0 < TB; j0 += 8) {
      u32x2 qv[8], kv[8]; unsigned short vv[8], yp[8]; float br[8], ar[8];
#pragma unroll
      for (int u = 0; u < 8; ++u) { const size_t row = (size_t)b * TB + seq_pos(d, j0 + u);
        qv[u] = *(const u32x2*)(Z + row * Z1W + colq); kv[u] = *(const u32x2*)(Z + row * Z1W + colk); vv[u] = Z[row * Z1W + colv];
        br[u] = DT[row * 32 + d * 8 + h]; ar[u] = DT[row * 32 + 16 + d * 8 + h]; yp[u] = d ? MIX[row * MIXW + outc] : (unsigned short)0; }
#pragma unroll
      for (int u = 0; u < 8; ++u) { const size_t row = (size_t)b * TB + seq_pos(d, j0 + u);
        const float al = __expf(Aneg * softplusf_(ar[u] + dtb)), be = sigmoidf_(br[u]);
        const float k0 = bflo(kv[u].x), k1 = bfhi(kv[u].x), k2 = bflo(kv[u].y), k3 = bfhi(kv[u].y);
        S0 *= al; S1 *= al; S2 *= al; S3 *= al;
        const float p = half_sum32((k0 * S0 + k1 * S1) + (k2 * S2 + k3 * S3));
        const float dl = be * (bf2f(vv[u]) - p);
        S0 += k0 * dl; S1 += k1 * dl; S2 += k2 * dl; S3 += k3 * dl;
        const float o = half_sum32((bflo(qv[u].x) * S0 + bfhi(qv[u].x) * S1) + (bflo(qv[u].y) * S2 + bfhi(qv[u].y) * S3));
        if (kg == 0) MIX[row * MIXW + outc] = (bf16_t)f2bf(o + bf2f(yp[u])); }
    }
    __threadfence_block();
  }
}
__device__ __forceinline__ void hgrn_task(const Params& P, const Ctx& C, int task) {
  const int b = task >> 9, h = (task >> 6) & 7, vs = task & 63; const int c = C.lane >> 5, kg = C.lane & 31;
  const bf16_t* Z = WS(OFF_Z1, bf16_t); bf16_t* MIX = WS(OFF_MIX1, bf16_t);
  const f32x4 lb = *(const f32x4*)(WS(OFF_LB1, float) + h * 128 + 4 * kg);
  const int colq = Z1_HQ + h * 128 + 4 * kg, colv = Z1_HI + h * 128 + 2 * vs + c, outc = 1024 + h * 128 + 2 * vs + c;
  for (int d = 0; d < 2; ++d) {
    const int colf = Z1_HF + d * 1024 + h * 128 + 4 * kg;
    float S0 = 0.f, S1 = 0.f, S2 = 0.f, S3 = 0.f;
    for (int j0 = 0; j0 < TB; j0 += 8) {
      u32x2 qv[8], fv[8]; unsigned short vv[8], yp[8];
#pragma unroll
      for (int u = 0; u < 8; ++u) { const size_t row = (size_t)b * TB + seq_pos(d, j0 + u);
        qv[u] = *(const u32x2*)(Z + row * Z1W + colq); fv[u] = *(const u32x2*)(Z + row * Z1W + colf); vv[u] = Z[row * Z1W + colv];
        yp[u] = d ? MIX[row * MIXW + outc] : (unsigned short)0; }
#pragma unroll
      for (int u = 0; u < 8; ++u) { const size_t row = (size_t)b * TB + seq_pos(d, j0 + u);
        const float f0 = lb[0] + (1.f - lb[0]) * sigmoidf_(bflo(fv[u].x)), f1 = lb[1] + (1.f - lb[1]) * sigmoidf_(bfhi(fv[u].x));
        const float f2 = lb[2] + (1.f - lb[2]) * sigmoidf_(bflo(fv[u].y)), f3 = lb[3] + (1.f - lb[3]) * sigmoidf_(bfhi(fv[u].y));
        const float v = bf2f(vv[u]);
        S0 = f0 * S0 + (1.f - f0) * v; S1 = f1 * S1 + (1.f - f1) * v; S2 = f2 * S2 + (1.f - f2) * v; S3 = f3 * S3 + (1.f - f3) * v;
        const float o = half_sum32((bflo(qv[u].x) * S0 + bfhi(qv[u].x) * S1) + (bflo(qv[u].y) * S2 + bfhi(qv[u].y) * S3));
        if (kg == 0) MIX[row * MIXW + outc] = (bf16_t)f2bf(o + bf2f(yp[u])); }
    }
    __threadfence_block();
  }
}

__device__ __forceinline__ int seq_chunk32(int dir, int j) { return dir == 0 ? j : (j < 8 ? 7 - j : 271 - j); }
__device__ __forceinline__ bool fwd_first32(int c) { return c < 8 ? (c <= 3) : (c <= 135); }

__device__ __forceinline__ void hgrn_chain_wg(const Params& P, const Ctx& C, int task) {
  const int b = task >> 5, h = (task >> 2) & 7, vs = task & 3;
  const int d = C.wave >> 2, w = C.wave & 3, td = C.tid & 255, lane = C.lane, fr = lane & 15, fq = lane >> 4;
  constexpr int LDN = 136, LDP = 40;
  constexpr int DIRSZ = 72 * 1024;
  LAS unsigned char* L = C.lds + d * DIRSZ;
  LAS bf16_t* Qt = (LAS bf16_t*)L;
  LAS bf16_t* Kh = Qt + 32 * LDN;
  LAS bf16_t* Kw = Kh + 32 * LDN;
  LAS bf16_t* Vs = Kw + 32 * LDN;
  LAS bf16_t* Pt = Vs + 32 * LDP;
  LAS bf16_t* St = Pt + 32 * LDP;
  LAS float* CUM = (LAS float*)(St + 2 * 32 * LDN);
  const bf16_t* Z = WS(OFF_Z1, bf16_t); bf16_t* MIX = WS(OFF_MIX1, bf16_t);
  const int colq = Z1_HQ + h * 128, colf = Z1_HF + d * 1024 + h * 128, colv = Z1_HI + h * 128 + vs * 32, outc = 1024 + h * 128 + vs * 32;
  __syncthreads();
  for (int i = td; i < 32 * LDP / 2; i += 256) ((LAS unsigned*)Pt)[i] = 0u;
  for (int i = td; i < 2 * 32 * LDN / 2; i += 256) ((LAS unsigned*)St)[i] = 0u;
  f32x4 Sacc[2][2];
#pragma unroll
  for (int a = 0; a < 2; ++a)
#pragma unroll
    for (int c = 0; c < 2; ++c) Sacc[a][c] = (f32x4){0.f, 0.f, 0.f, 0.f};
  const int st_t = td >> 3, st_s = td & 7;
  float lbv[16];
#pragma unroll
  for (int e = 0; e < 16; ++e) lbv[e] = WS(OFF_LB1, float)[h * 128 + st_s * 16 + e];
  u32x4 rq[2], rf[2]; u32x2 rv;
  auto issue_loads = [&](int step) {
    const int chunk = seq_chunk32(d, step); const size_t row = (size_t)b * TB + chunk * 32 + st_t;
    const u32x4* pq = (const u32x4*)(Z + row * Z1W + colq + st_s * 16); const u32x4* pf = (const u32x4*)(Z + row * Z1W + colf + st_s * 16);
    rq[0] = pq[0]; rq[1] = pq[1]; rf[0] = pf[0]; rf[1] = pf[1];
    rv = *(const u32x2*)(Z + row * Z1W + colv + st_s * 4);
  };
  issue_loads(0);
  for (int step = 0; step < 264; ++step) {
    const int chunk = seq_chunk32(d, step); const int row0 = b * TB + chunk * 32;
    const int si = d ? 31 - st_t : st_t;
    VMWAIT();
    float qv[16], kk[16];
    { const unsigned qw[8] = {rq[0].x, rq[0].y, rq[0].z, rq[0].w, rq[1].x, rq[1].y, rq[1].z, rq[1].w};
      const unsigned fw[8] = {rf[0].x, rf[0].y, rf[0].z, rf[0].w, rf[1].x, rf[1].y, rf[1].z, rf[1].w};
      f32x4 lf4[4];
#pragma unroll
      for (int e = 0; e < 8; ++e) { qv[2 * e] = bflo(qw[e]); qv[2 * e + 1] = bfhi(qw[e]);
        const float f0 = lbv[2 * e] + (1.f - lbv[2 * e]) * sigmoidf_(bflo(fw[e])), f1 = lbv[2 * e + 1] + (1.f - lbv[2 * e + 1]) * sigmoidf_(bfhi(fw[e]));
        kk[2 * e] = 1.f - f0; kk[2 * e + 1] = 1.f - f1; lf4[e >> 1][(2 * e) & 3] = __logf(f0); lf4[e >> 1][(2 * e + 1) & 3] = __logf(f1); }
#pragma unroll
      for (int e = 0; e < 4; ++e) *(LAS f32x4*)(CUM + si * 128 + st_s * 16 + 4 * e) = lf4[e];
      *(LAS u32x2*)(Vs + si * LDP + st_s * 4) = rv; }
    LBAR();
    if (step + 1 < 264) issue_loads(step + 1);
    const int vt = w & 1, it = w >> 1;
    const bool first = (d == 0) == fwd_first32(chunk);
    bf16_t* op; unsigned long long ppv = 0ull;
    { const int ii = 16 * it + fr; const int t = d ? 31 - ii : ii; op = MIX + (size_t)(row0 + t) * MIXW + outc + 16 * vt + 4 * fq; if (!first) ppv = ld_agent_u64(op); }
    if (td < 128) { float c = 0.f;
#pragma unroll 8
      for (int i = 0; i < 32; ++i) { c += CUM[i * 128 + td]; CUM[i * 128 + td] = c; } }
    LBAR();
    { unsigned oq[8], oh[8], ow[8];
#pragma unroll
      for (int e = 0; e < 8; ++e) { const int k0 = st_s * 16 + 2 * e;
        const float c0 = CUM[si * 128 + k0], c1 = CUM[si * 128 + k0 + 1], l0 = CUM[31 * 128 + k0], l1 = CUM[31 * 128 + k0 + 1];
        oq[e] = pk2(qv[2 * e] * __expf(c0), qv[2 * e + 1] * __expf(c1));
        oh[e] = pk2(kk[2 * e] * __expf(fminf(-c0, 80.f)), kk[2 * e + 1] * __expf(fminf(-c1, 80.f)));
        ow[e] = pk2(kk[2 * e] * __expf(l0 - c0), kk[2 * e + 1] * __expf(l1 - c1)); }
      LAS u32x4* dq = (LAS u32x4*)(Qt + si * LDN + st_s * 16); LAS u32x4* dh = (LAS u32x4*)(Kh + si * LDN + st_s * 16); LAS u32x4* dw = (LAS u32x4*)(Kw + si * LDN + st_s * 16);
      dq[0] = (u32x4){oq[0], oq[1], oq[2], oq[3]}; dq[1] = (u32x4){oq[4], oq[5], oq[6], oq[7]};
      dh[0] = (u32x4){oh[0], oh[1], oh[2], oh[3]}; dh[1] = (u32x4){oh[4], oh[5], oh[6], oh[7]};
      dw[0] = (u32x4){ow[0], ow[1], ow[2], ow[3]}; dw[1] = (u32x4){ow[4], ow[5], ow[6], ow[7]}; }
    LBAR();
    if (w < 3) { const int I = w >= 1 ? 1 : 0, J = w == 2 ? 1 : 0;
      f32x4 acc = (f32x4){0.f, 0.f, 0.f, 0.f};
#pragma unroll
      for (int k = 0; k < 4; ++k) acc = mma16(frag_row(Qt, LDN, 16 * I, 32 * k, lane), frag_row(Kh, LDN, 16 * J, 32 * k, lane), acc);
      const int jj = 16 * J + fr; float pv[4];
#pragma unroll
      for (int r = 0; r < 4; ++r) { const int ii = 16 * I + 4 * fq + r; pv[r] = (jj <= ii) ? acc[r] : 0.f; }
      u32x2 o; o.x = pk2(pv[0], pv[1]); o.y = pk2(pv[2], pv[3]);
      *(LAS u32x2*)(Pt + jj * LDP + 16 * I + 4 * fq) = o; }
    const LAS bf16_t* Sr = St + (step & 1) * 32 * LDN; LAS bf16_t* Sw = St + ((step + 1) & 1) * 32 * LDN;
    f32x4 o2 = (f32x4){0.f, 0.f, 0.f, 0.f};
#pragma unroll
    for (int k = 0; k < 4; ++k) o2 = mma16(frag_row(Sr, LDN, 16 * vt, 32 * k, lane), frag_row(Qt, LDN, 16 * it, 32 * k, lane), o2);
#pragma unroll
    for (int a = 0; a < 2; ++a) { const int kt = 2 * w + a; const f32x4 cl = *(const LAS f32x4*)(CUM + 31 * 128 + 16 * kt + 4 * fq);
      f32x4 dec; dec[0] = __expf(cl[0]); dec[1] = __expf(cl[1]); dec[2] = __expf(cl[2]); dec[3] = __expf(cl[3]);
#pragma unroll
      for (int c = 0; c < 2; ++c) { f32x4 acc = Sacc[a][c] * dec;
        acc = mma16(frag_tr(Kw, LDN, 0, 16 * kt, lane), frag_tr(Vs, LDP, 0, 16 * c, lane), acc);
        Sacc[a][c] = acc;
        u32x2 o; o.x = pk2(acc[0], acc[1]); o.y = pk2(acc[2], acc[3]);
        *(LAS u32x2*)(Sw + (16 * c + fr) * LDN + 16 * kt + 4 * fq) = o; } }
    LBAR();
    { f32x4 o1 = mma16(frag_tr(Vs, LDP, 0, 16 * vt, lane), frag_tr(Pt, LDP, 0, 16 * it, lane), (f32x4){0.f, 0.f, 0.f, 0.f});
      float o0 = o1[0] + o2[0], o1v = o1[1] + o2[1], o2v = o1[2] + o2[2], o3 = o1[3] + o2[3];
      if (!first) { const unsigned long long pv = ppv; const unsigned lo = (unsigned)pv, hi = (unsigned)(pv >> 32); o0 += bflo(lo); o1v += bfhi(lo); o2v += bflo(hi); o3 += bfhi(hi); }
      u32x2 o; o.x = pk2(o0, o1v); o.y = pk2(o2v, o3); *(u32x2*)op = o; }
    LBAR();
  }
}

__device__ __forceinline__ void gdn_chain_wg(const Params& P, const Ctx& C, int task) {
  const int b = task >> 5, h = (task >> 2) & 7, vs = task & 3;
  const int d = C.wave >> 2, w = C.wave & 3, td = C.tid & 255, lane = C.lane, fr = lane & 15, fq = lane >> 4;
  constexpr int LDN = 136, LDP = 40, LDT = 24;
  constexpr int DIRSZ = 72 * 1024;
  LAS unsigned char* L = C.lds + d * DIRSZ;
  LAS bf16_t* Qs = (LAS bf16_t*)L;
  LAS bf16_t* Ks = Qs + 32 * LDN;
  LAS bf16_t* Vs = Ks + 32 * LDN;
  LAS bf16_t* Mt = Vs + 32 * LDP;
  LAS bf16_t* At = Mt + 32 * LDP;
  LAS bf16_t* Tt = At + 32 * LDP;
  LAS bf16_t* Xt = Tt + 2 * 32 * LDT;
  LAS bf16_t* Rt = Xt + 160 * LDP;
  LAS bf16_t* Vn = Rt + 4 * 16 * LDP;
  LAS bf16_t* Vw = Vn + 32 * LDP;
  LAS bf16_t* St = Vw + 32 * LDP;
  LAS float* Md = (LAS float*)(St + 2 * 32 * LDN);
  LAS float* gL = Md + 2 * 256;
  LAS float* bL = gL + 32;
  const bf16_t* Z = WS(OFF_Z1, bf16_t); bf16_t* MIX = WS(OFF_MIX1, bf16_t); const float* DT = WS(OFF_DT, float);
  const float Aneg = -__expf(GIN(I_GALOG)[d * 8 + h]), dtb = GIN(I_GDTB)[d * 8 + h];
  const int colq = Z1_Q + h * 128, colk = Z1_K + h * 128, colv = Z1_V + h * 128 + vs * 32, outc = h * 128 + vs * 32;
  __syncthreads();
  for (int i = td; i < 71 * 1024 / 4; i += 256) ((LAS unsigned*)L)[i] = 0u;
  f32x4 Sacc[2][2];
#pragma unroll
  for (int a = 0; a < 2; ++a)
#pragma unroll
    for (int c = 0; c < 2; ++c) Sacc[a][c] = (f32x4){0.f, 0.f, 0.f, 0.f};
  const int st_t = td >> 3, st_s = td & 7;
  u32x4 rq[2], rk[2]; u32x2 rv; float ra = 0.f, rb = 0.f;
  auto issue_loads = [&](int step) {
    const int chunk = seq_chunk32(d, step); const size_t row = (size_t)b * TB + chunk * 32 + st_t;
    const u32x4* pq = (const u32x4*)(Z + row * Z1W + colq + st_s * 16); const u32x4* pk = (const u32x4*)(Z + row * Z1W + colk + st_s * 16);
    rq[0] = pq[0]; rq[1] = pq[1]; rk[0] = pk[0]; rk[1] = pk[1];
    rv = *(const u32x2*)(Z + row * Z1W + colv + st_s * 4);
    if (st_s == 0) { rb = DT[row * 32 + d * 8 + h]; ra = DT[row * 32 + 16 + d * 8 + h]; }
  };
  issue_loads(0);
  __syncthreads();
  LAS bf16_t* Rw = Rt + w * 16 * LDP;
  for (int step = 0; step < 264; ++step) {
    const int chunk = seq_chunk32(d, step); const int row0 = b * TB + chunk * 32;
    VMWAIT();
    { const int si = d ? 31 - st_t : st_t;
      LAS u32x4* dq = (LAS u32x4*)(Qs + si * LDN + st_s * 16); LAS u32x4* dk = (LAS u32x4*)(Ks + si * LDN + st_s * 16);
      dq[0] = rq[0]; dq[1] = rq[1]; dk[0] = rk[0]; dk[1] = rk[1];
      *(LAS u32x2*)(Vs + si * LDP + st_s * 4) = rv;
      if (st_s == 0) { gL[si] = Aneg * softplusf_(ra + dtb); bL[si] = sigmoidf_(rb); } }
    LBAR();
    if (step + 1 < 264) issue_loads(step + 1);
    const bool first = (d == 0) == fwd_first32(chunk);
    bf16_t* op; unsigned long long ppv = 0ull;
    { const int ii = 16 * (w >> 1) + fr; const int t = d ? 31 - ii : ii; op = MIX + (size_t)(row0 + t) * MIXW + outc + 16 * (w & 1) + 4 * fq; if (!first) ppv = ld_agent_u64(op); }
    const float cum = wave_incl_scan(lane < 32 ? gL[lane] : 0.f, lane);
    const float cum_last = __shfl(cum, 31);
    const LAS bf16_t* Sr = St + (step & 1) * 32 * LDN; LAS bf16_t* Sw = St + ((step + 1) & 1) * 32 * LDN;
    const int vt = w & 1, it = w >> 1;
    for (int job = w; job < 6; job += 4) {
      const int isq = job >= 3, tj = job - 3 * isq; const int I = tj >= 1 ? 1 : 0, J = tj == 2 ? 1 : 0;
      const LAS bf16_t* A = isq ? Qs : Ks;
      f32x4 acc = (f32x4){0.f, 0.f, 0.f, 0.f};
#pragma unroll
      for (int k = 0; k < 4; ++k) acc = mma16(frag_row(A, LDN, 16 * I, 32 * k, lane), frag_row(Ks, LDN, 16 * J, 32 * k, lane), acc);
      const int jj = 16 * J + fr; const float cj = __shfl(cum, jj); float pv[4];
#pragma unroll
      for (int r = 0; r < 4; ++r) { const int ii = 16 * I + 4 * fq + r; const float ci = __shfl(cum, ii); const float dec = __expf(ci - cj);
        if (isq) pv[r] = (jj <= ii) ? acc[r] * dec : 0.f;
        else { pv[r] = (jj < ii) ? acc[r] * dec * bL[ii] : 0.f; if (I == J) Md[I * 256 + (4 * fq + r) * 16 + fr] = pv[r]; } }
      u32x2 o; o.x = pk2(pv[0], pv[1]); o.y = pk2(pv[2], pv[3]);
      *(LAS u32x2*)((isq ? At : Mt) + jj * LDP + 16 * I + 4 * fq) = o;
    }
    f32x4 o2 = (f32x4){0.f, 0.f, 0.f, 0.f};
#pragma unroll
    for (int k = 0; k < 4; ++k) o2 = mma16(frag_row(Sr, LDN, 16 * vt, 32 * k, lane), frag_row(Qs, LDN, 16 * it, 32 * k, lane), o2);
    LBAR();
    if (w < 2) { const LAS float* M = Md + w * 256; const int c = lane & 15;
      float m[16];
#pragma unroll
      for (int q4 = 0; q4 < 4; ++q4) { const f32x4 t4 = *(const LAS f32x4*)(M + c * 16 + 4 * q4); m[4 * q4] = t4[0]; m[4 * q4 + 1] = t4[1]; m[4 * q4 + 2] = t4[2]; m[4 * q4 + 3] = t4[3]; }
      float T[16];
#pragma unroll
      for (int r = 0; r < 16; ++r) { float v = (r == c) ? 1.f : 0.f;
#pragma unroll
        for (int s2 = 0; s2 < r; ++s2) v -= __builtin_bit_cast(float, __builtin_amdgcn_readlane(__builtin_bit_cast(int, m[s2]), r)) * T[s2];
        T[r] = v; }
      if (lane < 16) { LAS u32x4* dst = (LAS u32x4*)(Tt + w * 32 * LDT + c * LDT);
        dst[0] = (u32x4){pk2(T[0], T[1]), pk2(T[2], T[3]), pk2(T[4], T[5]), pk2(T[6], T[7])};
        dst[1] = (u32x4){pk2(T[8], T[9]), pk2(T[10], T[11]), pk2(T[12], T[13]), pk2(T[14], T[15])}; } }
    LBAR();
    for (int ct = w; ct < 10; ct += 4) {
      const int cc = 16 * ct + fr;
      f32x4 rhs;
#pragma unroll
      for (int r = 0; r < 4; ++r) { const int ii = 4 * fq + r; const float bi = bL[ii];
        rhs[r] = ct < 2 ? bi * bf2f(Vs[ii * LDP + cc]) : bi * __expf(__shfl(cum, ii)) * bf2f(Ks[ii * LDN + cc - 32]); }
      { u32x2 o; o.x = pk2(rhs[0], rhs[1]); o.y = pk2(rhs[2], rhs[3]); *(LAS u32x2*)(Rw + fr * LDP + 4 * fq) = o; }
      asm volatile("s_waitcnt lgkmcnt(0)" ::: "memory");
      f32x4 x0 = mma16(frag_tr(Tt, LDT, 0, 0, lane), frag_row(Rw, LDP, 0, 0, lane), (f32x4){0.f, 0.f, 0.f, 0.f});
      { u32x2 o; o.x = pk2(x0[0], x0[1]); o.y = pk2(x0[2], x0[3]); *(LAS u32x2*)(Xt + cc * LDP + 4 * fq) = o; }
#pragma unroll
      for (int r = 0; r < 4; ++r) { const int ii = 16 + 4 * fq + r; const float bi = bL[ii];
        rhs[r] = ct < 2 ? bi * bf2f(Vs[ii * LDP + cc]) : bi * __expf(__shfl(cum, ii)) * bf2f(Ks[ii * LDN + cc - 32]); }
      asm volatile("s_waitcnt lgkmcnt(0)" ::: "memory");
      { bf16x8 fa = frag_tr(Mt, LDP, 0, 16, lane); if (fq >= 2) fa = (bf16x8){0, 0, 0, 0, 0, 0, 0, 0};
        bf16x8 fb = frag_row(Xt, LDP, 16 * ct, 0, lane); if (fq >= 2) fb = (bf16x8){0, 0, 0, 0, 0, 0, 0, 0};
        const f32x4 corr = mma16(fa, fb, (f32x4){0.f, 0.f, 0.f, 0.f});
        rhs = rhs - corr; }
      { u32x2 o; o.x = pk2(rhs[0], rhs[1]); o.y = pk2(rhs[2], rhs[3]); *(LAS u32x2*)(Rw + fr * LDP + 4 * fq) = o; }
      asm volatile("s_waitcnt lgkmcnt(0)" ::: "memory");
      f32x4 x1 = mma16(frag_tr(Tt + 32 * LDT, LDT, 0, 0, lane), frag_row(Rw, LDP, 0, 0, lane), (f32x4){0.f, 0.f, 0.f, 0.f});
      { u32x2 o; o.x = pk2(x1[0], x1[1]); o.y = pk2(x1[2], x1[3]); *(LAS u32x2*)(Xt + cc * LDP + 16 + 4 * fq) = o; }
    }
    LBAR();
    { f32x4 ws = (f32x4){0.f, 0.f, 0.f, 0.f};
#pragma unroll
      for (int k = 0; k < 4; ++k) ws = mma16(frag_tr(Xt + 32 * LDP, LDP, 32 * k, 16 * it, lane), frag_row(Sr, LDN, 16 * vt, 32 * k, lane), ws);
      const u32x2 uu = *(const LAS u32x2*)(Xt + (16 * vt + fr) * LDP + 16 * it + 4 * fq);
      float vn[4] = {bflo(uu.x) - ws[0], bfhi(uu.x) - ws[1], bflo(uu.y) - ws[2], bfhi(uu.y) - ws[3]};
      float vw[4];
#pragma unroll
      for (int r = 0; r < 4; ++r) vw[r] = vn[r] * __expf(cum_last - __shfl(cum, 16 * it + 4 * fq + r));
      u32x2 o; o.x = pk2(vn[0], vn[1]); o.y = pk2(vn[2], vn[3]); *(LAS u32x2*)(Vn + (16 * vt + fr) * LDP + 16 * it + 4 * fq) = o;
      o.x = pk2(vw[0], vw[1]); o.y = pk2(vw[2], vw[3]); *(LAS u32x2*)(Vw + (16 * vt + fr) * LDP + 16 * it + 4 * fq) = o; }
    LBAR();
    { const f32x4 o1 = mma16(frag_row(Vn, LDP, 16 * vt, 0, lane), frag_tr(At, LDP, 0, 16 * it, lane), (f32x4){0.f, 0.f, 0.f, 0.f});
      const int ii = 16 * it + fr; const float eci = __expf(__shfl(cum, ii));
      float o0 = o1[0] + eci * o2[0], o1v = o1[1] + eci * o2[1], o2v = o1[2] + eci * o2[2], o3 = o1[3] + eci * o2[3];
      if (!first) { const unsigned long long pv = ppv; const unsigned lo = (unsigned)pv, hi = (unsigned)(pv >> 32); o0 += bflo(lo); o1v += bfhi(lo); o2v += bflo(hi); o3 += bfhi(hi); }
      u32x2 o; o.x = pk2(o0, o1v); o.y = pk2(o2v, o3); *(u32x2*)op = o; }
    { const float el = __expf(cum_last);
#pragma unroll
      for (int a = 0; a < 2; ++a) { const int kt = 2 * w + a; const bf16x8 fa = frag_tr(Ks, LDN, 0, 16 * kt, lane);
#pragma unroll
        for (int c = 0; c < 2; ++c) { f32x4 acc = mma16(fa, frag_row(Vw, LDP, 16 * c, 0, lane), Sacc[a][c] * el);
          Sacc[a][c] = acc;
          u32x2 o; o.x = pk2(acc[0], acc[1]); o.y = pk2(acc[2], acc[3]);
          *(LAS u32x2*)(Sw + (16 * c + fr) * LDN + 16 * kt + 4 * fq) = o; } } }
    LBAR();
  }
}

__device__ __forceinline__ bf16x8 ldfr(const LAS bf16_t* p) { return *(const LAS bf16x8*)p; }
__device__ __forceinline__ bf16x8 ldft(const LAS bf16_t* p, int ld) {
  const s16x4 v0 = __builtin_amdgcn_ds_read_tr16_b64_v4i16((LAS s16x4*)p);
  const s16x4 v1 = __builtin_amdgcn_ds_read_tr16_b64_v4i16((LAS s16x4*)(p + 4 * ld));
  bf16x8 r; r[0] = v0[0]; r[1] = v0[1]; r[2] = v0[2]; r[3] = v0[3]; r[4] = v1[0]; r[5] = v1[1]; r[6] = v1[2]; r[7] = v1[3];
  return r;
}
__device__ __forceinline__ u32x2 pk4(float a, float b, float c, float dd) { u32x2 o; o.x = pg8::cvt_pk_bf16(a, b); o.y = pg8::cvt_pk_bf16(c, dd); return o; }
__device__ __forceinline__ float bcast_lane(float v, int l) { return __builtin_bit_cast(float, __builtin_amdgcn_readlane(__builtin_bit_cast(int, v), l)); }

__device__ __forceinline__ void gdn2_chain_wg(const Params& P, const Ctx& C, int task) {
  const int b = task >> 5, h = (task >> 2) & 7, vs = task & 3;
  const int d = C.wave >> 2, w = ((C.wave & 3) + 2 * d) & 3, td = C.tid & 255, lane = C.lane, fr = lane & 15, fq = lane >> 4;
  constexpr int LDN = 136, LDP = 40, LDT = 24;
  constexpr int DIRSZ = 64 * 1024;
  LAS unsigned char* L = C.lds + d * DIRSZ;
  LAS bf16_t* Qs = (LAS bf16_t*)L;
  LAS bf16_t* Ks = Qs + 32 * LDN;
  LAS bf16_t* Vt = Ks + 32 * LDN;
  LAS bf16_t* Mt = Vt + 32 * LDP;
  LAS bf16_t* At = Mt + 32 * LDP;
  LAS bf16_t* Rt = At + 32 * LDP;
  LAS bf16_t* Vn = Rt + 32 * LDP;
  LAS bf16_t* Vw = Vn + 32 * LDP;
  LAS bf16_t* Tt = Vw + 32 * LDP;
  LAS bf16_t* St = Tt + 2 * 32 * LDT;
  LAS float* Md = (LAS float*)(St + 2 * 32 * LDN);
  LAS float* gL = Md + 512;
  LAS float* bL = gL + 32; LAS float* becL = bL;
  LAS float* ecL = bL + 32 + (C.wave & 3) * 96; LAS float* encL = ecL + 32; LAS float* ewL = encL + 32;
  const bf16_t* Z = WS(OFF_Z1, bf16_t); bf16_t* MIX = WS(OFF_MIX1, bf16_t); const float* DT = WS(OFF_DT, float);
  const float Aneg = -__expf(GIN(I_GALOG)[d * 8 + h]), dtb = GIN(I_GDTB)[d * 8 + h];
  const int colq = Z1_Q + h * 128, colk = Z1_K + h * 128, colv = Z1_V + h * 128 + vs * 32, outc = h * 128 + vs * 32;
  __syncthreads();
  for (int i = td; i < 58 * 1024 / 4; i += 256) ((LAS unsigned*)L)[i] = 0u;
  f32x4 Sacc[2][2];
#pragma unroll
  for (int a = 0; a < 2; ++a)
#pragma unroll
    for (int c = 0; c < 2; ++c) Sacc[a][c] = (f32x4){0.f, 0.f, 0.f, 0.f};
  const int st_t = td >> 3, st_s = td & 7;
  u32x4 rq[2], rk[2]; u32x2 rv; float ra = 0.f, rb = 0.f;
  auto issue_loads = [&](int step) {
    const int chunk = seq_chunk32(d, step); const size_t row = (size_t)b * TB + chunk * 32 + st_t;
    const u32x4* pq = (const u32x4*)(Z + row * Z1W + colq + st_s * 16); const u32x4* pk = (const u32x4*)(Z + row * Z1W + colk + st_s * 16);
    rq[0] = pq[0]; rq[1] = pq[1]; rk[0] = pk[0]; rk[1] = pk[1];
    rv = *(const u32x2*)(Z + row * Z1W + colv + st_s * 4);
    if (st_s == 0) { rb = DT[row * 32 + d * 8 + h]; ra = DT[row * 32 + 16 + d * 8 + h]; }
  };
  issue_loads(0);
  __syncthreads();
  const int rL136 = fr * LDN + 8 * fq, rL40 = fr * LDP + 8 * fq;
  const int tq = fr >> 2, tp = fr & 3;
  const int tL136 = (8 * fq + tq) * LDN + 4 * tp, tL40 = (8 * fq + tq) * LDP + 4 * tp, tL24 = (8 * fq + tq) * LDT + 4 * tp;
  const int it = w >> 1, vt = w & 1;
  const int si = d ? 31 - st_t : st_t;
  LAS u32x4* stq = (LAS u32x4*)(Qs + si * LDN + st_s * 16); LAS u32x4* stk = (LAS u32x4*)(Ks + si * LDN + st_s * 16);
  LAS bf16_t* stv = Vt + (st_s * 4) * LDP + si;
  const LAS bf16_t* pK_it = Ks + 16 * it * LDN + rL136; const LAS bf16_t* pQ_it = Qs + 16 * it * LDN + rL136;
  for (int step = 0; step < 264; ++step) {
    const int chunk = seq_chunk32(d, step); const int row0 = b * TB + chunk * 32;
    VMWAIT();
    stq[0] = rq[0]; stq[1] = rq[1]; stk[0] = rk[0]; stk[1] = rk[1];
    stv[0] = (bf16_t)(rv.x & 0xffffu); stv[LDP] = (bf16_t)(rv.x >> 16); stv[2 * LDP] = (bf16_t)(rv.y & 0xffffu); stv[3 * LDP] = (bf16_t)(rv.y >> 16);
    if (st_s == 0) { gL[si] = Aneg * softplusf_(ra + dtb); bL[si] = fast_sigmoid(rb); }
    LBAR();
    if (step + 1 < 264) issue_loads(step + 1);
    const bool first = (d == 0) == fwd_first32(chunk);
    bf16_t* op; unsigned long long ppv = 0ull;
    { const int ii = 16 * it + fr; const int t = d ? 31 - ii : ii; op = MIX + (size_t)(row0 + t) * MIXW + outc + 16 * vt + 4 * fq; if (!first) ppv = ld_agent_u64(op); }
    float elast;
    { const float c = wave_incl_scan(lane < 32 ? gL[lane & 31] : 0.f, lane); const float cl = bcast_lane(c, 31); elast = __expf(cl);
      if (lane < 32) { const float ec = __expf(c); ecL[lane] = ec; encL[lane] = c; ewL[lane] = __expf(cl - c); } }
    asm volatile("s_waitcnt lgkmcnt(0)" ::: "memory");
    const LAS bf16_t* Sr = St + (step & 1) * 32 * LDN; LAS bf16_t* Sw = St + ((step + 1) & 1) * 32 * LDN;
    f32x4 o2 = (f32x4){0.f, 0.f, 0.f, 0.f};
    { f32x4 ks = (f32x4){0.f, 0.f, 0.f, 0.f};
      const LAS bf16_t* pS = Sr + 16 * vt * LDN + rL136;
#pragma unroll
      for (int k = 0; k < 4; ++k) { const bf16x8 fs = ldfr(pS + 32 * k); ks = mma16(ldfr(pK_it + 32 * k), fs, ks); o2 = mma16(fs, ldfr(pQ_it + 32 * k), o2); }
      const u32x2 vv = *(const LAS u32x2*)(Vt + (16 * vt + fr) * LDP + 16 * it + 4 * fq);
      const f32x4 ec4 = *(const LAS f32x4*)(ecL + 16 * it + 4 * fq), b4 = *(const LAS f32x4*)(bL + 16 * it + 4 * fq);
      *(LAS u32x2*)(Rt + (16 * vt + fr) * LDP + 16 * it + 4 * fq) =
        pk4(b4[0] * (bflo(vv.x) - ec4[0] * ks[0]), b4[1] * (bfhi(vv.x) - ec4[1] * ks[1]), b4[2] * (bflo(vv.y) - ec4[2] * ks[2]), b4[3] * (bfhi(vv.y) - ec4[3] * ks[3])); }
    { const int isq = w & 1; const LAS bf16_t* A = isq ? Qs : Ks;
      const int njobs = w < 2 ? 1 : 2;
      for (int jb = 0; jb < njobs; ++jb) {
        const int I = (w < 2) ? 1 : jb, J = (w < 2) ? 1 : 0;
        f32x4 acc = (f32x4){0.f, 0.f, 0.f, 0.f};
        const LAS bf16_t* pa = A + 16 * I * LDN + rL136; const LAS bf16_t* pb = Ks + 16 * J * LDN + rL136;
#pragma unroll
        for (int k = 0; k < 4; ++k) acc = mma16(ldfr(pa + 32 * k), ldfr(pb + 32 * k), acc);
        const int jj = 16 * J + fr, i0 = 16 * I + 4 * fq; const float cj = encL[jj];
        const f32x4 c4 = *(const LAS f32x4*)(encL + i0); const f32x4 b4 = *(const LAS f32x4*)(becL + i0);
        float pv[4];
#pragma unroll
        for (int r = 0; r < 4; ++r) { const bool keep = isq ? (jj <= i0 + r) : (jj < i0 + r); const float sc = isq ? 1.f : b4[r];
          pv[r] = keep ? acc[r] * sc * __expf(c4[r] - cj) : 0.f; }
        if (!isq && I == J) { LAS float* md = Md + I * 256 + (4 * fq) * 16 + fr; md[0] = pv[0]; md[16] = pv[1]; md[32] = pv[2]; md[48] = pv[3]; }
        *(LAS u32x2*)((isq ? At : Mt) + jj * LDP + i0) = pk4(pv[0], pv[1], pv[2], pv[3]);
      } }
    LBAR();
    if (w < 2) { const LAS float* M = Md + w * 256; const int c = fr;
      float m[16];
#pragma unroll
      for (int q4 = 0; q4 < 4; ++q4) { const f32x4 t4 = *(const LAS f32x4*)(M + c * 16 + 4 * q4); m[4 * q4] = t4[0]; m[4 * q4 + 1] = t4[1]; m[4 * q4 + 2] = t4[2]; m[4 * q4 + 3] = t4[3]; }
      float T[16];
#pragma unroll
      for (int r = 0; r < 16; ++r) { float v = (r == c) ? 1.f : 0.f;
#pragma unroll
        for (int s2 = 0; s2 < r; ++s2) v -= bcast_lane(m[s2], r) * T[s2];
        T[r] = v; }
      if (lane < 16) { LAS u32x4* dst = (LAS u32x4*)(Tt + w * 32 * LDT + c * LDT);
        dst[0] = (u32x4){pg8::cvt_pk_bf16(T[0], T[1]), pg8::cvt_pk_bf16(T[2], T[3]), pg8::cvt_pk_bf16(T[4], T[5]), pg8::cvt_pk_bf16(T[6], T[7])};
        dst[1] = (u32x4){pg8::cvt_pk_bf16(T[8], T[9]), pg8::cvt_pk_bf16(T[10], T[11]), pg8::cvt_pk_bf16(T[12], T[13]), pg8::cvt_pk_bf16(T[14], T[15])}; } }
    LBAR();
    if (w < 2) { const int ct = w; const int cc = 16 * ct + fr;
      const f32x4 x0 = mma16(ldft(Tt + tL24, LDT), ldfr(Rt + 16 * ct * LDP + rL40), (f32x4){0.f, 0.f, 0.f, 0.f});
      const f32x4 ew0 = *(const LAS f32x4*)(ewL + 4 * fq);
      *(LAS u32x2*)(Vn + cc * LDP + 4 * fq) = pk4(x0[0], x0[1], x0[2], x0[3]);
      *(LAS u32x2*)(Vw + cc * LDP + 4 * fq) = pk4(x0[0] * ew0[0], x0[1] * ew0[1], x0[2] * ew0[2], x0[3] * ew0[3]);
      const u32x2 r1 = *(const LAS u32x2*)(Rt + cc * LDP + 16 + 4 * fq);
      asm volatile("s_waitcnt lgkmcnt(0)" ::: "memory");
      bf16x8 fa = ldft(Mt + tL40 + 16, LDP); bf16x8 fb = ldfr(Vn + 16 * ct * LDP + rL40);
      if (fq >= 2) { fa = (bf16x8){0, 0, 0, 0, 0, 0, 0, 0}; fb = (bf16x8){0, 0, 0, 0, 0, 0, 0, 0}; }
      const f32x4 corr = mma16(fa, fb, (f32x4){0.f, 0.f, 0.f, 0.f});
      *(LAS u32x2*)(Rt + cc * LDP + 16 + 4 * fq) = pk4(bflo(r1.x) - corr[0], bfhi(r1.x) - corr[1], bflo(r1.y) - corr[2], bfhi(r1.y) - corr[3]);
      asm volatile("s_waitcnt lgkmcnt(0)" ::: "memory");
      const f32x4 x1 = mma16(ldft(Tt + 32 * LDT + tL24, LDT), ldfr(Rt + 16 * ct * LDP + 16 + rL40), (f32x4){0.f, 0.f, 0.f, 0.f});
      const f32x4 ew1 = *(const LAS f32x4*)(ewL + 16 + 4 * fq);
      *(LAS u32x2*)(Vn + cc * LDP + 16 + 4 * fq) = pk4(x1[0], x1[1], x1[2], x1[3]);
      *(LAS u32x2*)(Vw + cc * LDP + 16 + 4 * fq) = pk4(x1[0] * ew1[0], x1[1] * ew1[1], x1[2] * ew1[2], x1[3] * ew1[3]); }
    LBAR();
    { const f32x4 o1 = mma16(ldfr(Vn + 16 * vt * LDP + rL40), ldft(At + tL40 + 16 * it, LDP), (f32x4){0.f, 0.f, 0.f, 0.f});
      const float eci = ecL[16 * it + fr];
      float o0 = o1[0] + eci * o2[0], o1v = o1[1] + eci * o2[1], o2v = o1[2] + eci * o2[2], o3 = o1[3] + eci * o2[3];
      if (!first) { const unsigned lo = (unsigned)ppv, hi = (unsigned)(ppv >> 32); o0 += bflo(lo); o1v += bfhi(lo); o2v += bflo(hi); o3 += bfhi(hi); }
      *(u32x2*)op = pk4(o0, o1v, o2v, o3); }
    { const bf16x8 fv0 = ldfr(Vw + rL40), fv1 = ldfr(Vw + 16 * LDP + rL40);
#pragma unroll
      for (int a = 0; a < 2; ++a) { const int kt = 2 * w + a; const bf16x8 fa = ldft(Ks + tL136 + 16 * kt, LDN);
        f32x4 a0 = mma16(fa, fv0, Sacc[a][0] * elast), a1 = mma16(fa, fv1, Sacc[a][1] * elast);
        Sacc[a][0] = a0; Sacc[a][1] = a1;
        *(LAS u32x2*)(Sw + fr * LDN + 16 * kt + 4 * fq) = pk4(a0[0], a0[1], a0[2], a0[3]);
        *(LAS u32x2*)(Sw + (16 + fr) * LDN + 16 * kt + 4 * fq) = pk4(a1[0], a1[1], a1[2], a1[3]); } }
    LBAR();
  }
}


template <int L> __device__ __forceinline__ float dpp_bcast16(float v) {
  return __builtin_bit_cast(float, __builtin_amdgcn_update_dpp(0, __builtin_bit_cast(int, v), 0x150 + L, 0xf, 0xf, true));
}
template <int S, int R> __device__ __forceinline__ void inv_upd(const float (&mpos)[16], float (&acc)[16]) {
  if constexpr (R < 16) { asm("v_fmac_f32_dpp %0, -%1, %2 row_newbcast:%3 row_mask:0xf bank_mask:0xf" : "+v"(acc[R]) : "v"(mpos[S]), "v"(acc[S]), "n"(R)); inv_upd<S, R + 1>(mpos, acc); }
}
template <int S> __device__ __forceinline__ void inv_col(const float (&mneg)[16], float (&acc)[16]) {
  if constexpr (S < 15) { inv_upd<S, S + 1>(mneg, acc); inv_col<S + 1>(mneg, acc); }
}
__device__ __forceinline__ void gdn3_chain_wg(const Params& P, const Ctx& C, int task) {
  const int b = task >> 5, h = (task >> 2) & 7, vs = task & 3;
  const int d = C.wave >> 2, w = ((C.wave & 3) + 2 * d) & 3, td = C.tid & 255, lane = C.lane, fr = lane & 15, fq = lane >> 4;
  constexpr int LDN = 136, LDP = 40, LDT = 24;
  constexpr int DIRSZ = 64 * 1024;
  LAS unsigned char* L = C.lds + d * DIRSZ;
  LAS bf16_t* Qs = (LAS bf16_t*)L;
  LAS bf16_t* Ks = Qs + 32 * LDN;
  LAS bf16_t* Vt = Ks + 32 * LDN;
  LAS bf16_t* Mt = Vt + 32 * LDP;
  LAS bf16_t* At = Mt + 32 * LDP;
  LAS bf16_t* Rt = At + 32 * LDP;
  LAS bf16_t* Vn = Rt + 32 * LDP;
  LAS bf16_t* Vw = Vn + 32 * LDP;
  LAS bf16_t* Tt = Vw + 32 * LDP;
  LAS bf16_t* St = Tt + 2 * 32 * LDT;
  LAS float* Md = (LAS float*)(St + 2 * 32 * LDN);
  LAS float* gL = Md + 512;
  LAS float* bL = gL + 32; LAS float* becL = bL;
  LAS float* ecL = bL + 32; LAS float* encL = ecL + 32; LAS float* ewL = encL + 32;
  LAS f32x4* O2x = (LAS f32x4*)(bL + 32 + 4 * 96);
  LAS u32x2* TA = (LAS u32x2*)Tt;
  LAS u32x2* MA = (LAS u32x2*)Mt;
  const bf16_t* Z = WS(OFF_Z1, bf16_t); bf16_t* MIX = WS(OFF_MIX1, bf16_t); const f32x4* GV = WS(OFF_GV, f32x4);
  const int colq = Z1_Q + h * 128, colk = Z1_K + h * 128, colv = Z1_V + h * 128 + vs * 32, outc = h * 128 + vs * 32;
  __syncthreads();
  for (int i = td; i < 60 * 1024 / 4; i += 256) ((LAS unsigned*)L)[i] = 0u;
  f32x4 Sacc[2][2];
#pragma unroll
  for (int a = 0; a < 2; ++a)
#pragma unroll
    for (int c = 0; c < 2; ++c) Sacc[a][c] = (f32x4){0.f, 0.f, 0.f, 0.f};
  const int st_t = td >> 3, st_s = td & 7;
  u32x4 rq[2], rk[2]; unsigned short rv[4]; f32x4 rg = (f32x4){0.f, 0.f, 0.f, 0.f};
  const int cb_t = 8 * (td >> 6) + (lane >> 4), cb_p = lane & 15;
  const unsigned lq = (unsigned)(cb_t * Z1W + colq + 8 * cb_p), lk = (unsigned)(cb_t * Z1W + colk + 8 * cb_p);
  const int vc = td & 31, vq = td >> 5;
  unsigned lv[4];
#pragma unroll
  for (int j = 0; j < 4; ++j) { const int sl = 4 * vq + j; lv[j] = (unsigned)((d ? 31 - sl : sl) * Z1W + colv + vc); }
  auto issue_loads = [&](int step) {
    const int chunk = seq_chunk32(d, step); const size_t crow = (size_t)b * TB + chunk * 32;
    const bf16_t* zb = Z + crow * Z1W;
    rq[0] = *(const u32x4*)(zb + lq); rq[1] = *(const u32x4*)(zb + (size_t)4 * Z1W + lq); rk[0] = *(const u32x4*)(zb + lk); rk[1] = *(const u32x4*)(zb + (size_t)4 * Z1W + lk);
#pragma unroll
    for (int j = 0; j < 4; ++j) rv[j] = zb[lv[j]];
    if (st_s == 0) rg = (GV + crow * 16 + d * 8 + h)[(unsigned)(st_t * 16)];
  };
  issue_loads(0);
  __syncthreads();
  const int rL136 = fr * LDN + 8 * fq, rL40 = fr * LDP + 8 * fq;
  const int tq = fr >> 2, tp = fr & 3;
  const int tL136 = (8 * fq + tq) * LDN + 4 * tp, tL40 = (8 * fq + tq) * LDP + 4 * tp, tL24 = (8 * fq + tq) * LDT + 4 * tp;
  const int it = w >> 1, vt = w & 1;
  const int si = d ? 31 - st_t : st_t;
  const int sq0 = d ? 31 - cb_t : cb_t, sq1 = d ? 31 - (cb_t + 4) : cb_t + 4;
  LAS u32x4* stq = (LAS u32x4*)(Qs + 8 * cb_p); LAS u32x4* stk = (LAS u32x4*)(Ks + 8 * cb_p);
  LAS u32x2* stv = (LAS u32x2*)(Vt + vc * LDP + 4 * vq);
  const LAS bf16_t* pK_it = Ks + 16 * it * LDN + rL136; const LAS bf16_t* pQ_it = Qs + 16 * it * LDN + rL136;
  unsigned lop; { const int ii = 16 * it + fr; const int t = d ? 31 - ii : ii; lop = (unsigned)(t * MIXW + outc + 16 * vt + 4 * fq); }
  for (int step = 0; step < 264; ++step) {
    const int chunk = seq_chunk32(d, step); const int row0 = b * TB + chunk * 32;
    VMWAIT32(step);
    *(LAS u32x4*)((LAS bf16_t*)stq + sq0 * LDN) = rq[0]; *(LAS u32x4*)((LAS bf16_t*)stq + sq1 * LDN) = rq[1]; *(LAS u32x4*)((LAS bf16_t*)stk + sq0 * LDN) = rk[0]; *(LAS u32x4*)((LAS bf16_t*)stk + sq1 * LDN) = rk[1];
    stv[0] = (u32x2){(unsigned)rv[0] | ((unsigned)rv[1] << 16), (unsigned)rv[2] | ((unsigned)rv[3] << 16)};
    if (st_s == 0) { bL[si] = rg[0]; encL[si] = rg[1]; ecL[si] = rg[2]; ewL[si] = rg[3]; }
    LBAR();
    if (step + 1 < 264) issue_loads(step + 1);
    const bool first = (d == 0) == fwd_first32(chunk);
    bf16_t* op; unsigned long long ppv = 0ull;
    { op = MIX + (size_t)row0 * MIXW + lop; if (!first) ppv = ld_agent_u64(op); }
    const float elast = ecL[31];
    const LAS bf16_t* Sr = St + (step & 1) * 32 * LDN; LAS bf16_t* Sw = St + ((step + 1) & 1) * 32 * LDN;
    f32x4 o2 = (f32x4){0.f, 0.f, 0.f, 0.f};
    if (w < 2) {
      f32x4 acc = (f32x4){0.f, 0.f, 0.f, 0.f};
      { const LAS bf16_t* pk = Ks + 16 * w * LDN + rL136;
#pragma unroll
        for (int k = 0; k < 4; ++k) { const bf16x8 f = ldfr(pk + 32 * k); acc = mma16(f, f, acc); } }
      { const int jj = 16 * w + fr, i0 = 16 * w + 4 * fq; const float cj = encL[jj], bj = becL[jj];
        const f32x4 c4 = *(const LAS f32x4*)(encL + i0); const f32x4 b4 = *(const LAS f32x4*)(becL + i0);
        f32x4 mD, mT, s1;
#pragma unroll
        for (int r = 0; r < 4; ++r) { const int i = i0 + r; const float g = acc[r] * __expf(-fabsf(c4[r] - cj));
          mD[r] = (jj < i) ? g * b4[r] : 0.f; mT[r] = (i < jj) ? g * bj : 0.f; s1[r] = ((i == jj) ? 1.f : 0.f) - mT[r]; }
        auto opnd = [](const f32x4& x) { const u32x2 p = pk4(x[0], x[1], x[2], x[3]); return __builtin_bit_cast(bf16x8, (u32x4){p.x, p.y, 0u, 0u}); };
        const f32x4 z4 = (f32x4){0.f, 0.f, 0.f, 0.f};
        const bf16x8 X0 = opnd(mD), Y0 = opnd(mT);
        const f32x4 x1 = mma16(Y0, X0, z4), y1 = mma16(X0, Y0, z4);
        const bf16x8 X1 = opnd(x1), Y1 = opnd(y1);
        const f32x4 s2 = mma16(X1, opnd(s1), s1);
        const f32x4 x2 = mma16(Y1, X1, z4), y2 = mma16(X1, Y1, z4);
        const bf16x8 X2 = opnd(x2), Y2 = opnd(y2);
        const f32x4 s3 = mma16(X2, opnd(s2), s2);
        const f32x4 x3 = mma16(Y2, X2, z4);
        const f32x4 s4 = mma16(opnd(x3), opnd(s3), s3);
        TA[w * 64 + lane] = pk4(s4[0], s4[1], s4[2], s4[3]); }
    } else {
      const int pvt = w & 1;
      bf16x8 fS[4], fK0[4], fK1[4], fQ0[4], fQ1[4];
      { const LAS bf16_t* pS = Sr + 16 * pvt * LDN + rL136; const LAS bf16_t* pK = Ks + rL136; const LAS bf16_t* pQ = Qs + rL136;
#pragma unroll
        for (int k = 0; k < 4; ++k) { fS[k] = ldfr(pS + 32 * k); fK0[k] = ldfr(pK + 32 * k); fK1[k] = ldfr(pK + 16 * LDN + 32 * k); fQ0[k] = ldfr(pQ + 32 * k); fQ1[k] = ldfr(pQ + 16 * LDN + 32 * k); } }
      const u32x2 vv1 = *(const LAS u32x2*)(Vt + (16 * pvt + fr) * LDP + 16 + 4 * fq), vv0 = *(const LAS u32x2*)(Vt + (16 * pvt + fr) * LDP + 4 * fq);
      const f32x4 ec1 = *(const LAS f32x4*)(ecL + 16 + 4 * fq), ec0 = *(const LAS f32x4*)(ecL + 4 * fq), bb1 = *(const LAS f32x4*)(bL + 16 + 4 * fq), bb0 = *(const LAS f32x4*)(bL + 4 * fq);
      const f32x4 cc1 = *(const LAS f32x4*)(encL + 16 + 4 * fq), cc0 = *(const LAS f32x4*)(encL + 4 * fq); const float cj0 = encL[fr], cj1 = encL[16 + fr];
      f32x4 ks1 = (f32x4){0.f, 0.f, 0.f, 0.f}, qs1 = ks1, ks0 = ks1, qs0 = ks1, ta = ks1, tb = ks1;
#pragma unroll
      for (int k = 0; k < 4; ++k) {
        ks1 = mma16(fK1[k], fS[k], ks1); qs1 = mma16(fS[k], fQ1[k], qs1); ks0 = mma16(fK0[k], fS[k], ks0); qs0 = mma16(fS[k], fQ0[k], qs0);
        if (w == 2) { ta = mma16(fK0[k], fK1[k], ta); tb = mma16(fQ1[k], fK0[k], tb); } else { ta = mma16(fQ0[k], fK0[k], ta); tb = mma16(fQ1[k], fK1[k], tb); } }
      o2 = qs1;
      O2x[pvt * 64 + lane] = qs0;
      *(LAS u32x2*)(Rt + (16 * pvt + fr) * LDP + 16 + 4 * fq) =
        pk4(bb1[0] * (bflo(vv1.x) - ec1[0] * ks1[0]), bb1[1] * (bfhi(vv1.x) - ec1[1] * ks1[1]), bb1[2] * (bflo(vv1.y) - ec1[2] * ks1[2]), bb1[3] * (bfhi(vv1.y) - ec1[3] * ks1[3]));
      *(LAS u32x2*)(Rt + (16 * pvt + fr) * LDP + 4 * fq) =
        pk4(bb0[0] * (bflo(vv0.x) - ec0[0] * ks0[0]), bb0[1] * (bfhi(vv0.x) - ec0[1] * ks0[1]), bb0[2] * (bflo(vv0.y) - ec0[2] * ks0[2]), bb0[3] * (bfhi(vv0.y) - ec0[3] * ks0[3]));
      if (w == 2) {
        const float bi = bL[16 + fr];
        MA[lane] = pk4(ta[0] * bi * __expf(cj1 - cc0[0]), ta[1] * bi * __expf(cj1 - cc0[1]), ta[2] * bi * __expf(cj1 - cc0[2]), ta[3] * bi * __expf(cj1 - cc0[3]));
        *(LAS u32x2*)(At + fr * LDP + 16 + 4 * fq) = pk4(tb[0] * __expf(cc1[0] - cj0), tb[1] * __expf(cc1[1] - cj0), tb[2] * __expf(cc1[2] - cj0), tb[3] * __expf(cc1[3] - cj0));
      } else {
        const int j0 = fr, r0 = 4 * fq;
        *(LAS u32x2*)(At + fr * LDP + 4 * fq) = pk4(j0 <= r0 ? ta[0] * __expf(cc0[0] - cj0) : 0.f, j0 <= r0 + 1 ? ta[1] * __expf(cc0[1] - cj0) : 0.f, j0 <= r0 + 2 ? ta[2] * __expf(cc0[2] - cj0) : 0.f, j0 <= r0 + 3 ? ta[3] * __expf(cc0[3] - cj0) : 0.f);
        *(LAS u32x2*)(At + (16 + fr) * LDP + 16 + 4 * fq) = pk4(j0 <= r0 ? tb[0] * __expf(cc1[0] - cj1) : 0.f, j0 <= r0 + 1 ? tb[1] * __expf(cc1[1] - cj1) : 0.f, j0 <= r0 + 2 ? tb[2] * __expf(cc1[2] - cj1) : 0.f, j0 <= r0 + 3 ? tb[3] * __expf(cc1[3] - cj1) : 0.f);
      }
    }
    LBAR();
    if (w < 2) { const int ct = w; const int cc = 16 * ct + fr;
      auto op8 = [](const u32x2& p) { return __builtin_bit_cast(bf16x8, (u32x4){p.x, p.y, 0u, 0u}); };
      const u32x2 tA0 = TA[lane], tA1 = TA[64 + lane], mA = MA[lane];
      const u32x2 r0 = *(const LAS u32x2*)(Rt + cc * LDP + 4 * fq), r1 = *(const LAS u32x2*)(Rt + cc * LDP + 16 + 4 * fq);
      const f32x4 ew0 = *(const LAS f32x4*)(ewL + 4 * fq), ew1 = *(const LAS f32x4*)(ewL + 16 + 4 * fq);
      const f32x4 z4 = (f32x4){0.f, 0.f, 0.f, 0.f};
      const f32x4 x0 = mma16(op8(tA0), op8(r0), z4);
      const u32x2 x0p = pk4(x0[0], x0[1], x0[2], x0[3]);
      const f32x4 corr = mma16(op8(mA), op8(x0p), z4);
      const u32x2 r1p = pk4(bflo(r1.x) - corr[0], bfhi(r1.x) - corr[1], bflo(r1.y) - corr[2], bfhi(r1.y) - corr[3]);
      const f32x4 x1 = mma16(op8(tA1), op8(r1p), z4);
      *(LAS u32x2*)(Vn + cc * LDP + 4 * fq) = x0p;
      *(LAS u32x2*)(Vw + cc * LDP + 4 * fq) = pk4(x0[0] * ew0[0], x0[1] * ew0[1], x0[2] * ew0[2], x0[3] * ew0[3]);
      *(LAS u32x2*)(Vn + cc * LDP + 16 + 4 * fq) = pk4(x1[0], x1[1], x1[2], x1[3]);
      *(LAS u32x2*)(Vw + cc * LDP + 16 + 4 * fq) = pk4(x1[0] * ew1[0], x1[1] * ew1[1], x1[2] * ew1[2], x1[3] * ew1[3]); }
    LBAR();
    if (w < 2) o2 = O2x[w * 64 + lane];
    {
      const bf16x8 fvn = ldfr(Vn + 16 * vt * LDP + rL40), fat = ldft(At + tL40 + 16 * it, LDP);
      const float eci = ecL[16 * it + fr];
      const bf16x8 fv0 = ldfr(Vw + rL40), fv1 = ldfr(Vw + 16 * LDP + rL40);
      const bf16x8 fk0 = ldft(Ks + tL136 + 16 * (2 * w), LDN), fk1 = ldft(Ks + tL136 + 16 * (2 * w + 1), LDN);
      const f32x4 o1 = mma16(fvn, fat, (f32x4){0.f, 0.f, 0.f, 0.f});
      const f32x4 a00 = mma16(fk0, fv0, Sacc[0][0] * elast), a01 = mma16(fk0, fv1, Sacc[0][1] * elast);
      const f32x4 a10 = mma16(fk1, fv0, Sacc[1][0] * elast), a11 = mma16(fk1, fv1, Sacc[1][1] * elast);
      Sacc[0][0] = a00; Sacc[0][1] = a01; Sacc[1][0] = a10; Sacc[1][1] = a11;
      float o0 = o1[0] + eci * o2[0], o1v = o1[1] + eci * o2[1], o2v = o1[2] + eci * o2[2], o3 = o1[3] + eci * o2[3];
      if (!first) { const unsigned lo = (unsigned)ppv, hi = (unsigned)(ppv >> 32); o0 += bflo(lo); o1v += bfhi(lo); o2v += bflo(hi); o3 += bfhi(hi); }
      *(u32x2*)op = pk4(o0, o1v, o2v, o3);
      *(LAS u32x2*)(Sw + fr * LDN + 16 * (2 * w) + 4 * fq) = pk4(a00[0], a00[1], a00[2], a00[3]);
      *(LAS u32x2*)(Sw + (16 + fr) * LDN + 16 * (2 * w) + 4 * fq) = pk4(a01[0], a01[1], a01[2], a01[3]);
      *(LAS u32x2*)(Sw + fr * LDN + 16 * (2 * w + 1) + 4 * fq) = pk4(a10[0], a10[1], a10[2], a10[3]);
      *(LAS u32x2*)(Sw + (16 + fr) * LDN + 16 * (2 * w + 1) + 4 * fq) = pk4(a11[0], a11[1], a11[2], a11[3]); }
    LBAR();
  }
}

__device__ __forceinline__ void hgrn2_chain_wg(const Params& P, const Ctx& C, int task) {
  const int b = task >> 5, h = (task >> 2) & 7, vs = task & 3;
  const int d = C.wave >> 2, w = C.wave & 3, td = C.tid & 255, lane = C.lane, fr = lane & 15, fq = lane >> 4;
  constexpr int LDN = 136, LDP = 40;
  constexpr int DIRSZ = 72 * 1024;
  LAS unsigned char* L = C.lds + d * DIRSZ;
  LAS bf16_t* Qt = (LAS bf16_t*)L;
  LAS bf16_t* Kh = Qt + 32 * LDN;
  LAS bf16_t* Kw = Kh + 32 * LDN;
  LAS bf16_t* Vs = Kw + 32 * LDN;
  LAS bf16_t* Pt = Vs + 32 * LDP;
  LAS bf16_t* St = Pt + 32 * LDP;
  LAS float* PR = (LAS float*)(St + 2 * 32 * LDN);
  LAS float* PL = PR + 32 * 128;
  const bf16_t* Z = WS(OFF_Z1, bf16_t); bf16_t* MIX = WS(OFF_MIX1, bf16_t);
  const int colq = Z1_HQ + h * 128, colf = Z1_HF + d * 1024 + h * 128, colv = Z1_HI + h * 128 + vs * 32, outc = 1024 + h * 128 + vs * 32;
  __syncthreads();
  for (int i = td; i < 32 * LDP / 2; i += 256) ((LAS unsigned*)Pt)[i] = 0u;
  for (int i = td; i < 2 * 32 * LDN / 2; i += 256) ((LAS unsigned*)St)[i] = 0u;
  f32x4 Sacc[2][2];
#pragma unroll
  for (int a = 0; a < 2; ++a)
#pragma unroll
    for (int c = 0; c < 2; ++c) Sacc[a][c] = (f32x4){0.f, 0.f, 0.f, 0.f};
  const int st_t = td >> 3, st_s = td & 7;
  u32x4 rq[2], rf[2]; u32x2 rv;
  auto issue_loads = [&](int step) {
    const int chunk = seq_chunk32(d, step); const size_t row = (size_t)b * TB + chunk * 32 + st_t;
    const u32x4* pq = (const u32x4*)(Z + row * Z1W + colq + st_s * 16); const u32x4* pf = (const u32x4*)(Z + row * Z1W + colf + st_s * 16);
    rq[0] = pq[0]; rq[1] = pq[1]; rf[0] = pf[0]; rf[1] = pf[1];
    rv = *(const u32x2*)(Z + row * Z1W + colv + st_s * 4);
  };
  issue_loads(0);
  __syncthreads();
  const int rL136 = fr * LDN + 8 * fq;
  const int tq = fr >> 2, tp = fr & 3;
  const int tL136 = (8 * fq + tq) * LDN + 4 * tp, tL40 = (8 * fq + tq) * LDP + 4 * tp;
  const int vt = w & 1, it = w >> 1;
  const int si = d ? 31 - st_t : st_t;
  LAS float* prow = PR + si * 128 + st_s * 16;
  LAS float* pscan = PR + (td >> 7) * 16 * 128 + (td & 127);
  for (int step = 0; step < 264; ++step) {
    const int chunk = seq_chunk32(d, step); const int row0 = b * TB + chunk * 32;
    VMWAIT32(step);
    float qv[16], kk[16];
    { const unsigned qw[8] = {rq[0].x, rq[0].y, rq[0].z, rq[0].w, rq[1].x, rq[1].y, rq[1].z, rq[1].w};
      const unsigned fw[8] = {rf[0].x, rf[0].y, rf[0].z, rf[0].w, rf[1].x, rf[1].y, rf[1].z, rf[1].w};
      f32x4 f4[4];
#pragma unroll
      for (int e = 0; e < 8; ++e) { qv[2 * e] = bflo(qw[e]); qv[2 * e + 1] = bfhi(qw[e]);
        const f32x2 k2 = pg8::unpk2h(fw[e]);
        kk[2 * e] = k2[0]; kk[2 * e + 1] = k2[1]; f4[e >> 1][(2 * e) & 3] = 1.f - k2[0]; f4[e >> 1][(2 * e + 1) & 3] = 1.f - k2[1]; }
#pragma unroll
      for (int e = 0; e < 4; ++e) *(LAS f32x4*)(prow + 4 * e) = f4[e];
      *(LAS u32x2*)(Vs + si * LDP + st_s * 4) = rv; }
    LBAR();
    if (step + 1 < 264) issue_loads(step + 1);
    const bool first = (d == 0) == fwd_first32(chunk);
    bf16_t* op; unsigned long long ppv = 0ull;
    { const int ii = 16 * it + fr; const int t = d ? 31 - ii : ii; op = MIX + (size_t)(row0 + t) * MIXW + outc + 16 * vt + 4 * fq; if (!first) ppv = ld_agent_u64(op); }
    { float pv[16];
#pragma unroll
      for (int i = 0; i < 16; ++i) pv[i] = pscan[i * 128];
#pragma unroll
      for (int i = 1; i < 16; ++i) pv[i] *= pv[i - 1];
#pragma unroll
      for (int i = 0; i < 16; ++i) pscan[i * 128] = pv[i]; }
    LBAR();
    { const bool hi = si >= 16;
      f32x4 pp[4], p15[4], p31[4];
#pragma unroll
      for (int e4 = 0; e4 < 4; ++e4) { pp[e4] = *(const LAS f32x4*)(prow + 4 * e4); p15[e4] = *(const LAS f32x4*)(PR + 15 * 128 + st_s * 16 + 4 * e4); p31[e4] = *(const LAS f32x4*)(PR + 31 * 128 + st_s * 16 + 4 * e4); }
      unsigned oq[8], oh[8], ow[8]; f32x4 pl4[4];
#pragma unroll
      for (int e4 = 0; e4 < 4; ++e4) {
        f32x4 p = pp[e4]; const f32x4 pl = p15[e4] * p31[e4]; if (hi) p = p * p15[e4];
        pl4[e4] = pl;
        float q_[4], h_[4], w_[4];
#pragma unroll
        for (int r = 0; r < 4; ++r) { const int e = 4 * e4 + r; const float rp = __builtin_amdgcn_rcpf(__builtin_amdgcn_fmed3f(p[r], 1e-30f, 3.0e38f)); q_[r] = qv[e] * p[r]; h_[r] = kk[e] * rp; w_[r] = h_[r] * pl[r]; }
        oq[2 * e4] = pk2(q_[0], q_[1]); oq[2 * e4 + 1] = pk2(q_[2], q_[3]); oh[2 * e4] = pk2(h_[0], h_[1]); oh[2 * e4 + 1] = pk2(h_[2], h_[3]); ow[2 * e4] = pk2(w_[0], w_[1]); ow[2 * e4 + 1] = pk2(w_[2], w_[3]); }
      LAS u32x4* dq = (LAS u32x4*)(Qt + si * LDN + st_s * 16); LAS u32x4* dh = (LAS u32x4*)(Kh + si * LDN + st_s * 16); LAS u32x4* dw = (LAS u32x4*)(Kw + si * LDN + st_s * 16);
      dq[0] = (u32x4){oq[0], oq[1], oq[2], oq[3]}; dq[1] = (u32x4){oq[4], oq[5], oq[6], oq[7]};
      dh[0] = (u32x4){oh[0], oh[1], oh[2], oh[3]}; dh[1] = (u32x4){oh[4], oh[5], oh[6], oh[7]};
      dw[0] = (u32x4){ow[0], ow[1], ow[2], ow[3]}; dw[1] = (u32x4){ow[4], ow[5], ow[6], ow[7]};
      if (si == 0) {
#pragma unroll
        for (int e4 = 0; e4 < 4; ++e4) *(LAS f32x4*)(PL + st_s * 16 + 4 * e4) = pl4[e4]; } }
    LBAR();
    const LAS bf16_t* Sr = St + (step & 1) * 32 * LDN; LAS bf16_t* Sw = St + ((step + 1) & 1) * 32 * LDN;
    const int aI = w >= 1 ? 1 : 0, aJ = w == 2 ? 1 : 0;
    bf16x8 fa_[4], fb_[4], fs_[4], fq_[4];
    { const LAS bf16_t* pa = Qt + 16 * aI * LDN + rL136; const LAS bf16_t* pb = Kh + 16 * aJ * LDN + rL136;
      const LAS bf16_t* ps = Sr + 16 * vt * LDN + rL136; const LAS bf16_t* pq = Qt + 16 * it * LDN + rL136;
#pragma unroll
      for (int k = 0; k < 4; ++k) { fa_[k] = ldfr(pa + 32 * k); fb_[k] = ldfr(pb + 32 * k); fs_[k] = ldfr(ps + 32 * k); fq_[k] = ldfr(pq + 32 * k); } }
    const bf16x8 fv0 = ldft(Vs + tL40, LDP), fv1 = ldft(Vs + tL40 + 16, LDP);
    const bf16x8 fk0 = ldft(Kw + tL136 + 16 * (2 * w), LDN), fk1 = ldft(Kw + tL136 + 16 * (2 * w + 1), LDN);
    const f32x4 dec0 = *(const LAS f32x4*)(PL + 16 * (2 * w) + 4 * fq), dec1 = *(const LAS f32x4*)(PL + 16 * (2 * w + 1) + 4 * fq);
    f32x4 acc = (f32x4){0.f, 0.f, 0.f, 0.f}; f32x4 o2 = (f32x4){0.f, 0.f, 0.f, 0.f};
#pragma unroll
    for (int k = 0; k < 4; ++k) { acc = mma16(fa_[k], fb_[k], acc); o2 = mma16(fs_[k], fq_[k], o2); }
    const f32x4 a00 = mma16(fk0, fv0, Sacc[0][0] * dec0), a01 = mma16(fk0, fv1, Sacc[0][1] * dec0);
    const f32x4 a10 = mma16(fk1, fv0, Sacc[1][0] * dec1), a11 = mma16(fk1, fv1, Sacc[1][1] * dec1);
    Sacc[0][0] = a00; Sacc[0][1] = a01; Sacc[1][0] = a10; Sacc[1][1] = a11;
    if (w < 3) { const int jj = 16 * aJ + fr, i0 = 16 * aI + 4 * fq;
      *(LAS u32x2*)(Pt + jj * LDP + i0) = pk4(jj <= i0 ? acc[0] : 0.f, jj <= i0 + 1 ? acc[1] : 0.f, jj <= i0 + 2 ? acc[2] : 0.f, jj <= i0 + 3 ? acc[3] : 0.f); }
    *(LAS u32x2*)(Sw + fr * LDN + 16 * (2 * w) + 4 * fq) = pk4(a00[0], a00[1], a00[2], a00[3]);
    *(LAS u32x2*)(Sw + (16 + fr) * LDN + 16 * (2 * w) + 4 * fq) = pk4(a01[0], a01[1], a01[2], a01[3]);
    *(LAS u32x2*)(Sw + fr * LDN + 16 * (2 * w + 1) + 4 * fq) = pk4(a10[0], a10[1], a10[2], a10[3]);
    *(LAS u32x2*)(Sw + (16 + fr) * LDN + 16 * (2 * w + 1) + 4 * fq) = pk4(a11[0], a11[1], a11[2], a11[3]);
    LBAR();
    { const f32x4 o1 = mma16(ldft(Vs + tL40 + 16 * vt, LDP), ldft(Pt + tL40 + 16 * it, LDP), (f32x4){0.f, 0.f, 0.f, 0.f});
      float o0 = o1[0] + o2[0], o1v = o1[1] + o2[1], o2v = o1[2] + o2[2], o3 = o1[3] + o2[3];
      if (!first) { const unsigned lo = (unsigned)ppv, hi2 = (unsigned)(ppv >> 32); o0 += bflo(lo); o1v += bfhi(lo); o2v += bflo(hi2); o3 += bfhi(hi2); }
      *(u32x2*)op = pk4(o0, o1v, o2v, o3); }
    LBAR();
  }
}
template <int N> __device__ __forceinline__ void dpp_mul_shr(float& p) { asm volatile("v_mul_f32_dpp %0, %0, %0 row_shr:%1 row_mask:0xf bank_mask:0xf" : "+v"(p) : "n"(N)); }
__device__ __forceinline__ void dpp_mul_bcast15_odd(float& p) { asm volatile("v_mul_f32_dpp %0, %0, %0 row_bcast:15 row_mask:0xa bank_mask:0xf" : "+v"(p)); }
__device__ __forceinline__ void hgrn3_chain_wg(const Params& P, const Ctx& C, int task) {
  const int b = task >> 5, h = (task >> 2) & 7, vs = task & 3;
  const int d = C.wave >> 2, w = C.wave & 3, td = C.tid & 255, lane = C.lane, fr = lane & 15, fq = lane >> 4;
  constexpr int LDN = 136, LDP = 40;
  constexpr int DIRSZ = 48 * 1024;
  LAS unsigned char* L = C.lds + d * DIRSZ;
  LAS bf16_t* Qt = (LAS bf16_t*)L;
  LAS bf16_t* Kh = Qt + 32 * LDN;
  LAS bf16_t* Vs = Kh + 32 * LDN;
  LAS bf16_t* Pt = Vs + 2 * 32 * LDP;
  LAS bf16_t* St = Pt + 32 * LDP;
  LAS float* PL = (LAS float*)(St + 2 * 32 * LDN);
  const bf16_t* Z = WS(OFF_Z1, bf16_t); bf16_t* MIX = WS(OFF_MIX1, bf16_t);
  const int colq = Z1_HQ + h * 128, colf = Z1_HF + d * 1024 + h * 128, colv = Z1_HI + h * 128 + vs * 32, outc = 1024 + h * 128 + vs * 32;
  __syncthreads();
  for (int i = td; i < 32 * LDP / 2; i += 256) ((LAS unsigned*)Pt)[i] = 0u;
  for (int i = td; i < 2 * 32 * LDN / 2; i += 256) ((LAS unsigned*)St)[i] = 0u;
  f32x4 Sacc[2][2];
#pragma unroll
  for (int a = 0; a < 2; ++a)
#pragma unroll
    for (int c = 0; c < 2; ++c) Sacc[a][c] = (f32x4){0.f, 0.f, 0.f, 0.f};
  const int pg = 2 * w + (fq >> 1), psi = 16 * (fq & 1) + fr, ptok = d ? 31 - psi : psi;
  u32x4 rq[2], rf[2]; u32x2 rv;
  auto issue_loads = [&](int step) {
    const int chunk = seq_chunk32(d, step); const size_t row = (size_t)b * TB + chunk * 32 + ptok;
    const u32x4* pq = (const u32x4*)(Z + row * Z1W + colq + pg * 16); const u32x4* pf = (const u32x4*)(Z + row * Z1W + colf + pg * 16);
    rq[0] = pq[0]; rq[1] = pq[1]; rf[0] = pf[0]; rf[1] = pf[1];
    rv = *(const u32x2*)(Z + row * Z1W + colv + pg * 4);
  };
  LAS u32x4* dq = (LAS u32x4*)(Qt + psi * LDN + pg * 16); LAS u32x4* dh = (LAS u32x4*)(Kh + psi * LDN + pg * 16);
  auto prep = [&](int step) {
    const unsigned qw[8] = {rq[0].x, rq[0].y, rq[0].z, rq[0].w, rq[1].x, rq[1].y, rq[1].z, rq[1].w};
    const unsigned fw[8] = {rf[0].x, rf[0].y, rf[0].z, rf[0].w, rf[1].x, rf[1].y, rf[1].z, rf[1].w};
    float kk[16], p[16];
#pragma unroll
    for (int e = 0; e < 8; ++e) { const f32x2 k2 = pg8::unpk2h(fw[e]); kk[2 * e] = k2[0]; kk[2 * e + 1] = k2[1]; p[2 * e] = 1.f - k2[0]; p[2 * e + 1] = 1.f - k2[1]; }
    asm volatile("s_nop 4" : "+v"(p[0]), "+v"(p[1]), "+v"(p[2]), "+v"(p[3]), "+v"(p[4]), "+v"(p[5]), "+v"(p[6]), "+v"(p[7]), "+v"(p[8]), "+v"(p[9]), "+v"(p[10]), "+v"(p[11]), "+v"(p[12]), "+v"(p[13]), "+v"(p[14]), "+v"(p[15]));
#pragma unroll
    for (int e = 0; e < 16; ++e) dpp_mul_shr<1>(p[e]);
#pragma unroll
    for (int e = 0; e < 16; ++e) dpp_mul_shr<2>(p[e]);
#pragma unroll
    for (int e = 0; e < 16; ++e) dpp_mul_shr<4>(p[e]);
#pragma unroll
    for (int e = 0; e < 16; ++e) dpp_mul_shr<8>(p[e]);
#pragma unroll
    for (int e = 0; e < 16; ++e) dpp_mul_bcast15_odd(p[e]);
    unsigned oq[8], oh[8];
#pragma unroll
    for (int e = 0; e < 8; ++e) {
      const float rp0 = __builtin_amdgcn_rcpf(__builtin_amdgcn_fmed3f(p[2 * e], 1e-30f, 3.0e38f)), rp1 = __builtin_amdgcn_rcpf(__builtin_amdgcn_fmed3f(p[2 * e + 1], 1e-30f, 3.0e38f));
      oq[e] = pk2(bflo(qw[e]) * p[2 * e], bfhi(qw[e]) * p[2 * e + 1]); oh[e] = pk2(kk[2 * e] * rp0, kk[2 * e + 1] * rp1); }
    dq[0] = (u32x4){oq[0], oq[1], oq[2], oq[3]}; dq[1] = (u32x4){oq[4], oq[5], oq[6], oq[7]};
    dh[0] = (u32x4){oh[0], oh[1], oh[2], oh[3]}; dh[1] = (u32x4){oh[4], oh[5], oh[6], oh[7]};
    *(LAS u32x2*)(Vs + (step & 1) * 32 * LDP + psi * LDP + pg * 4) = rv;
    if (psi == 31) {
#pragma unroll
      for (int e4 = 0; e4 < 4; ++e4) *(LAS f32x4*)(PL + pg * 16 + 4 * e4) = (f32x4){p[4 * e4], p[4 * e4 + 1], p[4 * e4 + 2], p[4 * e4 + 3]}; }
  };
  issue_loads(0);
  const int rL136 = fr * LDN + 8 * fq;
  const int tq = fr >> 2, tp = fr & 3;
  const int tL136 = (8 * fq + tq) * LDN + 4 * tp, tL40 = (8 * fq + tq) * LDP + 4 * tp;
  const int vt = w & 1, it = w >> 1, aJ = w == 3 ? 1 : 0;
  __syncthreads();
  prep(0);
  issue_loads(1);
  LBAR();
  for (int step = 0; step < 264; ++step) {
    const int chunk = seq_chunk32(d, step); const int row0 = b * TB + chunk * 32;
    const bool first = (d == 0) == fwd_first32(chunk);
    bf16_t* op; unsigned long long ppv = 0ull;
    { const int ii = 16 * it + fr; const int t = d ? 31 - ii : ii; op = MIX + (size_t)(row0 + t) * MIXW + outc + 16 * vt + 4 * fq; if (!first) ppv = ld_agent_u64(op); }
    const LAS bf16_t* Sr = St + (step & 1) * 32 * LDN; LAS bf16_t* Sw = St + ((step + 1) & 1) * 32 * LDN;
    const LAS bf16_t* Vc = Vs + (step & 1) * 32 * LDP;
    bf16x8 fb_[4], fs_[4], fq_[4];
    { const LAS bf16_t* ps = Sr + 16 * vt * LDN + rL136; const LAS bf16_t* pq = Qt + 16 * it * LDN + rL136;
#pragma unroll
      for (int k = 0; k < 4; ++k) { fs_[k] = ldfr(ps + 32 * k); fq_[k] = ldfr(pq + 32 * k); } }
    if (w != 1) { const LAS bf16_t* pb = Kh + 16 * aJ * LDN + rL136;
#pragma unroll
      for (int k = 0; k < 4; ++k) fb_[k] = ldfr(pb + 32 * k); }
    else {
#pragma unroll
      for (int k = 0; k < 4; ++k) fb_[k] = fs_[k]; }
    const bf16x8 fv0 = ldft(Vc + tL40, LDP), fv1 = ldft(Vc + tL40 + 16, LDP);
    const bf16x8 fk0 = ldft(Kh + tL136 + 16 * (2 * w), LDN), fk1 = ldft(Kh + tL136 + 16 * (2 * w + 1), LDN);
    const f32x4 dec0 = *(const LAS f32x4*)(PL + 16 * (2 * w) + 4 * fq), dec1 = *(const LAS f32x4*)(PL + 16 * (2 * w + 1) + 4 * fq);
    f32x4 acc = (f32x4){0.f, 0.f, 0.f, 0.f}; f32x4 o2 = (f32x4){0.f, 0.f, 0.f, 0.f};
#pragma unroll
    for (int k = 0; k < 4; ++k) { o2 = mma16(fs_[k], fq_[k], o2); acc = mma16(fq_[k], fb_[k], acc); }
    const f32x4 a00 = mma16(fk0, fv0, Sacc[0][0]) * dec0, a01 = mma16(fk0, fv1, Sacc[0][1]) * dec0;
    const f32x4 a10 = mma16(fk1, fv0, Sacc[1][0]) * dec1, a11 = mma16(fk1, fv1, Sacc[1][1]) * dec1;
    Sacc[0][0] = a00; Sacc[0][1] = a01; Sacc[1][0] = a10; Sacc[1][1] = a11;
    if (w != 1) { const int jj = 16 * aJ + fr, i0 = 16 * it + 4 * fq;
      *(LAS u32x2*)(Pt + jj * LDP + i0) = pk4(jj <= i0 ? acc[0] : 0.f, jj <= i0 + 1 ? acc[1] : 0.f, jj <= i0 + 2 ? acc[2] : 0.f, jj <= i0 + 3 ? acc[3] : 0.f); }
    *(LAS u32x2*)(Sw + fr * LDN + 16 * (2 * w) + 4 * fq) = pk4(a00[0], a00[1], a00[2], a00[3]);
    *(LAS u32x2*)(Sw + (16 + fr) * LDN + 16 * (2 * w) + 4 * fq) = pk4(a01[0], a01[1], a01[2], a01[3]);
    *(LAS u32x2*)(Sw + fr * LDN + 16 * (2 * w + 1) + 4 * fq) = pk4(a10[0], a10[1], a10[2], a10[3]);
    *(LAS u32x2*)(Sw + (16 + fr) * LDN + 16 * (2 * w + 1) + 4 * fq) = pk4(a11[0], a11[1], a11[2], a11[3]);
    LBAR();
    { const f32x4 o1 = mma16(ldft(Vc + tL40 + 16 * vt, LDP), ldft(Pt + tL40 + 16 * it, LDP), (f32x4){0.f, 0.f, 0.f, 0.f});
      float o0 = o1[0] + o2[0], o1v = o1[1] + o2[1], o2v = o1[2] + o2[2], o3 = o1[3] + o2[3];
      if (!first) { const unsigned lo = (unsigned)ppv, hi2 = (unsigned)(ppv >> 32); o0 += bflo(lo); o1v += bfhi(lo); o2v += bflo(hi2); o3 += bfhi(hi2); }
      *(u32x2*)op = pk4(o0, o1v, o2v, o3); }
    if (step + 1 < 264) prep(step + 1);
    VMWAIT32(step + 1);
    if (step + 2 < 264) issue_loads(step + 2);
    LBAR();
  }
}
__device__ __forceinline__ void phase_chain1(const Params& P, const Ctx& C, int mode) {
  auto sib = [](int t) { return ((t & 31) << 2) | (t >> 5); };
  if (mode != 2) for (int task = C.bid; task < 128; task += C.nblk) gdn3_chain_wg(P, C, sib(task));
  __builtin_amdgcn_sched_barrier(0);
  if (mode != 1) for (int task = C.bid < 128 ? C.bid + C.nblk : C.bid; task < 256; task += C.nblk) hgrn3_chain_wg(P, C, sib(task - 128));
}
__device__ __forceinline__ void phase_onorm(const Params& P, const Ctx& C, int ident) {
  bf16_t* MIX = WS(OFF_MIX1, bf16_t); bf16_t* U = WS(OFF_U1B, bf16_t);
  const float* m1 = WS(OFF_MOD, float) + (size_t)5 * 6144;
  for (int r = C.gw; r < R; r += C.ngw) {
    const int b = r / TB, pos = r % TB; if (pos < CTXL) continue;
    f32x4 h[4], u[4]; row_load(GOUT + ((size_t)b * SEQ + (pos - CTXL)) * D, C.lane, h);
    row_modulate(h, m1 + (size_t)b * 6144, m1 + (size_t)b * 6144 + D, C.lane, u);
    row_store_bf16(U + (size_t)r * D, C.lane, u);
  }
  LAS float* scr = (LAS float*)C.lds + C.wave * (64 * 33);
  convert_experts(P, 1, WS(OFF_WE1, bf16_t), WS(OFF_WE1 + 64 * MiB, bf16_t), C, scr);
}
__device__ __forceinline__ void phase_gates(const Params& P, const Ctx& C) {
  pg8::Gemm g{WS(OFF_U1B, bf16_t), WS(OFF_WG1, bf16_t), D, D}; pg8::GridOrder S; S.init(128, 8, C.nblk, C.bid, 1);
  pg8::EpiGateMul E{WS(OFF_MIX1, bf16_t), MIXW, (LAS float*)(C.lds + 131072), GIN(I_GNG), GIN(I_HNG)};
  pg8::gemm_phase(C.lds, g, S, E);
}


#define XB_TMO      128
#define XB_XCNT(j)  (256  + 64 * (j))
#define XB_XSUB(j)  (1280 + 64 * (j))
#define XB_XGEN(j)  (2304 + 64 * (j))
#define XB_TOP      3328
#define XB_TOPGEN   3392
#define XCD_BAR_WORDS 3456
#define XB_SPIN_CAP (1u << 22)
constexpr size_t OFF_BAR = 16 * 1024;
constexpr int LDS_BAR_OFF = LDS_BYTES - 64;
__device__ __forceinline__ unsigned xb_ld(unsigned* p)              { return __hip_atomic_load(p, __ATOMIC_RELAXED, __HIP_MEMORY_SCOPE_AGENT); }
__device__ __forceinline__ unsigned xb_add(unsigned* p, unsigned v) { return __hip_atomic_fetch_add(p, v, __ATOMIC_RELAXED, __HIP_MEMORY_SCOPE_AGENT); }
__device__ __forceinline__ unsigned xb_xcc_id() { return (unsigned)__builtin_amdgcn_s_getreg((3 << 11) | 20) & 0xFu; }
#define XB_SPIN(cond, bar) do { unsigned _sp = 0; while (cond) { __builtin_amdgcn_s_sleep(8); \
    if ((++_sp & 255u) == 0u) { if (xb_ld(&(bar)[XB_TMO])) break; if (_sp > XB_SPIN_CAP) { atomicAdd(&(bar)[XB_TMO], 1u); break; } } } } while (0)
__device__ __forceinline__ void xcd_barrier_post(unsigned* bar) { if (threadIdx.x == 0) (void)xb_add(&bar[XB_XCNT(xb_xcc_id())], 1u); }
__device__ __forceinline__ void xcd_barrier_complete(unsigned* bar, unsigned x, unsigned& nloc, unsigned& nx) {
  const unsigned G = gridDim.x * gridDim.y * gridDim.z;
  unsigned sum, cnt, mine, sp = 0u;
  for (;;) {
    sum = 0u; cnt = 0u; mine = 0u;
#pragma unroll
    for (unsigned j = 0; j < 16; ++j) { const unsigned c = xb_ld(&bar[XB_XCNT(j)]); sum += c; cnt += (c > 0u) ? 1u : 0u; mine = (j == x) ? c : mine; }
    if (sum == G) break;
    __builtin_amdgcn_s_sleep(1);
    if ((++sp & 255u) == 0u) { if (xb_ld(&bar[XB_TMO])) break; if (sp > XB_SPIN_CAP) { atomicAdd(&bar[XB_TMO], 1u); break; } }
  }
  nloc = mine > 0u ? mine : 1u; nx = cnt > 0u ? cnt : 1u;
}
__device__ __forceinline__ void xcd_barrier(unsigned* bar, volatile LAS unsigned* st) {
  asm volatile("s_waitcnt vmcnt(0)" ::: "memory");
  __syncthreads();
  if (threadIdx.x == 0) {
    const unsigned x = xb_xcc_id();
    __builtin_amdgcn_s_waitcnt(0);
    unsigned nloc = st[0], nx = st[1];
    if (nloc == 0u) { xcd_barrier_complete(bar, x, nloc, nx); st[0] = nloc; st[1] = nx; }
    const unsigned old = xb_add(&bar[XB_XSUB(x)], 1u);
    const unsigned gen = old / nloc;
    if (old + 1u == (gen + 1u) * nloc) {
      __builtin_amdgcn_fence(__ATOMIC_RELEASE, "agent");
      asm volatile("s_waitcnt vmcnt(0)" ::: "memory");
      const unsigned og = xb_add(&bar[XB_TOP], 1u);
      const unsigned tg = og / nx;
      if (og + 1u == (tg + 1u) * nx) xb_add(&bar[XB_TOPGEN], 1u);
      else XB_SPIN(xb_ld(&bar[XB_TOPGEN]) == tg, bar);
      __builtin_amdgcn_fence(__ATOMIC_ACQUIRE, "agent");
      xb_add(&bar[XB_XGEN(x)], 1u);
      asm volatile("s_waitcnt vmcnt(0)" ::: "memory");
    } else {
      XB_SPIN(xb_ld(&bar[XB_XGEN(x)]) == gen, bar);
      __builtin_amdgcn_fence(__ATOMIC_ACQUIRE, "agent");
      asm volatile("s_waitcnt vmcnt(0)" ::: "memory");
    }
  }
  __syncthreads();
}
__global__ void __launch_bounds__(NT, 2) fwd_megakernel(Params Pk) {
  extern __shared__ __attribute__((aligned(16))) unsigned char lds_raw[];
  cg::grid_group grid = cg::this_grid();
#ifndef PADS
#define PADS {4, 0,0,0,0,0, 7,0,0,15,0, 0,0,0,0,7, 0,0,0,0,0, 0}
#endif
constexpr int PADN[22] = PADS;
#ifndef PROBE_DOUBLE
#define PROBE_DOUBLE -1
#endif
#ifndef PROBE_MODE
#define PROBE_MODE 0
#endif
#ifndef PHASE_MASK
#define PHASE_MASK 0xFFFFFFFFu
#endif
#define SYNC() do { const unsigned char* wsb_ = ((const Params*)(const __attribute__((address_space(4))) Params*)__builtin_amdgcn_kernarg_segment_ptr())->ws; \
    xcd_barrier((unsigned*)(GAS unsigned*)(wsb_ + OFF_BAR), (volatile LAS unsigned*)((LAS unsigned char*)lds_raw + LDS_BAR_OFF)); } while (0)
#define SYNC_CG() do { __syncthreads(); grid.sync(); } while (0)
#define PADK(k) asm volatile(".rept %0\n\ts_nop 0\n\t.endr" :: "n"(PADN[k]))
  PADK(0);
  if (threadIdx.x < 16) ((LAS unsigned*)((LAS unsigned char*)lds_raw + LDS_BAR_OFF))[threadIdx.x] = 0u;
  __syncthreads();
  xcd_barrier_post((unsigned*)(GAS unsigned*)(Pk.ws + OFF_BAR));
#define LAUNDER() const Params* pp; { unsigned long long a_ = (unsigned long long)__builtin_amdgcn_kernarg_segment_ptr(); asm volatile("" : "+s"(a_)); \
    const unsigned lo_ = __builtin_amdgcn_readfirstlane((unsigned)a_), hi_ = __builtin_amdgcn_readfirstlane((unsigned)(a_ >> 32)); \
    pp = (const Params*)(const __attribute__((address_space(4))) Params*)(((unsigned long long)hi_ << 32) | lo_); } \
  Ctx C; { int t_ = threadIdx.x; asm volatile("" : "+v"(t_)); t_ &= 511; int b_ = blockIdx.x; asm volatile("" : "+s"(b_)); b_ = __builtin_amdgcn_readfirstlane(b_); int g_ = gridDim.x; asm volatile("" : "+s"(g_)); g_ = __builtin_amdgcn_readfirstlane(g_); \
    C.lds = (LAS unsigned char*)lds_raw; C.tid = t_; C.lane = t_ & 63; C.wave = __builtin_amdgcn_readfirstlane(t_ >> 6); \
    C.bid = b_; C.nblk = g_; C.gw = b_ * NWAVES + C.wave; C.ngw = g_ * NWAVES; }
#define WSP(off, T) ((T*)(GAS T*)(pp->ws + (off)))
  PADK(1); for (int rep_ = 0; rep_ < ((PROBE_DOUBLE == 0) ? 2 : 1); ++rep_) { if (PHASE_MASK & (1u << 0)) { LAUNDER(); phase0(*pp, C); }  SYNC_CG(); }
  PADK(2); for (int rep_ = 0; rep_ < ((PROBE_DOUBLE == 1) ? 2 : 1); ++rep_) { if (PHASE_MASK & (1u << 1)) { LAUNDER(); phase_u0(*pp, C); }  SYNC(); }
  PADK(3); for (int rep_ = 0; rep_ < ((PROBE_DOUBLE == 2) ? 2 : 1); ++rep_) { if (PHASE_MASK & (1u << 2)) { LAUNDER(); phase_inproj(*pp, C, WSP(OFF_U0, bf16_t), WSP(OFF_WAB, bf16_t), WSP(OFF_Z0, bf16_t), Z0W); }  SYNC(); }
  PADK(4); for (int rep_ = 0; rep_ < ((PROBE_DOUBLE == 3) ? 2 : 1); ++rep_) { if (PHASE_MASK & (1u << 3)) { LAUNDER(); phase_feat0(*pp, C, rep_); }  SYNC(); }
  PADK(5); for (int rep_ = 0; rep_ < ((PROBE_DOUBLE == 4) ? 2 : 1); ++rep_) { if (PHASE_MASK & (1u << 4)) { LAUNDER(); phase_chain0(*pp, C, rep_ ? PROBE_MODE : 0); }  SYNC(); }
  PADK(6); for (int rep_ = 0; rep_ < ((PROBE_DOUBLE == 5) ? 2 : 1); ++rep_) { if (PHASE_MASK & (1u << 5)) { LAUNDER(); phase_ssdfin(*pp, C, rep_); }  SYNC(); }
  PADK(7); for (int rep_ = 0; rep_ < ((PROBE_DOUBLE == 6) ? 2 : 1); ++rep_) { if (PHASE_MASK & (1u << 6)) { LAUNDER(); phase_outproj(*pp, C, 0); }  SYNC(); }
  PADK(8); for (int rep_ = 0; rep_ < ((PROBE_DOUBLE == 7) ? 2 : 1); ++rep_) { if (PHASE_MASK & (1u << 7)) { LAUNDER(); phase_lnmix(*pp, C, 0, rep_); }  SYNC(); }
  PADK(9); for (int rep_ = 0; rep_ < ((PROBE_DOUBLE == 9) ? 2 : 1); ++rep_) { if (PHASE_MASK & (1u << 9)) { LAUNDER(); phase_moe1(*pp, C, 0); }  SYNC(); }
  PADK(10); for (int rep_ = 0; rep_ < ((PROBE_DOUBLE == 10) ? 2 : 1); ++rep_) { if (PHASE_MASK & (1u << 10)) { LAUNDER(); phase_moe2(*pp, C, 0); }  SYNC(); }
  PADK(11); for (int rep_ = 0; rep_ < ((PROBE_DOUBLE == 11) ? 2 : 1); ++rep_) { if (PHASE_MASK & (1u << 11)) { LAUNDER(); phase_lnffn(*pp, C, 0, rep_); }  SYNC(); }
  PADK(12); for (int rep_ = 0; rep_ < ((PROBE_DOUBLE == 12) ? 2 : 1); ++rep_) { if (PHASE_MASK & (1u << 12)) { LAUNDER(); phase_inproj(*pp, C, WSP(OFF_U1, bf16_t), WSP(OFF_WCD, bf16_t), WSP(OFF_Z1, bf16_t), Z1W); }  SYNC(); }
  PADK(13); for (int rep_ = 0; rep_ < ((PROBE_DOUBLE == 13) ? 2 : 1); ++rep_) { if (PHASE_MASK & (1u << 13)) { LAUNDER(); phase_feat1(*pp, C, rep_); }  SYNC(); }
  PADK(14); for (int rep_ = 0; rep_ < ((PROBE_DOUBLE == 14) ? 2 : 1); ++rep_) { if (PHASE_MASK & (1u << 14)) { LAUNDER(); phase_chain1(*pp, C, rep_ ? PROBE_MODE : 0); }  SYNC(); }
  PADK(15); for (int rep_ = 0; rep_ < ((PROBE_DOUBLE == 15) ? 2 : 1); ++rep_) { if (PHASE_MASK & (1u << 15)) { LAUNDER(); phase_onorm(*pp, C, rep_); }  SYNC(); }
  PADK(16); for (int rep_ = 0; rep_ < ((PROBE_DOUBLE == 16) ? 2 : 1); ++rep_) { if (PHASE_MASK & (1u << 16)) { LAUNDER(); phase_gates(*pp, C); }  SYNC(); }
  PADK(17); for (int rep_ = 0; rep_ < ((PROBE_DOUBLE == 17) ? 2 : 1); ++rep_) { if (PHASE_MASK & (1u << 17)) { LAUNDER(); phase_outproj(*pp, C, 1); }  SYNC(); }
  PADK(18); for (int rep_ = 0; rep_ < ((PROBE_DOUBLE == 18) ? 2 : 1); ++rep_) { if (PHASE_MASK & (1u << 18)) { LAUNDER(); phase_lnmix(*pp, C, 1, rep_); }  SYNC(); }
  PADK(19); for (int rep_ = 0; rep_ < ((PROBE_DOUBLE == 20) ? 2 : 1); ++rep_) { if (PHASE_MASK & (1u << 20)) { LAUNDER(); phase_moe1(*pp, C, 1); }  SYNC(); }
  PADK(20); for (int rep_ = 0; rep_ < ((PROBE_DOUBLE == 21) ? 2 : 1); ++rep_) { if (PHASE_MASK & (1u << 21)) { LAUNDER(); phase_moe2(*pp, C, 1); }  SYNC(); }
  PADK(21); for (int rep_ = 0; rep_ < ((PROBE_DOUBLE == 22) ? 2 : 1); ++rep_) { if (PHASE_MASK & (1u << 22)) { LAUNDER(); phase_lnffn(*pp, C, 1, rep_); } if (PROBE_DOUBLE == 22) SYNC(); }
}

extern "C" void kernel_launch(void* const* d_in, const int* in_sizes, int n_in, void* d_out, int out_size,
                              void* d_ws, size_t ws_size, hipStream_t stream) {
  static int grid_blocks = 0;
  if (!grid_blocks) {
    int dev = 0, cus = 0, per_cu = 0;
    (void)hipGetDevice(&dev);
    (void)hipDeviceGetAttribute(&cus, hipDeviceAttributeMultiprocessorCount, dev);
    (void)hipFuncSetAttribute((const void*)fwd_megakernel, hipFuncAttributeMaxDynamicSharedMemorySize, LDS_BYTES);
    (void)hipOccupancyMaxActiveBlocksPerMultiprocessor(&per_cu, (const void*)fwd_megakernel, NT, LDS_BYTES);
    if (per_cu < 1) per_cu = 1;
    grid_blocks = cus * 1;
    fprintf(stderr, "grid %d (cus %d per_cu %d) ws_size %zu need %zu n_in %d\n", grid_blocks, cus, per_cu, ws_size, (size_t)WS_NEED, n_in);
    if (ws_size < WS_NEED || n_in != 39) { fprintf(stderr, "kernel_launch: workspace too small or unexpected inputs\n"); grid_blocks = -1; }
  }
  if (grid_blocks < 0) return;
  (void)hipMemsetAsync(d_ws, 0, 64 * 1024, stream);
  Params p{};
  for (int i = 0; i < 39; ++i) p.in[i] = (const float*)d_in[i];
  p.out = (float*)d_out; p.ws = (unsigned char*)d_ws;
  void* args[] = {&p};
  hipError_t e = hipLaunchCooperativeKernel((const void*)fwd_megakernel, dim3(grid_blocks), dim3(NT), args, LDS_BYTES, stream);
  if (e != hipSuccess) fprintf(stderr, "cooperative launch failed: %s (grid %d)\n", hipGetErrorString(e), grid_blocks);
}
```
